# Optimizing an MI355X kernel written in HIP

```python
import math
import jax
import jax.numpy as jnp
from jax import lax
import numpy as np


D_MODEL = 4096
BATCH = 2
SEQ = 8192
DEPTH = 1
DEC_BATCH = 2
DEC_SEQ = 4096
PAST_LEN = 128

MIX_WIDTH = D_MODEL
SSM_WIDTH = MIX_WIDTH // 2
SSM_GROUP = 16
SSM_GROUPS = SSM_WIDTH // SSM_GROUP
SSM_STATE = 64
ATTN_WIDTH = MIX_WIDTH - SSM_WIDTH
V_HEAD_DIM = 128
N_HEADS = ATTN_WIDTH // V_HEAD_DIM
QK_NOPE_DIM = 128
QK_ROPE_DIM = 64
Q_LORA_RANK = 896
KV_LORA_RANK = 512
IN_COLS = SSM_WIDTH + Q_LORA_RANK + KV_LORA_RANK + QK_ROPE_DIM
D_FF = 11008
CONV_WIDTH = 3
Q_BLOCK = 128
ROPE_THETA = 10000.0
EPS = 1e-6

kernel_name = 'hymba_s5_mla_convffn_encoder'


def rms_norm(x, g):
    xf = x.astype(jnp.float32)
    xf = xf * lax.rsqrt(jnp.mean(xf * xf, axis=-1, keepdims=True) + EPS)
    return (xf * g.astype(jnp.float32)).astype(x.dtype)


def rope_tables(length):
    inv = 1.0 / (ROPE_THETA ** (jnp.arange(0, QK_ROPE_DIM, 2, dtype=jnp.float32) / QK_ROPE_DIM))
    ang = jnp.arange(length, dtype=jnp.float32)[:, None] * inv[None, :]
    return jnp.cos(ang)[:, None, :], jnp.sin(ang)[:, None, :]


def apply_rope(x, cos, sin):
    xf = x.astype(jnp.float32)
    half = QK_ROPE_DIM // 2
    x1, x2 = xf[..., :half], xf[..., half:]
    return jnp.concatenate([x1 * cos - x2 * sin, x2 * cos + x1 * sin], axis=-1).astype(x.dtype)


def _ssm_combine(earlier, later):
    a_i, b_i = earlier
    a_j, b_j = later
    return a_j * a_i, a_j * b_i + b_j


def s5_mixer(u, a_re, a_im, b_re, b_im, c_re, c_im, log_dt, d_skip, glu_w):
    bsz, length, _ = u.shape
    uf = u.astype(jnp.float32).reshape(bsz, length, SSM_GROUPS, SSM_GROUP)
    lam = lax.complex(a_re.astype(jnp.float32), a_im.astype(jnp.float32))
    dt = jnp.exp(log_dt.astype(jnp.float32))[..., None]
    abar = jnp.exp(lam * dt)
    bmat = lax.complex(b_re.astype(jnp.float32), b_im.astype(jnp.float32))
    bbar = ((abar - 1.0) / lam)[..., None] * bmat
    cmat = lax.complex(c_re.astype(jnp.float32), c_im.astype(jnp.float32))
    uc = uf.astype(jnp.complex64)
    y = d_skip.astype(jnp.float32) * uf
    for direction in range(2):
        bu = jnp.einsum('blgh,gph->blgp', uc, bbar[direction])
        a_el = jnp.broadcast_to(abar[direction], bu.shape)
        _, states = lax.associative_scan(_ssm_combine, (a_el, bu), reverse=(direction == 1), axis=1)
        y = y + jnp.real(jnp.einsum('blgp,ghp->blgh', states, cmat[direction]))
    y = y.reshape(bsz, length, SSM_WIDTH).astype(u.dtype)
    g = jax.nn.gelu(y)
    return g * jax.nn.sigmoid(g @ glu_w)


def mla_mixer(q_lat, kv_lat, k_rope_raw, q_norm_g, w_q_up, kv_norm_g, w_kv_up):
    bsz, length, _ = q_lat.shape
    q = (rms_norm(q_lat, q_norm_g) @ w_q_up).reshape(bsz, length, N_HEADS, QK_NOPE_DIM + QK_ROPE_DIM)
    kv = (rms_norm(kv_lat, kv_norm_g) @ w_kv_up).reshape(bsz, length, N_HEADS, QK_NOPE_DIM + V_HEAD_DIM)
    cos, sin = rope_tables(length)
    q_nope = q[..., :QK_NOPE_DIM]
    q_rope = apply_rope(q[..., QK_NOPE_DIM:], cos, sin)
    k_nope = kv[..., :QK_NOPE_DIM]
    v = kv[..., QK_NOPE_DIM:]
    k_rope = apply_rope(k_rope_raw[:, :, None, :], cos, sin)[:, :, 0, :]
    qb = min(Q_BLOCK, length)
    nb = length // qb
    qn_blocks = q_nope.reshape(bsz, nb, qb, N_HEADS, QK_NOPE_DIM).swapaxes(0, 1)
    qr_blocks = q_rope.reshape(bsz, nb, qb, N_HEADS, QK_ROPE_DIM).swapaxes(0, 1)
    scale = (QK_NOPE_DIM + QK_ROPE_DIM) ** -0.5

    def attend(blk):
        qn, qr = blk
        s = jnp.einsum('bqhd,bkhd->bhqk', qn, k_nope) + jnp.einsum('bqhr,bkr->bhqk', qr, k_rope)
        p = jax.nn.softmax(s.astype(jnp.float32) * scale, axis=-1).astype(v.dtype)
        return jnp.einsum('bhqk,bkhd->bqhd', p, v)

    out = lax.map(attend, (qn_blocks, qr_blocks))
    return out.swapaxes(0, 1).reshape(bsz, length, ATTN_WIDTH)


def conv_ffn(h, w_up, w_gate, conv_w, conv_b, w_down):
    up = h @ w_up
    pad = jnp.pad(up, ((0, 0), (1, 1), (0, 0)))
    up = pad[:, :-2] * conv_w[0] + pad[:, 1:-1] * conv_w[1] + pad[:, 2:] * conv_w[2] + conv_b
    return (jax.nn.silu(up) * (h @ w_gate)) @ w_down


def encode(x, w_in, norm_mix_g, ssm_a_re, ssm_a_im, ssm_b_re, ssm_b_im, ssm_c_re, ssm_c_im,
           ssm_log_dt, ssm_d, ssm_glu_w, q_norm_g, w_q_up, kv_norm_g, w_kv_up, ssm_out_norm_g,
           attn_out_norm_g, w_out, norm_ffn_g, w_ffn_up, w_ffn_gate, ffn_conv_w, ffn_conv_b,
           w_ffn_down, norm_final_g):
    o1 = SSM_WIDTH
    o2 = o1 + Q_LORA_RANK
    o3 = o2 + KV_LORA_RANK
    for l in range(DEPTH):
        h = rms_norm(x, norm_mix_g[l])
        proj = h @ w_in[l]
        ssm_out = s5_mixer(proj[..., :o1], ssm_a_re[l], ssm_a_im[l], ssm_b_re[l], ssm_b_im[l],
                           ssm_c_re[l], ssm_c_im[l], ssm_log_dt[l], ssm_d[l], ssm_glu_w[l])
        attn_out = mla_mixer(proj[..., o1:o2], proj[..., o2:o3], proj[..., o3:],
                             q_norm_g[l], w_q_up[l], kv_norm_g[l], w_kv_up[l])
        merged = jnp.concatenate([rms_norm(ssm_out, ssm_out_norm_g[l]),
                                  rms_norm(attn_out, attn_out_norm_g[l])], axis=-1)
        x = x + merged @ w_out[l]
        x = x + conv_ffn(rms_norm(x, norm_ffn_g[l]), w_ffn_up[l], w_ffn_gate[l],
                         ffn_conv_w[l], ffn_conv_b[l], w_ffn_down[l])
    return rms_norm(x, norm_final_g)


def setup_inputs(seed: int = 0) -> dict:
    key = jax.random.key(seed)
    ks = jax.random.split(key, 32)
    f32 = jnp.float32

    def nrm(k, shape, scale):
        return jax.random.normal(k, shape, f32) * scale

    def gain(k, shape):
        return 1.0 + 0.02 * jax.random.normal(k, shape, f32)

    a_re = -0.5 + 0.01 * jax.random.normal(ks[4], (DEPTH, 2, SSM_GROUPS, SSM_STATE), f32)
    a_im = math.pi * jnp.arange(SSM_STATE, dtype=f32) + 0.01 * jax.random.normal(ks[5], (DEPTH, 2, SSM_GROUPS, SSM_STATE), f32)
    log_dt = jax.random.uniform(ks[10], (DEPTH, 2, SSM_GROUPS), f32, math.log(0.001), math.log(0.1))
    return {
        'x_prompt': jax.random.normal(ks[0], (BATCH, SEQ, D_MODEL), f32),
        'x_sample': jax.random.normal(ks[1], (DEC_BATCH, DEC_SEQ, D_MODEL), f32),
        'w_in': nrm(ks[2], (DEPTH, D_MODEL, IN_COLS), D_MODEL ** -0.5),
        'norm_mix_g': gain(ks[3], (DEPTH, D_MODEL)),
        'ssm_a_re': a_re,
        'ssm_a_im': a_im,
        'ssm_b_re': nrm(ks[6], (DEPTH, 2, SSM_GROUPS, SSM_STATE, SSM_GROUP), (2 * SSM_GROUP) ** -0.5),
        'ssm_b_im': nrm(ks[7], (DEPTH, 2, SSM_GROUPS, SSM_STATE, SSM_GROUP), (2 * SSM_GROUP) ** -0.5),
        'ssm_c_re': nrm(ks[8], (DEPTH, 2, SSM_GROUPS, SSM_GROUP, SSM_STATE), (2 * SSM_STATE) ** -0.5),
        'ssm_c_im': nrm(ks[9], (DEPTH, 2, SSM_GROUPS, SSM_GROUP, SSM_STATE), (2 * SSM_STATE) ** -0.5),
        'ssm_log_dt': log_dt,
        'ssm_d': nrm(ks[11], (DEPTH, SSM_GROUPS, SSM_GROUP), 1.0),
        'ssm_glu_w': nrm(ks[12], (DEPTH, SSM_WIDTH, SSM_WIDTH), SSM_WIDTH ** -0.5),
        'q_norm_g': gain(ks[13], (DEPTH, Q_LORA_RANK)),
        'w_q_up': nrm(ks[14], (DEPTH, Q_LORA_RANK, N_HEADS * (QK_NOPE_DIM + QK_ROPE_DIM)), Q_LORA_RANK ** -0.5),
        'kv_norm_g': gain(ks[15], (DEPTH, KV_LORA_RANK)),
        'w_kv_up': nrm(ks[16], (DEPTH, KV_LORA_RANK, N_HEADS * (QK_NOPE_DIM + V_HEAD_DIM)), KV_LORA_RANK ** -0.5),
        'ssm_out_norm_g': gain(ks[17], (DEPTH, SSM_WIDTH)),
        'attn_out_norm_g': gain(ks[18], (DEPTH, ATTN_WIDTH)),
        'w_out': nrm(ks[19], (DEPTH, MIX_WIDTH, D_MODEL), MIX_WIDTH ** -0.5),
        'norm_ffn_g': gain(ks[20], (DEPTH, D_MODEL)),
        'w_ffn_up': nrm(ks[21], (DEPTH, D_MODEL, D_FF), D_MODEL ** -0.5),
        'w_ffn_gate': nrm(ks[22], (DEPTH, D_MODEL, D_FF), D_MODEL ** -0.5),
        'ffn_conv_w': nrm(ks[23], (DEPTH, CONV_WIDTH, D_FF), CONV_WIDTH ** -0.5),
        'ffn_conv_b': nrm(ks[24], (DEPTH, D_FF), 0.02),
        'w_ffn_down': nrm(ks[25], (DEPTH, D_FF, D_MODEL), D_FF ** -0.5),
        'norm_final_g': gain(ks[26], (D_MODEL,)),
    }


def reference(x_prompt, x_sample, w_in, norm_mix_g, ssm_a_re, ssm_a_im, ssm_b_re, ssm_b_im,
              ssm_c_re, ssm_c_im, ssm_log_dt, ssm_d, ssm_glu_w, q_norm_g, w_q_up, kv_norm_g,
              w_kv_up, ssm_out_norm_g, attn_out_norm_g, w_out, norm_ffn_g, w_ffn_up, w_ffn_gate,
              ffn_conv_w, ffn_conv_b, w_ffn_down, norm_final_g):
    y_prompt = encode(x_prompt, w_in, norm_mix_g, ssm_a_re, ssm_a_im, ssm_b_re, ssm_b_im, ssm_c_re,
                      ssm_c_im, ssm_log_dt, ssm_d, ssm_glu_w, q_norm_g, w_q_up, kv_norm_g, w_kv_up,
                      ssm_out_norm_g, attn_out_norm_g, w_out, norm_ffn_g, w_ffn_up, w_ffn_gate,
                      ffn_conv_w, ffn_conv_b, w_ffn_down, norm_final_g)
    y_sample = encode(x_sample, w_in, norm_mix_g, ssm_a_re, ssm_a_im, ssm_b_re, ssm_b_im, ssm_c_re,
                      ssm_c_im, ssm_log_dt, ssm_d, ssm_glu_w, q_norm_g, w_q_up, kv_norm_g, w_kv_up,
                      ssm_out_norm_g, attn_out_norm_g, w_out, norm_ffn_g, w_ffn_up, w_ffn_gate,
                      ffn_conv_w, ffn_conv_b, w_ffn_down, norm_final_g)
    return (y_prompt, y_sample)
```

```cpp
#include <hip/hip_runtime.h>
#include <hip/hip_bf16.h>
#include <cstdio>
#include <cstdint>

namespace pg8 {
#define PG8_LAS __attribute__((address_space(3)))
typedef unsigned short bf16_t;
typedef short bf16x8 __attribute__((ext_vector_type(8)));
typedef float f32x4 __attribute__((ext_vector_type(4)));
typedef float f32x2 __attribute__((ext_vector_type(2)));
typedef unsigned u32x4 __attribute__((ext_vector_type(4)));
typedef unsigned u32x2 __attribute__((ext_vector_type(2)));
constexpr int BM = 256, BK = 64, HALF = 128, HTB = HALF * BK * 2  , STAGE_BYTES = 8 * HTB, NXCD = 8, WGM = 8;

__host__ __device__ __forceinline__ int lds_byte(int r, int c) { const int st = (r >> 4) * 2 + (c >> 5), rr = r & 15, cc = c & 31, ob = rr * 64 + cc * 2; return st * 1024 + (ob ^ (((ob >> 9) & 1) << 5)); }
__host__ __device__ __forceinline__ void stage_rc(int b, int& R, int& C) { const int st = b / 1024, sb = b % 1024, swz = sb ^ (((sb >> 9) & 1) << 5); R = (st >> 1) * 16 + swz / 64; C = (st & 1) * 32 + (swz % 64) / 2; }
__host__ __device__ __forceinline__ int perm32(int rho) { const int n = rho >> 4, i = rho & 15; return 8 * (i >> 2) + 4 * n + (i & 3); }

struct Unit { int pm, pn; };
struct Gemm { const bf16_t* A; const bf16_t* Bt; int lda, ldb, K; };

struct StaticOrder {
    int nM, nN, nwg, G, c;
    __host__ __device__ void init(int M, int N, int G_, int c_) { nM = M / BM; nN = N / BM; nwg = nM * nN; G = G_; c = c_; }
    __host__ __device__ bool next(int i, Unit& u) const {
        const long L = (long)i * G + c; if (L >= nwg) return false;
        int wgid = (int)L; { const int q = nwg / NXCD, r = nwg % NXCD, xcd = wgid % NXCD, off = wgid / NXCD; wgid = (xcd < r ? xcd * (q + 1) : r * (q + 1) + (xcd - r) * q) + off; }
        const int nig = WGM * nN, gid = wgid / nig, fm = gid * WGM, gsz = (nM - fm) < WGM ? (nM - fm) : WGM;
        u.pm = fm + ((wgid % nig) % gsz); u.pn = (wgid % nig) / gsz; return true;
    }
};
struct GroupOrder {
    int n, per, G, c;
    __host__ __device__ bool next(int i, Unit& u) const { const long L = (long)i * G + c; if (L >= n) return false; u.pm = (int)L; u.pn = (int)L / per; return true; }
};

__device__ __forceinline__ unsigned cvt_pk_bf16(float lo, float hi) { unsigned r; asm volatile("v_cvt_pk_bf16_f32 %0, %1, %2" : "=v"(r) : "v"(lo), "v"(hi)); return r; }
__device__ __forceinline__ u32x4 pack8(const f32x4 a, const f32x4 b) { u32x4 w; w.x = cvt_pk_bf16(a[0], a[1]); w.y = cvt_pk_bf16(a[2], a[3]); w.z = cvt_pk_bf16(b[0], b[1]); w.w = cvt_pk_bf16(b[2], b[3]); return w; }

template <class Epi, class Sched>
__device__ __forceinline__ void gemm_phase(PG8_LAS unsigned char* lds, const Gemm g, const Sched& S, const Epi& E) {
    const int tid = threadIdx.x, wid = __builtin_amdgcn_readfirstlane(tid >> 6), lane = tid & 63, wr = wid >> 2, wc = wid & 3, fr = lane & 15, fq = lane >> 4;
    const int K = g.K, nt = K / BK;
    unsigned voffA[2], voffB[2];
#pragma unroll
    for (int i = 0; i < 2; ++i) { int R, C; stage_rc(tid * 16 + i * 8192, R, C); const int Rb = Epi::PERM ? ((R & ~31) + perm32(R & 31)) : R;
        voffA[i] = (unsigned)(R * g.lda + C) * 2u; voffB[i] = (unsigned)(Rb * g.ldb + C) * 2u; }
    asm volatile("" : "+v"(voffA[0]), "+v"(voffA[1]), "+v"(voffB[0]), "+v"(voffB[1]));
    const size_t kstep = (size_t)(BK * 2);
    const size_t hstepA = (size_t)HALF * g.lda * 2, hstepB = (size_t)HALF * g.ldb * 2;
    const size_t tstepA = 2 * hstepA, tstepB = 2 * hstepB;
    const unsigned ldsw = (unsigned)wid * 1024u;
    const int aoff = lds_byte(wr * 64 + fr, fq * 8), boff = lds_byte(wc * 32 + fr, fq * 8);
#define PG8_SA(b, h) (((b) * 2 + (h)) * HTB)
#define PG8_SB(b, h) ((4 + (b) * 2 + (h)) * HTB)
#define PG8_STAGE(bufoff, gbase, voff) do { _Pragma("unroll") for (int _i = 0; _i < 2; ++_i) \
        __builtin_amdgcn_global_load_lds((const unsigned*)((const char*)(gbase) + (voff)[_i]), (PG8_LAS unsigned*)(lds + (bufoff) + ldsw + _i * 8192), 16, 0, 0); } while (0)
#define PG8_LDA(dst, b, h) do { _Pragma("unroll") for (int m = 0; m < 4; ++m) _Pragma("unroll") for (int k = 0; k < 2; ++k) dst[m][k] = *(const PG8_LAS bf16x8*)(lds + PG8_SA(b, h) + aoff + m * 2048 + k * 1024); } while (0)
#define PG8_LDB(dst, b, h) do { _Pragma("unroll") for (int n = 0; n < 2; ++n) _Pragma("unroll") for (int k = 0; k < 2; ++k) dst[n][k] = *(const PG8_LAS bf16x8*)(lds + PG8_SB(b, h) + boff + n * 2048 + k * 1024); } while (0)
#define PG8_MMA(ai, bj, At, Bt) do { __builtin_amdgcn_s_setprio(1); _Pragma("unroll") for (int m = 0; m < 4; ++m) _Pragma("unroll") for (int n = 0; n < 2; ++n) _Pragma("unroll") for (int k = 0; k < 2; ++k) \
        acc[ai][bj][m][n] = __builtin_amdgcn_mfma_f32_16x16x32_bf16(Bt[n][k], At[m][k], acc[ai][bj][m][n], 0, 0, 0); __builtin_amdgcn_s_setprio(0); } while (0)
#define PG8_WAIT_V(n) asm volatile("s_waitcnt vmcnt(" #n ")" ::: "memory")
#define PG8_WAIT_L(n) asm volatile("s_waitcnt lgkmcnt(" #n ")" ::: "memory")
#define PG8_BAR __builtin_amdgcn_s_barrier()
#define PG8_SCHED __builtin_amdgcn_sched_barrier(0)
    Unit cur, nxt; int ui = 0;
    if (!S.next(0, cur)) return;
    f32x4 acc[2][2][4][2];
#pragma unroll
    for (int a = 0; a < 2; ++a)
#pragma unroll
        for (int b = 0; b < 2; ++b)
#pragma unroll
            for (int m = 0; m < 4; ++m)
#pragma unroll
                for (int n = 0; n < 2; ++n) acc[a][b][m][n] = (f32x4){0.f, 0.f, 0.f, 0.f};
    bf16x8 At[4][2], B0[2][2], B1[2][2];
    const char* cA = (const char*)g.A + (size_t)cur.pm * tstepA; const char* cB = (const char*)g.Bt + (size_t)cur.pn * tstepB;
    PG8_STAGE(PG8_SB(0, 0), cB, voffB); PG8_STAGE(PG8_SB(0, 1), cB + hstepB, voffB); PG8_STAGE(PG8_SA(0, 0), cA, voffA); PG8_STAGE(PG8_SA(0, 1), cA + hstepA, voffA);
    if (wr == 1) PG8_BAR;
    PG8_WAIT_V(2); PG8_BAR;
    PG8_STAGE(PG8_SB(1, 0), cB + kstep, voffB); PG8_STAGE(PG8_SA(1, 0), cA + kstep, voffA); PG8_STAGE(PG8_SB(1, 1), cB + hstepB + kstep, voffB);
    PG8_WAIT_V(6); PG8_BAR;
    for (;;) {
        const bool has_next = S.next(ui + 1, nxt);
        const char* nA = has_next ? (const char*)g.A + (size_t)nxt.pm * tstepA : cA; const char* nB = has_next ? (const char*)g.Bt + (size_t)nxt.pn * tstepB : cB;
#pragma unroll 1
        for (int t = 0; t < nt; t += 2) {
            const bool last = (t == nt - 2);
            if constexpr (Epi::MIDK) { if (t == (nt >> 1)) E.midk(acc, cur, wr, fr); }
            const char* a1 = cA + (size_t)(t + 1) * kstep;
            const char* a2 = last ? nA : cA + (size_t)(t + 2) * kstep; const char* b2 = last ? nB : cB + (size_t)(t + 2) * kstep;
            const char* a3 = a2 + kstep; const char* b3 = b2 + kstep;
            PG8_LDB(B0, 0, 0); PG8_LDB(B1, 0, 1); PG8_SCHED; PG8_LDA(At, 0, 0); PG8_STAGE(PG8_SA(1, 1), a1 + hstepA, voffA);
            PG8_WAIT_V(8); PG8_WAIT_L(0); PG8_BAR; PG8_MMA(0, 0, At, B0); PG8_MMA(0, 1, At, B1); PG8_BAR; PG8_SCHED;
            PG8_LDA(At, 0, 1); PG8_STAGE(PG8_SB(0, 0), b2, voffB); PG8_STAGE(PG8_SB(0, 1), b2 + hstepB, voffB); PG8_STAGE(PG8_SA(0, 0), a2, voffA);
            PG8_WAIT_V(8); PG8_WAIT_L(0); PG8_BAR; PG8_MMA(1, 0, At, B0); PG8_MMA(1, 1, At, B1); PG8_BAR; PG8_SCHED;
            PG8_LDB(B0, 1, 0); PG8_LDB(B1, 1, 1); PG8_SCHED; PG8_LDA(At, 1, 0); PG8_STAGE(PG8_SA(0, 1), a2 + hstepA, voffA);
            PG8_WAIT_V(8); PG8_WAIT_L(0); PG8_BAR; PG8_MMA(0, 0, At, B0); PG8_MMA(0, 1, At, B1); PG8_BAR; PG8_SCHED;
            PG8_LDA(At, 1, 1); PG8_STAGE(PG8_SB(1, 0), b3, voffB); PG8_STAGE(PG8_SB(1, 1), b3 + hstepB, voffB); PG8_STAGE(PG8_SA(1, 0), a3, voffA);
            PG8_WAIT_V(8); PG8_WAIT_L(0); PG8_BAR; PG8_MMA(1, 0, At, B0); PG8_MMA(1, 1, At, B1); PG8_BAR; PG8_SCHED;
        }
        if (wr == 0) PG8_BAR;
        E(acc, cur, wr, wc, fr, fq);
        if (!has_next) break;
#pragma unroll
        for (int a = 0; a < 2; ++a)
#pragma unroll
            for (int b = 0; b < 2; ++b)
#pragma unroll
                for (int m = 0; m < 4; ++m)
#pragma unroll
                    for (int n = 0; n < 2; ++n) acc[a][b][m][n] = (f32x4){0.f, 0.f, 0.f, 0.f};
        cur = nxt; cA = nA; cB = nB; ++ui;
        if (wr == 1) PG8_BAR;
    }
    PG8_WAIT_V(0);
    PG8_BAR;
#undef PG8_SA
#undef PG8_SB
#undef PG8_STAGE
#undef PG8_LDA
#undef PG8_LDB
#undef PG8_MMA
#undef PG8_WAIT_V
#undef PG8_WAIT_L
#undef PG8_BAR
#undef PG8_SCHED
}
}

constexpr int T = 24576, DM = 4096, DFF = 11008;
constexpr int NCHUNK = T / 16;
constexpr int QLAT = 896, KVLAT = 512, QW = 3072, KVW = 4096, MIXW = 2048;
constexpr float EPS = 1e-6f;
__device__ __forceinline__ int pos_of(int r) { return r < 16384 ? (r & 8191) : (r & 4095); }
__device__ __forceinline__ int len_of(int r) { return r < 16384 ? 8192 : 4096; }

typedef unsigned short bf16;
#define GAS __attribute__((address_space(1)))
#define LAS __attribute__((address_space(3)))
typedef unsigned v4u __attribute__((ext_vector_type(4)));
typedef unsigned v2u __attribute__((ext_vector_type(2)));
typedef float f32x4 __attribute__((ext_vector_type(4)));
typedef float f32x2 __attribute__((ext_vector_type(2)));
typedef short bf16x8 __attribute__((ext_vector_type(8)));

__device__ __forceinline__ unsigned f2bf(float f) { unsigned u = __builtin_bit_cast(unsigned, f); return (u + 0x7fffu + ((u >> 16) & 1u)) >> 16; }
__device__ __forceinline__ unsigned pk2(float lo, float hi) { return f2bf(lo) | (f2bf(hi) << 16); }
__device__ __forceinline__ float bf2f(unsigned short b) { return __builtin_bit_cast(float, (unsigned)b << 16); }
__device__ __forceinline__ float bflo(unsigned w) { return __builtin_bit_cast(float, w << 16); }
__device__ __forceinline__ float bfhi(unsigned w) { return __builtin_bit_cast(float, w & 0xffff0000u); }
__device__ __forceinline__ float sigmoidf_fast(float x) { return __builtin_amdgcn_rcpf(1.0f + __builtin_amdgcn_exp2f(-1.4426950408889634f * x)); }
__device__ __forceinline__ float gelu_tanh(float y) { const float in = 1.5957691216057308f * (y + 0.044715f * y * y * y); return y * sigmoidf_fast(in); }

namespace pg8 {
#define EPI_ROWS const int row0 = u.pm * 256 + wr * 64 + fr
__device__ __forceinline__ float sq8(const f32x4 a, const f32x4 b) { return (a[0] * a[0] + a[1] * a[1]) + (a[2] * a[2] + a[3] * a[3]) + (b[0] * b[0] + b[1] * b[1]) + (b[2] * b[2] + b[3] * b[3]); }
__device__ __forceinline__ float red_fq(float s) { s += __shfl_xor(s, 16); s += __shfl_xor(s, 32); return s; }

__device__ __forceinline__ f32x4 rope4(const f32x4 v, const f32x4 cs) { f32x4 o; o[0] = v[0] * cs[0] - v[1] * cs[1]; o[1] = v[1] * cs[0] + v[0] * cs[1]; o[2] = v[2] * cs[2] - v[3] * cs[3]; o[3] = v[3] * cs[2] + v[2] * cs[3]; return o; }

#define LAUNDER(p) asm volatile("" : "+v"(p))
struct EpiWin {
    static constexpr bool PERM = true, MIDK = false;
    const float* rstd_x; bf16_t* X; bf16_t* qlat; bf16_t* kvlat; bf16_t* krope; float* stQ; float* stKV; const float* ropetab;
    __device__ __forceinline__ void midk(f32x4 (&)[2][2][4][2], const Unit&, int, int) const {}
    __device__ __forceinline__ void operator()(const f32x4 (&acc)[2][2][4][2], const Unit& u, int wr, int wc, int fr, int fq) const {
        EPI_ROWS; const int tile = u.pn;
        const GAS float* rsp = (const GAS float*)(rstd_x + row0); LAUNDER(rsp);
        if (tile < 8) {
            const int c0 = tile * 256 + wc * 32 + 8 * fq;
            GAS bf16_t* xp0 = (GAS bf16_t*)X + ((size_t)((c0 >> 4) * NCHUNK + (row0 >> 4)) * 512 + 256 + (row0 & 15) * 16 + (c0 & 15)); LAUNDER(xp0);
#pragma unroll
            for (int ai = 0; ai < 2; ++ai)
#pragma unroll
                for (int m = 0; m < 4; ++m) { const float rs = rsp[ai * 128 + m * 16];
#pragma unroll
                    for (int bj = 0; bj < 2; ++bj)
                        *(GAS u32x4*)(xp0 + ((size_t)(bj * 8) * NCHUNK + ai * 8 + m) * 512) = pack8(acc[ai][bj][m][0] * rs, acc[ai][bj][m][1] * rs); }
        } else if (tile < 14) {
            const bool isq = tile < 12; const int tl = isq ? tile - 8 : tile - 12; const int ld = isq ? QLAT : KVLAT;
            const int c0 = tl * 256 + wc * 32 + 8 * fq;
            GAS bf16_t* op = (GAS bf16_t*)(isq ? qlat : kvlat) + (size_t)row0 * ld + c0; GAS float* sp = (GAS float*)(isq ? stQ + (size_t)row0 * 16 : stKV + (size_t)row0 * 8) + tl * 4 + wc; LAUNDER(op); LAUNDER(sp);
#pragma unroll
            for (int ai = 0; ai < 2; ++ai)
#pragma unroll
                for (int m = 0; m < 4; ++m) { const float rs = rsp[ai * 128 + m * 16]; float ss = 0.f;
#pragma unroll
                    for (int bj = 0; bj < 2; ++bj) { const f32x4 v0 = acc[ai][bj][m][0] * rs, v1 = acc[ai][bj][m][1] * rs; ss += sq8(v0, v1);
                        if (c0 + bj * 128 < ld) *(GAS u32x4*)(op + (size_t)(ai * 128 + m * 16) * ld + bj * 128) = pack8(v0, v1); }
                    ss = red_fq(ss); if (fq == 0) sp[(size_t)(ai * 128 + m * 16) * (isq ? 16 : 8)] = ss; }
        } else {
            if (wc < 2) { const int c = wc * 32 + 8 * fq;
                GAS bf16_t* op = (GAS bf16_t*)krope + (size_t)row0 * 64 + c; LAUNDER(op);
#pragma unroll
                for (int ai = 0; ai < 2; ++ai)
#pragma unroll
                    for (int m = 0; m < 4; ++m) { const int row = row0 + ai * 128 + m * 16; const float rs = rsp[ai * 128 + m * 16]; const int pos = pos_of(row);
                        const f32x4 cs0 = *(const GAS f32x4*)((const GAS float*)ropetab + (size_t)pos * 64 + c), cs1 = *(const GAS f32x4*)((const GAS float*)ropetab + (size_t)pos * 64 + c + 4);
                        const f32x4 v0 = rope4(acc[ai][0][m][0] * rs, cs0), v1 = rope4(acc[ai][0][m][1] * rs, cs1);
                        *(GAS u32x4*)(op + (size_t)(ai * 128 + m * 16) * 64) = pack8(v0, v1); } }
        }
    }
};
struct EpiSsm1 {
    static constexpr bool PERM = true, MIDK = false;
    bf16_t* X;
    __device__ __forceinline__ void midk(f32x4 (&)[2][2][4][2], const Unit&, int, int) const {}
    __device__ __forceinline__ void operator()(const f32x4 (&acc)[2][2][4][2], const Unit& u, int wr, int wc, int fr, int fq) const {
        EPI_ROWS; GAS bf16_t* op = (GAS bf16_t*)X + (size_t)row0 * 512 + wc * 32 + 8 * fq; LAUNDER(op);
#pragma unroll
        for (int ai = 0; ai < 2; ++ai)
#pragma unroll
            for (int m = 0; m < 4; ++m)
#pragma unroll
                for (int bj = 0; bj < 2; ++bj) *(GAS u32x4*)(op + (size_t)(ai * 128 + m * 16) * 512 + bj * 128) = pack8(acc[ai][bj][m][0], acc[ai][bj][m][1]);
    }
};
struct EpiSsm2 {
    static constexpr bool PERM = true, MIDK = false;
    bf16_t* gact;
    __device__ __forceinline__ void midk(f32x4 (&)[2][2][4][2], const Unit&, int, int) const {}
    __device__ __forceinline__ void operator()(const f32x4 (&acc)[2][2][4][2], const Unit& u, int wr, int wc, int fr, int fq) const {
        EPI_ROWS; const int g = u.pn; const int c0 = wc * 32 + 8 * fq;
        GAS bf16_t* op = (GAS bf16_t*)gact + ((size_t)(row0 - g * NCHUNK) * 16 + (c0 >> 4)) * MIXW + g * 16 + (c0 & 15); LAUNDER(op);
#pragma unroll
        for (int ai = 0; ai < 2; ++ai)
#pragma unroll
            for (int m = 0; m < 4; ++m)
#pragma unroll
                for (int bj = 0; bj < 2; ++bj) { f32x4 v0 = acc[ai][bj][m][0], v1 = acc[ai][bj][m][1];
#pragma unroll
                    for (int e = 0; e < 4; ++e) { v0[e] = gelu_tanh(v0[e]); v1[e] = gelu_tanh(v1[e]); }
                    *(GAS u32x4*)(op + ((size_t)(ai * 128 + m * 16) * 16 + bj * 8) * MIXW) = pack8(v0, v1); }
    }
};
struct EpiQ {
    static constexpr bool PERM = true, MIDK = false;
    const float* rstd_q; bf16_t* q; const float* ropetab;
    __device__ __forceinline__ void midk(f32x4 (&)[2][2][4][2], const Unit&, int, int) const {}
    __device__ __forceinline__ void operator()(const f32x4 (&acc)[2][2][4][2], const Unit& u, int wr, int wc, int fr, int fq) const {
        EPI_ROWS; const GAS float* rsp = (const GAS float*)(rstd_q + row0); GAS bf16_t* op = (GAS bf16_t*)q + (size_t)row0 * QW + u.pn * 256 + wc * 32 + 8 * fq; LAUNDER(rsp); LAUNDER(op);
#pragma unroll
        for (int ai = 0; ai < 2; ++ai)
#pragma unroll
            for (int m = 0; m < 4; ++m) { const int row = row0 + ai * 128 + m * 16; const float rs = rsp[ai * 128 + m * 16]; const int pos = pos_of(row);
#pragma unroll
                for (int bj = 0; bj < 2; ++bj) { const int strip = 8 * u.pn + 4 * bj + wc, s6 = strip % 6;
                    f32x4 v0 = acc[ai][bj][m][0] * rs, v1 = acc[ai][bj][m][1] * rs;
                    if (s6 >= 4) { const int pc = (s6 - 4) * 32 + 8 * fq;
                        const f32x4 cs0 = *(const GAS f32x4*)((const GAS float*)ropetab + (size_t)pos * 64 + pc), cs1 = *(const GAS f32x4*)((const GAS float*)ropetab + (size_t)pos * 64 + pc + 4);
                        v0 = rope4(v0, cs0); v1 = rope4(v1, cs1); }
                    *(GAS u32x4*)(op + (size_t)(ai * 128 + m * 16) * QW + bj * 128) = pack8(v0, v1); } }
    }
};
struct EpiKV {
    static constexpr bool PERM = true, MIDK = false;
    const float* rstd_kv; bf16_t* kv;
    __device__ __forceinline__ void midk(f32x4 (&)[2][2][4][2], const Unit&, int, int) const {}
    __device__ __forceinline__ void operator()(const f32x4 (&acc)[2][2][4][2], const Unit& u, int wr, int wc, int fr, int fq) const {
        EPI_ROWS; const GAS float* rsp = (const GAS float*)(rstd_kv + row0); GAS bf16_t* op = (GAS bf16_t*)kv + (size_t)row0 * KVW + u.pn * 256 + wc * 32 + 8 * fq; LAUNDER(rsp); LAUNDER(op);
#pragma unroll
        for (int ai = 0; ai < 2; ++ai)
#pragma unroll
            for (int m = 0; m < 4; ++m) { const float rs = rsp[ai * 128 + m * 16];
#pragma unroll
                for (int bj = 0; bj < 2; ++bj) *(GAS u32x4*)(op + (size_t)(ai * 128 + m * 16) * KVW + bj * 128) = pack8(acc[ai][bj][m][0] * rs, acc[ai][bj][m][1] * rs); }
    }
};
struct EpiGlu {
    static constexpr bool PERM = true, MIDK = false;
    const bf16_t* gact; bf16_t* merged; float* stA;
    __device__ __forceinline__ void midk(f32x4 (&)[2][2][4][2], const Unit&, int, int) const {}
    __device__ __forceinline__ void operator()(const f32x4 (&acc)[2][2][4][2], const Unit& u, int wr, int wc, int fr, int fq) const {
        EPI_ROWS; const int c0 = u.pn * 256 + wc * 32 + 8 * fq;
        const GAS bf16_t* gp = (const GAS bf16_t*)gact + (size_t)row0 * MIXW + c0; GAS bf16_t* op = (GAS bf16_t*)merged + (size_t)row0 * DM + c0; GAS float* sp = (GAS float*)stA + (size_t)row0 * 32 + u.pn * 4 + wc; LAUNDER(gp); LAUNDER(op); LAUNDER(sp);
#pragma unroll
        for (int ai = 0; ai < 2; ++ai)
#pragma unroll
            for (int m = 0; m < 4; ++m) { float ss = 0.f;
#pragma unroll
                for (int bj = 0; bj < 2; ++bj) {
                    const u32x4 gw = *(const GAS u32x4*)(gp + (size_t)(ai * 128 + m * 16) * MIXW + bj * 128);
                    f32x4 v0, v1; const f32x4 a0 = acc[ai][bj][m][0], a1 = acc[ai][bj][m][1];
                    v0[0] = bflo(gw.x) * sigmoidf_fast(a0[0]); v0[1] = bfhi(gw.x) * sigmoidf_fast(a0[1]); v0[2] = bflo(gw.y) * sigmoidf_fast(a0[2]); v0[3] = bfhi(gw.y) * sigmoidf_fast(a0[3]);
                    v1[0] = bflo(gw.z) * sigmoidf_fast(a1[0]); v1[1] = bfhi(gw.z) * sigmoidf_fast(a1[1]); v1[2] = bflo(gw.w) * sigmoidf_fast(a1[2]); v1[3] = bfhi(gw.w) * sigmoidf_fast(a1[3]);
                    ss += sq8(v0, v1);
                    *(GAS u32x4*)(op + (size_t)(ai * 128 + m * 16) * DM + bj * 128) = pack8(v0, v1); }
                ss = red_fq(ss); if (fq == 0) sp[(size_t)(ai * 128 + m * 16) * 32] = ss; }
    }
};
struct EpiWout {
    static constexpr bool PERM = true, MIDK = true;
    const float* xp; const float* xs; const float* r2; const float* ratio; float* xres; bf16_t* x1b; float* stA;
    __device__ __forceinline__ void midk(f32x4 (&acc)[2][2][4][2], const Unit& u, int wr, int fr) const {
        EPI_ROWS; const GAS float* rp = (const GAS float*)(ratio + row0); LAUNDER(rp);
#pragma unroll
        for (int ai = 0; ai < 2; ++ai)
#pragma unroll
            for (int m = 0; m < 4; ++m) { const float rt = rp[ai * 128 + m * 16];
#pragma unroll
                for (int bj = 0; bj < 2; ++bj)
#pragma unroll
                    for (int n = 0; n < 2; ++n) acc[ai][bj][m][n] *= rt; }
    }
    __device__ __forceinline__ void operator()(const f32x4 (&acc)[2][2][4][2], const Unit& u, int wr, int wc, int fr, int fq) const {
        EPI_ROWS; const int c0 = u.pn * 256 + wc * 32 + 8 * fq; const int rowt = u.pm * 256;
        const GAS float* xin = (const GAS float*)(rowt < 16384 ? xp + (size_t)row0 * DM : xs + (size_t)(row0 - 16384) * DM) + c0;
        const GAS float* rsp = (const GAS float*)(r2 + row0); GAS float* xo = (GAS float*)xres + (size_t)row0 * DM + c0; GAS bf16_t* bo = (GAS bf16_t*)x1b + (size_t)row0 * DM + c0; GAS float* sp = (GAS float*)stA + (size_t)row0 * 64 + u.pn * 4 + wc;
        LAUNDER(xin); LAUNDER(rsp); LAUNDER(xo); LAUNDER(bo); LAUNDER(sp);
#pragma unroll
        for (int ai = 0; ai < 2; ++ai)
#pragma unroll
            for (int m = 0; m < 4; ++m) { const float rs = rsp[ai * 128 + m * 16]; float ss = 0.f; const size_t ro = (size_t)(ai * 128 + m * 16) * DM;
#pragma unroll
                for (int bj = 0; bj < 2; ++bj) {
                    const f32x4 v0 = *(const GAS f32x4*)(xin + ro + bj * 128) + acc[ai][bj][m][0] * rs, v1 = *(const GAS f32x4*)(xin + ro + bj * 128 + 4) + acc[ai][bj][m][1] * rs;
                    ss += sq8(v0, v1);
                    *(GAS f32x4*)(xo + ro + bj * 128) = v0; *(GAS f32x4*)(xo + ro + bj * 128 + 4) = v1;
                    *(GAS u32x4*)(bo + ro + bj * 128) = pack8(v0, v1); }
                ss = red_fq(ss); if (fq == 0) sp[(size_t)(ai * 128 + m * 16) * 64] = ss; }
    }
};
__device__ __forceinline__ float dpp_ror1(float v) { return __builtin_bit_cast(float, __builtin_amdgcn_update_dpp(0, __builtin_bit_cast(int, v), 0x121, 0xf, 0xf, false)); }
__device__ __forceinline__ float dpp_rol1(float v) { return __builtin_bit_cast(float, __builtin_amdgcn_update_dpp(0, __builtin_bit_cast(int, v), 0x12f, 0xf, 0xf, false)); }
struct EpiFfnA {
    static constexpr bool PERM = true, MIDK = false;
    const float* rstd; int row_base; bf16_t* act; bf16_t* halo_up; bf16_t* halo_gate; const float* cw; const float* cb;
    __device__ __forceinline__ void midk(f32x4 (&)[2][2][4][2], const Unit&, int, int) const {}
    __device__ __forceinline__ void operator()(const f32x4 (&acc)[2][2][4][2], const Unit& u, int wr, int wc, int fr, int fq) const {
        EPI_ROWS; const int f0 = u.pn * 128 + wc * 32 + 8 * fq;
        const GAS float* rsp = (const GAS float*)(rstd + row_base + row0); GAS bf16_t* actp = (GAS bf16_t*)act + (size_t)row0 * DFF + f0;
        const int strip0 = u.pm * 4 + wr;
        GAS bf16_t* hup_p = (GAS bf16_t*)halo_up + (size_t)strip0 * 4 * DFF + f0; GAS bf16_t* hg_p = (GAS bf16_t*)halo_gate + (size_t)strip0 * 2 * DFF + f0;
        const GAS float* cwp = (const GAS float*)(cw + f0); const GAS float* cbp = (const GAS float*)(cb + f0);
        asm volatile("" : "+v"(rsp), "+v"(actp), "+v"(hup_p), "+v"(hg_p), "+v"(cwp), "+v"(cbp));
#pragma unroll
        for (int ai = 0; ai < 2; ++ai) {
            float rs[4];
#pragma unroll
            for (int m = 0; m < 4; ++m) rs[m] = rsp[ai * 128 + m * 16];
#pragma unroll
            for (int n = 0; n < 2; ++n) {
                const f32x4 w0 = *(const GAS f32x4*)(cwp + 4 * n), w1 = *(const GAS f32x4*)(cwp + DFF + 4 * n), w2 = *(const GAS f32x4*)(cwp + 2 * DFF + 4 * n), wb = *(const GAS f32x4*)(cbp + 4 * n);
                f32x4 res[4], Uu[4];
#pragma unroll
                for (int e = 0; e < 4; ++e) {
                    float U[4], R[4], L[4];
#pragma unroll
                    for (int m = 0; m < 4; ++m) { U[m] = acc[ai][0][m][n][e] * rs[m]; R[m] = dpp_ror1(U[m]); L[m] = dpp_rol1(U[m]); Uu[m][e] = U[m]; }
#pragma unroll
                    for (int m = 0; m < 4; ++m) {
                        const float prev = (fr == 0) ? R[m > 0 ? m - 1 : 0] : R[m];
                        const float next = (fr == 15) ? L[m < 3 ? m + 1 : 3] : L[m];
                        const float cv = w0[e] * prev + w1[e] * U[m] + w2[e] * next + wb[e];
                        res[m][e] = cv * sigmoidf_fast(cv) * (acc[ai][1][m][n][e] * rs[m]);
                    }
                }
#pragma unroll
                for (int m = 0; m < 4; ++m) {
                    const bool edge = (m == 0 && fr == 0) || (m == 3 && fr == 15);
                    if (!edge) { u32x2 w; w.x = cvt_pk_bf16(res[m][0], res[m][1]); w.y = cvt_pk_bf16(res[m][2], res[m][3]); *(GAS u32x2*)(actp + (size_t)(ai * 128 + m * 16) * DFF + 4 * n) = w; }
                    if (m == 0 || m == 3) {
                        const int hs = (m == 0) ? (fr == 0 ? 0 : (fr == 1 ? 1 : -1)) : (fr == 14 ? 2 : (fr == 15 ? 3 : -1));
                        if (hs >= 0) { u32x2 w; w.x = cvt_pk_bf16(Uu[m][0], Uu[m][1]); w.y = cvt_pk_bf16(Uu[m][2], Uu[m][3]);
                            *(GAS u32x2*)(hup_p + ((size_t)(ai * 2) * 4 + hs) * DFF + 4 * n) = w;
                            if (hs == 0 || hs == 3) { const f32x4 gv = acc[ai][1][m][n] * rs[m]; u32x2 wg; wg.x = cvt_pk_bf16(gv[0], gv[1]); wg.y = cvt_pk_bf16(gv[2], gv[3]);
                                *(GAS u32x2*)(hg_p + ((size_t)(ai * 2) * 2 + (hs == 3 ? 1 : 0)) * DFF + 4 * n) = wg; } }
                    }
                }
            }
        }
    }
};
struct EpiDown {
    static constexpr bool PERM = true, MIDK = false;
    float* xres; int row_base; float* stA;
    __device__ __forceinline__ void midk(f32x4 (&)[2][2][4][2], const Unit&, int, int) const {}
    __device__ __forceinline__ void operator()(const f32x4 (&acc)[2][2][4][2], const Unit& u, int wr, int wc, int fr, int fq) const {
        EPI_ROWS; GAS float* xo = (GAS float*)xres + (size_t)(row_base + row0) * DM + u.pn * 256 + wc * 32 + 8 * fq; GAS float* sp = (GAS float*)stA + (size_t)(row_base + row0) * 64 + u.pn * 4 + wc; LAUNDER(xo); LAUNDER(sp);
#pragma unroll
        for (int ai = 0; ai < 2; ++ai)
#pragma unroll
            for (int m = 0; m < 4; ++m) { float ss = 0.f; const size_t ro = (size_t)(ai * 128 + m * 16) * DM;
#pragma unroll
                for (int bj = 0; bj < 2; ++bj) { GAS float* p = xo + ro + bj * 128;
                    const f32x4 v0 = *(const f32x4*)p + acc[ai][bj][m][0], v1 = *(const GAS f32x4*)(p + 4) + acc[ai][bj][m][1];
                    ss += sq8(v0, v1); *(f32x4*)p = v0; *(GAS f32x4*)(p + 4) = v1; }
                ss = red_fq(ss); if (fq == 0) sp[(size_t)(ai * 128 + m * 16) * 64] = ss; }
    }
};
#undef EPI_ROWS
}

namespace attn {
using s16x4  = __attribute__((ext_vector_type(4))) short;
using f32x16 = __attribute__((ext_vector_type(16))) float;
using u32x4  = __attribute__((ext_vector_type(4))) unsigned;
constexpr int NW = 8, QBLK = 32, KVBLK = 64;
constexpr float SCALE = 0.07216878364870322f;
constexpr float THR = 8.f;
constexpr int LDQ = 3072, LDK = 4096, LDR = 64, LDO = 4096;
constexpr int SHM_V = KVBLK * 128 * 2, SHM_K = KVBLK * 128 * 2, SHM_R = KVBLK * 64 * 2;
constexpr int OFF_V = 0, OFF_K = 2 * SHM_V, OFF_R = OFF_K + 2 * SHM_K, OFF_WS = OFF_R + 2 * SHM_R, SHM_ATTN = OFF_WS + NW * 64 * 4;
#define KSWZ(row, colB) ((row) * 256 + ((colB) ^ (((row) & 7) << 4)))
#define RSWZ(row, ch) ((row) * 128 + ((((ch) ^ (((row) >> 1) & 7))) << 4))
#define SBAR() __builtin_amdgcn_sched_barrier(0)
__device__ __forceinline__ int crow(int r, int hi) { return (r & 3) + 8 * (r >> 2) + 4 * hi; }
__device__ __forceinline__ unsigned cvtpk(float lo, float hi) { unsigned r; asm volatile("v_cvt_pk_bf16_f32 %0, %1, %2" : "=v"(r) : "v"(lo), "v"(hi)); return r; }

__device__ __forceinline__ void partialSM(f32x16& p0, f32x16& p1, float& m_reg, float& mn, float& alpha) {
  constexpr float C = SCALE * 1.4426950408889634f;
  float pmax = p0[0];
#pragma unroll
  for (int r = 1; r < 16; ++r) pmax = fmaxf(pmax, p0[r]);
#pragma unroll
  for (int r = 0; r < 16; ++r) pmax = fmaxf(pmax, p1[r]);
  { auto rr = __builtin_amdgcn_permlane32_swap(__float_as_uint(pmax), __float_as_uint(pmax), false, false);
    pmax = fmaxf(__uint_as_float(rr[0]), __uint_as_float(rr[1])); }
  if (__builtin_expect(__all(pmax - m_reg <= THR / SCALE), 1)) { mn = m_reg; alpha = 1.f; }
  else { mn = fmaxf(m_reg, pmax); alpha = __builtin_amdgcn_exp2f((m_reg - mn) * C); m_reg = mn; }
  float mnC = -mn * C;
#pragma unroll
  for (int r = 0; r < 16; ++r) p0[r] = fmaf(p0[r], C, mnC);
#pragma unroll
  for (int r = 0; r < 16; ++r) p1[r] = fmaf(p1[r], C, mnC);
#pragma unroll
  for (int r = 0; r < 16; ++r) p0[r] = __builtin_amdgcn_exp2f(p0[r]);
}
__device__ __forceinline__ void finishSM(f32x16& p0, f32x16& p1, float alpha, float& l_reg, bf16x8& pa0, bf16x8& pa1, bf16x8& pa2, bf16x8& pa3) {
#pragma unroll
  for (int r = 0; r < 16; ++r) p1[r] = __builtin_amdgcn_exp2f(p1[r]);
  float ps = 0;
#pragma unroll
  for (int r = 0; r < 16; ++r) ps += p0[r];
#pragma unroll
  for (int r = 0; r < 16; ++r) ps += p1[r];
  { auto rr = __builtin_amdgcn_permlane32_swap(__float_as_uint(ps), __float_as_uint(ps), false, false);
    ps = __uint_as_float(rr[0]) + __uint_as_float(rr[1]); }
  l_reg = l_reg * alpha + ps;
#define PK4(P, BASE, OUT) do { unsigned a0 = cvtpk(P[BASE + 0], P[BASE + 1]), a1 = cvtpk(P[BASE + 2], P[BASE + 3]);   \
    unsigned b0 = cvtpk(P[BASE + 4], P[BASE + 5]), b1 = cvtpk(P[BASE + 6], P[BASE + 7]);                              \
    auto r0 = __builtin_amdgcn_permlane32_swap(a0, b0, false, false); auto r1 = __builtin_amdgcn_permlane32_swap(a1, b1, false, false); \
    u32x4 w = {r0[0], r1[0], r0[1], r1[1]}; OUT = *reinterpret_cast<bf16x8*>(&w); } while (0)
  PK4(p0, 0, pa0); PK4(p0, 8, pa1); PK4(p1, 0, pa2); PK4(p1, 8, pa3);
#undef PK4
}
__device__ __forceinline__ void qkt(f32x16& p0, f32x16& p1, const char* Ks, const char* Rs, const bf16x8* qr, int r32, int hi) {
  p0 = f32x16{}; p1 = f32x16{};
#pragma unroll
  for (int g4 = 0; g4 < 2; ++g4) {
#pragma unroll
    for (int dd = 0; dd < 4; ++dd) { const int d0 = g4 * 4 + dd; const int cb = (d0 * 16 + hi * 8) * 2;
      bf16x8 b0 = *reinterpret_cast<const bf16x8*>(Ks + KSWZ(r32, cb));
      bf16x8 b1 = *reinterpret_cast<const bf16x8*>(Ks + KSWZ(32 + r32, cb));
      p0 = __builtin_amdgcn_mfma_f32_32x32x16_bf16(b0, qr[d0], p0, 0, 0, 0);
      p1 = __builtin_amdgcn_mfma_f32_32x32x16_bf16(b1, qr[d0], p1, 0, 0, 0); }
    SBAR();
  }
#pragma unroll
  for (int d0 = 0; d0 < 4; ++d0) { const int ch = d0 * 2 + hi;
    bf16x8 b0 = *reinterpret_cast<const bf16x8*>(Rs + RSWZ(r32, ch));
    bf16x8 b1 = *reinterpret_cast<const bf16x8*>(Rs + RSWZ(32 + r32, ch));
    p0 = __builtin_amdgcn_mfma_f32_32x32x16_bf16(b0, qr[8 + d0], p0, 0, 0, 0);
    p1 = __builtin_amdgcn_mfma_f32_32x32x16_bf16(b1, qr[8 + d0], p1, 0, 0, 0); }
}
__device__ __forceinline__ int v_st(int k, int c) { const int kk = (k & ~0xC) | ((k & 4) << 1) | ((k & 8) >> 1); return ((kk >> 3) * 4 + (c >> 5)) * 512 + ((kk & 7) * 32 + (c & 31)) * 2; }
__device__ __forceinline__ int v_rd_base(int lane) { return ((lane & 3) << 3) | (((lane >> 2) & 3) << 6) | (((lane >> 4) & 1) << 5) | (((lane >> 5) & 1) << 8); }
constexpr int v_rd_off(int d0, int ks, int half) { return d0 * 512 + ks * 4096 + half * 2048; }
template <int OFF> __device__ __forceinline__ s16x4 tr_read(int vb) {
  s16x4 r; asm volatile("ds_read_b64_tr_b16 %0, %1 offset:%2" : "=&v"(r) : "v"(vb), "i"(OFF) : "memory"); return r;
}
template <int D0> __device__ __forceinline__ void pv_one(f32x16& od, int vb, bf16x8 pa0, bf16x8 pa1, bf16x8 pa2, bf16x8 pa3) {
  const s16x4 l0 = tr_read<v_rd_off(D0, 0, 0)>(vb), h0 = tr_read<v_rd_off(D0, 0, 1)>(vb), l1 = tr_read<v_rd_off(D0, 1, 0)>(vb), h1 = tr_read<v_rd_off(D0, 1, 1)>(vb);
  const s16x4 l2 = tr_read<v_rd_off(D0, 2, 0)>(vb), h2 = tr_read<v_rd_off(D0, 2, 1)>(vb), l3 = tr_read<v_rd_off(D0, 3, 0)>(vb), h3 = tr_read<v_rd_off(D0, 3, 1)>(vb);
  asm volatile("s_waitcnt lgkmcnt(0)" ::: "memory"); SBAR();
#define PK(L, H) (bf16x8){L[0], L[1], L[2], L[3], H[0], H[1], H[2], H[3]}
  od = __builtin_amdgcn_mfma_f32_32x32x16_bf16(pa0, PK(l0, h0), od, 0, 0, 0);
  od = __builtin_amdgcn_mfma_f32_32x32x16_bf16(pa1, PK(l1, h1), od, 0, 0, 0);
  od = __builtin_amdgcn_mfma_f32_32x32x16_bf16(pa2, PK(l2, h2), od, 0, 0, 0);
  od = __builtin_amdgcn_mfma_f32_32x32x16_bf16(pa3, PK(l3, h3), od, 0, 0, 0);
#undef PK
}
__device__ __forceinline__ void pv_d0(f32x16* o, int vb, bf16x8 pa0, bf16x8 pa1, bf16x8 pa2, bf16x8 pa3) {
  pv_one<0>(o[0], vb, pa0, pa1, pa2, pa3); pv_one<1>(o[1], vb, pa0, pa1, pa2, pa3); pv_one<2>(o[2], vb, pa0, pa1, pa2, pa3); pv_one<3>(o[3], vb, pa0, pa1, pa2, pa3);
}

__device__ __forceinline__ void attn_unit(const bf16* __restrict__ Qb, const bf16* __restrict__ Kh, const bf16* __restrict__ Vh, const bf16* __restrict__ Rh,
                                          bf16* __restrict__ Ob, float* __restrict__ st, int seq, char* lds) {
  const int tid = threadIdx.x, wid = tid >> 6, lane = tid & 63, r32 = lane & 31, hi = lane >> 5;
  char* V_lds = lds + OFF_V; char* K_lds = lds + OFF_K; char* R_lds = lds + OFF_R;
  float* ws = (float*)(lds + OFF_WS) + wid * 64; float* li_l = ws; float* al_l = ws + 32;
  float m_reg = -1e30f, l_reg = 0; f32x16 o[4] = {}; bf16x8 qr[12];
  const bf16* Qw = Qb + (long)(wid * QBLK + r32) * LDQ + hi * 8;
#pragma unroll
  for (int d0 = 0; d0 < 12; ++d0) qr[d0] = *reinterpret_cast<const bf16x8*>(Qw + d0 * 16);
  const int sr = tid >> 4, sc = (tid & 15) * 8, vst0 = v_st(sr, sc), vst1 = v_st(32 + sr, sc);
  const int rr_ = tid >> 3, rch = tid & 7, rst = RSWZ(rr_, rch);
  const int vb0 = (int)(uintptr_t)V_lds + v_rd_base(lane);
  struct { bf16x8 vs0, vs1, ks0, ks1, rs0; } sr_[1];
#define SLOAD(i, k0) do { sr_[i].vs0 = *reinterpret_cast<const bf16x8*>(&Vh[(long)((k0) + sr) * LDK + sc]); sr_[i].vs1 = *reinterpret_cast<const bf16x8*>(&Vh[(long)((k0) + 32 + sr) * LDK + sc]); \
    sr_[i].ks0 = *reinterpret_cast<const bf16x8*>(&Kh[(long)((k0) + sr) * LDK + sc]); sr_[i].ks1 = *reinterpret_cast<const bf16x8*>(&Kh[(long)((k0) + 32 + sr) * LDK + sc]); \
    sr_[i].rs0 = *reinterpret_cast<const bf16x8*>(&Rh[(long)((k0) + rr_) * LDR + rch * 8]); } while (0)
#define SWRITE(b, i) do { *(bf16x8*)(V_lds + (b) * SHM_V + vst0) = sr_[i].vs0;          \
    *(bf16x8*)(V_lds + (b) * SHM_V + vst1) = sr_[i].vs1; int kc = sc * 2;               \
    *(bf16x8*)(K_lds + (b) * SHM_K + KSWZ(sr, kc)) = sr_[i].ks0;                       \
    *(bf16x8*)(K_lds + (b) * SHM_K + KSWZ(32 + sr, kc)) = sr_[i].ks1;                  \
    *(bf16x8*)(R_lds + (b) * SHM_R + rst) = sr_[i].rs0; } while (0)
#define SWAIT() asm volatile("s_waitcnt vmcnt(0)" ::: "memory")
#define RESC(a) do { if (__any((a) < 1.f)) { if (hi == 0) al_l[r32] = (a); asm volatile("s_waitcnt lgkmcnt(0)" ::: "memory"); \
    _Pragma("unroll") for (int d = 0; d < 4; ++d) _Pragma("unroll") for (int r = 0; r < 16; ++r) o[d][r] *= al_l[crow(r, hi)]; } } while (0)
  f32x16 p0, p1; float mn, al; bf16x8 pa0, pa1, pa2, pa3; const int NT = seq / KVBLK;
  SLOAD(0, 0); asm volatile("s_waitcnt vmcnt(0)" ::: "memory"); SWRITE(0, 0); __syncthreads();
#pragma unroll 1
  for (int j = 0; j < NT; ++j) {
    const int b = j & 1;
    if (j + 1 < NT) SLOAD(0, (j + 1) * KVBLK);
    SBAR(); qkt(p0, p1, K_lds + b * SHM_K, R_lds + b * SHM_R, qr, r32, hi);
    partialSM(p0, p1, m_reg, mn, al);
    RESC(al);
    finishSM(p0, p1, al, l_reg, pa0, pa1, pa2, pa3); SBAR();
    pv_d0(o, vb0 + b * SHM_V, pa0, pa1, pa2, pa3);
    if (j + 1 < NT) { SWRITE(b ^ 1, 0); }
    __syncthreads();
  }
  if (hi == 0) li_l[r32] = l_reg; asm volatile("s_waitcnt lgkmcnt(0)" ::: "memory");
  GAS bf16* Ow = (GAS bf16*)Ob + (long)(wid * QBLK + 4 * hi) * LDO + r32; GAS float* stw = (GAS float*)st + (long)(wid * QBLK + 4 * hi) * 16;
  asm volatile("" : "+v"(Ow), "+v"(stw));
#pragma unroll
  for (int r = 0; r < 16; ++r) { const int ro = (r & 3) + 8 * (r >> 2); const float rl = __builtin_amdgcn_rcpf(li_l[ro + 4 * hi]); float ss = 0.f;
#pragma unroll
    for (int d0 = 0; d0 < 4; ++d0) { const float v = o[d0][r] * rl; ss += v * v; Ow[(long)ro * LDO + d0 * 32] = (bf16)f2bf(v); }
    ss += __shfl_xor(ss, 1); ss += __shfl_xor(ss, 2); ss += __shfl_xor(ss, 4); ss += __shfl_xor(ss, 8); ss += __shfl_xor(ss, 16);
    if (r32 == 0) stw[ro * 16] = ss; }
#undef SLOAD
#undef SWRITE
#undef SWAIT
#undef RESC
}
#undef KSWZ
#undef RSWZ
#undef SBAR
}

constexpr size_t MiB = 1u << 20;
constexpr size_t WS_CTL = 0, CTL_ZERO_BYTES = 1 * MiB;
constexpr size_t WS_RSTDX = 1 * MiB, WS_RSTDQ = WS_RSTDX + 98304, WS_RSTDKV = WS_RSTDQ + 98304, WS_R2 = WS_RSTDKV + 98304, WS_RATIO = WS_R2 + 98304, WS_RSTDX1 = WS_RATIO + 98304;
constexpr size_t WS_STA = 2 * MiB;
constexpr size_t WS_STB = 8 * MiB;
constexpr size_t WS_STQ = 10 * MiB;
constexpr size_t WS_STKV = 12 * MiB;
constexpr size_t WS_ROPE = 13 * MiB;
constexpr size_t WS_WIN = 16 * MiB;
constexpr size_t WS_WGLU = 46 * MiB;
constexpr size_t WS_WQ = 54 * MiB;
constexpr size_t WS_WKV = 60 * MiB;
constexpr size_t WS_WOUT = 64 * MiB;
constexpr size_t WS_WUG = 96 * MiB;
constexpr size_t WS_WDN = 268 * MiB;
constexpr size_t WS_W1T = 354 * MiB;
constexpr size_t WS_W2T = 370 * MiB;
constexpr size_t WS_A = 402 * MiB;
constexpr size_t WS_B = 594 * MiB;
constexpr size_t WS_QLAT = 786 * MiB, WS_KVLAT = 828 * MiB, WS_KROPE = 852 * MiB;
constexpr size_t WS_GACT = 856 * MiB;
constexpr size_t WS_HUP = 952 * MiB, WS_HGATE = 964 * MiB, WS_END = 970 * MiB;
static_assert(WS_HUP + (size_t)128 * 4 * DFF * 2 <= WS_HGATE && WS_HGATE + (size_t)128 * 2 * DFF * 2 <= WS_END, "halo");
constexpr size_t OUT_X = 0, OUT_KV = 192 * MiB;
constexpr int CW_BAR = 4096;

constexpr int NWAVES = 8;
constexpr int RING_BYTES = 131072, LDSCTL_OFF = RING_BYTES, MISC_OFF = LDSCTL_OFF + 320, LDS_BYTES = 147456;

typedef GAS unsigned gu32;
#define RLX_AGENT __ATOMIC_RELAXED, __HIP_MEMORY_SCOPE_AGENT
#define LDS_WAIT() asm volatile("s_waitcnt lgkmcnt(0)" ::: "memory")

#define XB_TMO      128
#define XB_XCNT(j)  (256  + 64 * (j))
#define XB_XSUB(j)  (1280 + 64 * (j))
#define XB_XGEN(j)  (2304 + 64 * (j))
#define XB_TOP      3328
#define XB_TOPGEN   3392
#define XCD_BAR_WORDS 3456
#define XB_SPIN_CAP (1u << 18)
__device__ __forceinline__ unsigned xb_ld(unsigned* p)              { return __hip_atomic_load(p, __ATOMIC_RELAXED, __HIP_MEMORY_SCOPE_AGENT); }
__device__ __forceinline__ unsigned xb_add(unsigned* p, unsigned v) { return __hip_atomic_fetch_add(p, v, __ATOMIC_RELAXED, __HIP_MEMORY_SCOPE_AGENT); }
__device__ __forceinline__ unsigned xb_xcc_id() { return (unsigned)__builtin_amdgcn_s_getreg((3 << 11) | 20) & 0xFu; }
#define XB_SPIN(cond, bar) do { unsigned _sp = 0; while (cond) { __builtin_amdgcn_s_sleep(1); \
    if ((++_sp & 255u) == 0u) { if (xb_ld(&(bar)[XB_TMO])) break; if (_sp > XB_SPIN_CAP) { atomicAdd(&(bar)[XB_TMO], 1u); break; } } } } while (0)
struct XcdBarrier { unsigned* bar; unsigned x; volatile LAS unsigned* st; };
__device__ __forceinline__ XcdBarrier xcd_barrier_post(unsigned* bar, volatile LAS unsigned* st) {
    XcdBarrier b; b.bar = bar; b.x = xb_xcc_id(); b.st = st;
    if (threadIdx.x == 0) (void)xb_add(&bar[XB_XCNT(b.x)], 1u);
    return b;
}
__device__ __forceinline__ void xcd_barrier_complete(unsigned* bar, unsigned x, unsigned& nloc, unsigned& nx) {
    const unsigned G = gridDim.x * gridDim.y * gridDim.z;
    unsigned sum, cnt, mine, sp = 0u;
    for (;;) {
        sum = 0u; cnt = 0u; mine = 0u;
#pragma unroll
        for (unsigned j = 0; j < 16; ++j) { const unsigned c = xb_ld(&bar[XB_XCNT(j)]); sum += c; cnt += (c > 0u) ? 1u : 0u; mine = (j == x) ? c : mine; }
        if (sum == G) break;
        __builtin_amdgcn_s_sleep(1);
        if ((++sp & 255u) == 0u) { if (xb_ld(&bar[XB_TMO])) break; if (sp > XB_SPIN_CAP) { atomicAdd(&bar[XB_TMO], 1u); break; } }
    }
    nloc = mine > 0u ? mine : 1u; nx = cnt > 0u ? cnt : 1u;
}
__device__ __forceinline__ void xcd_barrier(const XcdBarrier& b) {
    asm volatile("s_waitcnt vmcnt(0)" ::: "memory");
    __syncthreads();
    if (threadIdx.x == 0) {
        unsigned* bar = b.bar;
        __builtin_amdgcn_s_waitcnt(0);
        unsigned nloc = b.st[0], nx = b.st[1];
        if (nloc == 0u) { xcd_barrier_complete(bar, b.x, nloc, nx); b.st[0] = nloc; b.st[1] = nx; }
        const unsigned old = xb_add(&bar[XB_XSUB(b.x)], 1u);
        const unsigned gen = old / nloc;
        if (old + 1u == (gen + 1u) * nloc) {
            __builtin_amdgcn_fence(__ATOMIC_RELEASE, "agent");
            asm volatile("s_waitcnt vmcnt(0)" ::: "memory");
            const unsigned og = xb_add(&bar[XB_TOP], 1u);
            const unsigned tg = og / nx;
            if (og + 1u == (tg + 1u) * nx) xb_add(&bar[XB_TOPGEN], 1u);
            else XB_SPIN(xb_ld(&bar[XB_TOPGEN]) == tg, bar);
            __builtin_amdgcn_fence(__ATOMIC_ACQUIRE, "agent");
            xb_add(&bar[XB_XGEN(b.x)], 1u);
            asm volatile("s_waitcnt vmcnt(0)" ::: "memory");
        } else {
            XB_SPIN(xb_ld(&bar[XB_XGEN(b.x)]) == gen, bar);
            __builtin_amdgcn_fence(__ATOMIC_ACQUIRE, "agent");
            asm volatile("s_waitcnt vmcnt(0)" ::: "memory");
        }
    }
    __syncthreads();
}

__device__ __forceinline__ float wave_sum(float v) {
#pragma unroll
    for (int o = 1; o < 64; o <<= 1) v += __shfl_xor(v, o);
    return v;
}
template <class RowMap>
__device__ __forceinline__ void transpose_item(const float* W, int K, int N, bf16* WT, const float* g1, const float* g2, int ksplit, RowMap rm, LAS float* scr, int item, int lane) {
    const int nblk = N / 32, kb = item / nblk, nb = item % nblk, k0 = 64 * kb, n0 = 32 * nb;
#pragma unroll 8
    for (int i = 0; i < 32; ++i) { const int kk = 2 * i + (lane >> 5), k = k0 + kk; const float gn = g1 ? (k < ksplit ? g1[k] : g2[k - ksplit]) : 1.0f;
        scr[kk * 33 + (lane & 31)] = W[(size_t)k * N + n0 + (lane & 31)] * gn; }
    LDS_WAIT(); asm volatile("" ::: "memory");
    const int c = lane & 7;
#pragma unroll
    for (int j = 0; j < 4; ++j) { const int n = (lane >> 3) + 8 * j; const LAS float* s = scr + (8 * c) * 33 + n;
        v4u o; o.x = pk2(s[0 * 33], s[1 * 33]); o.y = pk2(s[2 * 33], s[3 * 33]); o.z = pk2(s[4 * 33], s[5 * 33]); o.w = pk2(s[6 * 33], s[7 * 33]);
        *(GAS v4u*)(WT + (size_t)rm(n0 + n) * K + k0 + 8 * c) = o; }
    LDS_WAIT(); asm volatile("" ::: "memory");
}
struct RmId  { __device__ __forceinline__ int operator()(int n) const { return n; } };
struct RmWin { __device__ __forceinline__ int operator()(int n) const { if (n < 2944) return n; if (n < 3456) return n + 128; const int i = n - 3456; return 3584 + (i < 32 ? 2 * i : 2 * (i - 32) + 1); } };
struct RmQ   { __device__ __forceinline__ int operator()(int n) const { const int r = n % 192, hb = n - r; if (r < 128) return n; const int i = r - 128; return hb + 128 + (i < 32 ? 2 * i : 2 * (i - 32) + 1); } };
struct RmUp  { __device__ __forceinline__ int operator()(int n) const { return (n >> 7) * 256 + (n & 127); } };
struct RmGate{ __device__ __forceinline__ int operator()(int n) const { return (n >> 7) * 256 + 128 + (n & 127); } };

__device__ __forceinline__ void sincos_d(double a, double& s, double& c) {
    const double kd = __builtin_rint(a * 0.63661977236758134308); const long k = (long)kd;
    double r = __builtin_fma(-kd, 1.57079632679489655800e+00, a); r = __builtin_fma(-kd, 6.12323399573676603587e-17, r);
    const double r2 = r * r;
    double sp = 1.0 / 6227020800.0; sp = sp * r2 - 1.0 / 39916800.0; sp = sp * r2 + 1.0 / 362880.0; sp = sp * r2 - 1.0 / 5040.0; sp = sp * r2 + 1.0 / 120.0; sp = sp * r2 - 1.0 / 6.0; sp = sp * r2 * r + r;
    double cp = 1.0 / 479001600.0; cp = cp * r2 - 1.0 / 3628800.0; cp = cp * r2 + 1.0 / 40320.0; cp = cp * r2 - 1.0 / 720.0; cp = cp * r2 + 1.0 / 24.0; cp = cp * r2 - 0.5; cp = cp * r2 + 1.0;
    const int q = (int)(k & 3);
    s = (q == 0) ? sp : (q == 1) ? cp : (q == 2) ? -sp : -cp;
    c = (q == 0) ? cp : (q == 1) ? -sp : (q == 2) ? -cp : sp;
}

__device__ __forceinline__ void ssm_weights_group(int g, const float* a_re, const float* a_im, const float* b_re, const float* b_im, const float* c_re, const float* c_im,
                                                  const float* log_dt, const float* dskip, bf16* W1t, bf16* W2t, LAS float* L, int tid) {
    LAS float* PW = L;
    LAS float* BB = PW + 2 * 17 * 64 * 2;
    LAS float* CC = BB + 2 * 64 * 16 * 2;
    LAS float* KT = CC + 2 * 16 * 64 * 2;
    for (int i = tid; i < 2 * 17 * 64; i += 512) { const int d = i / (17 * 64), e = (i / 64) % 17, p = i & 63;
        const double dt = exp((double)log_dt[d * 128 + g]); const double are = a_re[(d * 128 + g) * 64 + p], aim = a_im[(d * 128 + g) * 64 + p];
        const double mag = exp((double)e * dt * are); double s, c; sincos_d((double)e * dt * aim, s, c);
        PW[i * 2] = (float)(mag * c); PW[i * 2 + 1] = (float)(mag * s); }
    for (int i = tid; i < 2 * 64 * 16; i += 512) { const int d = i / 1024, p = (i >> 4) & 63, h = i & 15;
        const double dt = exp((double)log_dt[d * 128 + g]); const double are = a_re[(d * 128 + g) * 64 + p], aim = a_im[(d * 128 + g) * 64 + p];
        const double x = dt * are, y = dt * aim; double sy, cy, sh, ch; sincos_d(y, sy, cy); sincos_d(0.5 * y, sh, ch);
        const double em1 = expm1(x); const double re1 = em1 * cy - 2.0 * sh * sh, im1 = (em1 + 1.0) * sy;
        const double den = are * are + aim * aim; const double qre = (re1 * are + im1 * aim) / den, qim = (im1 * are - re1 * aim) / den;
        const size_t bi = ((size_t)((d * 128 + g) * 64 + p)) * 16 + h; const double br = b_re[bi], bim = b_im[bi];
        BB[i * 2] = (float)(qre * br - qim * bim); BB[i * 2 + 1] = (float)(qre * bim + qim * br); }
    for (int i = tid; i < 2 * 16 * 64; i += 512) { const int d = i / 1024, h = (i >> 6) & 15, p = i & 63; const size_t ci = ((size_t)((d * 128 + g) * 16 + h)) * 64 + p;
        CC[i * 2] = c_re[ci]; CC[i * 2 + 1] = c_im[ci]; }
    __syncthreads();
    for (int i = tid; i < 2 * 16 * 256; i += 512) { const int d = i >> 12, e = (i >> 8) & 15, h = (i >> 4) & 15, hh = i & 15; float acc = 0.f;
        for (int p = 0; p < 64; ++p) { const float cr = CC[((d * 16 + h) * 64 + p) * 2], ci = CC[((d * 16 + h) * 64 + p) * 2 + 1];
            const float pr = PW[((d * 17 + e) * 64 + p) * 2], pi = PW[((d * 17 + e) * 64 + p) * 2 + 1];
            const float br = BB[((d * 64 + p) * 16 + hh) * 2], bi = BB[((d * 64 + p) * 16 + hh) * 2 + 1];
            const float tr = cr * pr - ci * pi, ti = cr * pi + ci * pr; acc += tr * br - ti * bi; }
        KT[i] = acc; }
    __syncthreads();
    for (int i = tid; i < 256 * 32; i += 512) { const int n = i >> 5, k0 = (i & 31) * 8; const int d = n >> 7, im = (n >> 6) & 1, p = n & 63; const int s = k0 >> 4, h0 = k0 & 15, e = d ? s : 15 - s;
        const float pr = PW[((d * 17 + e) * 64 + p) * 2], pi = PW[((d * 17 + e) * 64 + p) * 2 + 1]; float v[8];
#pragma unroll
        for (int j = 0; j < 8; ++j) { const float br = BB[((d * 64 + p) * 16 + h0 + j) * 2], bi = BB[((d * 64 + p) * 16 + h0 + j) * 2 + 1]; v[j] = im ? (pr * bi + pi * br) : (pr * br - pi * bi); }
        v4u o; o.x = pk2(v[0], v[1]); o.y = pk2(v[2], v[3]); o.z = pk2(v[4], v[5]); o.w = pk2(v[6], v[7]);
        *(GAS v4u*)(W1t + ((size_t)(g * 256 + n)) * 256 + k0) = o; }
    for (int i = tid; i < 256 * 64; i += 512) { const int n = i >> 6, k0 = (i & 63) * 8; const int j = n >> 4, h = n & 15; float v[8];
        if (k0 < 256) { const int d = k0 >> 7, im = (k0 >> 6) & 1, p0 = k0 & 63, e = d ? 16 - j : j + 1;
#pragma unroll
            for (int q = 0; q < 8; ++q) { const int p = p0 + q; const float cr = CC[((d * 16 + h) * 64 + p) * 2], ci = CC[((d * 16 + h) * 64 + p) * 2 + 1];
                const float pr = PW[((d * 17 + e) * 64 + p) * 2], pi = PW[((d * 17 + e) * 64 + p) * 2 + 1]; v[q] = im ? -(cr * pi + ci * pr) : (cr * pr - ci * pi); }
        } else { const int s = (k0 - 256) >> 4, h0 = (k0 - 256) & 15;
#pragma unroll
            for (int q = 0; q < 8; ++q) { const int hh = h0 + q; float val = 0.f;
                if (s <= j) val += KT[((0 * 16 + (j - s)) * 16 + h) * 16 + hh];
                if (s >= j) val += KT[((1 * 16 + (s - j)) * 16 + h) * 16 + hh];
                if (s == j && h == hh) val += dskip[g * 16 + h];
                v[q] = val; } }
        v4u o; o.x = pk2(v[0], v[1]); o.y = pk2(v[2], v[3]); o.z = pk2(v[4], v[5]); o.w = pk2(v[6], v[7]);
        *(GAS v4u*)(W2t + ((size_t)(g * 256 + n)) * 512 + k0) = o; }
    __syncthreads();
}

struct Args { const float* in[27]; float* out; unsigned char* ws; int ph_lo, ph_hi; };

__global__ void __launch_bounds__(NWAVES * 64, 2) enc_fwd(Args args) {
    extern __shared__ __attribute__((aligned(16))) unsigned char lds[];
    LAS unsigned char* ldsb = (LAS unsigned char*)lds;
    volatile LAS unsigned* MISC = (volatile LAS unsigned*)(ldsb + MISC_OFF);
    const int tid = threadIdx.x, lane = tid & 63, wave = __builtin_amdgcn_readfirstlane(tid >> 6);
    const int G = gridDim.x, bx = blockIdx.x; const int vcu = (G % 8 == 0) ? (bx % 8) * (G / 8) + bx / 8 : bx;
    const int gw = vcu * NWAVES + wave, NGW = G * NWAVES, gt = vcu * (NWAVES * 64) + tid, NGT = G * NWAVES * 64;
    unsigned char* ws = args.ws; unsigned char* outb = (unsigned char*)args.out;
    gu32* ctl = (gu32*)(ws + WS_CTL);
    const float* x_p = args.in[0]; const float* x_s = args.in[1];
    float* rstd_x = (float*)(ws + WS_RSTDX); float* rstd_q = (float*)(ws + WS_RSTDQ); float* rstd_kv = (float*)(ws + WS_RSTDKV);
    float* r2v = (float*)(ws + WS_R2); float* ratio = (float*)(ws + WS_RATIO); float* rstd_x1 = (float*)(ws + WS_RSTDX1);
    float* stA = (float*)(ws + WS_STA); float* stB = (float*)(ws + WS_STB); float* stQ = (float*)(ws + WS_STQ); float* stKV = (float*)(ws + WS_STKV);
    float* ropetab = (float*)(ws + WS_ROPE);
    bf16* Wi = (bf16*)(ws + WS_WIN); bf16* Wglu = (bf16*)(ws + WS_WGLU); bf16* Wq = (bf16*)(ws + WS_WQ); bf16* Wkv = (bf16*)(ws + WS_WKV); bf16* Wout = (bf16*)(ws + WS_WOUT);
    bf16* Wug = (bf16*)(ws + WS_WUG); bf16* Wdn = (bf16*)(ws + WS_WDN); bf16* W1t = (bf16*)(ws + WS_W1T); bf16* W2t = (bf16*)(ws + WS_W2T);
    bf16* bufA = (bf16*)(ws + WS_A); bf16* bufB = (bf16*)(ws + WS_B);
    bf16* qlat = (bf16*)(ws + WS_QLAT); bf16* kvlat = (bf16*)(ws + WS_KVLAT); bf16* krope = (bf16*)(ws + WS_KROPE); bf16* gact = (bf16*)(ws + WS_GACT);
    bf16* hup = (bf16*)(ws + WS_HUP); bf16* hgate = (bf16*)(ws + WS_HGATE);
    bf16* X = (bf16*)(outb + OUT_X); bf16* kvb = (bf16*)(outb + OUT_KV);

    for (int u = tid; u < (LDS_BYTES - LDSCTL_OFF) / 4; u += NWAVES * 64) ((LAS unsigned*)(ldsb + LDSCTL_OFF))[u] = 0u;
    __syncthreads();
    XcdBarrier bar = xcd_barrier_post((unsigned*)(ctl + CW_BAR), MISC + 8);
    const int lo = args.ph_lo, hi = args.ph_hi;
#ifndef PHMASK
#define PHMASK 0xfffffffu
#endif
#define IN(k) (((PHMASK >> ((k) < 9 ? (k) : ((k) >= 18 ? 12 : 9 + ((k) - 9) % 3))) & 1u) && lo <= (k) && (k) < hi)
#define SEAM(k) do { if (IN(k) && IN((k) + 1)) xcd_barrier(bar); } while (0)

    if (IN(0)) {
        if (vcu < 128) ssm_weights_group(vcu, args.in[4], args.in[5], args.in[6], args.in[7], args.in[8], args.in[9], args.in[10], args.in[11], W1t, W2t, (LAS float*)ldsb, tid);
        LAS float* scr = (LAS float*)(ldsb + wave * 16384);
        constexpr int I_IN = 64 * 110, I_GLU = 32 * 64, I_Q = 14 * 96, I_KV = 8 * 128, I_OUT = 64 * 128, I_UP = 64 * 344, I_DN = 172 * 128;
        constexpr int NITEMS = I_IN + I_GLU + I_Q + I_KV + I_OUT + 2 * I_UP + I_DN;
        for (int it = gw; it < NITEMS; it += NGW) {
            int r = it;
            if (r < I_IN) { transpose_item(args.in[2], 4096, 3520, Wi, args.in[3], args.in[3], 4096, RmWin(), scr, r, lane); continue; } r -= I_IN;
            if (r < I_GLU) { transpose_item(args.in[12], 2048, 2048, Wglu, nullptr, nullptr, 0, RmId(), scr, r, lane); continue; } r -= I_GLU;
            if (r < I_Q) { transpose_item(args.in[14], 896, 3072, Wq, args.in[13], args.in[13], 896, RmQ(), scr, r, lane); continue; } r -= I_Q;
            if (r < I_KV) { transpose_item(args.in[16], 512, 4096, Wkv, args.in[15], args.in[15], 512, RmId(), scr, r, lane); continue; } r -= I_KV;
            if (r < I_OUT) { transpose_item(args.in[19], 4096, 4096, Wout, args.in[17], args.in[18], 2048, RmId(), scr, r, lane); continue; } r -= I_OUT;
            if (r < I_UP) { transpose_item(args.in[21], 4096, 11008, Wug, args.in[20], args.in[20], 4096, RmUp(), scr, r, lane); continue; } r -= I_UP;
            if (r < I_UP) { transpose_item(args.in[22], 4096, 11008, Wug, args.in[20], args.in[20], 4096, RmGate(), scr, r, lane); continue; } r -= I_UP;
            transpose_item(args.in[25], 11008, 4096, Wdn, nullptr, nullptr, 0, RmId(), scr, r, lane);
        }
        for (int i = gt; i < 320 * 512; i += NGT) { const int rr = i >> 9, c8 = (i & 511) * 8; const int row = rr < 128 ? 2944 + rr : 3648 + (rr - 128);
            *(GAS v4u*)(Wi + (size_t)row * 4096 + c8) = (v4u){0u, 0u, 0u, 0u}; }
        for (int m = gw; m < T; m += NGW) { const float* xr = m < 16384 ? x_p + (size_t)m * DM : x_s + (size_t)(m - 16384) * DM;
            f32x4 v[16]; float s = 0.f;
#pragma unroll
            for (int j = 0; j < 16; ++j) { v[j] = *((const GAS f32x4*)xr + lane + 64 * j); s += (v[j].x * v[j].x + v[j].y * v[j].y) + (v[j].z * v[j].z + v[j].w * v[j].w); }
            s = wave_sum(s); if (lane == 0) rstd_x[m] = 1.0f / sqrtf(s * (1.0f / DM) + EPS);
            GAS v2u* o8 = (GAS v2u*)(bufA + (size_t)m * DM) + lane;
#pragma unroll
            for (int j = 0; j < 16; ++j) o8[64 * j] = (v2u){pk2(v[j].x, v[j].y), pk2(v[j].z, v[j].w)}; }
        for (int i = gt; i < 8192 * 32; i += NGT) { const int pos = i >> 5, k = i & 31; const double inv = exp(-(double)k * (9.210340371976184 / 32.0));
            double s, c; sincos_d((double)pos * inv, s, c); *(GAS f32x2*)(ropetab + (size_t)i * 2) = (f32x2){(float)c, (float)s}; }
    }
    SEAM(0);

    if (IN(1)) {
        pg8::Gemm g{bufA, Wi, DM, DM, DM}; pg8::StaticOrder S; S.init(T, 3840, G, bx);
        pg8::EpiWin E{rstd_x, X, qlat, kvlat, krope, stQ, stKV, ropetab};
        pg8::gemm_phase(ldsb, g, S, E);
    }
    SEAM(1);

    if (IN(2)) {
        pg8::Gemm g{X + 256, W1t, 512, 256, 256}; pg8::GroupOrder S{768, 6, G, bx};
        pg8::EpiSsm1 E{X};
        pg8::gemm_phase(ldsb, g, S, E);
        for (int r = gt; r < T; r += NGT) { float s = 0.f;
#pragma unroll
            for (int j = 0; j < 4; ++j) { const f32x4 v = *(const GAS f32x4*)(stQ + (size_t)r * 16 + 4 * j); s += (v.x + v.y) + (v.z + v.w); }
            rstd_q[r] = 1.0f / sqrtf(s * (1.0f / QLAT) + EPS); float s2 = 0.f;
#pragma unroll
            for (int j = 0; j < 2; ++j) { const f32x4 v = *(const GAS f32x4*)(stKV + (size_t)r * 8 + 4 * j); s2 += (v.x + v.y) + (v.z + v.w); }
            rstd_kv[r] = 1.0f / sqrtf(s2 * (1.0f / KVLAT) + EPS); }
    }
    SEAM(2);

    if (IN(3)) {
        if (wave < 4) { const int task = vcu * 4 + wave;
            if (task < 1024) { const int seq = task >> 8, g = (task >> 1) & 127, dir = task & 1, p = lane;
                const int c0 = seq < 2 ? seq * 512 : 1024 + (seq - 2) * 256, nc = seq < 2 ? 512 : 256;
                const double dt = exp((double)args.in[10][dir * 128 + g]); const double are = args.in[4][(dir * 128 + g) * 64 + p], aim = args.in[5][(dir * 128 + g) * 64 + p];
                const double mag = exp(16.0 * dt * are); double sn, cs; sincos_d(16.0 * dt * aim, sn, cs);
                const float ar = (float)(mag * cs), ai = (float)(mag * sn);
                bf16* Xg = X + (size_t)g * NCHUNK * 512 + dir * 128 + p;
                float zr = 0.f, zi = 0.f;
                for (int cb = 0; cb < nc; cb += 16) {
                    unsigned short sre[16], sim[16];
#pragma unroll
                    for (int i = 0; i < 16; ++i) { const int c = dir ? (c0 + nc - 1 - (cb + i)) : (c0 + cb + i); sre[i] = Xg[(size_t)c * 512]; sim[i] = Xg[(size_t)c * 512 + 64]; }
#pragma unroll
                    for (int i = 0; i < 16; ++i) { const int c = dir ? (c0 + nc - 1 - (cb + i)) : (c0 + cb + i);
                        Xg[(size_t)c * 512] = (bf16)f2bf(zr); Xg[(size_t)c * 512 + 64] = (bf16)f2bf(zi);
                        const float sr = bf2f(sre[i]), si = bf2f(sim[i]); const float nr = ar * zr - ai * zi + sr, ni = ar * zi + ai * zr + si; zr = nr; zi = ni; }
                }
            }
        }
        __syncthreads();
        { pg8::Gemm g{qlat, Wq, QLAT, QLAT, QLAT}; pg8::StaticOrder S; S.init(T, QW, G, bx); pg8::EpiQ E{rstd_q, bufA, ropetab}; pg8::gemm_phase(ldsb, g, S, E); }
        { pg8::Gemm g{kvlat, Wkv, KVLAT, KVLAT, KVLAT}; pg8::StaticOrder S; S.init(T, KVW, G, bx); pg8::EpiKV E{rstd_kv, kvb}; pg8::gemm_phase(ldsb, g, S, E); }
    }
    SEAM(3);

    if (IN(4)) {
        pg8::Gemm g{X, W2t, 512, 512, 512}; pg8::GroupOrder S{768, 6, G, bx};
        pg8::EpiSsm2 E{gact};
        pg8::gemm_phase(ldsb, g, S, E);
    }
    SEAM(4);

    if (IN(5)) {
#ifndef NO_GLU
        { pg8::Gemm g{gact, Wglu, MIXW, MIXW, MIXW}; pg8::StaticOrder S; S.init(T, MIXW, G, bx); pg8::EpiGlu E{gact, bufB, stA}; pg8::gemm_phase(ldsb, g, S, E); }
#endif
#ifndef NO_ATTN
        const int xcd = vcu >> 5, cc = vcu & 31; const int nun = (G == 256) ? 6 : (1536 - bx + G - 1) / G;
#pragma unroll 1
        for (int i = 0; i < nun; ++i) {
            int bh, qb, seq, rowbase;
            if (G == 256) { if (i < 4) { bh = xcd * 4 + i; qb = cc; seq = 8192; } else { bh = xcd * 4 + 2 * (i - 4) + (cc >> 4); qb = cc & 15; seq = 4096; } }
            else { const int uidx = bx + i * G; if (uidx < 1024) { bh = uidx >> 5; qb = uidx & 31; seq = 8192; } else { const int v = uidx - 1024; bh = v >> 4; qb = v & 15; seq = 4096; } }
            const int b = bh >> 4, h = bh & 15; rowbase = (seq == 8192) ? b * 8192 : 16384 + b * 4096;
            __syncthreads();
            attn::attn_unit(bufA + (size_t)(rowbase + qb * 256) * QW + h * 192, kvb + (size_t)rowbase * KVW + h * 256, kvb + (size_t)rowbase * KVW + h * 256 + 128,
                            krope + (size_t)rowbase * 64, bufB + (size_t)(rowbase + qb * 256) * DM + 2048 + h * 128, stB + (size_t)(rowbase + qb * 256) * 16 + h, seq, (char*)lds);
        }
#endif
    }
    SEAM(5);

    if (IN(6)) {
        for (int r = gt; r < T; r += NGT) { float s = 0.f;
#pragma unroll
            for (int j = 0; j < 8; ++j) { const f32x4 v = *(const GAS f32x4*)(stA + (size_t)r * 32 + 4 * j); s += (v.x + v.y) + (v.z + v.w); }
            const float r1 = 1.0f / sqrtf(s * (1.0f / MIXW) + EPS); float s2 = 0.f;
#pragma unroll
            for (int j = 0; j < 4; ++j) { const f32x4 v = *(const GAS f32x4*)(stB + (size_t)r * 16 + 4 * j); s2 += (v.x + v.y) + (v.z + v.w); }
            const float r2 = 1.0f / sqrtf(s2 * (1.0f / MIXW) + EPS); r2v[r] = r2; ratio[r] = r1 / r2; }
    }
    SEAM(6);

    if (IN(7)) {
        pg8::Gemm g{bufB, Wout, DM, DM, DM}; pg8::StaticOrder S; S.init(T, DM, G, bx);
        pg8::EpiWout E{x_p, x_s, r2v, ratio, args.out, bufA, stA};
        pg8::gemm_phase(ldsb, g, S, E);
    }
    SEAM(7);

    if (IN(8)) {
        for (int r = gt; r < T; r += NGT) { float s = 0.f;
#pragma unroll
            for (int j = 0; j < 16; ++j) { const f32x4 v = *(const GAS f32x4*)(stA + (size_t)r * 64 + 4 * j); s += (v.x + v.y) + (v.z + v.w); }
            rstd_x1[r] = 1.0f / sqrtf(s * (1.0f / DM) + EPS); }
    }
    SEAM(8);

#pragma unroll 1
    for (int ch = 0; ch < 3; ++ch) {
        const int rb = ch * 8192;
        if (IN(9 + 3 * ch)) {
            pg8::Gemm g{bufA + (size_t)rb * DM, Wug, DM, DM, DM}; pg8::StaticOrder S; S.init(8192, 2 * DFF, G, bx);
            pg8::EpiFfnA E{rstd_x1, rb, bufB, hup, hgate, args.in[23], args.in[24]};
            pg8::gemm_phase(ldsb, g, S, E);
        }
        SEAM(9 + 3 * ch);
        if (IN(10 + 3 * ch)) {
            const float* cw = args.in[23]; const float* cb = args.in[24];
            for (int i = gt; i < 128 * 2 * (DFF / 8); i += NGT) { const int f0 = (i % (DFF / 8)) * 8, sw = i / (DFF / 8), strip = sw >> 1, which = sw & 1;
                const int lrow = strip * 64 + (which ? 63 : 0), grow = rb + lrow, pos = pos_of(grow), len = len_of(grow);
                v4u up0, up1, up2;
                if (which == 0) { up1 = *(const GAS v4u*)(hup + ((size_t)strip * 4 + 0) * DFF + f0); up2 = *(const GAS v4u*)(hup + ((size_t)strip * 4 + 1) * DFF + f0);
                    up0 = (pos == 0) ? (v4u){0u, 0u, 0u, 0u} : *(const GAS v4u*)(hup + ((size_t)(strip - 1) * 4 + 3) * DFF + f0); }
                else { up0 = *(const GAS v4u*)(hup + ((size_t)strip * 4 + 2) * DFF + f0); up1 = *(const GAS v4u*)(hup + ((size_t)strip * 4 + 3) * DFF + f0);
                    up2 = (pos == len - 1) ? (v4u){0u, 0u, 0u, 0u} : *(const GAS v4u*)(hup + ((size_t)(strip + 1) * 4 + 0) * DFF + f0); }
                const v4u gt4 = *(const GAS v4u*)(hgate + ((size_t)strip * 2 + which) * DFF + f0);
                unsigned ow[4];
#pragma unroll
                for (int k = 0; k < 4; ++k) { const int f = f0 + 2 * k;
                    const float a0 = bflo(up0[k]), a1 = bflo(up1[k]), a2 = bflo(up2[k]), b0 = bfhi(up0[k]), b1 = bfhi(up1[k]), b2 = bfhi(up2[k]);
                    const float c0 = cw[f] * a0 + cw[DFF + f] * a1 + cw[2 * DFF + f] * a2 + cb[f], c1 = cw[f + 1] * b0 + cw[DFF + f + 1] * b1 + cw[2 * DFF + f + 1] * b2 + cb[f + 1];
                    ow[k] = pk2(c0 * sigmoidf_fast(c0) * bflo(gt4[k]), c1 * sigmoidf_fast(c1) * bfhi(gt4[k])); }
                *(GAS v4u*)(bufB + (size_t)lrow * DFF + f0) = (v4u){ow[0], ow[1], ow[2], ow[3]}; }
        }
        SEAM(10 + 3 * ch);
        if (IN(11 + 3 * ch)) {
            pg8::Gemm g{bufB, Wdn, DFF, DFF, DFF}; pg8::StaticOrder S; S.init(8192, DM, G, bx);
            pg8::EpiDown E{args.out, rb, stA};
            pg8::gemm_phase(ldsb, g, S, E);
        }
        SEAM(11 + 3 * ch);
    }

    if (IN(18)) {
        const float* gf = args.in[26];
        for (int m = gw; m < T; m += NGW) { const float s = wave_sum(stA[(size_t)m * 64 + lane]); const float rs = 1.0f / sqrtf(s * (1.0f / DM) + EPS);
            GAS f32x4* xr = (GAS f32x4*)(args.out + (size_t)m * DM) + lane; const GAS f32x4* gr = (const GAS f32x4*)gf + lane;
#pragma unroll
            for (int j = 0; j < 16; ++j) { const f32x4 v = xr[64 * j], gg = gr[64 * j]; xr[64 * j] = v * rs * gg; } }
    }
#undef IN
#undef SEAM
}

constexpr int N_PHASES = 19;
extern "C" void kernel_launch(void* const* d_in, const int* in_sizes, int n_in, void* d_out, int out_size, void* d_ws, size_t ws_size, hipStream_t stream) {
    static int grid = 0;
    if (grid == 0) {
        if (n_in != 27 || out_size != T * DM || ws_size < WS_END) { fprintf(stderr, "kernel_launch: unexpected shapes (n_in %d out %d ws %zu)\n", n_in, out_size, ws_size); grid = -1; return; }
        int dev = 0, cus = 0, per_cu = 0;
        if (hipGetDevice(&dev) != hipSuccess || hipDeviceGetAttribute(&cus, hipDeviceAttributeMultiprocessorCount, dev) != hipSuccess) { grid = -1; return; }
        if (hipFuncSetAttribute((const void*)enc_fwd, hipFuncAttributeMaxDynamicSharedMemorySize, LDS_BYTES) != hipSuccess) { fprintf(stderr, "kernel_launch: hipFuncSetAttribute failed\n"); grid = -1; return; }
        if (hipOccupancyMaxActiveBlocksPerMultiprocessor(&per_cu, (const void*)enc_fwd, NWAVES * 64, LDS_BYTES) != hipSuccess || per_cu < 1) { fprintf(stderr, "kernel_launch: occupancy query says %d\n", per_cu); }
        (void)hipGetLastError();
        grid = cus;
    }
    if (grid < 0) return;
    if (hipMemsetAsync((char*)d_ws + WS_CTL, 0, CTL_ZERO_BYTES, stream) != hipSuccess) return;
    Args a{};
    for (int i = 0; i < 27; ++i) a.in[i] = (const float*)d_in[i];
    a.out = (float*)d_out; a.ws = (unsigned char*)d_ws;
#ifndef MK_N_LAUNCHES
#define MK_N_LAUNCHES 1
#endif
    if (MK_N_LAUNCHES == 1) { a.ph_lo = 0; a.ph_hi = N_PHASES; hipLaunchKernelGGL(enc_fwd, dim3(grid), dim3(NWAVES * 64), LDS_BYTES, stream, a); }
    else { for (int p = 0; p < N_PHASES; ++p) { a.ph_lo = p; a.ph_hi = p + 1; hipLaunchKernelGGL(enc_fwd, dim3(grid), dim3(NWAVES * 64), LDS_BYTES, stream, a); } }
    const hipError_t le = hipPeekAtLastError();
    if (le != hipSuccess) fprintf(stderr, "kernel_launch: launch failed: %s\n", hipGetErrorName(le));
}
```

```cpp
#include <hip/hip_runtime.h>
#include <hip/hip_bf16.h>
#include <cstdio>
#include <cstdint>

namespace pg8 {
#define PG8_LAS __attribute__((address_space(3)))
typedef unsigned short bf16_t;
typedef short bf16x8 __attribute__((ext_vector_type(8)));
typedef float f32x4 __attribute__((ext_vector_type(4)));
typedef float f32x2 __attribute__((ext_vector_type(2)));
typedef unsigned u32x4 __attribute__((ext_vector_type(4)));
typedef unsigned u32x2 __attribute__((ext_vector_type(2)));
constexpr int BM = 256, BK = 64, HALF = 128, HTB = HALF * BK * 2  , STAGE_BYTES = 8 * HTB, NXCD = 8, WGM = 8;

__host__ __device__ __forceinline__ int lds_byte(int r, int c) { const int st = (r >> 4) * 2 + (c >> 5), rr = r & 15, cc = c & 31, ob = rr * 64 + cc * 2; return st * 1024 + (ob ^ (((ob >> 9) & 1) << 5)); }
__host__ __device__ __forceinline__ void stage_rc(int b, int& R, int& C) { const int st = b / 1024, sb = b % 1024, swz = sb ^ (((sb >> 9) & 1) << 5); R = (st >> 1) * 16 + swz / 64; C = (st & 1) * 32 + (swz % 64) / 2; }
__host__ __device__ __forceinline__ int perm32(int rho) { const int n = rho >> 4, i = rho & 15; return 8 * (i >> 2) + 4 * n + (i & 3); }

struct Unit { int pm, pn; };
struct Gemm { const bf16_t* A; const bf16_t* Bt; int lda, ldb, K; };

struct StaticOrder {
    int nM, nN, nwg, G, c;
    __host__ __device__ void init(int M, int N, int G_, int c_) { nM = M / BM; nN = N / BM; nwg = nM * nN; G = G_; c = c_; }
    __host__ __device__ bool next(int i, Unit& u) const {
        const long L = (long)i * G + c; if (L >= nwg) return false;
        int wgid = (int)L; { const int q = nwg / NXCD, r = nwg % NXCD, xcd = wgid % NXCD, off = wgid / NXCD; wgid = (xcd < r ? xcd * (q + 1) : r * (q + 1) + (xcd - r) * q) + off; }
        const int nig = WGM * nN, gid = wgid / nig, fm = gid * WGM, gsz = (nM - fm) < WGM ? (nM - fm) : WGM;
        u.pm = fm + ((wgid % nig) % gsz); u.pn = (wgid % nig) / gsz; return true;
    }
};
struct ZeroOrder { int n, G, c; __host__ __device__ bool next(int i, Unit& u) const { const long L = (long)i * G + c; if (L >= n) return false; u.pm = 0; u.pn = 0; return true; } };
struct GroupOrder {
    int n, per, G, c;
    __host__ __device__ bool next(int i, Unit& u) const { const long L = (long)i * G + c; if (L >= n) return false; u.pm = (int)L; u.pn = (int)L / per; return true; }
};

__device__ __forceinline__ unsigned cvt_pk_bf16(float lo, float hi) { unsigned r; asm volatile("v_cvt_pk_bf16_f32 %0, %1, %2" : "=v"(r) : "v"(lo), "v"(hi)); return r; }
__device__ __forceinline__ u32x4 pack8(const f32x4 a, const f32x4 b) { u32x4 w; w.x = cvt_pk_bf16(a[0], a[1]); w.y = cvt_pk_bf16(a[2], a[3]); w.z = cvt_pk_bf16(b[0], b[1]); w.w = cvt_pk_bf16(b[2], b[3]); return w; }

template <class Epi, class Sched>
__device__ __forceinline__ void gemm_phase(PG8_LAS unsigned char* lds, const Gemm g, const Sched& S, const Epi& E) {
    int tid_l = threadIdx.x; asm volatile("" : "+v"(tid_l));
    const int tid = tid_l, wid = __builtin_amdgcn_readfirstlane(tid >> 6), lane = tid & 63, wr = wid >> 2, wc = wid & 3, fr = lane & 15, fq = lane >> 4;
    const int K = g.K, nt = K / BK;
    unsigned voffA[2], voffB[2];
#pragma unroll
    for (int i = 0; i < 2; ++i) { int R, C; stage_rc(tid * 16 + i * 8192, R, C); const int Rb = Epi::PERM ? ((R & ~31) + perm32(R & 31)) : R;
        voffA[i] = (unsigned)(R * g.lda + C) * 2u; voffB[i] = (unsigned)(Rb * g.ldb + C) * 2u; }
    asm volatile("" : "+v"(voffA[0]), "+v"(voffA[1]), "+v"(voffB[0]), "+v"(voffB[1]));
    const size_t kstep = (size_t)(BK * 2);
    const size_t hstepA = (size_t)HALF * g.lda * 2, hstepB = (size_t)HALF * g.ldb * 2;
    const size_t tstepA = 2 * hstepA, tstepB = 2 * hstepB;
    const unsigned ldsw = (unsigned)wid * 1024u;
    const int aoff = lds_byte(wr * 64 + fr, fq * 8), boff = lds_byte(wc * 32 + fr, fq * 8);
#define PG8_SA(b, h) (((b) * 2 + (h)) * HTB)
#define PG8_SB(b, h) ((4 + (b) * 2 + (h)) * HTB)
#define PG8_STAGE(bufoff, gbase, voff) do { _Pragma("unroll") for (int _i = 0; _i < 2; ++_i) \
        __builtin_amdgcn_global_load_lds((const unsigned*)((const char*)(gbase) + (voff)[_i]), (PG8_LAS unsigned*)(lds + (bufoff) + ldsw + _i * 8192), 16, 0, 0); } while (0)
#define PG8_LDA(dst, b, h) do { _Pragma("unroll") for (int m = 0; m < 4; ++m) _Pragma("unroll") for (int k = 0; k < 2; ++k) dst[m][k] = *(const PG8_LAS bf16x8*)(lds + PG8_SA(b, h) + aoff + m * 2048 + k * 1024); } while (0)
#define PG8_LDB(dst, b, h) do { _Pragma("unroll") for (int n = 0; n < 2; ++n) _Pragma("unroll") for (int k = 0; k < 2; ++k) dst[n][k] = *(const PG8_LAS bf16x8*)(lds + PG8_SB(b, h) + boff + n * 2048 + k * 1024); } while (0)
#define PG8_MMA(ai, bj, At, Bt) do { __builtin_amdgcn_s_setprio(1); _Pragma("unroll") for (int m = 0; m < 4; ++m) _Pragma("unroll") for (int n = 0; n < 2; ++n) _Pragma("unroll") for (int k = 0; k < 2; ++k) \
        acc[ai][bj][m][n] = __builtin_amdgcn_mfma_f32_16x16x32_bf16(Bt[n][k], At[m][k], acc[ai][bj][m][n], 0, 0, 0); __builtin_amdgcn_s_setprio(0); } while (0)
#define PG8_WAIT_V(n) asm volatile("s_waitcnt vmcnt(" #n ")" ::: "memory")
#define PG8_WAIT_L(n) asm volatile("s_waitcnt lgkmcnt(" #n ")" ::: "memory")
#define PG8_BAR __builtin_amdgcn_s_barrier()
#define PG8_SCHED __builtin_amdgcn_sched_barrier(0)
    Unit cur, nxt; int ui = 0;
    if (!S.next(0, cur)) return;
    f32x4 acc[2][2][4][2];
#pragma unroll
    for (int a = 0; a < 2; ++a)
#pragma unroll
        for (int b = 0; b < 2; ++b)
#pragma unroll
            for (int m = 0; m < 4; ++m)
#pragma unroll
                for (int n = 0; n < 2; ++n) acc[a][b][m][n] = (f32x4){0.f, 0.f, 0.f, 0.f};
    bf16x8 At[4][2], B0[2][2], B1[2][2];
    const char* cA = (const char*)g.A + (size_t)cur.pm * tstepA; const char* cB = (const char*)g.Bt + (size_t)cur.pn * tstepB;
    PG8_STAGE(PG8_SB(0, 0), cB, voffB); PG8_STAGE(PG8_SB(0, 1), cB + hstepB, voffB); PG8_STAGE(PG8_SA(0, 0), cA, voffA); PG8_STAGE(PG8_SA(0, 1), cA + hstepA, voffA);
    if (wr == 1) PG8_BAR;
    PG8_WAIT_V(2); PG8_BAR;
    PG8_STAGE(PG8_SB(1, 0), cB + kstep, voffB); PG8_STAGE(PG8_SA(1, 0), cA + kstep, voffA); PG8_STAGE(PG8_SB(1, 1), cB + hstepB + kstep, voffB);
    PG8_WAIT_V(6); PG8_BAR;
    for (;;) {
        const bool has_next = S.next(ui + 1, nxt);
        const char* nA = has_next ? (const char*)g.A + (size_t)nxt.pm * tstepA : cA; const char* nB = has_next ? (const char*)g.Bt + (size_t)nxt.pn * tstepB : cB;
#pragma unroll 1
        for (int t = 0; t < nt; t += 2) {
            const bool last = (t == nt - 2);
            if constexpr (Epi::MIDK) { if (t == (nt >> 1)) E.midk(acc, cur, wr, fr); }
            const char* a1 = cA + (size_t)(t + 1) * kstep;
            const char* a2 = last ? nA : cA + (size_t)(t + 2) * kstep; const char* b2 = last ? nB : cB + (size_t)(t + 2) * kstep;
            const char* a3 = a2 + kstep; const char* b3 = b2 + kstep;
            PG8_LDB(B0, 0, 0); PG8_LDB(B1, 0, 1); PG8_SCHED; PG8_LDA(At, 0, 0); PG8_STAGE(PG8_SA(1, 1), a1 + hstepA, voffA);
            PG8_WAIT_V(8); PG8_WAIT_L(0); PG8_BAR; PG8_MMA(0, 0, At, B0); PG8_MMA(0, 1, At, B1); PG8_BAR; PG8_SCHED;
            PG8_LDA(At, 0, 1); PG8_STAGE(PG8_SB(0, 0), b2, voffB); PG8_STAGE(PG8_SB(0, 1), b2 + hstepB, voffB); PG8_STAGE(PG8_SA(0, 0), a2, voffA);
            PG8_WAIT_V(8); PG8_WAIT_L(0); PG8_BAR; PG8_MMA(1, 0, At, B0); PG8_MMA(1, 1, At, B1); PG8_BAR; PG8_SCHED;
            PG8_LDB(B0, 1, 0); PG8_LDB(B1, 1, 1); PG8_SCHED; PG8_LDA(At, 1, 0); PG8_STAGE(PG8_SA(0, 1), a2 + hstepA, voffA);
            PG8_WAIT_V(8); PG8_WAIT_L(0); PG8_BAR; PG8_MMA(0, 0, At, B0); PG8_MMA(0, 1, At, B1); PG8_BAR; PG8_SCHED;
            PG8_LDA(At, 1, 1); PG8_STAGE(PG8_SB(1, 0), b3, voffB); PG8_STAGE(PG8_SB(1, 1), b3 + hstepB, voffB); PG8_STAGE(PG8_SA(1, 0), a3, voffA);
            PG8_WAIT_V(8); PG8_WAIT_L(0); PG8_BAR; PG8_MMA(1, 0, At, B0); PG8_MMA(1, 1, At, B1); PG8_BAR; PG8_SCHED;
        }
        if (wr == 0) PG8_BAR;
        E(acc, cur, wr, wc, fr, fq);
        if (!has_next) break;
#pragma unroll
        for (int a = 0; a < 2; ++a)
#pragma unroll
            for (int b = 0; b < 2; ++b)
#pragma unroll
                for (int m = 0; m < 4; ++m)
#pragma unroll
                    for (int n = 0; n < 2; ++n) acc[a][b][m][n] = (f32x4){0.f, 0.f, 0.f, 0.f};
        cur = nxt; cA = nA; cB = nB; ++ui;
        if (wr == 1) PG8_BAR;
    }
    PG8_WAIT_V(0);
    PG8_BAR;
#undef PG8_SA
#undef PG8_SB
#undef PG8_STAGE
#undef PG8_LDA
#undef PG8_LDB
#undef PG8_MMA
#undef PG8_WAIT_V
#undef PG8_WAIT_L
#undef PG8_BAR
#undef PG8_SCHED
}
}

constexpr int T = 24576, DM = 4096, DFF = 11008;
constexpr int NCHUNK = T / 16;
constexpr int QLAT = 896, KVLAT = 512, QW = 3072, KVW = 4096, MIXW = 2048;
constexpr float EPS = 1e-6f;
__device__ __forceinline__ int pos_of(int r) { return r < 16384 ? (r & 8191) : (r & 4095); }
__device__ __forceinline__ int len_of(int r) { return r < 16384 ? 8192 : 4096; }

typedef unsigned short bf16;
#define GAS __attribute__((address_space(1)))
#define LAS __attribute__((address_space(3)))
typedef unsigned v4u __attribute__((ext_vector_type(4)));
typedef unsigned v2u __attribute__((ext_vector_type(2)));
typedef float f32x4 __attribute__((ext_vector_type(4)));
typedef float f32x2 __attribute__((ext_vector_type(2)));
typedef short bf16x8 __attribute__((ext_vector_type(8)));

__device__ __forceinline__ unsigned f2bf(float f) { unsigned u = __builtin_bit_cast(unsigned, f); return (u + 0x7fffu + ((u >> 16) & 1u)) >> 16; }
__device__ __forceinline__ unsigned pk2(float lo, float hi) { return f2bf(lo) | (f2bf(hi) << 16); }
__device__ __forceinline__ float bf2f(unsigned short b) { return __builtin_bit_cast(float, (unsigned)b << 16); }
__device__ __forceinline__ float bflo(unsigned w) { return __builtin_bit_cast(float, w << 16); }
__device__ __forceinline__ float bfhi(unsigned w) { return __builtin_bit_cast(float, w & 0xffff0000u); }
__device__ __forceinline__ float sigmoidf_fast(float x) { return __builtin_amdgcn_rcpf(1.0f + __builtin_amdgcn_exp2f(-1.4426950408889634f * x)); }
__device__ __forceinline__ float gelu_tanh(float y) { const float in = 1.5957691216057308f * (y + 0.044715f * y * y * y); return y * sigmoidf_fast(in); }

namespace pg8 {
#define EPI_ROWS const int row0 = u.pm * 256 + wr * 64 + fr
__device__ __forceinline__ float sq8(const f32x4 a, const f32x4 b) { return (a[0] * a[0] + a[1] * a[1]) + (a[2] * a[2] + a[3] * a[3]) + (b[0] * b[0] + b[1] * b[1]) + (b[2] * b[2] + b[3] * b[3]); }
__device__ __forceinline__ float red_fq(float s) { s += __shfl_xor(s, 16); s += __shfl_xor(s, 32); return s; }

__device__ __forceinline__ f32x4 rope4(const f32x4 v, const f32x4 cs) { f32x4 o; o[0] = v[0] * cs[0] - v[1] * cs[1]; o[1] = v[1] * cs[0] + v[0] * cs[1]; o[2] = v[2] * cs[2] - v[3] * cs[3]; o[3] = v[3] * cs[2] + v[2] * cs[3]; return o; }

#define LAUNDER(p) asm volatile("" : "+v"(p))
struct EpiNull { static constexpr bool PERM = true, MIDK = false;
    __device__ __forceinline__ void midk(f32x4 (&)[2][2][4][2], const Unit&, int, int) const {}
    __device__ __forceinline__ void operator()(const f32x4 (&acc)[2][2][4][2], const Unit& u, int wr, int wc, int fr, int fq) const {
#pragma unroll
        for (int ai = 0; ai < 2; ++ai)
#pragma unroll
            for (int bj = 0; bj < 2; ++bj)
                asm volatile("" :: "v"(acc[ai][bj][0][0]), "v"(acc[ai][bj][0][1]), "v"(acc[ai][bj][1][0]), "v"(acc[ai][bj][1][1]), "v"(acc[ai][bj][2][0]), "v"(acc[ai][bj][2][1]), "v"(acc[ai][bj][3][0]), "v"(acc[ai][bj][3][1]));
    } };
struct EpiWin {
    static constexpr bool PERM = true, MIDK = false;
    const float* rstd_x; bf16_t* X; bf16_t* qlat; bf16_t* kvlat; bf16_t* krope; float* stQ; float* stKV; const float* ropetab;
    __device__ __forceinline__ void midk(f32x4 (&)[2][2][4][2], const Unit&, int, int) const {}
    __device__ __forceinline__ void operator()(const f32x4 (&acc)[2][2][4][2], const Unit& u, int wr, int wc, int fr, int fq) const {
        EPI_ROWS; const int tile = u.pn;
        const GAS float* rsp = (const GAS float*)(rstd_x + row0); LAUNDER(rsp);
        if (tile < 8) {
            const int c0 = tile * 256 + wc * 32 + 8 * fq;
            GAS bf16_t* xp0 = (GAS bf16_t*)X + ((size_t)((c0 >> 4) * NCHUNK + (row0 >> 4)) * 512 + 256 + (row0 & 15) * 16 + (c0 & 15)); LAUNDER(xp0);
#pragma unroll
            for (int ai = 0; ai < 2; ++ai)
#pragma unroll
                for (int m = 0; m < 4; ++m) { const float rs = rsp[ai * 128 + m * 16];
#pragma unroll
                    for (int bj = 0; bj < 2; ++bj)
                        *(GAS u32x4*)(xp0 + ((size_t)(bj * 8) * NCHUNK + ai * 8 + m) * 512) = pack8(acc[ai][bj][m][0] * rs, acc[ai][bj][m][1] * rs); }
        } else if (tile < 14) {
            const bool isq = tile < 12; const int tl = isq ? tile - 8 : tile - 12; const int ld = isq ? QLAT : KVLAT;
            const int c0 = tl * 256 + wc * 32 + 8 * fq;
            GAS bf16_t* op = (GAS bf16_t*)(isq ? qlat : kvlat) + (size_t)row0 * ld + c0; GAS float* sp = (GAS float*)(isq ? stQ + (size_t)row0 * 16 : stKV + (size_t)row0 * 8) + tl * 4 + wc; LAUNDER(op); LAUNDER(sp);
#pragma unroll
            for (int ai = 0; ai < 2; ++ai)
#pragma unroll
                for (int m = 0; m < 4; ++m) { const float rs = rsp[ai * 128 + m * 16]; float ss = 0.f;
#pragma unroll
                    for (int bj = 0; bj < 2; ++bj) { const f32x4 v0 = acc[ai][bj][m][0] * rs, v1 = acc[ai][bj][m][1] * rs; ss += sq8(v0, v1);
                        if (c0 + bj * 128 < ld) *(GAS u32x4*)(op + (size_t)(ai * 128 + m * 16) * ld + bj * 128) = pack8(v0, v1); }
                    ss = red_fq(ss); if (fq == 0) sp[(size_t)(ai * 128 + m * 16) * (isq ? 16 : 8)] = ss; }
        } else {
            if (wc < 2) { const int c = wc * 32 + 8 * fq;
                GAS bf16_t* op = (GAS bf16_t*)krope + (size_t)row0 * 64 + c; LAUNDER(op);
#pragma unroll
                for (int ai = 0; ai < 2; ++ai)
#pragma unroll
                    for (int m = 0; m < 4; ++m) { const int row = row0 + ai * 128 + m * 16; const float rs = rsp[ai * 128 + m * 16]; const int pos = pos_of(row);
                        const f32x4 cs0 = *(const GAS f32x4*)((const GAS float*)ropetab + (size_t)pos * 64 + c), cs1 = *(const GAS f32x4*)((const GAS float*)ropetab + (size_t)pos * 64 + c + 4);
                        const f32x4 v0 = rope4(acc[ai][0][m][0] * rs, cs0), v1 = rope4(acc[ai][0][m][1] * rs, cs1);
                        *(GAS u32x4*)(op + (size_t)(ai * 128 + m * 16) * 64) = pack8(v0, v1); } }
        }
    }
};
struct EpiSsm1 {
    static constexpr bool PERM = true, MIDK = false;
    bf16_t* X;
    __device__ __forceinline__ void midk(f32x4 (&)[2][2][4][2], const Unit&, int, int) const {}
    __device__ __forceinline__ void operator()(const f32x4 (&acc)[2][2][4][2], const Unit& u, int wr, int wc, int fr, int fq) const {
        EPI_ROWS; GAS bf16_t* op = (GAS bf16_t*)X + (size_t)row0 * 512 + wc * 32 + 8 * fq; LAUNDER(op);
#pragma unroll
        for (int ai = 0; ai < 2; ++ai)
#pragma unroll
            for (int m = 0; m < 4; ++m)
#pragma unroll
                for (int bj = 0; bj < 2; ++bj) *(GAS u32x4*)(op + (size_t)(ai * 128 + m * 16) * 512 + bj * 128) = pack8(acc[ai][bj][m][0], acc[ai][bj][m][1]);
    }
};
struct EpiSsm2 {
    static constexpr bool PERM = true, MIDK = false;
    bf16_t* gact;
    __device__ __forceinline__ void midk(f32x4 (&)[2][2][4][2], const Unit&, int, int) const {}
    __device__ __forceinline__ void operator()(const f32x4 (&acc)[2][2][4][2], const Unit& u, int wr, int wc, int fr, int fq) const {
        EPI_ROWS; const int g = u.pn; const int c0 = wc * 32 + 8 * fq;
        GAS bf16_t* op = (GAS bf16_t*)gact + ((size_t)(row0 - g * NCHUNK) * 16 + (c0 >> 4)) * MIXW + g * 16 + (c0 & 15); LAUNDER(op);
#pragma unroll
        for (int ai = 0; ai < 2; ++ai)
#pragma unroll
            for (int m = 0; m < 4; ++m)
#pragma unroll
                for (int bj = 0; bj < 2; ++bj) { f32x4 v0 = acc[ai][bj][m][0], v1 = acc[ai][bj][m][1];
#pragma unroll
                    for (int e = 0; e < 4; ++e) { v0[e] = gelu_tanh(v0[e]); v1[e] = gelu_tanh(v1[e]); }
                    *(GAS u32x4*)(op + ((size_t)(ai * 128 + m * 16) * 16 + bj * 8) * MIXW) = pack8(v0, v1); }
    }
};
struct EpiQ {
    static constexpr bool PERM = true, MIDK = false;
    const float* rstd_q; bf16_t* q; const float* ropetab;
    __device__ __forceinline__ void midk(f32x4 (&)[2][2][4][2], const Unit&, int, int) const {}
    __device__ __forceinline__ void operator()(const f32x4 (&acc)[2][2][4][2], const Unit& u, int wr, int wc, int fr, int fq) const {
        EPI_ROWS; const GAS float* rsp = (const GAS float*)(rstd_q + row0); GAS bf16_t* op = (GAS bf16_t*)q + (size_t)row0 * QW + u.pn * 256 + wc * 32 + 8 * fq; LAUNDER(rsp); LAUNDER(op);
#pragma unroll
        for (int ai = 0; ai < 2; ++ai)
#pragma unroll
            for (int m = 0; m < 4; ++m) { const int row = row0 + ai * 128 + m * 16; const float rs = rsp[ai * 128 + m * 16]; const int pos = pos_of(row);
#pragma unroll
                for (int bj = 0; bj < 2; ++bj) { const int strip = 8 * u.pn + 4 * bj + wc, s6 = strip % 6;
                    f32x4 v0 = acc[ai][bj][m][0] * rs, v1 = acc[ai][bj][m][1] * rs;
                    if (s6 >= 4) { const int pc = (s6 - 4) * 32 + 8 * fq;
                        const f32x4 cs0 = *(const GAS f32x4*)((const GAS float*)ropetab + (size_t)pos * 64 + pc), cs1 = *(const GAS f32x4*)((const GAS float*)ropetab + (size_t)pos * 64 + pc + 4);
                        v0 = rope4(v0, cs0); v1 = rope4(v1, cs1); }
                    *(GAS u32x4*)(op + (size_t)(ai * 128 + m * 16) * QW + bj * 128) = pack8(v0, v1); } }
    }
};
struct EpiKV {
    static constexpr bool PERM = true, MIDK = false;
    const float* rstd_kv; bf16_t* kv;
    __device__ __forceinline__ void midk(f32x4 (&)[2][2][4][2], const Unit&, int, int) const {}
    __device__ __forceinline__ void operator()(const f32x4 (&acc)[2][2][4][2], const Unit& u, int wr, int wc, int fr, int fq) const {
        EPI_ROWS; const GAS float* rsp = (const GAS float*)(rstd_kv + row0); GAS bf16_t* op = (GAS bf16_t*)kv + (size_t)row0 * KVW + u.pn * 256 + wc * 32 + 8 * fq; LAUNDER(rsp); LAUNDER(op);
#pragma unroll
        for (int ai = 0; ai < 2; ++ai)
#pragma unroll
            for (int m = 0; m < 4; ++m) { const float rs = rsp[ai * 128 + m * 16];
#pragma unroll
                for (int bj = 0; bj < 2; ++bj) *(GAS u32x4*)(op + (size_t)(ai * 128 + m * 16) * KVW + bj * 128) = pack8(acc[ai][bj][m][0] * rs, acc[ai][bj][m][1] * rs); }
    }
};
struct EpiGlu {
    static constexpr bool PERM = true, MIDK = false;
    const bf16_t* gact; bf16_t* merged; float* stA;
    __device__ __forceinline__ void midk(f32x4 (&)[2][2][4][2], const Unit&, int, int) const {}
    __device__ __forceinline__ void operator()(const f32x4 (&acc)[2][2][4][2], const Unit& u, int wr, int wc, int fr, int fq) const {
        EPI_ROWS; const int c0 = u.pn * 256 + wc * 32 + 8 * fq;
        const GAS bf16_t* gp = (const GAS bf16_t*)gact + (size_t)row0 * MIXW + c0; GAS bf16_t* op = (GAS bf16_t*)merged + (size_t)row0 * DM + c0; GAS float* sp = (GAS float*)stA + (size_t)row0 * 32 + u.pn * 4 + wc; LAUNDER(gp); LAUNDER(op); LAUNDER(sp);
#pragma unroll
        for (int ai = 0; ai < 2; ++ai)
#pragma unroll
            for (int m = 0; m < 4; ++m) { float ss = 0.f;
#pragma unroll
                for (int bj = 0; bj < 2; ++bj) {
                    const u32x4 gw = *(const GAS u32x4*)(gp + (size_t)(ai * 128 + m * 16) * MIXW + bj * 128);
                    f32x4 v0, v1; const f32x4 a0 = acc[ai][bj][m][0], a1 = acc[ai][bj][m][1];
                    v0[0] = bflo(gw.x) * sigmoidf_fast(a0[0]); v0[1] = bfhi(gw.x) * sigmoidf_fast(a0[1]); v0[2] = bflo(gw.y) * sigmoidf_fast(a0[2]); v0[3] = bfhi(gw.y) * sigmoidf_fast(a0[3]);
                    v1[0] = bflo(gw.z) * sigmoidf_fast(a1[0]); v1[1] = bfhi(gw.z) * sigmoidf_fast(a1[1]); v1[2] = bflo(gw.w) * sigmoidf_fast(a1[2]); v1[3] = bfhi(gw.w) * sigmoidf_fast(a1[3]);
                    ss += sq8(v0, v1);
                    *(GAS u32x4*)(op + (size_t)(ai * 128 + m * 16) * DM + bj * 128) = pack8(v0, v1); }
                ss = red_fq(ss); if (fq == 0) sp[(size_t)(ai * 128 + m * 16) * 32] = ss; }
    }
};
struct EpiWout {
    static constexpr bool PERM = true, MIDK = true;
    const float* xp; const float* xs; const float* r2; const float* ratio; float* xres; bf16_t* x1b; float* stA;
    __device__ __forceinline__ void midk(f32x4 (&acc)[2][2][4][2], const Unit& u, int wr, int fr) const {
        EPI_ROWS; const GAS float* rp = (const GAS float*)(ratio + row0); LAUNDER(rp);
#pragma unroll
        for (int ai = 0; ai < 2; ++ai)
#pragma unroll
            for (int m = 0; m < 4; ++m) { const float rt = rp[ai * 128 + m * 16];
#pragma unroll
                for (int bj = 0; bj < 2; ++bj)
#pragma unroll
                    for (int n = 0; n < 2; ++n) acc[ai][bj][m][n] *= rt; }
    }
    __device__ __forceinline__ void operator()(const f32x4 (&acc)[2][2][4][2], const Unit& u, int wr, int wc, int fr, int fq) const {
        EPI_ROWS; const int c0 = u.pn * 256 + wc * 32 + 8 * fq; const int rowt = u.pm * 256;
        const GAS float* xin = (const GAS float*)(rowt < 16384 ? xp + (size_t)row0 * DM : xs + (size_t)(row0 - 16384) * DM) + c0;
        const GAS float* rsp = (const GAS float*)(r2 + row0); GAS float* xo = (GAS float*)xres + (size_t)row0 * DM + c0; GAS bf16_t* bo = (GAS bf16_t*)x1b + (size_t)row0 * DM + c0; GAS float* sp = (GAS float*)stA + (size_t)row0 * 64 + u.pn * 4 + wc;
        LAUNDER(xin); LAUNDER(rsp); LAUNDER(xo); LAUNDER(bo); LAUNDER(sp);
#pragma unroll
        for (int ai = 0; ai < 2; ++ai)
#pragma unroll
            for (int m = 0; m < 4; ++m) { const float rs = rsp[ai * 128 + m * 16]; float ss = 0.f; const size_t ro = (size_t)(ai * 128 + m * 16) * DM;
#pragma unroll
                for (int bj = 0; bj < 2; ++bj) {
                    const f32x4 v0 = *(const GAS f32x4*)(xin + ro + bj * 128) + acc[ai][bj][m][0] * rs, v1 = *(const GAS f32x4*)(xin + ro + bj * 128 + 4) + acc[ai][bj][m][1] * rs;
                    ss += sq8(v0, v1);
                    *(GAS f32x4*)(xo + ro + bj * 128) = v0; *(GAS f32x4*)(xo + ro + bj * 128 + 4) = v1;
                    *(GAS u32x4*)(bo + ro + bj * 128) = pack8(v0, v1); }
                ss = red_fq(ss); if (fq == 0) sp[(size_t)(ai * 128 + m * 16) * 64] = ss; }
    }
};
__device__ __forceinline__ float dpp_ror1(float v) { return __builtin_bit_cast(float, __builtin_amdgcn_update_dpp(0, __builtin_bit_cast(int, v), 0x121, 0xf, 0xf, false)); }
__device__ __forceinline__ float dpp_rol1(float v) { return __builtin_bit_cast(float, __builtin_amdgcn_update_dpp(0, __builtin_bit_cast(int, v), 0x12f, 0xf, 0xf, false)); }
struct EpiFfnA {
    static constexpr bool PERM = true, MIDK = false;
    const float* rstd; int row_base; bf16_t* act; bf16_t* halo_up; bf16_t* halo_gate; const float* cw; const float* cb;
    __device__ __forceinline__ void midk(f32x4 (&)[2][2][4][2], const Unit&, int, int) const {}
    __device__ __forceinline__ void operator()(const f32x4 (&acc)[2][2][4][2], const Unit& u, int wr, int wc, int fr, int fq) const {
        EPI_ROWS; const int f0 = u.pn * 128 + wc * 32 + 8 * fq;
        const GAS float* rsp = (const GAS float*)(rstd + row_base + row0); GAS bf16_t* actp = (GAS bf16_t*)act + (size_t)row0 * DFF + f0;
        const int strip0 = u.pm * 4 + wr;
        GAS bf16_t* hup_p = (GAS bf16_t*)halo_up + (size_t)strip0 * 4 * DFF + f0; GAS bf16_t* hg_p = (GAS bf16_t*)halo_gate + (size_t)strip0 * 2 * DFF + f0;
        const GAS float* cwp = (const GAS float*)(cw + f0); const GAS float* cbp = (const GAS float*)(cb + f0);
        asm volatile("" : "+v"(rsp), "+v"(actp), "+v"(hup_p), "+v"(hg_p), "+v"(cwp), "+v"(cbp));
#pragma unroll
        for (int ai = 0; ai < 2; ++ai) {
            float rs[4];
#pragma unroll
            for (int m = 0; m < 4; ++m) rs[m] = rsp[ai * 128 + m * 16];
#pragma unroll
            for (int n = 0; n < 2; ++n) {
                const f32x4 w0 = *(const GAS f32x4*)(cwp + 4 * n), w1 = *(const GAS f32x4*)(cwp + DFF + 4 * n), w2 = *(const GAS f32x4*)(cwp + 2 * DFF + 4 * n), wb = *(const GAS f32x4*)(cbp + 4 * n);
                f32x4 res[4], Uu[4];
#pragma unroll
                for (int e = 0; e < 4; ++e) {
                    float U[4], R[4], L[4];
#pragma unroll
                    for (int m = 0; m < 4; ++m) { U[m] = acc[ai][0][m][n][e] * rs[m]; R[m] = dpp_ror1(U[m]); L[m] = dpp_rol1(U[m]); Uu[m][e] = U[m]; }
#pragma unroll
                    for (int m = 0; m < 4; ++m) {
                        const float prev = (fr == 0) ? R[m > 0 ? m - 1 : 0] : R[m];
                        const float next = (fr == 15) ? L[m < 3 ? m + 1 : 3] : L[m];
                        const float cv = w0[e] * prev + w1[e] * U[m] + w2[e] * next + wb[e];
                        res[m][e] = cv * sigmoidf_fast(cv) * (acc[ai][1][m][n][e] * rs[m]);
                    }
                }
#pragma unroll
                for (int m = 0; m < 4; ++m) {
                    const bool edge = (m == 0 && fr == 0) || (m == 3 && fr == 15);
                    if (!edge) { u32x2 w; w.x = cvt_pk_bf16(res[m][0], res[m][1]); w.y = cvt_pk_bf16(res[m][2], res[m][3]); *(GAS u32x2*)(actp + (size_t)(ai * 128 + m * 16) * DFF + 4 * n) = w; }
                    if (m == 0 || m == 3) {
                        const int hs = (m == 0) ? (fr == 0 ? 0 : (fr == 1 ? 1 : -1)) : (fr == 14 ? 2 : (fr == 15 ? 3 : -1));
                        if (hs >= 0) { u32x2 w; w.x = cvt_pk_bf16(Uu[m][0], Uu[m][1]); w.y = cvt_pk_bf16(Uu[m][2], Uu[m][3]);
                            *(GAS u32x2*)(hup_p + ((size_t)(ai * 2) * 4 + hs) * DFF + 4 * n) = w;
                            if (hs == 0 || hs == 3) { const f32x4 gv = acc[ai][1][m][n] * rs[m]; u32x2 wg; wg.x = cvt_pk_bf16(gv[0], gv[1]); wg.y = cvt_pk_bf16(gv[2], gv[3]);
                                *(GAS u32x2*)(hg_p + ((size_t)(ai * 2) * 2 + (hs == 3 ? 1 : 0)) * DFF + 4 * n) = wg; } }
                    }
                }
            }
        }
    }
};
struct EpiDown {
    static constexpr bool PERM = true, MIDK = false;
    float* xres; int row_base; float* stA;
    __device__ __forceinline__ void midk(f32x4 (&)[2][2][4][2], const Unit&, int, int) const {}
    __device__ __forceinline__ void operator()(const f32x4 (&acc)[2][2][4][2], const Unit& u, int wr, int wc, int fr, int fq) const {
        EPI_ROWS; GAS float* xo = (GAS float*)xres + (size_t)(row_base + row0) * DM + u.pn * 256 + wc * 32 + 8 * fq; GAS float* sp = (GAS float*)stA + (size_t)(row_base + row0) * 64 + u.pn * 4 + wc; LAUNDER(xo); LAUNDER(sp);
#pragma unroll
        for (int ai = 0; ai < 2; ++ai)
#pragma unroll
            for (int m = 0; m < 4; ++m) { float ss = 0.f; const size_t ro = (size_t)(ai * 128 + m * 16) * DM;
#pragma unroll
                for (int bj = 0; bj < 2; ++bj) { GAS float* p = xo + ro + bj * 128;
                    const f32x4 v0 = *(const f32x4*)p + acc[ai][bj][m][0], v1 = *(const GAS f32x4*)(p + 4) + acc[ai][bj][m][1];
                    ss += sq8(v0, v1); *(f32x4*)p = v0; *(GAS f32x4*)(p + 4) = v1; }
                ss = red_fq(ss); if (fq == 0) sp[(size_t)(ai * 128 + m * 16) * 64] = ss; }
    }
};
#undef EPI_ROWS
}

namespace attn {
using s16x4  = __attribute__((ext_vector_type(4))) short;
using f32x16 = __attribute__((ext_vector_type(16))) float;
using u32x4  = __attribute__((ext_vector_type(4))) unsigned;
constexpr int NW = 8, QBLK = 32, KVBLK = 64;
constexpr float SCALE = 0.07216878364870322f;
constexpr float THR = 8.f;
constexpr int LDQ = 3072, LDK = 4096, LDR = 64, LDO = 4096;
constexpr int SHM_V = KVBLK * 128 * 2, SHM_K = KVBLK * 128 * 2, SHM_R = KVBLK * 64 * 2;
constexpr int OFF_V = 0, OFF_K = 2 * SHM_V, OFF_R = OFF_K + 2 * SHM_K, OFF_WS = OFF_R + 2 * SHM_R, SHM_ATTN = OFF_WS + NW * 64 * 4;
#define KSWZ(row, colB) ((row) * 256 + ((colB) ^ (((row) & 7) << 4)))
#define RSWZ(row, ch) ((row) * 128 + ((((ch) ^ (((row) >> 1) & 7))) << 4))
#define SBAR() __builtin_amdgcn_sched_barrier(0)
__device__ __forceinline__ int crow(int r, int hi) { return (r & 3) + 8 * (r >> 2) + 4 * hi; }
__device__ __forceinline__ unsigned cvtpk(float lo, float hi) { unsigned r; asm volatile("v_cvt_pk_bf16_f32 %0, %1, %2" : "=v"(r) : "v"(lo), "v"(hi)); return r; }

__device__ __forceinline__ void partialSM(f32x16& p0, f32x16& p1, float& m_reg, float& mn, float& alpha) {
  constexpr float C = SCALE * 1.4426950408889634f;
  float pmax = p0[0];
#pragma unroll
  for (int r = 1; r < 16; ++r) pmax = fmaxf(pmax, p0[r]);
#pragma unroll
  for (int r = 0; r < 16; ++r) pmax = fmaxf(pmax, p1[r]);
  { auto rr = __builtin_amdgcn_permlane32_swap(__float_as_uint(pmax), __float_as_uint(pmax), false, false);
    pmax = fmaxf(__uint_as_float(rr[0]), __uint_as_float(rr[1])); }
  if (__builtin_expect(__all(pmax - m_reg <= THR / SCALE), 1)) { mn = m_reg; alpha = 1.f; }
  else { mn = fmaxf(m_reg, pmax); alpha = __builtin_amdgcn_exp2f((m_reg - mn) * C); m_reg = mn; }
  float mnC = -mn * C;
#pragma unroll
  for (int r = 0; r < 16; ++r) p0[r] = fmaf(p0[r], C, mnC);
#pragma unroll
  for (int r = 0; r < 16; ++r) p1[r] = fmaf(p1[r], C, mnC);
#pragma unroll
  for (int r = 0; r < 16; ++r) p0[r] = __builtin_amdgcn_exp2f(p0[r]);
}
__device__ __forceinline__ void finishSM(f32x16& p0, f32x16& p1, float alpha, float& l_reg, bf16x8& pa0, bf16x8& pa1, bf16x8& pa2, bf16x8& pa3) {
#pragma unroll
  for (int r = 0; r < 16; ++r) p1[r] = __builtin_amdgcn_exp2f(p1[r]);
  float ps = 0;
#pragma unroll
  for (int r = 0; r < 16; ++r) ps += p0[r];
#pragma unroll
  for (int r = 0; r < 16; ++r) ps += p1[r];
  { auto rr = __builtin_amdgcn_permlane32_swap(__float_as_uint(ps), __float_as_uint(ps), false, false);
    ps = __uint_as_float(rr[0]) + __uint_as_float(rr[1]); }
  l_reg = l_reg * alpha + ps;
#define PK4(P, BASE, OUT) do { unsigned a0 = cvtpk(P[BASE + 0], P[BASE + 1]), a1 = cvtpk(P[BASE + 2], P[BASE + 3]);   \
    unsigned b0 = cvtpk(P[BASE + 4], P[BASE + 5]), b1 = cvtpk(P[BASE + 6], P[BASE + 7]);                              \
    auto r0 = __builtin_amdgcn_permlane32_swap(a0, b0, false, false); auto r1 = __builtin_amdgcn_permlane32_swap(a1, b1, false, false); \
    u32x4 w = {r0[0], r1[0], r0[1], r1[1]}; OUT = *reinterpret_cast<bf16x8*>(&w); } while (0)
  PK4(p0, 0, pa0); PK4(p0, 8, pa1); PK4(p1, 0, pa2); PK4(p1, 8, pa3);
#undef PK4
}
__device__ __forceinline__ void qkt(f32x16& p0, f32x16& p1, const char* Ks, const char* Rs, const bf16x8* qr, int r32, int hi) {
  p0 = f32x16{}; p1 = f32x16{};
#pragma unroll
  for (int g4 = 0; g4 < 2; ++g4) {
#pragma unroll
    for (int dd = 0; dd < 4; ++dd) { const int d0 = g4 * 4 + dd; const int cb = (d0 * 16 + hi * 8) * 2;
      bf16x8 b0 = *reinterpret_cast<const bf16x8*>(Ks + KSWZ(r32, cb));
      bf16x8 b1 = *reinterpret_cast<const bf16x8*>(Ks + KSWZ(32 + r32, cb));
      p0 = __builtin_amdgcn_mfma_f32_32x32x16_bf16(b0, qr[d0], p0, 0, 0, 0);
      p1 = __builtin_amdgcn_mfma_f32_32x32x16_bf16(b1, qr[d0], p1, 0, 0, 0); }
    SBAR();
  }
#pragma unroll
  for (int d0 = 0; d0 < 4; ++d0) { const int ch = d0 * 2 + hi;
    bf16x8 b0 = *reinterpret_cast<const bf16x8*>(Rs + RSWZ(r32, ch));
    bf16x8 b1 = *reinterpret_cast<const bf16x8*>(Rs + RSWZ(32 + r32, ch));
    p0 = __builtin_amdgcn_mfma_f32_32x32x16_bf16(b0, qr[8 + d0], p0, 0, 0, 0);
    p1 = __builtin_amdgcn_mfma_f32_32x32x16_bf16(b1, qr[8 + d0], p1, 0, 0, 0); }
}
__device__ __forceinline__ int v_st(int k, int c) { const int kk = (k & ~0xC) | ((k & 4) << 1) | ((k & 8) >> 1); return ((kk >> 3) * 4 + (c >> 5)) * 512 + ((kk & 7) * 32 + (c & 31)) * 2; }
__device__ __forceinline__ int v_rd_base(int lane) { return ((lane & 3) << 3) | (((lane >> 2) & 3) << 6) | (((lane >> 4) & 1) << 5) | (((lane >> 5) & 1) << 8); }
constexpr int v_rd_off(int d0, int ks, int half) { return d0 * 512 + ks * 4096 + half * 2048; }
template <int OFF> __device__ __forceinline__ s16x4 tr_read(int vb) {
  s16x4 r; asm volatile("ds_read_b64_tr_b16 %0, %1 offset:%2" : "=&v"(r) : "v"(vb), "i"(OFF) : "memory"); return r;
}
template <int D0> __device__ __forceinline__ void pv_one(f32x16& od, int vb, bf16x8 pa0, bf16x8 pa1, bf16x8 pa2, bf16x8 pa3) {
  const s16x4 l0 = tr_read<v_rd_off(D0, 0, 0)>(vb), h0 = tr_read<v_rd_off(D0, 0, 1)>(vb), l1 = tr_read<v_rd_off(D0, 1, 0)>(vb), h1 = tr_read<v_rd_off(D0, 1, 1)>(vb);
  const s16x4 l2 = tr_read<v_rd_off(D0, 2, 0)>(vb), h2 = tr_read<v_rd_off(D0, 2, 1)>(vb), l3 = tr_read<v_rd_off(D0, 3, 0)>(vb), h3 = tr_read<v_rd_off(D0, 3, 1)>(vb);
  asm volatile("s_waitcnt lgkmcnt(0)" ::: "memory"); SBAR();
#define PK(L, H) (bf16x8){L[0], L[1], L[2], L[3], H[0], H[1], H[2], H[3]}
  od = __builtin_amdgcn_mfma_f32_32x32x16_bf16(pa0, PK(l0, h0), od, 0, 0, 0);
  od = __builtin_amdgcn_mfma_f32_32x32x16_bf16(pa1, PK(l1, h1), od, 0, 0, 0);
  od = __builtin_amdgcn_mfma_f32_32x32x16_bf16(pa2, PK(l2, h2), od, 0, 0, 0);
  od = __builtin_amdgcn_mfma_f32_32x32x16_bf16(pa3, PK(l3, h3), od, 0, 0, 0);
#undef PK
}
__device__ __forceinline__ void pv_d0(f32x16* o, int vb, bf16x8 pa0, bf16x8 pa1, bf16x8 pa2, bf16x8 pa3) {
  pv_one<0>(o[0], vb, pa0, pa1, pa2, pa3); pv_one<1>(o[1], vb, pa0, pa1, pa2, pa3); pv_one<2>(o[2], vb, pa0, pa1, pa2, pa3); pv_one<3>(o[3], vb, pa0, pa1, pa2, pa3);
}

__device__ __forceinline__ void attn_unit(const bf16* __restrict__ Qb, const bf16* __restrict__ Kh, const bf16* __restrict__ Vh, const bf16* __restrict__ Rh,
                                          bf16* __restrict__ Ob, float* __restrict__ st, int seq, char* lds) {
  int tid_l = threadIdx.x; asm volatile("" : "+v"(tid_l));
  const int tid = tid_l, wid = tid >> 6, lane = tid & 63, r32 = lane & 31, hi = lane >> 5;
  char* V_lds = lds + OFF_V; char* K_lds = lds + OFF_K; char* R_lds = lds + OFF_R;
  float* ws = (float*)(lds + OFF_WS) + wid * 64; float* li_l = ws; float* al_l = ws + 32;
  float m_reg = -1e30f, l_reg = 0; f32x16 o[4] = {}; bf16x8 qr[12];
  const bf16* Qw = Qb + (long)(wid * QBLK + r32) * LDQ + hi * 8;
#pragma unroll
  for (int d0 = 0; d0 < 12; ++d0) qr[d0] = *reinterpret_cast<const bf16x8*>(Qw + d0 * 16);
  const int sr = tid >> 4, sc = (tid & 15) * 8, vst0 = v_st(sr, sc), vst1 = v_st(32 + sr, sc);
  const int rr_ = tid >> 3, rch = tid & 7, rst = RSWZ(rr_, rch);
  const int vb0 = (int)(uintptr_t)V_lds + v_rd_base(lane);
  struct { bf16x8 vs0, vs1, ks0, ks1, rs0; } sr_[1];
#define SLOAD(i, k0) do { sr_[i].vs0 = *reinterpret_cast<const bf16x8*>(&Vh[(long)((k0) + sr) * LDK + sc]); sr_[i].vs1 = *reinterpret_cast<const bf16x8*>(&Vh[(long)((k0) + 32 + sr) * LDK + sc]); \
    sr_[i].ks0 = *reinterpret_cast<const bf16x8*>(&Kh[(long)((k0) + sr) * LDK + sc]); sr_[i].ks1 = *reinterpret_cast<const bf16x8*>(&Kh[(long)((k0) + 32 + sr) * LDK + sc]); \
    sr_[i].rs0 = *reinterpret_cast<const bf16x8*>(&Rh[(long)((k0) + rr_) * LDR + rch * 8]); } while (0)
#define SWRITE(b, i) do { *(bf16x8*)(V_lds + (b) * SHM_V + vst0) = sr_[i].vs0;          \
    *(bf16x8*)(V_lds + (b) * SHM_V + vst1) = sr_[i].vs1; int kc = sc * 2;               \
    *(bf16x8*)(K_lds + (b) * SHM_K + KSWZ(sr, kc)) = sr_[i].ks0;                       \
    *(bf16x8*)(K_lds + (b) * SHM_K + KSWZ(32 + sr, kc)) = sr_[i].ks1;                  \
    *(bf16x8*)(R_lds + (b) * SHM_R + rst) = sr_[i].rs0; } while (0)
#define SWAIT() asm volatile("s_waitcnt vmcnt(0)" ::: "memory")
#define RESC(a) do { if (__any((a) < 1.f)) { if (hi == 0) al_l[r32] = (a); asm volatile("s_waitcnt lgkmcnt(0)" ::: "memory"); \
    _Pragma("unroll") for (int d = 0; d < 4; ++d) _Pragma("unroll") for (int r = 0; r < 16; ++r) o[d][r] *= al_l[crow(r, hi)]; } } while (0)
  f32x16 p0, p1; float mn, al; bf16x8 pa0, pa1, pa2, pa3; const int NT = seq / KVBLK;
  SLOAD(0, 0); asm volatile("s_waitcnt vmcnt(0)" ::: "memory"); SWRITE(0, 0); __syncthreads();
#pragma unroll 1
  for (int j = 0; j < NT; ++j) {
    const int b = j & 1;
    if (j + 1 < NT) SLOAD(0, (j + 1) * KVBLK);
    SBAR(); qkt(p0, p1, K_lds + b * SHM_K, R_lds + b * SHM_R, qr, r32, hi);
    partialSM(p0, p1, m_reg, mn, al);
    RESC(al);
    finishSM(p0, p1, al, l_reg, pa0, pa1, pa2, pa3); SBAR();
    pv_d0(o, vb0 + b * SHM_V, pa0, pa1, pa2, pa3);
    if (j + 1 < NT) { SWRITE(b ^ 1, 0); }
    __syncthreads();
  }
  if (hi == 0) li_l[r32] = l_reg; asm volatile("s_waitcnt lgkmcnt(0)" ::: "memory");
  GAS bf16* Ow = (GAS bf16*)Ob + (long)(wid * QBLK + 4 * hi) * LDO + r32; GAS float* stw = (GAS float*)st + (long)(wid * QBLK + 4 * hi) * 16;
  asm volatile("" : "+v"(Ow), "+v"(stw));
#pragma unroll
  for (int r = 0; r < 16; ++r) { const int ro = (r & 3) + 8 * (r >> 2); const float rl = __builtin_amdgcn_rcpf(li_l[ro + 4 * hi]); float ss = 0.f;
#pragma unroll
    for (int d0 = 0; d0 < 4; ++d0) { const float v = o[d0][r] * rl; ss += v * v; Ow[(long)ro * LDO + d0 * 32] = (bf16)f2bf(v); }
    ss += __shfl_xor(ss, 1); ss += __shfl_xor(ss, 2); ss += __shfl_xor(ss, 4); ss += __shfl_xor(ss, 8); ss += __shfl_xor(ss, 16);
    if (r32 == 0) stw[ro * 16] = ss; }
#undef SLOAD
#undef SWRITE
#undef SWAIT
#undef RESC
}
#undef KSWZ
#undef RSWZ
#undef SBAR
}

constexpr size_t MiB = 1u << 20;
constexpr size_t WS_CTL = 0, CTL_ZERO_BYTES = 1 * MiB;
constexpr size_t WS_RSTDX = 1 * MiB, WS_RSTDQ = WS_RSTDX + 98304, WS_RSTDKV = WS_RSTDQ + 98304, WS_R2 = WS_RSTDKV + 98304, WS_RATIO = WS_R2 + 98304, WS_RSTDX1 = WS_RATIO + 98304;
constexpr size_t WS_STA = 2 * MiB;
constexpr size_t WS_STB = 8 * MiB;
constexpr size_t WS_STQ = 10 * MiB;
constexpr size_t WS_STKV = 12 * MiB;
constexpr size_t WS_ROPE = 13 * MiB;
constexpr size_t WS_WIN = 16 * MiB;
constexpr size_t WS_WGLU = 46 * MiB;
constexpr size_t WS_WQ = 54 * MiB;
constexpr size_t WS_WKV = 60 * MiB;
constexpr size_t WS_WOUT = 64 * MiB;
constexpr size_t WS_WUG = 96 * MiB;
constexpr size_t WS_WDN = 268 * MiB;
constexpr size_t WS_W1T = 354 * MiB;
constexpr size_t WS_W2T = 370 * MiB;
constexpr size_t WS_A = 402 * MiB;
constexpr size_t WS_B = 594 * MiB;
constexpr size_t WS_QLAT = 786 * MiB, WS_KVLAT = 828 * MiB, WS_KROPE = 852 * MiB;
constexpr size_t WS_GACT = 856 * MiB;
constexpr size_t WS_HUP = 952 * MiB, WS_HGATE = 964 * MiB, WS_END = 970 * MiB;
static_assert(WS_HUP + (size_t)128 * 4 * DFF * 2 <= WS_HGATE && WS_HGATE + (size_t)128 * 2 * DFF * 2 <= WS_END, "halo");
constexpr size_t OUT_X = 0, OUT_KV = 192 * MiB;
constexpr int CW_BAR = 4096;

constexpr int NWAVES = 8;
constexpr int RING_BYTES = 131072, LDSCTL_OFF = RING_BYTES, MISC_OFF = LDSCTL_OFF + 320, LDS_BYTES = 147456;

typedef GAS unsigned gu32;
#define RLX_AGENT __ATOMIC_RELAXED, __HIP_MEMORY_SCOPE_AGENT
#define LDS_WAIT() asm volatile("s_waitcnt lgkmcnt(0)" ::: "memory")

#define XB_TMO      128
#define XB_XCNT(j)  (256  + 64 * (j))
#define XB_XSUB(j)  (1280 + 64 * (j))
#define XB_XGEN(j)  (2304 + 64 * (j))
#define XB_TOP      3328
#define XB_TOPGEN   3392
#define XCD_BAR_WORDS 3456
#define XB_SPIN_CAP (1u << 18)
__device__ __forceinline__ unsigned xb_ld(unsigned* p)              { return __hip_atomic_load(p, __ATOMIC_RELAXED, __HIP_MEMORY_SCOPE_AGENT); }
__device__ __forceinline__ unsigned xb_add(unsigned* p, unsigned v) { return __hip_atomic_fetch_add(p, v, __ATOMIC_RELAXED, __HIP_MEMORY_SCOPE_AGENT); }
__device__ __forceinline__ unsigned xb_xcc_id() { return (unsigned)__builtin_amdgcn_s_getreg((3 << 11) | 20) & 0xFu; }
#define XB_SPIN(cond, bar) do { unsigned _sp = 0; while (cond) { __builtin_amdgcn_s_sleep(1); \
    if ((++_sp & 255u) == 0u) { if (xb_ld(&(bar)[XB_TMO])) break; if (_sp > XB_SPIN_CAP) { atomicAdd(&(bar)[XB_TMO], 1u); break; } } } } while (0)
struct XcdBarrier { unsigned* bar; unsigned x; volatile LAS unsigned* st; };
__device__ __forceinline__ XcdBarrier xcd_barrier_post(unsigned* bar, volatile LAS unsigned* st) {
    XcdBarrier b; b.bar = bar; b.x = xb_xcc_id(); b.st = st;
    if (threadIdx.x == 0) (void)xb_add(&bar[XB_XCNT(b.x)], 1u);
    return b;
}
__device__ __forceinline__ void xcd_barrier_complete(unsigned* bar, unsigned x, unsigned& nloc, unsigned& nx) {
    const unsigned G = gridDim.x * gridDim.y * gridDim.z;
    unsigned sum, cnt, mine, sp = 0u;
    for (;;) {
        sum = 0u; cnt = 0u; mine = 0u;
#pragma unroll
        for (unsigned j = 0; j < 16; ++j) { const unsigned c = xb_ld(&bar[XB_XCNT(j)]); sum += c; cnt += (c > 0u) ? 1u : 0u; mine = (j == x) ? c : mine; }
        if (sum == G) break;
        __builtin_amdgcn_s_sleep(1);
        if ((++sp & 255u) == 0u) { if (xb_ld(&bar[XB_TMO])) break; if (sp > XB_SPIN_CAP) { atomicAdd(&bar[XB_TMO], 1u); break; } }
    }
    nloc = mine > 0u ? mine : 1u; nx = cnt > 0u ? cnt : 1u;
}
__device__ __forceinline__ void xcd_barrier(const XcdBarrier& b) {
    asm volatile("s_waitcnt vmcnt(0)" ::: "memory");
    __syncthreads();
    if (threadIdx.x == 0) {
        unsigned* bar = b.bar;
        __builtin_amdgcn_s_waitcnt(0);
        unsigned nloc = b.st[0], nx = b.st[1];
        if (nloc == 0u) { xcd_barrier_complete(bar, b.x, nloc, nx); b.st[0] = nloc; b.st[1] = nx; }
        const unsigned old = xb_add(&bar[XB_XSUB(b.x)], 1u);
        const unsigned gen = old / nloc;
        if (old + 1u == (gen + 1u) * nloc) {
            __builtin_amdgcn_fence(__ATOMIC_RELEASE, "agent");
            asm volatile("s_waitcnt vmcnt(0)" ::: "memory");
            const unsigned og = xb_add(&bar[XB_TOP], 1u);
            const unsigned tg = og / nx;
            if (og + 1u == (tg + 1u) * nx) xb_add(&bar[XB_TOPGEN], 1u);
            else XB_SPIN(xb_ld(&bar[XB_TOPGEN]) == tg, bar);
            __builtin_amdgcn_fence(__ATOMIC_ACQUIRE, "agent");
            xb_add(&bar[XB_XGEN(b.x)], 1u);
            asm volatile("s_waitcnt vmcnt(0)" ::: "memory");
        } else {
            XB_SPIN(xb_ld(&bar[XB_XGEN(b.x)]) == gen, bar);
            __builtin_amdgcn_fence(__ATOMIC_ACQUIRE, "agent");
            asm volatile("s_waitcnt vmcnt(0)" ::: "memory");
        }
    }
    __syncthreads();
}

__device__ __forceinline__ float wave_sum(float v) {
#pragma unroll
    for (int o = 1; o < 64; o <<= 1) v += __shfl_xor(v, o);
    return v;
}
template <class RowMap>
__device__ __forceinline__ void transpose_item(const float* W, int K, int N, bf16* WT, const float* g1, const float* g2, int ksplit, RowMap rm, LAS float* scr, int item, int lane) {
    const int nblk = N / 32, kb = item / nblk, nb = item % nblk, k0 = 64 * kb, n0 = 32 * nb;
    float wv[32];
    const GAS float* wp = (const GAS float*)W + (size_t)(k0 + (lane >> 5)) * N + n0 + (lane & 31);
#pragma unroll
    for (int i = 0; i < 32; ++i) wv[i] = wp[(size_t)(2 * i) * N];
#pragma unroll
    for (int i = 0; i < 32; ++i) { const int kk = 2 * i + (lane >> 5), k = k0 + kk; const float gn = g1 ? (k < ksplit ? g1[k] : g2[k - ksplit]) : 1.0f;
        scr[kk * 33 + (lane & 31)] = wv[i] * gn; }
    LDS_WAIT(); asm volatile("" ::: "memory");
    const int c = lane & 7;
#pragma unroll
    for (int j = 0; j < 4; ++j) { const int n = (lane >> 3) + 8 * j; const LAS float* s = scr + (8 * c) * 33 + n;
        v4u o; o.x = pg8::cvt_pk_bf16(s[0 * 33], s[1 * 33]); o.y = pg8::cvt_pk_bf16(s[2 * 33], s[3 * 33]); o.z = pg8::cvt_pk_bf16(s[4 * 33], s[5 * 33]); o.w = pg8::cvt_pk_bf16(s[6 * 33], s[7 * 33]);
        *(GAS v4u*)(WT + (size_t)rm(n0 + n) * K + k0 + 8 * c) = o; }
    LDS_WAIT(); asm volatile("" ::: "memory");
}
struct RmId  { __device__ __forceinline__ int operator()(int n) const { return n; } };
struct RmWin { __device__ __forceinline__ int operator()(int n) const { if (n < 2944) return n; if (n < 3456) return n + 128; const int i = n - 3456; return 3584 + (i < 32 ? 2 * i : 2 * (i - 32) + 1); } };
struct RmQ   { __device__ __forceinline__ int operator()(int n) const { const int r = n % 192, hb = n - r; if (r < 128) return n; const int i = r - 128; return hb + 128 + (i < 32 ? 2 * i : 2 * (i - 32) + 1); } };
struct RmUp  { __device__ __forceinline__ int operator()(int n) const { return (n >> 7) * 256 + (n & 127); } };
struct RmGate{ __device__ __forceinline__ int operator()(int n) const { return (n >> 7) * 256 + 128 + (n & 127); } };

__device__ __forceinline__ void sincos_d(double a, double& s, double& c) {
    const double kd = __builtin_rint(a * 0.63661977236758134308); const long k = (long)kd;
    double r = __builtin_fma(-kd, 1.57079632679489655800e+00, a); r = __builtin_fma(-kd, 6.12323399573676603587e-17, r);
    const double r2 = r * r;
    double sp = 1.0 / 6227020800.0; sp = sp * r2 - 1.0 / 39916800.0; sp = sp * r2 + 1.0 / 362880.0; sp = sp * r2 - 1.0 / 5040.0; sp = sp * r2 + 1.0 / 120.0; sp = sp * r2 - 1.0 / 6.0; sp = sp * r2 * r + r;
    double cp = 1.0 / 479001600.0; cp = cp * r2 - 1.0 / 3628800.0; cp = cp * r2 + 1.0 / 40320.0; cp = cp * r2 - 1.0 / 720.0; cp = cp * r2 + 1.0 / 24.0; cp = cp * r2 - 0.5; cp = cp * r2 + 1.0;
    const int q = (int)(k & 3);
    s = (q == 0) ? sp : (q == 1) ? cp : (q == 2) ? -sp : -cp;
    c = (q == 0) ? cp : (q == 1) ? -sp : (q == 2) ? -cp : sp;
}

__device__ __forceinline__ void ssm_weights_group(int g, const float* a_re, const float* a_im, const float* b_re, const float* b_im, const float* c_re, const float* c_im,
                                                  const float* log_dt, const float* dskip, bf16* W1t, bf16* W2t, LAS float* L, int tid) {
    LAS float* PW = L;
    LAS float* BB = PW + 2 * 17 * 64 * 2;
    LAS float* CC = BB + 2 * 64 * 16 * 2;
    LAS float* KT = CC + 2 * 16 * 64 * 2;
    for (int i = tid; i < 2 * 17 * 64; i += 512) { const int d = i / (17 * 64), e = (i / 64) % 17, p = i & 63;
        const double dt = exp((double)log_dt[d * 128 + g]); const double are = a_re[(d * 128 + g) * 64 + p], aim = a_im[(d * 128 + g) * 64 + p];
        const double mag = exp((double)e * dt * are); double s, c; sincos_d((double)e * dt * aim, s, c);
        PW[i * 2] = (float)(mag * c); PW[i * 2 + 1] = (float)(mag * s); }
    for (int i = tid; i < 2 * 64 * 16; i += 512) { const int d = i / 1024, p = (i >> 4) & 63, h = i & 15;
        const double dt = exp((double)log_dt[d * 128 + g]); const double are = a_re[(d * 128 + g) * 64 + p], aim = a_im[(d * 128 + g) * 64 + p];
        const double x = dt * are, y = dt * aim; double sy, cy, sh, ch; sincos_d(y, sy, cy); sincos_d(0.5 * y, sh, ch);
        const double em1 = expm1(x); const double re1 = em1 * cy - 2.0 * sh * sh, im1 = (em1 + 1.0) * sy;
        const double den = are * are + aim * aim; const double qre = (re1 * are + im1 * aim) / den, qim = (im1 * are - re1 * aim) / den;
        const size_t bi = ((size_t)((d * 128 + g) * 64 + p)) * 16 + h; const double br = b_re[bi], bim = b_im[bi];
        BB[i * 2] = (float)(qre * br - qim * bim); BB[i * 2 + 1] = (float)(qre * bim + qim * br); }
    for (int i = tid; i < 2 * 16 * 64; i += 512) { const int d = i / 1024, h = (i >> 6) & 15, p = i & 63; const size_t ci = ((size_t)((d * 128 + g) * 16 + h)) * 64 + p;
        CC[i * 2] = c_re[ci]; CC[i * 2 + 1] = c_im[ci]; }
    __syncthreads();
    { const int d = tid >> 8, e = (tid >> 4) & 15, h = tid & 15; float acc[16];
#pragma unroll
        for (int q = 0; q < 16; ++q) acc[q] = 0.f;
        for (int p = 0; p < 64; ++p) { const float cr = CC[((d * 16 + h) * 64 + p) * 2], ci = CC[((d * 16 + h) * 64 + p) * 2 + 1];
            const float pr = PW[((d * 17 + e) * 64 + p) * 2], pi = PW[((d * 17 + e) * 64 + p) * 2 + 1];
            const float tr = cr * pr - ci * pi, ti = cr * pi + ci * pr; const LAS f32x4* bp = (const LAS f32x4*)(BB + ((d * 64 + p) * 16) * 2);
#pragma unroll
            for (int q = 0; q < 8; ++q) { const f32x4 b = bp[q]; acc[2 * q] += tr * b[0] - ti * b[1]; acc[2 * q + 1] += tr * b[2] - ti * b[3]; } }
#pragma unroll
        for (int q = 0; q < 16; ++q) KT[((d * 16 + e) * 16 + h) * 16 + q] = acc[q]; }
    __syncthreads();
    for (int i = tid; i < 256 * 32; i += 512) { const int n = i >> 5, k0 = (i & 31) * 8; const int d = n >> 7, im = (n >> 6) & 1, p = n & 63; const int s = k0 >> 4, h0 = k0 & 15, e = d ? s : 15 - s;
        const float pr = PW[((d * 17 + e) * 64 + p) * 2], pi = PW[((d * 17 + e) * 64 + p) * 2 + 1]; float v[8];
#pragma unroll
        for (int j = 0; j < 8; ++j) { const float br = BB[((d * 64 + p) * 16 + h0 + j) * 2], bi = BB[((d * 64 + p) * 16 + h0 + j) * 2 + 1]; v[j] = im ? (pr * bi + pi * br) : (pr * br - pi * bi); }
        v4u o; o.x = pk2(v[0], v[1]); o.y = pk2(v[2], v[3]); o.z = pk2(v[4], v[5]); o.w = pk2(v[6], v[7]);
        *(GAS v4u*)(W1t + ((size_t)(g * 256 + n)) * 256 + k0) = o; }
    for (int i = tid; i < 256 * 64; i += 512) { const int n = i >> 6, k0 = (i & 63) * 8; const int j = n >> 4, h = n & 15; float v[8];
        if (k0 < 256) { const int d = k0 >> 7, im = (k0 >> 6) & 1, p0 = k0 & 63, e = d ? 16 - j : j + 1;
#pragma unroll
            for (int q = 0; q < 8; ++q) { const int p = p0 + q; const float cr = CC[((d * 16 + h) * 64 + p) * 2], ci = CC[((d * 16 + h) * 64 + p) * 2 + 1];
                const float pr = PW[((d * 17 + e) * 64 + p) * 2], pi = PW[((d * 17 + e) * 64 + p) * 2 + 1]; v[q] = im ? -(cr * pi + ci * pr) : (cr * pr - ci * pi); }
        } else { const int s = (k0 - 256) >> 4, h0 = (k0 - 256) & 15;
#pragma unroll
            for (int q = 0; q < 8; ++q) { const int hh = h0 + q; float val = 0.f;
                if (s <= j) val += KT[((0 * 16 + (j - s)) * 16 + h) * 16 + hh];
                if (s >= j) val += KT[((1 * 16 + (s - j)) * 16 + h) * 16 + hh];
                if (s == j && h == hh) val += dskip[g * 16 + h];
                v[q] = val; } }
        v4u o; o.x = pk2(v[0], v[1]); o.y = pk2(v[2], v[3]); o.z = pk2(v[4], v[5]); o.w = pk2(v[6], v[7]);
        *(GAS v4u*)(W2t + ((size_t)(g * 256 + n)) * 512 + k0) = o; }
    __syncthreads();
}
#ifndef PROBE_ATTN
#define PROBE_ATTN 1
#endif
#ifndef PROBE_P0
#define PROBE_P0 1
#endif
#ifndef PROBE_P1
#define PROBE_P1 1
#endif
#ifndef PROBE_P7
#define PROBE_P7 1
#endif
#ifndef PROBE_FA
#define PROBE_FA 1
#endif

struct Args { const float* in[27]; float* out; unsigned char* ws; int ph_lo, ph_hi; };

__global__ void __launch_bounds__(NWAVES * 64, 2) enc_fwd(Args args) {
    extern __shared__ __attribute__((aligned(16))) unsigned char lds[];
    LAS unsigned char* ldsb = (LAS unsigned char*)lds;
    volatile LAS unsigned* MISC = (volatile LAS unsigned*)(ldsb + MISC_OFF);
    const int tid = threadIdx.x, lane = tid & 63, wave = __builtin_amdgcn_readfirstlane(tid >> 6);
    const int G = gridDim.x, bx = blockIdx.x; const int vcu = (G % 8 == 0) ? (bx % 8) * (G / 8) + bx / 8 : bx;
    const int gw = vcu * NWAVES + wave, NGW = G * NWAVES, gt = vcu * (NWAVES * 64) + tid, NGT = G * NWAVES * 64;
    unsigned char* ws = args.ws; unsigned char* outb = (unsigned char*)args.out;
    gu32* ctl = (gu32*)(ws + WS_CTL);
    const float* x_p = args.in[0]; const float* x_s = args.in[1];
    float* rstd_x = (float*)(ws + WS_RSTDX); float* rstd_q = (float*)(ws + WS_RSTDQ); float* rstd_kv = (float*)(ws + WS_RSTDKV);
    float* r2v = (float*)(ws + WS_R2); float* ratio = (float*)(ws + WS_RATIO); float* rstd_x1 = (float*)(ws + WS_RSTDX1);
    float* stA = (float*)(ws + WS_STA); float* stB = (float*)(ws + WS_STB); float* stQ = (float*)(ws + WS_STQ); float* stKV = (float*)(ws + WS_STKV);
    float* ropetab = (float*)(ws + WS_ROPE);
    bf16* Wi = (bf16*)(ws + WS_WIN); bf16* Wglu = (bf16*)(ws + WS_WGLU); bf16* Wq = (bf16*)(ws + WS_WQ); bf16* Wkv = (bf16*)(ws + WS_WKV); bf16* Wout = (bf16*)(ws + WS_WOUT);
    bf16* Wug = (bf16*)(ws + WS_WUG); bf16* Wdn = (bf16*)(ws + WS_WDN); bf16* W1t = (bf16*)(ws + WS_W1T); bf16* W2t = (bf16*)(ws + WS_W2T);
    bf16* bufA = (bf16*)(ws + WS_A); bf16* bufB = (bf16*)(ws + WS_B);
    bf16* qlat = (bf16*)(ws + WS_QLAT); bf16* kvlat = (bf16*)(ws + WS_KVLAT); bf16* krope = (bf16*)(ws + WS_KROPE); bf16* gact = (bf16*)(ws + WS_GACT);
    bf16* hup = (bf16*)(ws + WS_HUP); bf16* hgate = (bf16*)(ws + WS_HGATE);
    bf16* X = (bf16*)(outb + OUT_X); bf16* kvb = (bf16*)(outb + OUT_KV);

    for (int u = tid; u < (LDS_BYTES - LDSCTL_OFF) / 4; u += NWAVES * 64) ((LAS unsigned*)(ldsb + LDSCTL_OFF))[u] = 0u;
    __syncthreads();
    XcdBarrier bar = xcd_barrier_post((unsigned*)(ctl + CW_BAR), MISC + 8);
    const int lo = args.ph_lo, hi = args.ph_hi;
#ifndef PHMASK
#define PHMASK 0xfffffffu
#endif
#define IN(k) (((PHMASK >> ((k) < 9 ? (k) : ((k) >= 18 ? 12 : 9 + ((k) - 9) % 3))) & 1u) && lo <= (k) && (k) < hi)
#define SEAM(k) do { if (IN(k) && IN((k) + 1)) xcd_barrier(bar); } while (0)

#pragma unroll 1
    for (int rep = 0; rep < PROBE_P0; ++rep)
    if (IN(0)) {
        if (rep) __syncthreads();
        if (vcu < 128) ssm_weights_group(vcu, args.in[4], args.in[5], args.in[6], args.in[7], args.in[8], args.in[9], args.in[10], args.in[11], W1t, W2t, (LAS float*)ldsb, tid);
        LAS float* scr = (LAS float*)(ldsb + wave * 16384);
        constexpr int I_IN = 64 * 110, I_GLU = 32 * 64, I_Q = 14 * 96, I_KV = 8 * 128, I_OUT = 64 * 128, I_UP = 64 * 344, I_DN = 172 * 128;
        constexpr int NITEMS = I_IN + I_GLU + I_Q + I_KV + I_OUT + 2 * I_UP + I_DN;
        for (int it = gw; it < NITEMS; it += NGW) {
            int r = it;
            if (r < I_IN) { transpose_item(args.in[2], 4096, 3520, Wi, args.in[3], args.in[3], 4096, RmWin(), scr, r, lane); continue; } r -= I_IN;
            if (r < I_GLU) { transpose_item(args.in[12], 2048, 2048, Wglu, nullptr, nullptr, 0, RmId(), scr, r, lane); continue; } r -= I_GLU;
            if (r < I_Q) { transpose_item(args.in[14], 896, 3072, Wq, args.in[13], args.in[13], 896, RmQ(), scr, r, lane); continue; } r -= I_Q;
            if (r < I_KV) { transpose_item(args.in[16], 512, 4096, Wkv, args.in[15], args.in[15], 512, RmId(), scr, r, lane); continue; } r -= I_KV;
            if (r < I_OUT) { transpose_item(args.in[19], 4096, 4096, Wout, args.in[17], args.in[18], 2048, RmId(), scr, r, lane); continue; } r -= I_OUT;
            if (r < I_UP) { transpose_item(args.in[21], 4096, 11008, Wug, args.in[20], args.in[20], 4096, RmUp(), scr, r, lane); continue; } r -= I_UP;
            if (r < I_UP) { transpose_item(args.in[22], 4096, 11008, Wug, args.in[20], args.in[20], 4096, RmGate(), scr, r, lane); continue; } r -= I_UP;
            transpose_item(args.in[25], 11008, 4096, Wdn, nullptr, nullptr, 0, RmId(), scr, r, lane);
        }
        for (int i = gt; i < 320 * 512; i += NGT) { const int rr = i >> 9, c8 = (i & 511) * 8; const int row = rr < 128 ? 2944 + rr : 3648 + (rr - 128);
            *(GAS v4u*)(Wi + (size_t)row * 4096 + c8) = (v4u){0u, 0u, 0u, 0u}; }
        for (int m = gw; m < T; m += NGW) { const float* xr = m < 16384 ? x_p + (size_t)m * DM : x_s + (size_t)(m - 16384) * DM;
            f32x4 v[16]; float s = 0.f;
#pragma unroll
            for (int j = 0; j < 16; ++j) { v[j] = *((const GAS f32x4*)xr + lane + 64 * j); s += (v[j].x * v[j].x + v[j].y * v[j].y) + (v[j].z * v[j].z + v[j].w * v[j].w); }
            s = wave_sum(s); if (lane == 0) rstd_x[m] = 1.0f / sqrtf(s * (1.0f / DM) + EPS);
            GAS v2u* o8 = (GAS v2u*)(bufA + (size_t)m * DM) + lane;
#pragma unroll
            for (int j = 0; j < 16; ++j) o8[64 * j] = (v2u){pg8::cvt_pk_bf16(v[j].x, v[j].y), pg8::cvt_pk_bf16(v[j].z, v[j].w)}; }
        for (int i = gt; i < 8192 * 32; i += NGT) { const int pos = i >> 5, k = i & 31; const double inv = exp(-(double)k * (9.210340371976184 / 32.0));
            double s, c; sincos_d((double)pos * inv, s, c); *(GAS f32x2*)(ropetab + (size_t)i * 2) = (f32x2){(float)c, (float)s}; }
    }
    SEAM(0);

#pragma unroll 1
    for (int rep = 0; rep < PROBE_P1; ++rep)
    if (IN(1)) {
        pg8::Gemm g{bufA, Wi, DM, DM, DM}; pg8::StaticOrder S; S.init(T, 3840, G, bx);
        pg8::EpiWin E{rstd_x, X, qlat, kvlat, krope, stQ, stKV, ropetab};
        pg8::gemm_phase(ldsb, g, S, E);
    }
    SEAM(1);

    if (IN(2)) {
        pg8::Gemm g{X + 256, W1t, 512, 256, 256}; pg8::GroupOrder S{768, 6, G, bx};
        pg8::EpiSsm1 E{X};
        pg8::gemm_phase(ldsb, g, S, E);
        for (int r = gt; r < T; r += NGT) { float s = 0.f;
#pragma unroll
            for (int j = 0; j < 4; ++j) { const f32x4 v = *(const GAS f32x4*)(stQ + (size_t)r * 16 + 4 * j); s += (v.x + v.y) + (v.z + v.w); }
            rstd_q[r] = 1.0f / sqrtf(s * (1.0f / QLAT) + EPS); float s2 = 0.f;
#pragma unroll
            for (int j = 0; j < 2; ++j) { const f32x4 v = *(const GAS f32x4*)(stKV + (size_t)r * 8 + 4 * j); s2 += (v.x + v.y) + (v.z + v.w); }
            rstd_kv[r] = 1.0f / sqrtf(s2 * (1.0f / KVLAT) + EPS); }
    }
    SEAM(2);

    if (IN(3)) {
        if (wave < 4) { const int task = vcu * 4 + wave;
            if (task < 1024) { const int seq = task >> 8, g = (task >> 1) & 127, dir = task & 1, p = lane;
                const int c0 = seq < 2 ? seq * 512 : 1024 + (seq - 2) * 256, nc = seq < 2 ? 512 : 256;
                const double dt = exp((double)args.in[10][dir * 128 + g]); const double are = args.in[4][(dir * 128 + g) * 64 + p], aim = args.in[5][(dir * 128 + g) * 64 + p];
                const double mag = exp(16.0 * dt * are); double sn, cs; sincos_d(16.0 * dt * aim, sn, cs);
                const float ar = (float)(mag * cs), ai = (float)(mag * sn);
                bf16* Xg = X + (size_t)g * NCHUNK * 512 + dir * 128 + p;
                float zr = 0.f, zi = 0.f;
                for (int cb = 0; cb < nc; cb += 16) {
                    unsigned short sre[16], sim[16];
#pragma unroll
                    for (int i = 0; i < 16; ++i) { const int c = dir ? (c0 + nc - 1 - (cb + i)) : (c0 + cb + i); sre[i] = Xg[(size_t)c * 512]; sim[i] = Xg[(size_t)c * 512 + 64]; }
#pragma unroll
                    for (int i = 0; i < 16; ++i) { const int c = dir ? (c0 + nc - 1 - (cb + i)) : (c0 + cb + i);
                        Xg[(size_t)c * 512] = (bf16)f2bf(zr); Xg[(size_t)c * 512 + 64] = (bf16)f2bf(zi);
                        const float sr = bf2f(sre[i]), si = bf2f(sim[i]); const float nr = ar * zr - ai * zi + sr, ni = ar * zi + ai * zr + si; zr = nr; zi = ni; }
                }
            }
        }
        __syncthreads();
        { pg8::Gemm g{qlat, Wq, QLAT, QLAT, QLAT}; pg8::StaticOrder S; S.init(T, QW, G, bx); pg8::EpiQ E{rstd_q, bufA, ropetab}; pg8::gemm_phase(ldsb, g, S, E); }
        { pg8::Gemm g{kvlat, Wkv, KVLAT, KVLAT, KVLAT}; pg8::StaticOrder S; S.init(T, KVW, G, bx); pg8::EpiKV E{rstd_kv, kvb}; pg8::gemm_phase(ldsb, g, S, E); }
    }
    SEAM(3);

    if (IN(4)) {
        pg8::Gemm g{X, W2t, 512, 512, 512}; pg8::GroupOrder S{768, 6, G, bx};
        pg8::EpiSsm2 E{gact};
        pg8::gemm_phase(ldsb, g, S, E);
    }
    SEAM(4);

    if (IN(5)) {
#ifndef NO_GLU
        { pg8::Gemm g{gact, Wglu, MIXW, MIXW, MIXW}; pg8::StaticOrder S; S.init(T, MIXW, G, bx); pg8::EpiGlu E{gact, bufB, stA}; pg8::gemm_phase(ldsb, g, S, E); }
#endif
#ifndef NO_ATTN
        const int xcd = vcu >> 5, cc = vcu & 31; const int nun = (G == 256) ? 6 : (1536 - bx + G - 1) / G;
#pragma unroll 1
        for (int i2 = 0; i2 < PROBE_ATTN * nun; ++i2) { const int i = i2 % nun;
            int bh, qb, seq, rowbase;
            if (G == 256) { if (i < 4) { bh = xcd * 4 + i; qb = cc; seq = 8192; } else { bh = xcd * 4 + 2 * (i - 4) + (cc >> 4); qb = cc & 15; seq = 4096; } }
            else { const int uidx = bx + i * G; if (uidx < 1024) { bh = uidx >> 5; qb = uidx & 31; seq = 8192; } else { const int v = uidx - 1024; bh = v >> 4; qb = v & 15; seq = 4096; } }
            const int b = bh >> 4, h = bh & 15; rowbase = (seq == 8192) ? b * 8192 : 16384 + b * 4096;
            __syncthreads();
            attn::attn_unit(bufA + (size_t)(rowbase + qb * 256) * QW + h * 192, kvb + (size_t)rowbase * KVW + h * 256, kvb + (size_t)rowbase * KVW + h * 256 + 128,
                            krope + (size_t)rowbase * 64, bufB + (size_t)(rowbase + qb * 256) * DM + 2048 + h * 128, stB + (size_t)(rowbase + qb * 256) * 16 + h, seq, (char*)lds);
        }
#endif
    }
    SEAM(5);

    if (IN(6)) {
        for (int r = gt; r < T; r += NGT) { float s = 0.f;
#pragma unroll
            for (int j = 0; j < 8; ++j) { const f32x4 v = *(const GAS f32x4*)(stA + (size_t)r * 32 + 4 * j); s += (v.x + v.y) + (v.z + v.w); }
            const float r1 = 1.0f / sqrtf(s * (1.0f / MIXW) + EPS); float s2 = 0.f;
#pragma unroll
            for (int j = 0; j < 4; ++j) { const f32x4 v = *(const GAS f32x4*)(stB + (size_t)r * 16 + 4 * j); s2 += (v.x + v.y) + (v.z + v.w); }
            const float r2 = 1.0f / sqrtf(s2 * (1.0f / MIXW) + EPS); r2v[r] = r2; ratio[r] = r1 / r2; }
    }
    SEAM(6);

#pragma unroll 1
    for (int rep = 0; rep < PROBE_P7; ++rep)
    if (IN(7)) {
        pg8::Gemm g{bufB, Wout, DM, DM, DM}; pg8::StaticOrder S; S.init(T, DM, G, bx);
        pg8::EpiWout E{x_p, x_s, r2v, ratio, args.out, bufA, stA};
        pg8::gemm_phase(ldsb, g, S, E);
    }
    SEAM(7);

    if (IN(8)) {
        for (int r = gt; r < T; r += NGT) { float s = 0.f;
#pragma unroll
            for (int j = 0; j < 16; ++j) { const f32x4 v = *(const GAS f32x4*)(stA + (size_t)r * 64 + 4 * j); s += (v.x + v.y) + (v.z + v.w); }
            rstd_x1[r] = 1.0f / sqrtf(s * (1.0f / DM) + EPS); }
    }
    SEAM(8);

#ifdef PROBE_KLOOP
    if (IN(9)) {
#pragma unroll 1
        for (int ch = 0; ch < 3; ++ch) { pg8::Gemm g{bufA + (size_t)(ch * 8192) * DM, Wug, DM, DM, DM}; pg8::StaticOrder S; S.init(8192, 2 * DFF, G, bx); pg8::EpiNull E0; pg8::gemm_phase(ldsb, g, S, E0); }
    }
#endif
#pragma unroll 1
    for (int ch2 = 0; ch2 < 3 * PROBE_FA; ++ch2) {
        const int ch = ch2 / PROBE_FA; const bool lastrep = (ch2 % PROBE_FA) == PROBE_FA - 1;
        const int rb = ch * 8192;
        if (IN(9 + 3 * ch)) {
            pg8::Gemm g{bufA + (size_t)rb * DM, Wug, DM, DM, DM}; pg8::StaticOrder S; S.init(8192, 2 * DFF, G, bx);
            pg8::EpiFfnA E{rstd_x1, rb, bufB, hup, hgate, args.in[23], args.in[24]};
            pg8::gemm_phase(ldsb, g, S, E);
        }
        SEAM(9 + 3 * ch);
        if (lastrep && IN(10 + 3 * ch)) {
            const float* cw = args.in[23]; const float* cb = args.in[24];
            for (int i = gt; i < 128 * 2 * (DFF / 8); i += NGT) { const int f0 = (i % (DFF / 8)) * 8, sw = i / (DFF / 8), strip = sw >> 1, which = sw & 1;
                const int lrow = strip * 64 + (which ? 63 : 0), grow = rb + lrow, pos = pos_of(grow), len = len_of(grow);
                v4u up0, up1, up2;
                if (which == 0) { up1 = *(const GAS v4u*)(hup + ((size_t)strip * 4 + 0) * DFF + f0); up2 = *(const GAS v4u*)(hup + ((size_t)strip * 4 + 1) * DFF + f0);
                    up0 = (pos == 0) ? (v4u){0u, 0u, 0u, 0u} : *(const GAS v4u*)(hup + ((size_t)(strip - 1) * 4 + 3) * DFF + f0); }
                else { up0 = *(const GAS v4u*)(hup + ((size_t)strip * 4 + 2) * DFF + f0); up1 = *(const GAS v4u*)(hup + ((size_t)strip * 4 + 3) * DFF + f0);
                    up2 = (pos == len - 1) ? (v4u){0u, 0u, 0u, 0u} : *(const GAS v4u*)(hup + ((size_t)(strip + 1) * 4 + 0) * DFF + f0); }
                const v4u gt4 = *(const GAS v4u*)(hgate + ((size_t)strip * 2 + which) * DFF + f0);
                unsigned ow[4];
#pragma unroll
                for (int k = 0; k < 4; ++k) { const int f = f0 + 2 * k;
                    const float a0 = bflo(up0[k]), a1 = bflo(up1[k]), a2 = bflo(up2[k]), b0 = bfhi(up0[k]), b1 = bfhi(up1[k]), b2 = bfhi(up2[k]);
                    const float c0 = cw[f] * a0 + cw[DFF + f] * a1 + cw[2 * DFF + f] * a2 + cb[f], c1 = cw[f + 1] * b0 + cw[DFF + f + 1] * b1 + cw[2 * DFF + f + 1] * b2 + cb[f + 1];
                    ow[k] = pk2(c0 * sigmoidf_fast(c0) * bflo(gt4[k]), c1 * sigmoidf_fast(c1) * bfhi(gt4[k])); }
                *(GAS v4u*)(bufB + (size_t)lrow * DFF + f0) = (v4u){ow[0], ow[1], ow[2], ow[3]}; }
        }
        if (lastrep) SEAM(10 + 3 * ch);
        if (lastrep && IN(11 + 3 * ch)) {
            pg8::Gemm g{bufB, Wdn, DFF, DFF, DFF}; pg8::StaticOrder S; S.init(8192, DM, G, bx);
            pg8::EpiDown E{args.out, rb, stA};
            pg8::gemm_phase(ldsb, g, S, E);
        }
        if (lastrep) SEAM(11 + 3 * ch);
    }

    if (IN(18)) {
        const float* gf = args.in[26];
        for (int m = gw; m < T; m += NGW) { const float s = wave_sum(stA[(size_t)m * 64 + lane]); const float rs = 1.0f / sqrtf(s * (1.0f / DM) + EPS);
            GAS f32x4* xr = (GAS f32x4*)(args.out + (size_t)m * DM) + lane; const GAS f32x4* gr = (const GAS f32x4*)gf + lane;
#pragma unroll
            for (int j = 0; j < 16; ++j) { const f32x4 v = xr[64 * j], gg = gr[64 * j]; xr[64 * j] = v * rs * gg; } }
    }
#undef IN
#undef SEAM
}

constexpr int N_PHASES = 19;
extern "C" void kernel_launch(void* const* d_in, const int* in_sizes, int n_in, void* d_out, int out_size, void* d_ws, size_t ws_size, hipStream_t stream) {
    static int grid = 0;
    if (grid == 0) {
        if (n_in != 27 || out_size != T * DM || ws_size < WS_END) { fprintf(stderr, "kernel_launch: unexpected shapes (n_in %d out %d ws %zu)\n", n_in, out_size, ws_size); grid = -1; return; }
        int dev = 0, cus = 0, per_cu = 0;
        if (hipGetDevice(&dev) != hipSuccess || hipDeviceGetAttribute(&cus, hipDeviceAttributeMultiprocessorCount, dev) != hipSuccess) { grid = -1; return; }
        if (hipFuncSetAttribute((const void*)enc_fwd, hipFuncAttributeMaxDynamicSharedMemorySize, LDS_BYTES) != hipSuccess) { fprintf(stderr, "kernel_launch: hipFuncSetAttribute failed\n"); grid = -1; return; }
        if (hipOccupancyMaxActiveBlocksPerMultiprocessor(&per_cu, (const void*)enc_fwd, NWAVES * 64, LDS_BYTES) != hipSuccess || per_cu < 1) { fprintf(stderr, "kernel_launch: occupancy query says %d\n", per_cu); }
        (void)hipGetLastError();
        grid = cus;
    }
    if (grid < 0) return;
    if (hipMemsetAsync((char*)d_ws + WS_CTL, 0, CTL_ZERO_BYTES, stream) != hipSuccess) return;
    Args a{};
    for (int i = 0; i < 27; ++i) a.in[i] = (const float*)d_in[i];
    a.out = (float*)d_out; a.ws = (unsigned char*)d_ws;
#ifndef MK_N_LAUNCHES
#define MK_N_LAUNCHES 1
#endif
    if (MK_N_LAUNCHES == 1) { a.ph_lo = 0; a.ph_hi = N_PHASES; hipLaunchKernelGGL(enc_fwd, dim3(grid), dim3(NWAVES * 64), LDS_BYTES, stream, a); }
    else { for (int p = 0; p < N_PHASES; ++p) { a.ph_lo = p; a.ph_hi = p + 1; hipLaunchKernelGGL(enc_fwd, dim3(grid), dim3(NWAVES * 64), LDS_BYTES, stream, a); } }
    const hipError_t le = hipPeekAtLastError();
    if (le != hipSuccess) fprintf(stderr, "kernel_launch: launch failed: %s\n", hipGetErrorName(le));
}
```

```cpp
#include <hip/hip_runtime.h>
#include <hip/hip_bf16.h>
#include <cstdio>
#include <cstdint>

namespace pg8 {
#define PG8_LAS __attribute__((address_space(3)))
typedef unsigned short bf16_t;
typedef short bf16x8 __attribute__((ext_vector_type(8)));
typedef float f32x4 __attribute__((ext_vector_type(4)));
typedef float f32x2 __attribute__((ext_vector_type(2)));
typedef unsigned u32x4 __attribute__((ext_vector_type(4)));
typedef unsigned u32x2 __attribute__((ext_vector_type(2)));
constexpr int BM = 256, BK = 64, HALF = 128, HTB = HALF * BK * 2  , STAGE_BYTES = 8 * HTB, NXCD = 8, WGM = 8;

__host__ __device__ __forceinline__ int lds_byte(int r, int c) { const int st = (r >> 4) * 2 + (c >> 5), rr = r & 15, cc = c & 31, ob = rr * 64 + cc * 2; return st * 1024 + (ob ^ (((ob >> 9) & 1) << 5)); }
__host__ __device__ __forceinline__ void stage_rc(int b, int& R, int& C) { const int st = b / 1024, sb = b % 1024, swz = sb ^ (((sb >> 9) & 1) << 5); R = (st >> 1) * 16 + swz / 64; C = (st & 1) * 32 + (swz % 64) / 2; }
__host__ __device__ __forceinline__ int perm32(int rho) { const int n = rho >> 4, i = rho & 15; return 8 * (i >> 2) + 4 * n + (i & 3); }

struct Unit { int pm, pn; };
struct Gemm { const bf16_t* A; const bf16_t* Bt; int lda, ldb, K; };

struct StaticOrder {
    int nM, nN, nwg, G, c;
    __host__ __device__ void init(int M, int N, int G_, int c_) { nM = M / BM; nN = N / BM; nwg = nM * nN; G = G_; c = c_; }
    __host__ __device__ bool next(int i, Unit& u) const {
        const long L = (long)i * G + c; if (L >= nwg) return false;
        int wgid = (int)L; { const int q = nwg / NXCD, r = nwg % NXCD, xcd = wgid % NXCD, off = wgid / NXCD; wgid = (xcd < r ? xcd * (q + 1) : r * (q + 1) + (xcd - r) * q) + off; }
        const int nig = WGM * nN, gid = wgid / nig, fm = gid * WGM, gsz = (nM - fm) < WGM ? (nM - fm) : WGM;
        u.pm = fm + ((wgid % nig) % gsz); u.pn = (wgid % nig) / gsz; return true;
    }
};
struct ZeroOrder { int n, G, c; __host__ __device__ bool next(int i, Unit& u) const { const long L = (long)i * G + c; if (L >= n) return false; u.pm = 0; u.pn = 0; return true; } };
struct GroupOrder {
    int n, per, G, c;
    __host__ __device__ bool next(int i, Unit& u) const { const long L = (long)i * G + c; if (L >= n) return false; u.pm = (int)L; u.pn = (int)L / per; return true; }
};

__device__ __forceinline__ unsigned cvt_pk_bf16(float lo, float hi) { unsigned r; asm volatile("v_cvt_pk_bf16_f32 %0, %1, %2" : "=v"(r) : "v"(lo), "v"(hi)); return r; }
__device__ __forceinline__ u32x4 pack8(const f32x4 a, const f32x4 b) { u32x4 w; w.x = cvt_pk_bf16(a[0], a[1]); w.y = cvt_pk_bf16(a[2], a[3]); w.z = cvt_pk_bf16(b[0], b[1]); w.w = cvt_pk_bf16(b[2], b[3]); return w; }

template <class Epi, class Sched>
__device__ __forceinline__ void gemm_phase(PG8_LAS unsigned char* lds, const Gemm g, const Sched& S, const Epi& E) {
    int tid_l = threadIdx.x; asm volatile("" : "+v"(tid_l));
    const int tid = tid_l, wid = __builtin_amdgcn_readfirstlane(tid >> 6), lane = tid & 63, wr = wid >> 2, wc = wid & 3, fr = lane & 15, fq = lane >> 4;
    const int K = g.K, nt = K / BK;
    unsigned voffA[2], voffB[2];
#pragma unroll
    for (int i = 0; i < 2; ++i) { int R, C; stage_rc(tid * 16 + i * 8192, R, C); const int Rb = Epi::PERM ? ((R & ~31) + perm32(R & 31)) : R;
        voffA[i] = (unsigned)(R * g.lda + C) * 2u; voffB[i] = (unsigned)(Rb * g.ldb + C) * 2u; }
    asm volatile("" : "+v"(voffA[0]), "+v"(voffA[1]), "+v"(voffB[0]), "+v"(voffB[1]));
    const size_t kstep = (size_t)(BK * 2);
    const size_t hstepA = (size_t)HALF * g.lda * 2, hstepB = (size_t)HALF * g.ldb * 2;
    const size_t tstepA = 2 * hstepA, tstepB = 2 * hstepB;
    const unsigned ldsw = (unsigned)wid * 1024u;
    const int aoff = lds_byte(wr * 64 + fr, fq * 8), boff = lds_byte(wc * 32 + fr, fq * 8);
#define PG8_SA(b, h) (((b) * 2 + (h)) * HTB)
#define PG8_SB(b, h) ((4 + (b) * 2 + (h)) * HTB)
#define PG8_STAGE(bufoff, gbase, voff) do { _Pragma("unroll") for (int _i = 0; _i < 2; ++_i) \
        __builtin_amdgcn_global_load_lds((const unsigned*)((const char*)(gbase) + (voff)[_i]), (PG8_LAS unsigned*)(lds + (bufoff) + ldsw + _i * 8192), 16, 0, 0); } while (0)
#define PG8_LDA(dst, b, h) do { _Pragma("unroll") for (int m = 0; m < 4; ++m) _Pragma("unroll") for (int k = 0; k < 2; ++k) dst[m][k] = *(const PG8_LAS bf16x8*)(lds + PG8_SA(b, h) + aoff + m * 2048 + k * 1024); } while (0)
#define PG8_LDB(dst, b, h) do { _Pragma("unroll") for (int n = 0; n < 2; ++n) _Pragma("unroll") for (int k = 0; k < 2; ++k) dst[n][k] = *(const PG8_LAS bf16x8*)(lds + PG8_SB(b, h) + boff + n * 2048 + k * 1024); } while (0)
#define PG8_MMA(ai, bj, At, Bt) do { __builtin_amdgcn_s_setprio(1); _Pragma("unroll") for (int m = 0; m < 4; ++m) _Pragma("unroll") for (int n = 0; n < 2; ++n) _Pragma("unroll") for (int k = 0; k < 2; ++k) \
        acc[ai][bj][m][n] = __builtin_amdgcn_mfma_f32_16x16x32_bf16(Bt[n][k], At[m][k], acc[ai][bj][m][n], 0, 0, 0); __builtin_amdgcn_s_setprio(0); } while (0)
#define PG8_WAIT_V(n) asm volatile("s_waitcnt vmcnt(" #n ")" ::: "memory")
#define PG8_WAIT_L(n) asm volatile("s_waitcnt lgkmcnt(" #n ")" ::: "memory")
#define PG8_BAR __builtin_amdgcn_s_barrier()
#define PG8_SCHED __builtin_amdgcn_sched_barrier(0)
    Unit cur, nxt; int ui = 0;
    if (!S.next(0, cur)) return;
    f32x4 acc[2][2][4][2];
#pragma unroll
    for (int a = 0; a < 2; ++a)
#pragma unroll
        for (int b = 0; b < 2; ++b)
#pragma unroll
            for (int m = 0; m < 4; ++m)
#pragma unroll
                for (int n = 0; n < 2; ++n) acc[a][b][m][n] = (f32x4){0.f, 0.f, 0.f, 0.f};
    bf16x8 At[4][2], B0[2][2], B1[2][2];
    const char* cA = (const char*)g.A + (size_t)cur.pm * tstepA; const char* cB = (const char*)g.Bt + (size_t)cur.pn * tstepB;
    PG8_STAGE(PG8_SB(0, 0), cB, voffB); PG8_STAGE(PG8_SB(0, 1), cB + hstepB, voffB); PG8_STAGE(PG8_SA(0, 0), cA, voffA); PG8_STAGE(PG8_SA(0, 1), cA + hstepA, voffA);
    if (wr == 1) PG8_BAR;
    PG8_WAIT_V(2); PG8_BAR;
    PG8_STAGE(PG8_SB(1, 0), cB + kstep, voffB); PG8_STAGE(PG8_SA(1, 0), cA + kstep, voffA); PG8_STAGE(PG8_SB(1, 1), cB + hstepB + kstep, voffB);
    PG8_WAIT_V(6); PG8_BAR;
    for (;;) {
        const bool has_next = S.next(ui + 1, nxt);
        const char* nA = has_next ? (const char*)g.A + (size_t)nxt.pm * tstepA : cA; const char* nB = has_next ? (const char*)g.Bt + (size_t)nxt.pn * tstepB : cB;
#pragma unroll 1
        for (int t = 0; t < nt; t += 2) {
            const bool last = (t == nt - 2);
            if constexpr (Epi::MIDK) { if (t == (nt >> 1)) E.midk(acc, cur, wr, fr); }
            const char* a1 = cA + (size_t)(t + 1) * kstep;
            const char* a2 = last ? nA : cA + (size_t)(t + 2) * kstep; const char* b2 = last ? nB : cB + (size_t)(t + 2) * kstep;
            const char* a3 = a2 + kstep; const char* b3 = b2 + kstep;
            PG8_LDB(B0, 0, 0); PG8_LDB(B1, 0, 1); PG8_SCHED; PG8_LDA(At, 0, 0); PG8_STAGE(PG8_SA(1, 1), a1 + hstepA, voffA);
            PG8_WAIT_V(8); PG8_WAIT_L(0); PG8_BAR; PG8_MMA(0, 0, At, B0); PG8_MMA(0, 1, At, B1); PG8_BAR; PG8_SCHED;
            PG8_LDA(At, 0, 1); PG8_STAGE(PG8_SB(0, 0), b2, voffB); PG8_STAGE(PG8_SB(0, 1), b2 + hstepB, voffB); PG8_STAGE(PG8_SA(0, 0), a2, voffA);
            PG8_WAIT_V(8); PG8_WAIT_L(0); PG8_BAR; PG8_MMA(1, 0, At, B0); PG8_MMA(1, 1, At, B1); PG8_BAR; PG8_SCHED;
            PG8_LDB(B0, 1, 0); PG8_LDB(B1, 1, 1); PG8_SCHED; PG8_LDA(At, 1, 0); PG8_STAGE(PG8_SA(0, 1), a2 + hstepA, voffA);
            PG8_WAIT_V(8); PG8_WAIT_L(0); PG8_BAR; PG8_MMA(0, 0, At, B0); PG8_MMA(0, 1, At, B1); PG8_BAR; PG8_SCHED;
            PG8_LDA(At, 1, 1); PG8_STAGE(PG8_SB(1, 0), b3, voffB); PG8_STAGE(PG8_SB(1, 1), b3 + hstepB, voffB); PG8_STAGE(PG8_SA(1, 0), a3, voffA);
            PG8_WAIT_V(8); PG8_WAIT_L(0); PG8_BAR; PG8_MMA(1, 0, At, B0); PG8_MMA(1, 1, At, B1); PG8_BAR; PG8_SCHED;
        }
        if (wr == 0) PG8_BAR;
        E(acc, cur, wr, wc, fr, fq);
        if (!has_next) break;
#pragma unroll
        for (int a = 0; a < 2; ++a)
#pragma unroll
            for (int b = 0; b < 2; ++b)
#pragma unroll
                for (int m = 0; m < 4; ++m)
#pragma unroll
                    for (int n = 0; n < 2; ++n) acc[a][b][m][n] = (f32x4){0.f, 0.f, 0.f, 0.f};
        cur = nxt; cA = nA; cB = nB; ++ui;
        if (wr == 1) PG8_BAR;
    }
    PG8_WAIT_V(0);
    PG8_BAR;
#undef PG8_SA
#undef PG8_SB
#undef PG8_STAGE
#undef PG8_LDA
#undef PG8_LDB
#undef PG8_MMA
#undef PG8_WAIT_V
#undef PG8_WAIT_L
#undef PG8_BAR
#undef PG8_SCHED
}
}

constexpr int T = 24576, DM = 4096, DFF = 11008;
constexpr int NCHUNK = T / 16;
constexpr int QLAT = 896, KVLAT = 512, QW = 3072, KVW = 4096, MIXW = 2048;
constexpr float EPS = 1e-6f;
__device__ __forceinline__ int pos_of(int r) { return r < 16384 ? (r & 8191) : (r & 4095); }
__device__ __forceinline__ int len_of(int r) { return r < 16384 ? 8192 : 4096; }

typedef unsigned short bf16;
#define GAS __attribute__((address_space(1)))
#define LAS __attribute__((address_space(3)))
typedef unsigned v4u __attribute__((ext_vector_type(4)));
typedef unsigned v2u __attribute__((ext_vector_type(2)));
typedef float f32x4 __attribute__((ext_vector_type(4)));
typedef float f32x2 __attribute__((ext_vector_type(2)));
typedef short bf16x8 __attribute__((ext_vector_type(8)));

__device__ __forceinline__ unsigned f2bf(float f) { unsigned u = __builtin_bit_cast(unsigned, f); return (u + 0x7fffu + ((u >> 16) & 1u)) >> 16; }
__device__ __forceinline__ unsigned pk2(float lo, float hi) { return f2bf(lo) | (f2bf(hi) << 16); }
__device__ __forceinline__ float bf2f(unsigned short b) { return __builtin_bit_cast(float, (unsigned)b << 16); }
__device__ __forceinline__ float bflo(unsigned w) { return __builtin_bit_cast(float, w << 16); }
__device__ __forceinline__ float bfhi(unsigned w) { return __builtin_bit_cast(float, w & 0xffff0000u); }
__device__ __forceinline__ float sigmoidf_fast(float x) { return __builtin_amdgcn_rcpf(1.0f + __builtin_amdgcn_exp2f(-1.4426950408889634f * x)); }
__device__ __forceinline__ float gelu_tanh(float y) { const float in = 1.5957691216057308f * (y + 0.044715f * y * y * y); return y * sigmoidf_fast(in); }

namespace pg8 {
#define EPI_ROWS const int row0 = u.pm * 256 + wr * 64 + fr
__device__ __forceinline__ float sq8(const f32x4 a, const f32x4 b) { return (a[0] * a[0] + a[1] * a[1]) + (a[2] * a[2] + a[3] * a[3]) + (b[0] * b[0] + b[1] * b[1]) + (b[2] * b[2] + b[3] * b[3]); }
__device__ __forceinline__ float red_fq(float s) { s += __shfl_xor(s, 16); s += __shfl_xor(s, 32); return s; }

__device__ __forceinline__ f32x4 rope4(const f32x4 v, const f32x4 cs) { f32x4 o; o[0] = v[0] * cs[0] - v[1] * cs[1]; o[1] = v[1] * cs[0] + v[0] * cs[1]; o[2] = v[2] * cs[2] - v[3] * cs[3]; o[3] = v[3] * cs[2] + v[2] * cs[3]; return o; }

#define LAUNDER(p) asm volatile("" : "+v"(p))
struct EpiNull { static constexpr bool PERM = true, MIDK = false;
    __device__ __forceinline__ void midk(f32x4 (&)[2][2][4][2], const Unit&, int, int) const {}
    __device__ __forceinline__ void operator()(const f32x4 (&acc)[2][2][4][2], const Unit& u, int wr, int wc, int fr, int fq) const {
#pragma unroll
        for (int ai = 0; ai < 2; ++ai)
#pragma unroll
            for (int bj = 0; bj < 2; ++bj)
                asm volatile("" :: "v"(acc[ai][bj][0][0]), "v"(acc[ai][bj][0][1]), "v"(acc[ai][bj][1][0]), "v"(acc[ai][bj][1][1]), "v"(acc[ai][bj][2][0]), "v"(acc[ai][bj][2][1]), "v"(acc[ai][bj][3][0]), "v"(acc[ai][bj][3][1]));
    } };
struct EpiWin {
    static constexpr bool PERM = true, MIDK = false;
    const float* rstd_x; bf16_t* X; bf16_t* qlat; bf16_t* kvlat; bf16_t* krope; float* stQ; float* stKV; const float* ropetab;
    __device__ __forceinline__ void midk(f32x4 (&)[2][2][4][2], const Unit&, int, int) const {}
    __device__ __forceinline__ void operator()(const f32x4 (&acc)[2][2][4][2], const Unit& u, int wr, int wc, int fr, int fq) const {
        EPI_ROWS; const int tile = u.pn;
        const GAS float* rsp = (const GAS float*)(rstd_x + row0); LAUNDER(rsp);
        if (tile < 8) {
            const int c0 = tile * 256 + wc * 32 + 8 * fq;
            GAS bf16_t* xp0 = (GAS bf16_t*)X + ((size_t)((c0 >> 4) * NCHUNK + (row0 >> 4)) * 512 + 256 + (row0 & 15) * 16 + (c0 & 15)); LAUNDER(xp0);
#pragma unroll
            for (int ai = 0; ai < 2; ++ai)
#pragma unroll
                for (int m = 0; m < 4; ++m) { const float rs = rsp[ai * 128 + m * 16];
#pragma unroll
                    for (int bj = 0; bj < 2; ++bj)
                        *(GAS u32x4*)(xp0 + ((size_t)(bj * 8) * NCHUNK + ai * 8 + m) * 512) = pack8(acc[ai][bj][m][0] * rs, acc[ai][bj][m][1] * rs); }
        } else if (tile < 14) {
            const bool isq = tile < 12; const int tl = isq ? tile - 8 : tile - 12; const int ld = isq ? QLAT : KVLAT;
            const int c0 = tl * 256 + wc * 32 + 8 * fq;
            GAS bf16_t* op = (GAS bf16_t*)(isq ? qlat : kvlat) + (size_t)row0 * ld + c0; GAS float* sp = (GAS float*)(isq ? stQ + (size_t)row0 * 16 : stKV + (size_t)row0 * 8) + tl * 4 + wc; LAUNDER(op); LAUNDER(sp);
#pragma unroll
            for (int ai = 0; ai < 2; ++ai)
#pragma unroll
                for (int m = 0; m < 4; ++m) { const float rs = rsp[ai * 128 + m * 16]; float ss = 0.f;
#pragma unroll
                    for (int bj = 0; bj < 2; ++bj) { const f32x4 v0 = acc[ai][bj][m][0] * rs, v1 = acc[ai][bj][m][1] * rs; ss += sq8(v0, v1);
                        if (c0 + bj * 128 < ld) *(GAS u32x4*)(op + (size_t)(ai * 128 + m * 16) * ld + bj * 128) = pack8(v0, v1); }
                    ss = red_fq(ss); if (fq == 0) sp[(size_t)(ai * 128 + m * 16) * (isq ? 16 : 8)] = ss; }
        } else {
            if (wc < 2) { const int c = wc * 32 + 8 * fq;
                GAS bf16_t* op = (GAS bf16_t*)krope + (size_t)row0 * 64 + c; LAUNDER(op);
#pragma unroll
                for (int ai = 0; ai < 2; ++ai)
#pragma unroll
                    for (int m = 0; m < 4; ++m) { const int row = row0 + ai * 128 + m * 16; const float rs = rsp[ai * 128 + m * 16]; const int pos = pos_of(row);
                        const f32x4 cs0 = *(const GAS f32x4*)((const GAS float*)ropetab + (size_t)pos * 64 + c), cs1 = *(const GAS f32x4*)((const GAS float*)ropetab + (size_t)pos * 64 + c + 4);
                        const f32x4 v0 = rope4(acc[ai][0][m][0] * rs, cs0), v1 = rope4(acc[ai][0][m][1] * rs, cs1);
                        *(GAS u32x4*)(op + (size_t)(ai * 128 + m * 16) * 64) = pack8(v0, v1); } }
        }
    }
};
struct EpiSsm1 {
    static constexpr bool PERM = true, MIDK = false;
    bf16_t* X;
    __device__ __forceinline__ void midk(f32x4 (&)[2][2][4][2], const Unit&, int, int) const {}
    __device__ __forceinline__ void operator()(const f32x4 (&acc)[2][2][4][2], const Unit& u, int wr, int wc, int fr, int fq) const {
        EPI_ROWS; GAS bf16_t* op = (GAS bf16_t*)X + (size_t)row0 * 512 + wc * 32 + 8 * fq; LAUNDER(op);
#pragma unroll
        for (int ai = 0; ai < 2; ++ai)
#pragma unroll
            for (int m = 0; m < 4; ++m)
#pragma unroll
                for (int bj = 0; bj < 2; ++bj) *(GAS u32x4*)(op + (size_t)(ai * 128 + m * 16) * 512 + bj * 128) = pack8(acc[ai][bj][m][0], acc[ai][bj][m][1]);
    }
};
struct EpiSsm2 {
    static constexpr bool PERM = true, MIDK = false;
    bf16_t* gact;
    __device__ __forceinline__ void midk(f32x4 (&)[2][2][4][2], const Unit&, int, int) const {}
    __device__ __forceinline__ void operator()(const f32x4 (&acc)[2][2][4][2], const Unit& u, int wr, int wc, int fr, int fq) const {
        EPI_ROWS; const int g = u.pn; const int c0 = wc * 32 + 8 * fq;
        GAS bf16_t* op = (GAS bf16_t*)gact + ((size_t)(row0 - g * NCHUNK) * 16 + (c0 >> 4)) * MIXW + g * 16 + (c0 & 15); LAUNDER(op);
#pragma unroll
        for (int ai = 0; ai < 2; ++ai)
#pragma unroll
            for (int m = 0; m < 4; ++m)
#pragma unroll
                for (int bj = 0; bj < 2; ++bj) { f32x4 v0 = acc[ai][bj][m][0], v1 = acc[ai][bj][m][1];
#pragma unroll
                    for (int e = 0; e < 4; ++e) { v0[e] = gelu_tanh(v0[e]); v1[e] = gelu_tanh(v1[e]); }
                    *(GAS u32x4*)(op + ((size_t)(ai * 128 + m * 16) * 16 + bj * 8) * MIXW) = pack8(v0, v1); }
    }
};
struct EpiQ {
    static constexpr bool PERM = true, MIDK = false;
    const float* rstd_q; bf16_t* q; const float* ropetab;
    __device__ __forceinline__ void midk(f32x4 (&)[2][2][4][2], const Unit&, int, int) const {}
    __device__ __forceinline__ void operator()(const f32x4 (&acc)[2][2][4][2], const Unit& u, int wr, int wc, int fr, int fq) const {
        EPI_ROWS; const GAS float* rsp = (const GAS float*)(rstd_q + row0); GAS bf16_t* op = (GAS bf16_t*)q + (size_t)row0 * QW + u.pn * 256 + wc * 32 + 8 * fq; LAUNDER(rsp); LAUNDER(op);
#pragma unroll
        for (int ai = 0; ai < 2; ++ai)
#pragma unroll
            for (int m = 0; m < 4; ++m) { const int row = row0 + ai * 128 + m * 16; const float rs = rsp[ai * 128 + m * 16]; const int pos = pos_of(row);
#pragma unroll
                for (int bj = 0; bj < 2; ++bj) { const int strip = 8 * u.pn + 4 * bj + wc, s6 = strip % 6;
                    f32x4 v0 = acc[ai][bj][m][0] * rs, v1 = acc[ai][bj][m][1] * rs;
                    if (s6 >= 4) { const int pc = (s6 - 4) * 32 + 8 * fq;
                        const f32x4 cs0 = *(const GAS f32x4*)((const GAS float*)ropetab + (size_t)pos * 64 + pc), cs1 = *(const GAS f32x4*)((const GAS float*)ropetab + (size_t)pos * 64 + pc + 4);
                        v0 = rope4(v0, cs0); v1 = rope4(v1, cs1); }
                    *(GAS u32x4*)(op + (size_t)(ai * 128 + m * 16) * QW + bj * 128) = pack8(v0, v1); } }
    }
};
struct EpiKV {
    static constexpr bool PERM = true, MIDK = false;
    const float* rstd_kv; bf16_t* kv;
    __device__ __forceinline__ void midk(f32x4 (&)[2][2][4][2], const Unit&, int, int) const {}
    __device__ __forceinline__ void operator()(const f32x4 (&acc)[2][2][4][2], const Unit& u, int wr, int wc, int fr, int fq) const {
        EPI_ROWS; const GAS float* rsp = (const GAS float*)(rstd_kv + row0); GAS bf16_t* op = (GAS bf16_t*)kv + (size_t)row0 * KVW + u.pn * 256 + wc * 32 + 8 * fq; LAUNDER(rsp); LAUNDER(op);
#pragma unroll
        for (int ai = 0; ai < 2; ++ai)
#pragma unroll
            for (int m = 0; m < 4; ++m) { const float rs = rsp[ai * 128 + m * 16];
#pragma unroll
                for (int bj = 0; bj < 2; ++bj) *(GAS u32x4*)(op + (size_t)(ai * 128 + m * 16) * KVW + bj * 128) = pack8(acc[ai][bj][m][0] * rs, acc[ai][bj][m][1] * rs); }
    }
};
struct EpiGlu {
    static constexpr bool PERM = true, MIDK = false;
    const bf16_t* gact; bf16_t* merged; float* stA;
    __device__ __forceinline__ void midk(f32x4 (&)[2][2][4][2], const Unit&, int, int) const {}
    __device__ __forceinline__ void operator()(const f32x4 (&acc)[2][2][4][2], const Unit& u, int wr, int wc, int fr, int fq) const {
        EPI_ROWS; const int c0 = u.pn * 256 + wc * 32 + 8 * fq;
        const GAS bf16_t* gp = (const GAS bf16_t*)gact + (size_t)row0 * MIXW + c0; GAS bf16_t* op = (GAS bf16_t*)merged + (size_t)row0 * DM + c0; GAS float* sp = (GAS float*)stA + (size_t)row0 * 32 + u.pn * 4 + wc; LAUNDER(gp); LAUNDER(op); LAUNDER(sp);
#pragma unroll
        for (int ai = 0; ai < 2; ++ai)
#pragma unroll
            for (int m = 0; m < 4; ++m) { float ss = 0.f;
#pragma unroll
                for (int bj = 0; bj < 2; ++bj) {
                    const u32x4 gw = *(const GAS u32x4*)(gp + (size_t)(ai * 128 + m * 16) * MIXW + bj * 128);
                    f32x4 v0, v1; const f32x4 a0 = acc[ai][bj][m][0], a1 = acc[ai][bj][m][1];
                    v0[0] = bflo(gw.x) * sigmoidf_fast(a0[0]); v0[1] = bfhi(gw.x) * sigmoidf_fast(a0[1]); v0[2] = bflo(gw.y) * sigmoidf_fast(a0[2]); v0[3] = bfhi(gw.y) * sigmoidf_fast(a0[3]);
                    v1[0] = bflo(gw.z) * sigmoidf_fast(a1[0]); v1[1] = bfhi(gw.z) * sigmoidf_fast(a1[1]); v1[2] = bflo(gw.w) * sigmoidf_fast(a1[2]); v1[3] = bfhi(gw.w) * sigmoidf_fast(a1[3]);
                    ss += sq8(v0, v1);
                    *(GAS u32x4*)(op + (size_t)(ai * 128 + m * 16) * DM + bj * 128) = pack8(v0, v1); }
                ss = red_fq(ss); if (fq == 0) sp[(size_t)(ai * 128 + m * 16) * 32] = ss; }
    }
};
struct EpiWout {
    static constexpr bool PERM = true, MIDK = true;
    const float* xp; const float* xs; const float* r2; const float* ratio; bf16_t* x1b; float* stA;
    __device__ __forceinline__ void midk(f32x4 (&acc)[2][2][4][2], const Unit& u, int wr, int fr) const {
        EPI_ROWS; const GAS float* rp = (const GAS float*)(ratio + row0); LAUNDER(rp);
#pragma unroll
        for (int ai = 0; ai < 2; ++ai)
#pragma unroll
            for (int m = 0; m < 4; ++m) { const float rt = rp[ai * 128 + m * 16];
#pragma unroll
                for (int bj = 0; bj < 2; ++bj)
#pragma unroll
                    for (int n = 0; n < 2; ++n) acc[ai][bj][m][n] *= rt; }
    }
    __device__ __forceinline__ void operator()(const f32x4 (&acc)[2][2][4][2], const Unit& u, int wr, int wc, int fr, int fq) const {
        EPI_ROWS; const int c0 = u.pn * 256 + wc * 32 + 8 * fq; const int rowt = u.pm * 256;
        const GAS float* xin = (const GAS float*)(rowt < 16384 ? xp + (size_t)row0 * DM : xs + (size_t)(row0 - 16384) * DM) + c0;
        const GAS float* rsp = (const GAS float*)(r2 + row0); GAS bf16_t* bo = (GAS bf16_t*)x1b + (size_t)row0 * DM + c0; GAS float* sp = (GAS float*)stA + (size_t)row0 * 64 + u.pn * 4 + wc;
        LAUNDER(xin); LAUNDER(rsp); LAUNDER(bo); LAUNDER(sp);
#pragma unroll
        for (int ai = 0; ai < 2; ++ai)
#pragma unroll
            for (int m = 0; m < 4; ++m) { const float rs = rsp[ai * 128 + m * 16]; float ss = 0.f; const size_t ro = (size_t)(ai * 128 + m * 16) * DM;
#pragma unroll
                for (int bj = 0; bj < 2; ++bj) {
                    const f32x4 v0 = *(const GAS f32x4*)(xin + ro + bj * 128) + acc[ai][bj][m][0] * rs, v1 = *(const GAS f32x4*)(xin + ro + bj * 128 + 4) + acc[ai][bj][m][1] * rs;
                    ss += sq8(v0, v1);
                    *(GAS u32x4*)(bo + ro + bj * 128) = pack8(v0, v1); }
                ss = red_fq(ss); if (fq == 0) sp[(size_t)(ai * 128 + m * 16) * 64] = ss; }
    }
};
__device__ __forceinline__ float dpp_ror1(float v) { return __builtin_bit_cast(float, __builtin_amdgcn_update_dpp(0, __builtin_bit_cast(int, v), 0x121, 0xf, 0xf, false)); }
__device__ __forceinline__ float dpp_rol1(float v) { return __builtin_bit_cast(float, __builtin_amdgcn_update_dpp(0, __builtin_bit_cast(int, v), 0x12f, 0xf, 0xf, false)); }
struct EpiFfnA {
    static constexpr bool PERM = true, MIDK = false;
    const float* rstd; int row_base; bf16_t* act; bf16_t* halo_up; bf16_t* halo_gate; const float* cw; const float* cb;
    __device__ __forceinline__ void midk(f32x4 (&)[2][2][4][2], const Unit&, int, int) const {}
    __device__ __forceinline__ void operator()(const f32x4 (&acc)[2][2][4][2], const Unit& u, int wr, int wc, int fr, int fq) const {
        EPI_ROWS; const int f0 = u.pn * 128 + wc * 32 + 8 * fq;
        const GAS float* rsp = (const GAS float*)(rstd + row_base + row0); GAS bf16_t* actp = (GAS bf16_t*)act + (size_t)row0 * DFF + f0;
        const int strip0 = u.pm * 4 + wr;
        GAS bf16_t* hup_p = (GAS bf16_t*)halo_up + (size_t)strip0 * 4 * DFF + f0; GAS bf16_t* hg_p = (GAS bf16_t*)halo_gate + (size_t)strip0 * 2 * DFF + f0;
        const GAS float* cwp = (const GAS float*)(cw + f0); const GAS float* cbp = (const GAS float*)(cb + f0);
        asm volatile("" : "+v"(rsp), "+v"(actp), "+v"(hup_p), "+v"(hg_p), "+v"(cwp), "+v"(cbp));
#pragma unroll
        for (int ai = 0; ai < 2; ++ai) {
            float rs[4];
#pragma unroll
            for (int m = 0; m < 4; ++m) rs[m] = rsp[ai * 128 + m * 16];
#pragma unroll
            for (int n = 0; n < 2; ++n) {
                const f32x4 w0 = *(const GAS f32x4*)(cwp + 4 * n), w1 = *(const GAS f32x4*)(cwp + DFF + 4 * n), w2 = *(const GAS f32x4*)(cwp + 2 * DFF + 4 * n), wb = *(const GAS f32x4*)(cbp + 4 * n);
                f32x4 res[4], Uu[4];
#pragma unroll
                for (int e = 0; e < 4; ++e) {
                    float U[4], R[4], L[4];
#pragma unroll
                    for (int m = 0; m < 4; ++m) { U[m] = acc[ai][0][m][n][e] * rs[m]; R[m] = dpp_ror1(U[m]); L[m] = dpp_rol1(U[m]); Uu[m][e] = U[m]; }
#pragma unroll
                    for (int m = 0; m < 4; ++m) {
                        const float prev = (fr == 0) ? R[m > 0 ? m - 1 : 0] : R[m];
                        const float next = (fr == 15) ? L[m < 3 ? m + 1 : 3] : L[m];
                        const float cv = w0[e] * prev + w1[e] * U[m] + w2[e] * next + wb[e];
                        res[m][e] = cv * sigmoidf_fast(cv) * (acc[ai][1][m][n][e] * rs[m]);
                    }
                }
#pragma unroll
                for (int m = 0; m < 4; ++m) {
                    const bool edge = (m == 0 && fr == 0) || (m == 3 && fr == 15);
                    if (!edge) { u32x2 w; w.x = cvt_pk_bf16(res[m][0], res[m][1]); w.y = cvt_pk_bf16(res[m][2], res[m][3]); *(GAS u32x2*)(actp + (size_t)(ai * 128 + m * 16) * DFF + 4 * n) = w; }
                    if (m == 0 || m == 3) {
                        const int hs = (m == 0) ? (fr == 0 ? 0 : (fr == 1 ? 1 : -1)) : (fr == 14 ? 2 : (fr == 15 ? 3 : -1));
                        if (hs >= 0) { u32x2 w; w.x = cvt_pk_bf16(Uu[m][0], Uu[m][1]); w.y = cvt_pk_bf16(Uu[m][2], Uu[m][3]);
                            *(GAS u32x2*)(hup_p + ((size_t)(ai * 2) * 4 + hs) * DFF + 4 * n) = w;
                            if (hs == 0 || hs == 3) { const f32x4 gv = acc[ai][1][m][n] * rs[m]; u32x2 wg; wg.x = cvt_pk_bf16(gv[0], gv[1]); wg.y = cvt_pk_bf16(gv[2], gv[3]);
                                *(GAS u32x2*)(hg_p + ((size_t)(ai * 2) * 2 + (hs == 3 ? 1 : 0)) * DFF + 4 * n) = wg; } }
                    }
                }
            }
        }
    }
};
struct EpiDown {
    static constexpr bool PERM = true, MIDK = false;
    bf16_t* xb; int row_base; float* stA;
    __device__ __forceinline__ void midk(f32x4 (&)[2][2][4][2], const Unit&, int, int) const {}
    __device__ __forceinline__ void operator()(const f32x4 (&acc)[2][2][4][2], const Unit& u, int wr, int wc, int fr, int fq) const {
        EPI_ROWS; GAS bf16_t* xo = (GAS bf16_t*)xb + (size_t)(row_base + row0) * DM + u.pn * 256 + wc * 32 + 8 * fq; GAS float* sp = (GAS float*)stA + (size_t)(row_base + row0) * 64 + u.pn * 4 + wc; LAUNDER(xo); LAUNDER(sp);
#pragma unroll
        for (int ai = 0; ai < 2; ++ai)
#pragma unroll
            for (int m = 0; m < 4; ++m) { float ss = 0.f; const size_t ro = (size_t)(ai * 128 + m * 16) * DM;
#pragma unroll
                for (int bj = 0; bj < 2; ++bj) { GAS bf16_t* p = xo + ro + bj * 128; const u32x4 w = *(const GAS u32x4*)p; const f32x4 a0 = acc[ai][bj][m][0], a1 = acc[ai][bj][m][1];
                    f32x4 v0, v1; v0[0] = bflo(w.x) + a0[0]; v0[1] = bfhi(w.x) + a0[1]; v0[2] = bflo(w.y) + a0[2]; v0[3] = bfhi(w.y) + a0[3];
                    v1[0] = bflo(w.z) + a1[0]; v1[1] = bfhi(w.z) + a1[1]; v1[2] = bflo(w.w) + a1[2]; v1[3] = bfhi(w.w) + a1[3];
                    ss += sq8(v0, v1); *(GAS u32x4*)p = pack8(v0, v1); }
                ss = red_fq(ss); if (fq == 0) sp[(size_t)(ai * 128 + m * 16) * 64] = ss; }
    }
};
#undef EPI_ROWS
}

namespace attn {
using s16x4  = __attribute__((ext_vector_type(4))) short;
using f32x16 = __attribute__((ext_vector_type(16))) float;
using u32x4  = __attribute__((ext_vector_type(4))) unsigned;
constexpr int NW = 8, QBLK = 32, KVBLK = 64;
constexpr float SCALE = 0.07216878364870322f;
constexpr float THR = 8.f;
constexpr int LDQ = 3072, LDK = 4096, LDR = 64, LDO = 4096;
constexpr int SHM_V = KVBLK * 128 * 2, SHM_K = KVBLK * 128 * 2, SHM_R = KVBLK * 64 * 2;
constexpr int OFF_V = 0, OFF_K = 2 * SHM_V, OFF_R = OFF_K + 2 * SHM_K, OFF_WS = OFF_R + 2 * SHM_R, OFF_QR = OFF_WS + NW * 64 * 4, SHM_ATTN = OFF_QR + NW * 4096;
#define KSWZ(row, colB) ((row) * 256 + ((colB) ^ (((row) & 7) << 4)))
#define RSWZ(row, ch) ((row) * 128 + ((((ch) ^ (((row) >> 1) & 7))) << 4))
#define SBAR() __builtin_amdgcn_sched_barrier(0)
__device__ __forceinline__ int crow(int r, int hi) { return (r & 3) + 8 * (r >> 2) + 4 * hi; }
__device__ __forceinline__ unsigned cvtpk(float lo, float hi) { unsigned r; asm volatile("v_cvt_pk_bf16_f32 %0, %1, %2" : "=v"(r) : "v"(lo), "v"(hi)); return r; }

__device__ __forceinline__ void partialSM(f32x16& p0, f32x16& p1, float& m_reg, float& mn, float& alpha) {
  constexpr float C = SCALE * 1.4426950408889634f;
  float pmax = p0[0];
#pragma unroll
  for (int r = 1; r < 16; ++r) pmax = fmaxf(pmax, p0[r]);
#pragma unroll
  for (int r = 0; r < 16; ++r) pmax = fmaxf(pmax, p1[r]);
  { auto rr = __builtin_amdgcn_permlane32_swap(__float_as_uint(pmax), __float_as_uint(pmax), false, false);
    pmax = fmaxf(__uint_as_float(rr[0]), __uint_as_float(rr[1])); }
  if (__builtin_expect(__all(pmax - m_reg <= THR / SCALE), 1)) { mn = m_reg; alpha = 1.f; }
  else { mn = fmaxf(m_reg, pmax); alpha = __builtin_amdgcn_exp2f((m_reg - mn) * C); m_reg = mn; }
  float mnC = -mn * C;
#pragma unroll
  for (int r = 0; r < 16; ++r) p0[r] = fmaf(p0[r], C, mnC);
#pragma unroll
  for (int r = 0; r < 16; ++r) p1[r] = fmaf(p1[r], C, mnC);
#pragma unroll
  for (int r = 0; r < 16; ++r) p0[r] = __builtin_amdgcn_exp2f(p0[r]);
}
__device__ __forceinline__ void finishSM(f32x16& p0, f32x16& p1, float alpha, float& l_reg, bf16x8& pa0, bf16x8& pa1, bf16x8& pa2, bf16x8& pa3) {
#pragma unroll
  for (int r = 0; r < 16; ++r) p1[r] = __builtin_amdgcn_exp2f(p1[r]);
  float ps = 0;
#pragma unroll
  for (int r = 0; r < 16; ++r) ps += p0[r];
#pragma unroll
  for (int r = 0; r < 16; ++r) ps += p1[r];
  { auto rr = __builtin_amdgcn_permlane32_swap(__float_as_uint(ps), __float_as_uint(ps), false, false);
    ps = __uint_as_float(rr[0]) + __uint_as_float(rr[1]); }
  l_reg = l_reg * alpha + ps;
#define PK4(P, BASE, OUT) do { unsigned a0 = cvtpk(P[BASE + 0], P[BASE + 1]), a1 = cvtpk(P[BASE + 2], P[BASE + 3]);   \
    unsigned b0 = cvtpk(P[BASE + 4], P[BASE + 5]), b1 = cvtpk(P[BASE + 6], P[BASE + 7]);                              \
    auto r0 = __builtin_amdgcn_permlane32_swap(a0, b0, false, false); auto r1 = __builtin_amdgcn_permlane32_swap(a1, b1, false, false); \
    u32x4 w = {r0[0], r1[0], r0[1], r1[1]}; OUT = *reinterpret_cast<bf16x8*>(&w); } while (0)
  PK4(p0, 0, pa0); PK4(p0, 8, pa1); PK4(p1, 0, pa2); PK4(p1, 8, pa3);
#undef PK4
}
__device__ __forceinline__ void qkt(f32x16& p0, f32x16& p1, const char* Ks, const char* Rs, const bf16x8* qr, const char* qrl, int r32, int hi) {
  p0 = f32x16{}; p1 = f32x16{};
#pragma unroll
  for (int g4 = 0; g4 < 2; ++g4) {
#pragma unroll
    for (int dd = 0; dd < 4; ++dd) { const int d0 = g4 * 4 + dd; const int cb = (d0 * 16 + hi * 8) * 2;
      bf16x8 b0 = *reinterpret_cast<const bf16x8*>(Ks + KSWZ(r32, cb));
      bf16x8 b1 = *reinterpret_cast<const bf16x8*>(Ks + KSWZ(32 + r32, cb));
      p0 = __builtin_amdgcn_mfma_f32_32x32x16_bf16(b0, qr[d0], p0, 0, 0, 0);
      p1 = __builtin_amdgcn_mfma_f32_32x32x16_bf16(b1, qr[d0], p1, 0, 0, 0); }
    SBAR();
  }
#pragma unroll
  for (int d0 = 0; d0 < 4; ++d0) { const int ch = d0 * 2 + hi;
    bf16x8 b0 = *reinterpret_cast<const bf16x8*>(Rs + RSWZ(r32, ch));
    bf16x8 b1 = *reinterpret_cast<const bf16x8*>(Rs + RSWZ(32 + r32, ch));
    const bf16x8 qf = *reinterpret_cast<const bf16x8*>(qrl + d0 * 1024);
    p0 = __builtin_amdgcn_mfma_f32_32x32x16_bf16(b0, qf, p0, 0, 0, 0);
    p1 = __builtin_amdgcn_mfma_f32_32x32x16_bf16(b1, qf, p1, 0, 0, 0); }
}
__device__ __forceinline__ int v_st(int k, int c) { const int kk = (k & ~0xC) | ((k & 4) << 1) | ((k & 8) >> 1); return ((kk >> 3) * 4 + (c >> 5)) * 512 + ((kk & 7) * 32 + (c & 31)) * 2; }
__device__ __forceinline__ int v_rd_base(int lane) { return ((lane & 3) << 3) | (((lane >> 2) & 3) << 6) | (((lane >> 4) & 1) << 5) | (((lane >> 5) & 1) << 8); }
constexpr int v_rd_off(int d0, int ks, int half) { return d0 * 512 + ks * 4096 + half * 2048; }
template <int OFF> __device__ __forceinline__ s16x4 tr_read(int vb) {
  s16x4 r; asm volatile("ds_read_b64_tr_b16 %0, %1 offset:%2" : "=&v"(r) : "v"(vb), "i"(OFF) : "memory"); return r;
}
template <int D0> __device__ __forceinline__ void pv_one(f32x16& od, int vb, bf16x8 pa0, bf16x8 pa1, bf16x8 pa2, bf16x8 pa3) {
  const s16x4 l0 = tr_read<v_rd_off(D0, 0, 0)>(vb), h0 = tr_read<v_rd_off(D0, 0, 1)>(vb), l1 = tr_read<v_rd_off(D0, 1, 0)>(vb), h1 = tr_read<v_rd_off(D0, 1, 1)>(vb);
  const s16x4 l2 = tr_read<v_rd_off(D0, 2, 0)>(vb), h2 = tr_read<v_rd_off(D0, 2, 1)>(vb), l3 = tr_read<v_rd_off(D0, 3, 0)>(vb), h3 = tr_read<v_rd_off(D0, 3, 1)>(vb);
  asm volatile("s_waitcnt lgkmcnt(0)" ::: "memory"); SBAR();
#define PK(L, H) (bf16x8){L[0], L[1], L[2], L[3], H[0], H[1], H[2], H[3]}
  od = __builtin_amdgcn_mfma_f32_32x32x16_bf16(pa0, PK(l0, h0), od, 0, 0, 0);
  od = __builtin_amdgcn_mfma_f32_32x32x16_bf16(pa1, PK(l1, h1), od, 0, 0, 0);
  od = __builtin_amdgcn_mfma_f32_32x32x16_bf16(pa2, PK(l2, h2), od, 0, 0, 0);
  od = __builtin_amdgcn_mfma_f32_32x32x16_bf16(pa3, PK(l3, h3), od, 0, 0, 0);
#undef PK
}
__device__ __forceinline__ void pv_d0(f32x16* o, int vb, bf16x8 pa0, bf16x8 pa1, bf16x8 pa2, bf16x8 pa3) {
  pv_one<0>(o[0], vb, pa0, pa1, pa2, pa3); pv_one<1>(o[1], vb, pa0, pa1, pa2, pa3); pv_one<2>(o[2], vb, pa0, pa1, pa2, pa3); pv_one<3>(o[3], vb, pa0, pa1, pa2, pa3);
}

__device__ __forceinline__ void attn_unit(const bf16* __restrict__ Qb, const bf16* __restrict__ Kh, const bf16* __restrict__ Vh, const bf16* __restrict__ Rh,
                                          bf16* __restrict__ Ob, float* __restrict__ st, int seq, char* lds) {
  int tid_l = threadIdx.x; asm volatile("" : "+v"(tid_l));
  const int tid = tid_l, wid = tid >> 6, lane = tid & 63, r32 = lane & 31, hi = lane >> 5;
  char* V_lds = lds + OFF_V; char* K_lds = lds + OFF_K; char* R_lds = lds + OFF_R;
  float* ws = (float*)(lds + OFF_WS) + wid * 64; float* li_l = ws; float* al_l = ws + 32;
  float m_reg = -1e30f, l_reg = 0; f32x16 o[4] = {}; bf16x8 qr[8];
  const bf16* Qw = Qb + (long)(wid * QBLK + r32) * LDQ + hi * 8;
#pragma unroll
  for (int d0 = 0; d0 < 8; ++d0) qr[d0] = *reinterpret_cast<const bf16x8*>(Qw + d0 * 16);
  char* qrl = lds + OFF_QR + wid * 4096 + lane * 16;
#pragma unroll
  for (int d0 = 0; d0 < 4; ++d0) *reinterpret_cast<bf16x8*>(qrl + d0 * 1024) = *reinterpret_cast<const bf16x8*>(Qw + (8 + d0) * 16);
  const int sr = tid >> 4, sc = (tid & 15) * 8, vst0 = v_st(sr, sc), vst1 = v_st(32 + sr, sc);
  const int rr_ = tid >> 3, rch = tid & 7, rst = RSWZ(rr_, rch);
  const int vb0 = (int)(uintptr_t)V_lds + v_rd_base(lane);
  struct { bf16x8 vs0, vs1, ks0, ks1, rs0; } sr_[1];
#define SLOAD(i, k0) do { sr_[i].vs0 = *reinterpret_cast<const bf16x8*>(&Vh[(long)((k0) + sr) * LDK + sc]); sr_[i].vs1 = *reinterpret_cast<const bf16x8*>(&Vh[(long)((k0) + 32 + sr) * LDK + sc]); \
    sr_[i].ks0 = *reinterpret_cast<const bf16x8*>(&Kh[(long)((k0) + sr) * LDK + sc]); sr_[i].ks1 = *reinterpret_cast<const bf16x8*>(&Kh[(long)((k0) + 32 + sr) * LDK + sc]); \
    sr_[i].rs0 = *reinterpret_cast<const bf16x8*>(&Rh[(long)((k0) + rr_) * LDR + rch * 8]); } while (0)
#define SWRITE(b, i) do { *(bf16x8*)(V_lds + (b) * SHM_V + vst0) = sr_[i].vs0;          \
    *(bf16x8*)(V_lds + (b) * SHM_V + vst1) = sr_[i].vs1; int kc = sc * 2;               \
    *(bf16x8*)(K_lds + (b) * SHM_K + KSWZ(sr, kc)) = sr_[i].ks0;                       \
    *(bf16x8*)(K_lds + (b) * SHM_K + KSWZ(32 + sr, kc)) = sr_[i].ks1;                  \
    *(bf16x8*)(R_lds + (b) * SHM_R + rst) = sr_[i].rs0; } while (0)
#define SWAIT() asm volatile("s_waitcnt vmcnt(0)" ::: "memory")
#define RESC(a) do { if (__any((a) < 1.f)) { if (hi == 0) al_l[r32] = (a); asm volatile("s_waitcnt lgkmcnt(0)" ::: "memory"); \
    _Pragma("unroll") for (int d = 0; d < 4; ++d) _Pragma("unroll") for (int r = 0; r < 16; ++r) o[d][r] *= al_l[crow(r, hi)]; } } while (0)
  f32x16 pA0, pA1, pB0, pB1; float mnA, mnB, alA, alB; bf16x8 pa0, pa1, pa2, pa3; const int NT = seq / KVBLK;
  SLOAD(0, 0); asm volatile("s_waitcnt vmcnt(0)" ::: "memory"); SWRITE(0, 0); __syncthreads();
  qkt(pA0, pA1, K_lds, R_lds, qr, qrl, r32, hi); partialSM(pA0, pA1, m_reg, mnA, alA);
  SLOAD(0, KVBLK);
  SWAIT(); SWRITE(1, 0); __syncthreads();
#pragma unroll 1
  for (int j = 1; j + 1 < NT; j += 2) {
    SBAR(); qkt(pB0, pB1, K_lds + SHM_K, R_lds + SHM_R, qr, qrl, r32, hi);
    finishSM(pA0, pA1, alA, l_reg, pa0, pa1, pa2, pa3); SBAR();
    SLOAD(0, (j + 1) * KVBLK); SBAR();
    pv_d0(o, vb0, pa0, pa1, pa2, pa3); partialSM(pB0, pB1, m_reg, mnB, alB);
    __syncthreads(); SWAIT(); SWRITE(0, 0);
    RESC(alB); __syncthreads();
    SBAR(); qkt(pA0, pA1, K_lds, R_lds, qr, qrl, r32, hi);
    finishSM(pB0, pB1, alB, l_reg, pa0, pa1, pa2, pa3); SBAR();
    SLOAD(0, (j + 2) * KVBLK); SBAR();
    pv_d0(o, vb0 + SHM_V, pa0, pa1, pa2, pa3); partialSM(pA0, pA1, m_reg, mnA, alA);
    __syncthreads(); SWAIT(); SWRITE(1, 0);
    RESC(alA); __syncthreads();
  }
  SBAR(); qkt(pB0, pB1, K_lds + SHM_K, R_lds + SHM_R, qr, qrl, r32, hi);
  finishSM(pA0, pA1, alA, l_reg, pa0, pa1, pa2, pa3); SBAR();
  pv_d0(o, vb0, pa0, pa1, pa2, pa3); partialSM(pB0, pB1, m_reg, mnB, alB);
  __syncthreads(); RESC(alB);
  finishSM(pB0, pB1, alB, l_reg, pa0, pa1, pa2, pa3); SBAR();
  pv_d0(o, vb0 + SHM_V, pa0, pa1, pa2, pa3);
  if (hi == 0) li_l[r32] = l_reg; asm volatile("s_waitcnt lgkmcnt(0)" ::: "memory");
  GAS bf16* Ow = (GAS bf16*)Ob + (long)(wid * QBLK + 4 * hi) * LDO + r32; GAS float* stw = (GAS float*)st + (long)(wid * QBLK + 4 * hi) * 16;
  asm volatile("" : "+v"(Ow), "+v"(stw));
#pragma unroll
  for (int r = 0; r < 16; ++r) { const int ro = (r & 3) + 8 * (r >> 2); const float rl = __builtin_amdgcn_rcpf(li_l[ro + 4 * hi]); float ss = 0.f;
#pragma unroll
    for (int d0 = 0; d0 < 4; ++d0) { const float v = o[d0][r] * rl; ss += v * v; Ow[(long)ro * LDO + d0 * 32] = (bf16)f2bf(v); }
    ss += __shfl_xor(ss, 1); ss += __shfl_xor(ss, 2); ss += __shfl_xor(ss, 4); ss += __shfl_xor(ss, 8); ss += __shfl_xor(ss, 16);
    if (r32 == 0) stw[ro * 16] = ss; }
#undef SLOAD
#undef SWRITE
#undef SWAIT
#undef RESC
}
#undef KSWZ
#undef RSWZ
#undef SBAR
}

constexpr size_t MiB = 1u << 20;
constexpr size_t WS_CTL = 0, CTL_ZERO_BYTES = 1 * MiB;
constexpr size_t WS_RSTDX = 1 * MiB, WS_RSTDQ = WS_RSTDX + 98304, WS_RSTDKV = WS_RSTDQ + 98304, WS_R2 = WS_RSTDKV + 98304, WS_RATIO = WS_R2 + 98304, WS_RSTDX1 = WS_RATIO + 98304;
constexpr size_t WS_STA = 2 * MiB;
constexpr size_t WS_STB = 8 * MiB;
constexpr size_t WS_STQ = 10 * MiB;
constexpr size_t WS_STKV = 12 * MiB;
constexpr size_t WS_ROPE = 13 * MiB;
constexpr size_t WS_WIN = 16 * MiB;
constexpr size_t WS_WGLU = 46 * MiB;
constexpr size_t WS_WQ = 54 * MiB;
constexpr size_t WS_WKV = 60 * MiB;
constexpr size_t WS_WOUT = 64 * MiB;
constexpr size_t WS_WUG = 96 * MiB;
constexpr size_t WS_WDN = 268 * MiB;
constexpr size_t WS_W1T = 354 * MiB;
constexpr size_t WS_W2T = 370 * MiB;
constexpr size_t WS_A = 402 * MiB;
constexpr size_t WS_B = 594 * MiB;
constexpr size_t WS_QLAT = 786 * MiB, WS_KVLAT = 828 * MiB, WS_KROPE = 852 * MiB;
constexpr size_t WS_GACT = 856 * MiB;
constexpr size_t WS_HUP = 952 * MiB, WS_HGATE = 964 * MiB, WS_END = 970 * MiB;
static_assert(WS_HUP + (size_t)128 * 4 * DFF * 2 <= WS_HGATE && WS_HGATE + (size_t)128 * 2 * DFF * 2 <= WS_END, "halo");
constexpr size_t OUT_X = 0, OUT_KV = 192 * MiB;
constexpr int CW_BAR = 4096;

constexpr int NWAVES = 8;
constexpr int RING_BYTES = 131072, LDSCTL_OFF = RING_BYTES, MISC_OFF = LDSCTL_OFF + 320, LDS_BYTES = 147456;

typedef GAS unsigned gu32;
#define RLX_AGENT __ATOMIC_RELAXED, __HIP_MEMORY_SCOPE_AGENT
#define LDS_WAIT() asm volatile("s_waitcnt lgkmcnt(0)" ::: "memory")

#define XB_TMO      128
#define XB_XCNT(j)  (256  + 64 * (j))
#define XB_XSUB(j)  (1280 + 64 * (j))
#define XB_XGEN(j)  (2304 + 64 * (j))
#define XB_TOP      3328
#define XB_TOPGEN   3392
#define XCD_BAR_WORDS 3456
#define XB_SPIN_CAP (1u << 18)
__device__ __forceinline__ unsigned xb_ld(unsigned* p)              { return __hip_atomic_load(p, __ATOMIC_RELAXED, __HIP_MEMORY_SCOPE_AGENT); }
__device__ __forceinline__ unsigned xb_add(unsigned* p, unsigned v) { return __hip_atomic_fetch_add(p, v, __ATOMIC_RELAXED, __HIP_MEMORY_SCOPE_AGENT); }
__device__ __forceinline__ unsigned xb_xcc_id() { return (unsigned)__builtin_amdgcn_s_getreg((3 << 11) | 20) & 0xFu; }
#define XB_SPIN(cond, bar) do { unsigned _sp = 0; while (cond) { __builtin_amdgcn_s_sleep(1); \
    if ((++_sp & 255u) == 0u) { if (xb_ld(&(bar)[XB_TMO])) break; if (_sp > XB_SPIN_CAP) { atomicAdd(&(bar)[XB_TMO], 1u); break; } } } } while (0)
struct XcdBarrier { unsigned* bar; unsigned x; volatile LAS unsigned* st; };
__device__ __forceinline__ XcdBarrier xcd_barrier_post(unsigned* bar, volatile LAS unsigned* st) {
    XcdBarrier b; b.bar = bar; b.x = xb_xcc_id(); b.st = st;
    if (threadIdx.x == 0) (void)xb_add(&bar[XB_XCNT(b.x)], 1u);
    return b;
}
__device__ __forceinline__ void xcd_barrier_complete(unsigned* bar, unsigned x, unsigned& nloc, unsigned& nx) {
    const unsigned G = gridDim.x * gridDim.y * gridDim.z;
    unsigned sum, cnt, mine, sp = 0u;
    for (;;) {
        sum = 0u; cnt = 0u; mine = 0u;
#pragma unroll
        for (unsigned j = 0; j < 16; ++j) { const unsigned c = xb_ld(&bar[XB_XCNT(j)]); sum += c; cnt += (c > 0u) ? 1u : 0u; mine = (j == x) ? c : mine; }
        if (sum == G) break;
        __builtin_amdgcn_s_sleep(1);
        if ((++sp & 255u) == 0u) { if (xb_ld(&bar[XB_TMO])) break; if (sp > XB_SPIN_CAP) { atomicAdd(&bar[XB_TMO], 1u); break; } }
    }
    nloc = mine > 0u ? mine : 1u; nx = cnt > 0u ? cnt : 1u;
}
__device__ __forceinline__ void xcd_barrier(const XcdBarrier& b) {
    asm volatile("s_waitcnt vmcnt(0)" ::: "memory");
    __syncthreads();
    if (threadIdx.x == 0) {
        unsigned* bar = b.bar;
        __builtin_amdgcn_s_waitcnt(0);
        unsigned nloc = b.st[0], nx = b.st[1];
        if (nloc == 0u) { xcd_barrier_complete(bar, b.x, nloc, nx); b.st[0] = nloc; b.st[1] = nx; }
        const unsigned old = xb_add(&bar[XB_XSUB(b.x)], 1u);
        const unsigned gen = old / nloc;
        if (old + 1u == (gen + 1u) * nloc) {
            __builtin_amdgcn_fence(__ATOMIC_RELEASE, "agent");
            asm volatile("s_waitcnt vmcnt(0)" ::: "memory");
            const unsigned og = xb_add(&bar[XB_TOP], 1u);
            const unsigned tg = og / nx;
            if (og + 1u == (tg + 1u) * nx) xb_add(&bar[XB_TOPGEN], 1u);
            else XB_SPIN(xb_ld(&bar[XB_TOPGEN]) == tg, bar);
            __builtin_amdgcn_fence(__ATOMIC_ACQUIRE, "agent");
            xb_add(&bar[XB_XGEN(b.x)], 1u);
            asm volatile("s_waitcnt vmcnt(0)" ::: "memory");
        } else {
            XB_SPIN(xb_ld(&bar[XB_XGEN(b.x)]) == gen, bar);
            __builtin_amdgcn_fence(__ATOMIC_ACQUIRE, "agent");
            asm volatile("s_waitcnt vmcnt(0)" ::: "memory");
        }
    }
    __syncthreads();
}

__device__ __forceinline__ float wave_sum(float v) {
#pragma unroll
    for (int o = 1; o < 64; o <<= 1) v += __shfl_xor(v, o);
    return v;
}
template <class RowMap>
__device__ __forceinline__ void transpose_item(const float* W, int K, int N, bf16* WT, const float* g1, const float* g2, int ksplit, RowMap rm, LAS float* scr, int item, int lane) {
    const int nblk = N / 64, kb = item / nblk, nb = item % nblk, k0 = 64 * kb, n0 = 64 * nb;
    f32x2 wv[32];
    const GAS f32x2* wp = (const GAS f32x2*)((const GAS float*)W + (size_t)(k0 + (lane >> 5)) * N + n0) + (lane & 31);
#pragma unroll
    for (int i = 0; i < 32; ++i) wv[i] = *(const GAS f32x2*)((const GAS float*)wp + (size_t)(2 * i) * N);
    float gn[32];
#pragma unroll
    for (int i = 0; i < 32; ++i) { const int k = k0 + 2 * i + (lane >> 5); gn[i] = g1 ? (k < ksplit ? g1[k] : g2[k - ksplit]) : 1.0f; }
    const int c = lane & 7;
#pragma unroll
    for (int sub = 0; sub < 2; ++sub) {
#pragma unroll
        for (int i = 0; i < 32; ++i) { const int kk = 2 * i + (lane >> 5); scr[kk * 33 + (lane & 31)] = (sub ? wv[i].y : wv[i].x) * gn[i]; }
        LDS_WAIT(); asm volatile("" ::: "memory");
#pragma unroll
        for (int j = 0; j < 4; ++j) { const int nl = (lane >> 3) + 8 * j; const LAS float* s = scr + (8 * c) * 33 + nl;
            v4u o; o.x = pg8::cvt_pk_bf16(s[0 * 33], s[1 * 33]); o.y = pg8::cvt_pk_bf16(s[2 * 33], s[3 * 33]); o.z = pg8::cvt_pk_bf16(s[4 * 33], s[5 * 33]); o.w = pg8::cvt_pk_bf16(s[6 * 33], s[7 * 33]);
            *(GAS v4u*)(WT + (size_t)rm(n0 + 2 * nl + sub) * K + k0 + 8 * c) = o; }
        LDS_WAIT(); asm volatile("" ::: "memory");
    }
}
struct RmId  { __device__ __forceinline__ int operator()(int n) const { return n; } };
struct RmWin { __device__ __forceinline__ int operator()(int n) const { if (n < 2944) return n; if (n < 3456) return n + 128; const int i = n - 3456; return 3584 + (i < 32 ? 2 * i : 2 * (i - 32) + 1); } };
struct RmQ   { __device__ __forceinline__ int operator()(int n) const { const int r = n % 192, hb = n - r; if (r < 128) return n; const int i = r - 128; return hb + 128 + (i < 32 ? 2 * i : 2 * (i - 32) + 1); } };
struct RmUp  { __device__ __forceinline__ int operator()(int n) const { return (n >> 7) * 256 + (n & 127); } };
struct RmGate{ __device__ __forceinline__ int operator()(int n) const { return (n >> 7) * 256 + 128 + (n & 127); } };

__device__ __forceinline__ void sincos_d(double a, double& s, double& c) {
    const double kd = __builtin_rint(a * 0.63661977236758134308); const long k = (long)kd;
    double r = __builtin_fma(-kd, 1.57079632679489655800e+00, a); r = __builtin_fma(-kd, 6.12323399573676603587e-17, r);
    const double r2 = r * r;
    double sp = 1.0 / 6227020800.0; sp = sp * r2 - 1.0 / 39916800.0; sp = sp * r2 + 1.0 / 362880.0; sp = sp * r2 - 1.0 / 5040.0; sp = sp * r2 + 1.0 / 120.0; sp = sp * r2 - 1.0 / 6.0; sp = sp * r2 * r + r;
    double cp = 1.0 / 479001600.0; cp = cp * r2 - 1.0 / 3628800.0; cp = cp * r2 + 1.0 / 40320.0; cp = cp * r2 - 1.0 / 720.0; cp = cp * r2 + 1.0 / 24.0; cp = cp * r2 - 0.5; cp = cp * r2 + 1.0;
    const int q = (int)(k & 3);
    s = (q == 0) ? sp : (q == 1) ? cp : (q == 2) ? -sp : -cp;
    c = (q == 0) ? cp : (q == 1) ? -sp : (q == 2) ? -cp : sp;
}

__device__ __forceinline__ void ssm_weights_group(int g, const float* a_re, const float* a_im, const float* b_re, const float* b_im, const float* c_re, const float* c_im,
                                                  const float* log_dt, const float* dskip, bf16* W1t, bf16* W2t, LAS float* L, int tid) {
    LAS float* PW = L;
    LAS float* BB = PW + 2 * 17 * 64 * 2;
    LAS float* CC = BB + 2 * 64 * 16 * 2;
    LAS float* KT = CC + 2 * 16 * 64 * 2;
    for (int i = tid; i < 2 * 17 * 64; i += 512) { const int d = i / (17 * 64), e = (i / 64) % 17, p = i & 63;
        const double dt = exp((double)log_dt[d * 128 + g]); const double are = a_re[(d * 128 + g) * 64 + p], aim = a_im[(d * 128 + g) * 64 + p];
        const double mag = exp((double)e * dt * are); double s, c; sincos_d((double)e * dt * aim, s, c);
        PW[i * 2] = (float)(mag * c); PW[i * 2 + 1] = (float)(mag * s); }
    for (int i = tid; i < 2 * 64 * 16; i += 512) { const int d = i / 1024, p = (i >> 4) & 63, h = i & 15;
        const double dt = exp((double)log_dt[d * 128 + g]); const double are = a_re[(d * 128 + g) * 64 + p], aim = a_im[(d * 128 + g) * 64 + p];
        const double x = dt * are, y = dt * aim; double sy, cy, sh, ch; sincos_d(y, sy, cy); sincos_d(0.5 * y, sh, ch);
        const double em1 = expm1(x); const double re1 = em1 * cy - 2.0 * sh * sh, im1 = (em1 + 1.0) * sy;
        const double den = are * are + aim * aim; const double qre = (re1 * are + im1 * aim) / den, qim = (im1 * are - re1 * aim) / den;
        const size_t bi = ((size_t)((d * 128 + g) * 64 + p)) * 16 + h; const double br = b_re[bi], bim = b_im[bi];
        BB[i * 2] = (float)(qre * br - qim * bim); BB[i * 2 + 1] = (float)(qre * bim + qim * br); }
    for (int i = tid; i < 2 * 16 * 64; i += 512) { const int d = i / 1024, h = (i >> 6) & 15, p = i & 63; const size_t ci = ((size_t)((d * 128 + g) * 16 + h)) * 64 + p;
        CC[i * 2] = c_re[ci]; CC[i * 2 + 1] = c_im[ci]; }
    __syncthreads();
    { const int d = tid >> 8, e = (tid >> 4) & 15, h = tid & 15; float acc[16];
#pragma unroll
        for (int q = 0; q < 16; ++q) acc[q] = 0.f;
        for (int p = 0; p < 64; ++p) { const float cr = CC[((d * 16 + h) * 64 + p) * 2], ci = CC[((d * 16 + h) * 64 + p) * 2 + 1];
            const float pr = PW[((d * 17 + e) * 64 + p) * 2], pi = PW[((d * 17 + e) * 64 + p) * 2 + 1];
            const float tr = cr * pr - ci * pi, ti = cr * pi + ci * pr; const LAS f32x4* bp = (const LAS f32x4*)(BB + ((d * 64 + p) * 16) * 2);
#pragma unroll
            for (int q = 0; q < 8; ++q) { const f32x4 b = bp[q]; acc[2 * q] += tr * b[0] - ti * b[1]; acc[2 * q + 1] += tr * b[2] - ti * b[3]; } }
#pragma unroll
        for (int q = 0; q < 16; ++q) KT[((d * 16 + e) * 16 + h) * 16 + q] = acc[q]; }
    __syncthreads();
    for (int i = tid; i < 256 * 32; i += 512) { const int n = i >> 5, k0 = (i & 31) * 8; const int d = n >> 7, im = (n >> 6) & 1, p = n & 63; const int s = k0 >> 4, h0 = k0 & 15, e = d ? s : 15 - s;
        const float pr = PW[((d * 17 + e) * 64 + p) * 2], pi = PW[((d * 17 + e) * 64 + p) * 2 + 1]; float v[8];
#pragma unroll
        for (int j = 0; j < 8; ++j) { const float br = BB[((d * 64 + p) * 16 + h0 + j) * 2], bi = BB[((d * 64 + p) * 16 + h0 + j) * 2 + 1]; v[j] = im ? (pr * bi + pi * br) : (pr * br - pi * bi); }
        v4u o; o.x = pk2(v[0], v[1]); o.y = pk2(v[2], v[3]); o.z = pk2(v[4], v[5]); o.w = pk2(v[6], v[7]);
        *(GAS v4u*)(W1t + ((size_t)(g * 256 + n)) * 256 + k0) = o; }
    for (int i = tid; i < 256 * 64; i += 512) { const int n = i >> 6, k0 = (i & 63) * 8; const int j = n >> 4, h = n & 15; float v[8];
        if (k0 < 256) { const int d = k0 >> 7, im = (k0 >> 6) & 1, p0 = k0 & 63, e = d ? 16 - j : j + 1;
#pragma unroll
            for (int q = 0; q < 8; ++q) { const int p = p0 + q; const float cr = CC[((d * 16 + h) * 64 + p) * 2], ci = CC[((d * 16 + h) * 64 + p) * 2 + 1];
                const float pr = PW[((d * 17 + e) * 64 + p) * 2], pi = PW[((d * 17 + e) * 64 + p) * 2 + 1]; v[q] = im ? -(cr * pi + ci * pr) : (cr * pr - ci * pi); }
        } else { const int s = (k0 - 256) >> 4, h0 = (k0 - 256) & 15;
#pragma unroll
            for (int q = 0; q < 8; ++q) { const int hh = h0 + q; float val = 0.f;
                if (s <= j) val += KT[((0 * 16 + (j - s)) * 16 + h) * 16 + hh];
                if (s >= j) val += KT[((1 * 16 + (s - j)) * 16 + h) * 16 + hh];
                if (s == j && h == hh) val += dskip[g * 16 + h];
                v[q] = val; } }
        v4u o; o.x = pk2(v[0], v[1]); o.y = pk2(v[2], v[3]); o.z = pk2(v[4], v[5]); o.w = pk2(v[6], v[7]);
        *(GAS v4u*)(W2t + ((size_t)(g * 256 + n)) * 512 + k0) = o; }
    __syncthreads();
}
#ifndef PROBE_ATTN
#define PROBE_ATTN 1
#endif
#ifndef PROBE_P0
#define PROBE_P0 1
#endif
#ifndef PROBE_P1
#define PROBE_P1 1
#endif
#ifndef PROBE_P7
#define PROBE_P7 1
#endif
#ifndef PROBE_FA
#define PROBE_FA 1
#endif

struct Args { const float* in[27]; float* out; unsigned char* ws; int ph_lo, ph_hi; };

__global__ void __launch_bounds__(NWAVES * 64, 2) enc_fwd(Args args) {
    extern __shared__ __attribute__((aligned(16))) unsigned char lds[];
    LAS unsigned char* ldsb = (LAS unsigned char*)lds;
    volatile LAS unsigned* MISC = (volatile LAS unsigned*)(ldsb + MISC_OFF);
    const int G = gridDim.x, bx = blockIdx.x; const int vcu = (G % 8 == 0) ? (bx % 8) * (G / 8) + bx / 8 : bx;
    const int NGW = G * NWAVES, NGT = G * NWAVES * 64;
    gu32* ctl = (gu32*)(args.ws + WS_CTL);
#define PHB unsigned char* wsl = args.ws; unsigned char* outl = (unsigned char*)args.out; asm volatile("" : "+s"(wsl), "+s"(outl)); \
    int tid = threadIdx.x; asm volatile("" : "+v"(tid)); const int lane = tid & 63, wave = __builtin_amdgcn_readfirstlane(tid >> 6); \
    const int gw = vcu * NWAVES + wave, gt = vcu * (NWAVES * 64) + tid; (void)lane; (void)gw; (void)gt; (void)wsl; (void)outl
#define x_p (args.in[0])
#define x_s (args.in[1])
#define rstd_x ((float*)(wsl + WS_RSTDX))
#define rstd_q ((float*)(wsl + WS_RSTDQ))
#define rstd_kv ((float*)(wsl + WS_RSTDKV))
#define r2v ((float*)(wsl + WS_R2))
#define ratio ((float*)(wsl + WS_RATIO))
#define rstd_x1 ((float*)(wsl + WS_RSTDX1))
#define stA ((float*)(wsl + WS_STA))
#define stB ((float*)(wsl + WS_STB))
#define stQ ((float*)(wsl + WS_STQ))
#define stKV ((float*)(wsl + WS_STKV))
#define ropetab ((float*)(wsl + WS_ROPE))
#define Wi ((bf16*)(wsl + WS_WIN))
#define Wglu ((bf16*)(wsl + WS_WGLU))
#define Wq ((bf16*)(wsl + WS_WQ))
#define Wkv ((bf16*)(wsl + WS_WKV))
#define Wout ((bf16*)(wsl + WS_WOUT))
#define Wug ((bf16*)(wsl + WS_WUG))
#define Wdn ((bf16*)(wsl + WS_WDN))
#define W1t ((bf16*)(wsl + WS_W1T))
#define W2t ((bf16*)(wsl + WS_W2T))
#define bufA ((bf16*)(wsl + WS_A))
#define bufB ((bf16*)(wsl + WS_B))
#define qlat ((bf16*)(wsl + WS_QLAT))
#define kvlat ((bf16*)(wsl + WS_KVLAT))
#define krope ((bf16*)(wsl + WS_KROPE))
#define gact ((bf16*)(wsl + WS_GACT))
#define hup ((bf16*)(wsl + WS_HUP))
#define hgate ((bf16*)(wsl + WS_HGATE))
#define X ((bf16*)(outl + OUT_X))
#define kvb ((bf16*)(outl + OUT_KV))
#define xoutf ((float*)outl)
    for (int u = threadIdx.x; u < (LDS_BYTES - LDSCTL_OFF) / 4; u += NWAVES * 64) ((LAS unsigned*)(ldsb + LDSCTL_OFF))[u] = 0u;
    __syncthreads();
    XcdBarrier bar = xcd_barrier_post((unsigned*)(ctl + CW_BAR), MISC + 8);
    const int lo = args.ph_lo, hi = args.ph_hi;
#ifndef PHMASK
#define PHMASK 0xfffffffu
#endif
#define IN(k) (((PHMASK >> ((k) < 9 ? (k) : ((k) >= 18 ? 12 : 9 + ((k) - 9) % 3))) & 1u) && lo <= (k) && (k) < hi)
#define SEAM(k) do { if (IN(k) && IN((k) + 1)) xcd_barrier(bar); } while (0)

#pragma unroll 1
    for (int rep = 0; rep < PROBE_P0; ++rep)
    if (IN(0)) {
        PHB;
        if (rep) __syncthreads();
        if (vcu < 128) ssm_weights_group(vcu, args.in[4], args.in[5], args.in[6], args.in[7], args.in[8], args.in[9], args.in[10], args.in[11], W1t, W2t, (LAS float*)ldsb, tid);
        LAS float* scr = (LAS float*)(ldsb + wave * 16384);
        constexpr int I_IN = 64 * 55, I_GLU = 32 * 32, I_Q = 14 * 48, I_KV = 8 * 64, I_OUT = 64 * 64, I_UP = 64 * 172, I_DN = 172 * 64;
        constexpr int NITEMS = I_IN + I_GLU + I_Q + I_KV + I_OUT + 2 * I_UP + I_DN;
        for (int it = gw; it < NITEMS; it += NGW) {
            int r = it;
            if (r < I_IN) { transpose_item(args.in[2], 4096, 3520, Wi, args.in[3], args.in[3], 4096, RmWin(), scr, r, lane); continue; } r -= I_IN;
            if (r < I_GLU) { transpose_item(args.in[12], 2048, 2048, Wglu, nullptr, nullptr, 0, RmId(), scr, r, lane); continue; } r -= I_GLU;
            if (r < I_Q) { transpose_item(args.in[14], 896, 3072, Wq, args.in[13], args.in[13], 896, RmQ(), scr, r, lane); continue; } r -= I_Q;
            if (r < I_KV) { transpose_item(args.in[16], 512, 4096, Wkv, args.in[15], args.in[15], 512, RmId(), scr, r, lane); continue; } r -= I_KV;
            if (r < I_OUT) { transpose_item(args.in[19], 4096, 4096, Wout, args.in[17], args.in[18], 2048, RmId(), scr, r, lane); continue; } r -= I_OUT;
            if (r < I_UP) { transpose_item(args.in[21], 4096, 11008, Wug, args.in[20], args.in[20], 4096, RmUp(), scr, r, lane); continue; } r -= I_UP;
            if (r < I_UP) { transpose_item(args.in[22], 4096, 11008, Wug, args.in[20], args.in[20], 4096, RmGate(), scr, r, lane); continue; } r -= I_UP;
            transpose_item(args.in[25], 11008, 4096, Wdn, nullptr, nullptr, 0, RmId(), scr, r, lane);
        }
        for (int i = gt; i < 320 * 512; i += NGT) { const int rr = i >> 9, c8 = (i & 511) * 8; const int row = rr < 128 ? 2944 + rr : 3648 + (rr - 128);
            *(GAS v4u*)(Wi + (size_t)row * 4096 + c8) = (v4u){0u, 0u, 0u, 0u}; }
        for (int m = gw; m < T; m += NGW) { const float* xr = m < 16384 ? x_p + (size_t)m * DM : x_s + (size_t)(m - 16384) * DM;
            f32x4 v[16]; float s = 0.f;
#pragma unroll
            for (int j = 0; j < 16; ++j) { v[j] = *((const GAS f32x4*)xr + lane + 64 * j); s += (v[j].x * v[j].x + v[j].y * v[j].y) + (v[j].z * v[j].z + v[j].w * v[j].w); }
            s = wave_sum(s); if (lane == 0) rstd_x[m] = 1.0f / sqrtf(s * (1.0f / DM) + EPS);
            GAS v2u* o8 = (GAS v2u*)(bufA + (size_t)m * DM) + lane;
#pragma unroll
            for (int j = 0; j < 16; ++j) o8[64 * j] = (v2u){pg8::cvt_pk_bf16(v[j].x, v[j].y), pg8::cvt_pk_bf16(v[j].z, v[j].w)}; }
        for (int i = gt; i < 8192 * 32; i += NGT) { const int pos = i >> 5, k = i & 31; const double inv = exp(-(double)k * (9.210340371976184 / 32.0));
            double s, c; sincos_d((double)pos * inv, s, c); *(GAS f32x2*)(ropetab + (size_t)i * 2) = (f32x2){(float)c, (float)s}; }
    }
    SEAM(0);

#pragma unroll 1
    for (int rep = 0; rep < PROBE_P1; ++rep)
    if (IN(1)) {
        PHB;
        pg8::Gemm g{bufA, Wi, DM, DM, DM}; pg8::StaticOrder S; S.init(T, 3840, G, bx);
        pg8::EpiWin E{rstd_x, X, qlat, kvlat, krope, stQ, stKV, ropetab};
        pg8::gemm_phase(ldsb, g, S, E);
    }
    SEAM(1);

    if (IN(2)) {
        PHB;
        pg8::Gemm g{X + 256, W1t, 512, 256, 256}; pg8::GroupOrder S{768, 6, G, bx};
        pg8::EpiSsm1 E{X};
        pg8::gemm_phase(ldsb, g, S, E);
        for (int r = gt; r < T; r += NGT) { float s = 0.f;
#pragma unroll
            for (int j = 0; j < 4; ++j) { const f32x4 v = *(const GAS f32x4*)(stQ + (size_t)r * 16 + 4 * j); s += (v.x + v.y) + (v.z + v.w); }
            rstd_q[r] = 1.0f / sqrtf(s * (1.0f / QLAT) + EPS); float s2 = 0.f;
#pragma unroll
            for (int j = 0; j < 2; ++j) { const f32x4 v = *(const GAS f32x4*)(stKV + (size_t)r * 8 + 4 * j); s2 += (v.x + v.y) + (v.z + v.w); }
            rstd_kv[r] = 1.0f / sqrtf(s2 * (1.0f / KVLAT) + EPS); }
    }
    SEAM(2);

    if (IN(3)) {
        PHB;
        if (wave < 4) { const int task = vcu * 4 + wave;
            if (task < 1024) { const int seq = task >> 8, g = (task >> 1) & 127, dir = task & 1, p = lane;
                const int c0 = seq < 2 ? seq * 512 : 1024 + (seq - 2) * 256, nc = seq < 2 ? 512 : 256;
                const double dt = exp((double)args.in[10][dir * 128 + g]); const double are = args.in[4][(dir * 128 + g) * 64 + p], aim = args.in[5][(dir * 128 + g) * 64 + p];
                const double mag = exp(16.0 * dt * are); double sn, cs; sincos_d(16.0 * dt * aim, sn, cs);
                const float ar = (float)(mag * cs), ai = (float)(mag * sn);
                bf16* Xg = X + (size_t)g * NCHUNK * 512 + dir * 128 + p;
                float zr = 0.f, zi = 0.f;
                for (int cb = 0; cb < nc; cb += 16) {
                    unsigned short sre[16], sim[16];
#pragma unroll
                    for (int i = 0; i < 16; ++i) { const int c = dir ? (c0 + nc - 1 - (cb + i)) : (c0 + cb + i); sre[i] = Xg[(size_t)c * 512]; sim[i] = Xg[(size_t)c * 512 + 64]; }
#pragma unroll
                    for (int i = 0; i < 16; ++i) { const int c = dir ? (c0 + nc - 1 - (cb + i)) : (c0 + cb + i);
                        Xg[(size_t)c * 512] = (bf16)f2bf(zr); Xg[(size_t)c * 512 + 64] = (bf16)f2bf(zi);
                        const float sr = bf2f(sre[i]), si = bf2f(sim[i]); const float nr = ar * zr - ai * zi + sr, ni = ar * zi + ai * zr + si; zr = nr; zi = ni; }
                }
            }
        }
        __syncthreads();
        { pg8::Gemm g{qlat, Wq, QLAT, QLAT, QLAT}; pg8::StaticOrder S; S.init(T, QW, G, bx); pg8::EpiQ E{rstd_q, bufA, ropetab}; pg8::gemm_phase(ldsb, g, S, E); }
        { pg8::Gemm g{kvlat, Wkv, KVLAT, KVLAT, KVLAT}; pg8::StaticOrder S; S.init(T, KVW, G, bx); pg8::EpiKV E{rstd_kv, kvb}; pg8::gemm_phase(ldsb, g, S, E); }
    }
    SEAM(3);

    if (IN(4)) {
        PHB;
        pg8::Gemm g{X, W2t, 512, 512, 512}; pg8::GroupOrder S{768, 6, G, bx};
        pg8::EpiSsm2 E{gact};
        pg8::gemm_phase(ldsb, g, S, E);
    }
    SEAM(4);

    if (IN(5)) {
        PHB;
#ifndef NO_GLU
        { pg8::Gemm g{gact, Wglu, MIXW, MIXW, MIXW}; pg8::StaticOrder S; S.init(T, MIXW, G, bx); pg8::EpiGlu E{gact, bufB, stA}; pg8::gemm_phase(ldsb, g, S, E); }
#endif
#ifndef NO_ATTN
        const int xcd = vcu >> 5, cc = vcu & 31; const int nun = (G == 256) ? 6 : (1536 - bx + G - 1) / G;
#pragma unroll 1
        for (int i2 = 0; i2 < PROBE_ATTN * nun; ++i2) { const int i = i2 % nun;
            int bh, qb, seq, rowbase;
            if (G == 256) { if (i < 4) { bh = xcd * 4 + i; qb = cc; seq = 8192; } else { bh = xcd * 4 + 2 * (i - 4) + (cc >> 4); qb = cc & 15; seq = 4096; } }
            else { const int uidx = bx + i * G; if (uidx < 1024) { bh = uidx >> 5; qb = uidx & 31; seq = 8192; } else { const int v = uidx - 1024; bh = v >> 4; qb = v & 15; seq = 4096; } }
            const int b = bh >> 4, h = bh & 15; rowbase = (seq == 8192) ? b * 8192 : 16384 + b * 4096;
            __syncthreads();
            attn::attn_unit(bufA + (size_t)(rowbase + qb * 256) * QW + h * 192, kvb + (size_t)rowbase * KVW + h * 256, kvb + (size_t)rowbase * KVW + h * 256 + 128,
                            krope + (size_t)rowbase * 64, bufB + (size_t)(rowbase + qb * 256) * DM + 2048 + h * 128, stB + (size_t)(rowbase + qb * 256) * 16 + h, seq, (char*)lds);
        }
#endif
    }
    SEAM(5);

    if (IN(6)) {
        PHB;
        for (int r = gt; r < T; r += NGT) { float s = 0.f;
#pragma unroll
            for (int j = 0; j < 8; ++j) { const f32x4 v = *(const GAS f32x4*)(stA + (size_t)r * 32 + 4 * j); s += (v.x + v.y) + (v.z + v.w); }
            const float r1 = 1.0f / sqrtf(s * (1.0f / MIXW) + EPS); float s2 = 0.f;
#pragma unroll
            for (int j = 0; j < 4; ++j) { const f32x4 v = *(const GAS f32x4*)(stB + (size_t)r * 16 + 4 * j); s2 += (v.x + v.y) + (v.z + v.w); }
            const float r2 = 1.0f / sqrtf(s2 * (1.0f / MIXW) + EPS); r2v[r] = r2; ratio[r] = r1 / r2; }
    }
    SEAM(6);

#pragma unroll 1
    for (int rep = 0; rep < PROBE_P7; ++rep)
    if (IN(7)) {
        PHB;
        pg8::Gemm g{bufB, Wout, DM, DM, DM}; pg8::StaticOrder S; S.init(T, DM, G, bx);
        pg8::EpiWout E{x_p, x_s, r2v, ratio, bufA, stA};
        pg8::gemm_phase(ldsb, g, S, E);
    }
    SEAM(7);

    if (IN(8)) {
        PHB;
        for (int r = gt; r < T; r += NGT) { float s = 0.f;
#pragma unroll
            for (int j = 0; j < 16; ++j) { const f32x4 v = *(const GAS f32x4*)(stA + (size_t)r * 64 + 4 * j); s += (v.x + v.y) + (v.z + v.w); }
            rstd_x1[r] = 1.0f / sqrtf(s * (1.0f / DM) + EPS); }
    }
    SEAM(8);

#ifdef PROBE_KLOOP
    if (IN(9)) {
        PHB;
#pragma unroll 1
        for (int ch = 0; ch < 3; ++ch) { pg8::Gemm g{bufA + (size_t)(ch * 8192) * DM, Wug, DM, DM, DM}; pg8::StaticOrder S; S.init(8192, 2 * DFF, G, bx); pg8::EpiNull E0; pg8::gemm_phase(ldsb, g, S, E0); }
    }
#endif
#pragma unroll 1
    for (int ch2 = 0; ch2 < 3 * PROBE_FA; ++ch2) {
        const int ch = ch2 / PROBE_FA; const bool lastrep = (ch2 % PROBE_FA) == PROBE_FA - 1;
        const int rb = ch * 8192;
        if (IN(9 + 3 * ch)) {
        PHB;
            pg8::Gemm g{bufA + (size_t)rb * DM, Wug, DM, DM, DM}; pg8::StaticOrder S; S.init(8192, 2 * DFF, G, bx);
            pg8::EpiFfnA E{rstd_x1, rb, bufB, hup, hgate, args.in[23], args.in[24]};
            pg8::gemm_phase(ldsb, g, S, E);
        }
        SEAM(9 + 3 * ch);
        if (lastrep && IN(10 + 3 * ch)) {
        PHB;
            const float* cw = args.in[23]; const float* cb = args.in[24];
            for (int i = gt; i < 128 * 2 * (DFF / 8); i += NGT) { const int f0 = (i % (DFF / 8)) * 8, sw = i / (DFF / 8), strip = sw >> 1, which = sw & 1;
                const int lrow = strip * 64 + (which ? 63 : 0), grow = rb + lrow, pos = pos_of(grow), len = len_of(grow);
                v4u up0, up1, up2;
                if (which == 0) { up1 = *(const GAS v4u*)(hup + ((size_t)strip * 4 + 0) * DFF + f0); up2 = *(const GAS v4u*)(hup + ((size_t)strip * 4 + 1) * DFF + f0);
                    up0 = (pos == 0) ? (v4u){0u, 0u, 0u, 0u} : *(const GAS v4u*)(hup + ((size_t)(strip - 1) * 4 + 3) * DFF + f0); }
                else { up0 = *(const GAS v4u*)(hup + ((size_t)strip * 4 + 2) * DFF + f0); up1 = *(const GAS v4u*)(hup + ((size_t)strip * 4 + 3) * DFF + f0);
                    up2 = (pos == len - 1) ? (v4u){0u, 0u, 0u, 0u} : *(const GAS v4u*)(hup + ((size_t)(strip + 1) * 4 + 0) * DFF + f0); }
                const v4u gt4 = *(const GAS v4u*)(hgate + ((size_t)strip * 2 + which) * DFF + f0);
                unsigned ow[4];
#pragma unroll
                for (int k = 0; k < 4; ++k) { const int f = f0 + 2 * k;
                    const float a0 = bflo(up0[k]), a1 = bflo(up1[k]), a2 = bflo(up2[k]), b0 = bfhi(up0[k]), b1 = bfhi(up1[k]), b2 = bfhi(up2[k]);
                    const float c0 = cw[f] * a0 + cw[DFF + f] * a1 + cw[2 * DFF + f] * a2 + cb[f], c1 = cw[f + 1] * b0 + cw[DFF + f + 1] * b1 + cw[2 * DFF + f + 1] * b2 + cb[f + 1];
                    ow[k] = pk2(c0 * sigmoidf_fast(c0) * bflo(gt4[k]), c1 * sigmoidf_fast(c1) * bfhi(gt4[k])); }
                *(GAS v4u*)(bufB + (size_t)lrow * DFF + f0) = (v4u){ow[0], ow[1], ow[2], ow[3]}; }
        }
        if (lastrep) SEAM(10 + 3 * ch);
        if (lastrep && IN(11 + 3 * ch)) {
        PHB;
            pg8::Gemm g{bufB, Wdn, DFF, DFF, DFF}; pg8::StaticOrder S; S.init(8192, DM, G, bx);
            pg8::EpiDown E{bufA, rb, stA};
            pg8::gemm_phase(ldsb, g, S, E);
        }
        if (lastrep) SEAM(11 + 3 * ch);
    }

    if (IN(18)) {
        PHB;
        const float* gf = args.in[26];
        for (int m = gw; m < T; m += NGW) { const float s = wave_sum(stA[(size_t)m * 64 + lane]); const float rs = 1.0f / sqrtf(s * (1.0f / DM) + EPS);
            const GAS v4u* xr = (const GAS v4u*)(bufA + (size_t)m * DM) + lane; GAS f32x4* orow = (GAS f32x4*)(xoutf + (size_t)m * DM) + 2 * lane; const GAS f32x4* gr = (const GAS f32x4*)gf + 2 * lane;
#pragma unroll
            for (int j = 0; j < 8; ++j) { const v4u w = xr[64 * j]; const f32x4 g0 = gr[128 * j], g1 = gr[128 * j + 1];
                orow[128 * j] = (f32x4){bflo(w.x) * rs * g0[0], bfhi(w.x) * rs * g0[1], bflo(w.y) * rs * g0[2], bfhi(w.y) * rs * g0[3]};
                orow[128 * j + 1] = (f32x4){bflo(w.z) * rs * g1[0], bfhi(w.z) * rs * g1[1], bflo(w.w) * rs * g1[2], bfhi(w.w) * rs * g1[3]}; } }
    }
#undef IN
#undef SEAM
}

constexpr int N_PHASES = 19;
extern "C" void kernel_launch(void* const* d_in, const int* in_sizes, int n_in, void* d_out, int out_size, void* d_ws, size_t ws_size, hipStream_t stream) {
    static int grid = 0;
    if (grid == 0) {
        if (n_in != 27 || out_size != T * DM || ws_size < WS_END) { fprintf(stderr, "kernel_launch: unexpected shapes (n_in %d out %d ws %zu)\n", n_in, out_size, ws_size); grid = -1; return; }
        int dev = 0, cus = 0, per_cu = 0;
        if (hipGetDevice(&dev) != hipSuccess || hipDeviceGetAttribute(&cus, hipDeviceAttributeMultiprocessorCount, dev) != hipSuccess) { grid = -1; return; }
        if (hipFuncSetAttribute((const void*)enc_fwd, hipFuncAttributeMaxDynamicSharedMemorySize, LDS_BYTES) != hipSuccess) { fprintf(stderr, "kernel_launch: hipFuncSetAttribute failed\n"); grid = -1; return; }
        if (hipOccupancyMaxActiveBlocksPerMultiprocessor(&per_cu, (const void*)enc_fwd, NWAVES * 64, LDS_BYTES) != hipSuccess || per_cu < 1) { fprintf(stderr, "kernel_launch: occupancy query says %d\n", per_cu); }
        (void)hipGetLastError();
        grid = cus;
    }
    if (grid < 0) return;
    if (hipMemsetAsync((char*)d_ws + WS_CTL, 0, CTL_ZERO_BYTES, stream) != hipSuccess) return;
    Args a{};
    for (int i = 0; i < 27; ++i) a.in[i] = (const float*)d_in[i];
    a.out = (float*)d_out; a.ws = (unsigned char*)d_ws;
#ifndef MK_N_LAUNCHES
#define MK_N_LAUNCHES 1
#endif
    if (MK_N_LAUNCHES == 1) { a.ph_lo = 0; a.ph_hi = N_PHASES; hipLaunchKernelGGL(enc_fwd, dim3(grid), dim3(NWAVES * 64), LDS_BYTES, stream, a); }
    else { for (int p = 0; p < N_PHASES; ++p) { a.ph_lo = p; a.ph_hi = p + 1; hipLaunchKernelGGL(enc_fwd, dim3(grid), dim3(NWAVES * 64), LDS_BYTES, stream, a); } }
    const hipError_t le = hipPeekAtLastError();
    if (le != hipSuccess) fprintf(stderr, "kernel_launch: launch failed: %s\n", hipGetErrorName(le));
}
```

```cpp
#include <hip/hip_runtime.h>
#include <hip/hip_bf16.h>
#include <cstdio>
#include <cstdint>

namespace pg8 {
#define PG8_LAS __attribute__((address_space(3)))
typedef unsigned short bf16_t;
typedef short bf16x8 __attribute__((ext_vector_type(8)));
typedef float f32x4 __attribute__((ext_vector_type(4)));
typedef float f32x2 __attribute__((ext_vector_type(2)));
typedef unsigned u32x4 __attribute__((ext_vector_type(4)));
typedef unsigned u32x2 __attribute__((ext_vector_type(2)));
constexpr int BM = 256, BK = 64, HALF = 128, HTB = HALF * BK * 2  , STAGE_BYTES = 8 * HTB, NXCD = 8, WGM = 8;

__host__ __device__ __forceinline__ int lds_byte(int r, int c) { const int st = (r >> 4) * 2 + (c >> 5), rr = r & 15, cc = c & 31, ob = rr * 64 + cc * 2; return st * 1024 + (ob ^ (((ob >> 9) & 1) << 5)); }
__host__ __device__ __forceinline__ void stage_rc(int b, int& R, int& C) { const int st = b / 1024, sb = b % 1024, swz = sb ^ (((sb >> 9) & 1) << 5); R = (st >> 1) * 16 + swz / 64; C = (st & 1) * 32 + (swz % 64) / 2; }
__host__ __device__ __forceinline__ int perm32(int rho) { const int n = rho >> 4, i = rho & 15; return 8 * (i >> 2) + 4 * n + (i & 3); }

struct Unit { int pm, pn; };
struct Gemm { const bf16_t* A; const bf16_t* Bt; int lda, ldb, K; };

struct StaticOrder {
    int nM, nN, nwg, G, c;
    __host__ __device__ void init(int M, int N, int G_, int c_) { nM = M / BM; nN = N / BM; nwg = nM * nN; G = G_; c = c_; }
    __host__ __device__ bool next(int i, Unit& u) const {
        const long L = (long)i * G + c; if (L >= nwg) return false;
        int wgid = (int)L; { const int q = nwg / NXCD, r = nwg % NXCD, xcd = wgid % NXCD, off = wgid / NXCD; wgid = (xcd < r ? xcd * (q + 1) : r * (q + 1) + (xcd - r) * q) + off; }
        const int nig = WGM * nN, gid = wgid / nig, fm = gid * WGM, gsz = (nM - fm) < WGM ? (nM - fm) : WGM;
        u.pm = fm + ((wgid % nig) % gsz); u.pn = (wgid % nig) / gsz; return true;
    }
};
struct ZeroOrder { int n, G, c; __host__ __device__ bool next(int i, Unit& u) const { const long L = (long)i * G + c; if (L >= n) return false; u.pm = 0; u.pn = 0; return true; } };
struct GroupOrder {
    int n, per, G, c;
    __host__ __device__ bool next(int i, Unit& u) const { const long L = (long)i * G + c; if (L >= n) return false; u.pm = (int)L; u.pn = (int)L / per; return true; }
};

__device__ __forceinline__ unsigned cvt_pk_bf16(float lo, float hi) { unsigned r; asm volatile("v_cvt_pk_bf16_f32 %0, %1, %2" : "=v"(r) : "v"(lo), "v"(hi)); return r; }
__device__ __forceinline__ u32x4 pack8(const f32x4 a, const f32x4 b) { u32x4 w; w.x = cvt_pk_bf16(a[0], a[1]); w.y = cvt_pk_bf16(a[2], a[3]); w.z = cvt_pk_bf16(b[0], b[1]); w.w = cvt_pk_bf16(b[2], b[3]); return w; }

template <class Epi, class Sched>
__device__ __forceinline__ void gemm_phase(PG8_LAS unsigned char* lds, const Gemm g, const Sched& S, const Epi& E, int tid_in) {
    int tid_l = tid_in; asm volatile("" : "+v"(tid_l));
    const int tid = tid_l, wid = __builtin_amdgcn_readfirstlane(tid >> 6), lane = tid & 63, wr = wid >> 2, wc = wid & 3, fr = lane & 15, fq = lane >> 4;
    const int K = g.K, nt = K / BK;
    unsigned voffA[2], voffB[2];
#pragma unroll
    for (int i = 0; i < 2; ++i) { int R, C; stage_rc(tid * 16 + i * 8192, R, C); const int Rb = Epi::PERM ? ((R & ~31) + perm32(R & 31)) : R;
        voffA[i] = (unsigned)(R * g.lda + C) * 2u; voffB[i] = (unsigned)(Rb * g.ldb + C) * 2u; }
    asm volatile("" : "+v"(voffA[0]), "+v"(voffA[1]), "+v"(voffB[0]), "+v"(voffB[1]));
    const size_t kstep = (size_t)(BK * 2);
    const size_t hstepA = (size_t)HALF * g.lda * 2, hstepB = (size_t)HALF * g.ldb * 2;
    const size_t tstepA = 2 * hstepA, tstepB = 2 * hstepB;
    const unsigned ldsw = (unsigned)wid * 1024u;
    const int aoff = lds_byte(wr * 64 + fr, fq * 8), boff = lds_byte(wc * 32 + fr, fq * 8);
#define PG8_SA(b, h) (((b) * 2 + (h)) * HTB)
#define PG8_SB(b, h) ((4 + (b) * 2 + (h)) * HTB)
#define PG8_STAGE(bufoff, gbase, voff) do { _Pragma("unroll") for (int _i = 0; _i < 2; ++_i) \
        __builtin_amdgcn_global_load_lds((const unsigned*)((const char*)(gbase) + (voff)[_i]), (PG8_LAS unsigned*)(lds + (bufoff) + ldsw + _i * 8192), 16, 0, 0); } while (0)
#define PG8_LDA(dst, b, h) do { _Pragma("unroll") for (int m = 0; m < 4; ++m) _Pragma("unroll") for (int k = 0; k < 2; ++k) dst[m][k] = *(const PG8_LAS bf16x8*)(lds + PG8_SA(b, h) + aoff + m * 2048 + k * 1024); } while (0)
#define PG8_LDB(dst, b, h) do { _Pragma("unroll") for (int n = 0; n < 2; ++n) _Pragma("unroll") for (int k = 0; k < 2; ++k) dst[n][k] = *(const PG8_LAS bf16x8*)(lds + PG8_SB(b, h) + boff + n * 2048 + k * 1024); } while (0)
#define PG8_MMA(ai, bj, At, Bt) do { __builtin_amdgcn_s_setprio(1); _Pragma("unroll") for (int m = 0; m < 4; ++m) _Pragma("unroll") for (int n = 0; n < 2; ++n) _Pragma("unroll") for (int k = 0; k < 2; ++k) \
        acc[ai][bj][m][n] = __builtin_amdgcn_mfma_f32_16x16x32_bf16(Bt[n][k], At[m][k], acc[ai][bj][m][n], 0, 0, 0); __builtin_amdgcn_s_setprio(0); } while (0)
#define PG8_WAIT_V(n) asm volatile("s_waitcnt vmcnt(" #n ")" ::: "memory")
#define PG8_WAIT_L(n) asm volatile("s_waitcnt lgkmcnt(" #n ")" ::: "memory")
#define PG8_BAR __builtin_amdgcn_s_barrier()
#define PG8_SCHED __builtin_amdgcn_sched_barrier(0)
    Unit cur, nxt; int ui = 0;
    if (!S.next(0, cur)) return;
    f32x4 acc[2][2][4][2];
#pragma unroll
    for (int a = 0; a < 2; ++a)
#pragma unroll
        for (int b = 0; b < 2; ++b)
#pragma unroll
            for (int m = 0; m < 4; ++m)
#pragma unroll
                for (int n = 0; n < 2; ++n) acc[a][b][m][n] = (f32x4){0.f, 0.f, 0.f, 0.f};
    bf16x8 At[4][2], B0[2][2], B1[2][2];
    const char* cA = (const char*)g.A + (size_t)cur.pm * tstepA; const char* cB = (const char*)g.Bt + (size_t)cur.pn * tstepB;
    PG8_STAGE(PG8_SB(0, 0), cB, voffB); PG8_STAGE(PG8_SB(0, 1), cB + hstepB, voffB); PG8_STAGE(PG8_SA(0, 0), cA, voffA); PG8_STAGE(PG8_SA(0, 1), cA + hstepA, voffA);
    if (wr == 1) PG8_BAR;
    PG8_WAIT_V(2); PG8_BAR;
    PG8_STAGE(PG8_SB(1, 0), cB + kstep, voffB); PG8_STAGE(PG8_SA(1, 0), cA + kstep, voffA); PG8_STAGE(PG8_SB(1, 1), cB + hstepB + kstep, voffB);
    PG8_WAIT_V(6); PG8_BAR;
    for (;;) {
        const bool has_next = S.next(ui + 1, nxt);
        const char* nA = has_next ? (const char*)g.A + (size_t)nxt.pm * tstepA : cA; const char* nB = has_next ? (const char*)g.Bt + (size_t)nxt.pn * tstepB : cB;
#pragma unroll 1
        for (int t = 0; t < nt; t += 2) {
            const bool last = (t == nt - 2);
            if constexpr (Epi::MIDK) { if (t == (nt >> 1)) E.midk(acc, cur, wr, fr); }
            const char* a1 = cA + (size_t)(t + 1) * kstep;
            const char* a2 = last ? nA : cA + (size_t)(t + 2) * kstep; const char* b2 = last ? nB : cB + (size_t)(t + 2) * kstep;
            const char* a3 = a2 + kstep; const char* b3 = b2 + kstep;
            PG8_LDB(B0, 0, 0); PG8_LDB(B1, 0, 1); PG8_SCHED; PG8_LDA(At, 0, 0); PG8_STAGE(PG8_SA(1, 1), a1 + hstepA, voffA);
            PG8_WAIT_V(8); PG8_WAIT_L(0); PG8_BAR; PG8_MMA(0, 0, At, B0); PG8_MMA(0, 1, At, B1); PG8_BAR; PG8_SCHED;
            PG8_LDA(At, 0, 1); PG8_STAGE(PG8_SB(0, 0), b2, voffB); PG8_STAGE(PG8_SB(0, 1), b2 + hstepB, voffB); PG8_STAGE(PG8_SA(0, 0), a2, voffA);
            PG8_WAIT_V(8); PG8_WAIT_L(0); PG8_BAR; PG8_MMA(1, 0, At, B0); PG8_MMA(1, 1, At, B1); PG8_BAR; PG8_SCHED;
            PG8_LDB(B0, 1, 0); PG8_LDB(B1, 1, 1); PG8_SCHED; PG8_LDA(At, 1, 0); PG8_STAGE(PG8_SA(0, 1), a2 + hstepA, voffA);
            PG8_WAIT_V(8); PG8_WAIT_L(0); PG8_BAR; PG8_MMA(0, 0, At, B0); PG8_MMA(0, 1, At, B1); PG8_BAR; PG8_SCHED;
            PG8_LDA(At, 1, 1); PG8_STAGE(PG8_SB(1, 0), b3, voffB); PG8_STAGE(PG8_SB(1, 1), b3 + hstepB, voffB); PG8_STAGE(PG8_SA(1, 0), a3, voffA);
            PG8_WAIT_V(8); PG8_WAIT_L(0); PG8_BAR; PG8_MMA(1, 0, At, B0); PG8_MMA(1, 1, At, B1); PG8_BAR; PG8_SCHED;
        }
        if (wr == 0) PG8_BAR;
        E(acc, cur, wr, wc, fr, fq);
        if (!has_next) break;
#pragma unroll
        for (int a = 0; a < 2; ++a)
#pragma unroll
            for (int b = 0; b < 2; ++b)
#pragma unroll
                for (int m = 0; m < 4; ++m)
#pragma unroll
                    for (int n = 0; n < 2; ++n) acc[a][b][m][n] = (f32x4){0.f, 0.f, 0.f, 0.f};
        cur = nxt; cA = nA; cB = nB; ++ui;
        if (wr == 1) PG8_BAR;
    }
    PG8_WAIT_V(0);
    PG8_BAR;
#undef PG8_SA
#undef PG8_SB
#undef PG8_STAGE
#undef PG8_LDA
#undef PG8_LDB
#undef PG8_MMA
#undef PG8_WAIT_V
#undef PG8_WAIT_L
#undef PG8_BAR
#undef PG8_SCHED
}
}

constexpr int T = 24576, DM = 4096, DFF = 11008;
constexpr int NCHUNK = T / 16;
constexpr int QLAT = 896, KVLAT = 512, QW = 3072, KVW = 4096, MIXW = 2048;
constexpr float EPS = 1e-6f;
__device__ __forceinline__ int pos_of(int r) { return r < 16384 ? (r & 8191) : (r & 4095); }
__device__ __forceinline__ int len_of(int r) { return r < 16384 ? 8192 : 4096; }

typedef unsigned short bf16;
#define GAS __attribute__((address_space(1)))
#define LAS __attribute__((address_space(3)))
typedef unsigned v4u __attribute__((ext_vector_type(4)));
typedef unsigned v2u __attribute__((ext_vector_type(2)));
typedef float f32x4 __attribute__((ext_vector_type(4)));
typedef float f32x2 __attribute__((ext_vector_type(2)));
typedef short bf16x8 __attribute__((ext_vector_type(8)));

__device__ __forceinline__ unsigned f2bf(float f) { unsigned u = __builtin_bit_cast(unsigned, f); return (u + 0x7fffu + ((u >> 16) & 1u)) >> 16; }
__device__ __forceinline__ unsigned pk2(float lo, float hi) { return f2bf(lo) | (f2bf(hi) << 16); }
__device__ __forceinline__ float bf2f(unsigned short b) { return __builtin_bit_cast(float, (unsigned)b << 16); }
__device__ __forceinline__ float bflo(unsigned w) { return __builtin_bit_cast(float, w << 16); }
__device__ __forceinline__ float bfhi(unsigned w) { return __builtin_bit_cast(float, w & 0xffff0000u); }
__device__ __forceinline__ float sigmoidf_fast(float x) { return __builtin_amdgcn_rcpf(1.0f + __builtin_amdgcn_exp2f(-1.4426950408889634f * x)); }
__device__ __forceinline__ float gelu_tanh(float y) { const float in = 1.5957691216057308f * (y + 0.044715f * y * y * y); return y * sigmoidf_fast(in); }

namespace pg8 {
#define EPI_ROWS const int row0 = u.pm * 256 + wr * 64 + fr
__device__ __forceinline__ float sq8(const f32x4 a, const f32x4 b) { return (a[0] * a[0] + a[1] * a[1]) + (a[2] * a[2] + a[3] * a[3]) + (b[0] * b[0] + b[1] * b[1]) + (b[2] * b[2] + b[3] * b[3]); }
__device__ __forceinline__ float red_fq(float s) { s += __shfl_xor(s, 16); s += __shfl_xor(s, 32); return s; }

__device__ __forceinline__ f32x4 rope4(const f32x4 v, const f32x4 cs) { f32x4 o; o[0] = v[0] * cs[0] - v[1] * cs[1]; o[1] = v[1] * cs[0] + v[0] * cs[1]; o[2] = v[2] * cs[2] - v[3] * cs[3]; o[3] = v[3] * cs[2] + v[2] * cs[3]; return o; }

#define LAUNDER(p) asm volatile("" : "+v"(p))
struct EpiNull { static constexpr bool PERM = true, MIDK = false;
    __device__ __forceinline__ void midk(f32x4 (&)[2][2][4][2], const Unit&, int, int) const {}
    __device__ __forceinline__ void operator()(const f32x4 (&acc)[2][2][4][2], const Unit& u, int wr, int wc, int fr, int fq) const {
#pragma unroll
        for (int ai = 0; ai < 2; ++ai)
#pragma unroll
            for (int bj = 0; bj < 2; ++bj)
                asm volatile("" :: "v"(acc[ai][bj][0][0]), "v"(acc[ai][bj][0][1]), "v"(acc[ai][bj][1][0]), "v"(acc[ai][bj][1][1]), "v"(acc[ai][bj][2][0]), "v"(acc[ai][bj][2][1]), "v"(acc[ai][bj][3][0]), "v"(acc[ai][bj][3][1]));
    } };
struct EpiWin {
    static constexpr bool PERM = true, MIDK = false;
    const float* rstd_x; bf16_t* X; bf16_t* qlat; bf16_t* kvlat; bf16_t* krope; float* stQ; float* stKV; const float* ropetab;
    __device__ __forceinline__ void midk(f32x4 (&)[2][2][4][2], const Unit&, int, int) const {}
    __device__ __forceinline__ void operator()(const f32x4 (&acc)[2][2][4][2], const Unit& u, int wr, int wc, int fr, int fq) const {
        EPI_ROWS; const int tile = u.pn;
        const GAS float* rsp = (const GAS float*)(rstd_x + row0); LAUNDER(rsp);
        if (tile < 8) {
            const int c0 = tile * 256 + wc * 32 + 8 * fq;
            GAS bf16_t* xp0 = (GAS bf16_t*)X + ((size_t)((c0 >> 4) * NCHUNK + (row0 >> 4)) * 512 + 256 + (row0 & 15) * 16 + (c0 & 15)); LAUNDER(xp0);
#pragma unroll
            for (int ai = 0; ai < 2; ++ai)
#pragma unroll
                for (int m = 0; m < 4; ++m) { const float rs = rsp[ai * 128 + m * 16];
#pragma unroll
                    for (int bj = 0; bj < 2; ++bj)
                        *(GAS u32x4*)(xp0 + ((size_t)(bj * 8) * NCHUNK + ai * 8 + m) * 512) = pack8(acc[ai][bj][m][0] * rs, acc[ai][bj][m][1] * rs); }
        } else if (tile < 14) {
            const bool isq = tile < 12; const int tl = isq ? tile - 8 : tile - 12; const int ld = isq ? QLAT : KVLAT;
            const int c0 = tl * 256 + wc * 32 + 8 * fq;
            GAS bf16_t* op = (GAS bf16_t*)(isq ? qlat : kvlat) + (size_t)row0 * ld + c0; GAS float* sp = (GAS float*)(isq ? stQ + (size_t)row0 * 16 : stKV + (size_t)row0 * 8) + tl * 4 + wc; LAUNDER(op); LAUNDER(sp);
#pragma unroll
            for (int ai = 0; ai < 2; ++ai)
#pragma unroll
                for (int m = 0; m < 4; ++m) { const float rs = rsp[ai * 128 + m * 16]; float ss = 0.f;
#pragma unroll
                    for (int bj = 0; bj < 2; ++bj) { const f32x4 v0 = acc[ai][bj][m][0] * rs, v1 = acc[ai][bj][m][1] * rs; ss += sq8(v0, v1);
                        if (c0 + bj * 128 < ld) *(GAS u32x4*)(op + (size_t)(ai * 128 + m * 16) * ld + bj * 128) = pack8(v0, v1); }
                    ss = red_fq(ss); if (fq == 0) sp[(size_t)(ai * 128 + m * 16) * (isq ? 16 : 8)] = ss; }
        } else {
            if (wc < 2) { const int c = wc * 32 + 8 * fq;
                GAS bf16_t* op = (GAS bf16_t*)krope + (size_t)row0 * 64 + c; LAUNDER(op);
#pragma unroll
                for (int ai = 0; ai < 2; ++ai)
#pragma unroll
                    for (int m = 0; m < 4; ++m) { const int row = row0 + ai * 128 + m * 16; const float rs = rsp[ai * 128 + m * 16]; const int pos = pos_of(row);
                        const f32x4 cs0 = *(const GAS f32x4*)((const GAS float*)ropetab + (size_t)pos * 64 + c), cs1 = *(const GAS f32x4*)((const GAS float*)ropetab + (size_t)pos * 64 + c + 4);
                        const f32x4 v0 = rope4(acc[ai][0][m][0] * rs, cs0), v1 = rope4(acc[ai][0][m][1] * rs, cs1);
                        *(GAS u32x4*)(op + (size_t)(ai * 128 + m * 16) * 64) = pack8(v0, v1); } }
        }
    }
};
struct EpiSsm1 {
    static constexpr bool PERM = true, MIDK = false;
    bf16_t* X;
    __device__ __forceinline__ void midk(f32x4 (&)[2][2][4][2], const Unit&, int, int) const {}
    __device__ __forceinline__ void operator()(const f32x4 (&acc)[2][2][4][2], const Unit& u, int wr, int wc, int fr, int fq) const {
        EPI_ROWS; GAS bf16_t* op = (GAS bf16_t*)X + (size_t)row0 * 512 + wc * 32 + 8 * fq; LAUNDER(op);
#pragma unroll
        for (int ai = 0; ai < 2; ++ai)
#pragma unroll
            for (int m = 0; m < 4; ++m)
#pragma unroll
                for (int bj = 0; bj < 2; ++bj) *(GAS u32x4*)(op + (size_t)(ai * 128 + m * 16) * 512 + bj * 128) = pack8(acc[ai][bj][m][0], acc[ai][bj][m][1]);
    }
};
struct EpiSsm2 {
    static constexpr bool PERM = true, MIDK = false;
    bf16_t* gact;
    __device__ __forceinline__ void midk(f32x4 (&)[2][2][4][2], const Unit&, int, int) const {}
    __device__ __forceinline__ void operator()(const f32x4 (&acc)[2][2][4][2], const Unit& u, int wr, int wc, int fr, int fq) const {
        EPI_ROWS; const int g = u.pn; const int c0 = wc * 32 + 8 * fq;
        GAS bf16_t* op = (GAS bf16_t*)gact + ((size_t)(row0 - g * NCHUNK) * 16 + (c0 >> 4)) * MIXW + g * 16 + (c0 & 15); LAUNDER(op);
#pragma unroll
        for (int ai = 0; ai < 2; ++ai)
#pragma unroll
            for (int m = 0; m < 4; ++m)
#pragma unroll
                for (int bj = 0; bj < 2; ++bj) { f32x4 v0 = acc[ai][bj][m][0], v1 = acc[ai][bj][m][1];
#pragma unroll
                    for (int e = 0; e < 4; ++e) { v0[e] = gelu_tanh(v0[e]); v1[e] = gelu_tanh(v1[e]); }
                    *(GAS u32x4*)(op + ((size_t)(ai * 128 + m * 16) * 16 + bj * 8) * MIXW) = pack8(v0, v1); }
    }
};
struct EpiQ {
    static constexpr bool PERM = true, MIDK = false;
    const float* rstd_q; bf16_t* q; const float* ropetab;
    __device__ __forceinline__ void midk(f32x4 (&)[2][2][4][2], const Unit&, int, int) const {}
    __device__ __forceinline__ void operator()(const f32x4 (&acc)[2][2][4][2], const Unit& u, int wr, int wc, int fr, int fq) const {
        EPI_ROWS; const GAS float* rsp = (const GAS float*)(rstd_q + row0); GAS bf16_t* op = (GAS bf16_t*)q + (size_t)row0 * QW + u.pn * 256 + wc * 32 + 8 * fq; LAUNDER(rsp); LAUNDER(op);
#pragma unroll
        for (int ai = 0; ai < 2; ++ai)
#pragma unroll
            for (int m = 0; m < 4; ++m) { const int row = row0 + ai * 128 + m * 16; const float rs = rsp[ai * 128 + m * 16]; const int pos = pos_of(row);
#pragma unroll
                for (int bj = 0; bj < 2; ++bj) { const int strip = 8 * u.pn + 4 * bj + wc, s6 = strip % 6;
                    f32x4 v0 = acc[ai][bj][m][0] * rs, v1 = acc[ai][bj][m][1] * rs;
                    if (s6 >= 4) { const int pc = (s6 - 4) * 32 + 8 * fq;
                        const f32x4 cs0 = *(const GAS f32x4*)((const GAS float*)ropetab + (size_t)pos * 64 + pc), cs1 = *(const GAS f32x4*)((const GAS float*)ropetab + (size_t)pos * 64 + pc + 4);
                        v0 = rope4(v0, cs0); v1 = rope4(v1, cs1); }
                    *(GAS u32x4*)(op + (size_t)(ai * 128 + m * 16) * QW + bj * 128) = pack8(v0, v1); } }
    }
};
struct EpiKV {
    static constexpr bool PERM = true, MIDK = false;
    const float* rstd_kv; bf16_t* kv;
    __device__ __forceinline__ void midk(f32x4 (&)[2][2][4][2], const Unit&, int, int) const {}
    __device__ __forceinline__ void operator()(const f32x4 (&acc)[2][2][4][2], const Unit& u, int wr, int wc, int fr, int fq) const {
        EPI_ROWS; const GAS float* rsp = (const GAS float*)(rstd_kv + row0); GAS bf16_t* op = (GAS bf16_t*)kv + (size_t)row0 * KVW + u.pn * 256 + wc * 32 + 8 * fq; LAUNDER(rsp); LAUNDER(op);
#pragma unroll
        for (int ai = 0; ai < 2; ++ai)
#pragma unroll
            for (int m = 0; m < 4; ++m) { const float rs = rsp[ai * 128 + m * 16];
#pragma unroll
                for (int bj = 0; bj < 2; ++bj) *(GAS u32x4*)(op + (size_t)(ai * 128 + m * 16) * KVW + bj * 128) = pack8(acc[ai][bj][m][0] * rs, acc[ai][bj][m][1] * rs); }
    }
};
struct EpiGlu {
    static constexpr bool PERM = true, MIDK = false;
    const bf16_t* gact; bf16_t* merged; float* stA;
    __device__ __forceinline__ void midk(f32x4 (&)[2][2][4][2], const Unit&, int, int) const {}
    __device__ __forceinline__ void operator()(const f32x4 (&acc)[2][2][4][2], const Unit& u, int wr, int wc, int fr, int fq) const {
        EPI_ROWS; const int c0 = u.pn * 256 + wc * 32 + 8 * fq;
        const GAS bf16_t* gp = (const GAS bf16_t*)gact + (size_t)row0 * MIXW + c0; GAS bf16_t* op = (GAS bf16_t*)merged + (size_t)row0 * DM + c0; GAS float* sp = (GAS float*)stA + (size_t)row0 * 32 + u.pn * 4 + wc; LAUNDER(gp); LAUNDER(op); LAUNDER(sp);
#pragma unroll
        for (int ai = 0; ai < 2; ++ai)
#pragma unroll
            for (int m = 0; m < 4; ++m) { float ss = 0.f;
#pragma unroll
                for (int bj = 0; bj < 2; ++bj) {
                    const u32x4 gw = *(const GAS u32x4*)(gp + (size_t)(ai * 128 + m * 16) * MIXW + bj * 128);
                    f32x4 v0, v1; const f32x4 a0 = acc[ai][bj][m][0], a1 = acc[ai][bj][m][1];
                    v0[0] = bflo(gw.x) * sigmoidf_fast(a0[0]); v0[1] = bfhi(gw.x) * sigmoidf_fast(a0[1]); v0[2] = bflo(gw.y) * sigmoidf_fast(a0[2]); v0[3] = bfhi(gw.y) * sigmoidf_fast(a0[3]);
                    v1[0] = bflo(gw.z) * sigmoidf_fast(a1[0]); v1[1] = bfhi(gw.z) * sigmoidf_fast(a1[1]); v1[2] = bflo(gw.w) * sigmoidf_fast(a1[2]); v1[3] = bfhi(gw.w) * sigmoidf_fast(a1[3]);
                    ss += sq8(v0, v1);
                    *(GAS u32x4*)(op + (size_t)(ai * 128 + m * 16) * DM + bj * 128) = pack8(v0, v1); }
                ss = red_fq(ss); if (fq == 0) sp[(size_t)(ai * 128 + m * 16) * 32] = ss; }
    }
};
struct EpiWout {
    static constexpr bool PERM = true, MIDK = true;
    const float* xp; const float* xs; const float* r2; const float* ratio; bf16_t* x1b; float* stA;
    __device__ __forceinline__ void midk(f32x4 (&acc)[2][2][4][2], const Unit& u, int wr, int fr) const {
        EPI_ROWS; const GAS float* rp = (const GAS float*)(ratio + row0); LAUNDER(rp);
#pragma unroll
        for (int ai = 0; ai < 2; ++ai)
#pragma unroll
            for (int m = 0; m < 4; ++m) { const float rt = rp[ai * 128 + m * 16];
#pragma unroll
                for (int bj = 0; bj < 2; ++bj)
#pragma unroll
                    for (int n = 0; n < 2; ++n) acc[ai][bj][m][n] *= rt; }
    }
    __device__ __forceinline__ void operator()(const f32x4 (&acc)[2][2][4][2], const Unit& u, int wr, int wc, int fr, int fq) const {
        EPI_ROWS; const int c0 = u.pn * 256 + wc * 32 + 8 * fq; const int rowt = u.pm * 256;
        const GAS float* xin = (const GAS float*)(rowt < 16384 ? xp + (size_t)row0 * DM : xs + (size_t)(row0 - 16384) * DM) + c0;
        const GAS float* rsp = (const GAS float*)(r2 + row0); GAS bf16_t* bo = (GAS bf16_t*)x1b + (size_t)row0 * DM + c0; GAS float* sp = (GAS float*)stA + (size_t)row0 * 64 + u.pn * 4 + wc;
        LAUNDER(xin); LAUNDER(rsp); LAUNDER(bo); LAUNDER(sp);
#pragma unroll
        for (int ai = 0; ai < 2; ++ai)
#pragma unroll
            for (int m = 0; m < 4; ++m) { const float rs = rsp[ai * 128 + m * 16]; float ss = 0.f; const size_t ro = (size_t)(ai * 128 + m * 16) * DM;
#pragma unroll
                for (int bj = 0; bj < 2; ++bj) {
                    const f32x4 v0 = *(const GAS f32x4*)(xin + ro + bj * 128) + acc[ai][bj][m][0] * rs, v1 = *(const GAS f32x4*)(xin + ro + bj * 128 + 4) + acc[ai][bj][m][1] * rs;
                    ss += sq8(v0, v1);
                    *(GAS u32x4*)(bo + ro + bj * 128) = pack8(v0, v1); }
                ss = red_fq(ss); if (fq == 0) sp[(size_t)(ai * 128 + m * 16) * 64] = ss; }
    }
};
__device__ __forceinline__ float dpp_ror1(float v) { return __builtin_bit_cast(float, __builtin_amdgcn_update_dpp(0, __builtin_bit_cast(int, v), 0x121, 0xf, 0xf, false)); }
__device__ __forceinline__ float dpp_rol1(float v) { return __builtin_bit_cast(float, __builtin_amdgcn_update_dpp(0, __builtin_bit_cast(int, v), 0x12f, 0xf, 0xf, false)); }
struct EpiFfnA {
    static constexpr bool PERM = true, MIDK = false;
    const float* rstd; int row_base; bf16_t* act; bf16_t* halo_up; bf16_t* halo_gate; const float* cw; const float* cb;
    __device__ __forceinline__ void midk(f32x4 (&)[2][2][4][2], const Unit&, int, int) const {}
    __device__ __forceinline__ void operator()(const f32x4 (&acc)[2][2][4][2], const Unit& u, int wr, int wc, int fr, int fq) const {
        EPI_ROWS; const int f0 = u.pn * 128 + wc * 32 + 8 * fq;
        const GAS float* rsp = (const GAS float*)(rstd + row_base + row0); GAS bf16_t* actp = (GAS bf16_t*)act + (size_t)row0 * DFF + f0;
        const int strip0 = u.pm * 4 + wr;
        GAS bf16_t* hup_p = (GAS bf16_t*)halo_up + (size_t)strip0 * 4 * DFF + f0; GAS bf16_t* hg_p = (GAS bf16_t*)halo_gate + (size_t)strip0 * 2 * DFF + f0;
        const GAS float* cwp = (const GAS float*)(cw + f0); const GAS float* cbp = (const GAS float*)(cb + f0);
        asm volatile("" : "+v"(rsp), "+v"(actp), "+v"(hup_p), "+v"(hg_p), "+v"(cwp), "+v"(cbp));
#pragma unroll
        for (int ai = 0; ai < 2; ++ai) {
            float rs[4];
#pragma unroll
            for (int m = 0; m < 4; ++m) rs[m] = rsp[ai * 128 + m * 16];
#pragma unroll
            for (int n = 0; n < 2; ++n) {
                const f32x4 w0 = *(const GAS f32x4*)(cwp + 4 * n), w1 = *(const GAS f32x4*)(cwp + DFF + 4 * n), w2 = *(const GAS f32x4*)(cwp + 2 * DFF + 4 * n), wb = *(const GAS f32x4*)(cbp + 4 * n);
                f32x4 res[4], Uu[4];
#pragma unroll
                for (int e = 0; e < 4; ++e) {
                    float U[4], R[4], L[4];
#pragma unroll
                    for (int m = 0; m < 4; ++m) { U[m] = acc[ai][0][m][n][e] * rs[m]; R[m] = dpp_ror1(U[m]); L[m] = dpp_rol1(U[m]); Uu[m][e] = U[m]; }
#pragma unroll
                    for (int m = 0; m < 4; ++m) {
                        const float prev = (fr == 0) ? R[m > 0 ? m - 1 : 0] : R[m];
                        const float next = (fr == 15) ? L[m < 3 ? m + 1 : 3] : L[m];
                        const float cv = w0[e] * prev + w1[e] * U[m] + w2[e] * next + wb[e];
                        res[m][e] = cv * sigmoidf_fast(cv) * (acc[ai][1][m][n][e] * rs[m]);
                    }
                }
#pragma unroll
                for (int m = 0; m < 4; ++m) {
                    const bool edge = (m == 0 && fr == 0) || (m == 3 && fr == 15);
                    if (!edge) { u32x2 w; w.x = cvt_pk_bf16(res[m][0], res[m][1]); w.y = cvt_pk_bf16(res[m][2], res[m][3]); *(GAS u32x2*)(actp + (size_t)(ai * 128 + m * 16) * DFF + 4 * n) = w; }
                    if (m == 0 || m == 3) {
                        const int hs = (m == 0) ? (fr == 0 ? 0 : (fr == 1 ? 1 : -1)) : (fr == 14 ? 2 : (fr == 15 ? 3 : -1));
                        if (hs >= 0) { u32x2 w; w.x = cvt_pk_bf16(Uu[m][0], Uu[m][1]); w.y = cvt_pk_bf16(Uu[m][2], Uu[m][3]);
                            *(GAS u32x2*)(hup_p + ((size_t)(ai * 2) * 4 + hs) * DFF + 4 * n) = w;
                            if (hs == 0 || hs == 3) { const f32x4 gv = acc[ai][1][m][n] * rs[m]; u32x2 wg; wg.x = cvt_pk_bf16(gv[0], gv[1]); wg.y = cvt_pk_bf16(gv[2], gv[3]);
                                *(GAS u32x2*)(hg_p + ((size_t)(ai * 2) * 2 + (hs == 3 ? 1 : 0)) * DFF + 4 * n) = wg; } }
                    }
                }
            }
        }
    }
};
struct EpiDown {
    static constexpr bool PERM = true, MIDK = false;
    bf16_t* xb; int row_base; float* stA;
    __device__ __forceinline__ void midk(f32x4 (&)[2][2][4][2], const Unit&, int, int) const {}
    __device__ __forceinline__ void operator()(const f32x4 (&acc)[2][2][4][2], const Unit& u, int wr, int wc, int fr, int fq) const {
        EPI_ROWS; GAS bf16_t* xo = (GAS bf16_t*)xb + (size_t)(row_base + row0) * DM + u.pn * 256 + wc * 32 + 8 * fq; GAS float* sp = (GAS float*)stA + (size_t)(row_base + row0) * 64 + u.pn * 4 + wc; LAUNDER(xo); LAUNDER(sp);
#pragma unroll
        for (int ai = 0; ai < 2; ++ai)
#pragma unroll
            for (int m = 0; m < 4; ++m) { float ss = 0.f; const size_t ro = (size_t)(ai * 128 + m * 16) * DM;
#pragma unroll
                for (int bj = 0; bj < 2; ++bj) { GAS bf16_t* p = xo + ro + bj * 128; const u32x4 w = *(const GAS u32x4*)p; const f32x4 a0 = acc[ai][bj][m][0], a1 = acc[ai][bj][m][1];
                    f32x4 v0, v1; v0[0] = bflo(w.x) + a0[0]; v0[1] = bfhi(w.x) + a0[1]; v0[2] = bflo(w.y) + a0[2]; v0[3] = bfhi(w.y) + a0[3];
                    v1[0] = bflo(w.z) + a1[0]; v1[1] = bfhi(w.z) + a1[1]; v1[2] = bflo(w.w) + a1[2]; v1[3] = bfhi(w.w) + a1[3];
                    ss += sq8(v0, v1); *(GAS u32x4*)p = pack8(v0, v1); }
                ss = red_fq(ss); if (fq == 0) sp[(size_t)(ai * 128 + m * 16) * 64] = ss; }
    }
};
#undef EPI_ROWS
}

namespace attn {
using s16x4  = __attribute__((ext_vector_type(4))) short;
using f32x16 = __attribute__((ext_vector_type(16))) float;
using u32x4  = __attribute__((ext_vector_type(4))) unsigned;
constexpr int NW = 8, QBLK = 32, KVBLK = 64;
constexpr float SCALE = 0.07216878364870322f;
constexpr float THR = 8.f;
constexpr int LDQ = 3072, LDK = 4096, LDR = 64, LDO = 4096;
constexpr int SHM_V = KVBLK * 128 * 2, SHM_K = KVBLK * 128 * 2, SHM_R = KVBLK * 64 * 2;
constexpr int OFF_V = 0, OFF_K = 2 * SHM_V, OFF_R = OFF_K + 2 * SHM_K, OFF_WS = OFF_R + 2 * SHM_R, OFF_QR = OFF_WS + NW * 64 * 4, SHM_ATTN = OFF_QR + NW * 4096;
#define KSWZ(row, colB) ((row) * 256 + ((colB) ^ (((row) & 15) << 4)))
#define RSWZ(row, ch) ((row) * 128 + ((((ch) ^ (((row) >> 1) & 7))) << 4))
#define SBAR() __builtin_amdgcn_sched_barrier(0)
__device__ __forceinline__ void glds16(const void* gsrc, unsigned lds_dst) { unsigned keep;
  asm volatile("s_mov_b32 %0, m0\n\ts_mov_b32 m0, %2\n\ts_nop 0\n\tglobal_load_lds_dwordx4 %1, off\n\ts_mov_b32 m0, %0" : "=&s"(keep) : "v"(gsrc), "s"(lds_dst) : "memory"); }
__device__ __forceinline__ int crow(int r, int hi) { return (r & 3) + 8 * (r >> 2) + 4 * hi; }
__device__ __forceinline__ unsigned cvtpk(float lo, float hi) { unsigned r; asm volatile("v_cvt_pk_bf16_f32 %0, %1, %2" : "=v"(r) : "v"(lo), "v"(hi)); return r; }

__device__ __forceinline__ void partialSM(f32x16& p0, f32x16& p1, float& m_reg, float& mn, float& alpha) {
  constexpr float C = SCALE * 1.4426950408889634f;
  float pmax = p0[0];
#pragma unroll
  for (int r = 1; r < 16; ++r) pmax = fmaxf(pmax, p0[r]);
#pragma unroll
  for (int r = 0; r < 16; ++r) pmax = fmaxf(pmax, p1[r]);
  { auto rr = __builtin_amdgcn_permlane32_swap(__float_as_uint(pmax), __float_as_uint(pmax), false, false);
    pmax = fmaxf(__uint_as_float(rr[0]), __uint_as_float(rr[1])); }
  if (__builtin_expect(__all(pmax - m_reg <= THR / SCALE), 1)) { mn = m_reg; alpha = 1.f; }
  else { mn = fmaxf(m_reg, pmax); alpha = __builtin_amdgcn_exp2f((m_reg - mn) * C); m_reg = mn; }
  float mnC = -mn * C;
#pragma unroll
  for (int r = 0; r < 16; ++r) p0[r] = fmaf(p0[r], C, mnC);
#pragma unroll
  for (int r = 0; r < 16; ++r) p1[r] = fmaf(p1[r], C, mnC);
#pragma unroll
  for (int r = 0; r < 16; ++r) p0[r] = __builtin_amdgcn_exp2f(p0[r]);
}
__device__ __forceinline__ void finishSM(f32x16& p0, f32x16& p1, float alpha, float& l_reg, bf16x8& pa0, bf16x8& pa1, bf16x8& pa2, bf16x8& pa3) {
#pragma unroll
  for (int r = 0; r < 16; ++r) p1[r] = __builtin_amdgcn_exp2f(p1[r]);
  float ps = 0;
#pragma unroll
  for (int r = 0; r < 16; ++r) ps += p0[r];
#pragma unroll
  for (int r = 0; r < 16; ++r) ps += p1[r];
  { auto rr = __builtin_amdgcn_permlane32_swap(__float_as_uint(ps), __float_as_uint(ps), false, false);
    ps = __uint_as_float(rr[0]) + __uint_as_float(rr[1]); }
  l_reg = l_reg * alpha + ps;
#define PK4(P, BASE, OUT) do { unsigned a0 = cvtpk(P[BASE + 0], P[BASE + 1]), a1 = cvtpk(P[BASE + 2], P[BASE + 3]);   \
    unsigned b0 = cvtpk(P[BASE + 4], P[BASE + 5]), b1 = cvtpk(P[BASE + 6], P[BASE + 7]);                              \
    auto r0 = __builtin_amdgcn_permlane32_swap(a0, b0, false, false); auto r1 = __builtin_amdgcn_permlane32_swap(a1, b1, false, false); \
    u32x4 w = {r0[0], r1[0], r0[1], r1[1]}; OUT = *reinterpret_cast<bf16x8*>(&w); } while (0)
  PK4(p0, 0, pa0); PK4(p0, 8, pa1); PK4(p1, 0, pa2); PK4(p1, 8, pa3);
#undef PK4
}
__device__ __forceinline__ void qkt(f32x16& p0, f32x16& p1, const char* Ks, const char* Rs, const bf16x8* qr, const LAS char* qrl, int r32, int hi) {
  p0 = f32x16{}; p1 = f32x16{};
#pragma unroll
  for (int g4 = 0; g4 < 2; ++g4) {
#pragma unroll
    for (int dd = 0; dd < 4; ++dd) { const int d0 = g4 * 4 + dd; const int cb = (d0 * 16 + hi * 8) * 2;
      bf16x8 b0 = *reinterpret_cast<const bf16x8*>(Ks + KSWZ(r32, cb));
      bf16x8 b1 = *reinterpret_cast<const bf16x8*>(Ks + KSWZ(32 + r32, cb));
      p0 = __builtin_amdgcn_mfma_f32_32x32x16_bf16(b0, qr[d0], p0, 0, 0, 0);
      p1 = __builtin_amdgcn_mfma_f32_32x32x16_bf16(b1, qr[d0], p1, 0, 0, 0); }
    SBAR();
  }
#pragma unroll
  for (int d0 = 0; d0 < 4; ++d0) { const int ch = d0 * 2 + hi;
    bf16x8 b0 = *reinterpret_cast<const bf16x8*>(Rs + RSWZ(r32, ch));
    bf16x8 b1 = *reinterpret_cast<const bf16x8*>(Rs + RSWZ(32 + r32, ch));
    const bf16x8 qf = *(const LAS bf16x8*)(qrl + d0 * 1024);
    p0 = __builtin_amdgcn_mfma_f32_32x32x16_bf16(b0, qf, p0, 0, 0, 0);
    p1 = __builtin_amdgcn_mfma_f32_32x32x16_bf16(b1, qf, p1, 0, 0, 0); }
}
__device__ __forceinline__ int v_st(int k, int c) { const int kk = (k & ~0xC) | ((k & 4) << 1) | ((k & 8) >> 1); return ((kk >> 3) * 4 + (c >> 5)) * 512 + ((kk & 7) * 32 + (c & 31)) * 2; }
__device__ __forceinline__ int v_rd_base(int lane) { return ((lane & 3) << 3) | (((lane >> 2) & 3) << 6) | (((lane >> 4) & 1) << 5) | (((lane >> 5) & 1) << 8); }
constexpr int v_rd_off(int d0, int ks, int half) { return d0 * 512 + ks * 4096 + half * 2048; }
template <int OFF> __device__ __forceinline__ s16x4 tr_read(int vb) {
  s16x4 r; asm volatile("ds_read_b64_tr_b16 %0, %1 offset:%2" : "=&v"(r) : "v"(vb), "i"(OFF) : "memory"); return r;
}
template <int D0> __device__ __forceinline__ void pv_one(f32x16& od, int vb, bf16x8 pa0, bf16x8 pa1, bf16x8 pa2, bf16x8 pa3) {
  const s16x4 l0 = tr_read<v_rd_off(D0, 0, 0)>(vb), h0 = tr_read<v_rd_off(D0, 0, 1)>(vb), l1 = tr_read<v_rd_off(D0, 1, 0)>(vb), h1 = tr_read<v_rd_off(D0, 1, 1)>(vb);
  const s16x4 l2 = tr_read<v_rd_off(D0, 2, 0)>(vb), h2 = tr_read<v_rd_off(D0, 2, 1)>(vb), l3 = tr_read<v_rd_off(D0, 3, 0)>(vb), h3 = tr_read<v_rd_off(D0, 3, 1)>(vb);
  asm volatile("s_waitcnt lgkmcnt(0)" ::: "memory"); SBAR();
#define PK(L, H) (bf16x8){L[0], L[1], L[2], L[3], H[0], H[1], H[2], H[3]}
  od = __builtin_amdgcn_mfma_f32_32x32x16_bf16(pa0, PK(l0, h0), od, 0, 0, 0);
  od = __builtin_amdgcn_mfma_f32_32x32x16_bf16(pa1, PK(l1, h1), od, 0, 0, 0);
  od = __builtin_amdgcn_mfma_f32_32x32x16_bf16(pa2, PK(l2, h2), od, 0, 0, 0);
  od = __builtin_amdgcn_mfma_f32_32x32x16_bf16(pa3, PK(l3, h3), od, 0, 0, 0);
#undef PK
}
__device__ __forceinline__ void pv_d0(f32x16* o, int vb, bf16x8 pa0, bf16x8 pa1, bf16x8 pa2, bf16x8 pa3) {
  pv_one<0>(o[0], vb, pa0, pa1, pa2, pa3); pv_one<1>(o[1], vb, pa0, pa1, pa2, pa3); pv_one<2>(o[2], vb, pa0, pa1, pa2, pa3); pv_one<3>(o[3], vb, pa0, pa1, pa2, pa3);
}

typedef short v4i16_t __attribute__((ext_vector_type(4)));
__device__ __forceinline__ s16x4 vtr(const LAS char* p) { return __builtin_bit_cast(s16x4, __builtin_amdgcn_ds_read_tr16_b64_v4i16((LAS v4i16_t*)p)); }
#define PK4S(P, BASE, OUT) do { unsigned a0 = cvtpk(P[BASE + 0], P[BASE + 1]), a1 = cvtpk(P[BASE + 2], P[BASE + 3]);   \
    unsigned b0 = cvtpk(P[BASE + 4], P[BASE + 5]), b1 = cvtpk(P[BASE + 6], P[BASE + 7]);                              \
    auto r0 = __builtin_amdgcn_permlane32_swap(a0, b0, false, false); auto r1 = __builtin_amdgcn_permlane32_swap(a1, b1, false, false); \
    u32x4 w = {r0[0], r1[0], r0[1], r1[1]}; OUT = *reinterpret_cast<bf16x8*>(&w); } while (0)
__device__ __forceinline__ void attn_step(f32x16& c0, f32x16& c1, f32x16& q0, f32x16& q1, const LAS char* Kc, const LAS char* Rc, const LAS char* Vp,
                                          const bf16x8* qr, const LAS char* qrl, f32x16* o, float alp, float& l_reg, float& m_reg, float& mnc, float& alc, int ky, int rz, int hi) {
  constexpr float C = SCALE * 1.4426950408889634f;
  bf16x8 kf[2][2]; bf16x8 pa0, pa1, pa2, pa3; s16x4 vl[2][2], vh[2][2]; float ps = 0.f, pmax;
#define KLD(SET, D0) do { const int ca_ = ((D0) * 32) ^ ky; kf[SET][0] = *(const LAS bf16x8*)(Kc + ca_); kf[SET][1] = *(const LAS bf16x8*)(Kc + 8192 + ca_); } while (0)
#define RLD(SET, D) do { const int ca_ = ((((D) * 2 + hi) ^ rz) << 4); kf[SET][0] = *(const LAS bf16x8*)(Rc + ca_); kf[SET][1] = *(const LAS bf16x8*)(Rc + 4096 + ca_); } while (0)
#define VLD(SET, D0, KP) do { vl[SET][0] = vtr(Vp + (D0) * 512 + (2 * (KP)) * 4096); vh[SET][0] = vtr(Vp + (D0) * 512 + (2 * (KP)) * 4096 + 2048); \
    vl[SET][1] = vtr(Vp + (D0) * 512 + (2 * (KP) + 1) * 4096); vh[SET][1] = vtr(Vp + (D0) * 512 + (2 * (KP) + 1) * 4096 + 2048); } while (0)
#define QKM(SET, QF) do { c0 = __builtin_amdgcn_mfma_f32_32x32x16_bf16(kf[SET][0], QF, c0, 0, 0, 0); c1 = __builtin_amdgcn_mfma_f32_32x32x16_bf16(kf[SET][1], QF, c1, 0, 0, 0); } while (0)
#define VPK(SET, K) (bf16x8){vl[SET][K][0], vl[SET][K][1], vl[SET][K][2], vl[SET][K][3], vh[SET][K][0], vh[SET][K][1], vh[SET][K][2], vh[SET][K][3]}
#define PVM(SET, D0, PA, PB) do { o[D0] = __builtin_amdgcn_mfma_f32_32x32x16_bf16(PA, VPK(SET, 0), o[D0], 0, 0, 0); o[D0] = __builtin_amdgcn_mfma_f32_32x32x16_bf16(PB, VPK(SET, 1), o[D0], 0, 0, 0); } while (0)
#define PIN(x) asm volatile("" : "+v"(x))
#define EXPQ1(B) do { _Pragma("unroll") for (int r_ = (B); r_ < (B) + 4; ++r_) q1[r_] = __builtin_amdgcn_exp2f(q1[r_]); } while (0)
#define SUM8(P, B) do { _Pragma("unroll") for (int r_ = (B); r_ < (B) + 8; ++r_) ps += P[r_]; } while (0)
#define EXPC0(B) do { _Pragma("unroll") for (int r_ = (B); r_ < (B) + 4; ++r_) c0[r_] = __builtin_amdgcn_exp2f(c0[r_]); } while (0)
  KLD(0, 0); SBAR();
  KLD(1, 1); c0 = __builtin_amdgcn_mfma_f32_32x32x16_bf16(kf[0][0], qr[0], f32x16{}, 0, 0, 0); c1 = __builtin_amdgcn_mfma_f32_32x32x16_bf16(kf[0][1], qr[0], f32x16{}, 0, 0, 0); EXPQ1(0); PIN(q1); SBAR();
  KLD(0, 2); QKM(1, qr[1]); EXPQ1(4); PIN(q1); SBAR();
  KLD(1, 3); QKM(0, qr[2]); EXPQ1(8); PIN(q1); SBAR();
  KLD(0, 4); QKM(1, qr[3]); EXPQ1(12); PIN(q1); SBAR();
  KLD(1, 5); QKM(0, qr[4]); SUM8(q0, 0); PIN(ps); SBAR();
  KLD(0, 6); QKM(1, qr[5]); SUM8(q0, 8); PIN(ps); SBAR();
  KLD(1, 7); QKM(0, qr[6]); SUM8(q1, 0); PIN(ps); SBAR();
  RLD(0, 0); QKM(1, qr[7]); SUM8(q1, 8); PIN(ps); SBAR();
  { RLD(1, 1); const bf16x8 qf = *(const LAS bf16x8*)(qrl); QKM(0, qf);
    { auto rr = __builtin_amdgcn_permlane32_swap(__float_as_uint(ps), __float_as_uint(ps), false, false); ps = __uint_as_float(rr[0]) + __uint_as_float(rr[1]); }
    l_reg = l_reg * alp + ps; PK4S(q0, 0, pa0); PIN(pa0); PIN(l_reg); } SBAR();
  { RLD(0, 2); const bf16x8 qf = *(const LAS bf16x8*)(qrl + 1024); QKM(1, qf); PK4S(q0, 8, pa1); PIN(pa1); } SBAR();
  { RLD(1, 3); const bf16x8 qf = *(const LAS bf16x8*)(qrl + 2048); QKM(0, qf); PK4S(q1, 0, pa2); PIN(pa2); } SBAR();
  { VLD(0, 0, 0); const bf16x8 qf = *(const LAS bf16x8*)(qrl + 3072); QKM(1, qf); PK4S(q1, 8, pa3); PIN(pa3); } SBAR();
  VLD(1, 0, 1); PVM(0, 0, pa0, pa1);
  pmax = c0[0];
#pragma unroll
  for (int r = 1; r < 16; ++r) pmax = fmaxf(pmax, c0[r]);
  PIN(pmax); SBAR();
  VLD(0, 1, 0); PVM(1, 0, pa2, pa3);
#pragma unroll
  for (int r = 0; r < 16; ++r) pmax = fmaxf(pmax, c1[r]);
  PIN(pmax); SBAR();
  VLD(1, 1, 1); PVM(0, 1, pa0, pa1);
  { auto rr = __builtin_amdgcn_permlane32_swap(__float_as_uint(pmax), __float_as_uint(pmax), false, false); pmax = fmaxf(__uint_as_float(rr[0]), __uint_as_float(rr[1])); }
  if (__builtin_expect(__all(pmax - m_reg <= THR / SCALE), 1)) { mnc = m_reg; alc = 1.f; }
  else { mnc = fmaxf(m_reg, pmax); alc = __builtin_amdgcn_exp2f((m_reg - mnc) * C); m_reg = mnc; }
  const float mnC = -mnc * C;
#pragma unroll
  for (int r = 0; r < 16; ++r) c0[r] = fmaf(c0[r], C, mnC);
  PIN(c0); SBAR();
  VLD(0, 2, 0); PVM(1, 1, pa2, pa3);
#pragma unroll
  for (int r = 0; r < 16; ++r) c1[r] = fmaf(c1[r], C, mnC);
  PIN(c1); SBAR();
  VLD(1, 2, 1); PVM(0, 2, pa0, pa1); EXPC0(0); PIN(c0); SBAR();
  VLD(0, 3, 0); PVM(1, 2, pa2, pa3); EXPC0(4); PIN(c0); SBAR();
  VLD(1, 3, 1); PVM(0, 3, pa0, pa1); EXPC0(8); PIN(c0); SBAR();
  PVM(1, 3, pa2, pa3); EXPC0(12); PIN(c0); SBAR();
#undef KLD
#undef RLD
#undef VLD
#undef QKM
#undef VPK
#undef PVM
#undef EXPQ1
#undef PIN
#undef SUM8
#undef EXPC0
}

__device__ __forceinline__ void attn_unit(const bf16* __restrict__ Qb, const bf16* __restrict__ Kh, const bf16* __restrict__ Vh, const bf16* __restrict__ Rh,
                                          bf16* __restrict__ Ob, float* __restrict__ st, int seq, char* lds, int tid_in) {
  const int wid = tid_in;
  int lane_l = (int)__builtin_amdgcn_mbcnt_hi(~0u, __builtin_amdgcn_mbcnt_lo(~0u, 0u)); asm volatile("" : "+v"(lane_l));
  const int lane = lane_l, tid = wid * 64 + lane, r32 = lane & 31, hi = lane >> 5; (void)tid;
  char* V_lds = lds + OFF_V; char* K_lds = lds + OFF_K; char* R_lds = lds + OFF_R;
  float* ws = (float*)(lds + OFF_WS) + wid * 64; float* li_l = ws; float* al_l = ws + 32;
  float m_reg = -1e30f, l_reg = 0; f32x16 o[4] = {}; bf16x8 qr[8];
  const bf16* Qw = Qb + (long)(wid * QBLK + r32) * LDQ + hi * 8;
#pragma unroll
  for (int d0 = 0; d0 < 8; ++d0) qr[d0] = *(const GAS bf16x8*)(Qw + d0 * 16);
  LAS char* qrl = (LAS char*)(lds + OFF_QR + wid * 4096 + lane * 16);
#pragma unroll
  for (int d0 = 0; d0 < 4; ++d0) *(LAS bf16x8*)(qrl + d0 * 1024) = *(const GAS bf16x8*)(Qw + (8 + d0) * 16);
  unsigned kof0, kof1, rof, vof0, vof1;
  { const int q0 = wid, q1 = wid + 8;
    { const int row = 4 * q0 + (lane >> 4), ch = (lane & 15) ^ (row & 15); kof0 = (unsigned)(row * LDK + ch * 8) * 2u; }
    { const int row = 4 * q1 + (lane >> 4), ch = (lane & 15) ^ (row & 15); kof1 = (unsigned)(row * LDK + ch * 8) * 2u; }
    { const int row = 8 * q0 + (lane >> 3), ch = (lane & 7) ^ ((row >> 1) & 7); rof = (unsigned)(row * LDR + ch * 8) * 2u; }
    { const int st = 2 * q0 + (lane >> 5), gi = lane & 31, kk = (st >> 2) * 8 + (gi >> 2), c = (st & 3) * 32 + (gi & 3) * 8, k = (kk & ~0xC) | ((kk & 4) << 1) | ((kk & 8) >> 1); vof0 = (unsigned)(k * LDK + c) * 2u; }
    { const int st = 2 * q1 + (lane >> 5), gi = lane & 31, kk = (st >> 2) * 8 + (gi >> 2), c = (st & 3) * 32 + (gi & 3) * 8, k = (kk & ~0xC) | ((kk & 4) << 1) | ((kk & 8) >> 1); vof1 = (unsigned)(k * LDK + c) * 2u; } }
  const unsigned lds0 = (unsigned)(uintptr_t)lds;
  const unsigned dK = (unsigned)__builtin_amdgcn_readfirstlane(lds0 + OFF_K + wid * 1024), dR = (unsigned)__builtin_amdgcn_readfirstlane(lds0 + OFF_R + wid * 1024), dV = (unsigned)__builtin_amdgcn_readfirstlane(lds0 + OFF_V + wid * 1024);
#define DMA_KR(t, st) do { const char* kb_ = (const char*)Kh + (size_t)(t) * (KVBLK * LDK * 2); const char* rb_ = (const char*)Rh + (size_t)(t) * (KVBLK * LDR * 2); \
    glds16(kb_ + kof0, dK + (st) * SHM_K); glds16(kb_ + kof1, dK + (st) * SHM_K + 8192); glds16(rb_ + rof, dR + (st) * SHM_R); } while (0)
#define DMA_V(t, st) do { const char* vb_ = (const char*)Vh + (size_t)(t) * (KVBLK * LDK * 2); glds16(vb_ + vof0, dV + (st) * SHM_V); glds16(vb_ + vof1, dV + (st) * SHM_V + 8192); } while (0)
#define WAIT_BAR() asm volatile("s_waitcnt vmcnt(0) lgkmcnt(0)\n\ts_barrier" ::: "memory")
  const int vb0 = (int)(uintptr_t)V_lds + v_rd_base(lane);
#define RESC(a) do { if (__any((a) < 1.f)) { if (hi == 0) al_l[r32] = (a); asm volatile("s_waitcnt lgkmcnt(0)" ::: "memory"); \
    _Pragma("unroll") for (int d = 0; d < 4; ++d) _Pragma("unroll") for (int r = 0; r < 16; ++r) o[d][r] *= al_l[crow(r, hi)]; } } while (0)
  f32x16 pA0, pA1, pB0, pB1; float mnA, mnB, alA, alB; bf16x8 pa0, pa1, pa2, pa3; const int NT = seq / KVBLK;
  DMA_KR(0, 0); DMA_V(0, 0); WAIT_BAR();
  DMA_KR(1, 1);
  qkt(pA0, pA1, K_lds, R_lds, qr, qrl, r32, hi); partialSM(pA0, pA1, m_reg, mnA, alA);
  WAIT_BAR();
  const LAS char* Kc0 = (const LAS char*)K_lds + r32 * 256; const LAS char* Rc0 = (const LAS char*)R_lds + r32 * 128; const LAS char* Vp0 = (const LAS char*)V_lds + v_rd_base(lane);
  const int ky = (hi * 16) ^ ((r32 & 15) << 4), rz = (r32 >> 1) & 7;
#pragma unroll 1
  for (int j = 1; j + 1 < NT; j += 2) {
    DMA_KR(j + 1, 0); DMA_V(j, 1);
    attn_step(pB0, pB1, pA0, pA1, Kc0 + SHM_K, Rc0 + SHM_R, Vp0, qr, qrl, o, alA, l_reg, m_reg, mnB, alB, ky, rz, hi);
    RESC(alB); WAIT_BAR();
    if (j + 2 < NT) DMA_KR(j + 2, 1);
    DMA_V(j + 1, 0);
    attn_step(pA0, pA1, pB0, pB1, Kc0, Rc0, Vp0 + SHM_V, qr, qrl, o, alB, l_reg, m_reg, mnA, alA, ky, rz, hi);
    RESC(alA); WAIT_BAR();
  }
  DMA_V(NT - 1, 1);
  SBAR(); qkt(pB0, pB1, K_lds + SHM_K, R_lds + SHM_R, qr, qrl, r32, hi);
  finishSM(pA0, pA1, alA, l_reg, pa0, pa1, pa2, pa3); SBAR();
  pv_d0(o, vb0, pa0, pa1, pa2, pa3); partialSM(pB0, pB1, m_reg, mnB, alB);
  RESC(alB); WAIT_BAR();
  finishSM(pB0, pB1, alB, l_reg, pa0, pa1, pa2, pa3); SBAR();
  pv_d0(o, vb0 + SHM_V, pa0, pa1, pa2, pa3);
  if (hi == 0) li_l[r32] = l_reg; asm volatile("s_waitcnt lgkmcnt(0)" ::: "memory");
  int lane_e = (int)__builtin_amdgcn_mbcnt_hi(~0u, __builtin_amdgcn_mbcnt_lo(~0u, 0u)); asm volatile("" : "+v"(lane_e)); const int r32e = lane_e & 31, hie = lane_e >> 5;
  GAS bf16* Ow = (GAS bf16*)Ob + (long)(wid * QBLK + 4 * hie) * LDO + r32e; GAS float* stw = (GAS float*)st + (long)(wid * QBLK + 4 * hie) * 16;
  asm volatile("" : "+v"(Ow), "+v"(stw));
#pragma unroll
  for (int r = 0; r < 16; ++r) { const int ro = (r & 3) + 8 * (r >> 2); const float rl = __builtin_amdgcn_rcpf(li_l[ro + 4 * hie]); float ss = 0.f;
#pragma unroll
    for (int d0 = 0; d0 < 4; ++d0) { const float v = o[d0][r] * rl; ss += v * v; Ow[(long)ro * LDO + d0 * 32] = (bf16)f2bf(v); }
    ss += __shfl_xor(ss, 1); ss += __shfl_xor(ss, 2); ss += __shfl_xor(ss, 4); ss += __shfl_xor(ss, 8); ss += __shfl_xor(ss, 16);
    if (r32e == 0) stw[ro * 16] = ss; }
#undef DMA_KR
#undef DMA_V
#undef WAIT_BAR
#undef RESC
}
#undef KSWZ
#undef RSWZ
#undef SBAR
}

constexpr size_t MiB = 1u << 20;
constexpr size_t WS_CTL = 0, CTL_ZERO_BYTES = 1 * MiB;
constexpr size_t WS_RSTDX = 1 * MiB, WS_RSTDQ = WS_RSTDX + 98304, WS_RSTDKV = WS_RSTDQ + 98304, WS_R2 = WS_RSTDKV + 98304, WS_RATIO = WS_R2 + 98304, WS_RSTDX1 = WS_RATIO + 98304;
constexpr size_t WS_STA = 2 * MiB;
constexpr size_t WS_STB = 8 * MiB;
constexpr size_t WS_STQ = 10 * MiB;
constexpr size_t WS_STKV = 12 * MiB;
constexpr size_t WS_ROPE = 13 * MiB;
constexpr size_t WS_WIN = 16 * MiB;
constexpr size_t WS_WGLU = 46 * MiB;
constexpr size_t WS_WQ = 54 * MiB;
constexpr size_t WS_WKV = 60 * MiB;
constexpr size_t WS_WOUT = 64 * MiB;
constexpr size_t WS_WUG = 96 * MiB;
constexpr size_t WS_WDN = 268 * MiB;
constexpr size_t WS_W1T = 354 * MiB;
constexpr size_t WS_W2T = 370 * MiB;
constexpr size_t WS_A = 402 * MiB;
constexpr size_t WS_B = 594 * MiB;
constexpr size_t WS_QLAT = 786 * MiB, WS_KVLAT = 828 * MiB, WS_KROPE = 852 * MiB;
constexpr size_t WS_GACT = 856 * MiB;
constexpr size_t WS_HUP = 952 * MiB, WS_HGATE = 964 * MiB, WS_END = 970 * MiB;
static_assert(WS_HUP + (size_t)128 * 4 * DFF * 2 <= WS_HGATE && WS_HGATE + (size_t)128 * 2 * DFF * 2 <= WS_END, "halo");
constexpr size_t OUT_X = 0, OUT_KV = 192 * MiB;
constexpr int CW_BAR = 4096;

constexpr int NWAVES = 8;
constexpr int RING_BYTES = 131072, LDSCTL_OFF = RING_BYTES, MISC_OFF = LDSCTL_OFF + 320, LDS_BYTES = 147456;

typedef GAS unsigned gu32;
#define RLX_AGENT __ATOMIC_RELAXED, __HIP_MEMORY_SCOPE_AGENT
#define LDS_WAIT() asm volatile("s_waitcnt lgkmcnt(0)" ::: "memory")

#define XB_TMO      128
#define XB_XCNT(j)  (256  + 64 * (j))
#define XB_XSUB(j)  (1280 + 64 * (j))
#define XB_XGEN(j)  (2304 + 64 * (j))
#define XB_TOP      3328
#define XB_TOPGEN   3392
#define XCD_BAR_WORDS 3456
#define XB_SPIN_CAP (1u << 18)
__device__ __forceinline__ unsigned xb_ld(unsigned* p)              { return __hip_atomic_load(p, __ATOMIC_RELAXED, __HIP_MEMORY_SCOPE_AGENT); }
__device__ __forceinline__ unsigned xb_add(unsigned* p, unsigned v) { return __hip_atomic_fetch_add(p, v, __ATOMIC_RELAXED, __HIP_MEMORY_SCOPE_AGENT); }
__device__ __forceinline__ unsigned xb_xcc_id() { return (unsigned)__builtin_amdgcn_s_getreg((3 << 11) | 20) & 0xFu; }
#define XB_SPIN(cond, bar) do { unsigned _sp = 0; while (cond) { __builtin_amdgcn_s_sleep(1); \
    if ((++_sp & 255u) == 0u) { if (xb_ld(&(bar)[XB_TMO])) break; if (_sp > XB_SPIN_CAP) { atomicAdd(&(bar)[XB_TMO], 1u); break; } } } } while (0)
struct XcdBarrier { unsigned* bar; unsigned x; volatile LAS unsigned* st; };
__device__ __forceinline__ XcdBarrier xcd_barrier_post(unsigned* bar, volatile LAS unsigned* st) {
    XcdBarrier b; b.bar = bar; b.x = xb_xcc_id(); b.st = st;
    if (threadIdx.x == 0) (void)xb_add(&bar[XB_XCNT(b.x)], 1u);
    return b;
}
__device__ __forceinline__ void xcd_barrier_complete(unsigned* bar, unsigned x, unsigned& nloc, unsigned& nx) {
    const unsigned G = gridDim.x * gridDim.y * gridDim.z;
    unsigned sum, cnt, mine, sp = 0u;
    for (;;) {
        sum = 0u; cnt = 0u; mine = 0u;
#pragma unroll
        for (unsigned j = 0; j < 16; ++j) { const unsigned c = xb_ld(&bar[XB_XCNT(j)]); sum += c; cnt += (c > 0u) ? 1u : 0u; mine = (j == x) ? c : mine; }
        if (sum == G) break;
        __builtin_amdgcn_s_sleep(1);
        if ((++sp & 255u) == 0u) { if (xb_ld(&bar[XB_TMO])) break; if (sp > XB_SPIN_CAP) { atomicAdd(&bar[XB_TMO], 1u); break; } }
    }
    nloc = mine > 0u ? mine : 1u; nx = cnt > 0u ? cnt : 1u;
}
__device__ __forceinline__ void xcd_barrier(const XcdBarrier& b) {
    asm volatile("s_waitcnt vmcnt(0)" ::: "memory");
    __syncthreads();
    if (threadIdx.x == 0) {
        unsigned* bar = b.bar;
        __builtin_amdgcn_s_waitcnt(0);
        unsigned nloc = b.st[0], nx = b.st[1];
        if (nloc == 0u) { xcd_barrier_complete(bar, b.x, nloc, nx); b.st[0] = nloc; b.st[1] = nx; }
        const unsigned old = xb_add(&bar[XB_XSUB(b.x)], 1u);
        const unsigned gen = old / nloc;
        if (old + 1u == (gen + 1u) * nloc) {
            __builtin_amdgcn_fence(__ATOMIC_RELEASE, "agent");
            asm volatile("s_waitcnt vmcnt(0)" ::: "memory");
            const unsigned og = xb_add(&bar[XB_TOP], 1u);
            const unsigned tg = og / nx;
            if (og + 1u == (tg + 1u) * nx) xb_add(&bar[XB_TOPGEN], 1u);
            else XB_SPIN(xb_ld(&bar[XB_TOPGEN]) == tg, bar);
            __builtin_amdgcn_fence(__ATOMIC_ACQUIRE, "agent");
            xb_add(&bar[XB_XGEN(b.x)], 1u);
            asm volatile("s_waitcnt vmcnt(0)" ::: "memory");
        } else {
            XB_SPIN(xb_ld(&bar[XB_XGEN(b.x)]) == gen, bar);
            __builtin_amdgcn_fence(__ATOMIC_ACQUIRE, "agent");
            asm volatile("s_waitcnt vmcnt(0)" ::: "memory");
        }
    }
    __syncthreads();
}

__device__ __forceinline__ float wave_sum(float v) {
#pragma unroll
    for (int o = 1; o < 64; o <<= 1) v += __shfl_xor(v, o);
    return v;
}
template <class RowMap>
__device__ __forceinline__ void transpose_item(const float* W, int K, int N, bf16* WT, const float* g1, const float* g2, int ksplit, RowMap rm, LAS float* scr, int item, int lane) {
    const int nblk = N / 64; int kb, nb;
    if ((nblk & 3) == 0) { const int w = item & 7, rest = item >> 3, q = nblk >> 2; nb = (rest % q) * 4 + (w & 3); kb = (rest / q) * 2 + (w >> 2); }
    else { kb = item / nblk; nb = item % nblk; }
    const int k0 = 64 * kb, n0 = 64 * nb;
    f32x2 wv[32];
    const GAS f32x2* wp = (const GAS f32x2*)((const GAS float*)W + (size_t)(k0 + (lane >> 5)) * N + n0) + (lane & 31);
#pragma unroll
    for (int i = 0; i < 32; ++i) wv[i] = *(const GAS f32x2*)((const GAS float*)wp + (size_t)(2 * i) * N);
    float gn[32];
#pragma unroll
    for (int i = 0; i < 32; ++i) { const int k = k0 + 2 * i + (lane >> 5); gn[i] = g1 ? (k < ksplit ? g1[k] : g2[k - ksplit]) : 1.0f; }
    const int c = lane & 7;
#pragma unroll
    for (int sub = 0; sub < 2; ++sub) {
#pragma unroll
        for (int i = 0; i < 32; ++i) { const int kk = 2 * i + (lane >> 5); scr[kk * 33 + (lane & 31)] = (sub ? wv[i].y : wv[i].x) * gn[i]; }
        LDS_WAIT(); asm volatile("" ::: "memory");
#pragma unroll
        for (int j = 0; j < 4; ++j) { const int nl = (lane >> 3) + 8 * j; const LAS float* s = scr + (8 * c) * 33 + nl;
            v4u o; o.x = pg8::cvt_pk_bf16(s[0 * 33], s[1 * 33]); o.y = pg8::cvt_pk_bf16(s[2 * 33], s[3 * 33]); o.z = pg8::cvt_pk_bf16(s[4 * 33], s[5 * 33]); o.w = pg8::cvt_pk_bf16(s[6 * 33], s[7 * 33]);
            *(GAS v4u*)(WT + (size_t)rm(n0 + 2 * nl + sub) * K + k0 + 8 * c) = o; }
        LDS_WAIT(); asm volatile("" ::: "memory");
    }
}
struct RmId  { __device__ __forceinline__ int operator()(int n) const { return n; } };
struct RmWin { __device__ __forceinline__ int operator()(int n) const { if (n < 2944) return n; if (n < 3456) return n + 128; const int i = n - 3456; return 3584 + (i < 32 ? 2 * i : 2 * (i - 32) + 1); } };
struct RmQ   { __device__ __forceinline__ int operator()(int n) const { const int r = n % 192, hb = n - r; if (r < 128) return n; const int i = r - 128; return hb + 128 + (i < 32 ? 2 * i : 2 * (i - 32) + 1); } };
struct RmUp  { __device__ __forceinline__ int operator()(int n) const { return (n >> 7) * 256 + (n & 127); } };
struct RmGate{ __device__ __forceinline__ int operator()(int n) const { return (n >> 7) * 256 + 128 + (n & 127); } };

__device__ __forceinline__ void sincos_d(double a, double& s, double& c) {
    const double kd = __builtin_rint(a * 0.63661977236758134308); const long k = (long)kd;
    double r = __builtin_fma(-kd, 1.57079632679489655800e+00, a); r = __builtin_fma(-kd, 6.12323399573676603587e-17, r);
    const double r2 = r * r;
    double sp = 1.0 / 6227020800.0; sp = sp * r2 - 1.0 / 39916800.0; sp = sp * r2 + 1.0 / 362880.0; sp = sp * r2 - 1.0 / 5040.0; sp = sp * r2 + 1.0 / 120.0; sp = sp * r2 - 1.0 / 6.0; sp = sp * r2 * r + r;
    double cp = 1.0 / 479001600.0; cp = cp * r2 - 1.0 / 3628800.0; cp = cp * r2 + 1.0 / 40320.0; cp = cp * r2 - 1.0 / 720.0; cp = cp * r2 + 1.0 / 24.0; cp = cp * r2 - 0.5; cp = cp * r2 + 1.0;
    const int q = (int)(k & 3);
    s = (q == 0) ? sp : (q == 1) ? cp : (q == 2) ? -sp : -cp;
    c = (q == 0) ? cp : (q == 1) ? -sp : (q == 2) ? -cp : sp;
}

__device__ __forceinline__ void ssm_weights_group(int g, const float* a_re, const float* a_im, const float* b_re, const float* b_im, const float* c_re, const float* c_im,
                                                  const float* log_dt, const float* dskip, bf16* W1t, bf16* W2t, LAS float* L, int tid) {
    LAS float* PW = L;
    LAS float* BB = PW + 2 * 17 * 64 * 2;
    LAS float* CC = BB + 2 * 64 * 16 * 2;
    LAS float* KT = CC + 2 * 16 * 64 * 2;
    for (int i = tid; i < 2 * 17 * 64; i += 512) { const int d = i / (17 * 64), e = (i / 64) % 17, p = i & 63;
        const double dt = exp((double)log_dt[d * 128 + g]); const double are = a_re[(d * 128 + g) * 64 + p], aim = a_im[(d * 128 + g) * 64 + p];
        const double mag = exp((double)e * dt * are); double s, c; sincos_d((double)e * dt * aim, s, c);
        PW[i * 2] = (float)(mag * c); PW[i * 2 + 1] = (float)(mag * s); }
    for (int i = tid; i < 2 * 64 * 16; i += 512) { const int d = i / 1024, p = (i >> 4) & 63, h = i & 15;
        const double dt = exp((double)log_dt[d * 128 + g]); const double are = a_re[(d * 128 + g) * 64 + p], aim = a_im[(d * 128 + g) * 64 + p];
        const double x = dt * are, y = dt * aim; double sy, cy, sh, ch; sincos_d(y, sy, cy); sincos_d(0.5 * y, sh, ch);
        const double em1 = expm1(x); const double re1 = em1 * cy - 2.0 * sh * sh, im1 = (em1 + 1.0) * sy;
        const double den = are * are + aim * aim; const double qre = (re1 * are + im1 * aim) / den, qim = (im1 * are - re1 * aim) / den;
        const size_t bi = ((size_t)((d * 128 + g) * 64 + p)) * 16 + h; const double br = b_re[bi], bim = b_im[bi];
        BB[i * 2] = (float)(qre * br - qim * bim); BB[i * 2 + 1] = (float)(qre * bim + qim * br); }
    for (int i = tid; i < 2 * 16 * 64; i += 512) { const int d = i / 1024, h = (i >> 6) & 15, p = i & 63; const size_t ci = ((size_t)((d * 128 + g) * 16 + h)) * 64 + p;
        CC[i * 2] = c_re[ci]; CC[i * 2 + 1] = c_im[ci]; }
    __syncthreads();
    { const int d = tid >> 8, e = (tid >> 4) & 15, h = tid & 15; float acc[16];
#pragma unroll
        for (int q = 0; q < 16; ++q) acc[q] = 0.f;
        for (int p = 0; p < 64; ++p) { const float cr = CC[((d * 16 + h) * 64 + p) * 2], ci = CC[((d * 16 + h) * 64 + p) * 2 + 1];
            const float pr = PW[((d * 17 + e) * 64 + p) * 2], pi = PW[((d * 17 + e) * 64 + p) * 2 + 1];
            const float tr = cr * pr - ci * pi, ti = cr * pi + ci * pr; const LAS f32x4* bp = (const LAS f32x4*)(BB + ((d * 64 + p) * 16) * 2);
#pragma unroll
            for (int q = 0; q < 8; ++q) { const f32x4 b = bp[q]; acc[2 * q] += tr * b[0] - ti * b[1]; acc[2 * q + 1] += tr * b[2] - ti * b[3]; } }
#pragma unroll
        for (int q = 0; q < 16; ++q) KT[((d * 16 + e) * 16 + h) * 16 + q] = acc[q]; }
    __syncthreads();
    for (int i = tid; i < 256 * 32; i += 512) { const int n = i >> 5, k0 = (i & 31) * 8; const int d = n >> 7, im = (n >> 6) & 1, p = n & 63; const int s = k0 >> 4, h0 = k0 & 15, e = d ? s : 15 - s;
        const float pr = PW[((d * 17 + e) * 64 + p) * 2], pi = PW[((d * 17 + e) * 64 + p) * 2 + 1]; float v[8];
#pragma unroll
        for (int j = 0; j < 8; ++j) { const float br = BB[((d * 64 + p) * 16 + h0 + j) * 2], bi = BB[((d * 64 + p) * 16 + h0 + j) * 2 + 1]; v[j] = im ? (pr * bi + pi * br) : (pr * br - pi * bi); }
        v4u o; o.x = pk2(v[0], v[1]); o.y = pk2(v[2], v[3]); o.z = pk2(v[4], v[5]); o.w = pk2(v[6], v[7]);
        *(GAS v4u*)(W1t + ((size_t)(g * 256 + n)) * 256 + k0) = o; }
    for (int i = tid; i < 256 * 64; i += 512) { const int n = i >> 6, k0 = (i & 63) * 8; const int j = n >> 4, h = n & 15; float v[8];
        if (k0 < 256) { const int d = k0 >> 7, im = (k0 >> 6) & 1, p0 = k0 & 63, e = d ? 16 - j : j + 1;
#pragma unroll
            for (int q = 0; q < 8; ++q) { const int p = p0 + q; const float cr = CC[((d * 16 + h) * 64 + p) * 2], ci = CC[((d * 16 + h) * 64 + p) * 2 + 1];
                const float pr = PW[((d * 17 + e) * 64 + p) * 2], pi = PW[((d * 17 + e) * 64 + p) * 2 + 1]; v[q] = im ? -(cr * pi + ci * pr) : (cr * pr - ci * pi); }
        } else { const int s = (k0 - 256) >> 4, h0 = (k0 - 256) & 15;
#pragma unroll
            for (int q = 0; q < 8; ++q) { const int hh = h0 + q; float val = 0.f;
                if (s <= j) val += KT[((0 * 16 + (j - s)) * 16 + h) * 16 + hh];
                if (s >= j) val += KT[((1 * 16 + (s - j)) * 16 + h) * 16 + hh];
                if (s == j && h == hh) val += dskip[g * 16 + h];
                v[q] = val; } }
        v4u o; o.x = pk2(v[0], v[1]); o.y = pk2(v[2], v[3]); o.z = pk2(v[4], v[5]); o.w = pk2(v[6], v[7]);
        *(GAS v4u*)(W2t + ((size_t)(g * 256 + n)) * 512 + k0) = o; }
    __syncthreads();
}
#ifndef PROBE_ATTN
#define PROBE_ATTN 1
#endif
#ifndef PROBE_P0
#define PROBE_P0 1
#endif
#ifndef PROBE_P1
#define PROBE_P1 1
#endif
#ifndef PROBE_P7
#define PROBE_P7 1
#endif
#ifndef PROBE_FA
#define PROBE_FA 1
#endif

struct Args { const float* in[27]; float* out; unsigned char* ws; int ph_lo, ph_hi; };

__global__ void __launch_bounds__(NWAVES * 64, 2) enc_fwd(Args args) {
    extern __shared__ __attribute__((aligned(16))) unsigned char lds[];
    LAS unsigned char* ldsb = (LAS unsigned char*)lds;
    volatile LAS unsigned* MISC = (volatile LAS unsigned*)(ldsb + MISC_OFF);
    const int wave0 = __builtin_amdgcn_readfirstlane(threadIdx.x >> 6);
    const int G = gridDim.x, bx = blockIdx.x; const int vcu = (G % 8 == 0) ? (bx % 8) * (G / 8) + bx / 8 : bx;
    const int NGW = G * NWAVES, NGT = G * NWAVES * 64;
    gu32* ctl = (gu32*)(args.ws + WS_CTL);
#define PHB unsigned char* wsl = args.ws; unsigned char* outl = (unsigned char*)args.out; asm volatile("" : "+s"(wsl), "+s"(outl)); \
    int tid = wave0 * 64 + (int)__builtin_amdgcn_mbcnt_hi(~0u, __builtin_amdgcn_mbcnt_lo(~0u, 0u)); asm volatile("" : "+v"(tid)); const int lane = tid & 63, wave = wave0; \
    const int gw = vcu * NWAVES + wave, gt = vcu * (NWAVES * 64) + tid; (void)lane; (void)gw; (void)gt; (void)wsl; (void)outl
#define x_p (args.in[0])
#define x_s (args.in[1])
#define rstd_x ((float*)(wsl + WS_RSTDX))
#define rstd_q ((float*)(wsl + WS_RSTDQ))
#define rstd_kv ((float*)(wsl + WS_RSTDKV))
#define r2v ((float*)(wsl + WS_R2))
#define ratio ((float*)(wsl + WS_RATIO))
#define rstd_x1 ((float*)(wsl + WS_RSTDX1))
#define stA ((float*)(wsl + WS_STA))
#define stB ((float*)(wsl + WS_STB))
#define stQ ((float*)(wsl + WS_STQ))
#define stKV ((float*)(wsl + WS_STKV))
#define ropetab ((float*)(wsl + WS_ROPE))
#define Wi ((bf16*)(wsl + WS_WIN))
#define Wglu ((bf16*)(wsl + WS_WGLU))
#define Wq ((bf16*)(wsl + WS_WQ))
#define Wkv ((bf16*)(wsl + WS_WKV))
#define Wout ((bf16*)(wsl + WS_WOUT))
#define Wug ((bf16*)(wsl + WS_WUG))
#define Wdn ((bf16*)(wsl + WS_WDN))
#define W1t ((bf16*)(wsl + WS_W1T))
#define W2t ((bf16*)(wsl + WS_W2T))
#define bufA ((bf16*)(wsl + WS_A))
#define bufB ((bf16*)(wsl + WS_B))
#define qlat ((bf16*)(wsl + WS_QLAT))
#define kvlat ((bf16*)(wsl + WS_KVLAT))
#define krope ((bf16*)(wsl + WS_KROPE))
#define gact ((bf16*)(wsl + WS_GACT))
#define hup ((bf16*)(wsl + WS_HUP))
#define hgate ((bf16*)(wsl + WS_HGATE))
#define X ((bf16*)(outl + OUT_X))
#define kvb ((bf16*)(outl + OUT_KV))
#define xoutf ((float*)outl)
    for (int u = threadIdx.x; u < (LDS_BYTES - LDSCTL_OFF) / 4; u += NWAVES * 64) ((LAS unsigned*)(ldsb + LDSCTL_OFF))[u] = 0u;
    __syncthreads();
    XcdBarrier bar = xcd_barrier_post((unsigned*)(ctl + CW_BAR), MISC + 8);
    const int lo = args.ph_lo, hi = args.ph_hi;
#ifndef PHMASK
#define PHMASK 0xfffffffu
#endif
#define IN(k) (((PHMASK >> ((k) < 9 ? (k) : ((k) >= 18 ? 12 : 9 + ((k) - 9) % 3))) & 1u) && lo <= (k) && (k) < hi)
#define SEAM(k) do { if (IN(k) && IN((k) + 1)) xcd_barrier(bar); } while (0)

#pragma unroll 1
    for (int rep = 0; rep < PROBE_P0; ++rep)
    if (IN(0)) {
        PHB;
        if (rep) __syncthreads();
        if (vcu < 128) ssm_weights_group(vcu, args.in[4], args.in[5], args.in[6], args.in[7], args.in[8], args.in[9], args.in[10], args.in[11], W1t, W2t, (LAS float*)ldsb, tid);
        LAS float* scr = (LAS float*)(ldsb + wave * 16384);
        constexpr int I_IN = 64 * 55, I_GLU = 32 * 32, I_Q = 14 * 48, I_KV = 8 * 64, I_OUT = 64 * 64, I_UP = 64 * 172, I_DN = 172 * 64;
        constexpr int NITEMS = I_IN + I_GLU + I_Q + I_KV + I_OUT + 2 * I_UP + I_DN;
#ifndef PROBE_TR
#define PROBE_TR 1
#endif
#ifndef PROBE_X
#define PROBE_X 1
#endif
        for (int it2 = gw; it2 < PROBE_TR * NITEMS; it2 += NGW) { const int it = it2 % NITEMS;
            int r = it;
            if (r < I_IN) { transpose_item(args.in[2], 4096, 3520, Wi, args.in[3], args.in[3], 4096, RmWin(), scr, r, lane); continue; } r -= I_IN;
            if (r < I_GLU) { transpose_item(args.in[12], 2048, 2048, Wglu, nullptr, nullptr, 0, RmId(), scr, r, lane); continue; } r -= I_GLU;
            if (r < I_Q) { transpose_item(args.in[14], 896, 3072, Wq, args.in[13], args.in[13], 896, RmQ(), scr, r, lane); continue; } r -= I_Q;
            if (r < I_KV) { transpose_item(args.in[16], 512, 4096, Wkv, args.in[15], args.in[15], 512, RmId(), scr, r, lane); continue; } r -= I_KV;
            if (r < I_OUT) { transpose_item(args.in[19], 4096, 4096, Wout, args.in[17], args.in[18], 2048, RmId(), scr, r, lane); continue; } r -= I_OUT;
            if (r < I_UP) { transpose_item(args.in[21], 4096, 11008, Wug, args.in[20], args.in[20], 4096, RmUp(), scr, r, lane); continue; } r -= I_UP;
            if (r < I_UP) { transpose_item(args.in[22], 4096, 11008, Wug, args.in[20], args.in[20], 4096, RmGate(), scr, r, lane); continue; } r -= I_UP;
            transpose_item(args.in[25], 11008, 4096, Wdn, nullptr, nullptr, 0, RmId(), scr, r, lane);
        }
        for (int i = gt; i < 320 * 512; i += NGT) { const int rr = i >> 9, c8 = (i & 511) * 8; const int row = rr < 128 ? 2944 + rr : 3648 + (rr - 128);
            *(GAS v4u*)(Wi + (size_t)row * 4096 + c8) = (v4u){0u, 0u, 0u, 0u}; }
        for (int m2 = gw; m2 < PROBE_X * T; m2 += NGW) { const int m = m2 % T; const float* xr = m < 16384 ? x_p + (size_t)m * DM : x_s + (size_t)(m - 16384) * DM;
            f32x4 v[16]; float s = 0.f;
#pragma unroll
            for (int j = 0; j < 16; ++j) { v[j] = *((const GAS f32x4*)xr + lane + 64 * j); s += (v[j].x * v[j].x + v[j].y * v[j].y) + (v[j].z * v[j].z + v[j].w * v[j].w); }
            s = wave_sum(s); if (lane == 0) rstd_x[m] = 1.0f / sqrtf(s * (1.0f / DM) + EPS);
            GAS v2u* o8 = (GAS v2u*)(bufA + (size_t)m * DM) + lane;
#pragma unroll
            for (int j = 0; j < 16; ++j) o8[64 * j] = (v2u){pg8::cvt_pk_bf16(v[j].x, v[j].y), pg8::cvt_pk_bf16(v[j].z, v[j].w)}; }
        for (int i = gt; i < 8192 * 32; i += NGT) { const int pos = i >> 5, k = i & 31; const double inv = exp(-(double)k * (9.210340371976184 / 32.0));
            double s, c; sincos_d((double)pos * inv, s, c); *(GAS f32x2*)(ropetab + (size_t)i * 2) = (f32x2){(float)c, (float)s}; }
    }
    SEAM(0);

#pragma unroll 1
    for (int rep = 0; rep < PROBE_P1; ++rep)
    if (IN(1)) {
        PHB;
        pg8::Gemm g{bufA, Wi, DM, DM, DM}; pg8::StaticOrder S; S.init(T, 3840, G, bx);
        pg8::EpiWin E{rstd_x, X, qlat, kvlat, krope, stQ, stKV, ropetab};
        pg8::gemm_phase(ldsb, g, S, E, tid);
    }
    SEAM(1);

    if (IN(2)) {
        PHB;
        pg8::Gemm g{X + 256, W1t, 512, 256, 256}; pg8::GroupOrder S{768, 6, G, bx};
        pg8::EpiSsm1 E{X};
        pg8::gemm_phase(ldsb, g, S, E, tid);
        for (int r = gt; r < T; r += NGT) { float s = 0.f;
#pragma unroll
            for (int j = 0; j < 4; ++j) { const f32x4 v = *(const GAS f32x4*)(stQ + (size_t)r * 16 + 4 * j); s += (v.x + v.y) + (v.z + v.w); }
            rstd_q[r] = 1.0f / sqrtf(s * (1.0f / QLAT) + EPS); float s2 = 0.f;
#pragma unroll
            for (int j = 0; j < 2; ++j) { const f32x4 v = *(const GAS f32x4*)(stKV + (size_t)r * 8 + 4 * j); s2 += (v.x + v.y) + (v.z + v.w); }
            rstd_kv[r] = 1.0f / sqrtf(s2 * (1.0f / KVLAT) + EPS); }
    }
    SEAM(2);

    if (IN(3)) {
        PHB;
        if (wave < 4) { const int task = vcu * 4 + wave;
            if (task < 1024) { const int seq = task >> 8, g = (task >> 1) & 127, dir = task & 1, p = lane;
                const int c0 = seq < 2 ? seq * 512 : 1024 + (seq - 2) * 256, nc = seq < 2 ? 512 : 256;
                const double dt = exp((double)args.in[10][dir * 128 + g]); const double are = args.in[4][(dir * 128 + g) * 64 + p], aim = args.in[5][(dir * 128 + g) * 64 + p];
                const double mag = exp(16.0 * dt * are); double sn, cs; sincos_d(16.0 * dt * aim, sn, cs);
                const float ar = (float)(mag * cs), ai = (float)(mag * sn);
                GAS bf16* Xg = (GAS bf16*)X + (size_t)g * NCHUNK * 512 + dir * 128 + p;
                float zr = 0.f, zi = 0.f;
                for (int cb = 0; cb < nc; cb += 16) {
                    unsigned short sre[16], sim[16];
#pragma unroll
                    for (int i = 0; i < 16; ++i) { const int c = dir ? (c0 + nc - 1 - (cb + i)) : (c0 + cb + i); sre[i] = Xg[(size_t)c * 512]; sim[i] = Xg[(size_t)c * 512 + 64]; }
#pragma unroll
                    for (int i = 0; i < 16; ++i) { const int c = dir ? (c0 + nc - 1 - (cb + i)) : (c0 + cb + i);
                        Xg[(size_t)c * 512] = (bf16)f2bf(zr); Xg[(size_t)c * 512 + 64] = (bf16)f2bf(zi);
                        const float sr = bf2f(sre[i]), si = bf2f(sim[i]); const float nr = ar * zr - ai * zi + sr, ni = ar * zi + ai * zr + si; zr = nr; zi = ni; }
                }
            }
        }
        __syncthreads();
        { pg8::Gemm g{qlat, Wq, QLAT, QLAT, QLAT}; pg8::StaticOrder S; S.init(T, QW, G, bx); pg8::EpiQ E{rstd_q, bufA, ropetab}; pg8::gemm_phase(ldsb, g, S, E, tid); }
        { pg8::Gemm g{kvlat, Wkv, KVLAT, KVLAT, KVLAT}; pg8::StaticOrder S; S.init(T, KVW, G, bx); pg8::EpiKV E{rstd_kv, kvb}; pg8::gemm_phase(ldsb, g, S, E, tid); }
    }
    SEAM(3);

    if (IN(4)) {
        PHB;
        pg8::Gemm g{X, W2t, 512, 512, 512}; pg8::GroupOrder S{768, 6, G, bx};
        pg8::EpiSsm2 E{gact};
        pg8::gemm_phase(ldsb, g, S, E, tid);
    }
    SEAM(4);

    if (IN(5)) {
        PHB;
#ifndef NO_GLU
        { pg8::Gemm g{gact, Wglu, MIXW, MIXW, MIXW}; pg8::StaticOrder S; S.init(T, MIXW, G, bx); pg8::EpiGlu E{gact, bufB, stA}; pg8::gemm_phase(ldsb, g, S, E, tid); }
#endif
#ifndef NO_ATTN
        const int xcd = vcu >> 5, cc = vcu & 31; const int nun = (G == 256) ? 6 : (1536 - bx + G - 1) / G;
#pragma unroll 1
        for (int i2 = 0; i2 < PROBE_ATTN * nun; ++i2) { const int i = i2 % nun;
            int bh, qb, seq, rowbase;
            if (G == 256) { if (i < 4) { bh = xcd * 4 + i; qb = cc; seq = 8192; } else { bh = xcd * 4 + 2 * (i - 4) + (cc >> 4); qb = cc & 15; seq = 4096; } }
            else { const int uidx = bx + i * G; if (uidx < 1024) { bh = uidx >> 5; qb = uidx & 31; seq = 8192; } else { const int v = uidx - 1024; bh = v >> 4; qb = v & 15; seq = 4096; } }
            const int b = bh >> 4, h = bh & 15; rowbase = (seq == 8192) ? b * 8192 : 16384 + b * 4096;
            __syncthreads();
            attn::attn_unit(bufA + (size_t)(rowbase + qb * 256) * QW + h * 192, kvb + (size_t)rowbase * KVW + h * 256, kvb + (size_t)rowbase * KVW + h * 256 + 128,
                            krope + (size_t)rowbase * 64, bufB + (size_t)(rowbase + qb * 256) * DM + 2048 + h * 128, stB + (size_t)(rowbase + qb * 256) * 16 + h, seq, (char*)lds, wave0);
        }
#endif
    }
    SEAM(5);

    if (IN(6)) {
        PHB;
        for (int r = gt; r < T; r += NGT) { float s = 0.f;
#pragma unroll
            for (int j = 0; j < 8; ++j) { const f32x4 v = *(const GAS f32x4*)(stA + (size_t)r * 32 + 4 * j); s += (v.x + v.y) + (v.z + v.w); }
            const float r1 = 1.0f / sqrtf(s * (1.0f / MIXW) + EPS); float s2 = 0.f;
#pragma unroll
            for (int j = 0; j < 4; ++j) { const f32x4 v = *(const GAS f32x4*)(stB + (size_t)r * 16 + 4 * j); s2 += (v.x + v.y) + (v.z + v.w); }
            const float r2 = 1.0f / sqrtf(s2 * (1.0f / MIXW) + EPS); r2v[r] = r2; ratio[r] = r1 / r2; }
    }
    SEAM(6);

#pragma unroll 1
    for (int rep = 0; rep < PROBE_P7; ++rep)
    if (IN(7)) {
        PHB;
        pg8::Gemm g{bufB, Wout, DM, DM, DM}; pg8::StaticOrder S; S.init(T, DM, G, bx);
        pg8::EpiWout E{x_p, x_s, r2v, ratio, bufA, stA};
        pg8::gemm_phase(ldsb, g, S, E, tid);
    }
    SEAM(7);

    if (IN(8)) {
        PHB;
        for (int r = gt; r < T; r += NGT) { float s = 0.f;
#pragma unroll
            for (int j = 0; j < 16; ++j) { const f32x4 v = *(const GAS f32x4*)(stA + (size_t)r * 64 + 4 * j); s += (v.x + v.y) + (v.z + v.w); }
            rstd_x1[r] = 1.0f / sqrtf(s * (1.0f / DM) + EPS); }
    }
    SEAM(8);

#ifdef PROBE_KLOOP
    if (IN(9)) {
        PHB;
#pragma unroll 1
        for (int ch = 0; ch < 3; ++ch) { pg8::Gemm g{bufA + (size_t)(ch * 8192) * DM, Wug, DM, DM, DM}; pg8::StaticOrder S; S.init(8192, 2 * DFF, G, bx); pg8::EpiNull E0; pg8::gemm_phase(ldsb, g, S, E0, tid); }
    }
#endif
#pragma unroll 1
    for (int ch2 = 0; ch2 < 3 * PROBE_FA; ++ch2) {
        const int ch = ch2 / PROBE_FA; const bool lastrep = (ch2 % PROBE_FA) == PROBE_FA - 1;
        const int rb = ch * 8192;
        if (IN(9 + 3 * ch)) {
        PHB;
            pg8::Gemm g{bufA + (size_t)rb * DM, Wug, DM, DM, DM}; pg8::StaticOrder S; S.init(8192, 2 * DFF, G, bx);
            pg8::EpiFfnA E{rstd_x1, rb, bufB, hup, hgate, args.in[23], args.in[24]};
            pg8::gemm_phase(ldsb, g, S, E, tid);
        }
        SEAM(9 + 3 * ch);
        if (lastrep && IN(10 + 3 * ch)) {
        PHB;
            const float* cw = args.in[23]; const float* cb = args.in[24];
            for (int i = gt; i < 128 * 2 * (DFF / 8); i += NGT) { const int f0 = (i % (DFF / 8)) * 8, sw = i / (DFF / 8), strip = sw >> 1, which = sw & 1;
                const int lrow = strip * 64 + (which ? 63 : 0), grow = rb + lrow, pos = pos_of(grow), len = len_of(grow);
                v4u up0, up1, up2;
                if (which == 0) { up1 = *(const GAS v4u*)(hup + ((size_t)strip * 4 + 0) * DFF + f0); up2 = *(const GAS v4u*)(hup + ((size_t)strip * 4 + 1) * DFF + f0);
                    up0 = (pos == 0) ? (v4u){0u, 0u, 0u, 0u} : *(const GAS v4u*)(hup + ((size_t)(strip - 1) * 4 + 3) * DFF + f0); }
                else { up0 = *(const GAS v4u*)(hup + ((size_t)strip * 4 + 2) * DFF + f0); up1 = *(const GAS v4u*)(hup + ((size_t)strip * 4 + 3) * DFF + f0);
                    up2 = (pos == len - 1) ? (v4u){0u, 0u, 0u, 0u} : *(const GAS v4u*)(hup + ((size_t)(strip + 1) * 4 + 0) * DFF + f0); }
                const v4u gt4 = *(const GAS v4u*)(hgate + ((size_t)strip * 2 + which) * DFF + f0);
                unsigned ow[4];
#pragma unroll
                for (int k = 0; k < 4; ++k) { const int f = f0 + 2 * k;
                    const float a0 = bflo(up0[k]), a1 = bflo(up1[k]), a2 = bflo(up2[k]), b0 = bfhi(up0[k]), b1 = bfhi(up1[k]), b2 = bfhi(up2[k]);
                    const float c0 = cw[f] * a0 + cw[DFF + f] * a1 + cw[2 * DFF + f] * a2 + cb[f], c1 = cw[f + 1] * b0 + cw[DFF + f + 1] * b1 + cw[2 * DFF + f + 1] * b2 + cb[f + 1];
                    ow[k] = pk2(c0 * sigmoidf_fast(c0) * bflo(gt4[k]), c1 * sigmoidf_fast(c1) * bfhi(gt4[k])); }
                *(GAS v4u*)(bufB + (size_t)lrow * DFF + f0) = (v4u){ow[0], ow[1], ow[2], ow[3]}; }
        }
        if (lastrep) SEAM(10 + 3 * ch);
        if (lastrep && IN(11 + 3 * ch)) {
        PHB;
            pg8::Gemm g{bufB, Wdn, DFF, DFF, DFF}; pg8::StaticOrder S; S.init(8192, DM, G, bx);
            pg8::EpiDown E{bufA, rb, stA};
            pg8::gemm_phase(ldsb, g, S, E, tid);
        }
        if (lastrep) SEAM(11 + 3 * ch);
    }

    if (IN(18)) {
        PHB;
        const float* gf = args.in[26];
        for (int m = gw; m < T; m += NGW) { const float s = wave_sum(stA[(size_t)m * 64 + lane]); const float rs = 1.0f / sqrtf(s * (1.0f / DM) + EPS);
            const GAS v4u* xr = (const GAS v4u*)(bufA + (size_t)m * DM) + lane; GAS f32x4* orow = (GAS f32x4*)(xoutf + (size_t)m * DM) + 2 * lane; const GAS f32x4* gr = (const GAS f32x4*)gf + 2 * lane;
#pragma unroll
            for (int j = 0; j < 8; ++j) { const v4u w = xr[64 * j]; const f32x4 g0 = gr[128 * j], g1 = gr[128 * j + 1];
                orow[128 * j] = (f32x4){bflo(w.x) * rs * g0[0], bfhi(w.x) * rs * g0[1], bflo(w.y) * rs * g0[2], bfhi(w.y) * rs * g0[3]};
                orow[128 * j + 1] = (f32x4){bflo(w.z) * rs * g1[0], bfhi(w.z) * rs * g1[1], bflo(w.w) * rs * g1[2], bfhi(w.w) * rs * g1[3]}; } }
    }
#undef IN
#undef SEAM
}

constexpr int N_PHASES = 19;
extern "C" void kernel_launch(void* const* d_in, const int* in_sizes, int n_in, void* d_out, int out_size, void* d_ws, size_t ws_size, hipStream_t stream) {
    static int grid = 0;
    if (grid == 0) {
        if (n_in != 27 || out_size != T * DM || ws_size < WS_END) { fprintf(stderr, "kernel_launch: unexpected shapes (n_in %d out %d ws %zu)\n", n_in, out_size, ws_size); grid = -1; return; }
        int dev = 0, cus = 0, per_cu = 0;
        if (hipGetDevice(&dev) != hipSuccess || hipDeviceGetAttribute(&cus, hipDeviceAttributeMultiprocessorCount, dev) != hipSuccess) { grid = -1; return; }
        if (hipFuncSetAttribute((const void*)enc_fwd, hipFuncAttributeMaxDynamicSharedMemorySize, LDS_BYTES) != hipSuccess) { fprintf(stderr, "kernel_launch: hipFuncSetAttribute failed\n"); grid = -1; return; }
        if (hipOccupancyMaxActiveBlocksPerMultiprocessor(&per_cu, (const void*)enc_fwd, NWAVES * 64, LDS_BYTES) != hipSuccess || per_cu < 1) { fprintf(stderr, "kernel_launch: occupancy query says %d\n", per_cu); }
        (void)hipGetLastError();
        grid = cus;
    }
    if (grid < 0) return;
    if (hipMemsetAsync((char*)d_ws + WS_CTL, 0, CTL_ZERO_BYTES, stream) != hipSuccess) return;
    Args a{};
    for (int i = 0; i < 27; ++i) a.in[i] = (const float*)d_in[i];
    a.out = (float*)d_out; a.ws = (unsigned char*)d_ws;
#ifndef MK_N_LAUNCHES
#define MK_N_LAUNCHES 1
#endif
    if (MK_N_LAUNCHES == 1) { a.ph_lo = 0; a.ph_hi = N_PHASES; hipLaunchKernelGGL(enc_fwd, dim3(grid), dim3(NWAVES * 64), LDS_BYTES, stream, a); }
    else { for (int p = 0; p < N_PHASES; ++p) { a.ph_lo = p; a.ph_hi = p + 1; hipLaunchKernelGGL(enc_fwd, dim3(grid), dim3(NWAVES * 64), LDS_BYTES, stream, a); } }
    const hipError_t le = hipPeekAtLastError();
    if (le != hipSuccess) fprintf(stderr, "kernel_launch: launch failed: %s\n", hipGetErrorName(le));
}
```

```cpp
#include <hip/hip_runtime.h>
#include <hip/hip_bf16.h>
#include <cstdio>
#include <cstdint>

namespace pg8 {
#define PG8_LAS __attribute__((address_space(3)))
typedef unsigned short bf16_t;
typedef short bf16x8 __attribute__((ext_vector_type(8)));
typedef float f32x4 __attribute__((ext_vector_type(4)));
typedef float f32x2 __attribute__((ext_vector_type(2)));
typedef unsigned u32x4 __attribute__((ext_vector_type(4)));
typedef unsigned u32x2 __attribute__((ext_vector_type(2)));
constexpr int BM = 256, BK = 64, HALF = 128, HTB = HALF * BK * 2  , STAGE_BYTES = 8 * HTB, NXCD = 8, WGM = 8;

__host__ __device__ __forceinline__ int lds_byte(int r, int c) { const int st = (r >> 4) * 2 + (c >> 5), rr = r & 15, cc = c & 31, ob = rr * 64 + cc * 2; return st * 1024 + (ob ^ (((ob >> 9) & 1) << 5)); }
__host__ __device__ __forceinline__ void stage_rc(int b, int& R, int& C) { const int st = b / 1024, sb = b % 1024, swz = sb ^ (((sb >> 9) & 1) << 5); R = (st >> 1) * 16 + swz / 64; C = (st & 1) * 32 + (swz % 64) / 2; }
__host__ __device__ __forceinline__ int perm32(int rho) { const int n = rho >> 4, i = rho & 15; return 8 * (i >> 2) + 4 * n + (i & 3); }

struct Unit { int pm, pn; };
struct Gemm { const bf16_t* A; const bf16_t* Bt; int lda, ldb, K; };

struct StaticOrder {
    int nM, nN, nwg, G, c;
    __host__ __device__ void init(int M, int N, int G_, int c_) { nM = M / BM; nN = N / BM; nwg = nM * nN; G = G_; c = c_; }
    __host__ __device__ bool next(int i, Unit& u) const {
        const long L = (long)i * G + c; if (L >= nwg) return false;
        int wgid = (int)L; { const int q = nwg / NXCD, r = nwg % NXCD, xcd = wgid % NXCD, off = wgid / NXCD; wgid = (xcd < r ? xcd * (q + 1) : r * (q + 1) + (xcd - r) * q) + off; }
        const int nig = WGM * nN, gid = wgid / nig, fm = gid * WGM, gsz = (nM - fm) < WGM ? (nM - fm) : WGM;
        u.pm = fm + ((wgid % nig) % gsz); u.pn = (wgid % nig) / gsz; return true;
    }
};
struct ZeroOrder { int n, G, c; __host__ __device__ bool next(int i, Unit& u) const { const long L = (long)i * G + c; if (L >= n) return false; u.pm = 0; u.pn = 0; return true; } };
struct RangeOrder { int base, n, nN; __host__ __device__ bool next(int i, Unit& u) const { if (i >= n) return false; const int L = base + i; u.pm = L / nN; u.pn = L % nN; return true; } };
struct GroupOrder {
    int n, per, G, c;
    __host__ __device__ bool next(int i, Unit& u) const { const long L = (long)i * G + c; if (L >= n) return false; u.pm = (int)L; u.pn = (int)L / per; return true; }
};

__device__ __forceinline__ unsigned cvt_pk_bf16(float lo, float hi) { unsigned r; asm volatile("v_cvt_pk_bf16_f32 %0, %1, %2" : "=v"(r) : "v"(lo), "v"(hi)); return r; }
__device__ __forceinline__ u32x4 pack8(const f32x4 a, const f32x4 b) { u32x4 w; w.x = cvt_pk_bf16(a[0], a[1]); w.y = cvt_pk_bf16(a[2], a[3]); w.z = cvt_pk_bf16(b[0], b[1]); w.w = cvt_pk_bf16(b[2], b[3]); return w; }

template <class Epi, class Sched>
__device__ __forceinline__ void gemm_phase(PG8_LAS unsigned char* lds, const Gemm g, const Sched& S, const Epi& E, int tid_in) {
    int tid_l = tid_in; asm volatile("" : "+v"(tid_l));
    const int tid = tid_l, wid = __builtin_amdgcn_readfirstlane(tid >> 6), lane = tid & 63, wr = wid >> 2, wc = wid & 3, fr = lane & 15, fq = lane >> 4;
    const int K = g.K, nt = K / BK;
    unsigned voffA[2], voffB[2];
#pragma unroll
    for (int i = 0; i < 2; ++i) { int R, C; stage_rc(tid * 16 + i * 8192, R, C); const int Rb = Epi::PERM ? ((R & ~31) + perm32(R & 31)) : R;
        voffA[i] = (unsigned)(R * g.lda + C) * 2u; voffB[i] = (unsigned)(Rb * g.ldb + C) * 2u; }
    asm volatile("" : "+v"(voffA[0]), "+v"(voffA[1]), "+v"(voffB[0]), "+v"(voffB[1]));
    const size_t kstep = (size_t)(BK * 2);
    const size_t hstepA = (size_t)HALF * g.lda * 2, hstepB = (size_t)HALF * g.ldb * 2;
    const size_t tstepA = 2 * hstepA, tstepB = 2 * hstepB;
    const unsigned ldsw = (unsigned)wid * 1024u;
    const int aoff = lds_byte(wr * 64 + fr, fq * 8), boff = lds_byte(wc * 32 + fr, fq * 8);
#define PG8_SA(b, h) (((b) * 2 + (h)) * HTB)
#define PG8_SB(b, h) ((4 + (b) * 2 + (h)) * HTB)
#define PG8_STAGE(bufoff, gbase, voff) do { _Pragma("unroll") for (int _i = 0; _i < 2; ++_i) \
        __builtin_amdgcn_global_load_lds((const unsigned*)((const char*)(gbase) + (voff)[_i]), (PG8_LAS unsigned*)(lds + (bufoff) + ldsw + _i * 8192), 16, 0, 0); } while (0)
#define PG8_LDA(dst, b, h) do { _Pragma("unroll") for (int m = 0; m < 4; ++m) _Pragma("unroll") for (int k = 0; k < 2; ++k) dst[m][k] = *(const PG8_LAS bf16x8*)(lds + PG8_SA(b, h) + aoff + m * 2048 + k * 1024); } while (0)
#define PG8_LDB(dst, b, h) do { _Pragma("unroll") for (int n = 0; n < 2; ++n) _Pragma("unroll") for (int k = 0; k < 2; ++k) dst[n][k] = *(const PG8_LAS bf16x8*)(lds + PG8_SB(b, h) + boff + n * 2048 + k * 1024); } while (0)
#define PG8_MMA(ai, bj, At, Bt) do { __builtin_amdgcn_s_setprio(1); _Pragma("unroll") for (int m = 0; m < 4; ++m) _Pragma("unroll") for (int n = 0; n < 2; ++n) _Pragma("unroll") for (int k = 0; k < 2; ++k) \
        acc[ai][bj][m][n] = __builtin_amdgcn_mfma_f32_16x16x32_bf16(Bt[n][k], At[m][k], acc[ai][bj][m][n], 0, 0, 0); __builtin_amdgcn_s_setprio(0); } while (0)
#define PG8_WAIT_V(n) asm volatile("s_waitcnt vmcnt(" #n ")" ::: "memory")
#define PG8_WAIT_L(n) asm volatile("s_waitcnt lgkmcnt(" #n ")" ::: "memory")
#define PG8_BAR __builtin_amdgcn_s_barrier()
#define PG8_SCHED __builtin_amdgcn_sched_barrier(0)
    Unit cur, nxt; int ui = 0;
    if (!S.next(0, cur)) return;
    f32x4 acc[2][2][4][2];
#pragma unroll
    for (int a = 0; a < 2; ++a)
#pragma unroll
        for (int b = 0; b < 2; ++b)
#pragma unroll
            for (int m = 0; m < 4; ++m)
#pragma unroll
                for (int n = 0; n < 2; ++n) acc[a][b][m][n] = (f32x4){0.f, 0.f, 0.f, 0.f};
    bf16x8 At[4][2], B0[2][2], B1[2][2];
    const char* cA = (const char*)g.A + (size_t)cur.pm * tstepA; const char* cB = (const char*)g.Bt + (size_t)cur.pn * tstepB;
    PG8_STAGE(PG8_SB(0, 0), cB, voffB); PG8_STAGE(PG8_SB(0, 1), cB + hstepB, voffB); PG8_STAGE(PG8_SA(0, 0), cA, voffA); PG8_STAGE(PG8_SA(0, 1), cA + hstepA, voffA);
    if (wr == 1) PG8_BAR;
    PG8_WAIT_V(2); PG8_BAR;
    PG8_STAGE(PG8_SB(1, 0), cB + kstep, voffB); PG8_STAGE(PG8_SA(1, 0), cA + kstep, voffA); PG8_STAGE(PG8_SB(1, 1), cB + hstepB + kstep, voffB);
    PG8_WAIT_V(6); PG8_BAR;
    for (;;) {
        const bool has_next = S.next(ui + 1, nxt);
        const char* nA = has_next ? (const char*)g.A + (size_t)nxt.pm * tstepA : cA; const char* nB = has_next ? (const char*)g.Bt + (size_t)nxt.pn * tstepB : cB;
#pragma unroll 1
        for (int t = 0; t < nt; t += 2) {
            const bool last = (t == nt - 2);
            if constexpr (Epi::MIDK) { if (t == (nt >> 1)) E.midk(acc, cur, wr, fr); }
            const char* a1 = cA + (size_t)(t + 1) * kstep;
            const char* a2 = last ? nA : cA + (size_t)(t + 2) * kstep; const char* b2 = last ? nB : cB + (size_t)(t + 2) * kstep;
            const char* a3 = a2 + kstep; const char* b3 = b2 + kstep;
            PG8_LDB(B0, 0, 0); PG8_LDB(B1, 0, 1); PG8_SCHED; PG8_LDA(At, 0, 0); PG8_STAGE(PG8_SA(1, 1), a1 + hstepA, voffA);
            PG8_WAIT_V(8); PG8_WAIT_L(0); PG8_BAR; PG8_MMA(0, 0, At, B0); PG8_MMA(0, 1, At, B1); PG8_BAR; PG8_SCHED;
            PG8_LDA(At, 0, 1); PG8_STAGE(PG8_SB(0, 0), b2, voffB); PG8_STAGE(PG8_SB(0, 1), b2 + hstepB, voffB); PG8_STAGE(PG8_SA(0, 0), a2, voffA);
            PG8_WAIT_V(8); PG8_WAIT_L(0); PG8_BAR; PG8_MMA(1, 0, At, B0); PG8_MMA(1, 1, At, B1); PG8_BAR; PG8_SCHED;
            PG8_LDB(B0, 1, 0); PG8_LDB(B1, 1, 1); PG8_SCHED; PG8_LDA(At, 1, 0); PG8_STAGE(PG8_SA(0, 1), a2 + hstepA, voffA);
            PG8_WAIT_V(8); PG8_WAIT_L(0); PG8_BAR; PG8_MMA(0, 0, At, B0); PG8_MMA(0, 1, At, B1); PG8_BAR; PG8_SCHED;
            PG8_LDA(At, 1, 1); PG8_STAGE(PG8_SB(1, 0), b3, voffB); PG8_STAGE(PG8_SB(1, 1), b3 + hstepB, voffB); PG8_STAGE(PG8_SA(1, 0), a3, voffA);
            PG8_WAIT_V(8); PG8_WAIT_L(0); PG8_BAR; PG8_MMA(1, 0, At, B0); PG8_MMA(1, 1, At, B1); PG8_BAR; PG8_SCHED;
        }
        if (wr == 0) PG8_BAR;
        E(acc, cur, wr, wc, fr, fq);
        if (!has_next) break;
#pragma unroll
        for (int a = 0; a < 2; ++a)
#pragma unroll
            for (int b = 0; b < 2; ++b)
#pragma unroll
                for (int m = 0; m < 4; ++m)
#pragma unroll
                    for (int n = 0; n < 2; ++n) acc[a][b][m][n] = (f32x4){0.f, 0.f, 0.f, 0.f};
        cur = nxt; cA = nA; cB = nB; ++ui;
        if (wr == 1) PG8_BAR;
    }
    PG8_WAIT_V(0);
    PG8_BAR;
#undef PG8_SA
#undef PG8_SB
#undef PG8_STAGE
#undef PG8_LDA
#undef PG8_LDB
#undef PG8_MMA
#undef PG8_WAIT_V
#undef PG8_WAIT_L
#undef PG8_BAR
#undef PG8_SCHED
}
}

constexpr int T = 24576, DM = 4096, DFF = 11008;
constexpr int NCHUNK = T / 16;
constexpr int QLAT = 896, KVLAT = 512, QW = 3072, KVW = 4096, MIXW = 2048;
constexpr float EPS = 1e-6f;
__device__ __forceinline__ int pos_of(int r) { return r < 16384 ? (r & 8191) : (r & 4095); }
__device__ __forceinline__ int len_of(int r) { return r < 16384 ? 8192 : 4096; }

typedef unsigned short bf16;
#define GAS __attribute__((address_space(1)))
#define LAS __attribute__((address_space(3)))
typedef unsigned v4u __attribute__((ext_vector_type(4)));
typedef unsigned v2u __attribute__((ext_vector_type(2)));
typedef float f32x4 __attribute__((ext_vector_type(4)));
typedef float f32x2 __attribute__((ext_vector_type(2)));
typedef short bf16x8 __attribute__((ext_vector_type(8)));

__device__ __forceinline__ unsigned f2bf(float f) { unsigned u = __builtin_bit_cast(unsigned, f); return (u + 0x7fffu + ((u >> 16) & 1u)) >> 16; }
__device__ __forceinline__ unsigned pk2(float lo, float hi) { return f2bf(lo) | (f2bf(hi) << 16); }
__device__ __forceinline__ float bf2f(unsigned short b) { return __builtin_bit_cast(float, (unsigned)b << 16); }
__device__ __forceinline__ float bflo(unsigned w) { return __builtin_bit_cast(float, w << 16); }
__device__ __forceinline__ float bfhi(unsigned w) { return __builtin_bit_cast(float, w & 0xffff0000u); }
__device__ __forceinline__ float sigmoidf_fast(float x) { return __builtin_amdgcn_rcpf(1.0f + __builtin_amdgcn_exp2f(-1.4426950408889634f * x)); }
__device__ __forceinline__ float gelu_tanh(float y) { const float in = 1.5957691216057308f * (y + 0.044715f * y * y * y); return y * sigmoidf_fast(in); }

namespace pg8 {
#define EPI_ROWS const int row0 = u.pm * 256 + wr * 64 + fr
__device__ __forceinline__ float sq8(const f32x4 a, const f32x4 b) { return (a[0] * a[0] + a[1] * a[1]) + (a[2] * a[2] + a[3] * a[3]) + (b[0] * b[0] + b[1] * b[1]) + (b[2] * b[2] + b[3] * b[3]); }
__device__ __forceinline__ float red_fq(float s) { s += __shfl_xor(s, 16); s += __shfl_xor(s, 32); return s; }

__device__ __forceinline__ f32x4 rope4(const f32x4 v, const f32x4 cs) { f32x4 o; o[0] = v[0] * cs[0] - v[1] * cs[1]; o[1] = v[1] * cs[0] + v[0] * cs[1]; o[2] = v[2] * cs[2] - v[3] * cs[3]; o[3] = v[3] * cs[2] + v[2] * cs[3]; return o; }

#define LAUNDER(p) asm volatile("" : "+v"(p))
struct EpiNull { static constexpr bool PERM = true, MIDK = false;
    __device__ __forceinline__ void midk(f32x4 (&)[2][2][4][2], const Unit&, int, int) const {}
    __device__ __forceinline__ void operator()(const f32x4 (&acc)[2][2][4][2], const Unit& u, int wr, int wc, int fr, int fq) const {
#pragma unroll
        for (int ai = 0; ai < 2; ++ai)
#pragma unroll
            for (int bj = 0; bj < 2; ++bj)
                asm volatile("" :: "v"(acc[ai][bj][0][0]), "v"(acc[ai][bj][0][1]), "v"(acc[ai][bj][1][0]), "v"(acc[ai][bj][1][1]), "v"(acc[ai][bj][2][0]), "v"(acc[ai][bj][2][1]), "v"(acc[ai][bj][3][0]), "v"(acc[ai][bj][3][1]));
    } };
struct EpiWin {
    static constexpr bool PERM = true, MIDK = false;
    const float* rstd_x; bf16_t* X; bf16_t* qlat; bf16_t* kvlat; bf16_t* krope; float* stQ; float* stKV; const float* ropetab;
    __device__ __forceinline__ void midk(f32x4 (&)[2][2][4][2], const Unit&, int, int) const {}
    __device__ __forceinline__ void operator()(const f32x4 (&acc)[2][2][4][2], const Unit& u, int wr, int wc, int fr, int fq) const {
        EPI_ROWS; const int tile = u.pn;
        const GAS float* rsp = (const GAS float*)(rstd_x + row0); LAUNDER(rsp);
        if (tile < 8) {
            const int c0 = tile * 256 + wc * 32 + 8 * fq;
            GAS bf16_t* xp0 = (GAS bf16_t*)X + ((size_t)((c0 >> 4) * NCHUNK + (row0 >> 4)) * 512 + 256 + (row0 & 15) * 16 + (c0 & 15)); LAUNDER(xp0);
#pragma unroll
            for (int ai = 0; ai < 2; ++ai)
#pragma unroll
                for (int m = 0; m < 4; ++m) { const float rs = rsp[ai * 128 + m * 16];
#pragma unroll
                    for (int bj = 0; bj < 2; ++bj)
                        *(GAS u32x4*)(xp0 + ((size_t)(bj * 8) * NCHUNK + ai * 8 + m) * 512) = pack8(acc[ai][bj][m][0] * rs, acc[ai][bj][m][1] * rs); }
        } else if (tile < 14) {
            const bool isq = tile < 12; const int tl = isq ? tile - 8 : tile - 12; const int ld = isq ? QLAT : KVLAT;
            const int c0 = tl * 256 + wc * 32 + 8 * fq;
            GAS bf16_t* op = (GAS bf16_t*)(isq ? qlat : kvlat) + (size_t)row0 * ld + c0; GAS float* sp = (GAS float*)(isq ? stQ + (size_t)row0 * 16 : stKV + (size_t)row0 * 8) + tl * 4 + wc; LAUNDER(op); LAUNDER(sp);
#pragma unroll
            for (int ai = 0; ai < 2; ++ai)
#pragma unroll
                for (int m = 0; m < 4; ++m) { const float rs = rsp[ai * 128 + m * 16]; float ss = 0.f;
#pragma unroll
                    for (int bj = 0; bj < 2; ++bj) { const f32x4 v0 = acc[ai][bj][m][0] * rs, v1 = acc[ai][bj][m][1] * rs; ss += sq8(v0, v1);
                        if (c0 + bj * 128 < ld) *(GAS u32x4*)(op + (size_t)(ai * 128 + m * 16) * ld + bj * 128) = pack8(v0, v1); }
                    ss = red_fq(ss); if (fq == 0) sp[(size_t)(ai * 128 + m * 16) * (isq ? 16 : 8)] = ss; }
        } else {
            if (wc < 2) { const int c = wc * 32 + 8 * fq;
                GAS bf16_t* op = (GAS bf16_t*)krope + (size_t)row0 * 64 + c; LAUNDER(op);
#pragma unroll
                for (int ai = 0; ai < 2; ++ai)
#pragma unroll
                    for (int m = 0; m < 4; ++m) { const int row = row0 + ai * 128 + m * 16; const float rs = rsp[ai * 128 + m * 16]; const int pos = pos_of(row);
                        const f32x4 cs0 = *(const GAS f32x4*)((const GAS float*)ropetab + (size_t)pos * 64 + c), cs1 = *(const GAS f32x4*)((const GAS float*)ropetab + (size_t)pos * 64 + c + 4);
                        const f32x4 v0 = rope4(acc[ai][0][m][0] * rs, cs0), v1 = rope4(acc[ai][0][m][1] * rs, cs1);
                        *(GAS u32x4*)(op + (size_t)(ai * 128 + m * 16) * 64) = pack8(v0, v1); } }
        }
    }
};
struct EpiSsm1 {
    static constexpr bool PERM = true, MIDK = false;
    bf16_t* X;
    __device__ __forceinline__ void midk(f32x4 (&)[2][2][4][2], const Unit&, int, int) const {}
    __device__ __forceinline__ void operator()(const f32x4 (&acc)[2][2][4][2], const Unit& u, int wr, int wc, int fr, int fq) const {
        EPI_ROWS; GAS bf16_t* op = (GAS bf16_t*)X + (size_t)row0 * 512 + wc * 32 + 8 * fq; LAUNDER(op);
#pragma unroll
        for (int ai = 0; ai < 2; ++ai)
#pragma unroll
            for (int m = 0; m < 4; ++m)
#pragma unroll
                for (int bj = 0; bj < 2; ++bj) *(GAS u32x4*)(op + (size_t)(ai * 128 + m * 16) * 512 + bj * 128) = pack8(acc[ai][bj][m][0], acc[ai][bj][m][1]);
    }
};
struct EpiSsm2 {
    static constexpr bool PERM = true, MIDK = false;
    bf16_t* gact;
    __device__ __forceinline__ void midk(f32x4 (&)[2][2][4][2], const Unit&, int, int) const {}
    __device__ __forceinline__ void operator()(const f32x4 (&acc)[2][2][4][2], const Unit& u, int wr, int wc, int fr, int fq) const {
        EPI_ROWS; const int g = u.pn; const int c0 = wc * 32 + 8 * fq;
        GAS bf16_t* op = (GAS bf16_t*)gact + ((size_t)(row0 - g * NCHUNK) * 16 + (c0 >> 4)) * MIXW + g * 16 + (c0 & 15); LAUNDER(op);
#pragma unroll
        for (int ai = 0; ai < 2; ++ai)
#pragma unroll
            for (int m = 0; m < 4; ++m)
#pragma unroll
                for (int bj = 0; bj < 2; ++bj) { f32x4 v0 = acc[ai][bj][m][0], v1 = acc[ai][bj][m][1];
#pragma unroll
                    for (int e = 0; e < 4; ++e) { v0[e] = gelu_tanh(v0[e]); v1[e] = gelu_tanh(v1[e]); }
                    *(GAS u32x4*)(op + ((size_t)(ai * 128 + m * 16) * 16 + bj * 8) * MIXW) = pack8(v0, v1); }
    }
};
struct EpiQ {
    static constexpr bool PERM = true, MIDK = false;
    const float* rstd_q; bf16_t* q; const float* ropetab;
    __device__ __forceinline__ void midk(f32x4 (&)[2][2][4][2], const Unit&, int, int) const {}
    __device__ __forceinline__ void operator()(const f32x4 (&acc)[2][2][4][2], const Unit& u, int wr, int wc, int fr, int fq) const {
        EPI_ROWS; const GAS float* rsp = (const GAS float*)(rstd_q + row0); GAS bf16_t* op = (GAS bf16_t*)q + (size_t)row0 * QW + u.pn * 256 + wc * 32 + 8 * fq; LAUNDER(rsp); LAUNDER(op);
#pragma unroll
        for (int ai = 0; ai < 2; ++ai)
#pragma unroll
            for (int m = 0; m < 4; ++m) { const int row = row0 + ai * 128 + m * 16; const float rs = rsp[ai * 128 + m * 16]; const int pos = pos_of(row);
#pragma unroll
                for (int bj = 0; bj < 2; ++bj) { const int strip = 8 * u.pn + 4 * bj + wc, s6 = strip % 6;
                    f32x4 v0 = acc[ai][bj][m][0] * rs, v1 = acc[ai][bj][m][1] * rs;
                    if (s6 >= 4) { const int pc = (s6 - 4) * 32 + 8 * fq;
                        const f32x4 cs0 = *(const GAS f32x4*)((const GAS float*)ropetab + (size_t)pos * 64 + pc), cs1 = *(const GAS f32x4*)((const GAS float*)ropetab + (size_t)pos * 64 + pc + 4);
                        v0 = rope4(v0, cs0); v1 = rope4(v1, cs1); }
                    *(GAS u32x4*)(op + (size_t)(ai * 128 + m * 16) * QW + bj * 128) = pack8(v0, v1); } }
    }
};
struct EpiKV {
    static constexpr bool PERM = true, MIDK = false;
    const float* rstd_kv; bf16_t* kv;
    __device__ __forceinline__ void midk(f32x4 (&)[2][2][4][2], const Unit&, int, int) const {}
    __device__ __forceinline__ void operator()(const f32x4 (&acc)[2][2][4][2], const Unit& u, int wr, int wc, int fr, int fq) const {
        EPI_ROWS; const GAS float* rsp = (const GAS float*)(rstd_kv + row0); GAS bf16_t* op = (GAS bf16_t*)kv + (size_t)row0 * KVW + u.pn * 256 + wc * 32 + 8 * fq; LAUNDER(rsp); LAUNDER(op);
#pragma unroll
        for (int ai = 0; ai < 2; ++ai)
#pragma unroll
            for (int m = 0; m < 4; ++m) { const float rs = rsp[ai * 128 + m * 16];
#pragma unroll
                for (int bj = 0; bj < 2; ++bj) *(GAS u32x4*)(op + (size_t)(ai * 128 + m * 16) * KVW + bj * 128) = pack8(acc[ai][bj][m][0] * rs, acc[ai][bj][m][1] * rs); }
    }
};
struct EpiGlu {
    static constexpr bool PERM = true, MIDK = false;
    const bf16_t* gact; bf16_t* merged; float* stA;
    __device__ __forceinline__ void midk(f32x4 (&)[2][2][4][2], const Unit&, int, int) const {}
    __device__ __forceinline__ void operator()(const f32x4 (&acc)[2][2][4][2], const Unit& u, int wr, int wc, int fr, int fq) const {
        EPI_ROWS; const int c0 = u.pn * 256 + wc * 32 + 8 * fq;
        const GAS bf16_t* gp = (const GAS bf16_t*)gact + (size_t)row0 * MIXW + c0; GAS bf16_t* op = (GAS bf16_t*)merged + (size_t)row0 * DM + c0; GAS float* sp = (GAS float*)stA + (size_t)row0 * 32 + u.pn * 4 + wc; LAUNDER(gp); LAUNDER(op); LAUNDER(sp);
#pragma unroll
        for (int ai = 0; ai < 2; ++ai)
#pragma unroll
            for (int m = 0; m < 4; ++m) { float ss = 0.f;
#pragma unroll
                for (int bj = 0; bj < 2; ++bj) {
                    const u32x4 gw = *(const GAS u32x4*)(gp + (size_t)(ai * 128 + m * 16) * MIXW + bj * 128);
                    f32x4 v0, v1; const f32x4 a0 = acc[ai][bj][m][0], a1 = acc[ai][bj][m][1];
                    v0[0] = bflo(gw.x) * sigmoidf_fast(a0[0]); v0[1] = bfhi(gw.x) * sigmoidf_fast(a0[1]); v0[2] = bflo(gw.y) * sigmoidf_fast(a0[2]); v0[3] = bfhi(gw.y) * sigmoidf_fast(a0[3]);
                    v1[0] = bflo(gw.z) * sigmoidf_fast(a1[0]); v1[1] = bfhi(gw.z) * sigmoidf_fast(a1[1]); v1[2] = bflo(gw.w) * sigmoidf_fast(a1[2]); v1[3] = bfhi(gw.w) * sigmoidf_fast(a1[3]);
                    ss += sq8(v0, v1);
                    *(GAS u32x4*)(op + (size_t)(ai * 128 + m * 16) * DM + bj * 128) = pack8(v0, v1); }
                ss = red_fq(ss); if (fq == 0) sp[(size_t)(ai * 128 + m * 16) * 32] = ss; }
    }
};
struct EpiWout {
    static constexpr bool PERM = true, MIDK = true;
    const float* xp; const float* xs; const float* r2; const float* ratio; bf16_t* x1b; float* stA;
    __device__ __forceinline__ void midk(f32x4 (&acc)[2][2][4][2], const Unit& u, int wr, int fr) const {
        EPI_ROWS; const GAS float* rp = (const GAS float*)(ratio + row0); LAUNDER(rp);
#pragma unroll
        for (int ai = 0; ai < 2; ++ai)
#pragma unroll
            for (int m = 0; m < 4; ++m) { const float rt = rp[ai * 128 + m * 16];
#pragma unroll
                for (int bj = 0; bj < 2; ++bj)
#pragma unroll
                    for (int n = 0; n < 2; ++n) acc[ai][bj][m][n] *= rt; }
    }
    __device__ __forceinline__ void operator()(const f32x4 (&acc)[2][2][4][2], const Unit& u, int wr, int wc, int fr, int fq) const {
        EPI_ROWS; const int c0 = u.pn * 256 + wc * 32 + 8 * fq; const int rowt = u.pm * 256;
        const GAS float* xin = (const GAS float*)(rowt < 16384 ? xp + (size_t)row0 * DM : xs + (size_t)(row0 - 16384) * DM) + c0;
        const GAS float* rsp = (const GAS float*)(r2 + row0); GAS bf16_t* bo = (GAS bf16_t*)x1b + (size_t)row0 * DM + c0; GAS float* sp = (GAS float*)stA + (size_t)row0 * 64 + u.pn * 4 + wc;
        LAUNDER(xin); LAUNDER(rsp); LAUNDER(bo); LAUNDER(sp);
#pragma unroll
        for (int ai = 0; ai < 2; ++ai)
#pragma unroll
            for (int m = 0; m < 4; ++m) { const float rs = rsp[ai * 128 + m * 16]; float ss = 0.f; const size_t ro = (size_t)(ai * 128 + m * 16) * DM;
#pragma unroll
                for (int bj = 0; bj < 2; ++bj) {
                    const f32x4 v0 = *(const GAS f32x4*)(xin + ro + bj * 128) + acc[ai][bj][m][0] * rs, v1 = *(const GAS f32x4*)(xin + ro + bj * 128 + 4) + acc[ai][bj][m][1] * rs;
                    ss += sq8(v0, v1);
                    *(GAS u32x4*)(bo + ro + bj * 128) = pack8(v0, v1); }
                ss = red_fq(ss); if (fq == 0) sp[(size_t)(ai * 128 + m * 16) * 64] = ss; }
    }
};
__device__ __forceinline__ float dpp_ror1(float v) { return __builtin_bit_cast(float, __builtin_amdgcn_update_dpp(0, __builtin_bit_cast(int, v), 0x121, 0xf, 0xf, false)); }
__device__ __forceinline__ float dpp_rol1(float v) { return __builtin_bit_cast(float, __builtin_amdgcn_update_dpp(0, __builtin_bit_cast(int, v), 0x12f, 0xf, 0xf, false)); }
struct EpiFfnA {
    static constexpr bool PERM = true, MIDK = false;
    const float* rstd; int row_base; bf16_t* act; bf16_t* halo_up; bf16_t* halo_gate; const float* cw; const float* cb;
    __device__ __forceinline__ void midk(f32x4 (&)[2][2][4][2], const Unit&, int, int) const {}
    __device__ __forceinline__ void operator()(const f32x4 (&acc)[2][2][4][2], const Unit& u, int wr, int wc, int fr, int fq) const {
        EPI_ROWS; const int f0 = u.pn * 128 + wc * 32 + 8 * fq;
        const GAS float* rsp = (const GAS float*)(rstd + row_base + row0); GAS bf16_t* actp = (GAS bf16_t*)act + (size_t)row0 * DFF + f0;
        const int strip0 = u.pm * 4 + wr;
        GAS bf16_t* hup_p = (GAS bf16_t*)halo_up + (size_t)strip0 * 4 * DFF + f0; GAS bf16_t* hg_p = (GAS bf16_t*)halo_gate + (size_t)strip0 * 2 * DFF + f0;
        const GAS float* cwp = (const GAS float*)(cw + f0); const GAS float* cbp = (const GAS float*)(cb + f0);
        asm volatile("" : "+v"(rsp), "+v"(actp), "+v"(hup_p), "+v"(hg_p), "+v"(cwp), "+v"(cbp));
#pragma unroll
        for (int ai = 0; ai < 2; ++ai) {
            float rs[4];
#pragma unroll
            for (int m = 0; m < 4; ++m) rs[m] = rsp[ai * 128 + m * 16];
#pragma unroll
            for (int n = 0; n < 2; ++n) {
                const f32x4 w0 = *(const GAS f32x4*)(cwp + 4 * n), w1 = *(const GAS f32x4*)(cwp + DFF + 4 * n), w2 = *(const GAS f32x4*)(cwp + 2 * DFF + 4 * n), wb = *(const GAS f32x4*)(cbp + 4 * n);
                f32x4 res[4], Uu[4];
#pragma unroll
                for (int e = 0; e < 4; ++e) {
                    float U[4], R[4], L[4];
#pragma unroll
                    for (int m = 0; m < 4; ++m) { U[m] = acc[ai][0][m][n][e] * rs[m]; R[m] = dpp_ror1(U[m]); L[m] = dpp_rol1(U[m]); Uu[m][e] = U[m]; }
#pragma unroll
                    for (int m = 0; m < 4; ++m) {
                        const float prev = (fr == 0) ? R[m > 0 ? m - 1 : 0] : R[m];
                        const float next = (fr == 15) ? L[m < 3 ? m + 1 : 3] : L[m];
                        const float cv = w0[e] * prev + w1[e] * U[m] + w2[e] * next + wb[e];
                        res[m][e] = cv * sigmoidf_fast(cv) * (acc[ai][1][m][n][e] * rs[m]);
                    }
                }
#pragma unroll
                for (int m = 0; m < 4; ++m) {
                    const bool edge = (m == 0 && fr == 0) || (m == 3 && fr == 15);
                    if (!edge) { u32x2 w; w.x = cvt_pk_bf16(res[m][0], res[m][1]); w.y = cvt_pk_bf16(res[m][2], res[m][3]); *(GAS u32x2*)(actp + (size_t)(ai * 128 + m * 16) * DFF + 4 * n) = w; }
                    if (m == 0 || m == 3) {
                        const int hs = (m == 0) ? (fr == 0 ? 0 : (fr == 1 ? 1 : -1)) : (fr == 14 ? 2 : (fr == 15 ? 3 : -1));
                        if (hs >= 0) { u32x2 w; w.x = cvt_pk_bf16(Uu[m][0], Uu[m][1]); w.y = cvt_pk_bf16(Uu[m][2], Uu[m][3]);
                            *(GAS u32x2*)(hup_p + ((size_t)(ai * 2) * 4 + hs) * DFF + 4 * n) = w;
                            if (hs == 0 || hs == 3) { const f32x4 gv = acc[ai][1][m][n] * rs[m]; u32x2 wg; wg.x = cvt_pk_bf16(gv[0], gv[1]); wg.y = cvt_pk_bf16(gv[2], gv[3]);
                                *(GAS u32x2*)(hg_p + ((size_t)(ai * 2) * 2 + (hs == 3 ? 1 : 0)) * DFF + 4 * n) = wg; } }
                    }
                }
            }
        }
    }
};
struct EpiDown {
    static constexpr bool PERM = true, MIDK = false;
    bf16_t* xb; int row_base; float* stA;
    __device__ __forceinline__ void midk(f32x4 (&)[2][2][4][2], const Unit&, int, int) const {}
    __device__ __forceinline__ void operator()(const f32x4 (&acc)[2][2][4][2], const Unit& u, int wr, int wc, int fr, int fq) const {
        EPI_ROWS; GAS bf16_t* xo = (GAS bf16_t*)xb + (size_t)(row_base + row0) * DM + u.pn * 256 + wc * 32 + 8 * fq; GAS float* sp = (GAS float*)stA + (size_t)(row_base + row0) * 64 + u.pn * 4 + wc; LAUNDER(xo); LAUNDER(sp);
#pragma unroll
        for (int ai = 0; ai < 2; ++ai)
#pragma unroll
            for (int m = 0; m < 4; ++m) { float ss = 0.f; const size_t ro = (size_t)(ai * 128 + m * 16) * DM;
#pragma unroll
                for (int bj = 0; bj < 2; ++bj) { GAS bf16_t* p = xo + ro + bj * 128; const u32x4 w = *(const GAS u32x4*)p; const f32x4 a0 = acc[ai][bj][m][0], a1 = acc[ai][bj][m][1];
                    f32x4 v0, v1; v0[0] = bflo(w.x) + a0[0]; v0[1] = bfhi(w.x) + a0[1]; v0[2] = bflo(w.y) + a0[2]; v0[3] = bfhi(w.y) + a0[3];
                    v1[0] = bflo(w.z) + a1[0]; v1[1] = bfhi(w.z) + a1[1]; v1[2] = bflo(w.w) + a1[2]; v1[3] = bfhi(w.w) + a1[3];
                    ss += sq8(v0, v1); *(GAS u32x4*)p = pack8(v0, v1); }
                ss = red_fq(ss); if (fq == 0) sp[(size_t)(ai * 128 + m * 16) * 64] = ss; }
    }
};
#undef EPI_ROWS
}

namespace attn {
using s16x4  = __attribute__((ext_vector_type(4))) short;
using f32x16 = __attribute__((ext_vector_type(16))) float;
using u32x4  = __attribute__((ext_vector_type(4))) unsigned;
constexpr int NW = 8, QBLK = 32, KVBLK = 64;
constexpr float SCALE = 0.07216878364870322f;
constexpr float THR = 8.f;
constexpr int LDQ = 3072, LDK = 4096, LDR = 64, LDO = 4096;
constexpr int SHM_V = KVBLK * 128 * 2, SHM_K = KVBLK * 128 * 2, SHM_R = KVBLK * 64 * 2;
constexpr int OFF_V = 0, OFF_K = 2 * SHM_V, OFF_R = OFF_K + 2 * SHM_K, OFF_WS = OFF_R + 2 * SHM_R, OFF_QR = OFF_WS + NW * 64 * 4, SHM_ATTN = OFF_QR + NW * 4096;
#define KSWZ(row, colB) ((row) * 256 + ((colB) ^ (((row) & 15) << 4)))
#define RSWZ(row, ch) ((row) * 128 + ((((ch) ^ (((row) >> 1) & 7))) << 4))
#define SBAR() __builtin_amdgcn_sched_barrier(0)
__device__ __forceinline__ void glds16(const void* gsrc, unsigned lds_dst) { unsigned keep;
  asm volatile("s_mov_b32 %0, m0\n\ts_mov_b32 m0, %2\n\ts_nop 0\n\tglobal_load_lds_dwordx4 %1, off\n\ts_mov_b32 m0, %0" : "=&s"(keep) : "v"(gsrc), "s"(lds_dst) : "memory"); }
__device__ __forceinline__ int crow(int r, int hi) { return (r & 3) + 8 * (r >> 2) + 4 * hi; }
__device__ __forceinline__ unsigned cvtpk(float lo, float hi) { unsigned r; asm volatile("v_cvt_pk_bf16_f32 %0, %1, %2" : "=v"(r) : "v"(lo), "v"(hi)); return r; }

__device__ __forceinline__ void partialSM(f32x16& p0, f32x16& p1, float& m_reg, float& mn, float& alpha) {
  constexpr float C = SCALE * 1.4426950408889634f;
  float pmax = p0[0];
#pragma unroll
  for (int r = 1; r < 16; ++r) pmax = fmaxf(pmax, p0[r]);
#pragma unroll
  for (int r = 0; r < 16; ++r) pmax = fmaxf(pmax, p1[r]);
  { auto rr = __builtin_amdgcn_permlane32_swap(__float_as_uint(pmax), __float_as_uint(pmax), false, false);
    pmax = fmaxf(__uint_as_float(rr[0]), __uint_as_float(rr[1])); }
  if (__builtin_expect(__all(pmax - m_reg <= THR / SCALE), 1)) { mn = m_reg; alpha = 1.f; }
  else { mn = fmaxf(m_reg, pmax); alpha = __builtin_amdgcn_exp2f((m_reg - mn) * C); m_reg = mn; }
  float mnC = -mn * C;
#pragma unroll
  for (int r = 0; r < 16; ++r) p0[r] = fmaf(p0[r], C, mnC);
#pragma unroll
  for (int r = 0; r < 16; ++r) p1[r] = fmaf(p1[r], C, mnC);
#pragma unroll
  for (int r = 0; r < 16; ++r) p0[r] = __builtin_amdgcn_exp2f(p0[r]);
}
__device__ __forceinline__ void finishSM(f32x16& p0, f32x16& p1, float alpha, float& l_reg, bf16x8& pa0, bf16x8& pa1, bf16x8& pa2, bf16x8& pa3) {
#pragma unroll
  for (int r = 0; r < 16; ++r) p1[r] = __builtin_amdgcn_exp2f(p1[r]);
  float ps = 0;
#pragma unroll
  for (int r = 0; r < 16; ++r) ps += p0[r];
#pragma unroll
  for (int r = 0; r < 16; ++r) ps += p1[r];
  { auto rr = __builtin_amdgcn_permlane32_swap(__float_as_uint(ps), __float_as_uint(ps), false, false);
    ps = __uint_as_float(rr[0]) + __uint_as_float(rr[1]); }
  l_reg = l_reg * alpha + ps;
#define PK4(P, BASE, OUT) do { unsigned a0 = cvtpk(P[BASE + 0], P[BASE + 1]), a1 = cvtpk(P[BASE + 2], P[BASE + 3]);   \
    unsigned b0 = cvtpk(P[BASE + 4], P[BASE + 5]), b1 = cvtpk(P[BASE + 6], P[BASE + 7]);                              \
    auto r0 = __builtin_amdgcn_permlane32_swap(a0, b0, false, false); auto r1 = __builtin_amdgcn_permlane32_swap(a1, b1, false, false); \
    u32x4 w = {r0[0], r1[0], r0[1], r1[1]}; OUT = *reinterpret_cast<bf16x8*>(&w); } while (0)
  PK4(p0, 0, pa0); PK4(p0, 8, pa1); PK4(p1, 0, pa2); PK4(p1, 8, pa3);
#undef PK4
}
__device__ __forceinline__ void qkt(f32x16& p0, f32x16& p1, const char* Ks, const char* Rs, const bf16x8* qr, const LAS char* qrl, int r32, int hi) {
  p0 = f32x16{}; p1 = f32x16{};
#pragma unroll
  for (int g4 = 0; g4 < 2; ++g4) {
#pragma unroll
    for (int dd = 0; dd < 4; ++dd) { const int d0 = g4 * 4 + dd; const int cb = (d0 * 16 + hi * 8) * 2;
      bf16x8 b0 = *reinterpret_cast<const bf16x8*>(Ks + KSWZ(r32, cb));
      bf16x8 b1 = *reinterpret_cast<const bf16x8*>(Ks + KSWZ(32 + r32, cb));
      p0 = __builtin_amdgcn_mfma_f32_32x32x16_bf16(b0, qr[d0], p0, 0, 0, 0);
      p1 = __builtin_amdgcn_mfma_f32_32x32x16_bf16(b1, qr[d0], p1, 0, 0, 0); }
    SBAR();
  }
#pragma unroll
  for (int d0 = 0; d0 < 4; ++d0) { const int ch = d0 * 2 + hi;
    bf16x8 b0 = *reinterpret_cast<const bf16x8*>(Rs + RSWZ(r32, ch));
    bf16x8 b1 = *reinterpret_cast<const bf16x8*>(Rs + RSWZ(32 + r32, ch));
    const bf16x8 qf = *(const LAS bf16x8*)(qrl + d0 * 1024);
    p0 = __builtin_amdgcn_mfma_f32_32x32x16_bf16(b0, qf, p0, 0, 0, 0);
    p1 = __builtin_amdgcn_mfma_f32_32x32x16_bf16(b1, qf, p1, 0, 0, 0); }
}
__device__ __forceinline__ int v_st(int k, int c) { const int kk = (k & ~0xC) | ((k & 4) << 1) | ((k & 8) >> 1); return ((kk >> 3) * 4 + (c >> 5)) * 512 + ((kk & 7) * 32 + (c & 31)) * 2; }
__device__ __forceinline__ int v_rd_base(int lane) { return ((lane & 3) << 3) | (((lane >> 2) & 3) << 6) | (((lane >> 4) & 1) << 5) | (((lane >> 5) & 1) << 8); }
constexpr int v_rd_off(int d0, int ks, int half) { return d0 * 512 + ks * 4096 + half * 2048; }
template <int OFF> __device__ __forceinline__ s16x4 tr_read(int vb) {
  s16x4 r; asm volatile("ds_read_b64_tr_b16 %0, %1 offset:%2" : "=&v"(r) : "v"(vb), "i"(OFF) : "memory"); return r;
}
template <int D0> __device__ __forceinline__ void pv_one(f32x16& od, int vb, bf16x8 pa0, bf16x8 pa1, bf16x8 pa2, bf16x8 pa3) {
  const s16x4 l0 = tr_read<v_rd_off(D0, 0, 0)>(vb), h0 = tr_read<v_rd_off(D0, 0, 1)>(vb), l1 = tr_read<v_rd_off(D0, 1, 0)>(vb), h1 = tr_read<v_rd_off(D0, 1, 1)>(vb);
  const s16x4 l2 = tr_read<v_rd_off(D0, 2, 0)>(vb), h2 = tr_read<v_rd_off(D0, 2, 1)>(vb), l3 = tr_read<v_rd_off(D0, 3, 0)>(vb), h3 = tr_read<v_rd_off(D0, 3, 1)>(vb);
  asm volatile("s_waitcnt lgkmcnt(0)" ::: "memory"); SBAR();
#define PK(L, H) (bf16x8){L[0], L[1], L[2], L[3], H[0], H[1], H[2], H[3]}
  od = __builtin_amdgcn_mfma_f32_32x32x16_bf16(pa0, PK(l0, h0), od, 0, 0, 0);
  od = __builtin_amdgcn_mfma_f32_32x32x16_bf16(pa1, PK(l1, h1), od, 0, 0, 0);
  od = __builtin_amdgcn_mfma_f32_32x32x16_bf16(pa2, PK(l2, h2), od, 0, 0, 0);
  od = __builtin_amdgcn_mfma_f32_32x32x16_bf16(pa3, PK(l3, h3), od, 0, 0, 0);
#undef PK
}
__device__ __forceinline__ void pv_d0(f32x16* o, int vb, bf16x8 pa0, bf16x8 pa1, bf16x8 pa2, bf16x8 pa3) {
  pv_one<0>(o[0], vb, pa0, pa1, pa2, pa3); pv_one<1>(o[1], vb, pa0, pa1, pa2, pa3); pv_one<2>(o[2], vb, pa0, pa1, pa2, pa3); pv_one<3>(o[3], vb, pa0, pa1, pa2, pa3);
}

typedef short v4i16_t __attribute__((ext_vector_type(4)));
__device__ __forceinline__ s16x4 vtr(const LAS char* p) { return __builtin_bit_cast(s16x4, __builtin_amdgcn_ds_read_tr16_b64_v4i16((LAS v4i16_t*)p)); }
#define PK4S(P, BASE, OUT) do { unsigned a0 = cvtpk(P[BASE + 0], P[BASE + 1]), a1 = cvtpk(P[BASE + 2], P[BASE + 3]);   \
    unsigned b0 = cvtpk(P[BASE + 4], P[BASE + 5]), b1 = cvtpk(P[BASE + 6], P[BASE + 7]);                              \
    auto r0 = __builtin_amdgcn_permlane32_swap(a0, b0, false, false); auto r1 = __builtin_amdgcn_permlane32_swap(a1, b1, false, false); \
    u32x4 w = {r0[0], r1[0], r0[1], r1[1]}; OUT = *reinterpret_cast<bf16x8*>(&w); } while (0)
__device__ __forceinline__ void attn_step(f32x16& c0, f32x16& c1, f32x16& q0, f32x16& q1, const LAS char* Kc, const LAS char* Rc, const LAS char* Vp,
                                          const bf16x8* qr, const LAS char* qrl, f32x16* o, float alp, float& l_reg, float& m_reg, float& mnc, float& alc, int ky, int rz, int hi) {
  constexpr float C = SCALE * 1.4426950408889634f;
  bf16x8 kf[2][2]; bf16x8 pa0, pa1, pa2, pa3; s16x4 vl[2][2], vh[2][2]; float ps = 0.f, pmax;
#define KLD(SET, D0) do { const int ca_ = ((D0) * 32) ^ ky; kf[SET][0] = *(const LAS bf16x8*)(Kc + ca_); kf[SET][1] = *(const LAS bf16x8*)(Kc + 8192 + ca_); } while (0)
#define RLD(SET, D) do { const int ca_ = ((((D) * 2 + hi) ^ rz) << 4); kf[SET][0] = *(const LAS bf16x8*)(Rc + ca_); kf[SET][1] = *(const LAS bf16x8*)(Rc + 4096 + ca_); } while (0)
#define VLD(SET, D0, KP) do { vl[SET][0] = vtr(Vp + (D0) * 512 + (2 * (KP)) * 4096); vh[SET][0] = vtr(Vp + (D0) * 512 + (2 * (KP)) * 4096 + 2048); \
    vl[SET][1] = vtr(Vp + (D0) * 512 + (2 * (KP) + 1) * 4096); vh[SET][1] = vtr(Vp + (D0) * 512 + (2 * (KP) + 1) * 4096 + 2048); } while (0)
#define QKM(SET, QF) do { c0 = __builtin_amdgcn_mfma_f32_32x32x16_bf16(kf[SET][0], QF, c0, 0, 0, 0); c1 = __builtin_amdgcn_mfma_f32_32x32x16_bf16(kf[SET][1], QF, c1, 0, 0, 0); } while (0)
#define VPK(SET, K) (bf16x8){vl[SET][K][0], vl[SET][K][1], vl[SET][K][2], vl[SET][K][3], vh[SET][K][0], vh[SET][K][1], vh[SET][K][2], vh[SET][K][3]}
#define PVM(SET, D0, PA, PB) do { o[D0] = __builtin_amdgcn_mfma_f32_32x32x16_bf16(PA, VPK(SET, 0), o[D0], 0, 0, 0); o[D0] = __builtin_amdgcn_mfma_f32_32x32x16_bf16(PB, VPK(SET, 1), o[D0], 0, 0, 0); } while (0)
#define PIN(x) asm volatile("" : "+v"(x))
#define EXPQ1(B) do { _Pragma("unroll") for (int r_ = (B); r_ < (B) + 4; ++r_) q1[r_] = __builtin_amdgcn_exp2f(q1[r_]); } while (0)
#define SUM8(P, B) do { _Pragma("unroll") for (int r_ = (B); r_ < (B) + 8; ++r_) ps += P[r_]; } while (0)
#define EXPC0(B) do { _Pragma("unroll") for (int r_ = (B); r_ < (B) + 4; ++r_) c0[r_] = __builtin_amdgcn_exp2f(c0[r_]); } while (0)
  KLD(0, 0); SBAR();
  KLD(1, 1); c0 = __builtin_amdgcn_mfma_f32_32x32x16_bf16(kf[0][0], qr[0], f32x16{}, 0, 0, 0); c1 = __builtin_amdgcn_mfma_f32_32x32x16_bf16(kf[0][1], qr[0], f32x16{}, 0, 0, 0); EXPQ1(0); PIN(q1); SBAR();
  KLD(0, 2); QKM(1, qr[1]); EXPQ1(4); PIN(q1); SBAR();
  KLD(1, 3); QKM(0, qr[2]); EXPQ1(8); PIN(q1); SBAR();
  KLD(0, 4); QKM(1, qr[3]); EXPQ1(12); PIN(q1); SBAR();
  KLD(1, 5); QKM(0, qr[4]); SUM8(q0, 0); PIN(ps); SBAR();
  KLD(0, 6); QKM(1, qr[5]); SUM8(q0, 8); PIN(ps); SBAR();
  KLD(1, 7); QKM(0, qr[6]); SUM8(q1, 0); PIN(ps); SBAR();
  RLD(0, 0); QKM(1, qr[7]); SUM8(q1, 8); PIN(ps); SBAR();
  { RLD(1, 1); const bf16x8 qf = *(const LAS bf16x8*)(qrl); QKM(0, qf);
    { auto rr = __builtin_amdgcn_permlane32_swap(__float_as_uint(ps), __float_as_uint(ps), false, false); ps = __uint_as_float(rr[0]) + __uint_as_float(rr[1]); }
    l_reg = l_reg * alp + ps; PK4S(q0, 0, pa0); PIN(pa0); PIN(l_reg); } SBAR();
  { RLD(0, 2); const bf16x8 qf = *(const LAS bf16x8*)(qrl + 1024); QKM(1, qf); PK4S(q0, 8, pa1); PIN(pa1); } SBAR();
  { RLD(1, 3); const bf16x8 qf = *(const LAS bf16x8*)(qrl + 2048); QKM(0, qf); PK4S(q1, 0, pa2); PIN(pa2); } SBAR();
  { VLD(0, 0, 0); const bf16x8 qf = *(const LAS bf16x8*)(qrl + 3072); QKM(1, qf); PK4S(q1, 8, pa3); PIN(pa3); } SBAR();
  VLD(1, 0, 1); PVM(0, 0, pa0, pa1);
  pmax = c0[0];
#pragma unroll
  for (int r = 1; r < 16; ++r) pmax = fmaxf(pmax, c0[r]);
  PIN(pmax); SBAR();
  VLD(0, 1, 0); PVM(1, 0, pa2, pa3);
#pragma unroll
  for (int r = 0; r < 16; ++r) pmax = fmaxf(pmax, c1[r]);
  PIN(pmax); SBAR();
  VLD(1, 1, 1); PVM(0, 1, pa0, pa1);
  { auto rr = __builtin_amdgcn_permlane32_swap(__float_as_uint(pmax), __float_as_uint(pmax), false, false); pmax = fmaxf(__uint_as_float(rr[0]), __uint_as_float(rr[1])); }
  if (__builtin_expect(__all(pmax - m_reg <= THR / SCALE), 1)) { mnc = m_reg; alc = 1.f; }
  else { mnc = fmaxf(m_reg, pmax); alc = __builtin_amdgcn_exp2f((m_reg - mnc) * C); m_reg = mnc; }
  const float mnC = -mnc * C;
#pragma unroll
  for (int r = 0; r < 16; ++r) c0[r] = fmaf(c0[r], C, mnC);
  PIN(c0); SBAR();
  VLD(0, 2, 0); PVM(1, 1, pa2, pa3);
#pragma unroll
  for (int r = 0; r < 16; ++r) c1[r] = fmaf(c1[r], C, mnC);
  PIN(c1); SBAR();
  VLD(1, 2, 1); PVM(0, 2, pa0, pa1); EXPC0(0); PIN(c0); SBAR();
  VLD(0, 3, 0); PVM(1, 2, pa2, pa3); EXPC0(4); PIN(c0); SBAR();
  VLD(1, 3, 1); PVM(0, 3, pa0, pa1); EXPC0(8); PIN(c0); SBAR();
  PVM(1, 3, pa2, pa3); EXPC0(12); PIN(c0); SBAR();
#undef KLD
#undef RLD
#undef VLD
#undef QKM
#undef VPK
#undef PVM
#undef EXPQ1
#undef PIN
#undef SUM8
#undef EXPC0
}

__device__ __forceinline__ void attn_unit(const bf16* __restrict__ Qb, const bf16* __restrict__ Kh, const bf16* __restrict__ Vh, const bf16* __restrict__ Rh,
                                          bf16* __restrict__ Ob, float* __restrict__ st, int seq, char* lds, int tid_in) {
  const int wid = tid_in;
  int lane_l = (int)__builtin_amdgcn_mbcnt_hi(~0u, __builtin_amdgcn_mbcnt_lo(~0u, 0u)); asm volatile("" : "+v"(lane_l));
  const int lane = lane_l, tid = wid * 64 + lane, r32 = lane & 31, hi = lane >> 5; (void)tid;
  char* V_lds = lds + OFF_V; char* K_lds = lds + OFF_K; char* R_lds = lds + OFF_R;
  float* ws = (float*)(lds + OFF_WS) + wid * 64; float* li_l = ws; float* al_l = ws + 32;
  float m_reg = -1e30f, l_reg = 0; f32x16 o[4] = {}; bf16x8 qr[8];
  const bf16* Qw = Qb + (long)(wid * QBLK + r32) * LDQ + hi * 8;
#pragma unroll
  for (int d0 = 0; d0 < 8; ++d0) qr[d0] = *(const GAS bf16x8*)(Qw + d0 * 16);
  LAS char* qrl = (LAS char*)(lds + OFF_QR + wid * 4096 + lane * 16);
#pragma unroll
  for (int d0 = 0; d0 < 4; ++d0) *(LAS bf16x8*)(qrl + d0 * 1024) = *(const GAS bf16x8*)(Qw + (8 + d0) * 16);
  unsigned kof0, kof1, rof, vof0, vof1;
  { const int q0 = wid, q1 = wid + 8;
    { const int row = 4 * q0 + (lane >> 4), ch = (lane & 15) ^ (row & 15); kof0 = (unsigned)(row * LDK + ch * 8) * 2u; }
    { const int row = 4 * q1 + (lane >> 4), ch = (lane & 15) ^ (row & 15); kof1 = (unsigned)(row * LDK + ch * 8) * 2u; }
    { const int row = 8 * q0 + (lane >> 3), ch = (lane & 7) ^ ((row >> 1) & 7); rof = (unsigned)(row * LDR + ch * 8) * 2u; }
    { const int st = 2 * q0 + (lane >> 5), gi = lane & 31, kk = (st >> 2) * 8 + (gi >> 2), c = (st & 3) * 32 + (gi & 3) * 8, k = (kk & ~0xC) | ((kk & 4) << 1) | ((kk & 8) >> 1); vof0 = (unsigned)(k * LDK + c) * 2u; }
    { const int st = 2 * q1 + (lane >> 5), gi = lane & 31, kk = (st >> 2) * 8 + (gi >> 2), c = (st & 3) * 32 + (gi & 3) * 8, k = (kk & ~0xC) | ((kk & 4) << 1) | ((kk & 8) >> 1); vof1 = (unsigned)(k * LDK + c) * 2u; } }
  const unsigned lds0 = (unsigned)(uintptr_t)lds;
  const unsigned dK = (unsigned)__builtin_amdgcn_readfirstlane(lds0 + OFF_K + wid * 1024), dR = (unsigned)__builtin_amdgcn_readfirstlane(lds0 + OFF_R + wid * 1024), dV = (unsigned)__builtin_amdgcn_readfirstlane(lds0 + OFF_V + wid * 1024);
#define DMA_KR(t, st) do { const char* kb_ = (const char*)Kh + (size_t)(t) * (KVBLK * LDK * 2); const char* rb_ = (const char*)Rh + (size_t)(t) * (KVBLK * LDR * 2); \
    glds16(kb_ + kof0, dK + (st) * SHM_K); glds16(kb_ + kof1, dK + (st) * SHM_K + 8192); glds16(rb_ + rof, dR + (st) * SHM_R); } while (0)
#define DMA_V(t, st) do { const char* vb_ = (const char*)Vh + (size_t)(t) * (KVBLK * LDK * 2); glds16(vb_ + vof0, dV + (st) * SHM_V); glds16(vb_ + vof1, dV + (st) * SHM_V + 8192); } while (0)
#define WAIT_BAR() asm volatile("s_waitcnt vmcnt(0) lgkmcnt(0)\n\ts_barrier" ::: "memory")
  const int vb0 = (int)(uintptr_t)V_lds + v_rd_base(lane);
#define RESC(a) do { if (__any((a) < 1.f)) { if (hi == 0) al_l[r32] = (a); asm volatile("s_waitcnt lgkmcnt(0)" ::: "memory"); \
    _Pragma("unroll") for (int d = 0; d < 4; ++d) _Pragma("unroll") for (int r = 0; r < 16; ++r) o[d][r] *= al_l[crow(r, hi)]; } } while (0)
  f32x16 pA0, pA1, pB0, pB1; float mnA, mnB, alA, alB; bf16x8 pa0, pa1, pa2, pa3; const int NT = seq / KVBLK;
  DMA_KR(0, 0); DMA_V(0, 0); WAIT_BAR();
  DMA_KR(1, 1);
  qkt(pA0, pA1, K_lds, R_lds, qr, qrl, r32, hi); partialSM(pA0, pA1, m_reg, mnA, alA);
  WAIT_BAR();
  const LAS char* Kc0 = (const LAS char*)K_lds + r32 * 256; const LAS char* Rc0 = (const LAS char*)R_lds + r32 * 128; const LAS char* Vp0 = (const LAS char*)V_lds + v_rd_base(lane);
  const int ky = (hi * 16) ^ ((r32 & 15) << 4), rz = (r32 >> 1) & 7;
#pragma unroll 1
  for (int j = 1; j + 1 < NT; j += 2) {
    DMA_KR(j + 1, 0); DMA_V(j, 1);
    attn_step(pB0, pB1, pA0, pA1, Kc0 + SHM_K, Rc0 + SHM_R, Vp0, qr, qrl, o, alA, l_reg, m_reg, mnB, alB, ky, rz, hi);
    RESC(alB); WAIT_BAR();
    if (j + 2 < NT) DMA_KR(j + 2, 1);
    DMA_V(j + 1, 0);
    attn_step(pA0, pA1, pB0, pB1, Kc0, Rc0, Vp0 + SHM_V, qr, qrl, o, alB, l_reg, m_reg, mnA, alA, ky, rz, hi);
    RESC(alA); WAIT_BAR();
  }
  DMA_V(NT - 1, 1);
  SBAR(); qkt(pB0, pB1, K_lds + SHM_K, R_lds + SHM_R, qr, qrl, r32, hi);
  finishSM(pA0, pA1, alA, l_reg, pa0, pa1, pa2, pa3); SBAR();
  pv_d0(o, vb0, pa0, pa1, pa2, pa3); partialSM(pB0, pB1, m_reg, mnB, alB);
  RESC(alB); WAIT_BAR();
  finishSM(pB0, pB1, alB, l_reg, pa0, pa1, pa2, pa3); SBAR();
  pv_d0(o, vb0 + SHM_V, pa0, pa1, pa2, pa3);
  if (hi == 0) li_l[r32] = l_reg; asm volatile("s_waitcnt lgkmcnt(0)" ::: "memory");
  int lane_e = (int)__builtin_amdgcn_mbcnt_hi(~0u, __builtin_amdgcn_mbcnt_lo(~0u, 0u)); asm volatile("" : "+v"(lane_e)); const int r32e = lane_e & 31, hie = lane_e >> 5;
  GAS bf16* Ow = (GAS bf16*)Ob + (long)(wid * QBLK + 4 * hie) * LDO + r32e; GAS float* stw = (GAS float*)st + (long)(wid * QBLK + 4 * hie) * 16;
  asm volatile("" : "+v"(Ow), "+v"(stw));
#pragma unroll
  for (int r = 0; r < 16; ++r) { const int ro = (r & 3) + 8 * (r >> 2); const float rl = __builtin_amdgcn_rcpf(li_l[ro + 4 * hie]); float ss = 0.f;
#pragma unroll
    for (int d0 = 0; d0 < 4; ++d0) { const float v = o[d0][r] * rl; ss += v * v; Ow[(long)ro * LDO + d0 * 32] = (bf16)f2bf(v); }
    ss += __shfl_xor(ss, 1); ss += __shfl_xor(ss, 2); ss += __shfl_xor(ss, 4); ss += __shfl_xor(ss, 8); ss += __shfl_xor(ss, 16);
    if (r32e == 0) stw[ro * 16] = ss; }
#undef DMA_KR
#undef DMA_V
#undef WAIT_BAR
#undef RESC
}
#undef KSWZ
#undef RSWZ
#undef SBAR
}

constexpr size_t MiB = 1u << 20;
constexpr size_t WS_CTL = 0, CTL_ZERO_BYTES = 1 * MiB;
constexpr size_t WS_RSTDX = 1 * MiB, WS_RSTDQ = WS_RSTDX + 98304, WS_RSTDKV = WS_RSTDQ + 98304, WS_R2 = WS_RSTDKV + 98304, WS_RATIO = WS_R2 + 98304, WS_RSTDX1 = WS_RATIO + 98304;
constexpr size_t WS_STA = 2 * MiB;
constexpr size_t WS_STB = 8 * MiB;
constexpr size_t WS_STQ = 10 * MiB;
constexpr size_t WS_STKV = 12 * MiB;
constexpr size_t WS_ROPE = 13 * MiB;
constexpr size_t WS_WIN = 16 * MiB;
constexpr size_t WS_WGLU = 46 * MiB;
constexpr size_t WS_WQ = 54 * MiB;
constexpr size_t WS_WKV = 60 * MiB;
constexpr size_t WS_WOUT = 64 * MiB;
constexpr size_t WS_WUG = 96 * MiB;
constexpr size_t WS_WDN = 268 * MiB;
constexpr size_t WS_W1T = 354 * MiB;
constexpr size_t WS_W2T = 370 * MiB;
constexpr size_t WS_A = 402 * MiB;
constexpr size_t WS_B = 594 * MiB;
constexpr size_t WS_QLAT = 786 * MiB, WS_KVLAT = 828 * MiB, WS_KROPE = 852 * MiB;
constexpr size_t WS_GACT = 856 * MiB;
constexpr size_t WS_HUP = 952 * MiB, WS_HGATE = 964 * MiB, WS_END = 970 * MiB;
static_assert(WS_HUP + (size_t)128 * 4 * DFF * 2 <= WS_HGATE && WS_HGATE + (size_t)128 * 2 * DFF * 2 <= WS_END, "halo");
constexpr size_t OUT_X = 0, OUT_KV = 192 * MiB;
constexpr int CW_BAR = 4096;

constexpr int NWAVES = 8;
constexpr int RING_BYTES = 131072, LDSCTL_OFF = RING_BYTES, MISC_OFF = LDSCTL_OFF + 320, LDS_BYTES = 147456;

typedef GAS unsigned gu32;
#define RLX_AGENT __ATOMIC_RELAXED, __HIP_MEMORY_SCOPE_AGENT
#define LDS_WAIT() asm volatile("s_waitcnt lgkmcnt(0)" ::: "memory")

#define XB_TMO      128
#define XB_XCNT(j)  (256  + 64 * (j))
#define XB_XSUB(j)  (1280 + 64 * (j))
#define XB_XGEN(j)  (2304 + 64 * (j))
#define XB_TOP      3328
#define XB_TOPGEN   3392
#define XCD_BAR_WORDS 3456
#define XB_SPIN_CAP (1u << 18)
__device__ __forceinline__ unsigned xb_ld(unsigned* p)              { return __hip_atomic_load(p, __ATOMIC_RELAXED, __HIP_MEMORY_SCOPE_AGENT); }
__device__ __forceinline__ unsigned xb_add(unsigned* p, unsigned v) { return __hip_atomic_fetch_add(p, v, __ATOMIC_RELAXED, __HIP_MEMORY_SCOPE_AGENT); }
__device__ __forceinline__ unsigned xb_xcc_id() { return (unsigned)__builtin_amdgcn_s_getreg((3 << 11) | 20) & 0xFu; }
#define XB_SPIN(cond, bar) do { unsigned _sp = 0; while (cond) { __builtin_amdgcn_s_sleep(1); \
    if ((++_sp & 255u) == 0u) { if (xb_ld(&(bar)[XB_TMO])) break; if (_sp > XB_SPIN_CAP) { atomicAdd(&(bar)[XB_TMO], 1u); break; } } } } while (0)
struct XcdBarrier { unsigned* bar; unsigned x; volatile LAS unsigned* st; };
__device__ __forceinline__ XcdBarrier xcd_barrier_post(unsigned* bar, volatile LAS unsigned* st) {
    XcdBarrier b; b.bar = bar; b.x = xb_xcc_id(); b.st = st;
    if (threadIdx.x == 0) (void)xb_add(&bar[XB_XCNT(b.x)], 1u);
    return b;
}
__device__ __forceinline__ void xcd_barrier_complete(unsigned* bar, unsigned x, unsigned& nloc, unsigned& nx) {
    const unsigned G = gridDim.x * gridDim.y * gridDim.z;
    unsigned sum, cnt, mine, sp = 0u;
    for (;;) {
        sum = 0u; cnt = 0u; mine = 0u;
#pragma unroll
        for (unsigned j = 0; j < 16; ++j) { const unsigned c = xb_ld(&bar[XB_XCNT(j)]); sum += c; cnt += (c > 0u) ? 1u : 0u; mine = (j == x) ? c : mine; }
        if (sum == G) break;
        __builtin_amdgcn_s_sleep(1);
        if ((++sp & 255u) == 0u) { if (xb_ld(&bar[XB_TMO])) break; if (sp > XB_SPIN_CAP) { atomicAdd(&bar[XB_TMO], 1u); break; } }
    }
    nloc = mine > 0u ? mine : 1u; nx = cnt > 0u ? cnt : 1u;
}
__device__ __forceinline__ void xcd_barrier(const XcdBarrier& b) {
    asm volatile("s_waitcnt vmcnt(0)" ::: "memory");
    __syncthreads();
    if (threadIdx.x == 0) {
        unsigned* bar = b.bar;
        __builtin_amdgcn_s_waitcnt(0);
        unsigned nloc = b.st[0], nx = b.st[1];
        if (nloc == 0u) { xcd_barrier_complete(bar, b.x, nloc, nx); b.st[0] = nloc; b.st[1] = nx; }
        const unsigned old = xb_add(&bar[XB_XSUB(b.x)], 1u);
        const unsigned gen = old / nloc;
        if (old + 1u == (gen + 1u) * nloc) {
            __builtin_amdgcn_fence(__ATOMIC_RELEASE, "agent");
            asm volatile("s_waitcnt vmcnt(0)" ::: "memory");
            const unsigned og = xb_add(&bar[XB_TOP], 1u);
            const unsigned tg = og / nx;
            if (og + 1u == (tg + 1u) * nx) xb_add(&bar[XB_TOPGEN], 1u);
            else XB_SPIN(xb_ld(&bar[XB_TOPGEN]) == tg, bar);
            __builtin_amdgcn_fence(__ATOMIC_ACQUIRE, "agent");
            xb_add(&bar[XB_XGEN(b.x)], 1u);
            asm volatile("s_waitcnt vmcnt(0)" ::: "memory");
        } else {
            XB_SPIN(xb_ld(&bar[XB_XGEN(b.x)]) == gen, bar);
            __builtin_amdgcn_fence(__ATOMIC_ACQUIRE, "agent");
            asm volatile("s_waitcnt vmcnt(0)" ::: "memory");
        }
    }
    __syncthreads();
}

__device__ __forceinline__ float wave_sum(float v) {
#pragma unroll
    for (int o = 1; o < 64; o <<= 1) v += __shfl_xor(v, o);
    return v;
}
template <class RowMap>
__device__ __forceinline__ void transpose_item(const float* W, int K, int N, bf16* WT, const float* g1, const float* g2, int ksplit, RowMap rm, LAS float* scr, int item, int lane) {
    const int nblk = N / 64; int kb, nb;
    if ((nblk & 3) == 0) { const int w = item & 7, rest = item >> 3, q = nblk >> 2; nb = (rest % q) * 4 + (w & 3); kb = (rest / q) * 2 + (w >> 2); }
    else { kb = item / nblk; nb = item % nblk; }
    const int k0 = 64 * kb, n0 = 64 * nb;
    f32x2 wv[32];
    const GAS f32x2* wp = (const GAS f32x2*)((const GAS float*)W + (size_t)(k0 + (lane >> 5)) * N + n0) + (lane & 31);
#pragma unroll
    for (int i = 0; i < 32; ++i) wv[i] = *(const GAS f32x2*)((const GAS float*)wp + (size_t)(2 * i) * N);
    float gn[32];
#pragma unroll
    for (int i = 0; i < 32; ++i) { const int k = k0 + 2 * i + (lane >> 5); gn[i] = g1 ? (k < ksplit ? g1[k] : g2[k - ksplit]) : 1.0f; }
    const int c = lane & 7;
#pragma unroll
    for (int sub = 0; sub < 2; ++sub) {
#pragma unroll
        for (int i = 0; i < 32; ++i) { const int kk = 2 * i + (lane >> 5); scr[kk * 33 + (lane & 31)] = (sub ? wv[i].y : wv[i].x) * gn[i]; }
        LDS_WAIT(); asm volatile("" ::: "memory");
#pragma unroll
        for (int j = 0; j < 4; ++j) { const int nl = (lane >> 3) + 8 * j; const LAS float* s = scr + (8 * c) * 33 + nl;
            v4u o; o.x = pg8::cvt_pk_bf16(s[0 * 33], s[1 * 33]); o.y = pg8::cvt_pk_bf16(s[2 * 33], s[3 * 33]); o.z = pg8::cvt_pk_bf16(s[4 * 33], s[5 * 33]); o.w = pg8::cvt_pk_bf16(s[6 * 33], s[7 * 33]);
            *(GAS v4u*)(WT + (size_t)rm(n0 + 2 * nl + sub) * K + k0 + 8 * c) = o; }
        LDS_WAIT(); asm volatile("" ::: "memory");
    }
}
struct RmId  { __device__ __forceinline__ int operator()(int n) const { return n; } };
struct RmWin { __device__ __forceinline__ int operator()(int n) const { if (n < 2944) return n; if (n < 3456) return n + 128; const int i = n - 3456; return 3584 + (i < 32 ? 2 * i : 2 * (i - 32) + 1); } };
struct RmQ   { __device__ __forceinline__ int operator()(int n) const { const int r = n % 192, hb = n - r; if (r < 128) return n; const int i = r - 128; return hb + 128 + (i < 32 ? 2 * i : 2 * (i - 32) + 1); } };
struct RmUp  { __device__ __forceinline__ int operator()(int n) const { return (n >> 7) * 256 + (n & 127); } };
struct RmGate{ __device__ __forceinline__ int operator()(int n) const { return (n >> 7) * 256 + 128 + (n & 127); } };

__device__ __forceinline__ void sincos_d(double a, double& s, double& c) {
    const double kd = __builtin_rint(a * 0.63661977236758134308); const long k = (long)kd;
    double r = __builtin_fma(-kd, 1.57079632679489655800e+00, a); r = __builtin_fma(-kd, 6.12323399573676603587e-17, r);
    const double r2 = r * r;
    double sp = 1.0 / 6227020800.0; sp = sp * r2 - 1.0 / 39916800.0; sp = sp * r2 + 1.0 / 362880.0; sp = sp * r2 - 1.0 / 5040.0; sp = sp * r2 + 1.0 / 120.0; sp = sp * r2 - 1.0 / 6.0; sp = sp * r2 * r + r;
    double cp = 1.0 / 479001600.0; cp = cp * r2 - 1.0 / 3628800.0; cp = cp * r2 + 1.0 / 40320.0; cp = cp * r2 - 1.0 / 720.0; cp = cp * r2 + 1.0 / 24.0; cp = cp * r2 - 0.5; cp = cp * r2 + 1.0;
    const int q = (int)(k & 3);
    s = (q == 0) ? sp : (q == 1) ? cp : (q == 2) ? -sp : -cp;
    c = (q == 0) ? cp : (q == 1) ? -sp : (q == 2) ? -cp : sp;
}

__device__ __forceinline__ void ssm_weights_group(int g, const float* a_re, const float* a_im, const float* b_re, const float* b_im, const float* c_re, const float* c_im,
                                                  const float* log_dt, const float* dskip, bf16* W1t, bf16* W2t, LAS float* L, int tid) {
    LAS float* PW = L;
    LAS float* BB = PW + 2 * 17 * 64 * 2;
    LAS float* CC = BB + 2 * 64 * 16 * 2;
    LAS float* KT = CC + 2 * 16 * 64 * 2;
    for (int i = tid; i < 2 * 17 * 64; i += 512) { const int d = i / (17 * 64), e = (i / 64) % 17, p = i & 63;
        const double dt = exp((double)log_dt[d * 128 + g]); const double are = a_re[(d * 128 + g) * 64 + p], aim = a_im[(d * 128 + g) * 64 + p];
        const double mag = exp((double)e * dt * are); double s, c; sincos_d((double)e * dt * aim, s, c);
        PW[i * 2] = (float)(mag * c); PW[i * 2 + 1] = (float)(mag * s); }
    for (int i = tid; i < 2 * 64 * 16; i += 512) { const int d = i / 1024, p = (i >> 4) & 63, h = i & 15;
        const double dt = exp((double)log_dt[d * 128 + g]); const double are = a_re[(d * 128 + g) * 64 + p], aim = a_im[(d * 128 + g) * 64 + p];
        const double x = dt * are, y = dt * aim; double sy, cy, sh, ch; sincos_d(y, sy, cy); sincos_d(0.5 * y, sh, ch);
        const double em1 = expm1(x); const double re1 = em1 * cy - 2.0 * sh * sh, im1 = (em1 + 1.0) * sy;
        const double den = are * are + aim * aim; const double qre = (re1 * are + im1 * aim) / den, qim = (im1 * are - re1 * aim) / den;
        const size_t bi = ((size_t)((d * 128 + g) * 64 + p)) * 16 + h; const double br = b_re[bi], bim = b_im[bi];
        BB[i * 2] = (float)(qre * br - qim * bim); BB[i * 2 + 1] = (float)(qre * bim + qim * br); }
    for (int i = tid; i < 2 * 16 * 64; i += 512) { const int d = i / 1024, h = (i >> 6) & 15, p = i & 63; const size_t ci = ((size_t)((d * 128 + g) * 16 + h)) * 64 + p;
        CC[i * 2] = c_re[ci]; CC[i * 2 + 1] = c_im[ci]; }
    __syncthreads();
    { const int d = tid >> 8, e = (tid >> 4) & 15, h = tid & 15; float acc[16];
#pragma unroll
        for (int q = 0; q < 16; ++q) acc[q] = 0.f;
        for (int p = 0; p < 64; ++p) { const float cr = CC[((d * 16 + h) * 64 + p) * 2], ci = CC[((d * 16 + h) * 64 + p) * 2 + 1];
            const float pr = PW[((d * 17 + e) * 64 + p) * 2], pi = PW[((d * 17 + e) * 64 + p) * 2 + 1];
            const float tr = cr * pr - ci * pi, ti = cr * pi + ci * pr; const LAS f32x4* bp = (const LAS f32x4*)(BB + ((d * 64 + p) * 16) * 2);
#pragma unroll
            for (int q = 0; q < 8; ++q) { const f32x4 b = bp[q]; acc[2 * q] += tr * b[0] - ti * b[1]; acc[2 * q + 1] += tr * b[2] - ti * b[3]; } }
#pragma unroll
        for (int q = 0; q < 16; ++q) KT[((d * 16 + e) * 16 + h) * 16 + q] = acc[q]; }
    __syncthreads();
    for (int i = tid; i < 256 * 32; i += 512) { const int n = i >> 5, k0 = (i & 31) * 8; const int d = n >> 7, im = (n >> 6) & 1, p = n & 63; const int s = k0 >> 4, h0 = k0 & 15, e = d ? s : 15 - s;
        const float pr = PW[((d * 17 + e) * 64 + p) * 2], pi = PW[((d * 17 + e) * 64 + p) * 2 + 1]; float v[8];
#pragma unroll
        for (int j = 0; j < 8; ++j) { const float br = BB[((d * 64 + p) * 16 + h0 + j) * 2], bi = BB[((d * 64 + p) * 16 + h0 + j) * 2 + 1]; v[j] = im ? (pr * bi + pi * br) : (pr * br - pi * bi); }
        v4u o; o.x = pk2(v[0], v[1]); o.y = pk2(v[2], v[3]); o.z = pk2(v[4], v[5]); o.w = pk2(v[6], v[7]);
        *(GAS v4u*)(W1t + ((size_t)(g * 256 + n)) * 256 + k0) = o; }
    for (int i = tid; i < 256 * 64; i += 512) { const int n = i >> 6, k0 = (i & 63) * 8; const int j = n >> 4, h = n & 15; float v[8];
        if (k0 < 256) { const int d = k0 >> 7, im = (k0 >> 6) & 1, p0 = k0 & 63, e = d ? 16 - j : j + 1;
#pragma unroll
            for (int q = 0; q < 8; ++q) { const int p = p0 + q; const float cr = CC[((d * 16 + h) * 64 + p) * 2], ci = CC[((d * 16 + h) * 64 + p) * 2 + 1];
                const float pr = PW[((d * 17 + e) * 64 + p) * 2], pi = PW[((d * 17 + e) * 64 + p) * 2 + 1]; v[q] = im ? -(cr * pi + ci * pr) : (cr * pr - ci * pi); }
        } else { const int s = (k0 - 256) >> 4, h0 = (k0 - 256) & 15;
#pragma unroll
            for (int q = 0; q < 8; ++q) { const int hh = h0 + q; float val = 0.f;
                if (s <= j) val += KT[((0 * 16 + (j - s)) * 16 + h) * 16 + hh];
                if (s >= j) val += KT[((1 * 16 + (s - j)) * 16 + h) * 16 + hh];
                if (s == j && h == hh) val += dskip[g * 16 + h];
                v[q] = val; } }
        v4u o; o.x = pk2(v[0], v[1]); o.y = pk2(v[2], v[3]); o.z = pk2(v[4], v[5]); o.w = pk2(v[6], v[7]);
        *(GAS v4u*)(W2t + ((size_t)(g * 256 + n)) * 512 + k0) = o; }
    __syncthreads();
}
#ifndef PROBE_ATTN
#define PROBE_ATTN 1
#endif
#ifndef PROBE_P0
#define PROBE_P0 1
#endif
#ifndef PROBE_P1
#define PROBE_P1 1
#endif
#ifndef PROBE_P7
#define PROBE_P7 1
#endif
#ifndef PROBE_FA
#define PROBE_FA 1
#endif

struct Args { const float* in[27]; float* out; unsigned char* ws; int ph_lo, ph_hi; };

__global__ void __launch_bounds__(NWAVES * 64, 2) enc_fwd(Args args) {
    extern __shared__ __attribute__((aligned(16))) unsigned char lds[];
    LAS unsigned char* ldsb = (LAS unsigned char*)lds;
    volatile LAS unsigned* MISC = (volatile LAS unsigned*)(ldsb + MISC_OFF);
    const int wave0 = __builtin_amdgcn_readfirstlane(threadIdx.x >> 6);
    const int G = gridDim.x, bx = blockIdx.x; const int vcu = (G % 8 == 0) ? (bx % 8) * (G / 8) + bx / 8 : bx;
    const int NGW = G * NWAVES, NGT = G * NWAVES * 64;
    gu32* ctl = (gu32*)(args.ws + WS_CTL);
#define PHB unsigned char* wsl = args.ws; unsigned char* outl = (unsigned char*)args.out; asm volatile("" : "+s"(wsl), "+s"(outl)); \
    int tid = wave0 * 64 + (int)__builtin_amdgcn_mbcnt_hi(~0u, __builtin_amdgcn_mbcnt_lo(~0u, 0u)); asm volatile("" : "+v"(tid)); const int lane = tid & 63, wave = wave0; \
    const int gw = vcu * NWAVES + wave, gt = vcu * (NWAVES * 64) + tid; (void)lane; (void)gw; (void)gt; (void)wsl; (void)outl
#define x_p (args.in[0])
#define x_s (args.in[1])
#define rstd_x ((float*)(wsl + WS_RSTDX))
#define rstd_q ((float*)(wsl + WS_RSTDQ))
#define rstd_kv ((float*)(wsl + WS_RSTDKV))
#define r2v ((float*)(wsl + WS_R2))
#define ratio ((float*)(wsl + WS_RATIO))
#define rstd_x1 ((float*)(wsl + WS_RSTDX1))
#define stA ((float*)(wsl + WS_STA))
#define stB ((float*)(wsl + WS_STB))
#define stQ ((float*)(wsl + WS_STQ))
#define stKV ((float*)(wsl + WS_STKV))
#define ropetab ((float*)(wsl + WS_ROPE))
#define Wi ((bf16*)(wsl + WS_WIN))
#define Wglu ((bf16*)(wsl + WS_WGLU))
#define Wq ((bf16*)(wsl + WS_WQ))
#define Wkv ((bf16*)(wsl + WS_WKV))
#define Wout ((bf16*)(wsl + WS_WOUT))
#define Wug ((bf16*)(wsl + WS_WUG))
#define Wdn ((bf16*)(wsl + WS_WDN))
#define W1t ((bf16*)(wsl + WS_W1T))
#define W2t ((bf16*)(wsl + WS_W2T))
#define bufA ((bf16*)(wsl + WS_A))
#define bufB ((bf16*)(wsl + WS_B))
#define qlat ((bf16*)(wsl + WS_QLAT))
#define kvlat ((bf16*)(wsl + WS_KVLAT))
#define krope ((bf16*)(wsl + WS_KROPE))
#define gact ((bf16*)(wsl + WS_GACT))
#define hup ((bf16*)(wsl + WS_HUP))
#define hgate ((bf16*)(wsl + WS_HGATE))
#define X ((bf16*)(outl + OUT_X))
#define kvb ((bf16*)(outl + OUT_KV))
#define xoutf ((float*)outl)
    for (int u = threadIdx.x; u < (LDS_BYTES - LDSCTL_OFF) / 4; u += NWAVES * 64) ((LAS unsigned*)(ldsb + LDSCTL_OFF))[u] = 0u;
    __syncthreads();
    XcdBarrier bar = xcd_barrier_post((unsigned*)(ctl + CW_BAR), MISC + 8);
    const int lo = args.ph_lo, hi = args.ph_hi;
#ifndef PHMASK
#define PHMASK 0xfffffffu
#endif
#define IN(k) (((PHMASK >> ((k) < 9 ? (k) : ((k) >= 18 ? 12 : 9 + ((k) - 9) % 3))) & 1u) && lo <= (k) && (k) < hi)
#define SEAM(k) do { if (IN(k) && IN((k) + 1)) xcd_barrier(bar); } while (0)

#pragma unroll 1
    for (int rep = 0; rep < PROBE_P0; ++rep)
    if (IN(0)) {
        PHB;
        if (rep) __syncthreads();
        if (vcu < 128) ssm_weights_group(vcu, args.in[4], args.in[5], args.in[6], args.in[7], args.in[8], args.in[9], args.in[10], args.in[11], W1t, W2t, (LAS float*)ldsb, tid);
        LAS float* scr = (LAS float*)(ldsb + wave * 16384);
        constexpr int I_IN = 64 * 55, I_GLU = 32 * 32, I_Q = 14 * 48, I_KV = 8 * 64, I_OUT = 64 * 64, I_UP = 64 * 172, I_DN = 172 * 64;
        constexpr int NITEMS = I_IN + I_GLU + I_Q + I_KV + I_OUT + 2 * I_UP + I_DN;
#ifndef PROBE_TR
#define PROBE_TR 1
#endif
#ifndef PROBE_X
#define PROBE_X 1
#endif
        for (int it2 = gw; it2 < PROBE_TR * NITEMS; it2 += NGW) { const int it = it2 % NITEMS;
            int r = it;
            if (r < I_IN) { transpose_item(args.in[2], 4096, 3520, Wi, args.in[3], args.in[3], 4096, RmWin(), scr, r, lane); continue; } r -= I_IN;
            if (r < I_GLU) { transpose_item(args.in[12], 2048, 2048, Wglu, nullptr, nullptr, 0, RmId(), scr, r, lane); continue; } r -= I_GLU;
            if (r < I_Q) { transpose_item(args.in[14], 896, 3072, Wq, args.in[13], args.in[13], 896, RmQ(), scr, r, lane); continue; } r -= I_Q;
            if (r < I_KV) { transpose_item(args.in[16], 512, 4096, Wkv, args.in[15], args.in[15], 512, RmId(), scr, r, lane); continue; } r -= I_KV;
            if (r < I_OUT) { transpose_item(args.in[19], 4096, 4096, Wout, args.in[17], args.in[18], 2048, RmId(), scr, r, lane); continue; } r -= I_OUT;
            if (r < I_UP) { transpose_item(args.in[21], 4096, 11008, Wug, args.in[20], args.in[20], 4096, RmUp(), scr, r, lane); continue; } r -= I_UP;
            if (r < I_UP) { transpose_item(args.in[22], 4096, 11008, Wug, args.in[20], args.in[20], 4096, RmGate(), scr, r, lane); continue; } r -= I_UP;
            transpose_item(args.in[25], 11008, 4096, Wdn, nullptr, nullptr, 0, RmId(), scr, r, lane);
        }
        for (int i = gt; i < 320 * 512; i += NGT) { const int rr = i >> 9, c8 = (i & 511) * 8; const int row = rr < 128 ? 2944 + rr : 3648 + (rr - 128);
            *(GAS v4u*)(Wi + (size_t)row * 4096 + c8) = (v4u){0u, 0u, 0u, 0u}; }
        for (int m2 = gw; m2 < PROBE_X * T; m2 += NGW) { const int m = m2 % T; const float* xr = m < 16384 ? x_p + (size_t)m * DM : x_s + (size_t)(m - 16384) * DM;
            f32x4 v[16]; float s = 0.f;
#pragma unroll
            for (int j = 0; j < 16; ++j) { v[j] = *((const GAS f32x4*)xr + lane + 64 * j); s += (v[j].x * v[j].x + v[j].y * v[j].y) + (v[j].z * v[j].z + v[j].w * v[j].w); }
            s = wave_sum(s); if (lane == 0) rstd_x[m] = 1.0f / sqrtf(s * (1.0f / DM) + EPS);
            GAS v2u* o8 = (GAS v2u*)(bufA + (size_t)m * DM) + lane;
#pragma unroll
            for (int j = 0; j < 16; ++j) o8[64 * j] = (v2u){pg8::cvt_pk_bf16(v[j].x, v[j].y), pg8::cvt_pk_bf16(v[j].z, v[j].w)}; }
        for (int i = gt; i < 8192 * 32; i += NGT) { const int pos = i >> 5, k = i & 31; const double inv = exp(-(double)k * (9.210340371976184 / 32.0));
            double s, c; sincos_d((double)pos * inv, s, c); *(GAS f32x2*)(ropetab + (size_t)i * 2) = (f32x2){(float)c, (float)s}; }
    }
    SEAM(0);

#pragma unroll 1
    for (int rep = 0; rep < PROBE_P1; ++rep)
    if (IN(1)) {
        PHB;
        pg8::Gemm g{bufA, Wi, DM, DM, DM}; pg8::StaticOrder S; S.init(T, 3840, G, bx);
        pg8::EpiWin E{rstd_x, X, qlat, kvlat, krope, stQ, stKV, ropetab};
        pg8::gemm_phase(ldsb, g, S, E, tid);
    }
    SEAM(1);

    if (IN(2)) {
        PHB;
        pg8::Gemm g{X + 256, W1t, 512, 256, 256}; pg8::GroupOrder S{768, 6, G, bx};
        pg8::EpiSsm1 E{X};
        pg8::gemm_phase(ldsb, g, S, E, tid);
        for (int r = gt; r < T; r += NGT) { float s = 0.f;
#pragma unroll
            for (int j = 0; j < 4; ++j) { const f32x4 v = *(const GAS f32x4*)(stQ + (size_t)r * 16 + 4 * j); s += (v.x + v.y) + (v.z + v.w); }
            rstd_q[r] = 1.0f / sqrtf(s * (1.0f / QLAT) + EPS); float s2 = 0.f;
#pragma unroll
            for (int j = 0; j < 2; ++j) { const f32x4 v = *(const GAS f32x4*)(stKV + (size_t)r * 8 + 4 * j); s2 += (v.x + v.y) + (v.z + v.w); }
            rstd_kv[r] = 1.0f / sqrtf(s2 * (1.0f / KVLAT) + EPS); }
    }
    SEAM(2);

    if (IN(3)) {
        PHB;
        const bool scan_cu = (G == 256) ? ((vcu & 1) == 0) : true;
        if (G == 256 ? scan_cu : (wave < 4)) { const int task = (G == 256) ? (vcu >> 1) * 8 + wave : vcu * 4 + wave;
            if (task < 1024) { const int seq = task >> 8, g = (task >> 1) & 127, dir = task & 1, p = lane;
                const int c0 = seq < 2 ? seq * 512 : 1024 + (seq - 2) * 256, nc = seq < 2 ? 512 : 256;
                const double dt = exp((double)args.in[10][dir * 128 + g]); const double are = args.in[4][(dir * 128 + g) * 64 + p], aim = args.in[5][(dir * 128 + g) * 64 + p];
                const double mag = exp(16.0 * dt * are); double sn, cs; sincos_d(16.0 * dt * aim, sn, cs);
                const float ar = (float)(mag * cs), ai = (float)(mag * sn);
                GAS bf16* Xg = (GAS bf16*)X + (size_t)g * NCHUNK * 512 + dir * 128 + p;
                float zr = 0.f, zi = 0.f;
                for (int cb = 0; cb < nc; cb += 16) {
                    unsigned short sre[16], sim[16];
#pragma unroll
                    for (int i = 0; i < 16; ++i) { const int c = dir ? (c0 + nc - 1 - (cb + i)) : (c0 + cb + i); sre[i] = Xg[(size_t)c * 512]; sim[i] = Xg[(size_t)c * 512 + 64]; }
#pragma unroll
                    for (int i = 0; i < 16; ++i) { const int c = dir ? (c0 + nc - 1 - (cb + i)) : (c0 + cb + i);
                        Xg[(size_t)c * 512] = (bf16)f2bf(zr); Xg[(size_t)c * 512 + 64] = (bf16)f2bf(zi);
                        const float sr = bf2f(sre[i]), si = bf2f(sim[i]); const float nr = ar * zr - ai * zi + sr, ni = ar * zi + ai * zr + si; zr = nr; zi = ni; }
                }
            }
        }
        __syncthreads();
        if (G == 256) { pg8::Gemm g{qlat, Wq, QLAT, QLAT, QLAT}; pg8::RangeOrder S{scan_cu ? (vcu >> 1) * 3 : 384 + (vcu >> 1) * 6, scan_cu ? 3 : 6, 12}; pg8::EpiQ E{rstd_q, bufA, ropetab}; pg8::gemm_phase(ldsb, g, S, E, tid); }
        else { pg8::Gemm g{qlat, Wq, QLAT, QLAT, QLAT}; pg8::StaticOrder S; S.init(T, QW, G, bx); pg8::EpiQ E{rstd_q, bufA, ropetab}; pg8::gemm_phase(ldsb, g, S, E, tid); }
        { pg8::Gemm g{kvlat, Wkv, KVLAT, KVLAT, KVLAT}; pg8::StaticOrder S; S.init(T, KVW, G, bx); pg8::EpiKV E{rstd_kv, kvb}; pg8::gemm_phase(ldsb, g, S, E, tid); }
    }
    SEAM(3);

    if (IN(4)) {
        PHB;
        pg8::Gemm g{X, W2t, 512, 512, 512}; pg8::GroupOrder S{768, 6, G, bx};
        pg8::EpiSsm2 E{gact};
        pg8::gemm_phase(ldsb, g, S, E, tid);
    }
    SEAM(4);

    if (IN(5)) {
        PHB;
#ifndef NO_GLU
        { pg8::Gemm g{gact, Wglu, MIXW, MIXW, MIXW}; pg8::StaticOrder S; S.init(T, MIXW, G, bx); pg8::EpiGlu E{gact, bufB, stA}; pg8::gemm_phase(ldsb, g, S, E, tid); }
#endif
#ifndef NO_ATTN
        const int xcd = vcu >> 5, cc = vcu & 31; const int nun = (G == 256) ? 6 : (1536 - bx + G - 1) / G;
#pragma unroll 1
        for (int i2 = 0; i2 < PROBE_ATTN * nun; ++i2) { const int i = i2 % nun;
            int bh, qb, seq, rowbase;
            if (G == 256) { if (i < 4) { bh = xcd * 4 + i; qb = cc; seq = 8192; } else { bh = xcd * 4 + 2 * (i - 4) + (cc >> 4); qb = cc & 15; seq = 4096; } }
            else { const int uidx = bx + i * G; if (uidx < 1024) { bh = uidx >> 5; qb = uidx & 31; seq = 8192; } else { const int v = uidx - 1024; bh = v >> 4; qb = v & 15; seq = 4096; } }
            const int b = bh >> 4, h = bh & 15; rowbase = (seq == 8192) ? b * 8192 : 16384 + b * 4096;
            __syncthreads();
            attn::attn_unit(bufA + (size_t)(rowbase + qb * 256) * QW + h * 192, kvb + (size_t)rowbase * KVW + h * 256, kvb + (size_t)rowbase * KVW + h * 256 + 128,
                            krope + (size_t)rowbase * 64, bufB + (size_t)(rowbase + qb * 256) * DM + 2048 + h * 128, stB + (size_t)(rowbase + qb * 256) * 16 + h, seq, (char*)lds, wave0);
        }
#endif
    }
    SEAM(5);

    if (IN(6)) {
        PHB;
        for (int r = gt; r < T; r += NGT) { float s = 0.f;
#pragma unroll
            for (int j = 0; j < 8; ++j) { const f32x4 v = *(const GAS f32x4*)(stA + (size_t)r * 32 + 4 * j); s += (v.x + v.y) + (v.z + v.w); }
            const float r1 = 1.0f / sqrtf(s * (1.0f / MIXW) + EPS); float s2 = 0.f;
#pragma unroll
            for (int j = 0; j < 4; ++j) { const f32x4 v = *(const GAS f32x4*)(stB + (size_t)r * 16 + 4 * j); s2 += (v.x + v.y) + (v.z + v.w); }
            const float r2 = 1.0f / sqrtf(s2 * (1.0f / MIXW) + EPS); r2v[r] = r2; ratio[r] = r1 / r2; }
    }
    SEAM(6);

#pragma unroll 1
    for (int rep = 0; rep < PROBE_P7; ++rep)
    if (IN(7)) {
        PHB;
        pg8::Gemm g{bufB, Wout, DM, DM, DM}; pg8::StaticOrder S; S.init(T, DM, G, bx);
        pg8::EpiWout E{x_p, x_s, r2v, ratio, bufA, stA};
        pg8::gemm_phase(ldsb, g, S, E, tid);
    }
    SEAM(7);

    if (IN(8)) {
        PHB;
        for (int r = gt; r < T; r += NGT) { float s = 0.f;
#pragma unroll
            for (int j = 0; j < 16; ++j) { const f32x4 v = *(const GAS f32x4*)(stA + (size_t)r * 64 + 4 * j); s += (v.x + v.y) + (v.z + v.w); }
            rstd_x1[r] = 1.0f / sqrtf(s * (1.0f / DM) + EPS); }
    }
    SEAM(8);

#ifdef PROBE_KLOOP
    if (IN(9)) {
        PHB;
#pragma unroll 1
        for (int ch = 0; ch < 3; ++ch) { pg8::Gemm g{bufA + (size_t)(ch * 8192) * DM, Wug, DM, DM, DM}; pg8::StaticOrder S; S.init(8192, 2 * DFF, G, bx); pg8::EpiNull E0; pg8::gemm_phase(ldsb, g, S, E0, tid); }
    }
#endif
#pragma unroll 1
    for (int ch2 = 0; ch2 < 3 * PROBE_FA; ++ch2) {
        const int ch = ch2 / PROBE_FA; const bool lastrep = (ch2 % PROBE_FA) == PROBE_FA - 1;
        const int rb = ch * 8192;
        if (IN(9 + 3 * ch)) {
        PHB;
            pg8::Gemm g{bufA + (size_t)rb * DM, Wug, DM, DM, DM}; pg8::StaticOrder S; S.init(8192, 2 * DFF, G, bx);
            pg8::EpiFfnA E{rstd_x1, rb, bufB, hup, hgate, args.in[23], args.in[24]};
            pg8::gemm_phase(ldsb, g, S, E, tid);
        }
        SEAM(9 + 3 * ch);
        if (lastrep && IN(10 + 3 * ch)) {
        PHB;
            const float* cw = args.in[23]; const float* cb = args.in[24];
            for (int i = gt; i < 128 * 2 * (DFF / 8); i += NGT) { const int f0 = (i % (DFF / 8)) * 8, sw = i / (DFF / 8), strip = sw >> 1, which = sw & 1;
                const int lrow = strip * 64 + (which ? 63 : 0), grow = rb + lrow, pos = pos_of(grow), len = len_of(grow);
                v4u up0, up1, up2;
                if (which == 0) { up1 = *(const GAS v4u*)(hup + ((size_t)strip * 4 + 0) * DFF + f0); up2 = *(const GAS v4u*)(hup + ((size_t)strip * 4 + 1) * DFF + f0);
                    up0 = (pos == 0) ? (v4u){0u, 0u, 0u, 0u} : *(const GAS v4u*)(hup + ((size_t)(strip - 1) * 4 + 3) * DFF + f0); }
                else { up0 = *(const GAS v4u*)(hup + ((size_t)strip * 4 + 2) * DFF + f0); up1 = *(const GAS v4u*)(hup + ((size_t)strip * 4 + 3) * DFF + f0);
                    up2 = (pos == len - 1) ? (v4u){0u, 0u, 0u, 0u} : *(const GAS v4u*)(hup + ((size_t)(strip + 1) * 4 + 0) * DFF + f0); }
                const v4u gt4 = *(const GAS v4u*)(hgate + ((size_t)strip * 2 + which) * DFF + f0);
                unsigned ow[4];
#pragma unroll
                for (int k = 0; k < 4; ++k) { const int f = f0 + 2 * k;
                    const float a0 = bflo(up0[k]), a1 = bflo(up1[k]), a2 = bflo(up2[k]), b0 = bfhi(up0[k]), b1 = bfhi(up1[k]), b2 = bfhi(up2[k]);
                    const float c0 = cw[f] * a0 + cw[DFF + f] * a1 + cw[2 * DFF + f] * a2 + cb[f], c1 = cw[f + 1] * b0 + cw[DFF + f + 1] * b1 + cw[2 * DFF + f + 1] * b2 + cb[f + 1];
                    ow[k] = pk2(c0 * sigmoidf_fast(c0) * bflo(gt4[k]), c1 * sigmoidf_fast(c1) * bfhi(gt4[k])); }
                *(GAS v4u*)(bufB + (size_t)lrow * DFF + f0) = (v4u){ow[0], ow[1], ow[2], ow[3]}; }
        }
        if (lastrep) SEAM(10 + 3 * ch);
        if (lastrep && IN(11 + 3 * ch)) {
        PHB;
            pg8::Gemm g{bufB, Wdn, DFF, DFF, DFF}; pg8::StaticOrder S; S.init(8192, DM, G, bx);
            pg8::EpiDown E{bufA, rb, stA};
            pg8::gemm_phase(ldsb, g, S, E, tid);
        }
        if (lastrep) SEAM(11 + 3 * ch);
    }

    if (IN(18)) {
        PHB;
        const float* gf = args.in[26];
        for (int m = gw; m < T; m += NGW) { const float s = wave_sum(stA[(size_t)m * 64 + lane]); const float rs = 1.0f / sqrtf(s * (1.0f / DM) + EPS);
            const GAS v4u* xr = (const GAS v4u*)(bufA + (size_t)m * DM) + lane; GAS f32x4* orow = (GAS f32x4*)(xoutf + (size_t)m * DM) + 2 * lane; const GAS f32x4* gr = (const GAS f32x4*)gf + 2 * lane;
#pragma unroll
            for (int j = 0; j < 8; ++j) { const v4u w = xr[64 * j]; const f32x4 g0 = gr[128 * j], g1 = gr[128 * j + 1];
                orow[128 * j] = (f32x4){bflo(w.x) * rs * g0[0], bfhi(w.x) * rs * g0[1], bflo(w.y) * rs * g0[2], bfhi(w.y) * rs * g0[3]};
                orow[128 * j + 1] = (f32x4){bflo(w.z) * rs * g1[0], bfhi(w.z) * rs * g1[1], bflo(w.w) * rs * g1[2], bfhi(w.w) * rs * g1[3]}; } }
    }
#undef IN
#undef SEAM
}

constexpr int N_PHASES = 19;
extern "C" void kernel_launch(void* const* d_in, const int* in_sizes, int n_in, void* d_out, int out_size, void* d_ws, size_t ws_size, hipStream_t stream) {
    static int grid = 0;
    if (grid == 0) {
        if (n_in != 27 || out_size != T * DM || ws_size < WS_END) { fprintf(stderr, "kernel_launch: unexpected shapes (n_in %d out %d ws %zu)\n", n_in, out_size, ws_size); grid = -1; return; }
        int dev = 0, cus = 0, per_cu = 0;
        if (hipGetDevice(&dev) != hipSuccess || hipDeviceGetAttribute(&cus, hipDeviceAttributeMultiprocessorCount, dev) != hipSuccess) { grid = -1; return; }
        if (hipFuncSetAttribute((const void*)enc_fwd, hipFuncAttributeMaxDynamicSharedMemorySize, LDS_BYTES) != hipSuccess) { fprintf(stderr, "kernel_launch: hipFuncSetAttribute failed\n"); grid = -1; return; }
        if (hipOccupancyMaxActiveBlocksPerMultiprocessor(&per_cu, (const void*)enc_fwd, NWAVES * 64, LDS_BYTES) != hipSuccess || per_cu < 1) { fprintf(stderr, "kernel_launch: occupancy query says %d\n", per_cu); }
        (void)hipGetLastError();
        grid = cus;
    }
    if (grid < 0) return;
    if (hipMemsetAsync((char*)d_ws + WS_CTL, 0, CTL_ZERO_BYTES, stream) != hipSuccess) return;
    Args a{};
    for (int i = 0; i < 27; ++i) a.in[i] = (const float*)d_in[i];
    a.out = (float*)d_out; a.ws = (unsigned char*)d_ws;
#ifndef MK_N_LAUNCHES
#define MK_N_LAUNCHES 1
#endif
    if (MK_N_LAUNCHES == 1) { a.ph_lo = 0; a.ph_hi = N_PHASES; hipLaunchKernelGGL(enc_fwd, dim3(grid), dim3(NWAVES * 64), LDS_BYTES, stream, a); }
    else { for (int p = 0; p < N_PHASES; ++p) { a.ph_lo = p; a.ph_hi = p + 1; hipLaunchKernelGGL(enc_fwd, dim3(grid), dim3(NWAVES * 64), LDS_BYTES, stream, a); } }
    const hipError_t le = hipPeekAtLastError();
    if (le != hipSuccess) fprintf(stderr, "kernel_launch: launch failed: %s\n", hipGetErrorName(le));
}
```

```cpp
#include <hip/hip_runtime.h>
#include <hip/hip_bf16.h>
#include <cstdio>
#include <cstdint>

namespace pg8 {
#define PG8_LAS __attribute__((address_space(3)))
typedef unsigned short bf16_t;
typedef short bf16x8 __attribute__((ext_vector_type(8)));
typedef float f32x4 __attribute__((ext_vector_type(4)));
typedef float f32x2 __attribute__((ext_vector_type(2)));
typedef unsigned u32x4 __attribute__((ext_vector_type(4)));
typedef unsigned u32x2 __attribute__((ext_vector_type(2)));
constexpr int BM = 256, BK = 64, HALF = 128, HTB = HALF * BK * 2  , STAGE_BYTES = 8 * HTB, NXCD = 8, WGM = 8;

__host__ __device__ __forceinline__ int lds_byte(int r, int c) { const int st = (r >> 4) * 2 + (c >> 5), rr = r & 15, cc = c & 31, ob = rr * 64 + cc * 2; return st * 1024 + (ob ^ (((ob >> 9) & 1) << 5)); }
__host__ __device__ __forceinline__ void stage_rc(int b, int& R, int& C) { const int st = b / 1024, sb = b % 1024, swz = sb ^ (((sb >> 9) & 1) << 5); R = (st >> 1) * 16 + swz / 64; C = (st & 1) * 32 + (swz % 64) / 2; }
__host__ __device__ __forceinline__ int perm32(int rho) { const int n = rho >> 4, i = rho & 15; return 8 * (i >> 2) + 4 * n + (i & 3); }

struct Unit { int pm, pn; };
struct Gemm { const bf16_t* A; const bf16_t* Bt; int lda, ldb, K; };

struct StaticOrder {
    int nM, nN, nwg, G, c;
    __host__ __device__ void init(int M, int N, int G_, int c_) { nM = M / BM; nN = N / BM; nwg = nM * nN; G = G_; c = c_; }
    __host__ __device__ bool next(int i, Unit& u) const {
        const long L = (long)i * G + c; if (L >= nwg) return false;
        int wgid = (int)L; { const int q = nwg / NXCD, r = nwg % NXCD, xcd = wgid % NXCD, off = wgid / NXCD; wgid = (xcd < r ? xcd * (q + 1) : r * (q + 1) + (xcd - r) * q) + off; }
        const int nig = WGM * nN, gid = wgid / nig, fm = gid * WGM, gsz = (nM - fm) < WGM ? (nM - fm) : WGM;
        u.pm = fm + ((wgid % nig) % gsz); u.pn = (wgid % nig) / gsz; return true;
    }
};
struct ZeroOrder { int n, G, c; __host__ __device__ bool next(int i, Unit& u) const { const long L = (long)i * G + c; if (L >= n) return false; u.pm = 0; u.pn = 0; return true; } };
struct RangeOrder { int base, n, nN; __host__ __device__ bool next(int i, Unit& u) const { if (i >= n) return false; const int L = base + i; u.pm = L / nN; u.pn = L % nN; return true; } };
struct GroupOrder {
    int n, per, G, c;
    __host__ __device__ bool next(int i, Unit& u) const { const long L = (long)i * G + c; if (L >= n) return false; u.pm = (int)L; u.pn = (int)L / per; return true; }
};

__device__ __forceinline__ unsigned cvt_pk_bf16(float lo, float hi) { unsigned r; asm volatile("v_cvt_pk_bf16_f32 %0, %1, %2" : "=v"(r) : "v"(lo), "v"(hi)); return r; }
__device__ __forceinline__ u32x4 pack8(const f32x4 a, const f32x4 b) { u32x4 w; w.x = cvt_pk_bf16(a[0], a[1]); w.y = cvt_pk_bf16(a[2], a[3]); w.z = cvt_pk_bf16(b[0], b[1]); w.w = cvt_pk_bf16(b[2], b[3]); return w; }

template <class Epi, class Sched>
__device__ __forceinline__ void gemm_phase(PG8_LAS unsigned char* lds, const Gemm g, const Sched& S, const Epi& E, int tid_in) {
    int tid_l = tid_in; asm volatile("" : "+v"(tid_l));
    const int tid = tid_l, wid = __builtin_amdgcn_readfirstlane(tid >> 6), lane = tid & 63, wr = wid >> 2, wc = wid & 3, fr = lane & 15, fq = lane >> 4;
    const int K = g.K, nt = K / BK;
    unsigned voffA[2], voffB[2];
#pragma unroll
    for (int i = 0; i < 2; ++i) { int R, C; stage_rc(tid * 16 + i * 8192, R, C); const int Rb = Epi::PERM ? ((R & ~31) + perm32(R & 31)) : R;
        voffA[i] = (unsigned)(R * g.lda + C) * 2u; voffB[i] = (unsigned)(Rb * g.ldb + C) * 2u; }
    asm volatile("" : "+v"(voffA[0]), "+v"(voffA[1]), "+v"(voffB[0]), "+v"(voffB[1]));
    const size_t kstep = (size_t)(BK * 2);
    const size_t hstepA = (size_t)HALF * g.lda * 2, hstepB = (size_t)HALF * g.ldb * 2;
    const size_t tstepA = 2 * hstepA, tstepB = 2 * hstepB;
    const unsigned ldsw = (unsigned)wid * 1024u;
    const int aoff = lds_byte(wr * 64 + fr, fq * 8), boff = lds_byte(wc * 32 + fr, fq * 8);
#define PG8_SA(b, h) (((b) * 2 + (h)) * HTB)
#define PG8_SB(b, h) ((4 + (b) * 2 + (h)) * HTB)
#define PG8_STAGE(bufoff, gbase, voff) do { _Pragma("unroll") for (int _i = 0; _i < 2; ++_i) \
        __builtin_amdgcn_global_load_lds((const unsigned*)((const char*)(gbase) + (voff)[_i]), (PG8_LAS unsigned*)(lds + (bufoff) + ldsw + _i * 8192), 16, 0, 0); } while (0)
#define PG8_LDA(dst, b, h) do { _Pragma("unroll") for (int m = 0; m < 4; ++m) _Pragma("unroll") for (int k = 0; k < 2; ++k) dst[m][k] = *(const PG8_LAS bf16x8*)(lds + PG8_SA(b, h) + aoff + m * 2048 + k * 1024); } while (0)
#define PG8_LDB(dst, b, h) do { _Pragma("unroll") for (int n = 0; n < 2; ++n) _Pragma("unroll") for (int k = 0; k < 2; ++k) dst[n][k] = *(const PG8_LAS bf16x8*)(lds + PG8_SB(b, h) + boff + n * 2048 + k * 1024); } while (0)
#define PG8_MMA(ai, bj, At, Bt) do { __builtin_amdgcn_s_setprio(1); _Pragma("unroll") for (int m = 0; m < 4; ++m) _Pragma("unroll") for (int n = 0; n < 2; ++n) _Pragma("unroll") for (int k = 0; k < 2; ++k) \
        acc[ai][bj][m][n] = __builtin_amdgcn_mfma_f32_16x16x32_bf16(Bt[n][k], At[m][k], acc[ai][bj][m][n], 0, 0, 0); __builtin_amdgcn_s_setprio(0); } while (0)
#define PG8_WAIT_V(n) asm volatile("s_waitcnt vmcnt(" #n ")" ::: "memory")
#define PG8_WAIT_L(n) asm volatile("s_waitcnt lgkmcnt(" #n ")" ::: "memory")
#define PG8_BAR __builtin_amdgcn_s_barrier()
#define PG8_SCHED __builtin_amdgcn_sched_barrier(0)
    Unit cur, nxt; int ui = 0;
    if (!S.next(0, cur)) return;
    f32x4 acc[2][2][4][2];
#pragma unroll
    for (int a = 0; a < 2; ++a)
#pragma unroll
        for (int b = 0; b < 2; ++b)
#pragma unroll
            for (int m = 0; m < 4; ++m)
#pragma unroll
                for (int n = 0; n < 2; ++n) acc[a][b][m][n] = (f32x4){0.f, 0.f, 0.f, 0.f};
    bf16x8 At[4][2], B0[2][2], B1[2][2];
    const char* cA = (const char*)g.A + (size_t)cur.pm * tstepA; const char* cB = (const char*)g.Bt + (size_t)cur.pn * tstepB;
    PG8_STAGE(PG8_SB(0, 0), cB, voffB); PG8_STAGE(PG8_SB(0, 1), cB + hstepB, voffB); PG8_STAGE(PG8_SA(0, 0), cA, voffA); PG8_STAGE(PG8_SA(0, 1), cA + hstepA, voffA);
    if (wr == 1) PG8_BAR;
    PG8_WAIT_V(2); PG8_BAR;
    PG8_STAGE(PG8_SB(1, 0), cB + kstep, voffB); PG8_STAGE(PG8_SA(1, 0), cA + kstep, voffA); PG8_STAGE(PG8_SB(1, 1), cB + hstepB + kstep, voffB);
    PG8_WAIT_V(6); PG8_BAR;
    for (;;) {
        const bool has_next = S.next(ui + 1, nxt);
        const char* nA = has_next ? (const char*)g.A + (size_t)nxt.pm * tstepA : cA; const char* nB = has_next ? (const char*)g.Bt + (size_t)nxt.pn * tstepB : cB;
#pragma unroll 1
        for (int t = 0; t < nt; t += 2) {
            const bool last = (t == nt - 2);
            if constexpr (Epi::MIDK) { if (t == (nt >> 1)) E.midk(acc, cur, wr, fr); }
            const char* a1 = cA + (size_t)(t + 1) * kstep;
            const char* a2 = last ? nA : cA + (size_t)(t + 2) * kstep; const char* b2 = last ? nB : cB + (size_t)(t + 2) * kstep;
            const char* a3 = a2 + kstep; const char* b3 = b2 + kstep;
            PG8_LDB(B0, 0, 0); PG8_LDB(B1, 0, 1); PG8_SCHED; PG8_LDA(At, 0, 0); PG8_STAGE(PG8_SA(1, 1), a1 + hstepA, voffA);
            PG8_WAIT_V(8); PG8_WAIT_L(0); PG8_BAR; PG8_MMA(0, 0, At, B0); PG8_MMA(0, 1, At, B1); PG8_BAR; PG8_SCHED;
            PG8_LDA(At, 0, 1); PG8_STAGE(PG8_SB(0, 0), b2, voffB); PG8_STAGE(PG8_SB(0, 1), b2 + hstepB, voffB); PG8_STAGE(PG8_SA(0, 0), a2, voffA);
            PG8_WAIT_V(8); PG8_WAIT_L(0); PG8_BAR; PG8_MMA(1, 0, At, B0); PG8_MMA(1, 1, At, B1); PG8_BAR; PG8_SCHED;
            PG8_LDB(B0, 1, 0); PG8_LDB(B1, 1, 1); PG8_SCHED; PG8_LDA(At, 1, 0); PG8_STAGE(PG8_SA(0, 1), a2 + hstepA, voffA);
            PG8_WAIT_V(8); PG8_WAIT_L(0); PG8_BAR; PG8_MMA(0, 0, At, B0); PG8_MMA(0, 1, At, B1); PG8_BAR; PG8_SCHED;
            PG8_LDA(At, 1, 1); PG8_STAGE(PG8_SB(1, 0), b3, voffB); PG8_STAGE(PG8_SB(1, 1), b3 + hstepB, voffB); PG8_STAGE(PG8_SA(1, 0), a3, voffA);
            PG8_WAIT_V(8); PG8_WAIT_L(0); PG8_BAR; PG8_MMA(1, 0, At, B0); PG8_MMA(1, 1, At, B1); PG8_BAR; PG8_SCHED;
        }
        if (wr == 0) PG8_BAR;
        E(acc, cur, wr, wc, fr, fq);
        if (!has_next) break;
#pragma unroll
        for (int a = 0; a < 2; ++a)
#pragma unroll
            for (int b = 0; b < 2; ++b)
#pragma unroll
                for (int m = 0; m < 4; ++m)
#pragma unroll
                    for (int n = 0; n < 2; ++n) acc[a][b][m][n] = (f32x4){0.f, 0.f, 0.f, 0.f};
        cur = nxt; cA = nA; cB = nB; ++ui;
        if (wr == 1) PG8_BAR;
    }
    PG8_WAIT_V(0);
    PG8_BAR;
#undef PG8_SA
#undef PG8_SB
#undef PG8_STAGE
#undef PG8_LDA
#undef PG8_LDB
#undef PG8_MMA
#undef PG8_WAIT_V
#undef PG8_WAIT_L
#undef PG8_BAR
#undef PG8_SCHED
}
}

constexpr int T = 24576, DM = 4096, DFF = 11008;
constexpr int NCHUNK = T / 16;
constexpr int QLAT = 896, KVLAT = 512, QW = 3072, KVW = 4096, MIXW = 2048;
constexpr float EPS = 1e-6f;
__device__ __forceinline__ int pos_of(int r) { return r < 16384 ? (r & 8191) : (r & 4095); }
__device__ __forceinline__ int len_of(int r) { return r < 16384 ? 8192 : 4096; }

typedef unsigned short bf16;
#define GAS __attribute__((address_space(1)))
#define LAS __attribute__((address_space(3)))
typedef unsigned v4u __attribute__((ext_vector_type(4)));
typedef unsigned v2u __attribute__((ext_vector_type(2)));
typedef float f32x4 __attribute__((ext_vector_type(4)));
typedef float f32x2 __attribute__((ext_vector_type(2)));
typedef short bf16x8 __attribute__((ext_vector_type(8)));

__device__ __forceinline__ unsigned f2bf(float f) { unsigned u = __builtin_bit_cast(unsigned, f); return (u + 0x7fffu + ((u >> 16) & 1u)) >> 16; }
__device__ __forceinline__ unsigned pk2(float lo, float hi) { return f2bf(lo) | (f2bf(hi) << 16); }
__device__ __forceinline__ float bf2f(unsigned short b) { return __builtin_bit_cast(float, (unsigned)b << 16); }
__device__ __forceinline__ float bflo(unsigned w) { return __builtin_bit_cast(float, w << 16); }
__device__ __forceinline__ float bfhi(unsigned w) { return __builtin_bit_cast(float, w & 0xffff0000u); }
__device__ __forceinline__ float sigmoidf_fast(float x) { return __builtin_amdgcn_rcpf(1.0f + __builtin_amdgcn_exp2f(-1.4426950408889634f * x)); }
__device__ __forceinline__ float gelu_tanh(float y) { const float in = 1.5957691216057308f * (y + 0.044715f * y * y * y); return y * sigmoidf_fast(in); }

namespace pg8 {
#define EPI_ROWS const int row0 = u.pm * 256 + wr * 64 + fr
__device__ __forceinline__ float sq8(const f32x4 a, const f32x4 b) { return (a[0] * a[0] + a[1] * a[1]) + (a[2] * a[2] + a[3] * a[3]) + (b[0] * b[0] + b[1] * b[1]) + (b[2] * b[2] + b[3] * b[3]); }
__device__ __forceinline__ float red_fq(float s) { s += __shfl_xor(s, 16); s += __shfl_xor(s, 32); return s; }

__device__ __forceinline__ f32x4 rope4(const f32x4 v, const f32x4 cs) { f32x4 o; o[0] = v[0] * cs[0] - v[1] * cs[1]; o[1] = v[1] * cs[0] + v[0] * cs[1]; o[2] = v[2] * cs[2] - v[3] * cs[3]; o[3] = v[3] * cs[2] + v[2] * cs[3]; return o; }

#define LAUNDER(p) asm volatile("" : "+v"(p))
struct EpiNull { static constexpr bool PERM = true, MIDK = false;
    __device__ __forceinline__ void midk(f32x4 (&)[2][2][4][2], const Unit&, int, int) const {}
    __device__ __forceinline__ void operator()(const f32x4 (&acc)[2][2][4][2], const Unit& u, int wr, int wc, int fr, int fq) const {
#pragma unroll
        for (int ai = 0; ai < 2; ++ai)
#pragma unroll
            for (int bj = 0; bj < 2; ++bj)
                asm volatile("" :: "v"(acc[ai][bj][0][0]), "v"(acc[ai][bj][0][1]), "v"(acc[ai][bj][1][0]), "v"(acc[ai][bj][1][1]), "v"(acc[ai][bj][2][0]), "v"(acc[ai][bj][2][1]), "v"(acc[ai][bj][3][0]), "v"(acc[ai][bj][3][1]));
    } };
struct EpiWin {
    static constexpr bool PERM = true, MIDK = false;
    const float* rstd_x; bf16_t* X; bf16_t* qlat; bf16_t* kvlat; bf16_t* krope; float* stQ; float* stKV; const float* ropetab;
    __device__ __forceinline__ void midk(f32x4 (&)[2][2][4][2], const Unit&, int, int) const {}
    __device__ __forceinline__ void operator()(const f32x4 (&acc)[2][2][4][2], const Unit& u, int wr, int wc, int fr, int fq) const {
        EPI_ROWS; const int tile = u.pn;
        const GAS float* rsp = (const GAS float*)(rstd_x + row0); LAUNDER(rsp);
        if (tile < 8) {
            const int c0 = tile * 256 + wc * 32 + 8 * fq;
            GAS bf16_t* xp0 = (GAS bf16_t*)X + ((size_t)((c0 >> 4) * NCHUNK + (row0 >> 4)) * 512 + 256 + (row0 & 15) * 16 + (c0 & 15)); LAUNDER(xp0);
#pragma unroll
            for (int ai = 0; ai < 2; ++ai)
#pragma unroll
                for (int m = 0; m < 4; ++m) { const float rs = rsp[ai * 128 + m * 16];
#pragma unroll
                    for (int bj = 0; bj < 2; ++bj)
                        *(GAS u32x4*)(xp0 + ((size_t)(bj * 8) * NCHUNK + ai * 8 + m) * 512) = pack8(acc[ai][bj][m][0] * rs, acc[ai][bj][m][1] * rs); }
        } else if (tile < 14) {
            const bool isq = tile < 12; const int tl = isq ? tile - 8 : tile - 12; const int ld = isq ? QLAT : KVLAT;
            const int c0 = tl * 256 + wc * 32 + 8 * fq;
            GAS bf16_t* op = (GAS bf16_t*)(isq ? qlat : kvlat) + (size_t)row0 * ld + c0; GAS float* sp = (GAS float*)(isq ? stQ + (size_t)row0 * 16 : stKV + (size_t)row0 * 8) + tl * 4 + wc; LAUNDER(op); LAUNDER(sp);
#pragma unroll
            for (int ai = 0; ai < 2; ++ai)
#pragma unroll
                for (int m = 0; m < 4; ++m) { const float rs = rsp[ai * 128 + m * 16]; float ss = 0.f;
#pragma unroll
                    for (int bj = 0; bj < 2; ++bj) { const f32x4 v0 = acc[ai][bj][m][0] * rs, v1 = acc[ai][bj][m][1] * rs; ss += sq8(v0, v1);
                        if (c0 + bj * 128 < ld) *(GAS u32x4*)(op + (size_t)(ai * 128 + m * 16) * ld + bj * 128) = pack8(v0, v1); }
                    ss = red_fq(ss); if (fq == 0) sp[(size_t)(ai * 128 + m * 16) * (isq ? 16 : 8)] = ss; }
        } else {
            if (wc < 2) { const int c = wc * 32 + 8 * fq;
                GAS bf16_t* op = (GAS bf16_t*)krope + (size_t)row0 * 64 + c; LAUNDER(op);
#pragma unroll
                for (int ai = 0; ai < 2; ++ai)
#pragma unroll
                    for (int m = 0; m < 4; ++m) { const int row = row0 + ai * 128 + m * 16; const float rs = rsp[ai * 128 + m * 16]; const int pos = pos_of(row);
                        const f32x4 cs0 = *(const GAS f32x4*)((const GAS float*)ropetab + (size_t)pos * 64 + c), cs1 = *(const GAS f32x4*)((const GAS float*)ropetab + (size_t)pos * 64 + c + 4);
                        const f32x4 v0 = rope4(acc[ai][0][m][0] * rs, cs0), v1 = rope4(acc[ai][0][m][1] * rs, cs1);
                        *(GAS u32x4*)(op + (size_t)(ai * 128 + m * 16) * 64) = pack8(v0, v1); } }
        }
    }
};
struct EpiSsm1 {
    static constexpr bool PERM = true, MIDK = false;
    bf16_t* X;
    __device__ __forceinline__ void midk(f32x4 (&)[2][2][4][2], const Unit&, int, int) const {}
    __device__ __forceinline__ void operator()(const f32x4 (&acc)[2][2][4][2], const Unit& u, int wr, int wc, int fr, int fq) const {
        EPI_ROWS; GAS bf16_t* op = (GAS bf16_t*)X + (size_t)row0 * 512 + wc * 32 + 8 * fq; LAUNDER(op);
#pragma unroll
        for (int ai = 0; ai < 2; ++ai)
#pragma unroll
            for (int m = 0; m < 4; ++m)
#pragma unroll
                for (int bj = 0; bj < 2; ++bj) *(GAS u32x4*)(op + (size_t)(ai * 128 + m * 16) * 512 + bj * 128) = pack8(acc[ai][bj][m][0], acc[ai][bj][m][1]);
    }
};
struct EpiSsm2 {
    static constexpr bool PERM = true, MIDK = false;
    bf16_t* gact;
    __device__ __forceinline__ void midk(f32x4 (&)[2][2][4][2], const Unit&, int, int) const {}
    __device__ __forceinline__ void operator()(const f32x4 (&acc)[2][2][4][2], const Unit& u, int wr, int wc, int fr, int fq) const {
        EPI_ROWS; const int g = u.pn; const int c0 = wc * 32 + 8 * fq;
        GAS bf16_t* op = (GAS bf16_t*)gact + ((size_t)(row0 - g * NCHUNK) * 16 + (c0 >> 4)) * MIXW + g * 16 + (c0 & 15); LAUNDER(op);
#pragma unroll
        for (int ai = 0; ai < 2; ++ai)
#pragma unroll
            for (int m = 0; m < 4; ++m)
#pragma unroll
                for (int bj = 0; bj < 2; ++bj) { f32x4 v0 = acc[ai][bj][m][0], v1 = acc[ai][bj][m][1];
#pragma unroll
                    for (int e = 0; e < 4; ++e) { v0[e] = gelu_tanh(v0[e]); v1[e] = gelu_tanh(v1[e]); }
                    *(GAS u32x4*)(op + ((size_t)(ai * 128 + m * 16) * 16 + bj * 8) * MIXW) = pack8(v0, v1); }
    }
};
struct EpiQ {
    static constexpr bool PERM = true, MIDK = false;
    const float* rstd_q; bf16_t* q; const float* ropetab;
    __device__ __forceinline__ void midk(f32x4 (&)[2][2][4][2], const Unit&, int, int) const {}
    __device__ __forceinline__ void operator()(const f32x4 (&acc)[2][2][4][2], const Unit& u, int wr, int wc, int fr, int fq) const {
        EPI_ROWS; const GAS float* rsp = (const GAS float*)(rstd_q + row0); GAS bf16_t* op = (GAS bf16_t*)q + (size_t)row0 * QW + u.pn * 256 + wc * 32 + 8 * fq; LAUNDER(rsp); LAUNDER(op);
#pragma unroll
        for (int ai = 0; ai < 2; ++ai)
#pragma unroll
            for (int m = 0; m < 4; ++m) { const int row = row0 + ai * 128 + m * 16; const float rs = rsp[ai * 128 + m * 16]; const int pos = pos_of(row);
#pragma unroll
                for (int bj = 0; bj < 2; ++bj) { const int strip = 8 * u.pn + 4 * bj + wc, s6 = strip % 6;
                    f32x4 v0 = acc[ai][bj][m][0] * rs, v1 = acc[ai][bj][m][1] * rs;
                    if (s6 >= 4) { const int pc = (s6 - 4) * 32 + 8 * fq;
                        const f32x4 cs0 = *(const GAS f32x4*)((const GAS float*)ropetab + (size_t)pos * 64 + pc), cs1 = *(const GAS f32x4*)((const GAS float*)ropetab + (size_t)pos * 64 + pc + 4);
                        v0 = rope4(v0, cs0); v1 = rope4(v1, cs1); }
                    *(GAS u32x4*)(op + (size_t)(ai * 128 + m * 16) * QW + bj * 128) = pack8(v0, v1); } }
    }
};
struct EpiKV {
    static constexpr bool PERM = true, MIDK = false;
    const float* rstd_kv; bf16_t* kv;
    __device__ __forceinline__ void midk(f32x4 (&)[2][2][4][2], const Unit&, int, int) const {}
    __device__ __forceinline__ void operator()(const f32x4 (&acc)[2][2][4][2], const Unit& u, int wr, int wc, int fr, int fq) const {
        EPI_ROWS; const GAS float* rsp = (const GAS float*)(rstd_kv + row0); GAS bf16_t* op = (GAS bf16_t*)kv + (size_t)row0 * 2048 + u.pn * 256 + wc * 32 + 8 * fq; LAUNDER(rsp); LAUNDER(op);
#pragma unroll
        for (int ai = 0; ai < 2; ++ai)
#pragma unroll
            for (int m = 0; m < 4; ++m) { const float rs = rsp[ai * 128 + m * 16];
#pragma unroll
                for (int bj = 0; bj < 2; ++bj) *(GAS u32x4*)(op + (size_t)(ai * 128 + m * 16) * 2048 + bj * 128) = pack8(acc[ai][bj][m][0] * rs, acc[ai][bj][m][1] * rs); }
    }
};
struct EpiVT {
    static constexpr bool PERM = true, MIDK = false;
    const float* rstd_kv; bf16_t* vt;
    __device__ __forceinline__ void midk(f32x4 (&)[2][2][4][2], const Unit&, int, int) const {}
    __device__ __forceinline__ void operator()(const f32x4 (&acc)[2][2][4][2], const Unit& u, int wr, int wc, int fr, int fq) const {
        EPI_ROWS; const int c0 = u.pn * 256 + wc * 32 + 8 * fq; const GAS float* rsp = (const GAS float*)(rstd_kv + c0); GAS bf16_t* op = (GAS bf16_t*)vt + (size_t)row0 * T + c0; LAUNDER(rsp); LAUNDER(op);
        GAS bf16_t* opp = op - 8 * fq + 16 * (fq & 1) + 4 * (fq >> 1);
#pragma unroll
        for (int bj = 0; bj < 2; ++bj) { const f32x4 r0 = *(const GAS f32x4*)(rsp + bj * 128), r1 = *(const GAS f32x4*)(rsp + bj * 128 + 4);
#pragma unroll
            for (int ai = 0; ai < 2; ++ai)
#pragma unroll
                for (int m = 0; m < 4; ++m) { const u32x4 w = pack8(acc[ai][bj][m][0] * r0, acc[ai][bj][m][1] * r1); GAS bf16_t* q_ = opp + (size_t)(ai * 128 + m * 16) * T + bj * 128;
                    *(GAS u32x2*)q_ = (u32x2){w.x, w.y}; *(GAS u32x2*)(q_ + 8) = (u32x2){w.z, w.w}; } }
    }
};
struct EpiGlu {
    static constexpr bool PERM = true, MIDK = false;
    const bf16_t* gact; bf16_t* merged; float* stA;
    __device__ __forceinline__ void midk(f32x4 (&)[2][2][4][2], const Unit&, int, int) const {}
    __device__ __forceinline__ void operator()(const f32x4 (&acc)[2][2][4][2], const Unit& u, int wr, int wc, int fr, int fq) const {
        EPI_ROWS; const int c0 = u.pn * 256 + wc * 32 + 8 * fq;
        const GAS bf16_t* gp = (const GAS bf16_t*)gact + (size_t)row0 * MIXW + c0; GAS bf16_t* op = (GAS bf16_t*)merged + (size_t)row0 * DM + c0; GAS float* sp = (GAS float*)stA + (size_t)row0 * 32 + u.pn * 4 + wc; LAUNDER(gp); LAUNDER(op); LAUNDER(sp);
#pragma unroll
        for (int ai = 0; ai < 2; ++ai)
#pragma unroll
            for (int m = 0; m < 4; ++m) { float ss = 0.f;
#pragma unroll
                for (int bj = 0; bj < 2; ++bj) {
                    const u32x4 gw = *(const GAS u32x4*)(gp + (size_t)(ai * 128 + m * 16) * MIXW + bj * 128);
                    f32x4 v0, v1; const f32x4 a0 = acc[ai][bj][m][0], a1 = acc[ai][bj][m][1];
                    v0[0] = bflo(gw.x) * sigmoidf_fast(a0[0]); v0[1] = bfhi(gw.x) * sigmoidf_fast(a0[1]); v0[2] = bflo(gw.y) * sigmoidf_fast(a0[2]); v0[3] = bfhi(gw.y) * sigmoidf_fast(a0[3]);
                    v1[0] = bflo(gw.z) * sigmoidf_fast(a1[0]); v1[1] = bfhi(gw.z) * sigmoidf_fast(a1[1]); v1[2] = bflo(gw.w) * sigmoidf_fast(a1[2]); v1[3] = bfhi(gw.w) * sigmoidf_fast(a1[3]);
                    ss += sq8(v0, v1);
                    *(GAS u32x4*)(op + (size_t)(ai * 128 + m * 16) * DM + bj * 128) = pack8(v0, v1); }
                ss = red_fq(ss); if (fq == 0) sp[(size_t)(ai * 128 + m * 16) * 32] = ss; }
    }
};
struct EpiWout {
    static constexpr bool PERM = true, MIDK = true;
    const float* xp; const float* xs; const float* r2; const float* ratio; bf16_t* x1b; float* stA;
    __device__ __forceinline__ void midk(f32x4 (&acc)[2][2][4][2], const Unit& u, int wr, int fr) const {
        EPI_ROWS; const GAS float* rp = (const GAS float*)(ratio + row0); LAUNDER(rp);
#pragma unroll
        for (int ai = 0; ai < 2; ++ai)
#pragma unroll
            for (int m = 0; m < 4; ++m) { const float rt = rp[ai * 128 + m * 16];
#pragma unroll
                for (int bj = 0; bj < 2; ++bj)
#pragma unroll
                    for (int n = 0; n < 2; ++n) acc[ai][bj][m][n] *= rt; }
    }
    __device__ __forceinline__ void operator()(const f32x4 (&acc)[2][2][4][2], const Unit& u, int wr, int wc, int fr, int fq) const {
        EPI_ROWS; const int c0 = u.pn * 256 + wc * 32 + 8 * fq; const int rowt = u.pm * 256;
        const GAS float* xin = (const GAS float*)(rowt < 16384 ? xp + (size_t)row0 * DM : xs + (size_t)(row0 - 16384) * DM) + c0;
        const GAS float* rsp = (const GAS float*)(r2 + row0); GAS bf16_t* bo = (GAS bf16_t*)x1b + (size_t)row0 * DM + c0; GAS float* sp = (GAS float*)stA + (size_t)row0 * 64 + u.pn * 4 + wc;
        LAUNDER(xin); LAUNDER(rsp); LAUNDER(bo); LAUNDER(sp);
#pragma unroll
        for (int ai = 0; ai < 2; ++ai)
#pragma unroll
            for (int m = 0; m < 4; ++m) { const float rs = rsp[ai * 128 + m * 16]; float ss = 0.f; const size_t ro = (size_t)(ai * 128 + m * 16) * DM;
#pragma unroll
                for (int bj = 0; bj < 2; ++bj) {
                    const f32x4 v0 = *(const GAS f32x4*)(xin + ro + bj * 128) + acc[ai][bj][m][0] * rs, v1 = *(const GAS f32x4*)(xin + ro + bj * 128 + 4) + acc[ai][bj][m][1] * rs;
                    ss += sq8(v0, v1);
                    *(GAS u32x4*)(bo + ro + bj * 128) = pack8(v0, v1); }
                ss = red_fq(ss); if (fq == 0) sp[(size_t)(ai * 128 + m * 16) * 64] = ss; }
    }
};
__device__ __forceinline__ float dpp_ror1(float v) { return __builtin_bit_cast(float, __builtin_amdgcn_update_dpp(0, __builtin_bit_cast(int, v), 0x121, 0xf, 0xf, false)); }
__device__ __forceinline__ float dpp_rol1(float v) { return __builtin_bit_cast(float, __builtin_amdgcn_update_dpp(0, __builtin_bit_cast(int, v), 0x12f, 0xf, 0xf, false)); }
struct EpiFfnA {
    static constexpr bool PERM = true, MIDK = false;
    const float* rstd; int row_base; bf16_t* act; bf16_t* halo_up; bf16_t* halo_gate; const float* cw; const float* cb;
    __device__ __forceinline__ void midk(f32x4 (&)[2][2][4][2], const Unit&, int, int) const {}
    __device__ __forceinline__ void operator()(const f32x4 (&acc)[2][2][4][2], const Unit& u, int wr, int wc, int fr, int fq) const {
        EPI_ROWS; const int f0 = u.pn * 128 + wc * 32 + 8 * fq;
        const GAS float* rsp = (const GAS float*)(rstd + row_base + row0); GAS bf16_t* actp = (GAS bf16_t*)act + (size_t)row0 * DFF + f0;
        const int strip0 = u.pm * 4 + wr;
        GAS bf16_t* hup_p = (GAS bf16_t*)halo_up + (size_t)strip0 * 4 * DFF + f0; GAS bf16_t* hg_p = (GAS bf16_t*)halo_gate + (size_t)strip0 * 2 * DFF + f0;
        const GAS float* cwp = (const GAS float*)(cw + f0); const GAS float* cbp = (const GAS float*)(cb + f0);
        asm volatile("" : "+v"(rsp), "+v"(actp), "+v"(hup_p), "+v"(hg_p), "+v"(cwp), "+v"(cbp));
#pragma unroll
        for (int ai = 0; ai < 2; ++ai) {
            float rs[4];
#pragma unroll
            for (int m = 0; m < 4; ++m) rs[m] = rsp[ai * 128 + m * 16];
#pragma unroll
            for (int n = 0; n < 2; ++n) {
                const f32x4 w0 = *(const GAS f32x4*)(cwp + 4 * n), w1 = *(const GAS f32x4*)(cwp + DFF + 4 * n), w2 = *(const GAS f32x4*)(cwp + 2 * DFF + 4 * n), wb = *(const GAS f32x4*)(cbp + 4 * n);
                f32x4 res[4], Uu[4];
#pragma unroll
                for (int e = 0; e < 4; ++e) {
                    float U[4], R[4], L[4];
#pragma unroll
                    for (int m = 0; m < 4; ++m) { U[m] = acc[ai][0][m][n][e] * rs[m]; R[m] = dpp_ror1(U[m]); L[m] = dpp_rol1(U[m]); Uu[m][e] = U[m]; }
#pragma unroll
                    for (int m = 0; m < 4; ++m) {
                        const float prev = (fr == 0) ? R[m > 0 ? m - 1 : 0] : R[m];
                        const float next = (fr == 15) ? L[m < 3 ? m + 1 : 3] : L[m];
                        const float cv = w0[e] * prev + w1[e] * U[m] + w2[e] * next + wb[e];
                        res[m][e] = cv * sigmoidf_fast(cv) * (acc[ai][1][m][n][e] * rs[m]);
                    }
                }
#pragma unroll
                for (int m = 0; m < 4; ++m) {
                    const bool edge = (m == 0 && fr == 0) || (m == 3 && fr == 15);
                    if (!edge) { u32x2 w; w.x = cvt_pk_bf16(res[m][0], res[m][1]); w.y = cvt_pk_bf16(res[m][2], res[m][3]); *(GAS u32x2*)(actp + (size_t)(ai * 128 + m * 16) * DFF + 4 * n) = w; }
                    if (m == 0 || m == 3) {
                        const int hs = (m == 0) ? (fr == 0 ? 0 : (fr == 1 ? 1 : -1)) : (fr == 14 ? 2 : (fr == 15 ? 3 : -1));
                        if (hs >= 0) { u32x2 w; w.x = cvt_pk_bf16(Uu[m][0], Uu[m][1]); w.y = cvt_pk_bf16(Uu[m][2], Uu[m][3]);
                            *(GAS u32x2*)(hup_p + ((size_t)(ai * 2) * 4 + hs) * DFF + 4 * n) = w;
                            if (hs == 0 || hs == 3) { const f32x4 gv = acc[ai][1][m][n] * rs[m]; u32x2 wg; wg.x = cvt_pk_bf16(gv[0], gv[1]); wg.y = cvt_pk_bf16(gv[2], gv[3]);
                                *(GAS u32x2*)(hg_p + ((size_t)(ai * 2) * 2 + (hs == 3 ? 1 : 0)) * DFF + 4 * n) = wg; } }
                    }
                }
            }
        }
    }
};
struct EpiDown {
    static constexpr bool PERM = true, MIDK = false;
    bf16_t* xb; int row_base; float* stA;
    __device__ __forceinline__ void midk(f32x4 (&)[2][2][4][2], const Unit&, int, int) const {}
    __device__ __forceinline__ void operator()(const f32x4 (&acc)[2][2][4][2], const Unit& u, int wr, int wc, int fr, int fq) const {
        EPI_ROWS; GAS bf16_t* xo = (GAS bf16_t*)xb + (size_t)(row_base + row0) * DM + u.pn * 256 + wc * 32 + 8 * fq; GAS float* sp = (GAS float*)stA + (size_t)(row_base + row0) * 64 + u.pn * 4 + wc; LAUNDER(xo); LAUNDER(sp);
#pragma unroll
        for (int ai = 0; ai < 2; ++ai)
#pragma unroll
            for (int m = 0; m < 4; ++m) { float ss = 0.f; const size_t ro = (size_t)(ai * 128 + m * 16) * DM;
#pragma unroll
                for (int bj = 0; bj < 2; ++bj) { GAS bf16_t* p = xo + ro + bj * 128; const u32x4 w = *(const GAS u32x4*)p; const f32x4 a0 = acc[ai][bj][m][0], a1 = acc[ai][bj][m][1];
                    f32x4 v0, v1; v0[0] = bflo(w.x) + a0[0]; v0[1] = bfhi(w.x) + a0[1]; v0[2] = bflo(w.y) + a0[2]; v0[3] = bfhi(w.y) + a0[3];
                    v1[0] = bflo(w.z) + a1[0]; v1[1] = bfhi(w.z) + a1[1]; v1[2] = bflo(w.w) + a1[2]; v1[3] = bfhi(w.w) + a1[3];
                    ss += sq8(v0, v1); *(GAS u32x4*)p = pack8(v0, v1); }
                ss = red_fq(ss); if (fq == 0) sp[(size_t)(ai * 128 + m * 16) * 64] = ss; }
    }
};
#undef EPI_ROWS
}

namespace attn {
using f32x4v = __attribute__((ext_vector_type(4))) float;
using u32x2v = __attribute__((ext_vector_type(2))) unsigned;
using u32x4v = __attribute__((ext_vector_type(4))) unsigned;
constexpr int NW = 8, KVBLK = 64;
constexpr float SCALE = 0.07216878364870322f;
constexpr float THR = 8.f;
constexpr int LDQ = 3072, LDK = 2048, LDR = 64, LDVT = T, LDO = 4096;
constexpr int SHM_V = 128 * KVBLK * 2, SHM_K = KVBLK * 128 * 2, SHM_R = KVBLK * 64 * 2;
constexpr int OFF_V = 0, OFF_K = 2 * SHM_V, OFF_R = OFF_K + 2 * SHM_K, OFF_QR = OFF_R + 2 * SHM_R, SHM_ATTN = OFF_QR + NW * 4096;
#define SBAR() __builtin_amdgcn_sched_barrier(0)
#define PIN(x) asm volatile("" : "+v"(x))
__device__ __forceinline__ void glds16(const void* gsrc, unsigned lds_dst) { unsigned keep;
  asm volatile("s_mov_b32 %0, m0\n\ts_mov_b32 m0, %2\n\ts_nop 0\n\tglobal_load_lds_dwordx4 %1, off\n\ts_mov_b32 m0, %0" : "=&s"(keep) : "v"(gsrc), "s"(lds_dst) : "memory"); }
__device__ __forceinline__ unsigned cvtpk(float lo, float hi) { unsigned r; asm volatile("v_cvt_pk_bf16_f32 %0, %1, %2" : "=v"(r) : "v"(lo), "v"(hi)); return r; }
__device__ __forceinline__ float xmax16(float v) { auto r = __builtin_amdgcn_permlane16_swap(__float_as_uint(v), __float_as_uint(v), false, false); return fmaxf(__uint_as_float(r[0]), __uint_as_float(r[1])); }
__device__ __forceinline__ float xmax32(float v) { auto r = __builtin_amdgcn_permlane32_swap(__float_as_uint(v), __float_as_uint(v), false, false); return fmaxf(__uint_as_float(r[0]), __uint_as_float(r[1])); }
__device__ __forceinline__ float xsum16(float v) { auto r = __builtin_amdgcn_permlane16_swap(__float_as_uint(v), __float_as_uint(v), false, false); return __uint_as_float(r[0]) + __uint_as_float(r[1]); }
__device__ __forceinline__ float xsum32(float v) { auto r = __builtin_amdgcn_permlane32_swap(__float_as_uint(v), __float_as_uint(v), false, false); return __uint_as_float(r[0]) + __uint_as_float(r[1]); }
#define MF16(A, B, C) __builtin_amdgcn_mfma_f32_16x16x32_bf16(A, B, C, 0, 0, 0)
struct Lane { const LAS char* Kl; const LAS char* Rl; const LAS char* Vl; const LAS char* qrl; int ky, rz, vz; };
template <int KB, int S> __device__ __forceinline__ bf16x8 kfrag(const Lane& L, int kst, int rst) {
  if constexpr (S < 4) return *(const LAS bf16x8*)(L.Kl + kst + KB * 4096 + ((64 * S) ^ L.ky));
  else return *(const LAS bf16x8*)(L.Rl + rst + KB * 2048 + ((64 * (S - 4)) ^ L.rz));
}
template <int DB, int C> __device__ __forceinline__ bf16x8 vfrag(const Lane& L, int vst) { return *(const LAS bf16x8*)(L.Vl + vst + DB * 2048 + ((64 * C) ^ L.rz)); }
template <int QB, int S> __device__ __forceinline__ bf16x8 qfrag(const bf16x8 (&qn)[2][6], const Lane& L) { return qn[QB][S]; }
template <int KB> __device__ __forceinline__ void qk_block_plain(f32x4v (&s)[2][4], const bf16x8 (&qn)[2][6], const Lane& L, int kst, int rst) {
  bf16x8 k = kfrag<KB, 0>(L, kst, rst); s[0][KB] = MF16(k, (qfrag<0, 0>(qn, L)), ((f32x4v){0.f, 0.f, 0.f, 0.f})); s[1][KB] = MF16(k, (qfrag<1, 0>(qn, L)), ((f32x4v){0.f, 0.f, 0.f, 0.f}));
  k = kfrag<KB, 1>(L, kst, rst); s[0][KB] = MF16(k, (qfrag<0, 1>(qn, L)), s[0][KB]); s[1][KB] = MF16(k, (qfrag<1, 1>(qn, L)), s[1][KB]);
  k = kfrag<KB, 2>(L, kst, rst); s[0][KB] = MF16(k, (qfrag<0, 2>(qn, L)), s[0][KB]); s[1][KB] = MF16(k, (qfrag<1, 2>(qn, L)), s[1][KB]);
  k = kfrag<KB, 3>(L, kst, rst); s[0][KB] = MF16(k, (qfrag<0, 3>(qn, L)), s[0][KB]); s[1][KB] = MF16(k, (qfrag<1, 3>(qn, L)), s[1][KB]);
  k = kfrag<KB, 4>(L, kst, rst); s[0][KB] = MF16(k, (qfrag<0, 4>(qn, L)), s[0][KB]); s[1][KB] = MF16(k, (qfrag<1, 4>(qn, L)), s[1][KB]);
  k = kfrag<KB, 5>(L, kst, rst); s[0][KB] = MF16(k, (qfrag<0, 5>(qn, L)), s[0][KB]); s[1][KB] = MF16(k, (qfrag<1, 5>(qn, L)), s[1][KB]);
}
template <int QB> __device__ __forceinline__ float rowmax(const f32x4v (&s)[2][4]) {
  float m = fmaxf(fmaxf(s[QB][0][0], s[QB][0][1]), fmaxf(s[QB][0][2], s[QB][0][3]));
#pragma unroll
  for (int kb = 1; kb < 4; ++kb) m = fmaxf(m, fmaxf(fmaxf(s[QB][kb][0], s[QB][kb][1]), fmaxf(s[QB][kb][2], s[QB][kb][3])));
  return m;
}
__device__ __forceinline__ void decide(float pm0, float pm1, float (&m)[2], float (&al)[2], float (&mnC)[2]) {
  constexpr float C = SCALE * 1.4426950408889634f;
  pm0 = xmax32(xmax16(pm0)); pm1 = xmax32(xmax16(pm1));
  if (__builtin_expect(__all((pm0 - m[0] <= THR / SCALE) && (pm1 - m[1] <= THR / SCALE)), 1)) { al[0] = 1.f; al[1] = 1.f; }
  else { const float n0 = fmaxf(m[0], pm0), n1 = fmaxf(m[1], pm1); al[0] = __builtin_amdgcn_exp2f((m[0] - n0) * C); al[1] = __builtin_amdgcn_exp2f((m[1] - n1) * C); m[0] = n0; m[1] = n1; }
  mnC[0] = -m[0] * C; mnC[1] = -m[1] * C;
}
__device__ __forceinline__ bf16x8 packp(const f32x4v a, const f32x4v b) { const u32x4v w = {cvtpk(a[0], a[1]), cvtpk(a[2], a[3]), cvtpk(b[0], b[1]), cvtpk(b[2], b[3])}; return __builtin_bit_cast(bf16x8, w); }

__device__ __forceinline__ void attn_step(f32x4v (&c)[2][4], f32x4v (&p)[2][4], f32x4v (&o)[2][8], const bf16x8 (&qn)[2][6], const Lane& L, int kst, int rst, int vst,
                                          const float (&alp)[2], float (&l)[2], float (&m)[2], float (&alc)[2]) {
  constexpr float C = SCALE * 1.4426950408889634f;
  bf16x8 ka, kb_, kc, kd, P00, P01, P10, P11; float mnC[2];
#define QKR(KB, S, FIRST, KX, KY) do { \
    if (FIRST) { c[0][KB] = MF16(KX, (qfrag<0, S>(qn, L)), ((f32x4v){0.f, 0.f, 0.f, 0.f})); c[1][KB] = MF16(KX, (qfrag<1, S>(qn, L)), ((f32x4v){0.f, 0.f, 0.f, 0.f})); \
                 c[0][KB + 1] = MF16(KY, (qfrag<0, S>(qn, L)), ((f32x4v){0.f, 0.f, 0.f, 0.f})); c[1][KB + 1] = MF16(KY, (qfrag<1, S>(qn, L)), ((f32x4v){0.f, 0.f, 0.f, 0.f})); } \
    else { c[0][KB] = MF16(KX, (qfrag<0, S>(qn, L)), c[0][KB]); c[1][KB] = MF16(KX, (qfrag<1, S>(qn, L)), c[1][KB]); \
           c[0][KB + 1] = MF16(KY, (qfrag<0, S>(qn, L)), c[0][KB + 1]); c[1][KB + 1] = MF16(KY, (qfrag<1, S>(qn, L)), c[1][KB + 1]); } } while (0)
#define EXP4(V) do { V[0] = __builtin_amdgcn_exp2f(V[0]); V[1] = __builtin_amdgcn_exp2f(V[1]); V[2] = __builtin_amdgcn_exp2f(V[2]); V[3] = __builtin_amdgcn_exp2f(V[3]); } while (0)
  ka = kfrag<0, 0>(L, kst, rst); kb_ = kfrag<1, 0>(L, kst, rst); SBAR();
  kc = kfrag<0, 1>(L, kst, rst); kd = kfrag<1, 1>(L, kst, rst); QKR(0, 0, true, ka, kb_); EXP4(p[0][2]); PIN(p[0][2]); SBAR();
  ka = kfrag<0, 2>(L, kst, rst); kb_ = kfrag<1, 2>(L, kst, rst); QKR(0, 1, false, kc, kd); EXP4(p[0][3]); PIN(p[0][3]); SBAR();
  kc = kfrag<0, 3>(L, kst, rst); kd = kfrag<1, 3>(L, kst, rst); QKR(0, 2, false, ka, kb_); EXP4(p[1][2]); PIN(p[1][2]); SBAR();
  ka = kfrag<0, 4>(L, kst, rst); kb_ = kfrag<1, 4>(L, kst, rst); QKR(0, 3, false, kc, kd); EXP4(p[1][3]); PIN(p[1][3]); SBAR();
  kc = kfrag<0, 5>(L, kst, rst); kd = kfrag<1, 5>(L, kst, rst); QKR(0, 4, false, ka, kb_);
  { float s = (p[0][0][0] + p[0][0][1]) + (p[0][0][2] + p[0][0][3]); s += (p[0][1][0] + p[0][1][1]) + (p[0][1][2] + p[0][1][3]); s += (p[0][2][0] + p[0][2][1]) + (p[0][2][2] + p[0][2][3]); s += (p[0][3][0] + p[0][3][1]) + (p[0][3][2] + p[0][3][3]);
    l[0] = l[0] * alp[0] + s; PIN(l[0]); } SBAR();
  ka = kfrag<2, 0>(L, kst, rst); kb_ = kfrag<3, 0>(L, kst, rst); QKR(0, 5, false, kc, kd);
  { float s = (p[1][0][0] + p[1][0][1]) + (p[1][0][2] + p[1][0][3]); s += (p[1][1][0] + p[1][1][1]) + (p[1][1][2] + p[1][1][3]); s += (p[1][2][0] + p[1][2][1]) + (p[1][2][2] + p[1][2][3]); s += (p[1][3][0] + p[1][3][1]) + (p[1][3][2] + p[1][3][3]);
    l[1] = l[1] * alp[1] + s; PIN(l[1]); } SBAR();
  kc = kfrag<2, 1>(L, kst, rst); kd = kfrag<3, 1>(L, kst, rst); QKR(2, 0, true, ka, kb_); P00 = packp(p[0][0], p[0][1]); PIN(P00); SBAR();
  ka = kfrag<2, 2>(L, kst, rst); kb_ = kfrag<3, 2>(L, kst, rst); QKR(2, 1, false, kc, kd); P01 = packp(p[0][2], p[0][3]); PIN(P01); SBAR();
  kc = kfrag<2, 3>(L, kst, rst); kd = kfrag<3, 3>(L, kst, rst); QKR(2, 2, false, ka, kb_); P10 = packp(p[1][0], p[1][1]); PIN(P10); SBAR();
  ka = kfrag<2, 4>(L, kst, rst); kb_ = kfrag<3, 4>(L, kst, rst); QKR(2, 3, false, kc, kd); P11 = packp(p[1][2], p[1][3]); PIN(P11); SBAR();
  kc = kfrag<2, 5>(L, kst, rst); kd = kfrag<3, 5>(L, kst, rst); QKR(2, 4, false, ka, kb_); SBAR();
  ka = vfrag<0, 0>(L, vst); kb_ = vfrag<1, 0>(L, vst); QKR(2, 5, false, kc, kd); SBAR();
#define PVR(DB, VX, VY, PA, PB) do { o[0][DB] = MF16(VX, PA, o[0][DB]); o[1][DB] = MF16(VX, PB, o[1][DB]); o[0][DB + 1] = MF16(VY, PA, o[0][DB + 1]); o[1][DB + 1] = MF16(VY, PB, o[1][DB + 1]); } while (0)
  float pm0, pm1;
  kc = vfrag<2, 0>(L, vst); kd = vfrag<3, 0>(L, vst); PVR(0, ka, kb_, P00, P10); pm0 = rowmax<0>(c); PIN(pm0); SBAR();
  ka = vfrag<4, 0>(L, vst); kb_ = vfrag<5, 0>(L, vst); PVR(2, kc, kd, P00, P10); pm1 = rowmax<1>(c); PIN(pm1); SBAR();
  kc = vfrag<6, 0>(L, vst); kd = vfrag<7, 0>(L, vst); PVR(4, ka, kb_, P00, P10); decide(pm0, pm1, m, alc, mnC); SBAR();
  ka = vfrag<0, 1>(L, vst); kb_ = vfrag<1, 1>(L, vst); PVR(6, kc, kd, P00, P10);
#pragma unroll
  for (int kb = 0; kb < 4; ++kb) { c[0][kb] = c[0][kb] * C + mnC[0]; PIN(c[0][kb]); } SBAR();
  kc = vfrag<2, 1>(L, vst); kd = vfrag<3, 1>(L, vst); PVR(0, ka, kb_, P01, P11);
#pragma unroll
  for (int kb = 0; kb < 4; ++kb) { c[1][kb] = c[1][kb] * C + mnC[1]; PIN(c[1][kb]); } SBAR();
  ka = vfrag<4, 1>(L, vst); kb_ = vfrag<5, 1>(L, vst); PVR(2, kc, kd, P01, P11); EXP4(c[0][0]); PIN(c[0][0]); SBAR();
  kc = vfrag<6, 1>(L, vst); kd = vfrag<7, 1>(L, vst); PVR(4, ka, kb_, P01, P11); EXP4(c[0][1]); PIN(c[0][1]); SBAR();
  PVR(6, kc, kd, P01, P11); EXP4(c[1][0]); EXP4(c[1][1]); PIN(c[1][0]); PIN(c[1][1]); SBAR();
#undef QKR
#undef PVR
}

__device__ __forceinline__ void attn_unit(const bf16* __restrict__ Qb, const bf16* __restrict__ Kh, const bf16* __restrict__ VTh, const bf16* __restrict__ Rh,
                                          bf16* __restrict__ Ob, float* __restrict__ st, int seq, int k0g, char* lds, int wid) {
  int lane_l = (int)__builtin_amdgcn_mbcnt_hi(~0u, __builtin_amdgcn_mbcnt_lo(~0u, 0u)); asm volatile("" : "+v"(lane_l));
  const int lane = lane_l, l15 = lane & 15, kq = lane >> 4;
  constexpr float C = SCALE * 1.4426950408889634f;
  bf16x8 qn[2][6]; Lane L;
  L.qrl = (const LAS char*)(lds + OFF_QR + wid * 4096 + lane * 16);
  { const bf16* Qw = Qb + (long)(wid * 32 + l15) * LDQ + kq * 8;
#pragma unroll
    for (int qb = 0; qb < 2; ++qb) {
#pragma unroll
      for (int s = 0; s < 6; ++s) qn[qb][s] = *(const GAS bf16x8*)(Qw + (long)qb * 16 * LDQ + s * 32); } }
  L.Kl = (const LAS char*)(lds + OFF_K) + l15 * 256; L.Rl = (const LAS char*)(lds + OFF_R) + l15 * 128; L.Vl = (const LAS char*)(lds + OFF_V) + l15 * 128;
  L.ky = (kq ^ l15) << 4; L.rz = (kq ^ ((l15 >> 1) & 7)) << 4; L.vz = 0;
  unsigned kof0, kof1, rof, vof0, vof1;
  { const int q0 = wid, q1 = wid + 8;
    { const int row = 4 * q0 + (lane >> 4), ch = (lane & 15) ^ (row & 15); kof0 = (unsigned)(row * LDK + ch * 8) * 2u; }
    { const int row = 4 * q1 + (lane >> 4), ch = (lane & 15) ^ (row & 15); kof1 = (unsigned)(row * LDK + ch * 8) * 2u; }
    { const int row = 8 * q0 + (lane >> 3), ch = (lane & 7) ^ ((row >> 1) & 7); rof = (unsigned)(row * LDR + ch * 8) * 2u; }
    { const int row = 8 * q0 + (lane >> 3), ch = (lane & 7) ^ ((row >> 1) & 7); vof0 = (unsigned)(row * LDVT + ch * 8) * 2u; }
    { const int row = 8 * q1 + (lane >> 3), ch = (lane & 7) ^ ((row >> 1) & 7); vof1 = (unsigned)(row * LDVT + ch * 8) * 2u; } }
  const unsigned lds0 = (unsigned)(uintptr_t)lds;
  const unsigned dK = (unsigned)__builtin_amdgcn_readfirstlane(lds0 + OFF_K + wid * 1024), dR = (unsigned)__builtin_amdgcn_readfirstlane(lds0 + OFF_R + wid * 1024), dV = (unsigned)__builtin_amdgcn_readfirstlane(lds0 + OFF_V + wid * 1024);
  const char* VTk = (const char*)VTh + (size_t)k0g * 2;
#define DMA_KR(t, s) do { const char* kb_ = (const char*)Kh + (size_t)(t) * (KVBLK * LDK * 2); const char* rb_ = (const char*)Rh + (size_t)(t) * (KVBLK * LDR * 2); \
    glds16(kb_ + kof0, dK + (s) * SHM_K); glds16(kb_ + kof1, dK + (s) * SHM_K + 8192); glds16(rb_ + rof, dR + (s) * SHM_R); } while (0)
#define DMA_V(t, s) do { const char* vb_ = VTk + (size_t)(t) * (KVBLK * 2); glds16(vb_ + vof0, dV + (s) * SHM_V); glds16(vb_ + vof1, dV + (s) * SHM_V + 8192); } while (0)
#define WAIT_BAR() asm volatile("s_waitcnt vmcnt(0) lgkmcnt(0)\n\ts_barrier" ::: "memory")
#define RESC(a) do { if (__any(((a)[0] < 1.f) || ((a)[1] < 1.f))) { _Pragma("unroll") for (int d_ = 0; d_ < 8; ++d_) { o[0][d_] *= (a)[0]; o[1][d_] *= (a)[1]; } } } while (0)
  f32x4v o[2][8], sA[2][4], sB[2][4]; float m[2] = {-1e30f, -1e30f}, l[2] = {0.f, 0.f}, alA[2], alB[2];
#pragma unroll
  for (int d = 0; d < 8; ++d) { o[0][d] = (f32x4v){0.f, 0.f, 0.f, 0.f}; o[1][d] = (f32x4v){0.f, 0.f, 0.f, 0.f}; }
  const int NT = seq / KVBLK;
  DMA_KR(0, 0); DMA_V(0, 0); WAIT_BAR();
  DMA_KR(1, 1);
  qk_block_plain<0>(sA, qn, L, 0, 0); qk_block_plain<1>(sA, qn, L, 0, 0); qk_block_plain<2>(sA, qn, L, 0, 0); qk_block_plain<3>(sA, qn, L, 0, 0);
  { float mnC[2]; decide(rowmax<0>(sA), rowmax<1>(sA), m, alA, mnC); alA[0] = 1.f; alA[1] = 1.f;
#pragma unroll
    for (int kb = 0; kb < 4; ++kb) { sA[0][kb] = sA[0][kb] * C + mnC[0]; sA[1][kb] = sA[1][kb] * C + mnC[1]; }
#pragma unroll
    for (int kb = 0; kb < 2; ++kb)
#pragma unroll
      for (int e = 0; e < 4; ++e) { sA[0][kb][e] = __builtin_amdgcn_exp2f(sA[0][kb][e]); sA[1][kb][e] = __builtin_amdgcn_exp2f(sA[1][kb][e]); } }
  WAIT_BAR();
#pragma unroll 1
  for (int j = 1; j + 1 < NT; j += 2) {
    DMA_KR(j + 1, 0); DMA_V(j, 1);
    attn_step(sB, sA, o, qn, L, SHM_K, SHM_R, 0, alA, l, m, alB);
    RESC(alB); WAIT_BAR();
    if (j + 2 < NT) DMA_KR(j + 2, 1);
    DMA_V(j + 1, 0);
    attn_step(sA, sB, o, qn, L, 0, 0, SHM_V, alB, l, m, alA);
    RESC(alA); WAIT_BAR();
  }
  DMA_V(NT - 1, 1);
  attn_step(sB, sA, o, qn, L, SHM_K, SHM_R, 0, alA, l, m, alB);
  RESC(alB); WAIT_BAR();
  {
#pragma unroll
    for (int kb = 2; kb < 4; ++kb)
#pragma unroll
      for (int e = 0; e < 4; ++e) { sB[0][kb][e] = __builtin_amdgcn_exp2f(sB[0][kb][e]); sB[1][kb][e] = __builtin_amdgcn_exp2f(sB[1][kb][e]); }
    float s0 = 0.f, s1 = 0.f;
#pragma unroll
    for (int kb = 0; kb < 4; ++kb) { s0 += (sB[0][kb][0] + sB[0][kb][1]) + (sB[0][kb][2] + sB[0][kb][3]); s1 += (sB[1][kb][0] + sB[1][kb][1]) + (sB[1][kb][2] + sB[1][kb][3]); }
    l[0] = l[0] * alB[0] + s0; l[1] = l[1] * alB[1] + s1;
    const bf16x8 P00 = packp(sB[0][0], sB[0][1]), P01 = packp(sB[0][2], sB[0][3]), P10 = packp(sB[1][0], sB[1][1]), P11 = packp(sB[1][2], sB[1][3]);
#define PVD(DB) do { bf16x8 v0 = vfrag<DB, 0>(L, SHM_V), v1 = vfrag<DB, 1>(L, SHM_V); o[0][DB] = MF16(v0, P00, o[0][DB]); o[1][DB] = MF16(v0, P10, o[1][DB]); o[0][DB] = MF16(v1, P01, o[0][DB]); o[1][DB] = MF16(v1, P11, o[1][DB]); } while (0)
    PVD(0); PVD(1); PVD(2); PVD(3); PVD(4); PVD(5); PVD(6); PVD(7);
#undef PVD
  }
  int lane_e = (int)__builtin_amdgcn_mbcnt_hi(~0u, __builtin_amdgcn_mbcnt_lo(~0u, 0u)); asm volatile("" : "+v"(lane_e)); const int l15e = lane_e & 15, kqe = lane_e >> 4;
  GAS bf16* Ow = (GAS bf16*)Ob + (long)(wid * 32 + l15e) * LDO + 4 * kqe; GAS float* stw = (GAS float*)st + (long)(wid * 32 + l15e) * 16;
  asm volatile("" : "+v"(Ow), "+v"(stw));
#pragma unroll
  for (int qb = 0; qb < 2; ++qb) { const float lt = xsum32(xsum16(l[qb])); const float rl = __builtin_amdgcn_rcpf(lt); float ss = 0.f;
#pragma unroll
    for (int db = 0; db < 8; ++db) { const f32x4v v = o[qb][db] * rl; u32x2v w; w.x = cvtpk(v[0], v[1]); w.y = cvtpk(v[2], v[3]);
      const float a0 = bflo(w.x), a1 = bfhi(w.x), a2 = bflo(w.y), a3 = bfhi(w.y); ss += (a0 * a0 + a1 * a1) + (a2 * a2 + a3 * a3);
      *(GAS u32x2v*)(Ow + (long)(qb * 16) * LDO + db * 16) = w; }
    ss = xsum32(xsum16(ss)); if (kqe == 0) stw[(long)(qb * 16) * 16] = ss; }
  asm volatile("s_waitcnt lgkmcnt(0)\n\ts_barrier" ::: "memory");
#undef DMA_KR
#undef DMA_V
#undef WAIT_BAR
#undef RESC
}
#undef SBAR
#undef PIN
#undef MF16
#undef EXP4
}

constexpr size_t MiB = 1u << 20;
constexpr size_t WS_CTL = 0, CTL_ZERO_BYTES = 1 * MiB;
constexpr size_t WS_RSTDX = 1 * MiB, WS_RSTDQ = WS_RSTDX + 98304, WS_RSTDKV = WS_RSTDQ + 98304, WS_R2 = WS_RSTDKV + 98304, WS_RATIO = WS_R2 + 98304, WS_RSTDX1 = WS_RATIO + 98304;
constexpr size_t WS_STA = 2 * MiB;
constexpr size_t WS_STB = 8 * MiB;
constexpr size_t WS_STQ = 10 * MiB;
constexpr size_t WS_STKV = 12 * MiB;
constexpr size_t WS_ROPE = 13 * MiB;
constexpr size_t WS_WIN = 16 * MiB;
constexpr size_t WS_WGLU = 46 * MiB;
constexpr size_t WS_WQ = 54 * MiB;
constexpr size_t WS_WKV = 60 * MiB;
constexpr size_t WS_WOUT = 64 * MiB;
constexpr size_t WS_WUG = 96 * MiB;
constexpr size_t WS_WDN = 268 * MiB;
constexpr size_t WS_W1T = 354 * MiB;
constexpr size_t WS_W2T = 370 * MiB;
constexpr size_t WS_A = 402 * MiB;
constexpr size_t WS_B = 594 * MiB;
constexpr size_t WS_QLAT = 786 * MiB, WS_KVLAT = 828 * MiB, WS_KROPE = 852 * MiB;
constexpr size_t WS_GACT = 856 * MiB;
constexpr size_t WS_HUP = 952 * MiB, WS_HGATE = 964 * MiB, WS_END = 970 * MiB;
static_assert(WS_HUP + (size_t)128 * 4 * DFF * 2 <= WS_HGATE && WS_HGATE + (size_t)128 * 2 * DFF * 2 <= WS_END, "halo");
constexpr size_t OUT_X = 0, OUT_KV = 192 * MiB;
constexpr int CW_BAR = 4096;

constexpr int NWAVES = 8;
constexpr int RING_BYTES = 131072, LDSCTL_OFF = 143360, MISC_OFF = LDSCTL_OFF + 320, LDS_BYTES = 147456;

typedef GAS unsigned gu32;
#define RLX_AGENT __ATOMIC_RELAXED, __HIP_MEMORY_SCOPE_AGENT
#define LDS_WAIT() asm volatile("s_waitcnt lgkmcnt(0)" ::: "memory")

#define XB_TMO      128
#define XB_XCNT(j)  (256  + 64 * (j))
#define XB_XSUB(j)  (1280 + 64 * (j))
#define XB_XGEN(j)  (2304 + 64 * (j))
#define XB_TOP      3328
#define XB_TOPGEN   3392
#define XCD_BAR_WORDS 3456
#define XB_SPIN_CAP (1u << 18)
__device__ __forceinline__ unsigned xb_ld(unsigned* p)              { return __hip_atomic_load(p, __ATOMIC_RELAXED, __HIP_MEMORY_SCOPE_AGENT); }
__device__ __forceinline__ unsigned xb_add(unsigned* p, unsigned v) { return __hip_atomic_fetch_add(p, v, __ATOMIC_RELAXED, __HIP_MEMORY_SCOPE_AGENT); }
__device__ __forceinline__ unsigned xb_xcc_id() { return (unsigned)__builtin_amdgcn_s_getreg((3 << 11) | 20) & 0xFu; }
#define XB_SPIN(cond, bar) do { unsigned _sp = 0; while (cond) { __builtin_amdgcn_s_sleep(1); \
    if ((++_sp & 255u) == 0u) { if (xb_ld(&(bar)[XB_TMO])) break; if (_sp > XB_SPIN_CAP) { atomicAdd(&(bar)[XB_TMO], 1u); break; } } } } while (0)
struct XcdBarrier { unsigned* bar; unsigned x; volatile LAS unsigned* st; };
__device__ __forceinline__ XcdBarrier xcd_barrier_post(unsigned* bar, volatile LAS unsigned* st) {
    XcdBarrier b; b.bar = bar; b.x = xb_xcc_id(); b.st = st;
    if (threadIdx.x == 0) (void)xb_add(&bar[XB_XCNT(b.x)], 1u);
    return b;
}
__device__ __forceinline__ void xcd_barrier_complete(unsigned* bar, unsigned x, unsigned& nloc, unsigned& nx) {
    const unsigned G = gridDim.x * gridDim.y * gridDim.z;
    unsigned sum, cnt, mine, sp = 0u;
    for (;;) {
        sum = 0u; cnt = 0u; mine = 0u;
#pragma unroll
        for (unsigned j = 0; j < 16; ++j) { const unsigned c = xb_ld(&bar[XB_XCNT(j)]); sum += c; cnt += (c > 0u) ? 1u : 0u; mine = (j == x) ? c : mine; }
        if (sum == G) break;
        __builtin_amdgcn_s_sleep(1);
        if ((++sp & 255u) == 0u) { if (xb_ld(&bar[XB_TMO])) break; if (sp > XB_SPIN_CAP) { atomicAdd(&bar[XB_TMO], 1u); break; } }
    }
    nloc = mine > 0u ? mine : 1u; nx = cnt > 0u ? cnt : 1u;
}
__device__ __forceinline__ void xcd_barrier(const XcdBarrier& b) {
    asm volatile("s_waitcnt vmcnt(0)" ::: "memory");
    __syncthreads();
    if (threadIdx.x == 0) {
        unsigned* bar = b.bar;
        __builtin_amdgcn_s_waitcnt(0);
        unsigned nloc = b.st[0], nx = b.st[1];
        if (nloc == 0u) { xcd_barrier_complete(bar, b.x, nloc, nx); b.st[0] = nloc; b.st[1] = nx; }
        const unsigned old = xb_add(&bar[XB_XSUB(b.x)], 1u);
        const unsigned gen = old / nloc;
        if (old + 1u == (gen + 1u) * nloc) {
            __builtin_amdgcn_fence(__ATOMIC_RELEASE, "agent");
            asm volatile("s_waitcnt vmcnt(0)" ::: "memory");
            const unsigned og = xb_add(&bar[XB_TOP], 1u);
            const unsigned tg = og / nx;
            if (og + 1u == (tg + 1u) * nx) xb_add(&bar[XB_TOPGEN], 1u);
            else XB_SPIN(xb_ld(&bar[XB_TOPGEN]) == tg, bar);
            __builtin_amdgcn_fence(__ATOMIC_ACQUIRE, "agent");
            xb_add(&bar[XB_XGEN(b.x)], 1u);
            asm volatile("s_waitcnt vmcnt(0)" ::: "memory");
        } else {
            XB_SPIN(xb_ld(&bar[XB_XGEN(b.x)]) == gen, bar);
            __builtin_amdgcn_fence(__ATOMIC_ACQUIRE, "agent");
            asm volatile("s_waitcnt vmcnt(0)" ::: "memory");
        }
    }
    __syncthreads();
}

__device__ __forceinline__ float wave_sum(float v) {
#pragma unroll
    for (int o = 1; o < 64; o <<= 1) v += __shfl_xor(v, o);
    return v;
}
template <class RowMap>
__device__ __forceinline__ void transpose_item(const float* W, int K, int N, bf16* WT, const float* g1, const float* g2, int ksplit, RowMap rm, LAS float* scr, int item, int lane) {
    const int nblk = N / 64; int kb, nb;
    if ((nblk & 3) == 0) { const int w = item & 7, rest = item >> 3, q = nblk >> 2; nb = (rest % q) * 4 + (w & 3); kb = (rest / q) * 2 + (w >> 2); }
    else { kb = item / nblk; nb = item % nblk; }
    const int k0 = 64 * kb, n0 = 64 * nb;
    f32x2 wv[32];
    const GAS f32x2* wp = (const GAS f32x2*)((const GAS float*)W + (size_t)(k0 + (lane >> 5)) * N + n0) + (lane & 31);
#pragma unroll
    for (int i = 0; i < 32; ++i) wv[i] = *(const GAS f32x2*)((const GAS float*)wp + (size_t)(2 * i) * N);
    float gn[32];
#pragma unroll
    for (int i = 0; i < 32; ++i) { const int k = k0 + 2 * i + (lane >> 5); gn[i] = g1 ? (k < ksplit ? g1[k] : g2[k - ksplit]) : 1.0f; }
    const int c = lane & 7;
#pragma unroll
    for (int sub = 0; sub < 2; ++sub) {
#pragma unroll
        for (int i = 0; i < 32; ++i) { const int kk = 2 * i + (lane >> 5); scr[kk * 33 + (lane & 31)] = (sub ? wv[i].y : wv[i].x) * gn[i]; }
        LDS_WAIT(); asm volatile("" ::: "memory");
#pragma unroll
        for (int j = 0; j < 4; ++j) { const int nl = (lane >> 3) + 8 * j; const LAS float* s = scr + (8 * c) * 33 + nl;
            v4u o; o.x = pg8::cvt_pk_bf16(s[0 * 33], s[1 * 33]); o.y = pg8::cvt_pk_bf16(s[2 * 33], s[3 * 33]); o.z = pg8::cvt_pk_bf16(s[4 * 33], s[5 * 33]); o.w = pg8::cvt_pk_bf16(s[6 * 33], s[7 * 33]);
            *(GAS v4u*)(WT + (size_t)rm(n0 + 2 * nl + sub) * K + k0 + 8 * c) = o; }
        LDS_WAIT(); asm volatile("" ::: "memory");
    }
}
struct RmId  { __device__ __forceinline__ int operator()(int n) const { return n; } };
struct RmWin { __device__ __forceinline__ int operator()(int n) const { if (n < 2944) return n; if (n < 3456) return n + 128; const int i = n - 3456; return 3584 + (i < 32 ? 2 * i : 2 * (i - 32) + 1); } };
struct RmQ   { __device__ __forceinline__ int operator()(int n) const { const int r = n % 192, hb = n - r; if (r < 128) return n; const int i = r - 128; return hb + 128 + (i < 32 ? 2 * i : 2 * (i - 32) + 1); } };
struct RmKV  { __device__ __forceinline__ int operator()(int n) const { const int h = n >> 8, c = n & 255; return c < 128 ? h * 128 + c : 2048 + h * 128 + (c - 128); } };
struct RmUp  { __device__ __forceinline__ int operator()(int n) const { return (n >> 7) * 256 + (n & 127); } };
struct RmGate{ __device__ __forceinline__ int operator()(int n) const { return (n >> 7) * 256 + 128 + (n & 127); } };

__device__ __forceinline__ void sincos_d(double a, double& s, double& c) {
    const double kd = __builtin_rint(a * 0.63661977236758134308); const long k = (long)kd;
    double r = __builtin_fma(-kd, 1.57079632679489655800e+00, a); r = __builtin_fma(-kd, 6.12323399573676603587e-17, r);
    const double r2 = r * r;
    double sp = 1.0 / 6227020800.0; sp = sp * r2 - 1.0 / 39916800.0; sp = sp * r2 + 1.0 / 362880.0; sp = sp * r2 - 1.0 / 5040.0; sp = sp * r2 + 1.0 / 120.0; sp = sp * r2 - 1.0 / 6.0; sp = sp * r2 * r + r;
    double cp = 1.0 / 479001600.0; cp = cp * r2 - 1.0 / 3628800.0; cp = cp * r2 + 1.0 / 40320.0; cp = cp * r2 - 1.0 / 720.0; cp = cp * r2 + 1.0 / 24.0; cp = cp * r2 - 0.5; cp = cp * r2 + 1.0;
    const int q = (int)(k & 3);
    s = (q == 0) ? sp : (q == 1) ? cp : (q == 2) ? -sp : -cp;
    c = (q == 0) ? cp : (q == 1) ? -sp : (q == 2) ? -cp : sp;
}

__device__ __forceinline__ void ssm_weights_group(int g, const float* a_re, const float* a_im, const float* b_re, const float* b_im, const float* c_re, const float* c_im,
                                                  const float* log_dt, const float* dskip, bf16* W1t, bf16* W2t, LAS float* L, int tid) {
    LAS float* PW = L;
    LAS float* BB = PW + 2 * 17 * 64 * 2;
    LAS float* CC = BB + 2 * 64 * 16 * 2;
    LAS float* KT = CC + 2 * 16 * 64 * 2;
    for (int i = tid; i < 2 * 17 * 64; i += 512) { const int d = i / (17 * 64), e = (i / 64) % 17, p = i & 63;
        const double dt = exp((double)log_dt[d * 128 + g]); const double are = a_re[(d * 128 + g) * 64 + p], aim = a_im[(d * 128 + g) * 64 + p];
        const double mag = exp((double)e * dt * are); double s, c; sincos_d((double)e * dt * aim, s, c);
        PW[i * 2] = (float)(mag * c); PW[i * 2 + 1] = (float)(mag * s); }
    for (int i = tid; i < 2 * 64 * 16; i += 512) { const int d = i / 1024, p = (i >> 4) & 63, h = i & 15;
        const double dt = exp((double)log_dt[d * 128 + g]); const double are = a_re[(d * 128 + g) * 64 + p], aim = a_im[(d * 128 + g) * 64 + p];
        const double x = dt * are, y = dt * aim; double sy, cy, sh, ch; sincos_d(y, sy, cy); sincos_d(0.5 * y, sh, ch);
        const double em1 = expm1(x); const double re1 = em1 * cy - 2.0 * sh * sh, im1 = (em1 + 1.0) * sy;
        const double den = are * are + aim * aim; const double qre = (re1 * are + im1 * aim) / den, qim = (im1 * are - re1 * aim) / den;
        const size_t bi = ((size_t)((d * 128 + g) * 64 + p)) * 16 + h; const double br = b_re[bi], bim = b_im[bi];
        BB[i * 2] = (float)(qre * br - qim * bim); BB[i * 2 + 1] = (float)(qre * bim + qim * br); }
    for (int i = tid; i < 2 * 16 * 64; i += 512) { const int d = i / 1024, h = (i >> 6) & 15, p = i & 63; const size_t ci = ((size_t)((d * 128 + g) * 16 + h)) * 64 + p;
        CC[i * 2] = c_re[ci]; CC[i * 2 + 1] = c_im[ci]; }
    __syncthreads();
    { const int d = tid >> 8, e = (tid >> 4) & 15, h = tid & 15; float acc[16];
#pragma unroll
        for (int q = 0; q < 16; ++q) acc[q] = 0.f;
        for (int p = 0; p < 64; ++p) { const float cr = CC[((d * 16 + h) * 64 + p) * 2], ci = CC[((d * 16 + h) * 64 + p) * 2 + 1];
            const float pr = PW[((d * 17 + e) * 64 + p) * 2], pi = PW[((d * 17 + e) * 64 + p) * 2 + 1];
            const float tr = cr * pr - ci * pi, ti = cr * pi + ci * pr; const LAS f32x4* bp = (const LAS f32x4*)(BB + ((d * 64 + p) * 16) * 2);
#pragma unroll
            for (int q = 0; q < 8; ++q) { const f32x4 b = bp[q]; acc[2 * q] += tr * b[0] - ti * b[1]; acc[2 * q + 1] += tr * b[2] - ti * b[3]; } }
#pragma unroll
        for (int q = 0; q < 16; ++q) KT[((d * 16 + e) * 16 + h) * 16 + q] = acc[q]; }
    __syncthreads();
    for (int i = tid; i < 256 * 32; i += 512) { const int n = i >> 5, k0 = (i & 31) * 8; const int d = n >> 7, im = (n >> 6) & 1, p = n & 63; const int s = k0 >> 4, h0 = k0 & 15, e = d ? s : 15 - s;
        const float pr = PW[((d * 17 + e) * 64 + p) * 2], pi = PW[((d * 17 + e) * 64 + p) * 2 + 1]; float v[8];
#pragma unroll
        for (int j = 0; j < 8; ++j) { const float br = BB[((d * 64 + p) * 16 + h0 + j) * 2], bi = BB[((d * 64 + p) * 16 + h0 + j) * 2 + 1]; v[j] = im ? (pr * bi + pi * br) : (pr * br - pi * bi); }
        v4u o; o.x = pk2(v[0], v[1]); o.y = pk2(v[2], v[3]); o.z = pk2(v[4], v[5]); o.w = pk2(v[6], v[7]);
        *(GAS v4u*)(W1t + ((size_t)(g * 256 + n)) * 256 + k0) = o; }
    for (int i = tid; i < 256 * 64; i += 512) { const int n = i >> 6, k0 = (i & 63) * 8; const int j = n >> 4, h = n & 15; float v[8];
        if (k0 < 256) { const int d = k0 >> 7, im = (k0 >> 6) & 1, p0 = k0 & 63, e = d ? 16 - j : j + 1;
#pragma unroll
            for (int q = 0; q < 8; ++q) { const int p = p0 + q; const float cr = CC[((d * 16 + h) * 64 + p) * 2], ci = CC[((d * 16 + h) * 64 + p) * 2 + 1];
                const float pr = PW[((d * 17 + e) * 64 + p) * 2], pi = PW[((d * 17 + e) * 64 + p) * 2 + 1]; v[q] = im ? -(cr * pi + ci * pr) : (cr * pr - ci * pi); }
        } else { const int s = (k0 - 256) >> 4, h0 = (k0 - 256) & 15;
#pragma unroll
            for (int q = 0; q < 8; ++q) { const int hh = h0 + q; float val = 0.f;
                if (s <= j) val += KT[((0 * 16 + (j - s)) * 16 + h) * 16 + hh];
                if (s >= j) val += KT[((1 * 16 + (s - j)) * 16 + h) * 16 + hh];
                if (s == j && h == hh) val += dskip[g * 16 + h];
                v[q] = val; } }
        v4u o; o.x = pk2(v[0], v[1]); o.y = pk2(v[2], v[3]); o.z = pk2(v[4], v[5]); o.w = pk2(v[6], v[7]);
        *(GAS v4u*)(W2t + ((size_t)(g * 256 + n)) * 512 + k0) = o; }
    __syncthreads();
}
#ifndef PROBE_ATTN
#define PROBE_ATTN 1
#endif
#ifndef PROBE_P0
#define PROBE_P0 1
#endif
#ifndef PROBE_P1
#define PROBE_P1 1
#endif
#ifndef PROBE_P7
#define PROBE_P7 1
#endif
#ifndef PROBE_FA
#define PROBE_FA 1
#endif

struct Args { const float* in[27]; float* out; unsigned char* ws; int ph_lo, ph_hi; };

__global__ void __launch_bounds__(NWAVES * 64, 2) enc_fwd(Args args) {
    extern __shared__ __attribute__((aligned(16))) unsigned char lds[];
    LAS unsigned char* ldsb = (LAS unsigned char*)lds;
    volatile LAS unsigned* MISC = (volatile LAS unsigned*)(ldsb + MISC_OFF);
    const int wave0 = __builtin_amdgcn_readfirstlane(threadIdx.x >> 6);
    const int G = gridDim.x, bx = blockIdx.x; const int vcu = (G % 8 == 0) ? (bx % 8) * (G / 8) + bx / 8 : bx;
    const int NGW = G * NWAVES, NGT = G * NWAVES * 64;
    gu32* ctl = (gu32*)(args.ws + WS_CTL);
#define PHB unsigned char* wsl = args.ws; unsigned char* outl = (unsigned char*)args.out; asm volatile("" : "+s"(wsl), "+s"(outl)); \
    int tid = wave0 * 64 + (int)__builtin_amdgcn_mbcnt_hi(~0u, __builtin_amdgcn_mbcnt_lo(~0u, 0u)); asm volatile("" : "+v"(tid)); const int lane = tid & 63, wave = wave0; \
    const int gw = vcu * NWAVES + wave, gt = vcu * (NWAVES * 64) + tid; (void)lane; (void)gw; (void)gt; (void)wsl; (void)outl
#define x_p (args.in[0])
#define x_s (args.in[1])
#define rstd_x ((float*)(wsl + WS_RSTDX))
#define rstd_q ((float*)(wsl + WS_RSTDQ))
#define rstd_kv ((float*)(wsl + WS_RSTDKV))
#define r2v ((float*)(wsl + WS_R2))
#define ratio ((float*)(wsl + WS_RATIO))
#define rstd_x1 ((float*)(wsl + WS_RSTDX1))
#define stA ((float*)(wsl + WS_STA))
#define stB ((float*)(wsl + WS_STB))
#define stQ ((float*)(wsl + WS_STQ))
#define stKV ((float*)(wsl + WS_STKV))
#define ropetab ((float*)(wsl + WS_ROPE))
#define Wi ((bf16*)(wsl + WS_WIN))
#define Wglu ((bf16*)(wsl + WS_WGLU))
#define Wq ((bf16*)(wsl + WS_WQ))
#define Wkv ((bf16*)(wsl + WS_WKV))
#define Wout ((bf16*)(wsl + WS_WOUT))
#define Wug ((bf16*)(wsl + WS_WUG))
#define Wdn ((bf16*)(wsl + WS_WDN))
#define W1t ((bf16*)(wsl + WS_W1T))
#define W2t ((bf16*)(wsl + WS_W2T))
#define bufA ((bf16*)(wsl + WS_A))
#define bufB ((bf16*)(wsl + WS_B))
#define qlat ((bf16*)(wsl + WS_QLAT))
#define kvlat ((bf16*)(wsl + WS_KVLAT))
#define krope ((bf16*)(wsl + WS_KROPE))
#define gact ((bf16*)(wsl + WS_GACT))
#define hup ((bf16*)(wsl + WS_HUP))
#define hgate ((bf16*)(wsl + WS_HGATE))
#define X ((bf16*)(outl + OUT_X))
#define kvb ((bf16*)(outl + OUT_KV))
#define vtb ((bf16*)(outl + OUT_KV) + (size_t)T * 2048)
#define xoutf ((float*)outl)
    for (int u = threadIdx.x; u < (LDS_BYTES - LDSCTL_OFF) / 4; u += NWAVES * 64) ((LAS unsigned*)(ldsb + LDSCTL_OFF))[u] = 0u;
    __syncthreads();
    XcdBarrier bar = xcd_barrier_post((unsigned*)(ctl + CW_BAR), MISC + 8);
    const int lo = args.ph_lo, hi = args.ph_hi;
#ifndef PHMASK
#define PHMASK 0xfffffffu
#endif
#define IN(k) (((PHMASK >> ((k) < 9 ? (k) : ((k) >= 18 ? 12 : 9 + ((k) - 9) % 3))) & 1u) && lo <= (k) && (k) < hi)
#define SEAM(k) do { if (IN(k) && IN((k) + 1)) xcd_barrier(bar); } while (0)

#pragma unroll 1
    for (int rep = 0; rep < PROBE_P0; ++rep)
    if (IN(0)) {
        PHB;
        if (rep) __syncthreads();
        if (vcu < 128) ssm_weights_group(vcu, args.in[4], args.in[5], args.in[6], args.in[7], args.in[8], args.in[9], args.in[10], args.in[11], W1t, W2t, (LAS float*)ldsb, tid);
        LAS float* scr = (LAS float*)(ldsb + wave * 16384);
        constexpr int I_IN = 64 * 55, I_GLU = 32 * 32, I_Q = 14 * 48, I_KV = 8 * 64, I_OUT = 64 * 64, I_UP = 64 * 172, I_DN = 172 * 64;
        constexpr int NITEMS = I_IN + I_GLU + I_Q + I_KV + I_OUT + 2 * I_UP + I_DN;
#ifndef PROBE_TR
#define PROBE_TR 1
#endif
#ifndef PROBE_X
#define PROBE_X 1
#endif
        for (int it2 = gw; it2 < PROBE_TR * NITEMS; it2 += NGW) { const int it = it2 % NITEMS;
            int r = it;
            if (r < I_IN) { transpose_item(args.in[2], 4096, 3520, Wi, args.in[3], args.in[3], 4096, RmWin(), scr, r, lane); continue; } r -= I_IN;
            if (r < I_GLU) { transpose_item(args.in[12], 2048, 2048, Wglu, nullptr, nullptr, 0, RmId(), scr, r, lane); continue; } r -= I_GLU;
            if (r < I_Q) { transpose_item(args.in[14], 896, 3072, Wq, args.in[13], args.in[13], 896, RmQ(), scr, r, lane); continue; } r -= I_Q;
            if (r < I_KV) { transpose_item(args.in[16], 512, 4096, Wkv, args.in[15], args.in[15], 512, RmKV(), scr, r, lane); continue; } r -= I_KV;
            if (r < I_OUT) { transpose_item(args.in[19], 4096, 4096, Wout, args.in[17], args.in[18], 2048, RmId(), scr, r, lane); continue; } r -= I_OUT;
            if (r < I_UP) { transpose_item(args.in[21], 4096, 11008, Wug, args.in[20], args.in[20], 4096, RmUp(), scr, r, lane); continue; } r -= I_UP;
            if (r < I_UP) { transpose_item(args.in[22], 4096, 11008, Wug, args.in[20], args.in[20], 4096, RmGate(), scr, r, lane); continue; } r -= I_UP;
            transpose_item(args.in[25], 11008, 4096, Wdn, nullptr, nullptr, 0, RmId(), scr, r, lane);
        }
        for (int i = gt; i < 320 * 512; i += NGT) { const int rr = i >> 9, c8 = (i & 511) * 8; const int row = rr < 128 ? 2944 + rr : 3648 + (rr - 128);
            *(GAS v4u*)(Wi + (size_t)row * 4096 + c8) = (v4u){0u, 0u, 0u, 0u}; }
        for (int m2 = gw; m2 < PROBE_X * T; m2 += NGW) { const int m = m2 % T; const float* xr = m < 16384 ? x_p + (size_t)m * DM : x_s + (size_t)(m - 16384) * DM;
            f32x4 v[16]; float s = 0.f;
#pragma unroll
            for (int j = 0; j < 16; ++j) { v[j] = *((const GAS f32x4*)xr + lane + 64 * j); s += (v[j].x * v[j].x + v[j].y * v[j].y) + (v[j].z * v[j].z + v[j].w * v[j].w); }
            s = wave_sum(s); if (lane == 0) rstd_x[m] = 1.0f / sqrtf(s * (1.0f / DM) + EPS);
            GAS v2u* o8 = (GAS v2u*)(bufA + (size_t)m * DM) + lane;
#pragma unroll
            for (int j = 0; j < 16; ++j) o8[64 * j] = (v2u){pg8::cvt_pk_bf16(v[j].x, v[j].y), pg8::cvt_pk_bf16(v[j].z, v[j].w)}; }
        for (int i = gt; i < 8192 * 32; i += NGT) { const int pos = i >> 5, k = i & 31; const double inv = exp(-(double)k * (9.210340371976184 / 32.0));
            double s, c; sincos_d((double)pos * inv, s, c); *(GAS f32x2*)(ropetab + (size_t)i * 2) = (f32x2){(float)c, (float)s}; }
    }
    SEAM(0);

#pragma unroll 1
    for (int rep = 0; rep < PROBE_P1; ++rep)
    if (IN(1)) {
        PHB;
        pg8::Gemm g{bufA, Wi, DM, DM, DM}; pg8::StaticOrder S; S.init(T, 3840, G, bx);
        pg8::EpiWin E{rstd_x, X, qlat, kvlat, krope, stQ, stKV, ropetab};
        pg8::gemm_phase(ldsb, g, S, E, tid);
    }
    SEAM(1);

    if (IN(2)) {
        PHB;
        pg8::Gemm g{X + 256, W1t, 512, 256, 256}; pg8::GroupOrder S{768, 6, G, bx};
        pg8::EpiSsm1 E{X};
        pg8::gemm_phase(ldsb, g, S, E, tid);
        for (int r = gt; r < T; r += NGT) { float s = 0.f;
#pragma unroll
            for (int j = 0; j < 4; ++j) { const f32x4 v = *(const GAS f32x4*)(stQ + (size_t)r * 16 + 4 * j); s += (v.x + v.y) + (v.z + v.w); }
            rstd_q[r] = 1.0f / sqrtf(s * (1.0f / QLAT) + EPS); float s2 = 0.f;
#pragma unroll
            for (int j = 0; j < 2; ++j) { const f32x4 v = *(const GAS f32x4*)(stKV + (size_t)r * 8 + 4 * j); s2 += (v.x + v.y) + (v.z + v.w); }
            rstd_kv[r] = 1.0f / sqrtf(s2 * (1.0f / KVLAT) + EPS); }
    }
    SEAM(2);

    if (IN(3)) {
        PHB;
        const bool scan_cu = (G == 256) ? ((vcu & 1) == 0) : true;
        if (G == 256 ? scan_cu : (wave < 4)) { const int task = (G == 256) ? (vcu >> 1) * 8 + wave : vcu * 4 + wave;
            if (task < 1024) { const int seq = task >> 8, g = (task >> 1) & 127, dir = task & 1, p = lane;
                const int c0 = seq < 2 ? seq * 512 : 1024 + (seq - 2) * 256, nc = seq < 2 ? 512 : 256;
                const double dt = exp((double)args.in[10][dir * 128 + g]); const double are = args.in[4][(dir * 128 + g) * 64 + p], aim = args.in[5][(dir * 128 + g) * 64 + p];
                const double mag = exp(16.0 * dt * are); double sn, cs; sincos_d(16.0 * dt * aim, sn, cs);
                const float ar = (float)(mag * cs), ai = (float)(mag * sn);
                GAS bf16* Xg = (GAS bf16*)X + (size_t)g * NCHUNK * 512 + dir * 128 + p;
                float zr = 0.f, zi = 0.f;
                for (int cb = 0; cb < nc; cb += 16) {
                    unsigned short sre[16], sim[16];
#pragma unroll
                    for (int i = 0; i < 16; ++i) { const int c = dir ? (c0 + nc - 1 - (cb + i)) : (c0 + cb + i); sre[i] = Xg[(size_t)c * 512]; sim[i] = Xg[(size_t)c * 512 + 64]; }
#pragma unroll
                    for (int i = 0; i < 16; ++i) { const int c = dir ? (c0 + nc - 1 - (cb + i)) : (c0 + cb + i);
                        Xg[(size_t)c * 512] = (bf16)f2bf(zr); Xg[(size_t)c * 512 + 64] = (bf16)f2bf(zi);
                        const float sr = bf2f(sre[i]), si = bf2f(sim[i]); const float nr = ar * zr - ai * zi + sr, ni = ar * zi + ai * zr + si; zr = nr; zi = ni; }
                }
            }
        }
        __syncthreads();
        if (G == 256) { pg8::Gemm g{qlat, Wq, QLAT, QLAT, QLAT}; pg8::RangeOrder S{scan_cu ? (vcu >> 1) * 3 : 384 + (vcu >> 1) * 6, scan_cu ? 3 : 6, 12}; pg8::EpiQ E{rstd_q, bufA, ropetab}; pg8::gemm_phase(ldsb, g, S, E, tid); }
        else { pg8::Gemm g{qlat, Wq, QLAT, QLAT, QLAT}; pg8::StaticOrder S; S.init(T, QW, G, bx); pg8::EpiQ E{rstd_q, bufA, ropetab}; pg8::gemm_phase(ldsb, g, S, E, tid); }
        { pg8::Gemm g{kvlat, Wkv, KVLAT, KVLAT, KVLAT}; pg8::StaticOrder S; S.init(T, 2048, G, bx); pg8::EpiKV E{rstd_kv, kvb}; pg8::gemm_phase(ldsb, g, S, E, tid); }
        { pg8::Gemm g{Wkv + (size_t)2048 * KVLAT, kvlat, KVLAT, KVLAT, KVLAT}; pg8::StaticOrder S; S.init(2048, T, G, bx); pg8::EpiVT E{rstd_kv, vtb}; pg8::gemm_phase(ldsb, g, S, E, tid); }
    }
    SEAM(3);

    if (IN(4)) {
        PHB;
        pg8::Gemm g{X, W2t, 512, 512, 512}; pg8::GroupOrder S{768, 6, G, bx};
        pg8::EpiSsm2 E{gact};
        pg8::gemm_phase(ldsb, g, S, E, tid);
    }
    SEAM(4);

    if (IN(5)) {
        PHB;
#ifndef NO_GLU
        { pg8::Gemm g{gact, Wglu, MIXW, MIXW, MIXW}; pg8::StaticOrder S; S.init(T, MIXW, G, bx); pg8::EpiGlu E{gact, bufB, stA}; pg8::gemm_phase(ldsb, g, S, E, tid); }
#endif
#ifndef NO_ATTN
        const int xcd = vcu >> 5, cc = vcu & 31; const int nun = (G == 256) ? 6 : (1536 - bx + G - 1) / G;
#pragma unroll 1
        for (int i = 0; i < nun; ++i) {
            int bh, qb, seq, rowbase;
            if (G == 256) { if (i < 4) { bh = xcd * 4 + i; qb = cc; seq = 8192; } else { bh = xcd * 4 + 2 * (i - 4) + (cc >> 4); qb = cc & 15; seq = 4096; } }
            else { const int uidx = bx + i * G; if (uidx < 1024) { bh = uidx >> 5; qb = uidx & 31; seq = 8192; } else { const int v = uidx - 1024; bh = v >> 4; qb = v & 15; seq = 4096; } }
            const int b = bh >> 4, h = bh & 15; rowbase = (seq == 8192) ? b * 8192 : 16384 + b * 4096;
            __syncthreads();
            attn::attn_unit(bufA + (size_t)(rowbase + qb * 256) * QW + h * 192, kvb + (size_t)rowbase * 2048 + h * 128, vtb + (size_t)(h * 128) * T,
                            krope + (size_t)rowbase * 64, bufB + (size_t)(rowbase + qb * 256) * DM + 2048 + h * 128, stB + (size_t)(rowbase + qb * 256) * 16 + h, seq, rowbase, (char*)lds, wave0);
        }
#endif
    }
    SEAM(5);

    if (IN(6)) {
        PHB;
        for (int r = gt; r < T; r += NGT) { float s = 0.f;
#pragma unroll
            for (int j = 0; j < 8; ++j) { const f32x4 v = *(const GAS f32x4*)(stA + (size_t)r * 32 + 4 * j); s += (v.x + v.y) + (v.z + v.w); }
            const float r1 = 1.0f / sqrtf(s * (1.0f / MIXW) + EPS); float s2 = 0.f;
#pragma unroll
            for (int j = 0; j < 4; ++j) { const f32x4 v = *(const GAS f32x4*)(stB + (size_t)r * 16 + 4 * j); s2 += (v.x + v.y) + (v.z + v.w); }
            const float r2 = 1.0f / sqrtf(s2 * (1.0f / MIXW) + EPS); r2v[r] = r2; ratio[r] = r1 / r2; }
    }
    SEAM(6);

#pragma unroll 1
    for (int rep = 0; rep < PROBE_P7; ++rep)
    if (IN(7)) {
        PHB;
        pg8::Gemm g{bufB, Wout, DM, DM, DM}; pg8::StaticOrder S; S.init(T, DM, G, bx);
        pg8::EpiWout E{x_p, x_s, r2v, ratio, bufA, stA};
        pg8::gemm_phase(ldsb, g, S, E, tid);
    }
    SEAM(7);

    if (IN(8)) {
        PHB;
        for (int r = gt; r < T; r += NGT) { float s = 0.f;
#pragma unroll
            for (int j = 0; j < 16; ++j) { const f32x4 v = *(const GAS f32x4*)(stA + (size_t)r * 64 + 4 * j); s += (v.x + v.y) + (v.z + v.w); }
            rstd_x1[r] = 1.0f / sqrtf(s * (1.0f / DM) + EPS); }
    }
    SEAM(8);

#ifdef PROBE_DOWN
    if (IN(9)) { PHB;
#pragma unroll 1
        for (int ch = 0; ch < 3; ++ch) { pg8::Gemm g{bufB, Wdn, DFF, DFF, DFF}; pg8::StaticOrder S; S.init(8192, DM, G, bx); pg8::EpiNull E0; pg8::gemm_phase(ldsb, g, S, E0, tid); }
    }
#endif
#ifdef PROBE_KLOOP
    if (IN(9)) {
        PHB;
#pragma unroll 1
        for (int ch = 0; ch < 3; ++ch) { pg8::Gemm g{bufA + (size_t)(ch * 8192) * DM, Wug, DM, DM, DM}; pg8::StaticOrder S; S.init(8192, 2 * DFF, G, bx); pg8::EpiNull E0; pg8::gemm_phase(ldsb, g, S, E0, tid); }
    }
#endif
#pragma unroll 1
    for (int ch2 = 0; ch2 < 3 * PROBE_FA; ++ch2) {
        const int ch = ch2 / PROBE_FA; const bool lastrep = (ch2 % PROBE_FA) == PROBE_FA - 1;
        const int rb = ch * 8192;
        if (IN(9 + 3 * ch)) {
        PHB;
            pg8::Gemm g{bufA + (size_t)rb * DM, Wug, DM, DM, DM}; pg8::StaticOrder S; S.init(8192, 2 * DFF, G, bx);
            pg8::EpiFfnA E{rstd_x1, rb, bufB, hup, hgate, args.in[23], args.in[24]};
            pg8::gemm_phase(ldsb, g, S, E, tid);
        }
        SEAM(9 + 3 * ch);
        if (lastrep && IN(10 + 3 * ch)) {
        PHB;
            const float* cw = args.in[23]; const float* cb = args.in[24];
            for (int i = gt; i < 128 * 2 * (DFF / 8); i += NGT) { const int f0 = (i % (DFF / 8)) * 8, sw = i / (DFF / 8), strip = sw >> 1, which = sw & 1;
                const int lrow = strip * 64 + (which ? 63 : 0), grow = rb + lrow, pos = pos_of(grow), len = len_of(grow);
                v4u up0, up1, up2;
                if (which == 0) { up1 = *(const GAS v4u*)(hup + ((size_t)strip * 4 + 0) * DFF + f0); up2 = *(const GAS v4u*)(hup + ((size_t)strip * 4 + 1) * DFF + f0);
                    up0 = (pos == 0) ? (v4u){0u, 0u, 0u, 0u} : *(const GAS v4u*)(hup + ((size_t)(strip - 1) * 4 + 3) * DFF + f0); }
                else { up0 = *(const GAS v4u*)(hup + ((size_t)strip * 4 + 2) * DFF + f0); up1 = *(const GAS v4u*)(hup + ((size_t)strip * 4 + 3) * DFF + f0);
                    up2 = (pos == len - 1) ? (v4u){0u, 0u, 0u, 0u} : *(const GAS v4u*)(hup + ((size_t)(strip + 1) * 4 + 0) * DFF + f0); }
                const v4u gt4 = *(const GAS v4u*)(hgate + ((size_t)strip * 2 + which) * DFF + f0);
                unsigned ow[4];
#pragma unroll
                for (int k = 0; k < 4; ++k) { const int f = f0 + 2 * k;
                    const float a0 = bflo(up0[k]), a1 = bflo(up1[k]), a2 = bflo(up2[k]), b0 = bfhi(up0[k]), b1 = bfhi(up1[k]), b2 = bfhi(up2[k]);
                    const float c0 = cw[f] * a0 + cw[DFF + f] * a1 + cw[2 * DFF + f] * a2 + cb[f], c1 = cw[f + 1] * b0 + cw[DFF + f + 1] * b1 + cw[2 * DFF + f + 1] * b2 + cb[f + 1];
                    ow[k] = pk2(c0 * sigmoidf_fast(c0) * bflo(gt4[k]), c1 * sigmoidf_fast(c1) * bfhi(gt4[k])); }
                *(GAS v4u*)(bufB + (size_t)lrow * DFF + f0) = (v4u){ow[0], ow[1], ow[2], ow[3]}; }
        }
        if (lastrep) SEAM(10 + 3 * ch);
        if (lastrep && IN(11 + 3 * ch)) {
        PHB;
            pg8::Gemm g{bufB, Wdn, DFF, DFF, DFF}; pg8::StaticOrder S; S.init(8192, DM, G, bx);
            pg8::EpiDown E{bufA, rb, stA};
            pg8::gemm_phase(ldsb, g, S, E, tid);
        }
        if (lastrep) SEAM(11 + 3 * ch);
    }

    if (IN(18)) {
        PHB;
        const float* gf = args.in[26];
        for (int m = gw; m < T; m += NGW) { const float s = wave_sum(stA[(size_t)m * 64 + lane]); const float rs = 1.0f / sqrtf(s * (1.0f / DM) + EPS);
            const GAS v4u* xr = (const GAS v4u*)(bufA + (size_t)m * DM) + lane; GAS f32x4* orow = (GAS f32x4*)(xoutf + (size_t)m * DM) + 2 * lane; const GAS f32x4* gr = (const GAS f32x4*)gf + 2 * lane;
#pragma unroll
            for (int j = 0; j < 8; ++j) { const v4u w = xr[64 * j]; const f32x4 g0 = gr[128 * j], g1 = gr[128 * j + 1];
                orow[128 * j] = (f32x4){bflo(w.x) * rs * g0[0], bfhi(w.x) * rs * g0[1], bflo(w.y) * rs * g0[2], bfhi(w.y) * rs * g0[3]};
                orow[128 * j + 1] = (f32x4){bflo(w.z) * rs * g1[0], bfhi(w.z) * rs * g1[1], bflo(w.w) * rs * g1[2], bfhi(w.w) * rs * g1[3]}; } }
    }
#undef IN
#undef SEAM
}

constexpr int N_PHASES = 19;
extern "C" void kernel_launch(void* const* d_in, const int* in_sizes, int n_in, void* d_out, int out_size, void* d_ws, size_t ws_size, hipStream_t stream) {
    static int grid = 0;
    if (grid == 0) {
        if (n_in != 27 || out_size != T * DM || ws_size < WS_END) { fprintf(stderr, "kernel_launch: unexpected shapes (n_in %d out %d ws %zu)\n", n_in, out_size, ws_size); grid = -1; return; }
        int dev = 0, cus = 0, per_cu = 0;
        if (hipGetDevice(&dev) != hipSuccess || hipDeviceGetAttribute(&cus, hipDeviceAttributeMultiprocessorCount, dev) != hipSuccess) { grid = -1; return; }
        if (hipFuncSetAttribute((const void*)enc_fwd, hipFuncAttributeMaxDynamicSharedMemorySize, LDS_BYTES) != hipSuccess) { fprintf(stderr, "kernel_launch: hipFuncSetAttribute failed\n"); grid = -1; return; }
        if (hipOccupancyMaxActiveBlocksPerMultiprocessor(&per_cu, (const void*)enc_fwd, NWAVES * 64, LDS_BYTES) != hipSuccess || per_cu < 1) { fprintf(stderr, "kernel_launch: occupancy query says %d\n", per_cu); }
        (void)hipGetLastError();
        grid = cus;
    }
    if (grid < 0) return;
    if (hipMemsetAsync((char*)d_ws + WS_CTL, 0, CTL_ZERO_BYTES, stream) != hipSuccess) return;
    Args a{};
    for (int i = 0; i < 27; ++i) a.in[i] = (const float*)d_in[i];
    a.out = (float*)d_out; a.ws = (unsigned char*)d_ws;
#ifndef MK_N_LAUNCHES
#define MK_N_LAUNCHES 1
#endif
    if (MK_N_LAUNCHES == 1) { a.ph_lo = 0; a.ph_hi = N_PHASES; hipLaunchKernelGGL(enc_fwd, dim3(grid), dim3(NWAVES * 64), LDS_BYTES, stream, a); }
    else { for (int p = 0; p < N_PHASES; ++p) { a.ph_lo = p; a.ph_hi = p + 1; hipLaunchKernelGGL(enc_fwd, dim3(grid), dim3(NWAVES * 64), LDS_BYTES, stream, a); } }
    const hipError_t le = hipPeekAtLastError();
    if (le != hipSuccess) fprintf(stderr, "kernel_launch: launch failed: %s\n", hipGetErrorName(le));
}
```

```cpp
#include <hip/hip_runtime.h>
#include <hip/hip_bf16.h>
#include <cstdio>
#include <cstdint>

namespace pg8 {
#define PG8_LAS __attribute__((address_space(3)))
typedef unsigned short bf16_t;
typedef short bf16x8 __attribute__((ext_vector_type(8)));
typedef float f32x4 __attribute__((ext_vector_type(4)));
typedef float f32x2 __attribute__((ext_vector_type(2)));
typedef unsigned u32x4 __attribute__((ext_vector_type(4)));
typedef unsigned u32x2 __attribute__((ext_vector_type(2)));
constexpr int BM = 256, BK = 64, HALF = 128, HTB = HALF * BK * 2  , STAGE_BYTES = 8 * HTB, NXCD = 8, WGM = 8;

__host__ __device__ __forceinline__ int lds_byte(int r, int c) { const int st = (r >> 4) * 2 + (c >> 5), rr = r & 15, cc = c & 31, ob = rr * 64 + cc * 2; return st * 1024 + (ob ^ (((ob >> 9) & 1) << 5)); }
__host__ __device__ __forceinline__ void stage_rc(int b, int& R, int& C) { const int st = b / 1024, sb = b % 1024, swz = sb ^ (((sb >> 9) & 1) << 5); R = (st >> 1) * 16 + swz / 64; C = (st & 1) * 32 + (swz % 64) / 2; }
__host__ __device__ __forceinline__ int perm32(int rho) { const int n = rho >> 4, i = rho & 15; return 8 * (i >> 2) + 4 * n + (i & 3); }

struct Unit { int pm, pn; };
struct Gemm { const bf16_t* A; const bf16_t* Bt; int lda, ldb, K; };

struct StaticOrder {
    int nM, nN, nwg, G, c;
    __host__ __device__ void init(int M, int N, int G_, int c_) { nM = M / BM; nN = N / BM; nwg = nM * nN; G = G_; c = c_; }
    __host__ __device__ bool next(int i, Unit& u) const {
        const long L = (long)i * G + c; if (L >= nwg) return false;
        int wgid = (int)L; { const int q = nwg / NXCD, r = nwg % NXCD, xcd = wgid % NXCD, off = wgid / NXCD; wgid = (xcd < r ? xcd * (q + 1) : r * (q + 1) + (xcd - r) * q) + off; }
        const int nig = WGM * nN, gid = wgid / nig, fm = gid * WGM, gsz = (nM - fm) < WGM ? (nM - fm) : WGM;
        u.pm = fm + ((wgid % nig) % gsz); u.pn = (wgid % nig) / gsz; return true;
    }
};
struct ZeroOrder { int n, G, c; __host__ __device__ bool next(int i, Unit& u) const { const long L = (long)i * G + c; if (L >= n) return false; u.pm = 0; u.pn = 0; return true; } };
struct RangeOrder { int base, n, nN; __host__ __device__ bool next(int i, Unit& u) const { if (i >= n) return false; const int L = base + i; u.pm = L / nN; u.pn = L % nN; return true; } };
struct GroupOrder {
    int n, per, G, c;
    __host__ __device__ bool next(int i, Unit& u) const { const long L = (long)i * G + c; if (L >= n) return false; u.pm = (int)L; u.pn = (int)L / per; return true; }
};

__device__ __forceinline__ unsigned cvt_pk_bf16(float lo, float hi) { unsigned r; asm volatile("v_cvt_pk_bf16_f32 %0, %1, %2" : "=v"(r) : "v"(lo), "v"(hi)); return r; }
__device__ __forceinline__ u32x4 pack8(const f32x4 a, const f32x4 b) { u32x4 w; w.x = cvt_pk_bf16(a[0], a[1]); w.y = cvt_pk_bf16(a[2], a[3]); w.z = cvt_pk_bf16(b[0], b[1]); w.w = cvt_pk_bf16(b[2], b[3]); return w; }

template <class Epi, class Sched>
__device__ __forceinline__ void gemm_phase(PG8_LAS unsigned char* lds, const Gemm g, const Sched& S, const Epi& E, int tid_in) {
    int tid_l = tid_in; asm volatile("" : "+v"(tid_l));
    const int tid = tid_l, wid = __builtin_amdgcn_readfirstlane(tid >> 6), lane = tid & 63, wr = wid >> 2, wc = wid & 3, fr = lane & 15, fq = lane >> 4;
    const int K = g.K, nt = K / BK;
    unsigned voffA[2], voffB[2];
#pragma unroll
    for (int i = 0; i < 2; ++i) { int R, C; stage_rc(tid * 16 + i * 8192, R, C); const int Rb = Epi::PERM ? ((R & ~31) + perm32(R & 31)) : R;
        voffA[i] = (unsigned)(R * g.lda + C) * 2u; voffB[i] = (unsigned)(Rb * g.ldb + C) * 2u; }
    asm volatile("" : "+v"(voffA[0]), "+v"(voffA[1]), "+v"(voffB[0]), "+v"(voffB[1]));
    const size_t kstep = (size_t)(BK * 2);
    const size_t hstepA = (size_t)HALF * g.lda * 2, hstepB = (size_t)HALF * g.ldb * 2;
    const size_t tstepA = 2 * hstepA, tstepB = 2 * hstepB;
    const unsigned ldsw = (unsigned)wid * 1024u;
    const int aoff = lds_byte(wr * 64 + fr, fq * 8), boff = lds_byte(wc * 32 + fr, fq * 8);
#define PG8_SA(b, h) (((b) * 2 + (h)) * HTB)
#define PG8_SB(b, h) ((4 + (b) * 2 + (h)) * HTB)
#define PG8_STAGE(bufoff, gbase, voff) do { _Pragma("unroll") for (int _i = 0; _i < 2; ++_i) \
        __builtin_amdgcn_global_load_lds((const unsigned*)((const char*)(gbase) + (voff)[_i]), (PG8_LAS unsigned*)(lds + (bufoff) + ldsw + _i * 8192), 16, 0, 0); } while (0)
#define PG8_LDA(dst, b, h) do { _Pragma("unroll") for (int m = 0; m < 4; ++m) _Pragma("unroll") for (int k = 0; k < 2; ++k) dst[m][k] = *(const PG8_LAS bf16x8*)(lds + PG8_SA(b, h) + aoff + m * 2048 + k * 1024); } while (0)
#define PG8_LDB(dst, b, h) do { _Pragma("unroll") for (int n = 0; n < 2; ++n) _Pragma("unroll") for (int k = 0; k < 2; ++k) dst[n][k] = *(const PG8_LAS bf16x8*)(lds + PG8_SB(b, h) + boff + n * 2048 + k * 1024); } while (0)
#define PG8_MMA(ai, bj, At, Bt) do { __builtin_amdgcn_s_setprio(1); _Pragma("unroll") for (int m = 0; m < 4; ++m) _Pragma("unroll") for (int n = 0; n < 2; ++n) _Pragma("unroll") for (int k = 0; k < 2; ++k) \
        acc[ai][bj][m][n] = __builtin_amdgcn_mfma_f32_16x16x32_bf16(Bt[n][k], At[m][k], acc[ai][bj][m][n], 0, 0, 0); __builtin_amdgcn_s_setprio(0); } while (0)
#define PG8_WAIT_V(n) asm volatile("s_waitcnt vmcnt(" #n ")" ::: "memory")
#define PG8_WAIT_L(n) asm volatile("s_waitcnt lgkmcnt(" #n ")" ::: "memory")
#define PG8_BAR __builtin_amdgcn_s_barrier()
#define PG8_SCHED __builtin_amdgcn_sched_barrier(0)
    Unit cur, nxt; int ui = 0;
    if (!S.next(0, cur)) return;
    f32x4 acc[2][2][4][2];
#pragma unroll
    for (int a = 0; a < 2; ++a)
#pragma unroll
        for (int b = 0; b < 2; ++b)
#pragma unroll
            for (int m = 0; m < 4; ++m)
#pragma unroll
                for (int n = 0; n < 2; ++n) acc[a][b][m][n] = (f32x4){0.f, 0.f, 0.f, 0.f};
    bf16x8 At[4][2], B0[2][2], B1[2][2];
    const char* cA = (const char*)g.A + (size_t)cur.pm * tstepA; const char* cB = (const char*)g.Bt + (size_t)cur.pn * tstepB;
    PG8_STAGE(PG8_SB(0, 0), cB, voffB); PG8_STAGE(PG8_SB(0, 1), cB + hstepB, voffB); PG8_STAGE(PG8_SA(0, 0), cA, voffA); PG8_STAGE(PG8_SA(0, 1), cA + hstepA, voffA);
    if (wr == 1) PG8_BAR;
    PG8_WAIT_V(2); PG8_BAR;
    PG8_STAGE(PG8_SB(1, 0), cB + kstep, voffB); PG8_STAGE(PG8_SA(1, 0), cA + kstep, voffA); PG8_STAGE(PG8_SB(1, 1), cB + hstepB + kstep, voffB);
    PG8_WAIT_V(6); PG8_BAR;
    for (;;) {
        const bool has_next = S.next(ui + 1, nxt);
        const char* nA = has_next ? (const char*)g.A + (size_t)nxt.pm * tstepA : cA; const char* nB = has_next ? (const char*)g.Bt + (size_t)nxt.pn * tstepB : cB;
#pragma unroll 1
        for (int t = 0; t < nt; t += 2) {
            const bool last = (t == nt - 2);
            if constexpr (Epi::MIDK) { if (t == (nt >> 1)) E.midk(acc, cur, wr, fr); }
            const char* a1 = cA + (size_t)(t + 1) * kstep;
            const char* a2 = last ? nA : cA + (size_t)(t + 2) * kstep; const char* b2 = last ? nB : cB + (size_t)(t + 2) * kstep;
            const char* a3 = a2 + kstep; const char* b3 = b2 + kstep;
            PG8_LDB(B0, 0, 0); PG8_LDB(B1, 0, 1); PG8_SCHED; PG8_LDA(At, 0, 0); PG8_STAGE(PG8_SA(1, 1), a1 + hstepA, voffA);
            PG8_WAIT_V(8); PG8_WAIT_L(0); PG8_BAR; PG8_MMA(0, 0, At, B0); PG8_MMA(0, 1, At, B1); PG8_BAR; PG8_SCHED;
            PG8_LDA(At, 0, 1); PG8_STAGE(PG8_SB(0, 0), b2, voffB); PG8_STAGE(PG8_SB(0, 1), b2 + hstepB, voffB); PG8_STAGE(PG8_SA(0, 0), a2, voffA);
            PG8_WAIT_V(8); PG8_WAIT_L(0); PG8_BAR; PG8_MMA(1, 0, At, B0); PG8_MMA(1, 1, At, B1); PG8_BAR; PG8_SCHED;
            PG8_LDB(B0, 1, 0); PG8_LDB(B1, 1, 1); PG8_SCHED; PG8_LDA(At, 1, 0); PG8_STAGE(PG8_SA(0, 1), a2 + hstepA, voffA);
            PG8_WAIT_V(8); PG8_WAIT_L(0); PG8_BAR; PG8_MMA(0, 0, At, B0); PG8_MMA(0, 1, At, B1); PG8_BAR; PG8_SCHED;
            PG8_LDA(At, 1, 1); PG8_STAGE(PG8_SB(1, 0), b3, voffB); PG8_STAGE(PG8_SB(1, 1), b3 + hstepB, voffB); PG8_STAGE(PG8_SA(1, 0), a3, voffA);
            PG8_WAIT_V(8); PG8_WAIT_L(0); PG8_BAR; PG8_MMA(1, 0, At, B0); PG8_MMA(1, 1, At, B1); PG8_BAR; PG8_SCHED;
        }
        if (wr == 0) PG8_BAR;
        E(acc, cur, wr, wc, fr, fq);
        if (!has_next) break;
#pragma unroll
        for (int a = 0; a < 2; ++a)
#pragma unroll
            for (int b = 0; b < 2; ++b)
#pragma unroll
                for (int m = 0; m < 4; ++m)
#pragma unroll
                    for (int n = 0; n < 2; ++n) acc[a][b][m][n] = (f32x4){0.f, 0.f, 0.f, 0.f};
        cur = nxt; cA = nA; cB = nB; ++ui;
        if (wr == 1) PG8_BAR;
    }
    PG8_WAIT_V(0);
    PG8_BAR;
#undef PG8_SA
#undef PG8_SB
#undef PG8_STAGE
#undef PG8_LDA
#undef PG8_LDB
#undef PG8_MMA
#undef PG8_WAIT_V
#undef PG8_WAIT_L
#undef PG8_BAR
#undef PG8_SCHED
}
}

constexpr int T = 24576, DM = 4096, DFF = 11008;
constexpr int NCHUNK = T / 16;
constexpr int QLAT = 896, KVLAT = 512, QW = 3072, KVW = 4096, MIXW = 2048;
constexpr float EPS = 1e-6f;
__device__ __forceinline__ int pos_of(int r) { return r < 16384 ? (r & 8191) : (r & 4095); }
__device__ __forceinline__ int len_of(int r) { return r < 16384 ? 8192 : 4096; }

typedef unsigned short bf16;
#define GAS __attribute__((address_space(1)))
#define LAS __attribute__((address_space(3)))
typedef unsigned v4u __attribute__((ext_vector_type(4)));
typedef unsigned v2u __attribute__((ext_vector_type(2)));
typedef float f32x4 __attribute__((ext_vector_type(4)));
typedef float f32x2 __attribute__((ext_vector_type(2)));
typedef short bf16x8 __attribute__((ext_vector_type(8)));

__device__ __forceinline__ unsigned f2bf(float f) { unsigned u = __builtin_bit_cast(unsigned, f); return (u + 0x7fffu + ((u >> 16) & 1u)) >> 16; }
__device__ __forceinline__ unsigned pk2(float lo, float hi) { return f2bf(lo) | (f2bf(hi) << 16); }
__device__ __forceinline__ float bf2f(unsigned short b) { return __builtin_bit_cast(float, (unsigned)b << 16); }
__device__ __forceinline__ float bflo(unsigned w) { return __builtin_bit_cast(float, w << 16); }
__device__ __forceinline__ float bfhi(unsigned w) { return __builtin_bit_cast(float, w & 0xffff0000u); }
__device__ __forceinline__ float sigmoidf_fast(float x) { return __builtin_amdgcn_rcpf(1.0f + __builtin_amdgcn_exp2f(-1.4426950408889634f * x)); }
__device__ __forceinline__ float gelu_tanh(float y) { const float in = 1.5957691216057308f * (y + 0.044715f * y * y * y); return y * sigmoidf_fast(in); }

namespace pg8 {
#define EPI_ROWS const int row0 = u.pm * 256 + wr * 64 + fr
__device__ __forceinline__ float sq8(const f32x4 a, const f32x4 b) { return (a[0] * a[0] + a[1] * a[1]) + (a[2] * a[2] + a[3] * a[3]) + (b[0] * b[0] + b[1] * b[1]) + (b[2] * b[2] + b[3] * b[3]); }
__device__ __forceinline__ float red_fq(float s) { s += __shfl_xor(s, 16); s += __shfl_xor(s, 32); return s; }

__device__ __forceinline__ f32x4 rope4(const f32x4 v, const f32x4 cs) { f32x4 o; o[0] = v[0] * cs[0] - v[1] * cs[1]; o[1] = v[1] * cs[0] + v[0] * cs[1]; o[2] = v[2] * cs[2] - v[3] * cs[3]; o[3] = v[3] * cs[2] + v[2] * cs[3]; return o; }

#define LAUNDER(p) asm volatile("" : "+v"(p))
struct EpiNull { static constexpr bool PERM = true, MIDK = false;
    __device__ __forceinline__ void midk(f32x4 (&)[2][2][4][2], const Unit&, int, int) const {}
    __device__ __forceinline__ void operator()(const f32x4 (&acc)[2][2][4][2], const Unit& u, int wr, int wc, int fr, int fq) const {
#pragma unroll
        for (int ai = 0; ai < 2; ++ai)
#pragma unroll
            for (int bj = 0; bj < 2; ++bj)
                asm volatile("" :: "v"(acc[ai][bj][0][0]), "v"(acc[ai][bj][0][1]), "v"(acc[ai][bj][1][0]), "v"(acc[ai][bj][1][1]), "v"(acc[ai][bj][2][0]), "v"(acc[ai][bj][2][1]), "v"(acc[ai][bj][3][0]), "v"(acc[ai][bj][3][1]));
    } };
struct EpiWin {
    static constexpr bool PERM = true, MIDK = false;
    const float* rstd_x; bf16_t* X; bf16_t* qlat; bf16_t* kvlat; bf16_t* krope; float* stQ; float* stKV; const float* ropetab;
    __device__ __forceinline__ void midk(f32x4 (&)[2][2][4][2], const Unit&, int, int) const {}
    __device__ __forceinline__ void operator()(const f32x4 (&acc)[2][2][4][2], const Unit& u, int wr, int wc, int fr, int fq) const {
        EPI_ROWS; const int tile = u.pn;
        const GAS float* rsp = (const GAS float*)(rstd_x + row0); LAUNDER(rsp);
        if (tile < 8) {
            const int c0 = tile * 256 + wc * 32 + 8 * fq;
            GAS bf16_t* xp0 = (GAS bf16_t*)X + ((size_t)((c0 >> 4) * NCHUNK + (row0 >> 4)) * 512 + 256 + (row0 & 15) * 16 + (c0 & 15)); LAUNDER(xp0);
#pragma unroll
            for (int ai = 0; ai < 2; ++ai)
#pragma unroll
                for (int m = 0; m < 4; ++m) { const float rs = rsp[ai * 128 + m * 16];
#pragma unroll
                    for (int bj = 0; bj < 2; ++bj)
                        *(GAS u32x4*)(xp0 + ((size_t)(bj * 8) * NCHUNK + ai * 8 + m) * 512) = pack8(acc[ai][bj][m][0] * rs, acc[ai][bj][m][1] * rs); }
        } else if (tile < 14) {
            const bool isq = tile < 12; const int tl = isq ? tile - 8 : tile - 12; const int ld = isq ? QLAT : KVLAT;
            const int c0 = tl * 256 + wc * 32 + 8 * fq;
            GAS bf16_t* op = (GAS bf16_t*)(isq ? qlat : kvlat) + (size_t)row0 * ld + c0; GAS float* sp = (GAS float*)(isq ? stQ + (size_t)row0 * 16 : stKV + (size_t)row0 * 8) + tl * 4 + wc; LAUNDER(op); LAUNDER(sp);
#pragma unroll
            for (int ai = 0; ai < 2; ++ai)
#pragma unroll
                for (int m = 0; m < 4; ++m) { const float rs = rsp[ai * 128 + m * 16]; float ss = 0.f;
#pragma unroll
                    for (int bj = 0; bj < 2; ++bj) { const f32x4 v0 = acc[ai][bj][m][0] * rs, v1 = acc[ai][bj][m][1] * rs; ss += sq8(v0, v1);
                        if (c0 + bj * 128 < ld) *(GAS u32x4*)(op + (size_t)(ai * 128 + m * 16) * ld + bj * 128) = pack8(v0, v1); }
                    ss = red_fq(ss); if (fq == 0) sp[(size_t)(ai * 128 + m * 16) * (isq ? 16 : 8)] = ss; }
        } else {
            if (wc < 2) { const int c = wc * 32 + 8 * fq;
                GAS bf16_t* op = (GAS bf16_t*)krope + (size_t)row0 * 64 + c; LAUNDER(op);
#pragma unroll
                for (int ai = 0; ai < 2; ++ai)
#pragma unroll
                    for (int m = 0; m < 4; ++m) { const int row = row0 + ai * 128 + m * 16; const float rs = rsp[ai * 128 + m * 16]; const int pos = pos_of(row);
                        const f32x4 cs0 = *(const GAS f32x4*)((const GAS float*)ropetab + (size_t)pos * 64 + c), cs1 = *(const GAS f32x4*)((const GAS float*)ropetab + (size_t)pos * 64 + c + 4);
                        const f32x4 v0 = rope4(acc[ai][0][m][0] * rs, cs0), v1 = rope4(acc[ai][0][m][1] * rs, cs1);
                        *(GAS u32x4*)(op + (size_t)(ai * 128 + m * 16) * 64) = pack8(v0, v1); } }
        }
    }
};
struct EpiSsm1 {
    static constexpr bool PERM = true, MIDK = false;
    bf16_t* X;
    __device__ __forceinline__ void midk(f32x4 (&)[2][2][4][2], const Unit&, int, int) const {}
    __device__ __forceinline__ void operator()(const f32x4 (&acc)[2][2][4][2], const Unit& u, int wr, int wc, int fr, int fq) const {
        EPI_ROWS; GAS bf16_t* op = (GAS bf16_t*)X + (size_t)row0 * 512 + wc * 32 + 8 * fq; LAUNDER(op);
#pragma unroll
        for (int ai = 0; ai < 2; ++ai)
#pragma unroll
            for (int m = 0; m < 4; ++m)
#pragma unroll
                for (int bj = 0; bj < 2; ++bj) *(GAS u32x4*)(op + (size_t)(ai * 128 + m * 16) * 512 + bj * 128) = pack8(acc[ai][bj][m][0], acc[ai][bj][m][1]);
    }
};
struct EpiSsm2 {
    static constexpr bool PERM = true, MIDK = false;
    bf16_t* gact;
    __device__ __forceinline__ void midk(f32x4 (&)[2][2][4][2], const Unit&, int, int) const {}
    __device__ __forceinline__ void operator()(const f32x4 (&acc)[2][2][4][2], const Unit& u, int wr, int wc, int fr, int fq) const {
        EPI_ROWS; const int g = u.pn; const int c0 = wc * 32 + 8 * fq;
        GAS bf16_t* op = (GAS bf16_t*)gact + ((size_t)(row0 - g * NCHUNK) * 16 + (c0 >> 4)) * MIXW + g * 16 + (c0 & 15); LAUNDER(op);
#pragma unroll
        for (int ai = 0; ai < 2; ++ai)
#pragma unroll
            for (int m = 0; m < 4; ++m)
#pragma unroll
                for (int bj = 0; bj < 2; ++bj) { f32x4 v0 = acc[ai][bj][m][0], v1 = acc[ai][bj][m][1];
#pragma unroll
                    for (int e = 0; e < 4; ++e) { v0[e] = gelu_tanh(v0[e]); v1[e] = gelu_tanh(v1[e]); }
                    *(GAS u32x4*)(op + ((size_t)(ai * 128 + m * 16) * 16 + bj * 8) * MIXW) = pack8(v0, v1); }
    }
};
struct EpiQ {
    static constexpr bool PERM = true, MIDK = false;
    const float* rstd_q; bf16_t* q; const float* ropetab;
    __device__ __forceinline__ void midk(f32x4 (&)[2][2][4][2], const Unit&, int, int) const {}
    __device__ __forceinline__ void operator()(const f32x4 (&acc)[2][2][4][2], const Unit& u, int wr, int wc, int fr, int fq) const {
        EPI_ROWS; const GAS float* rsp = (const GAS float*)(rstd_q + row0); GAS bf16_t* op = (GAS bf16_t*)q + (size_t)row0 * QW + u.pn * 256 + wc * 32 + 8 * fq; LAUNDER(rsp); LAUNDER(op);
#pragma unroll
        for (int ai = 0; ai < 2; ++ai)
#pragma unroll
            for (int m = 0; m < 4; ++m) { const int row = row0 + ai * 128 + m * 16; const float rs = rsp[ai * 128 + m * 16] * 0.10411754627697264f;     const int pos = pos_of(row);
#pragma unroll
                for (int bj = 0; bj < 2; ++bj) { const int strip = 8 * u.pn + 4 * bj + wc, s6 = strip % 6;
                    f32x4 v0 = acc[ai][bj][m][0] * rs, v1 = acc[ai][bj][m][1] * rs;
                    if (s6 >= 4) { const int pc = (s6 - 4) * 32 + 8 * fq;
                        const f32x4 cs0 = *(const GAS f32x4*)((const GAS float*)ropetab + (size_t)pos * 64 + pc), cs1 = *(const GAS f32x4*)((const GAS float*)ropetab + (size_t)pos * 64 + pc + 4);
                        v0 = rope4(v0, cs0); v1 = rope4(v1, cs1); }
                    *(GAS u32x4*)(op + (size_t)(ai * 128 + m * 16) * QW + bj * 128) = pack8(v0, v1); } }
    }
};
struct EpiKV {
    static constexpr bool PERM = true, MIDK = false;
    const float* rstd_kv; bf16_t* kv;
    __device__ __forceinline__ void midk(f32x4 (&)[2][2][4][2], const Unit&, int, int) const {}
    __device__ __forceinline__ void operator()(const f32x4 (&acc)[2][2][4][2], const Unit& u, int wr, int wc, int fr, int fq) const {
        EPI_ROWS; const GAS float* rsp = (const GAS float*)(rstd_kv + row0); GAS bf16_t* op = (GAS bf16_t*)kv + (size_t)row0 * 2048 + u.pn * 256 + wc * 32 + 8 * fq; LAUNDER(rsp); LAUNDER(op);
#pragma unroll
        for (int ai = 0; ai < 2; ++ai)
#pragma unroll
            for (int m = 0; m < 4; ++m) { const float rs = rsp[ai * 128 + m * 16];
#pragma unroll
                for (int bj = 0; bj < 2; ++bj) *(GAS u32x4*)(op + (size_t)(ai * 128 + m * 16) * 2048 + bj * 128) = pack8(acc[ai][bj][m][0] * rs, acc[ai][bj][m][1] * rs); }
    }
};
struct EpiVT {
    static constexpr bool PERM = true, MIDK = false;
    const float* rstd_kv; bf16_t* vt;
    __device__ __forceinline__ void midk(f32x4 (&)[2][2][4][2], const Unit&, int, int) const {}
    __device__ __forceinline__ void operator()(const f32x4 (&acc)[2][2][4][2], const Unit& u, int wr, int wc, int fr, int fq) const {
        EPI_ROWS; const int c0 = u.pn * 256 + wc * 32 + 8 * fq; const GAS float* rsp = (const GAS float*)(rstd_kv + c0); GAS bf16_t* op = (GAS bf16_t*)vt + (size_t)row0 * T + c0; LAUNDER(rsp); LAUNDER(op);
        GAS bf16_t* opp = op - 8 * fq + 16 * (fq & 1) + 4 * (fq >> 1);
#pragma unroll
        for (int bj = 0; bj < 2; ++bj) { const f32x4 r0 = *(const GAS f32x4*)(rsp + bj * 128), r1 = *(const GAS f32x4*)(rsp + bj * 128 + 4);
#pragma unroll
            for (int ai = 0; ai < 2; ++ai)
#pragma unroll
                for (int m = 0; m < 4; ++m) { const u32x4 w = pack8(acc[ai][bj][m][0] * r0, acc[ai][bj][m][1] * r1); GAS bf16_t* q_ = opp + (size_t)(ai * 128 + m * 16) * T + bj * 128;
                    *(GAS u32x2*)q_ = (u32x2){w.x, w.y}; *(GAS u32x2*)(q_ + 8) = (u32x2){w.z, w.w}; } }
    }
};
struct EpiGlu {
    static constexpr bool PERM = true, MIDK = false;
    const bf16_t* gact; bf16_t* merged; float* stA;
    __device__ __forceinline__ void midk(f32x4 (&)[2][2][4][2], const Unit&, int, int) const {}
    __device__ __forceinline__ void operator()(const f32x4 (&acc)[2][2][4][2], const Unit& u, int wr, int wc, int fr, int fq) const {
        EPI_ROWS; const int c0 = u.pn * 256 + wc * 32 + 8 * fq;
        const GAS bf16_t* gp = (const GAS bf16_t*)gact + (size_t)row0 * MIXW + c0; GAS bf16_t* op = (GAS bf16_t*)merged + (size_t)row0 * DM + c0; GAS float* sp = (GAS float*)stA + (size_t)row0 * 32 + u.pn * 4 + wc; LAUNDER(gp); LAUNDER(op); LAUNDER(sp);
#pragma unroll
        for (int ai = 0; ai < 2; ++ai)
#pragma unroll
            for (int m = 0; m < 4; ++m) { float ss = 0.f;
#pragma unroll
                for (int bj = 0; bj < 2; ++bj) {
                    const u32x4 gw = *(const GAS u32x4*)(gp + (size_t)(ai * 128 + m * 16) * MIXW + bj * 128);
                    f32x4 v0, v1; const f32x4 a0 = acc[ai][bj][m][0], a1 = acc[ai][bj][m][1];
                    v0[0] = bflo(gw.x) * sigmoidf_fast(a0[0]); v0[1] = bfhi(gw.x) * sigmoidf_fast(a0[1]); v0[2] = bflo(gw.y) * sigmoidf_fast(a0[2]); v0[3] = bfhi(gw.y) * sigmoidf_fast(a0[3]);
                    v1[0] = bflo(gw.z) * sigmoidf_fast(a1[0]); v1[1] = bfhi(gw.z) * sigmoidf_fast(a1[1]); v1[2] = bflo(gw.w) * sigmoidf_fast(a1[2]); v1[3] = bfhi(gw.w) * sigmoidf_fast(a1[3]);
                    ss += sq8(v0, v1);
                    *(GAS u32x4*)(op + (size_t)(ai * 128 + m * 16) * DM + bj * 128) = pack8(v0, v1); }
                ss = red_fq(ss); if (fq == 0) sp[(size_t)(ai * 128 + m * 16) * 32] = ss; }
    }
};
struct EpiWout {
    static constexpr bool PERM = true, MIDK = true;
    const float* xp; const float* xs; const float* r2; const float* ratio; bf16_t* x1b; float* stA;
    __device__ __forceinline__ void midk(f32x4 (&acc)[2][2][4][2], const Unit& u, int wr, int fr) const {
        EPI_ROWS; const GAS float* rp = (const GAS float*)(ratio + row0); LAUNDER(rp);
#pragma unroll
        for (int ai = 0; ai < 2; ++ai)
#pragma unroll
            for (int m = 0; m < 4; ++m) { const float rt = rp[ai * 128 + m * 16];
#pragma unroll
                for (int bj = 0; bj < 2; ++bj)
#pragma unroll
                    for (int n = 0; n < 2; ++n) acc[ai][bj][m][n] *= rt; }
    }
    __device__ __forceinline__ void operator()(const f32x4 (&acc)[2][2][4][2], const Unit& u, int wr, int wc, int fr, int fq) const {
        EPI_ROWS; const int c0 = u.pn * 256 + wc * 32 + 8 * fq; const int rowt = u.pm * 256;
        const GAS float* xin = (const GAS float*)(rowt < 16384 ? xp + (size_t)row0 * DM : xs + (size_t)(row0 - 16384) * DM) + c0;
        const GAS float* rsp = (const GAS float*)(r2 + row0); GAS bf16_t* bo = (GAS bf16_t*)x1b + (size_t)row0 * DM + c0; GAS float* sp = (GAS float*)stA + (size_t)row0 * 64 + u.pn * 4 + wc;
        LAUNDER(xin); LAUNDER(rsp); LAUNDER(bo); LAUNDER(sp);
#pragma unroll
        for (int ai = 0; ai < 2; ++ai)
#pragma unroll
            for (int m = 0; m < 4; ++m) { const float rs = rsp[ai * 128 + m * 16]; float ss = 0.f; const size_t ro = (size_t)(ai * 128 + m * 16) * DM;
#pragma unroll
                for (int bj = 0; bj < 2; ++bj) {
                    const f32x4 v0 = *(const GAS f32x4*)(xin + ro + bj * 128) + acc[ai][bj][m][0] * rs, v1 = *(const GAS f32x4*)(xin + ro + bj * 128 + 4) + acc[ai][bj][m][1] * rs;
                    ss += sq8(v0, v1);
                    *(GAS u32x4*)(bo + ro + bj * 128) = pack8(v0, v1); }
                ss = red_fq(ss); if (fq == 0) sp[(size_t)(ai * 128 + m * 16) * 64] = ss; }
    }
};
__device__ __forceinline__ float dpp_ror1(float v) { return __builtin_bit_cast(float, __builtin_amdgcn_update_dpp(0, __builtin_bit_cast(int, v), 0x121, 0xf, 0xf, false)); }
__device__ __forceinline__ float dpp_rol1(float v) { return __builtin_bit_cast(float, __builtin_amdgcn_update_dpp(0, __builtin_bit_cast(int, v), 0x12f, 0xf, 0xf, false)); }
struct EpiFfnA {
    static constexpr bool PERM = true, MIDK = false;
    const float* rstd; int row_base; bf16_t* act; bf16_t* halo_up; bf16_t* halo_gate; const float* cw; const float* cb;
    __device__ __forceinline__ void midk(f32x4 (&)[2][2][4][2], const Unit&, int, int) const {}
    __device__ __forceinline__ void operator()(const f32x4 (&acc)[2][2][4][2], const Unit& u, int wr, int wc, int fr, int fq) const {
        EPI_ROWS; const int f0 = u.pn * 128 + wc * 32 + 8 * fq;
        const GAS float* rsp = (const GAS float*)(rstd + row_base + row0); GAS bf16_t* actp = (GAS bf16_t*)act + (size_t)row0 * DFF + f0;
        const int strip0 = u.pm * 4 + wr;
        GAS bf16_t* hup_p = (GAS bf16_t*)halo_up + (size_t)strip0 * 4 * DFF + f0; GAS bf16_t* hg_p = (GAS bf16_t*)halo_gate + (size_t)strip0 * 2 * DFF + f0;
        const GAS float* cwp = (const GAS float*)(cw + f0); const GAS float* cbp = (const GAS float*)(cb + f0);
        asm volatile("" : "+v"(rsp), "+v"(actp), "+v"(hup_p), "+v"(hg_p), "+v"(cwp), "+v"(cbp));
#pragma unroll
        for (int ai = 0; ai < 2; ++ai) {
            float rs[4];
#pragma unroll
            for (int m = 0; m < 4; ++m) rs[m] = rsp[ai * 128 + m * 16];
#pragma unroll
            for (int n = 0; n < 2; ++n) {
                const f32x4 w0 = *(const GAS f32x4*)(cwp + 4 * n), w1 = *(const GAS f32x4*)(cwp + DFF + 4 * n), w2 = *(const GAS f32x4*)(cwp + 2 * DFF + 4 * n), wb = *(const GAS f32x4*)(cbp + 4 * n);
                f32x4 res[4], Uu[4];
#pragma unroll
                for (int e = 0; e < 4; ++e) {
                    float U[4], R[4], L[4];
#pragma unroll
                    for (int m = 0; m < 4; ++m) { U[m] = acc[ai][0][m][n][e] * rs[m]; R[m] = dpp_ror1(U[m]); L[m] = dpp_rol1(U[m]); Uu[m][e] = U[m]; }
#pragma unroll
                    for (int m = 0; m < 4; ++m) {
                        const float prev = (fr == 0) ? R[m > 0 ? m - 1 : 0] : R[m];
                        const float next = (fr == 15) ? L[m < 3 ? m + 1 : 3] : L[m];
                        const float cv = w0[e] * prev + w1[e] * U[m] + w2[e] * next + wb[e];
                        res[m][e] = cv * sigmoidf_fast(cv) * (acc[ai][1][m][n][e] * rs[m]);
                    }
                }
#pragma unroll
                for (int m = 0; m < 4; ++m) {
                    const bool edge = (m == 0 && fr == 0) || (m == 3 && fr == 15);
                    if (!edge) { u32x2 w; w.x = cvt_pk_bf16(res[m][0], res[m][1]); w.y = cvt_pk_bf16(res[m][2], res[m][3]); *(GAS u32x2*)(actp + (size_t)(ai * 128 + m * 16) * DFF + 4 * n) = w; }
                    if (m == 0 || m == 3) {
                        const int hs = (m == 0) ? (fr == 0 ? 0 : (fr == 1 ? 1 : -1)) : (fr == 14 ? 2 : (fr == 15 ? 3 : -1));
                        if (hs >= 0) { u32x2 w; w.x = cvt_pk_bf16(Uu[m][0], Uu[m][1]); w.y = cvt_pk_bf16(Uu[m][2], Uu[m][3]);
                            *(GAS u32x2*)(hup_p + ((size_t)(ai * 2) * 4 + hs) * DFF + 4 * n) = w;
                            if (hs == 0 || hs == 3) { const f32x4 gv = acc[ai][1][m][n] * rs[m]; u32x2 wg; wg.x = cvt_pk_bf16(gv[0], gv[1]); wg.y = cvt_pk_bf16(gv[2], gv[3]);
                                *(GAS u32x2*)(hg_p + ((size_t)(ai * 2) * 2 + (hs == 3 ? 1 : 0)) * DFF + 4 * n) = wg; } }
                    }
                }
            }
        }
    }
};
struct EpiDown {
    static constexpr bool PERM = true, MIDK = false;
    bf16_t* xb; int row_base; float* stA;
    __device__ __forceinline__ void midk(f32x4 (&)[2][2][4][2], const Unit&, int, int) const {}
    __device__ __forceinline__ void operator()(const f32x4 (&acc)[2][2][4][2], const Unit& u, int wr, int wc, int fr, int fq) const {
        EPI_ROWS; GAS bf16_t* xo = (GAS bf16_t*)xb + (size_t)(row_base + row0) * DM + u.pn * 256 + wc * 32 + 8 * fq; GAS float* sp = (GAS float*)stA + (size_t)(row_base + row0) * 64 + u.pn * 4 + wc; LAUNDER(xo); LAUNDER(sp);
#pragma unroll
        for (int ai = 0; ai < 2; ++ai)
#pragma unroll
            for (int m = 0; m < 4; ++m) { float ss = 0.f; const size_t ro = (size_t)(ai * 128 + m * 16) * DM;
#pragma unroll
                for (int bj = 0; bj < 2; ++bj) { GAS bf16_t* p = xo + ro + bj * 128; const u32x4 w = *(const GAS u32x4*)p; const f32x4 a0 = acc[ai][bj][m][0], a1 = acc[ai][bj][m][1];
                    f32x4 v0, v1; v0[0] = bflo(w.x) + a0[0]; v0[1] = bfhi(w.x) + a0[1]; v0[2] = bflo(w.y) + a0[2]; v0[3] = bfhi(w.y) + a0[3];
                    v1[0] = bflo(w.z) + a1[0]; v1[1] = bfhi(w.z) + a1[1]; v1[2] = bflo(w.w) + a1[2]; v1[3] = bfhi(w.w) + a1[3];
                    ss += sq8(v0, v1); *(GAS u32x4*)p = pack8(v0, v1); }
                ss = red_fq(ss); if (fq == 0) sp[(size_t)(ai * 128 + m * 16) * 64] = ss; }
    }
};
#undef EPI_ROWS
}

namespace attn {
using f32x4v = __attribute__((ext_vector_type(4))) float;
using u32x2v = __attribute__((ext_vector_type(2))) unsigned;
using u32x4v = __attribute__((ext_vector_type(4))) unsigned;
constexpr int NW = 8, KVBLK = 64;
constexpr float SCALE = 0.07216878364870322f;
constexpr float THR = 8.f;
constexpr int LDQ = 3072, LDK = 2048, LDR = 64, LDVT = T, LDO = 4096;
constexpr int SHM_V = 128 * KVBLK * 2, SHM_K = KVBLK * 128 * 2, SHM_R = KVBLK * 64 * 2;
constexpr int OFF_V = 0, OFF_K = 2 * SHM_V, OFF_R = OFF_K + 2 * SHM_K, OFF_QR = OFF_R + 2 * SHM_R, SHM_ATTN = OFF_QR + NW * 4096;
#define SBAR() __builtin_amdgcn_sched_barrier(0)
#define PIN(x) asm volatile("" : "+v"(x))
__device__ __forceinline__ void glds16(const void* gsrc, unsigned lds_dst) { unsigned keep;
  asm volatile("s_mov_b32 %0, m0\n\ts_mov_b32 m0, %2\n\ts_nop 0\n\tglobal_load_lds_dwordx4 %1, off\n\ts_mov_b32 m0, %0" : "=&s"(keep) : "v"(gsrc), "s"(lds_dst) : "memory"); }
__device__ __forceinline__ unsigned cvtpk(float lo, float hi) { unsigned r; asm volatile("v_cvt_pk_bf16_f32 %0, %1, %2" : "=v"(r) : "v"(lo), "v"(hi)); return r; }
__device__ __forceinline__ float xmax16(float v) { auto r = __builtin_amdgcn_permlane16_swap(__float_as_uint(v), __float_as_uint(v), false, false); return fmaxf(__uint_as_float(r[0]), __uint_as_float(r[1])); }
__device__ __forceinline__ float xmax32(float v) { auto r = __builtin_amdgcn_permlane32_swap(__float_as_uint(v), __float_as_uint(v), false, false); return fmaxf(__uint_as_float(r[0]), __uint_as_float(r[1])); }
__device__ __forceinline__ float xsum16(float v) { auto r = __builtin_amdgcn_permlane16_swap(__float_as_uint(v), __float_as_uint(v), false, false); return __uint_as_float(r[0]) + __uint_as_float(r[1]); }
__device__ __forceinline__ float xsum32(float v) { auto r = __builtin_amdgcn_permlane32_swap(__float_as_uint(v), __float_as_uint(v), false, false); return __uint_as_float(r[0]) + __uint_as_float(r[1]); }
__device__ __forceinline__ float max3f(float a, float b, float c) { float r; asm("v_max3_f32 %0, %1, %2, %3" : "=v"(r) : "v"(a), "v"(b), "v"(c)); return r; }
#define MF16(A, B, C) __builtin_amdgcn_mfma_f32_16x16x32_bf16(A, B, C, 0, 0, 0)
struct Lane { const LAS char* Kl; const LAS char* Rl; const LAS char* Vl; const LAS char* qrl; int ky, rz, vz; };
template <int KB, int S> __device__ __forceinline__ bf16x8 kfrag(const Lane& L, int kst, int rst) {
  if constexpr (S < 4) return *(const LAS bf16x8*)(L.Kl + kst + KB * 4096 + ((64 * S) ^ L.ky));
  else return *(const LAS bf16x8*)(L.Rl + rst + KB * 2048 + ((64 * (S - 4)) ^ L.rz));
}
template <int DB, int C> __device__ __forceinline__ bf16x8 vfrag(const Lane& L, int vst) { return *(const LAS bf16x8*)(L.Vl + vst + DB * 2048 + ((64 * C) ^ L.rz)); }
template <int QB, int S> __device__ __forceinline__ bf16x8 qfrag(const bf16x8 (&qn)[2][6], const Lane& L) { return qn[QB][S]; }
template <int KB> __device__ __forceinline__ void qk_block_plain(f32x4v (&s)[2][4], const bf16x8 (&qn)[2][6], const Lane& L, int kst, int rst) {
  bf16x8 k = kfrag<KB, 0>(L, kst, rst); s[0][KB] = MF16(k, (qfrag<0, 0>(qn, L)), ((f32x4v){0.f, 0.f, 0.f, 0.f})); s[1][KB] = MF16(k, (qfrag<1, 0>(qn, L)), ((f32x4v){0.f, 0.f, 0.f, 0.f}));
  k = kfrag<KB, 1>(L, kst, rst); s[0][KB] = MF16(k, (qfrag<0, 1>(qn, L)), s[0][KB]); s[1][KB] = MF16(k, (qfrag<1, 1>(qn, L)), s[1][KB]);
  k = kfrag<KB, 2>(L, kst, rst); s[0][KB] = MF16(k, (qfrag<0, 2>(qn, L)), s[0][KB]); s[1][KB] = MF16(k, (qfrag<1, 2>(qn, L)), s[1][KB]);
  k = kfrag<KB, 3>(L, kst, rst); s[0][KB] = MF16(k, (qfrag<0, 3>(qn, L)), s[0][KB]); s[1][KB] = MF16(k, (qfrag<1, 3>(qn, L)), s[1][KB]);
  k = kfrag<KB, 4>(L, kst, rst); s[0][KB] = MF16(k, (qfrag<0, 4>(qn, L)), s[0][KB]); s[1][KB] = MF16(k, (qfrag<1, 4>(qn, L)), s[1][KB]);
  k = kfrag<KB, 5>(L, kst, rst); s[0][KB] = MF16(k, (qfrag<0, 5>(qn, L)), s[0][KB]); s[1][KB] = MF16(k, (qfrag<1, 5>(qn, L)), s[1][KB]);
}
template <int QB> __device__ __forceinline__ float rowmax(const f32x4v (&s)[2][4]) {
  float m = max3f(s[QB][0][0], s[QB][0][1], s[QB][0][2]); m = max3f(m, s[QB][0][3], s[QB][1][0]); m = max3f(m, s[QB][1][1], s[QB][1][2]); m = max3f(m, s[QB][1][3], s[QB][2][0]);
  m = max3f(m, s[QB][2][1], s[QB][2][2]); m = max3f(m, s[QB][2][3], s[QB][3][0]); m = max3f(m, s[QB][3][1], s[QB][3][2]); m = max3f(m, s[QB][3][3], s[QB][3][3]); return m;
}
constexpr float THRL = 11.541560327111707f;
__device__ __forceinline__ void decide(float pm0, float pm1, f32x4v (&c)[2][4], float (&mh)[2], f32x4v (&negm)[2], float (&al)[2]) {
  pm0 = xmax32(xmax16(pm0)); pm1 = xmax32(xmax16(pm1));
  if (__builtin_expect(__all((pm0 <= THRL) && (pm1 <= THRL)), 1)) { al[0] = 1.f; al[1] = 1.f; }
  else { const float d0 = fmaxf(pm0, 0.f), d1 = fmaxf(pm1, 0.f); mh[0] += d0; mh[1] += d1;
#pragma unroll
    for (int kb = 0; kb < 4; ++kb) { c[0][kb] = c[0][kb] - d0; c[1][kb] = c[1][kb] - d1; }
    al[0] = __builtin_amdgcn_exp2f(-d0); al[1] = __builtin_amdgcn_exp2f(-d1);
    negm[0] = (f32x4v){-mh[0], -mh[0], -mh[0], -mh[0]}; negm[1] = (f32x4v){-mh[1], -mh[1], -mh[1], -mh[1]}; }
}
__device__ __forceinline__ bf16x8 packp(const f32x4v a, const f32x4v b) { const u32x4v w = {cvtpk(a[0], a[1]), cvtpk(a[2], a[3]), cvtpk(b[0], b[1]), cvtpk(b[2], b[3])}; return __builtin_bit_cast(bf16x8, w); }

__device__ __forceinline__ void attn_step(f32x4v (&c)[2][4], f32x4v (&p)[2][4], f32x4v (&o)[2][8], const bf16x8 (&qn)[2][6], const Lane& L, int kst, int rst, int vst,
                                          const float (&alp)[2], float (&l)[2], float (&mh)[2], f32x4v (&negm)[2], float (&alc)[2]) {
  bf16x8 ka, kb_, kc, kd, P00, P01, P10, P11;
#define QKR(KB, S, FIRST, KX, KY) do { \
    if (FIRST) { c[0][KB] = MF16(KX, (qfrag<0, S>(qn, L)), negm[0]); c[1][KB] = MF16(KX, (qfrag<1, S>(qn, L)), negm[1]); \
                 c[0][KB + 1] = MF16(KY, (qfrag<0, S>(qn, L)), negm[0]); c[1][KB + 1] = MF16(KY, (qfrag<1, S>(qn, L)), negm[1]); } \
    else { c[0][KB] = MF16(KX, (qfrag<0, S>(qn, L)), c[0][KB]); c[1][KB] = MF16(KX, (qfrag<1, S>(qn, L)), c[1][KB]); \
           c[0][KB + 1] = MF16(KY, (qfrag<0, S>(qn, L)), c[0][KB + 1]); c[1][KB + 1] = MF16(KY, (qfrag<1, S>(qn, L)), c[1][KB + 1]); } } while (0)
#define EXP4(V) do { V[0] = __builtin_amdgcn_exp2f(V[0]); V[1] = __builtin_amdgcn_exp2f(V[1]); V[2] = __builtin_amdgcn_exp2f(V[2]); V[3] = __builtin_amdgcn_exp2f(V[3]); } while (0)
  ka = kfrag<0, 0>(L, kst, rst); kb_ = kfrag<1, 0>(L, kst, rst); SBAR();
  kc = kfrag<0, 1>(L, kst, rst); kd = kfrag<1, 1>(L, kst, rst); QKR(0, 0, true, ka, kb_); EXP4(p[0][2]); PIN(p[0][2]); SBAR();
  ka = kfrag<0, 2>(L, kst, rst); kb_ = kfrag<1, 2>(L, kst, rst); QKR(0, 1, false, kc, kd); EXP4(p[0][3]); PIN(p[0][3]); SBAR();
  kc = kfrag<0, 3>(L, kst, rst); kd = kfrag<1, 3>(L, kst, rst); QKR(0, 2, false, ka, kb_); EXP4(p[1][2]); PIN(p[1][2]); SBAR();
  ka = kfrag<0, 4>(L, kst, rst); kb_ = kfrag<1, 4>(L, kst, rst); QKR(0, 3, false, kc, kd); EXP4(p[1][3]); PIN(p[1][3]); SBAR();
  kc = kfrag<0, 5>(L, kst, rst); kd = kfrag<1, 5>(L, kst, rst); QKR(0, 4, false, ka, kb_);
  { float s = (p[0][0][0] + p[0][0][1]) + (p[0][0][2] + p[0][0][3]); s += (p[0][1][0] + p[0][1][1]) + (p[0][1][2] + p[0][1][3]); s += (p[0][2][0] + p[0][2][1]) + (p[0][2][2] + p[0][2][3]); s += (p[0][3][0] + p[0][3][1]) + (p[0][3][2] + p[0][3][3]);
    l[0] = l[0] * alp[0] + s; PIN(l[0]); } SBAR();
  ka = kfrag<2, 0>(L, kst, rst); kb_ = kfrag<3, 0>(L, kst, rst); QKR(0, 5, false, kc, kd);
  { float s = (p[1][0][0] + p[1][0][1]) + (p[1][0][2] + p[1][0][3]); s += (p[1][1][0] + p[1][1][1]) + (p[1][1][2] + p[1][1][3]); s += (p[1][2][0] + p[1][2][1]) + (p[1][2][2] + p[1][2][3]); s += (p[1][3][0] + p[1][3][1]) + (p[1][3][2] + p[1][3][3]);
    l[1] = l[1] * alp[1] + s; PIN(l[1]); } SBAR();
  kc = kfrag<2, 1>(L, kst, rst); kd = kfrag<3, 1>(L, kst, rst); QKR(2, 0, true, ka, kb_); P00 = packp(p[0][0], p[0][1]); PIN(P00); SBAR();
  ka = kfrag<2, 2>(L, kst, rst); kb_ = kfrag<3, 2>(L, kst, rst); QKR(2, 1, false, kc, kd); P01 = packp(p[0][2], p[0][3]); PIN(P01); SBAR();
  kc = kfrag<2, 3>(L, kst, rst); kd = kfrag<3, 3>(L, kst, rst); QKR(2, 2, false, ka, kb_); P10 = packp(p[1][0], p[1][1]); PIN(P10); SBAR();
  ka = kfrag<2, 4>(L, kst, rst); kb_ = kfrag<3, 4>(L, kst, rst); QKR(2, 3, false, kc, kd); P11 = packp(p[1][2], p[1][3]); PIN(P11); SBAR();
  kc = kfrag<2, 5>(L, kst, rst); kd = kfrag<3, 5>(L, kst, rst); QKR(2, 4, false, ka, kb_); SBAR();
  ka = vfrag<0, 0>(L, vst); kb_ = vfrag<1, 0>(L, vst); QKR(2, 5, false, kc, kd); SBAR();
#define PVR(DB, VX, VY, PA, PB) do { o[0][DB] = MF16(VX, PA, o[0][DB]); o[1][DB] = MF16(VX, PB, o[1][DB]); o[0][DB + 1] = MF16(VY, PA, o[0][DB + 1]); o[1][DB + 1] = MF16(VY, PB, o[1][DB + 1]); } while (0)
  float pm0, pm1;
  kc = vfrag<2, 0>(L, vst); kd = vfrag<3, 0>(L, vst); PVR(0, ka, kb_, P00, P10); pm0 = rowmax<0>(c); PIN(pm0); SBAR();
  ka = vfrag<4, 0>(L, vst); kb_ = vfrag<5, 0>(L, vst); PVR(2, kc, kd, P00, P10); pm1 = rowmax<1>(c); PIN(pm1); SBAR();
  kc = vfrag<6, 0>(L, vst); kd = vfrag<7, 0>(L, vst); PVR(4, ka, kb_, P00, P10); decide(pm0, pm1, c, mh, negm, alc); SBAR();
  ka = vfrag<0, 1>(L, vst); kb_ = vfrag<1, 1>(L, vst); PVR(6, kc, kd, P00, P10); EXP4(c[0][0]); PIN(c[0][0]); SBAR();
  kc = vfrag<2, 1>(L, vst); kd = vfrag<3, 1>(L, vst); PVR(0, ka, kb_, P01, P11); EXP4(c[0][1]); PIN(c[0][1]); SBAR();
  ka = vfrag<4, 1>(L, vst); kb_ = vfrag<5, 1>(L, vst); PVR(2, kc, kd, P01, P11); EXP4(c[1][0]); PIN(c[1][0]); SBAR();
  kc = vfrag<6, 1>(L, vst); kd = vfrag<7, 1>(L, vst); PVR(4, ka, kb_, P01, P11); EXP4(c[1][1]); PIN(c[1][1]); SBAR();
  PVR(6, kc, kd, P01, P11); SBAR();
#undef QKR
#undef PVR
}

__device__ __forceinline__ void attn_unit(const bf16* __restrict__ Qb, const bf16* __restrict__ Kh, const bf16* __restrict__ VTh, const bf16* __restrict__ Rh,
                                          bf16* __restrict__ Ob, float* __restrict__ st, int seq, int k0g, char* lds, int wid) {
  int lane_l = (int)__builtin_amdgcn_mbcnt_hi(~0u, __builtin_amdgcn_mbcnt_lo(~0u, 0u)); asm volatile("" : "+v"(lane_l));
  const int lane = lane_l, l15 = lane & 15, kq = lane >> 4;
  bf16x8 qn[2][6]; Lane L;
  L.qrl = (const LAS char*)(lds + OFF_QR + wid * 4096 + lane * 16);
  { const bf16* Qw = Qb + (long)(wid * 32 + l15) * LDQ + kq * 8;
#pragma unroll
    for (int qb = 0; qb < 2; ++qb) {
#pragma unroll
      for (int s = 0; s < 6; ++s) qn[qb][s] = *(const GAS bf16x8*)(Qw + (long)qb * 16 * LDQ + s * 32); } }
  L.Kl = (const LAS char*)(lds + OFF_K) + l15 * 256; L.Rl = (const LAS char*)(lds + OFF_R) + l15 * 128; L.Vl = (const LAS char*)(lds + OFF_V) + l15 * 128;
  L.ky = (kq ^ l15) << 4; L.rz = (kq ^ ((l15 >> 1) & 7)) << 4; L.vz = 0;
  unsigned kof0, kof1, rof, vof0, vof1;
  { const int q0 = wid, q1 = wid + 8;
    { const int row = 4 * q0 + (lane >> 4), ch = (lane & 15) ^ (row & 15); kof0 = (unsigned)(row * LDK + ch * 8) * 2u; }
    { const int row = 4 * q1 + (lane >> 4), ch = (lane & 15) ^ (row & 15); kof1 = (unsigned)(row * LDK + ch * 8) * 2u; }
    { const int row = 8 * q0 + (lane >> 3), ch = (lane & 7) ^ ((row >> 1) & 7); rof = (unsigned)(row * LDR + ch * 8) * 2u; }
    { const int row = 8 * q0 + (lane >> 3), ch = (lane & 7) ^ ((row >> 1) & 7); vof0 = (unsigned)(row * LDVT + ch * 8) * 2u; }
    { const int row = 8 * q1 + (lane >> 3), ch = (lane & 7) ^ ((row >> 1) & 7); vof1 = (unsigned)(row * LDVT + ch * 8) * 2u; } }
  const unsigned lds0 = (unsigned)(uintptr_t)lds;
  const unsigned dK = (unsigned)__builtin_amdgcn_readfirstlane(lds0 + OFF_K + wid * 1024), dR = (unsigned)__builtin_amdgcn_readfirstlane(lds0 + OFF_R + wid * 1024), dV = (unsigned)__builtin_amdgcn_readfirstlane(lds0 + OFF_V + wid * 1024);
  const char* VTk = (const char*)VTh + (size_t)k0g * 2;
#define DMA_KR(t, s) do { const char* kb_ = (const char*)Kh + (size_t)(t) * (KVBLK * LDK * 2); const char* rb_ = (const char*)Rh + (size_t)(t) * (KVBLK * LDR * 2); \
    glds16(kb_ + kof0, dK + (s) * SHM_K); glds16(kb_ + kof1, dK + (s) * SHM_K + 8192); glds16(rb_ + rof, dR + (s) * SHM_R); } while (0)
#define DMA_V(t, s) do { const char* vb_ = VTk + (size_t)(t) * (KVBLK * 2); glds16(vb_ + vof0, dV + (s) * SHM_V); glds16(vb_ + vof1, dV + (s) * SHM_V + 8192); } while (0)
#define WAIT_BAR() asm volatile("s_waitcnt vmcnt(0) lgkmcnt(0)\n\ts_barrier" ::: "memory")
#define RESC(a) do { if (__any(((a)[0] < 1.f) || ((a)[1] < 1.f))) { _Pragma("unroll") for (int d_ = 0; d_ < 8; ++d_) { o[0][d_] *= (a)[0]; o[1][d_] *= (a)[1]; } } } while (0)
  f32x4v o[2][8], sA[2][4], sB[2][4], negm[2]; float mh[2], l[2] = {0.f, 0.f}, alA[2], alB[2];
#pragma unroll
  for (int d = 0; d < 8; ++d) { o[0][d] = (f32x4v){0.f, 0.f, 0.f, 0.f}; o[1][d] = (f32x4v){0.f, 0.f, 0.f, 0.f}; }
  const int NT = seq / KVBLK;
  DMA_KR(0, 0); DMA_V(0, 0); WAIT_BAR();
  DMA_KR(1, 1);
  qk_block_plain<0>(sA, qn, L, 0, 0); qk_block_plain<1>(sA, qn, L, 0, 0); qk_block_plain<2>(sA, qn, L, 0, 0); qk_block_plain<3>(sA, qn, L, 0, 0);
  { mh[0] = xmax32(xmax16(rowmax<0>(sA))); mh[1] = xmax32(xmax16(rowmax<1>(sA))); alA[0] = 1.f; alA[1] = 1.f;
    negm[0] = (f32x4v){-mh[0], -mh[0], -mh[0], -mh[0]}; negm[1] = (f32x4v){-mh[1], -mh[1], -mh[1], -mh[1]};
#pragma unroll
    for (int kb = 0; kb < 4; ++kb) { sA[0][kb] = sA[0][kb] - mh[0]; sA[1][kb] = sA[1][kb] - mh[1]; }
#pragma unroll
    for (int kb = 0; kb < 2; ++kb)
#pragma unroll
      for (int e = 0; e < 4; ++e) { sA[0][kb][e] = __builtin_amdgcn_exp2f(sA[0][kb][e]); sA[1][kb][e] = __builtin_amdgcn_exp2f(sA[1][kb][e]); } }
  WAIT_BAR();
#pragma unroll 1
  for (int j = 1; j + 1 < NT; j += 2) {
    DMA_KR(j + 1, 0); DMA_V(j, 1);
    attn_step(sB, sA, o, qn, L, SHM_K, SHM_R, 0, alA, l, mh, negm, alB);
    RESC(alB); WAIT_BAR();
    if (j + 2 < NT) DMA_KR(j + 2, 1);
    DMA_V(j + 1, 0);
    attn_step(sA, sB, o, qn, L, 0, 0, SHM_V, alB, l, mh, negm, alA);
    RESC(alA); WAIT_BAR();
  }
  DMA_V(NT - 1, 1);
  attn_step(sB, sA, o, qn, L, SHM_K, SHM_R, 0, alA, l, mh, negm, alB);
  RESC(alB); WAIT_BAR();
  {
#pragma unroll
    for (int kb = 2; kb < 4; ++kb)
#pragma unroll
      for (int e = 0; e < 4; ++e) { sB[0][kb][e] = __builtin_amdgcn_exp2f(sB[0][kb][e]); sB[1][kb][e] = __builtin_amdgcn_exp2f(sB[1][kb][e]); }
    float s0 = 0.f, s1 = 0.f;
#pragma unroll
    for (int kb = 0; kb < 4; ++kb) { s0 += (sB[0][kb][0] + sB[0][kb][1]) + (sB[0][kb][2] + sB[0][kb][3]); s1 += (sB[1][kb][0] + sB[1][kb][1]) + (sB[1][kb][2] + sB[1][kb][3]); }
    l[0] = l[0] * alB[0] + s0; l[1] = l[1] * alB[1] + s1;
    const bf16x8 P00 = packp(sB[0][0], sB[0][1]), P01 = packp(sB[0][2], sB[0][3]), P10 = packp(sB[1][0], sB[1][1]), P11 = packp(sB[1][2], sB[1][3]);
#define PVD(DB) do { bf16x8 v0 = vfrag<DB, 0>(L, SHM_V), v1 = vfrag<DB, 1>(L, SHM_V); o[0][DB] = MF16(v0, P00, o[0][DB]); o[1][DB] = MF16(v0, P10, o[1][DB]); o[0][DB] = MF16(v1, P01, o[0][DB]); o[1][DB] = MF16(v1, P11, o[1][DB]); } while (0)
    PVD(0); PVD(1); PVD(2); PVD(3); PVD(4); PVD(5); PVD(6); PVD(7);
#undef PVD
  }
  int lane_e = (int)__builtin_amdgcn_mbcnt_hi(~0u, __builtin_amdgcn_mbcnt_lo(~0u, 0u)); asm volatile("" : "+v"(lane_e)); const int l15e = lane_e & 15, kqe = lane_e >> 4;
  GAS bf16* Ow = (GAS bf16*)Ob + (long)(wid * 32 + l15e) * LDO + 4 * kqe; GAS float* stw = (GAS float*)st + (long)(wid * 32 + l15e) * 16;
  asm volatile("" : "+v"(Ow), "+v"(stw));
#pragma unroll
  for (int qb = 0; qb < 2; ++qb) { const float lt = xsum32(xsum16(l[qb])); const float rl = __builtin_amdgcn_rcpf(lt); float ss = 0.f;
#pragma unroll
    for (int db = 0; db < 8; ++db) { const f32x4v v = o[qb][db] * rl; u32x2v w; w.x = cvtpk(v[0], v[1]); w.y = cvtpk(v[2], v[3]);
      const float a0 = bflo(w.x), a1 = bfhi(w.x), a2 = bflo(w.y), a3 = bfhi(w.y); ss += (a0 * a0 + a1 * a1) + (a2 * a2 + a3 * a3);
      *(GAS u32x2v*)(Ow + (long)(qb * 16) * LDO + db * 16) = w; }
    ss = xsum32(xsum16(ss)); if (kqe == 0) stw[(long)(qb * 16) * 16] = ss; }
  asm volatile("s_waitcnt lgkmcnt(0)\n\ts_barrier" ::: "memory");
#undef DMA_KR
#undef DMA_V
#undef WAIT_BAR
#undef RESC
}
#undef SBAR
#undef PIN
#undef MF16
#undef EXP4
}

constexpr size_t MiB = 1u << 20;
constexpr size_t WS_CTL = 0, CTL_ZERO_BYTES = 1 * MiB;
constexpr size_t WS_RSTDX = 1 * MiB, WS_RSTDQ = WS_RSTDX + 98304, WS_RSTDKV = WS_RSTDQ + 98304, WS_R2 = WS_RSTDKV + 98304, WS_RATIO = WS_R2 + 98304, WS_RSTDX1 = WS_RATIO + 98304;
constexpr size_t WS_STA = 2 * MiB;
constexpr size_t WS_STB = 8 * MiB;
constexpr size_t WS_STQ = 10 * MiB;
constexpr size_t WS_STKV = 12 * MiB;
constexpr size_t WS_ROPE = 13 * MiB;
constexpr size_t WS_WIN = 16 * MiB;
constexpr size_t WS_WGLU = 46 * MiB;
constexpr size_t WS_WQ = 54 * MiB;
constexpr size_t WS_WKV = 60 * MiB;
constexpr size_t WS_WOUT = 64 * MiB;
constexpr size_t WS_WUG = 96 * MiB;
constexpr size_t WS_WDN = 268 * MiB;
constexpr size_t WS_W1T = 354 * MiB;
constexpr size_t WS_W2T = 370 * MiB;
constexpr size_t WS_A = 402 * MiB;
constexpr size_t WS_B = 594 * MiB;
constexpr size_t WS_QLAT = 786 * MiB, WS_KVLAT = 828 * MiB, WS_KROPE = 852 * MiB;
constexpr size_t WS_GACT = 856 * MiB;
constexpr size_t WS_HUP = 952 * MiB, WS_HGATE = 964 * MiB, WS_END = 970 * MiB;
static_assert(WS_HUP + (size_t)128 * 4 * DFF * 2 <= WS_HGATE && WS_HGATE + (size_t)128 * 2 * DFF * 2 <= WS_END, "halo");
constexpr size_t OUT_X = 0, OUT_KV = 192 * MiB;
constexpr int CW_BAR = 4096;

constexpr int NWAVES = 8;
constexpr int RING_BYTES = 131072, LDSCTL_OFF = 143360, MISC_OFF = LDSCTL_OFF + 320, LDS_BYTES = 147456;

typedef GAS unsigned gu32;
#define RLX_AGENT __ATOMIC_RELAXED, __HIP_MEMORY_SCOPE_AGENT
#define LDS_WAIT() asm volatile("s_waitcnt lgkmcnt(0)" ::: "memory")

#define XB_TMO      128
#define XB_XCNT(j)  (256  + 64 * (j))
#define XB_XSUB(j)  (1280 + 64 * (j))
#define XB_XGEN(j)  (2304 + 64 * (j))
#define XB_TOP      3328
#define XB_TOPGEN   3392
#define XCD_BAR_WORDS 3456
#define XB_SPIN_CAP (1u << 18)
__device__ __forceinline__ unsigned xb_ld(unsigned* p)              { return __hip_atomic_load(p, __ATOMIC_RELAXED, __HIP_MEMORY_SCOPE_AGENT); }
__device__ __forceinline__ unsigned xb_add(unsigned* p, unsigned v) { return __hip_atomic_fetch_add(p, v, __ATOMIC_RELAXED, __HIP_MEMORY_SCOPE_AGENT); }
__device__ __forceinline__ unsigned xb_xcc_id() { return (unsigned)__builtin_amdgcn_s_getreg((3 << 11) | 20) & 0xFu; }
#define XB_SPIN(cond, bar) do { unsigned _sp = 0; while (cond) { __builtin_amdgcn_s_sleep(1); \
    if ((++_sp & 255u) == 0u) { if (xb_ld(&(bar)[XB_TMO])) break; if (_sp > XB_SPIN_CAP) { atomicAdd(&(bar)[XB_TMO], 1u); break; } } } } while (0)
struct XcdBarrier { unsigned* bar; unsigned x; volatile LAS unsigned* st; };
__device__ __forceinline__ XcdBarrier xcd_barrier_post(unsigned* bar, volatile LAS unsigned* st) {
    XcdBarrier b; b.bar = bar; b.x = xb_xcc_id(); b.st = st;
    if (threadIdx.x == 0) (void)xb_add(&bar[XB_XCNT(b.x)], 1u);
    return b;
}
__device__ __forceinline__ void xcd_barrier_complete(unsigned* bar, unsigned x, unsigned& nloc, unsigned& nx) {
    const unsigned G = gridDim.x * gridDim.y * gridDim.z;
    unsigned sum, cnt, mine, sp = 0u;
    for (;;) {
        sum = 0u; cnt = 0u; mine = 0u;
#pragma unroll
        for (unsigned j = 0; j < 16; ++j) { const unsigned c = xb_ld(&bar[XB_XCNT(j)]); sum += c; cnt += (c > 0u) ? 1u : 0u; mine = (j == x) ? c : mine; }
        if (sum == G) break;
        __builtin_amdgcn_s_sleep(1);
        if ((++sp & 255u) == 0u) { if (xb_ld(&bar[XB_TMO])) break; if (sp > XB_SPIN_CAP) { atomicAdd(&bar[XB_TMO], 1u); break; } }
    }
    nloc = mine > 0u ? mine : 1u; nx = cnt > 0u ? cnt : 1u;
}
__device__ __forceinline__ void xcd_barrier(const XcdBarrier& b) {
    asm volatile("s_waitcnt vmcnt(0)" ::: "memory");
    __syncthreads();
    if (threadIdx.x == 0) {
        unsigned* bar = b.bar;
        __builtin_amdgcn_s_waitcnt(0);
        unsigned nloc = b.st[0], nx = b.st[1];
        if (nloc == 0u) { xcd_barrier_complete(bar, b.x, nloc, nx); b.st[0] = nloc; b.st[1] = nx; }
        const unsigned old = xb_add(&bar[XB_XSUB(b.x)], 1u);
        const unsigned gen = old / nloc;
        if (old + 1u == (gen + 1u) * nloc) {
            __builtin_amdgcn_fence(__ATOMIC_RELEASE, "agent");
            asm volatile("s_waitcnt vmcnt(0)" ::: "memory");
            const unsigned og = xb_add(&bar[XB_TOP], 1u);
            const unsigned tg = og / nx;
            if (og + 1u == (tg + 1u) * nx) xb_add(&bar[XB_TOPGEN], 1u);
            else XB_SPIN(xb_ld(&bar[XB_TOPGEN]) == tg, bar);
            __builtin_amdgcn_fence(__ATOMIC_ACQUIRE, "agent");
            xb_add(&bar[XB_XGEN(b.x)], 1u);
            asm volatile("s_waitcnt vmcnt(0)" ::: "memory");
        } else {
            XB_SPIN(xb_ld(&bar[XB_XGEN(b.x)]) == gen, bar);
            __builtin_amdgcn_fence(__ATOMIC_ACQUIRE, "agent");
            asm volatile("s_waitcnt vmcnt(0)" ::: "memory");
        }
    }
    __syncthreads();
}

__device__ __forceinline__ float wave_sum(float v) {
#pragma unroll
    for (int o = 1; o < 64; o <<= 1) v += __shfl_xor(v, o);
    return v;
}
template <class RowMap>
__device__ __forceinline__ void transpose_item(const float* W, int K, int N, bf16* WT, const float* g1, const float* g2, int ksplit, RowMap rm, LAS float* scr, int item, int lane) {
    const int nblk = N / 64; int kb, nb;
    if ((nblk & 3) == 0) { const int w = item & 7, rest = item >> 3, q = nblk >> 2; nb = (rest % q) * 4 + (w & 3); kb = (rest / q) * 2 + (w >> 2); }
    else { kb = item / nblk; nb = item % nblk; }
    const int k0 = 64 * kb, n0 = 64 * nb;
    f32x2 wv[32];
    const GAS f32x2* wp = (const GAS f32x2*)((const GAS float*)W + (size_t)(k0 + (lane >> 5)) * N + n0) + (lane & 31);
#pragma unroll
    for (int i = 0; i < 32; ++i) wv[i] = *(const GAS f32x2*)((const GAS float*)wp + (size_t)(2 * i) * N);
    float gn[32];
#pragma unroll
    for (int i = 0; i < 32; ++i) { const int k = k0 + 2 * i + (lane >> 5); gn[i] = g1 ? (k < ksplit ? g1[k] : g2[k - ksplit]) : 1.0f; }
    const int c = lane & 7;
#pragma unroll
    for (int sub = 0; sub < 2; ++sub) {
#pragma unroll
        for (int i = 0; i < 32; ++i) { const int kk = 2 * i + (lane >> 5); scr[kk * 33 + (lane & 31)] = (sub ? wv[i].y : wv[i].x) * gn[i]; }
        LDS_WAIT(); asm volatile("" ::: "memory");
#pragma unroll
        for (int j = 0; j < 4; ++j) { const int nl = (lane >> 3) + 8 * j; const LAS float* s = scr + (8 * c) * 33 + nl;
            v4u o; o.x = pg8::cvt_pk_bf16(s[0 * 33], s[1 * 33]); o.y = pg8::cvt_pk_bf16(s[2 * 33], s[3 * 33]); o.z = pg8::cvt_pk_bf16(s[4 * 33], s[5 * 33]); o.w = pg8::cvt_pk_bf16(s[6 * 33], s[7 * 33]);
            *(GAS v4u*)(WT + (size_t)rm(n0 + 2 * nl + sub) * K + k0 + 8 * c) = o; }
        LDS_WAIT(); asm volatile("" ::: "memory");
    }
}
struct RmId  { __device__ __forceinline__ int operator()(int n) const { return n; } };
struct RmWin { __device__ __forceinline__ int operator()(int n) const { if (n < 2944) return n; if (n < 3456) return n + 128; const int i = n - 3456; return 3584 + (i < 32 ? 2 * i : 2 * (i - 32) + 1); } };
struct RmQ   { __device__ __forceinline__ int operator()(int n) const { const int r = n % 192, hb = n - r; if (r < 128) return n; const int i = r - 128; return hb + 128 + (i < 32 ? 2 * i : 2 * (i - 32) + 1); } };
struct RmKV  { __device__ __forceinline__ int operator()(int n) const { const int h = n >> 8, c = n & 255; return c < 128 ? h * 128 + c : 2048 + h * 128 + (c - 128); } };
struct RmUp  { __device__ __forceinline__ int operator()(int n) const { return (n >> 7) * 256 + (n & 127); } };
struct RmGate{ __device__ __forceinline__ int operator()(int n) const { return (n >> 7) * 256 + 128 + (n & 127); } };

__device__ __forceinline__ void sincos_d(double a, double& s, double& c) {
    const double kd = __builtin_rint(a * 0.63661977236758134308); const long k = (long)kd;
    double r = __builtin_fma(-kd, 1.57079632679489655800e+00, a); r = __builtin_fma(-kd, 6.12323399573676603587e-17, r);
    const double r2 = r * r;
    double sp = 1.0 / 6227020800.0; sp = sp * r2 - 1.0 / 39916800.0; sp = sp * r2 + 1.0 / 362880.0; sp = sp * r2 - 1.0 / 5040.0; sp = sp * r2 + 1.0 / 120.0; sp = sp * r2 - 1.0 / 6.0; sp = sp * r2 * r + r;
    double cp = 1.0 / 479001600.0; cp = cp * r2 - 1.0 / 3628800.0; cp = cp * r2 + 1.0 / 40320.0; cp = cp * r2 - 1.0 / 720.0; cp = cp * r2 + 1.0 / 24.0; cp = cp * r2 - 0.5; cp = cp * r2 + 1.0;
    const int q = (int)(k & 3);
    s = (q == 0) ? sp : (q == 1) ? cp : (q == 2) ? -sp : -cp;
    c = (q == 0) ? cp : (q == 1) ? -sp : (q == 2) ? -cp : sp;
}

__device__ __forceinline__ void ssm_weights_group(int g, const float* a_re, const float* a_im, const float* b_re, const float* b_im, const float* c_re, const float* c_im,
                                                  const float* log_dt, const float* dskip, bf16* W1t, bf16* W2t, LAS float* L, int tid) {
    LAS float* PW = L;
    LAS float* BB = PW + 2 * 17 * 64 * 2;
    LAS float* CC = BB + 2 * 64 * 16 * 2;
    LAS float* KT = CC + 2 * 16 * 64 * 2;
    for (int i = tid; i < 2 * 17 * 64; i += 512) { const int d = i / (17 * 64), e = (i / 64) % 17, p = i & 63;
        const double dt = exp((double)log_dt[d * 128 + g]); const double are = a_re[(d * 128 + g) * 64 + p], aim = a_im[(d * 128 + g) * 64 + p];
        const double mag = exp((double)e * dt * are); double s, c; sincos_d((double)e * dt * aim, s, c);
        PW[i * 2] = (float)(mag * c); PW[i * 2 + 1] = (float)(mag * s); }
    for (int i = tid; i < 2 * 64 * 16; i += 512) { const int d = i / 1024, p = (i >> 4) & 63, h = i & 15;
        const double dt = exp((double)log_dt[d * 128 + g]); const double are = a_re[(d * 128 + g) * 64 + p], aim = a_im[(d * 128 + g) * 64 + p];
        const double x = dt * are, y = dt * aim; double sy, cy, sh, ch; sincos_d(y, sy, cy); sincos_d(0.5 * y, sh, ch);
        const double em1 = expm1(x); const double re1 = em1 * cy - 2.0 * sh * sh, im1 = (em1 + 1.0) * sy;
        const double den = are * are + aim * aim; const double qre = (re1 * are + im1 * aim) / den, qim = (im1 * are - re1 * aim) / den;
        const size_t bi = ((size_t)((d * 128 + g) * 64 + p)) * 16 + h; const double br = b_re[bi], bim = b_im[bi];
        BB[i * 2] = (float)(qre * br - qim * bim); BB[i * 2 + 1] = (float)(qre * bim + qim * br); }
    for (int i = tid; i < 2 * 16 * 64; i += 512) { const int d = i / 1024, h = (i >> 6) & 15, p = i & 63; const size_t ci = ((size_t)((d * 128 + g) * 16 + h)) * 64 + p;
        CC[i * 2] = c_re[ci]; CC[i * 2 + 1] = c_im[ci]; }
    __syncthreads();
    { const int d = tid >> 8, e = (tid >> 4) & 15, h = tid & 15; float acc[16];
#pragma unroll
        for (int q = 0; q < 16; ++q) acc[q] = 0.f;
        for (int p = 0; p < 64; ++p) { const float cr = CC[((d * 16 + h) * 64 + p) * 2], ci = CC[((d * 16 + h) * 64 + p) * 2 + 1];
            const float pr = PW[((d * 17 + e) * 64 + p) * 2], pi = PW[((d * 17 + e) * 64 + p) * 2 + 1];
            const float tr = cr * pr - ci * pi, ti = cr * pi + ci * pr; const LAS f32x4* bp = (const LAS f32x4*)(BB + ((d * 64 + p) * 16) * 2);
#pragma unroll
            for (int q = 0; q < 8; ++q) { const f32x4 b = bp[q]; acc[2 * q] += tr * b[0] - ti * b[1]; acc[2 * q + 1] += tr * b[2] - ti * b[3]; } }
#pragma unroll
        for (int q = 0; q < 16; ++q) KT[((d * 16 + e) * 16 + h) * 16 + q] = acc[q]; }
    __syncthreads();
    for (int i = tid; i < 256 * 32; i += 512) { const int n = i >> 5, k0 = (i & 31) * 8; const int d = n >> 7, im = (n >> 6) & 1, p = n & 63; const int s = k0 >> 4, h0 = k0 & 15, e = d ? s : 15 - s;
        const float pr = PW[((d * 17 + e) * 64 + p) * 2], pi = PW[((d * 17 + e) * 64 + p) * 2 + 1]; float v[8];
#pragma unroll
        for (int j = 0; j < 8; ++j) { const float br = BB[((d * 64 + p) * 16 + h0 + j) * 2], bi = BB[((d * 64 + p) * 16 + h0 + j) * 2 + 1]; v[j] = im ? (pr * bi + pi * br) : (pr * br - pi * bi); }
        v4u o; o.x = pk2(v[0], v[1]); o.y = pk2(v[2], v[3]); o.z = pk2(v[4], v[5]); o.w = pk2(v[6], v[7]);
        *(GAS v4u*)(W1t + ((size_t)(g * 256 + n)) * 256 + k0) = o; }
    for (int i = tid; i < 256 * 64; i += 512) { const int n = i >> 6, k0 = (i & 63) * 8; const int j = n >> 4, h = n & 15; float v[8];
        if (k0 < 256) { const int d = k0 >> 7, im = (k0 >> 6) & 1, p0 = k0 & 63, e = d ? 16 - j : j + 1;
#pragma unroll
            for (int q = 0; q < 8; ++q) { const int p = p0 + q; const float cr = CC[((d * 16 + h) * 64 + p) * 2], ci = CC[((d * 16 + h) * 64 + p) * 2 + 1];
                const float pr = PW[((d * 17 + e) * 64 + p) * 2], pi = PW[((d * 17 + e) * 64 + p) * 2 + 1]; v[q] = im ? -(cr * pi + ci * pr) : (cr * pr - ci * pi); }
        } else { const int s = (k0 - 256) >> 4, h0 = (k0 - 256) & 15;
#pragma unroll
            for (int q = 0; q < 8; ++q) { const int hh = h0 + q; float val = 0.f;
                if (s <= j) val += KT[((0 * 16 + (j - s)) * 16 + h) * 16 + hh];
                if (s >= j) val += KT[((1 * 16 + (s - j)) * 16 + h) * 16 + hh];
                if (s == j && h == hh) val += dskip[g * 16 + h];
                v[q] = val; } }
        v4u o; o.x = pk2(v[0], v[1]); o.y = pk2(v[2], v[3]); o.z = pk2(v[4], v[5]); o.w = pk2(v[6], v[7]);
        *(GAS v4u*)(W2t + ((size_t)(g * 256 + n)) * 512 + k0) = o; }
    __syncthreads();
}
#ifndef PROBE_ATTN
#define PROBE_ATTN 1
#endif
#ifndef PROBE_P0
#define PROBE_P0 1
#endif
#ifndef PROBE_P1
#define PROBE_P1 1
#endif
#ifndef PROBE_P7
#define PROBE_P7 1
#endif
#ifndef PROBE_FA
#define PROBE_FA 1
#endif

struct Args { const float* in[27]; float* out; unsigned char* ws; int ph_lo, ph_hi; };

__global__ void __launch_bounds__(NWAVES * 64, 2) enc_fwd(Args args) {
    extern __shared__ __attribute__((aligned(16))) unsigned char lds[];
    LAS unsigned char* ldsb = (LAS unsigned char*)lds;
    volatile LAS unsigned* MISC = (volatile LAS unsigned*)(ldsb + MISC_OFF);
    const int wave0 = __builtin_amdgcn_readfirstlane(threadIdx.x >> 6);
    const int G = gridDim.x, bx = blockIdx.x; const int vcu = (G % 8 == 0) ? (bx % 8) * (G / 8) + bx / 8 : bx;
    const int NGW = G * NWAVES, NGT = G * NWAVES * 64;
    gu32* ctl = (gu32*)(args.ws + WS_CTL);
#define PHB unsigned char* wsl = args.ws; unsigned char* outl = (unsigned char*)args.out; asm volatile("" : "+s"(wsl), "+s"(outl)); \
    int tid = wave0 * 64 + (int)__builtin_amdgcn_mbcnt_hi(~0u, __builtin_amdgcn_mbcnt_lo(~0u, 0u)); asm volatile("" : "+v"(tid)); const int lane = tid & 63, wave = wave0; \
    const int gw = vcu * NWAVES + wave, gt = vcu * (NWAVES * 64) + tid; (void)lane; (void)gw; (void)gt; (void)wsl; (void)outl
#define x_p (args.in[0])
#define x_s (args.in[1])
#define rstd_x ((float*)(wsl + WS_RSTDX))
#define rstd_q ((float*)(wsl + WS_RSTDQ))
#define rstd_kv ((float*)(wsl + WS_RSTDKV))
#define r2v ((float*)(wsl + WS_R2))
#define ratio ((float*)(wsl + WS_RATIO))
#define rstd_x1 ((float*)(wsl + WS_RSTDX1))
#define stA ((float*)(wsl + WS_STA))
#define stB ((float*)(wsl + WS_STB))
#define stQ ((float*)(wsl + WS_STQ))
#define stKV ((float*)(wsl + WS_STKV))
#define ropetab ((float*)(wsl + WS_ROPE))
#define Wi ((bf16*)(wsl + WS_WIN))
#define Wglu ((bf16*)(wsl + WS_WGLU))
#define Wq ((bf16*)(wsl + WS_WQ))
#define Wkv ((bf16*)(wsl + WS_WKV))
#define Wout ((bf16*)(wsl + WS_WOUT))
#define Wug ((bf16*)(wsl + WS_WUG))
#define Wdn ((bf16*)(wsl + WS_WDN))
#define W1t ((bf16*)(wsl + WS_W1T))
#define W2t ((bf16*)(wsl + WS_W2T))
#define bufA ((bf16*)(wsl + WS_A))
#define bufB ((bf16*)(wsl + WS_B))
#define qlat ((bf16*)(wsl + WS_QLAT))
#define kvlat ((bf16*)(wsl + WS_KVLAT))
#define krope ((bf16*)(wsl + WS_KROPE))
#define gact ((bf16*)(wsl + WS_GACT))
#define hup ((bf16*)(wsl + WS_HUP))
#define hgate ((bf16*)(wsl + WS_HGATE))
#define X ((bf16*)(outl + OUT_X))
#define kvb ((bf16*)(outl + OUT_KV))
#define vtb ((bf16*)(outl + OUT_KV) + (size_t)T * 2048)
#define xoutf ((float*)outl)
    for (int u = threadIdx.x; u < (LDS_BYTES - LDSCTL_OFF) / 4; u += NWAVES * 64) ((LAS unsigned*)(ldsb + LDSCTL_OFF))[u] = 0u;
    __syncthreads();
    XcdBarrier bar = xcd_barrier_post((unsigned*)(ctl + CW_BAR), MISC + 8);
    const int lo = args.ph_lo, hi = args.ph_hi;
#ifndef PHMASK
#define PHMASK 0xfffffffu
#endif
#define IN(k) (((PHMASK >> ((k) < 9 ? (k) : ((k) >= 18 ? 12 : 9 + ((k) - 9) % 3))) & 1u) && lo <= (k) && (k) < hi)
#define SEAM(k) do { if (IN(k) && IN((k) + 1)) xcd_barrier(bar); } while (0)

#pragma unroll 1
    for (int rep = 0; rep < PROBE_P0; ++rep)
    if (IN(0)) {
        PHB;
        if (rep) __syncthreads();
        if (vcu < 128) ssm_weights_group(vcu, args.in[4], args.in[5], args.in[6], args.in[7], args.in[8], args.in[9], args.in[10], args.in[11], W1t, W2t, (LAS float*)ldsb, tid);
        LAS float* scr = (LAS float*)(ldsb + wave * 16384);
        constexpr int I_IN = 64 * 55, I_GLU = 32 * 32, I_Q = 14 * 48, I_KV = 8 * 64, I_OUT = 64 * 64, I_UP = 64 * 172, I_DN = 172 * 64;
        constexpr int NITEMS = I_IN + I_GLU + I_Q + I_KV + I_OUT + 2 * I_UP + I_DN;
#ifndef PROBE_TR
#define PROBE_TR 1
#endif
#ifndef PROBE_X
#define PROBE_X 1
#endif
        for (int it2 = gw; it2 < PROBE_TR * NITEMS; it2 += NGW) { const int it = it2 % NITEMS;
            int r = it;
            if (r < I_IN) { transpose_item(args.in[2], 4096, 3520, Wi, args.in[3], args.in[3], 4096, RmWin(), scr, r, lane); continue; } r -= I_IN;
            if (r < I_GLU) { transpose_item(args.in[12], 2048, 2048, Wglu, nullptr, nullptr, 0, RmId(), scr, r, lane); continue; } r -= I_GLU;
            if (r < I_Q) { transpose_item(args.in[14], 896, 3072, Wq, args.in[13], args.in[13], 896, RmQ(), scr, r, lane); continue; } r -= I_Q;
            if (r < I_KV) { transpose_item(args.in[16], 512, 4096, Wkv, args.in[15], args.in[15], 512, RmKV(), scr, r, lane); continue; } r -= I_KV;
            if (r < I_OUT) { transpose_item(args.in[19], 4096, 4096, Wout, args.in[17], args.in[18], 2048, RmId(), scr, r, lane); continue; } r -= I_OUT;
            if (r < I_UP) { transpose_item(args.in[21], 4096, 11008, Wug, args.in[20], args.in[20], 4096, RmUp(), scr, r, lane); continue; } r -= I_UP;
            if (r < I_UP) { transpose_item(args.in[22], 4096, 11008, Wug, args.in[20], args.in[20], 4096, RmGate(), scr, r, lane); continue; } r -= I_UP;
            transpose_item(args.in[25], 11008, 4096, Wdn, nullptr, nullptr, 0, RmId(), scr, r, lane);
        }
        for (int i = gt; i < 320 * 512; i += NGT) { const int rr = i >> 9, c8 = (i & 511) * 8; const int row = rr < 128 ? 2944 + rr : 3648 + (rr - 128);
            *(GAS v4u*)(Wi + (size_t)row * 4096 + c8) = (v4u){0u, 0u, 0u, 0u}; }
        for (int m2 = gw; m2 < PROBE_X * T; m2 += NGW) { const int m = m2 % T; const float* xr = m < 16384 ? x_p + (size_t)m * DM : x_s + (size_t)(m - 16384) * DM;
            f32x4 v[16]; float s = 0.f;
#pragma unroll
            for (int j = 0; j < 16; ++j) { v[j] = *((const GAS f32x4*)xr + lane + 64 * j); s += (v[j].x * v[j].x + v[j].y * v[j].y) + (v[j].z * v[j].z + v[j].w * v[j].w); }
            s = wave_sum(s); if (lane == 0) rstd_x[m] = 1.0f / sqrtf(s * (1.0f / DM) + EPS);
            GAS v2u* o8 = (GAS v2u*)(bufA + (size_t)m * DM) + lane;
#pragma unroll
            for (int j = 0; j < 16; ++j) o8[64 * j] = (v2u){pg8::cvt_pk_bf16(v[j].x, v[j].y), pg8::cvt_pk_bf16(v[j].z, v[j].w)}; }
        for (int i = gt; i < 8192 * 32; i += NGT) { const int pos = i >> 5, k = i & 31; const double inv = exp(-(double)k * (9.210340371976184 / 32.0));
            double s, c; sincos_d((double)pos * inv, s, c); *(GAS f32x2*)(ropetab + (size_t)i * 2) = (f32x2){(float)c, (float)s}; }
    }
    SEAM(0);

#pragma unroll 1
    for (int rep = 0; rep < PROBE_P1; ++rep)
    if (IN(1)) {
        PHB;
        pg8::Gemm g{bufA, Wi, DM, DM, DM}; pg8::StaticOrder S; S.init(T, 3840, G, bx);
        pg8::EpiWin E{rstd_x, X, qlat, kvlat, krope, stQ, stKV, ropetab};
        pg8::gemm_phase(ldsb, g, S, E, tid);
    }
    SEAM(1);

    if (IN(2)) {
        PHB;
        pg8::Gemm g{X + 256, W1t, 512, 256, 256}; pg8::GroupOrder S{768, 6, G, bx};
        pg8::EpiSsm1 E{X};
        pg8::gemm_phase(ldsb, g, S, E, tid);
        for (int r = gt; r < T; r += NGT) { float s = 0.f;
#pragma unroll
            for (int j = 0; j < 4; ++j) { const f32x4 v = *(const GAS f32x4*)(stQ + (size_t)r * 16 + 4 * j); s += (v.x + v.y) + (v.z + v.w); }
            rstd_q[r] = 1.0f / sqrtf(s * (1.0f / QLAT) + EPS); float s2 = 0.f;
#pragma unroll
            for (int j = 0; j < 2; ++j) { const f32x4 v = *(const GAS f32x4*)(stKV + (size_t)r * 8 + 4 * j); s2 += (v.x + v.y) + (v.z + v.w); }
            rstd_kv[r] = 1.0f / sqrtf(s2 * (1.0f / KVLAT) + EPS); }
    }
    SEAM(2);

    if (IN(3)) {
        PHB;
        const bool scan_cu = (G == 256) ? ((vcu & 1) == 0) : true;
        if (G == 256 ? scan_cu : (wave < 4)) { const int task = (G == 256) ? (vcu >> 1) * 8 + wave : vcu * 4 + wave;
            if (task < 1024) { const int seq = task >> 8, g = (task >> 1) & 127, dir = task & 1, p = lane;
                const int c0 = seq < 2 ? seq * 512 : 1024 + (seq - 2) * 256, nc = seq < 2 ? 512 : 256;
                const double dt = exp((double)args.in[10][dir * 128 + g]); const double are = args.in[4][(dir * 128 + g) * 64 + p], aim = args.in[5][(dir * 128 + g) * 64 + p];
                const double mag = exp(16.0 * dt * are); double sn, cs; sincos_d(16.0 * dt * aim, sn, cs);
                const float ar = (float)(mag * cs), ai = (float)(mag * sn);
                GAS bf16* Xg = (GAS bf16*)X + (size_t)g * NCHUNK * 512 + dir * 128 + p;
                float zr = 0.f, zi = 0.f;
                for (int cb = 0; cb < nc; cb += 16) {
                    unsigned short sre[16], sim[16];
#pragma unroll
                    for (int i = 0; i < 16; ++i) { const int c = dir ? (c0 + nc - 1 - (cb + i)) : (c0 + cb + i); sre[i] = Xg[(size_t)c * 512]; sim[i] = Xg[(size_t)c * 512 + 64]; }
#pragma unroll
                    for (int i = 0; i < 16; ++i) { const int c = dir ? (c0 + nc - 1 - (cb + i)) : (c0 + cb + i);
                        Xg[(size_t)c * 512] = (bf16)f2bf(zr); Xg[(size_t)c * 512 + 64] = (bf16)f2bf(zi);
                        const float sr = bf2f(sre[i]), si = bf2f(sim[i]); const float nr = ar * zr - ai * zi + sr, ni = ar * zi + ai * zr + si; zr = nr; zi = ni; }
                }
            }
        }
        __syncthreads();
        if (G == 256) { pg8::Gemm g{qlat, Wq, QLAT, QLAT, QLAT}; pg8::RangeOrder S{scan_cu ? (vcu >> 1) * 3 : 384 + (vcu >> 1) * 6, scan_cu ? 3 : 6, 12}; pg8::EpiQ E{rstd_q, bufA, ropetab}; pg8::gemm_phase(ldsb, g, S, E, tid); }
        else { pg8::Gemm g{qlat, Wq, QLAT, QLAT, QLAT}; pg8::StaticOrder S; S.init(T, QW, G, bx); pg8::EpiQ E{rstd_q, bufA, ropetab}; pg8::gemm_phase(ldsb, g, S, E, tid); }
        { pg8::Gemm g{kvlat, Wkv, KVLAT, KVLAT, KVLAT}; pg8::StaticOrder S; S.init(T, 2048, G, bx); pg8::EpiKV E{rstd_kv, kvb}; pg8::gemm_phase(ldsb, g, S, E, tid); }
        { pg8::Gemm g{Wkv + (size_t)2048 * KVLAT, kvlat, KVLAT, KVLAT, KVLAT}; pg8::StaticOrder S; S.init(2048, T, G, bx); pg8::EpiVT E{rstd_kv, vtb}; pg8::gemm_phase(ldsb, g, S, E, tid); }
    }
    SEAM(3);

    if (IN(4)) {
        PHB;
        pg8::Gemm g{X, W2t, 512, 512, 512}; pg8::GroupOrder S{768, 6, G, bx};
        pg8::EpiSsm2 E{gact};
        pg8::gemm_phase(ldsb, g, S, E, tid);
    }
    SEAM(4);

    if (IN(5)) {
        PHB;
#ifndef NO_GLU
        { pg8::Gemm g{gact, Wglu, MIXW, MIXW, MIXW}; pg8::StaticOrder S; S.init(T, MIXW, G, bx); pg8::EpiGlu E{gact, bufB, stA}; pg8::gemm_phase(ldsb, g, S, E, tid); }
#endif
#ifndef NO_ATTN
        const int xcd = vcu >> 5, cc = vcu & 31; const int nun = (G == 256) ? 6 : (1536 - bx + G - 1) / G;
#pragma unroll 1
        for (int i = 0; i < nun; ++i) {
            int bh, qb, seq, rowbase;
            if (G == 256) { if (i < 4) { bh = xcd * 4 + i; qb = cc; seq = 8192; } else { bh = xcd * 4 + 2 * (i - 4) + (cc >> 4); qb = cc & 15; seq = 4096; } }
            else { const int uidx = bx + i * G; if (uidx < 1024) { bh = uidx >> 5; qb = uidx & 31; seq = 8192; } else { const int v = uidx - 1024; bh = v >> 4; qb = v & 15; seq = 4096; } }
            const int b = bh >> 4, h = bh & 15; rowbase = (seq == 8192) ? b * 8192 : 16384 + b * 4096;
            __syncthreads();
            attn::attn_unit(bufA + (size_t)(rowbase + qb * 256) * QW + h * 192, kvb + (size_t)rowbase * 2048 + h * 128, vtb + (size_t)(h * 128) * T,
                            krope + (size_t)rowbase * 64, bufB + (size_t)(rowbase + qb * 256) * DM + 2048 + h * 128, stB + (size_t)(rowbase + qb * 256) * 16 + h, seq, rowbase, (char*)lds, wave0);
        }
#endif
    }
    SEAM(5);

    if (IN(6)) {
        PHB;
        for (int r = gt; r < T; r += NGT) { float s = 0.f;
#pragma unroll
            for (int j = 0; j < 8; ++j) { const f32x4 v = *(const GAS f32x4*)(stA + (size_t)r * 32 + 4 * j); s += (v.x + v.y) + (v.z + v.w); }
            const float r1 = 1.0f / sqrtf(s * (1.0f / MIXW) + EPS); float s2 = 0.f;
#pragma unroll
            for (int j = 0; j < 4; ++j) { const f32x4 v = *(const GAS f32x4*)(stB + (size_t)r * 16 + 4 * j); s2 += (v.x + v.y) + (v.z + v.w); }
            const float r2 = 1.0f / sqrtf(s2 * (1.0f / MIXW) + EPS); r2v[r] = r2; ratio[r] = r1 / r2; }
    }
    SEAM(6);

#pragma unroll 1
    for (int rep = 0; rep < PROBE_P7; ++rep)
    if (IN(7)) {
        PHB;
        pg8::Gemm g{bufB, Wout, DM, DM, DM}; pg8::StaticOrder S; S.init(T, DM, G, bx);
        pg8::EpiWout E{x_p, x_s, r2v, ratio, bufA, stA};
        pg8::gemm_phase(ldsb, g, S, E, tid);
    }
    SEAM(7);

    if (IN(8)) {
        PHB;
        for (int r = gt; r < T; r += NGT) { float s = 0.f;
#pragma unroll
            for (int j = 0; j < 16; ++j) { const f32x4 v = *(const GAS f32x4*)(stA + (size_t)r * 64 + 4 * j); s += (v.x + v.y) + (v.z + v.w); }
            rstd_x1[r] = 1.0f / sqrtf(s * (1.0f / DM) + EPS); }
    }
    SEAM(8);

#ifdef PROBE_DOWN
    if (IN(9)) { PHB;
#pragma unroll 1
        for (int ch = 0; ch < 3; ++ch) { pg8::Gemm g{bufB, Wdn, DFF, DFF, DFF}; pg8::StaticOrder S; S.init(8192, DM, G, bx); pg8::EpiNull E0; pg8::gemm_phase(ldsb, g, S, E0, tid); }
    }
#endif
#ifdef PROBE_KLOOP
    if (IN(9)) {
        PHB;
#pragma unroll 1
        for (int ch = 0; ch < 3; ++ch) { pg8::Gemm g{bufA + (size_t)(ch * 8192) * DM, Wug, DM, DM, DM}; pg8::StaticOrder S; S.init(8192, 2 * DFF, G, bx); pg8::EpiNull E0; pg8::gemm_phase(ldsb, g, S, E0, tid); }
    }
#endif
#pragma unroll 1
    for (int ch2 = 0; ch2 < 3 * PROBE_FA; ++ch2) {
        const int ch = ch2 / PROBE_FA; const bool lastrep = (ch2 % PROBE_FA) == PROBE_FA - 1;
        const int rb = ch * 8192;
        if (IN(9 + 3 * ch)) {
        PHB;
            pg8::Gemm g{bufA + (size_t)rb * DM, Wug, DM, DM, DM}; pg8::StaticOrder S; S.init(8192, 2 * DFF, G, bx);
            pg8::EpiFfnA E{rstd_x1, rb, bufB, hup, hgate, args.in[23], args.in[24]};
            pg8::gemm_phase(ldsb, g, S, E, tid);
        }
        SEAM(9 + 3 * ch);
        if (lastrep && IN(10 + 3 * ch)) {
        PHB;
            const float* cw = args.in[23]; const float* cb = args.in[24];
            for (int i = gt; i < 128 * 2 * (DFF / 8); i += NGT) { const int f0 = (i % (DFF / 8)) * 8, sw = i / (DFF / 8), strip = sw >> 1, which = sw & 1;
                const int lrow = strip * 64 + (which ? 63 : 0), grow = rb + lrow, pos = pos_of(grow), len = len_of(grow);
                v4u up0, up1, up2;
                if (which == 0) { up1 = *(const GAS v4u*)(hup + ((size_t)strip * 4 + 0) * DFF + f0); up2 = *(const GAS v4u*)(hup + ((size_t)strip * 4 + 1) * DFF + f0);
                    up0 = (pos == 0) ? (v4u){0u, 0u, 0u, 0u} : *(const GAS v4u*)(hup + ((size_t)(strip - 1) * 4 + 3) * DFF + f0); }
                else { up0 = *(const GAS v4u*)(hup + ((size_t)strip * 4 + 2) * DFF + f0); up1 = *(const GAS v4u*)(hup + ((size_t)strip * 4 + 3) * DFF + f0);
                    up2 = (pos == len - 1) ? (v4u){0u, 0u, 0u, 0u} : *(const GAS v4u*)(hup + ((size_t)(strip + 1) * 4 + 0) * DFF + f0); }
                const v4u gt4 = *(const GAS v4u*)(hgate + ((size_t)strip * 2 + which) * DFF + f0);
                unsigned ow[4];
#pragma unroll
                for (int k = 0; k < 4; ++k) { const int f = f0 + 2 * k;
                    const float a0 = bflo(up0[k]), a1 = bflo(up1[k]), a2 = bflo(up2[k]), b0 = bfhi(up0[k]), b1 = bfhi(up1[k]), b2 = bfhi(up2[k]);
                    const float c0 = cw[f] * a0 + cw[DFF + f] * a1 + cw[2 * DFF + f] * a2 + cb[f], c1 = cw[f + 1] * b0 + cw[DFF + f + 1] * b1 + cw[2 * DFF + f + 1] * b2 + cb[f + 1];
                    ow[k] = pk2(c0 * sigmoidf_fast(c0) * bflo(gt4[k]), c1 * sigmoidf_fast(c1) * bfhi(gt4[k])); }
                *(GAS v4u*)(bufB + (size_t)lrow * DFF + f0) = (v4u){ow[0], ow[1], ow[2], ow[3]}; }
        }
        if (lastrep) SEAM(10 + 3 * ch);
        if (lastrep && IN(11 + 3 * ch)) {
        PHB;
            pg8::Gemm g{bufB, Wdn, DFF, DFF, DFF}; pg8::StaticOrder S; S.init(8192, DM, G, bx);
            pg8::EpiDown E{bufA, rb, stA};
            pg8::gemm_phase(ldsb, g, S, E, tid);
        }
        if (lastrep) SEAM(11 + 3 * ch);
    }

    if (IN(18)) {
        PHB;
        const float* gf = args.in[26];
        for (int m = gw; m < T; m += NGW) { const float s = wave_sum(stA[(size_t)m * 64 + lane]); const float rs = 1.0f / sqrtf(s * (1.0f / DM) + EPS);
            const GAS v4u* xr = (const GAS v4u*)(bufA + (size_t)m * DM) + lane; GAS f32x4* orow = (GAS f32x4*)(xoutf + (size_t)m * DM) + 2 * lane; const GAS f32x4* gr = (const GAS f32x4*)gf + 2 * lane;
#pragma unroll
            for (int j = 0; j < 8; ++j) { const v4u w = xr[64 * j]; const f32x4 g0 = gr[128 * j], g1 = gr[128 * j + 1];
                orow[128 * j] = (f32x4){bflo(w.x) * rs * g0[0], bfhi(w.x) * rs * g0[1], bflo(w.y) * rs * g0[2], bfhi(w.y) * rs * g0[3]};
                orow[128 * j + 1] = (f32x4){bflo(w.z) * rs * g1[0], bfhi(w.z) * rs * g1[1], bflo(w.w) * rs * g1[2], bfhi(w.w) * rs * g1[3]}; } }
    }
#undef IN
#undef SEAM
}

constexpr int N_PHASES = 19;
extern "C" void kernel_launch(void* const* d_in, const int* in_sizes, int n_in, void* d_out, int out_size, void* d_ws, size_t ws_size, hipStream_t stream) {
    static int grid = 0;
    if (grid == 0) {
        if (n_in != 27 || out_size != T * DM || ws_size < WS_END) { fprintf(stderr, "kernel_launch: unexpected shapes (n_in %d out %d ws %zu)\n", n_in, out_size, ws_size); grid = -1; return; }
        int dev = 0, cus = 0, per_cu = 0;
        if (hipGetDevice(&dev) != hipSuccess || hipDeviceGetAttribute(&cus, hipDeviceAttributeMultiprocessorCount, dev) != hipSuccess) { grid = -1; return; }
        if (hipFuncSetAttribute((const void*)enc_fwd, hipFuncAttributeMaxDynamicSharedMemorySize, LDS_BYTES) != hipSuccess) { fprintf(stderr, "kernel_launch: hipFuncSetAttribute failed\n"); grid = -1; return; }
        if (hipOccupancyMaxActiveBlocksPerMultiprocessor(&per_cu, (const void*)enc_fwd, NWAVES * 64, LDS_BYTES) != hipSuccess || per_cu < 1) { fprintf(stderr, "kernel_launch: occupancy query says %d\n", per_cu); }
        (void)hipGetLastError();
        grid = cus;
    }
    if (grid < 0) return;
    if (hipMemsetAsync((char*)d_ws + WS_CTL, 0, CTL_ZERO_BYTES, stream) != hipSuccess) return;
    Args a{};
    for (int i = 0; i < 27; ++i) a.in[i] = (const float*)d_in[i];
    a.out = (float*)d_out; a.ws = (unsigned char*)d_ws;
#ifndef MK_N_LAUNCHES
#define MK_N_LAUNCHES 1
#endif
    if (MK_N_LAUNCHES == 1) { a.ph_lo = 0; a.ph_hi = N_PHASES; hipLaunchKernelGGL(enc_fwd, dim3(grid), dim3(NWAVES * 64), LDS_BYTES, stream, a); }
    else { for (int p = 0; p < N_PHASES; ++p) { a.ph_lo = p; a.ph_hi = p + 1; hipLaunchKernelGGL(enc_fwd, dim3(grid), dim3(NWAVES * 64), LDS_BYTES, stream, a); } }
    const hipError_t le = hipPeekAtLastError();
    if (le != hipSuccess) fprintf(stderr, "kernel_launch: launch failed: %s\n", hipGetErrorName(le));
}
```

```cpp
#include <hip/hip_runtime.h>
#include <hip/hip_bf16.h>
#include <cstdio>
#include <cstdint>

namespace pg8 {
#define PG8_LAS __attribute__((address_space(3)))
typedef unsigned short bf16_t;
typedef short bf16x8 __attribute__((ext_vector_type(8)));
typedef float f32x4 __attribute__((ext_vector_type(4)));
typedef float f32x2 __attribute__((ext_vector_type(2)));
typedef unsigned u32x4 __attribute__((ext_vector_type(4)));
typedef unsigned u32x2 __attribute__((ext_vector_type(2)));
constexpr int BM = 256, BK = 64, HALF = 128, HTB = HALF * BK * 2  , STAGE_BYTES = 8 * HTB, NXCD = 8, WGM = 8;

__host__ __device__ __forceinline__ int lds_byte(int r, int c) { const int st = (r >> 4) * 2 + (c >> 5), rr = r & 15, cc = c & 31, ob = rr * 64 + cc * 2; return st * 1024 + (ob ^ (((ob >> 9) & 1) << 5)); }
__host__ __device__ __forceinline__ void stage_rc(int b, int& R, int& C) { const int st = b / 1024, sb = b % 1024, swz = sb ^ (((sb >> 9) & 1) << 5); R = (st >> 1) * 16 + swz / 64; C = (st & 1) * 32 + (swz % 64) / 2; }
__host__ __device__ __forceinline__ int perm32(int rho) { const int n = rho >> 4, i = rho & 15; return 8 * (i >> 2) + 4 * n + (i & 3); }

struct Unit { int pm, pn; };
struct Gemm { const bf16_t* A; const bf16_t* Bt; int lda, ldb, K; };

struct StaticOrder {
    int nM, nN, nwg, G, c;
    __host__ __device__ void init(int M, int N, int G_, int c_) { nM = M / BM; nN = N / BM; nwg = nM * nN; G = G_; c = c_; }
    __host__ __device__ bool next(int i, Unit& u) const {
        const long L = (long)i * G + c; if (L >= nwg) return false;
        int wgid = (int)L; { const int q = nwg / NXCD, r = nwg % NXCD, xcd = wgid % NXCD, off = wgid / NXCD; wgid = (xcd < r ? xcd * (q + 1) : r * (q + 1) + (xcd - r) * q) + off; }
        const int nig = WGM * nN, gid = wgid / nig, fm = gid * WGM, gsz = (nM - fm) < WGM ? (nM - fm) : WGM;
        u.pm = fm + ((wgid % nig) % gsz); u.pn = (wgid % nig) / gsz; return true;
    }
};
struct ZeroOrder { int n, G, c; __host__ __device__ bool next(int i, Unit& u) const { const long L = (long)i * G + c; if (L >= n) return false; u.pm = 0; u.pn = 0; return true; } };
struct RangeOrder { int base, n, nN; __host__ __device__ bool next(int i, Unit& u) const { if (i >= n) return false; const int L = base + i; u.pm = L / nN; u.pn = L % nN; return true; } };
struct GroupOrder {
    int n, per, G, c;
    __host__ __device__ bool next(int i, Unit& u) const { const long L = (long)i * G + c; if (L >= n) return false; u.pm = (int)L; u.pn = (int)L / per; return true; }
};

__device__ __forceinline__ unsigned cvt_pk_bf16(float lo, float hi) { unsigned r; asm volatile("v_cvt_pk_bf16_f32 %0, %1, %2" : "=v"(r) : "v"(lo), "v"(hi)); return r; }
__device__ __forceinline__ u32x4 pack8(const f32x4 a, const f32x4 b) { u32x4 w; w.x = cvt_pk_bf16(a[0], a[1]); w.y = cvt_pk_bf16(a[2], a[3]); w.z = cvt_pk_bf16(b[0], b[1]); w.w = cvt_pk_bf16(b[2], b[3]); return w; }

template <class Epi, class Sched>
__device__ __forceinline__ void gemm_phase(PG8_LAS unsigned char* lds, const Gemm g, const Sched& S, const Epi& E, int tid_in) {
    int tid_l = tid_in; asm volatile("" : "+v"(tid_l));
    const int tid = tid_l, wid = __builtin_amdgcn_readfirstlane(tid >> 6), lane = tid & 63, wr = wid >> 2, wc = wid & 3, fr = lane & 15, fq = lane >> 4;
    const int K = g.K, nt = K / BK;
    unsigned voffA[2], voffB[2];
#pragma unroll
    for (int i = 0; i < 2; ++i) { int R, C; stage_rc(tid * 16 + i * 8192, R, C); const int Rb = Epi::PERM ? ((R & ~31) + perm32(R & 31)) : R;
        voffA[i] = (unsigned)(R * g.lda + C) * 2u; voffB[i] = (unsigned)(Rb * g.ldb + C) * 2u; }
    asm volatile("" : "+v"(voffA[0]), "+v"(voffA[1]), "+v"(voffB[0]), "+v"(voffB[1]));
    const size_t kstep = (size_t)(BK * 2);
    const size_t hstepA = (size_t)HALF * g.lda * 2, hstepB = (size_t)HALF * g.ldb * 2;
    const size_t tstepA = 2 * hstepA, tstepB = 2 * hstepB;
    const unsigned ldsw = (unsigned)wid * 1024u;
    const int aoff = lds_byte(wr * 64 + fr, fq * 8), boff = lds_byte(wc * 32 + fr, fq * 8);
#define PG8_SA(b, h) (((b) * 2 + (h)) * HTB)
#define PG8_SB(b, h) ((4 + (b) * 2 + (h)) * HTB)
#define PG8_STAGE(bufoff, gbase, voff) do { _Pragma("unroll") for (int _i = 0; _i < 2; ++_i) \
        __builtin_amdgcn_global_load_lds((const unsigned*)((const char*)(gbase) + (voff)[_i]), (PG8_LAS unsigned*)(lds + (bufoff) + ldsw + _i * 8192), 16, 0, 0); } while (0)
#define PG8_LDA(dst, b, h) do { _Pragma("unroll") for (int m = 0; m < 4; ++m) _Pragma("unroll") for (int k = 0; k < 2; ++k) dst[m][k] = *(const PG8_LAS bf16x8*)(lds + PG8_SA(b, h) + aoff + m * 2048 + k * 1024); } while (0)
#define PG8_LDB(dst, b, h) do { _Pragma("unroll") for (int n = 0; n < 2; ++n) _Pragma("unroll") for (int k = 0; k < 2; ++k) dst[n][k] = *(const PG8_LAS bf16x8*)(lds + PG8_SB(b, h) + boff + n * 2048 + k * 1024); } while (0)
#define PG8_MMA(ai, bj, At, Bt) do { __builtin_amdgcn_s_setprio(1); _Pragma("unroll") for (int m = 0; m < 4; ++m) _Pragma("unroll") for (int n = 0; n < 2; ++n) _Pragma("unroll") for (int k = 0; k < 2; ++k) \
        acc[ai][bj][m][n] = __builtin_amdgcn_mfma_f32_16x16x32_bf16(Bt[n][k], At[m][k], acc[ai][bj][m][n], 0, 0, 0); __builtin_amdgcn_s_setprio(0); } while (0)
#define PG8_WAIT_V(n) asm volatile("s_waitcnt vmcnt(" #n ")" ::: "memory")
#define PG8_WAIT_L(n) asm volatile("s_waitcnt lgkmcnt(" #n ")" ::: "memory")
#define PG8_BAR __builtin_amdgcn_s_barrier()
#define PG8_SCHED __builtin_amdgcn_sched_barrier(0)
    Unit cur, nxt; int ui = 0;
    if (!S.next(0, cur)) return;
    f32x4 acc[2][2][4][2];
#pragma unroll
    for (int a = 0; a < 2; ++a)
#pragma unroll
        for (int b = 0; b < 2; ++b)
#pragma unroll
            for (int m = 0; m < 4; ++m)
#pragma unroll
                for (int n = 0; n < 2; ++n) acc[a][b][m][n] = (f32x4){0.f, 0.f, 0.f, 0.f};
    bf16x8 At[4][2], B0[2][2], B1[2][2];
    const char* cA = (const char*)g.A + (size_t)cur.pm * tstepA; const char* cB = (const char*)g.Bt + (size_t)cur.pn * tstepB;
    PG8_STAGE(PG8_SB(0, 0), cB, voffB); PG8_STAGE(PG8_SB(0, 1), cB + hstepB, voffB); PG8_STAGE(PG8_SA(0, 0), cA, voffA); PG8_STAGE(PG8_SA(0, 1), cA + hstepA, voffA);
    if (wr == 1) PG8_BAR;
    PG8_WAIT_V(2); PG8_BAR;
    PG8_STAGE(PG8_SB(1, 0), cB + kstep, voffB); PG8_STAGE(PG8_SA(1, 0), cA + kstep, voffA); PG8_STAGE(PG8_SB(1, 1), cB + hstepB + kstep, voffB);
    PG8_WAIT_V(6); PG8_BAR;
    for (;;) {
        const bool has_next = S.next(ui + 1, nxt);
        const char* nA = has_next ? (const char*)g.A + (size_t)nxt.pm * tstepA : cA; const char* nB = has_next ? (const char*)g.Bt + (size_t)nxt.pn * tstepB : cB;
#pragma unroll 1
        for (int t = 0; t < nt; t += 2) {
            const bool last = (t == nt - 2);
            if constexpr (Epi::MIDK) { if (t == (nt >> 1)) E.midk(acc, cur, wr, fr); }
            const char* a1 = cA + (size_t)(t + 1) * kstep;
            const char* a2 = last ? nA : cA + (size_t)(t + 2) * kstep; const char* b2 = last ? nB : cB + (size_t)(t + 2) * kstep;
            const char* a3 = a2 + kstep; const char* b3 = b2 + kstep;
            PG8_LDB(B0, 0, 0); PG8_LDB(B1, 0, 1); PG8_SCHED; PG8_LDA(At, 0, 0); PG8_STAGE(PG8_SA(1, 1), a1 + hstepA, voffA);
            PG8_WAIT_V(8); PG8_WAIT_L(0); PG8_BAR; PG8_MMA(0, 0, At, B0); PG8_MMA(0, 1, At, B1); PG8_BAR; PG8_SCHED;
            PG8_LDA(At, 0, 1); PG8_STAGE(PG8_SB(0, 0), b2, voffB); PG8_STAGE(PG8_SB(0, 1), b2 + hstepB, voffB); PG8_STAGE(PG8_SA(0, 0), a2, voffA);
            PG8_WAIT_V(8); PG8_WAIT_L(0); PG8_BAR; PG8_MMA(1, 0, At, B0); PG8_MMA(1, 1, At, B1); PG8_BAR; PG8_SCHED;
            PG8_LDB(B0, 1, 0); PG8_LDB(B1, 1, 1); PG8_SCHED; PG8_LDA(At, 1, 0); PG8_STAGE(PG8_SA(0, 1), a2 + hstepA, voffA);
            PG8_WAIT_V(8); PG8_WAIT_L(0); PG8_BAR; PG8_MMA(0, 0, At, B0); PG8_MMA(0, 1, At, B1); PG8_BAR; PG8_SCHED;
            PG8_LDA(At, 1, 1); PG8_STAGE(PG8_SB(1, 0), b3, voffB); PG8_STAGE(PG8_SB(1, 1), b3 + hstepB, voffB); PG8_STAGE(PG8_SA(1, 0), a3, voffA);
            PG8_WAIT_V(8); PG8_WAIT_L(0); PG8_BAR; PG8_MMA(1, 0, At, B0); PG8_MMA(1, 1, At, B1); PG8_BAR; PG8_SCHED;
        }
        if (wr == 0) PG8_BAR;
        E(acc, cur, wr, wc, fr, fq);
        if (!has_next) break;
#pragma unroll
        for (int a = 0; a < 2; ++a)
#pragma unroll
            for (int b = 0; b < 2; ++b)
#pragma unroll
                for (int m = 0; m < 4; ++m)
#pragma unroll
                    for (int n = 0; n < 2; ++n) acc[a][b][m][n] = (f32x4){0.f, 0.f, 0.f, 0.f};
        cur = nxt; cA = nA; cB = nB; ++ui;
        if (wr == 1) PG8_BAR;
    }
    PG8_WAIT_V(0);
    PG8_BAR;
#undef PG8_SA
#undef PG8_SB
#undef PG8_STAGE
#undef PG8_LDA
#undef PG8_LDB
#undef PG8_MMA
#undef PG8_WAIT_V
#undef PG8_WAIT_L
#undef PG8_BAR
#undef PG8_SCHED
}
}

constexpr int T = 24576, DM = 4096, DFF = 11008;
constexpr int NCHUNK = T / 16;
constexpr int QLAT = 896, KVLAT = 512, QW = 3072, KVW = 4096, MIXW = 2048;
constexpr float EPS = 1e-6f;
__device__ __forceinline__ int pos_of(int r) { return r < 16384 ? (r & 8191) : (r & 4095); }
__device__ __forceinline__ int len_of(int r) { return r < 16384 ? 8192 : 4096; }

typedef unsigned short bf16;
#define GAS __attribute__((address_space(1)))
#define LAS __attribute__((address_space(3)))
typedef unsigned v4u __attribute__((ext_vector_type(4)));
typedef unsigned v2u __attribute__((ext_vector_type(2)));
typedef float f32x4 __attribute__((ext_vector_type(4)));
typedef float f32x2 __attribute__((ext_vector_type(2)));
typedef short bf16x8 __attribute__((ext_vector_type(8)));

__device__ __forceinline__ unsigned f2bf(float f) { unsigned u = __builtin_bit_cast(unsigned, f); return (u + 0x7fffu + ((u >> 16) & 1u)) >> 16; }
__device__ __forceinline__ unsigned pk2(float lo, float hi) { return f2bf(lo) | (f2bf(hi) << 16); }
__device__ __forceinline__ float bf2f(unsigned short b) { return __builtin_bit_cast(float, (unsigned)b << 16); }
__device__ __forceinline__ float bflo(unsigned w) { return __builtin_bit_cast(float, w << 16); }
__device__ __forceinline__ float bfhi(unsigned w) { return __builtin_bit_cast(float, w & 0xffff0000u); }
__device__ __forceinline__ float sigmoidf_fast(float x) { return __builtin_amdgcn_rcpf(1.0f + __builtin_amdgcn_exp2f(-1.4426950408889634f * x)); }
__device__ __forceinline__ float gelu_tanh(float y) { const float in = 1.5957691216057308f * (y + 0.044715f * y * y * y); return y * sigmoidf_fast(in); }

namespace pg8 {
#define EPI_ROWS const int row0 = u.pm * 256 + wr * 64 + fr
__device__ __forceinline__ float sq8(const f32x4 a, const f32x4 b) { return (a[0] * a[0] + a[1] * a[1]) + (a[2] * a[2] + a[3] * a[3]) + (b[0] * b[0] + b[1] * b[1]) + (b[2] * b[2] + b[3] * b[3]); }
__device__ __forceinline__ float red_fq(float s) { s += __shfl_xor(s, 16); s += __shfl_xor(s, 32); return s; }

__device__ __forceinline__ f32x4 rope4(const f32x4 v, const f32x4 cs) { f32x4 o; o[0] = v[0] * cs[0] - v[1] * cs[1]; o[1] = v[1] * cs[0] + v[0] * cs[1]; o[2] = v[2] * cs[2] - v[3] * cs[3]; o[3] = v[3] * cs[2] + v[2] * cs[3]; return o; }

#define LAUNDER(p) asm volatile("" : "+v"(p))
struct EpiNull { static constexpr bool PERM = true, MIDK = false;
    __device__ __forceinline__ void midk(f32x4 (&)[2][2][4][2], const Unit&, int, int) const {}
    __device__ __forceinline__ void operator()(const f32x4 (&acc)[2][2][4][2], const Unit& u, int wr, int wc, int fr, int fq) const {
#pragma unroll
        for (int ai = 0; ai < 2; ++ai)
#pragma unroll
            for (int bj = 0; bj < 2; ++bj)
                asm volatile("" :: "v"(acc[ai][bj][0][0]), "v"(acc[ai][bj][0][1]), "v"(acc[ai][bj][1][0]), "v"(acc[ai][bj][1][1]), "v"(acc[ai][bj][2][0]), "v"(acc[ai][bj][2][1]), "v"(acc[ai][bj][3][0]), "v"(acc[ai][bj][3][1]));
    } };
struct EpiWin {
    static constexpr bool PERM = true, MIDK = false;
    const float* rstd_x; bf16_t* X; bf16_t* qlat; bf16_t* kvlat; bf16_t* krope; float* stQ; float* stKV; const float* ropetab;
    __device__ __forceinline__ void midk(f32x4 (&)[2][2][4][2], const Unit&, int, int) const {}
    __device__ __forceinline__ void operator()(const f32x4 (&acc)[2][2][4][2], const Unit& u, int wr, int wc, int fr, int fq) const {
        EPI_ROWS; const int tile = u.pn;
        const GAS float* rsp = (const GAS float*)(rstd_x + row0); LAUNDER(rsp);
        if (tile < 8) {
            const int c0 = tile * 256 + wc * 32 + 8 * fq;
            GAS bf16_t* xp0 = (GAS bf16_t*)X + ((size_t)((c0 >> 4) * NCHUNK + (row0 >> 4)) * 512 + 256 + (row0 & 15) * 16 + (c0 & 15)); LAUNDER(xp0);
#pragma unroll
            for (int ai = 0; ai < 2; ++ai)
#pragma unroll
                for (int m = 0; m < 4; ++m) { const float rs = rsp[ai * 128 + m * 16];
#pragma unroll
                    for (int bj = 0; bj < 2; ++bj)
                        *(GAS u32x4*)(xp0 + ((size_t)(bj * 8) * NCHUNK + ai * 8 + m) * 512) = pack8(acc[ai][bj][m][0] * rs, acc[ai][bj][m][1] * rs); }
        } else if (tile < 14) {
            const bool isq = tile < 12; const int tl = isq ? tile - 8 : tile - 12; const int ld = isq ? QLAT : KVLAT;
            const int c0 = tl * 256 + wc * 32 + 8 * fq;
            GAS bf16_t* op = (GAS bf16_t*)(isq ? qlat : kvlat) + (size_t)row0 * ld + c0; GAS float* sp = (GAS float*)(isq ? stQ + (size_t)row0 * 16 : stKV + (size_t)row0 * 8) + tl * 4 + wc; LAUNDER(op); LAUNDER(sp);
#pragma unroll
            for (int ai = 0; ai < 2; ++ai)
#pragma unroll
                for (int m = 0; m < 4; ++m) { const float rs = rsp[ai * 128 + m * 16]; float ss = 0.f;
#pragma unroll
                    for (int bj = 0; bj < 2; ++bj) { const f32x4 v0 = acc[ai][bj][m][0] * rs, v1 = acc[ai][bj][m][1] * rs; ss += sq8(v0, v1);
                        if (c0 + bj * 128 < ld) *(GAS u32x4*)(op + (size_t)(ai * 128 + m * 16) * ld + bj * 128) = pack8(v0, v1); }
                    ss = red_fq(ss); if (fq == 0) sp[(size_t)(ai * 128 + m * 16) * (isq ? 16 : 8)] = ss; }
        } else {
            if (wc < 2) { const int c = wc * 32 + 8 * fq;
                GAS bf16_t* op = (GAS bf16_t*)krope + (size_t)row0 * 64 + c; LAUNDER(op);
#pragma unroll
                for (int ai = 0; ai < 2; ++ai)
#pragma unroll
                    for (int m = 0; m < 4; ++m) { const int row = row0 + ai * 128 + m * 16; const float rs = rsp[ai * 128 + m * 16]; const int pos = pos_of(row);
                        const f32x4 cs0 = *(const GAS f32x4*)((const GAS float*)ropetab + (size_t)pos * 64 + c), cs1 = *(const GAS f32x4*)((const GAS float*)ropetab + (size_t)pos * 64 + c + 4);
                        const f32x4 v0 = rope4(acc[ai][0][m][0] * rs, cs0), v1 = rope4(acc[ai][0][m][1] * rs, cs1);
                        *(GAS u32x4*)(op + (size_t)(ai * 128 + m * 16) * 64) = pack8(v0, v1); } }
        }
    }
};
struct EpiSsm1 {
    static constexpr bool PERM = true, MIDK = false;
    bf16_t* X;
    __device__ __forceinline__ void midk(f32x4 (&)[2][2][4][2], const Unit&, int, int) const {}
    __device__ __forceinline__ void operator()(const f32x4 (&acc)[2][2][4][2], const Unit& u, int wr, int wc, int fr, int fq) const {
        EPI_ROWS; GAS bf16_t* op = (GAS bf16_t*)X + (size_t)row0 * 512 + wc * 32 + 8 * fq; LAUNDER(op);
#pragma unroll
        for (int ai = 0; ai < 2; ++ai)
#pragma unroll
            for (int m = 0; m < 4; ++m)
#pragma unroll
                for (int bj = 0; bj < 2; ++bj) *(GAS u32x4*)(op + (size_t)(ai * 128 + m * 16) * 512 + bj * 128) = pack8(acc[ai][bj][m][0], acc[ai][bj][m][1]);
    }
};
struct EpiSsm2 {
    static constexpr bool PERM = true, MIDK = false;
    bf16_t* gact;
    __device__ __forceinline__ void midk(f32x4 (&)[2][2][4][2], const Unit&, int, int) const {}
    __device__ __forceinline__ void operator()(const f32x4 (&acc)[2][2][4][2], const Unit& u, int wr, int wc, int fr, int fq) const {
        EPI_ROWS; const int g = u.pn; const int c0 = wc * 32 + 8 * fq;
        GAS bf16_t* op = (GAS bf16_t*)gact + ((size_t)(row0 - g * NCHUNK) * 16 + (c0 >> 4)) * MIXW + g * 16 + (c0 & 15); LAUNDER(op);
#pragma unroll
        for (int ai = 0; ai < 2; ++ai)
#pragma unroll
            for (int m = 0; m < 4; ++m)
#pragma unroll
                for (int bj = 0; bj < 2; ++bj) { f32x4 v0 = acc[ai][bj][m][0], v1 = acc[ai][bj][m][1];
#pragma unroll
                    for (int e = 0; e < 4; ++e) { v0[e] = gelu_tanh(v0[e]); v1[e] = gelu_tanh(v1[e]); }
                    *(GAS u32x4*)(op + ((size_t)(ai * 128 + m * 16) * 16 + bj * 8) * MIXW) = pack8(v0, v1); }
    }
};
struct EpiQ {
    static constexpr bool PERM = true, MIDK = false;
    const float* rstd_q; bf16_t* q; const float* ropetab;
    __device__ __forceinline__ void midk(f32x4 (&)[2][2][4][2], const Unit&, int, int) const {}
    __device__ __forceinline__ void operator()(const f32x4 (&acc)[2][2][4][2], const Unit& u, int wr, int wc, int fr, int fq) const {
        EPI_ROWS; const GAS float* rsp = (const GAS float*)(rstd_q + row0); GAS bf16_t* op = (GAS bf16_t*)q + (size_t)row0 * QW + u.pn * 256 + wc * 32 + 8 * fq; LAUNDER(rsp); LAUNDER(op);
#pragma unroll
        for (int ai = 0; ai < 2; ++ai)
#pragma unroll
            for (int m = 0; m < 4; ++m) { const int row = row0 + ai * 128 + m * 16; const float rs = rsp[ai * 128 + m * 16] * 0.10411754627697264f;     const int pos = pos_of(row);
#pragma unroll
                for (int bj = 0; bj < 2; ++bj) { const int strip = 8 * u.pn + 4 * bj + wc, s6 = strip % 6;
                    f32x4 v0 = acc[ai][bj][m][0] * rs, v1 = acc[ai][bj][m][1] * rs;
                    if (s6 >= 4) { const int pc = (s6 - 4) * 32 + 8 * fq;
                        const f32x4 cs0 = *(const GAS f32x4*)((const GAS float*)ropetab + (size_t)pos * 64 + pc), cs1 = *(const GAS f32x4*)((const GAS float*)ropetab + (size_t)pos * 64 + pc + 4);
                        v0 = rope4(v0, cs0); v1 = rope4(v1, cs1); }
                    *(GAS u32x4*)(op + (size_t)(ai * 128 + m * 16) * QW + bj * 128) = pack8(v0, v1); } }
    }
};
struct EpiKV {
    static constexpr bool PERM = true, MIDK = false;
    const float* rstd_kv; bf16_t* kv;
    __device__ __forceinline__ void midk(f32x4 (&)[2][2][4][2], const Unit&, int, int) const {}
    __device__ __forceinline__ void operator()(const f32x4 (&acc)[2][2][4][2], const Unit& u, int wr, int wc, int fr, int fq) const {
        EPI_ROWS; const GAS float* rsp = (const GAS float*)(rstd_kv + row0); GAS bf16_t* op = (GAS bf16_t*)kv + (size_t)row0 * 2048 + u.pn * 256 + wc * 32 + 8 * fq; LAUNDER(rsp); LAUNDER(op);
#pragma unroll
        for (int ai = 0; ai < 2; ++ai)
#pragma unroll
            for (int m = 0; m < 4; ++m) { const float rs = rsp[ai * 128 + m * 16];
#pragma unroll
                for (int bj = 0; bj < 2; ++bj) *(GAS u32x4*)(op + (size_t)(ai * 128 + m * 16) * 2048 + bj * 128) = pack8(acc[ai][bj][m][0] * rs, acc[ai][bj][m][1] * rs); }
    }
};
struct EpiVT {
    static constexpr bool PERM = true, MIDK = false;
    const float* rstd_kv; bf16_t* vt;
    __device__ __forceinline__ void midk(f32x4 (&)[2][2][4][2], const Unit&, int, int) const {}
    __device__ __forceinline__ void operator()(const f32x4 (&acc)[2][2][4][2], const Unit& u, int wr, int wc, int fr, int fq) const {
        EPI_ROWS; const int c0 = u.pn * 256 + wc * 32 + 8 * fq; const GAS float* rsp = (const GAS float*)(rstd_kv + c0); GAS bf16_t* op = (GAS bf16_t*)vt + (size_t)row0 * T + c0; LAUNDER(rsp); LAUNDER(op);
        GAS bf16_t* opp = op - 8 * fq + 16 * (fq & 1) + 4 * (fq >> 1);
#pragma unroll
        for (int bj = 0; bj < 2; ++bj) { const f32x4 r0 = *(const GAS f32x4*)(rsp + bj * 128), r1 = *(const GAS f32x4*)(rsp + bj * 128 + 4);
#pragma unroll
            for (int ai = 0; ai < 2; ++ai)
#pragma unroll
                for (int m = 0; m < 4; ++m) { const u32x4 w = pack8(acc[ai][bj][m][0] * r0, acc[ai][bj][m][1] * r1); GAS bf16_t* q_ = opp + (size_t)(ai * 128 + m * 16) * T + bj * 128;
                    *(GAS u32x2*)q_ = (u32x2){w.x, w.y}; *(GAS u32x2*)(q_ + 8) = (u32x2){w.z, w.w}; } }
    }
};
struct EpiGlu {
    static constexpr bool PERM = true, MIDK = false;
    const bf16_t* gact; bf16_t* merged; float* stA;
    __device__ __forceinline__ void midk(f32x4 (&)[2][2][4][2], const Unit&, int, int) const {}
    __device__ __forceinline__ void operator()(const f32x4 (&acc)[2][2][4][2], const Unit& u, int wr, int wc, int fr, int fq) const {
        EPI_ROWS; const int c0 = u.pn * 256 + wc * 32 + 8 * fq;
        const GAS bf16_t* gp = (const GAS bf16_t*)gact + (size_t)row0 * MIXW + c0; GAS bf16_t* op = (GAS bf16_t*)merged + (size_t)row0 * DM + c0; GAS float* sp = (GAS float*)stA + (size_t)row0 * 32 + u.pn * 4 + wc; LAUNDER(gp); LAUNDER(op); LAUNDER(sp);
#pragma unroll
        for (int ai = 0; ai < 2; ++ai)
#pragma unroll
            for (int m = 0; m < 4; ++m) { float ss = 0.f;
#pragma unroll
                for (int bj = 0; bj < 2; ++bj) {
                    const u32x4 gw = *(const GAS u32x4*)(gp + (size_t)(ai * 128 + m * 16) * MIXW + bj * 128);
                    f32x4 v0, v1; const f32x4 a0 = acc[ai][bj][m][0], a1 = acc[ai][bj][m][1];
                    v0[0] = bflo(gw.x) * sigmoidf_fast(a0[0]); v0[1] = bfhi(gw.x) * sigmoidf_fast(a0[1]); v0[2] = bflo(gw.y) * sigmoidf_fast(a0[2]); v0[3] = bfhi(gw.y) * sigmoidf_fast(a0[3]);
                    v1[0] = bflo(gw.z) * sigmoidf_fast(a1[0]); v1[1] = bfhi(gw.z) * sigmoidf_fast(a1[1]); v1[2] = bflo(gw.w) * sigmoidf_fast(a1[2]); v1[3] = bfhi(gw.w) * sigmoidf_fast(a1[3]);
                    ss += sq8(v0, v1);
                    *(GAS u32x4*)(op + (size_t)(ai * 128 + m * 16) * DM + bj * 128) = pack8(v0, v1); }
                ss = red_fq(ss); if (fq == 0) sp[(size_t)(ai * 128 + m * 16) * 32] = ss; }
    }
};
struct EpiWout {
    static constexpr bool PERM = true, MIDK = true;
    const float* xp; const float* xs; const float* r2; const float* ratio; bf16_t* x1b; float* stA;
    __device__ __forceinline__ void midk(f32x4 (&acc)[2][2][4][2], const Unit& u, int wr, int fr) const {
        EPI_ROWS; const GAS float* rp = (const GAS float*)(ratio + row0); LAUNDER(rp);
#pragma unroll
        for (int ai = 0; ai < 2; ++ai)
#pragma unroll
            for (int m = 0; m < 4; ++m) { const float rt = rp[ai * 128 + m * 16];
#pragma unroll
                for (int bj = 0; bj < 2; ++bj)
#pragma unroll
                    for (int n = 0; n < 2; ++n) acc[ai][bj][m][n] *= rt; }
    }
    __device__ __forceinline__ void operator()(const f32x4 (&acc)[2][2][4][2], const Unit& u, int wr, int wc, int fr, int fq) const {
        EPI_ROWS; const int c0 = u.pn * 256 + wc * 32 + 8 * fq; const int rowt = u.pm * 256;
        const GAS float* xin = (const GAS float*)(rowt < 16384 ? xp + (size_t)row0 * DM : xs + (size_t)(row0 - 16384) * DM) + c0;
        const GAS float* rsp = (const GAS float*)(r2 + row0); GAS bf16_t* bo = (GAS bf16_t*)x1b + (size_t)row0 * DM + c0; GAS float* sp = (GAS float*)stA + (size_t)row0 * 64 + u.pn * 4 + wc;
        LAUNDER(xin); LAUNDER(rsp); LAUNDER(bo); LAUNDER(sp);
#pragma unroll
        for (int ai = 0; ai < 2; ++ai)
#pragma unroll
            for (int m = 0; m < 4; ++m) { const float rs = rsp[ai * 128 + m * 16]; float ss = 0.f; const size_t ro = (size_t)(ai * 128 + m * 16) * DM;
#pragma unroll
                for (int bj = 0; bj < 2; ++bj) {
                    const f32x4 v0 = *(const GAS f32x4*)(xin + ro + bj * 128) + acc[ai][bj][m][0] * rs, v1 = *(const GAS f32x4*)(xin + ro + bj * 128 + 4) + acc[ai][bj][m][1] * rs;
                    ss += sq8(v0, v1);
                    *(GAS u32x4*)(bo + ro + bj * 128) = pack8(v0, v1); }
                ss = red_fq(ss); if (fq == 0) sp[(size_t)(ai * 128 + m * 16) * 64] = ss; }
    }
};
__device__ __forceinline__ float dpp_ror1(float v) { return __builtin_bit_cast(float, __builtin_amdgcn_update_dpp(0, __builtin_bit_cast(int, v), 0x121, 0xf, 0xf, false)); }
__device__ __forceinline__ float dpp_rol1(float v) { return __builtin_bit_cast(float, __builtin_amdgcn_update_dpp(0, __builtin_bit_cast(int, v), 0x12f, 0xf, 0xf, false)); }
struct EpiFfnA {
    static constexpr bool PERM = true, MIDK = false;
    const float* rstd; int row_base; bf16_t* act; bf16_t* halo_up; bf16_t* halo_gate; const float* cw; const float* cb;
    __device__ __forceinline__ void midk(f32x4 (&)[2][2][4][2], const Unit&, int, int) const {}
    __device__ __forceinline__ void operator()(const f32x4 (&acc)[2][2][4][2], const Unit& u, int wr, int wc, int fr, int fq) const {
        EPI_ROWS; const int f0 = u.pn * 128 + wc * 32 + 8 * fq;
        const GAS float* rsp = (const GAS float*)(rstd + row_base + row0); GAS bf16_t* actp = (GAS bf16_t*)act + (size_t)row0 * DFF + f0;
        const int strip0 = u.pm * 4 + wr;
        GAS bf16_t* hup_p = (GAS bf16_t*)halo_up + (size_t)strip0 * 4 * DFF + f0; GAS bf16_t* hg_p = (GAS bf16_t*)halo_gate + (size_t)strip0 * 2 * DFF + f0;
        const GAS float* cwp = (const GAS float*)(cw + f0); const GAS float* cbp = (const GAS float*)(cb + f0);
        asm volatile("" : "+v"(rsp), "+v"(actp), "+v"(hup_p), "+v"(hg_p), "+v"(cwp), "+v"(cbp));
#pragma unroll
        for (int ai = 0; ai < 2; ++ai) {
            float rs[4];
#pragma unroll
            for (int m = 0; m < 4; ++m) rs[m] = rsp[ai * 128 + m * 16];
            u32x2 keep[4];
#pragma unroll
            for (int n = 0; n < 2; ++n) {
                const f32x4 w0 = *(const GAS f32x4*)(cwp + 4 * n), w1 = *(const GAS f32x4*)(cwp + DFF + 4 * n), w2 = *(const GAS f32x4*)(cwp + 2 * DFF + 4 * n), wb = *(const GAS f32x4*)(cbp + 4 * n);
                f32x4 res[4], Uu[4];
#pragma unroll
                for (int e = 0; e < 4; ++e) {
                    float U[4], R[4], L[4];
#pragma unroll
                    for (int m = 0; m < 4; ++m) { U[m] = acc[ai][0][m][n][e] * rs[m]; R[m] = dpp_ror1(U[m]); L[m] = dpp_rol1(U[m]); Uu[m][e] = U[m]; }
#pragma unroll
                    for (int m = 0; m < 4; ++m) {
                        const float prev = (fr == 0) ? R[m > 0 ? m - 1 : 0] : R[m];
                        const float next = (fr == 15) ? L[m < 3 ? m + 1 : 3] : L[m];
                        const float cv = w0[e] * prev + w1[e] * U[m] + w2[e] * next + wb[e];
                        res[m][e] = cv * sigmoidf_fast(cv) * (acc[ai][1][m][n][e] * rs[m]);
                    }
                }
#pragma unroll
                for (int m = 0; m < 4; ++m) {
                    const bool edge = (m == 0 && fr == 0) || (m == 3 && fr == 15);
                    { u32x2 w; w.x = cvt_pk_bf16(res[m][0], res[m][1]); w.y = cvt_pk_bf16(res[m][2], res[m][3]);
                      if (n == 0) keep[m] = w; else if (!edge) *(GAS u32x4*)(actp + (size_t)(ai * 128 + m * 16) * DFF) = (u32x4){keep[m].x, keep[m].y, w.x, w.y}; }
                    if (m == 0 || m == 3) {
                        const int hs = (m == 0) ? (fr == 0 ? 0 : (fr == 1 ? 1 : -1)) : (fr == 14 ? 2 : (fr == 15 ? 3 : -1));
                        if (hs >= 0) { u32x2 w; w.x = cvt_pk_bf16(Uu[m][0], Uu[m][1]); w.y = cvt_pk_bf16(Uu[m][2], Uu[m][3]);
                            *(GAS u32x2*)(hup_p + ((size_t)(ai * 2) * 4 + hs) * DFF + 4 * n) = w;
                            if (hs == 0 || hs == 3) { const f32x4 gv = acc[ai][1][m][n] * rs[m]; u32x2 wg; wg.x = cvt_pk_bf16(gv[0], gv[1]); wg.y = cvt_pk_bf16(gv[2], gv[3]);
                                *(GAS u32x2*)(hg_p + ((size_t)(ai * 2) * 2 + (hs == 3 ? 1 : 0)) * DFF + 4 * n) = wg; } }
                    }
                }
            }
        }
    }
};
struct EpiDown {
    static constexpr bool PERM = true, MIDK = false;
    bf16_t* xb; int row_base; float* stA;
    __device__ __forceinline__ void midk(f32x4 (&)[2][2][4][2], const Unit&, int, int) const {}
    __device__ __forceinline__ void operator()(const f32x4 (&acc)[2][2][4][2], const Unit& u, int wr, int wc, int fr, int fq) const {
        EPI_ROWS; GAS bf16_t* xo = (GAS bf16_t*)xb + (size_t)(row_base + row0) * DM + u.pn * 256 + wc * 32 + 8 * fq; GAS float* sp = (GAS float*)stA + (size_t)(row_base + row0) * 64 + u.pn * 4 + wc; LAUNDER(xo); LAUNDER(sp);
#pragma unroll
        for (int ai = 0; ai < 2; ++ai)
#pragma unroll
            for (int m = 0; m < 4; ++m) { float ss = 0.f; const size_t ro = (size_t)(ai * 128 + m * 16) * DM;
#pragma unroll
                for (int bj = 0; bj < 2; ++bj) { GAS bf16_t* p = xo + ro + bj * 128; const u32x4 w = *(const GAS u32x4*)p; const f32x4 a0 = acc[ai][bj][m][0], a1 = acc[ai][bj][m][1];
                    f32x4 v0, v1; v0[0] = bflo(w.x) + a0[0]; v0[1] = bfhi(w.x) + a0[1]; v0[2] = bflo(w.y) + a0[2]; v0[3] = bfhi(w.y) + a0[3];
                    v1[0] = bflo(w.z) + a1[0]; v1[1] = bfhi(w.z) + a1[1]; v1[2] = bflo(w.w) + a1[2]; v1[3] = bfhi(w.w) + a1[3];
                    ss += sq8(v0, v1); *(GAS u32x4*)p = pack8(v0, v1); }
                ss = red_fq(ss); if (fq == 0) sp[(size_t)(ai * 128 + m * 16) * 64] = ss; }
    }
};
#undef EPI_ROWS
}

namespace attn {
using f32x4v = __attribute__((ext_vector_type(4))) float;
using u32x2v = __attribute__((ext_vector_type(2))) unsigned;
using u32x4v = __attribute__((ext_vector_type(4))) unsigned;
constexpr int NW = 8, KVBLK = 64;
constexpr float SCALE = 0.07216878364870322f;
constexpr float THR = 8.f;
constexpr int LDQ = 3072, LDK = 2048, LDR = 64, LDVT = T, LDO = 4096;
constexpr int SHM_V = 128 * KVBLK * 2, SHM_K = KVBLK * 128 * 2, SHM_R = KVBLK * 64 * 2;
constexpr int OFF_V = 0, OFF_K = 2 * SHM_V, OFF_R = OFF_K + 2 * SHM_K, OFF_QR = OFF_R + 2 * SHM_R, SHM_ATTN = OFF_QR + NW * 4096;
#define SBAR() __builtin_amdgcn_sched_barrier(0)
#define PIN(x) asm volatile("" : "+v"(x))
__device__ __forceinline__ void glds16(const void* gsrc, unsigned lds_dst) { unsigned keep;
  asm volatile("s_mov_b32 %0, m0\n\ts_mov_b32 m0, %2\n\ts_nop 0\n\tglobal_load_lds_dwordx4 %1, off\n\ts_mov_b32 m0, %0" : "=&s"(keep) : "v"(gsrc), "s"(lds_dst) : "memory"); }
__device__ __forceinline__ unsigned cvtpk(float lo, float hi) { unsigned r; asm volatile("v_cvt_pk_bf16_f32 %0, %1, %2" : "=v"(r) : "v"(lo), "v"(hi)); return r; }
__device__ __forceinline__ float xmax16(float v) { auto r = __builtin_amdgcn_permlane16_swap(__float_as_uint(v), __float_as_uint(v), false, false); return fmaxf(__uint_as_float(r[0]), __uint_as_float(r[1])); }
__device__ __forceinline__ float xmax32(float v) { auto r = __builtin_amdgcn_permlane32_swap(__float_as_uint(v), __float_as_uint(v), false, false); return fmaxf(__uint_as_float(r[0]), __uint_as_float(r[1])); }
__device__ __forceinline__ float xsum16(float v) { auto r = __builtin_amdgcn_permlane16_swap(__float_as_uint(v), __float_as_uint(v), false, false); return __uint_as_float(r[0]) + __uint_as_float(r[1]); }
__device__ __forceinline__ float xsum32(float v) { auto r = __builtin_amdgcn_permlane32_swap(__float_as_uint(v), __float_as_uint(v), false, false); return __uint_as_float(r[0]) + __uint_as_float(r[1]); }
__device__ __forceinline__ float max3f(float a, float b, float c) { float r; asm("v_max3_f32 %0, %1, %2, %3" : "=v"(r) : "v"(a), "v"(b), "v"(c)); return r; }
#define MF16(A, B, C) __builtin_amdgcn_mfma_f32_16x16x32_bf16(A, B, C, 0, 0, 0)
struct Lane { const LAS char* Kl; const LAS char* Rl; const LAS char* Vl; const LAS char* qrl; int ky, rz, vz; };
template <int KB, int S> __device__ __forceinline__ bf16x8 kfrag(const Lane& L, int kst, int rst) {
  if constexpr (S < 4) return *(const LAS bf16x8*)(L.Kl + kst + KB * 4096 + ((64 * S) ^ L.ky));
  else return *(const LAS bf16x8*)(L.Rl + rst + KB * 2048 + ((64 * (S - 4)) ^ L.rz));
}
template <int DB, int C> __device__ __forceinline__ bf16x8 vfrag(const Lane& L, int vst) { return *(const LAS bf16x8*)(L.Vl + vst + DB * 2048 + ((64 * C) ^ L.rz)); }
template <int QB, int S> __device__ __forceinline__ bf16x8 qfrag(const bf16x8 (&qn)[2][6], const Lane& L) { return qn[QB][S]; }
template <int KB> __device__ __forceinline__ void qk_block_plain(f32x4v (&s)[2][4], const bf16x8 (&qn)[2][6], const Lane& L, int kst, int rst) {
  bf16x8 k = kfrag<KB, 0>(L, kst, rst); s[0][KB] = MF16(k, (qfrag<0, 0>(qn, L)), ((f32x4v){0.f, 0.f, 0.f, 0.f})); s[1][KB] = MF16(k, (qfrag<1, 0>(qn, L)), ((f32x4v){0.f, 0.f, 0.f, 0.f}));
  k = kfrag<KB, 1>(L, kst, rst); s[0][KB] = MF16(k, (qfrag<0, 1>(qn, L)), s[0][KB]); s[1][KB] = MF16(k, (qfrag<1, 1>(qn, L)), s[1][KB]);
  k = kfrag<KB, 2>(L, kst, rst); s[0][KB] = MF16(k, (qfrag<0, 2>(qn, L)), s[0][KB]); s[1][KB] = MF16(k, (qfrag<1, 2>(qn, L)), s[1][KB]);
  k = kfrag<KB, 3>(L, kst, rst); s[0][KB] = MF16(k, (qfrag<0, 3>(qn, L)), s[0][KB]); s[1][KB] = MF16(k, (qfrag<1, 3>(qn, L)), s[1][KB]);
  k = kfrag<KB, 4>(L, kst, rst); s[0][KB] = MF16(k, (qfrag<0, 4>(qn, L)), s[0][KB]); s[1][KB] = MF16(k, (qfrag<1, 4>(qn, L)), s[1][KB]);
  k = kfrag<KB, 5>(L, kst, rst); s[0][KB] = MF16(k, (qfrag<0, 5>(qn, L)), s[0][KB]); s[1][KB] = MF16(k, (qfrag<1, 5>(qn, L)), s[1][KB]);
}
template <int QB> __device__ __forceinline__ float rowmax(const f32x4v (&s)[2][4]) {
  float m = max3f(s[QB][0][0], s[QB][0][1], s[QB][0][2]); m = max3f(m, s[QB][0][3], s[QB][1][0]); m = max3f(m, s[QB][1][1], s[QB][1][2]); m = max3f(m, s[QB][1][3], s[QB][2][0]);
  m = max3f(m, s[QB][2][1], s[QB][2][2]); m = max3f(m, s[QB][2][3], s[QB][3][0]); m = max3f(m, s[QB][3][1], s[QB][3][2]); m = max3f(m, s[QB][3][3], s[QB][3][3]); return m;
}
constexpr float THRL = 11.541560327111707f;
__device__ __forceinline__ void decide(float pm0, float pm1, f32x4v (&c)[2][4], float (&mh)[2], f32x4v (&negm)[2], float (&al)[2]) {
  pm0 = xmax32(xmax16(pm0)); pm1 = xmax32(xmax16(pm1));
  if (__builtin_expect(__all((pm0 <= THRL) && (pm1 <= THRL)), 1)) { al[0] = 1.f; al[1] = 1.f; }
  else { const float d0 = fmaxf(pm0, 0.f), d1 = fmaxf(pm1, 0.f); mh[0] += d0; mh[1] += d1;
#pragma unroll
    for (int kb = 0; kb < 4; ++kb) { c[0][kb] = c[0][kb] - d0; c[1][kb] = c[1][kb] - d1; }
    al[0] = __builtin_amdgcn_exp2f(-d0); al[1] = __builtin_amdgcn_exp2f(-d1);
    negm[0] = (f32x4v){-mh[0], -mh[0], -mh[0], -mh[0]}; negm[1] = (f32x4v){-mh[1], -mh[1], -mh[1], -mh[1]}; }
}
__device__ __forceinline__ bf16x8 packp(const f32x4v a, const f32x4v b) { const u32x4v w = {cvtpk(a[0], a[1]), cvtpk(a[2], a[3]), cvtpk(b[0], b[1]), cvtpk(b[2], b[3])}; return __builtin_bit_cast(bf16x8, w); }

__device__ __forceinline__ void attn_step(f32x4v (&c)[2][4], f32x4v (&p)[2][4], f32x4v (&o)[2][8], const bf16x8 (&qn)[2][6], const Lane& L, int kst, int rst, int vst,
                                          const float (&alp)[2], float (&l)[2], float (&mh)[2], f32x4v (&negm)[2], float (&alc)[2]) {
  bf16x8 ka, kb_, kc, kd, P00, P01, P10, P11;
#define QKR(KB, S, FIRST, KX, KY) do { \
    if (FIRST) { c[0][KB] = MF16(KX, (qfrag<0, S>(qn, L)), negm[0]); c[1][KB] = MF16(KX, (qfrag<1, S>(qn, L)), negm[1]); \
                 c[0][KB + 1] = MF16(KY, (qfrag<0, S>(qn, L)), negm[0]); c[1][KB + 1] = MF16(KY, (qfrag<1, S>(qn, L)), negm[1]); } \
    else { c[0][KB] = MF16(KX, (qfrag<0, S>(qn, L)), c[0][KB]); c[1][KB] = MF16(KX, (qfrag<1, S>(qn, L)), c[1][KB]); \
           c[0][KB + 1] = MF16(KY, (qfrag<0, S>(qn, L)), c[0][KB + 1]); c[1][KB + 1] = MF16(KY, (qfrag<1, S>(qn, L)), c[1][KB + 1]); } } while (0)
#define EXP4(V) do { V[0] = __builtin_amdgcn_exp2f(V[0]); V[1] = __builtin_amdgcn_exp2f(V[1]); V[2] = __builtin_amdgcn_exp2f(V[2]); V[3] = __builtin_amdgcn_exp2f(V[3]); } while (0)
  ka = kfrag<0, 0>(L, kst, rst); kb_ = kfrag<1, 0>(L, kst, rst); SBAR();
  kc = kfrag<0, 1>(L, kst, rst); kd = kfrag<1, 1>(L, kst, rst); QKR(0, 0, true, ka, kb_); EXP4(p[0][2]); PIN(p[0][2]); SBAR();
  ka = kfrag<0, 2>(L, kst, rst); kb_ = kfrag<1, 2>(L, kst, rst); QKR(0, 1, false, kc, kd); EXP4(p[0][3]); PIN(p[0][3]); SBAR();
  kc = kfrag<0, 3>(L, kst, rst); kd = kfrag<1, 3>(L, kst, rst); QKR(0, 2, false, ka, kb_); EXP4(p[1][2]); PIN(p[1][2]); SBAR();
  ka = kfrag<0, 4>(L, kst, rst); kb_ = kfrag<1, 4>(L, kst, rst); QKR(0, 3, false, kc, kd); EXP4(p[1][3]); PIN(p[1][3]); SBAR();
  kc = kfrag<0, 5>(L, kst, rst); kd = kfrag<1, 5>(L, kst, rst); QKR(0, 4, false, ka, kb_);
  { float s = (p[0][0][0] + p[0][0][1]) + (p[0][0][2] + p[0][0][3]); s += (p[0][1][0] + p[0][1][1]) + (p[0][1][2] + p[0][1][3]); s += (p[0][2][0] + p[0][2][1]) + (p[0][2][2] + p[0][2][3]); s += (p[0][3][0] + p[0][3][1]) + (p[0][3][2] + p[0][3][3]);
    l[0] = l[0] * alp[0] + s; PIN(l[0]); } SBAR();
  ka = kfrag<2, 0>(L, kst, rst); kb_ = kfrag<3, 0>(L, kst, rst); QKR(0, 5, false, kc, kd);
  { float s = (p[1][0][0] + p[1][0][1]) + (p[1][0][2] + p[1][0][3]); s += (p[1][1][0] + p[1][1][1]) + (p[1][1][2] + p[1][1][3]); s += (p[1][2][0] + p[1][2][1]) + (p[1][2][2] + p[1][2][3]); s += (p[1][3][0] + p[1][3][1]) + (p[1][3][2] + p[1][3][3]);
    l[1] = l[1] * alp[1] + s; PIN(l[1]); } SBAR();
  kc = kfrag<2, 1>(L, kst, rst); kd = kfrag<3, 1>(L, kst, rst); QKR(2, 0, true, ka, kb_); P00 = packp(p[0][0], p[0][1]); PIN(P00); SBAR();
  ka = kfrag<2, 2>(L, kst, rst); kb_ = kfrag<3, 2>(L, kst, rst); QKR(2, 1, false, kc, kd); P01 = packp(p[0][2], p[0][3]); PIN(P01); SBAR();
  kc = kfrag<2, 3>(L, kst, rst); kd = kfrag<3, 3>(L, kst, rst); QKR(2, 2, false, ka, kb_); P10 = packp(p[1][0], p[1][1]); PIN(P10); SBAR();
  ka = kfrag<2, 4>(L, kst, rst); kb_ = kfrag<3, 4>(L, kst, rst); QKR(2, 3, false, kc, kd); P11 = packp(p[1][2], p[1][3]); PIN(P11); SBAR();
  kc = kfrag<2, 5>(L, kst, rst); kd = kfrag<3, 5>(L, kst, rst); QKR(2, 4, false, ka, kb_); SBAR();
  ka = vfrag<0, 0>(L, vst); kb_ = vfrag<1, 0>(L, vst); QKR(2, 5, false, kc, kd); SBAR();
#define PVR(DB, VX, VY, PA, PB) do { o[0][DB] = MF16(VX, PA, o[0][DB]); o[1][DB] = MF16(VX, PB, o[1][DB]); o[0][DB + 1] = MF16(VY, PA, o[0][DB + 1]); o[1][DB + 1] = MF16(VY, PB, o[1][DB + 1]); } while (0)
  float pm0, pm1;
  kc = vfrag<2, 0>(L, vst); kd = vfrag<3, 0>(L, vst); PVR(0, ka, kb_, P00, P10); pm0 = rowmax<0>(c); PIN(pm0); SBAR();
  ka = vfrag<4, 0>(L, vst); kb_ = vfrag<5, 0>(L, vst); PVR(2, kc, kd, P00, P10); pm1 = rowmax<1>(c); PIN(pm1); SBAR();
  kc = vfrag<6, 0>(L, vst); kd = vfrag<7, 0>(L, vst); PVR(4, ka, kb_, P00, P10); decide(pm0, pm1, c, mh, negm, alc); SBAR();
  ka = vfrag<0, 1>(L, vst); kb_ = vfrag<1, 1>(L, vst); PVR(6, kc, kd, P00, P10); EXP4(c[0][0]); PIN(c[0][0]); SBAR();
  kc = vfrag<2, 1>(L, vst); kd = vfrag<3, 1>(L, vst); PVR(0, ka, kb_, P01, P11); EXP4(c[0][1]); PIN(c[0][1]); SBAR();
  ka = vfrag<4, 1>(L, vst); kb_ = vfrag<5, 1>(L, vst); PVR(2, kc, kd, P01, P11); EXP4(c[1][0]); PIN(c[1][0]); SBAR();
  kc = vfrag<6, 1>(L, vst); kd = vfrag<7, 1>(L, vst); PVR(4, ka, kb_, P01, P11); EXP4(c[1][1]); PIN(c[1][1]); SBAR();
  PVR(6, kc, kd, P01, P11); SBAR();
#undef QKR
#undef PVR
}

__device__ __forceinline__ void attn_unit(const bf16* __restrict__ Qb, const bf16* __restrict__ Kh, const bf16* __restrict__ VTh, const bf16* __restrict__ Rh,
                                          bf16* __restrict__ Ob, float* __restrict__ st, int seq, int k0g, char* lds, int wid) {
  int lane_l = (int)__builtin_amdgcn_mbcnt_hi(~0u, __builtin_amdgcn_mbcnt_lo(~0u, 0u)); asm volatile("" : "+v"(lane_l));
  const int lane = lane_l, l15 = lane & 15, kq = lane >> 4;
  bf16x8 qn[2][6]; Lane L;
  L.qrl = (const LAS char*)(lds + OFF_QR + wid * 4096 + lane * 16);
  { const bf16* Qw = Qb + (long)(wid * 32 + l15) * LDQ + kq * 8;
#pragma unroll
    for (int qb = 0; qb < 2; ++qb) {
#pragma unroll
      for (int s = 0; s < 6; ++s) qn[qb][s] = *(const GAS bf16x8*)(Qw + (long)qb * 16 * LDQ + s * 32); } }
  L.Kl = (const LAS char*)(lds + OFF_K) + l15 * 256; L.Rl = (const LAS char*)(lds + OFF_R) + l15 * 128; L.Vl = (const LAS char*)(lds + OFF_V) + l15 * 128;
  L.ky = (kq ^ l15) << 4; L.rz = (kq ^ ((l15 >> 1) & 7)) << 4; L.vz = 0;
  unsigned kof0, kof1, rof, vof0, vof1;
  { const int q0 = wid, q1 = wid + 8;
    { const int row = 4 * q0 + (lane >> 4), ch = (lane & 15) ^ (row & 15); kof0 = (unsigned)(row * LDK + ch * 8) * 2u; }
    { const int row = 4 * q1 + (lane >> 4), ch = (lane & 15) ^ (row & 15); kof1 = (unsigned)(row * LDK + ch * 8) * 2u; }
    { const int row = 8 * q0 + (lane >> 3), ch = (lane & 7) ^ ((row >> 1) & 7); rof = (unsigned)(row * LDR + ch * 8) * 2u; }
    { const int row = 8 * q0 + (lane >> 3), ch = (lane & 7) ^ ((row >> 1) & 7); vof0 = (unsigned)(row * LDVT + ch * 8) * 2u; }
    { const int row = 8 * q1 + (lane >> 3), ch = (lane & 7) ^ ((row >> 1) & 7); vof1 = (unsigned)(row * LDVT + ch * 8) * 2u; } }
  const unsigned lds0 = (unsigned)(uintptr_t)lds;
  const unsigned dK = (unsigned)__builtin_amdgcn_readfirstlane(lds0 + OFF_K + wid * 1024), dR = (unsigned)__builtin_amdgcn_readfirstlane(lds0 + OFF_R + wid * 1024), dV = (unsigned)__builtin_amdgcn_readfirstlane(lds0 + OFF_V + wid * 1024);
  const char* VTk = (const char*)VTh + (size_t)k0g * 2;
#define DMA_KR(t, s) do { const char* kb_ = (const char*)Kh + (size_t)(t) * (KVBLK * LDK * 2); const char* rb_ = (const char*)Rh + (size_t)(t) * (KVBLK * LDR * 2); \
    glds16(kb_ + kof0, dK + (s) * SHM_K); glds16(kb_ + kof1, dK + (s) * SHM_K + 8192); glds16(rb_ + rof, dR + (s) * SHM_R); } while (0)
#define DMA_V(t, s) do { const char* vb_ = VTk + (size_t)(t) * (KVBLK * 2); glds16(vb_ + vof0, dV + (s) * SHM_V); glds16(vb_ + vof1, dV + (s) * SHM_V + 8192); } while (0)
#define WAIT_BAR() asm volatile("s_waitcnt vmcnt(0) lgkmcnt(0)\n\ts_barrier" ::: "memory")
#define RESC(a) do { if (__any(((a)[0] < 1.f) || ((a)[1] < 1.f))) { _Pragma("unroll") for (int d_ = 0; d_ < 8; ++d_) { o[0][d_] *= (a)[0]; o[1][d_] *= (a)[1]; } } } while (0)
  f32x4v o[2][8], sA[2][4], sB[2][4], negm[2]; float mh[2], l[2] = {0.f, 0.f}, alA[2], alB[2];
#pragma unroll
  for (int d = 0; d < 8; ++d) { o[0][d] = (f32x4v){0.f, 0.f, 0.f, 0.f}; o[1][d] = (f32x4v){0.f, 0.f, 0.f, 0.f}; }
  const int NT = seq / KVBLK;
  DMA_KR(0, 0); DMA_V(0, 0); WAIT_BAR();
  DMA_KR(1, 1);
  qk_block_plain<0>(sA, qn, L, 0, 0); qk_block_plain<1>(sA, qn, L, 0, 0); qk_block_plain<2>(sA, qn, L, 0, 0); qk_block_plain<3>(sA, qn, L, 0, 0);
  { mh[0] = xmax32(xmax16(rowmax<0>(sA))); mh[1] = xmax32(xmax16(rowmax<1>(sA))); alA[0] = 1.f; alA[1] = 1.f;
    negm[0] = (f32x4v){-mh[0], -mh[0], -mh[0], -mh[0]}; negm[1] = (f32x4v){-mh[1], -mh[1], -mh[1], -mh[1]};
#pragma unroll
    for (int kb = 0; kb < 4; ++kb) { sA[0][kb] = sA[0][kb] - mh[0]; sA[1][kb] = sA[1][kb] - mh[1]; }
#pragma unroll
    for (int kb = 0; kb < 2; ++kb)
#pragma unroll
      for (int e = 0; e < 4; ++e) { sA[0][kb][e] = __builtin_amdgcn_exp2f(sA[0][kb][e]); sA[1][kb][e] = __builtin_amdgcn_exp2f(sA[1][kb][e]); } }
  WAIT_BAR();
#pragma unroll 1
  for (int j = 1; j + 1 < NT; j += 2) {
    DMA_KR(j + 1, 0); DMA_V(j, 1);
    attn_step(sB, sA, o, qn, L, SHM_K, SHM_R, 0, alA, l, mh, negm, alB);
    RESC(alB); WAIT_BAR();
    if (j + 2 < NT) DMA_KR(j + 2, 1);
    DMA_V(j + 1, 0);
    attn_step(sA, sB, o, qn, L, 0, 0, SHM_V, alB, l, mh, negm, alA);
    RESC(alA); WAIT_BAR();
  }
  DMA_V(NT - 1, 1);
  attn_step(sB, sA, o, qn, L, SHM_K, SHM_R, 0, alA, l, mh, negm, alB);
  RESC(alB); WAIT_BAR();
  {
#pragma unroll
    for (int kb = 2; kb < 4; ++kb)
#pragma unroll
      for (int e = 0; e < 4; ++e) { sB[0][kb][e] = __builtin_amdgcn_exp2f(sB[0][kb][e]); sB[1][kb][e] = __builtin_amdgcn_exp2f(sB[1][kb][e]); }
    float s0 = 0.f, s1 = 0.f;
#pragma unroll
    for (int kb = 0; kb < 4; ++kb) { s0 += (sB[0][kb][0] + sB[0][kb][1]) + (sB[0][kb][2] + sB[0][kb][3]); s1 += (sB[1][kb][0] + sB[1][kb][1]) + (sB[1][kb][2] + sB[1][kb][3]); }
    l[0] = l[0] * alB[0] + s0; l[1] = l[1] * alB[1] + s1;
    const bf16x8 P00 = packp(sB[0][0], sB[0][1]), P01 = packp(sB[0][2], sB[0][3]), P10 = packp(sB[1][0], sB[1][1]), P11 = packp(sB[1][2], sB[1][3]);
#define PVD(DB) do { bf16x8 v0 = vfrag<DB, 0>(L, SHM_V), v1 = vfrag<DB, 1>(L, SHM_V); o[0][DB] = MF16(v0, P00, o[0][DB]); o[1][DB] = MF16(v0, P10, o[1][DB]); o[0][DB] = MF16(v1, P01, o[0][DB]); o[1][DB] = MF16(v1, P11, o[1][DB]); } while (0)
    PVD(0); PVD(1); PVD(2); PVD(3); PVD(4); PVD(5); PVD(6); PVD(7);
#undef PVD
  }
  int lane_e = (int)__builtin_amdgcn_mbcnt_hi(~0u, __builtin_amdgcn_mbcnt_lo(~0u, 0u)); asm volatile("" : "+v"(lane_e)); const int l15e = lane_e & 15, kqe = lane_e >> 4;
  GAS bf16* Ow = (GAS bf16*)Ob + (long)(wid * 32 + l15e) * LDO + 4 * kqe; GAS float* stw = (GAS float*)st + (long)(wid * 32 + l15e) * 16;
  asm volatile("" : "+v"(Ow), "+v"(stw));
#pragma unroll
  for (int qb = 0; qb < 2; ++qb) { const float lt = xsum32(xsum16(l[qb])); const float rl = __builtin_amdgcn_rcpf(lt); float ss = 0.f;
#pragma unroll
    for (int db = 0; db < 8; ++db) { const f32x4v v = o[qb][db] * rl; u32x2v w; w.x = cvtpk(v[0], v[1]); w.y = cvtpk(v[2], v[3]);
      const float a0 = bflo(w.x), a1 = bfhi(w.x), a2 = bflo(w.y), a3 = bfhi(w.y); ss += (a0 * a0 + a1 * a1) + (a2 * a2 + a3 * a3);
      *(GAS u32x2v*)(Ow + (long)(qb * 16) * LDO + db * 16) = w; }
    ss = xsum32(xsum16(ss)); if (kqe == 0) stw[(long)(qb * 16) * 16] = ss; }
  asm volatile("s_waitcnt lgkmcnt(0)\n\ts_barrier" ::: "memory");
#undef DMA_KR
#undef DMA_V
#undef WAIT_BAR
#undef RESC
}
#undef SBAR
#undef PIN
#undef MF16
#undef EXP4
}

constexpr size_t MiB = 1u << 20;
constexpr size_t WS_CTL = 0, CTL_ZERO_BYTES = 1 * MiB;
constexpr size_t WS_RSTDX = 1 * MiB, WS_RSTDQ = WS_RSTDX + 98304, WS_RSTDKV = WS_RSTDQ + 98304, WS_R2 = WS_RSTDKV + 98304, WS_RATIO = WS_R2 + 98304, WS_RSTDX1 = WS_RATIO + 98304;
constexpr size_t WS_STA = 2 * MiB;
constexpr size_t WS_STB = 8 * MiB;
constexpr size_t WS_STQ = 10 * MiB;
constexpr size_t WS_STKV = 12 * MiB;
constexpr size_t WS_ROPE = 13 * MiB;
constexpr size_t WS_WIN = 16 * MiB;
constexpr size_t WS_WGLU = 46 * MiB;
constexpr size_t WS_WQ = 54 * MiB;
constexpr size_t WS_WKV = 60 * MiB;
constexpr size_t WS_WOUT = 64 * MiB;
constexpr size_t WS_WUG = 96 * MiB;
constexpr size_t WS_WDN = 268 * MiB;
constexpr size_t WS_W1T = 354 * MiB;
constexpr size_t WS_W2T = 370 * MiB;
constexpr size_t WS_A = 402 * MiB;
constexpr size_t WS_B = 594 * MiB;
constexpr size_t WS_QLAT = 786 * MiB, WS_KVLAT = 828 * MiB, WS_KROPE = 852 * MiB;
constexpr size_t WS_GACT = 856 * MiB;
constexpr size_t WS_HUP = 952 * MiB, WS_HGATE = 964 * MiB, WS_END = 970 * MiB;
static_assert(WS_HUP + (size_t)128 * 4 * DFF * 2 <= WS_HGATE && WS_HGATE + (size_t)128 * 2 * DFF * 2 <= WS_END, "halo");
constexpr size_t OUT_X = 0, OUT_KV = 192 * MiB;
constexpr int CW_BAR = 4096;

constexpr int NWAVES = 8;
constexpr int RING_BYTES = 131072, LDSCTL_OFF = 143360, MISC_OFF = LDSCTL_OFF + 320, LDS_BYTES = 147456;

typedef GAS unsigned gu32;
#define RLX_AGENT __ATOMIC_RELAXED, __HIP_MEMORY_SCOPE_AGENT
#define LDS_WAIT() asm volatile("s_waitcnt lgkmcnt(0)" ::: "memory")

#define XB_TMO      128
#define XB_XCNT(j)  (256  + 64 * (j))
#define XB_XSUB(j)  (1280 + 64 * (j))
#define XB_XGEN(j)  (2304 + 64 * (j))
#define XB_TOP      3328
#define XB_TOPGEN   3392
#define XCD_BAR_WORDS 3456
#define XB_SPIN_CAP (1u << 18)
__device__ __forceinline__ unsigned xb_ld(unsigned* p)              { return __hip_atomic_load(p, __ATOMIC_RELAXED, __HIP_MEMORY_SCOPE_AGENT); }
__device__ __forceinline__ unsigned xb_add(unsigned* p, unsigned v) { return __hip_atomic_fetch_add(p, v, __ATOMIC_RELAXED, __HIP_MEMORY_SCOPE_AGENT); }
__device__ __forceinline__ unsigned xb_xcc_id() { return (unsigned)__builtin_amdgcn_s_getreg((3 << 11) | 20) & 0xFu; }
#define XB_SPIN(cond, bar) do { unsigned _sp = 0; while (cond) { __builtin_amdgcn_s_sleep(1); \
    if ((++_sp & 255u) == 0u) { if (xb_ld(&(bar)[XB_TMO])) break; if (_sp > XB_SPIN_CAP) { atomicAdd(&(bar)[XB_TMO], 1u); break; } } } } while (0)
struct XcdBarrier { unsigned* bar; unsigned x; volatile LAS unsigned* st; };
__device__ __forceinline__ XcdBarrier xcd_barrier_post(unsigned* bar, volatile LAS unsigned* st) {
    XcdBarrier b; b.bar = bar; b.x = xb_xcc_id(); b.st = st;
    if (threadIdx.x == 0) (void)xb_add(&bar[XB_XCNT(b.x)], 1u);
    return b;
}
__device__ __forceinline__ void xcd_barrier_complete(unsigned* bar, unsigned x, unsigned& nloc, unsigned& nx) {
    const unsigned G = gridDim.x * gridDim.y * gridDim.z;
    unsigned sum, cnt, mine, sp = 0u;
    for (;;) {
        sum = 0u; cnt = 0u; mine = 0u;
#pragma unroll
        for (unsigned j = 0; j < 16; ++j) { const unsigned c = xb_ld(&bar[XB_XCNT(j)]); sum += c; cnt += (c > 0u) ? 1u : 0u; mine = (j == x) ? c : mine; }
        if (sum == G) break;
        __builtin_amdgcn_s_sleep(1);
        if ((++sp & 255u) == 0u) { if (xb_ld(&bar[XB_TMO])) break; if (sp > XB_SPIN_CAP) { atomicAdd(&bar[XB_TMO], 1u); break; } }
    }
    nloc = mine > 0u ? mine : 1u; nx = cnt > 0u ? cnt : 1u;
}
__device__ __forceinline__ void xcd_barrier(const XcdBarrier& b) {
    asm volatile("s_waitcnt vmcnt(0)" ::: "memory");
    __syncthreads();
    if (threadIdx.x == 0) {
        unsigned* bar = b.bar;
        __builtin_amdgcn_s_waitcnt(0);
        unsigned nloc = b.st[0], nx = b.st[1];
        if (nloc == 0u) { xcd_barrier_complete(bar, b.x, nloc, nx); b.st[0] = nloc; b.st[1] = nx; }
        const unsigned old = xb_add(&bar[XB_XSUB(b.x)], 1u);
        const unsigned gen = old / nloc;
        if (old + 1u == (gen + 1u) * nloc) {
            __builtin_amdgcn_fence(__ATOMIC_RELEASE, "agent");
            asm volatile("s_waitcnt vmcnt(0)" ::: "memory");
            const unsigned og = xb_add(&bar[XB_TOP], 1u);
            const unsigned tg = og / nx;
            if (og + 1u == (tg + 1u) * nx) xb_add(&bar[XB_TOPGEN], 1u);
            else XB_SPIN(xb_ld(&bar[XB_TOPGEN]) == tg, bar);
            __builtin_amdgcn_fence(__ATOMIC_ACQUIRE, "agent");
            xb_add(&bar[XB_XGEN(b.x)], 1u);
            asm volatile("s_waitcnt vmcnt(0)" ::: "memory");
        } else {
            XB_SPIN(xb_ld(&bar[XB_XGEN(b.x)]) == gen, bar);
            __builtin_amdgcn_fence(__ATOMIC_ACQUIRE, "agent");
            asm volatile("s_waitcnt vmcnt(0)" ::: "memory");
        }
    }
    __syncthreads();
}

__device__ __forceinline__ float wave_sum(float v) {
#pragma unroll
    for (int o = 1; o < 64; o <<= 1) v += __shfl_xor(v, o);
    return v;
}
template <class RowMap>
__device__ __forceinline__ void transpose_item(const float* W, int K, int N, bf16* WT, const float* g1, const float* g2, int ksplit, RowMap rm, LAS float* scr, int item, int lane) {
    const int nblk = N / 64; int kb, nb;
    if ((nblk & 3) == 0) { const int w = item & 7, rest = item >> 3, q = nblk >> 2; nb = (rest % q) * 4 + (w & 3); kb = (rest / q) * 2 + (w >> 2); }
    else { kb = item / nblk; nb = item % nblk; }
    const int k0 = 64 * kb, n0 = 64 * nb;
    f32x2 wv[32];
    const GAS f32x2* wp = (const GAS f32x2*)((const GAS float*)W + (size_t)(k0 + (lane >> 5)) * N + n0) + (lane & 31);
#pragma unroll
    for (int i = 0; i < 32; ++i) wv[i] = *(const GAS f32x2*)((const GAS float*)wp + (size_t)(2 * i) * N);
    float gn[32];
#pragma unroll
    for (int i = 0; i < 32; ++i) { const int k = k0 + 2 * i + (lane >> 5); gn[i] = g1 ? (k < ksplit ? g1[k] : g2[k - ksplit]) : 1.0f; }
    const int c = lane & 7;
#pragma unroll
    for (int sub = 0; sub < 2; ++sub) {
#pragma unroll
        for (int i = 0; i < 32; ++i) { const int kk = 2 * i + (lane >> 5); scr[kk * 33 + (lane & 31)] = (sub ? wv[i].y : wv[i].x) * gn[i]; }
        LDS_WAIT(); asm volatile("" ::: "memory");
#pragma unroll
        for (int j = 0; j < 4; ++j) { const int nl = (lane >> 3) + 8 * j; const LAS float* s = scr + (8 * c) * 33 + nl;
            v4u o; o.x = pg8::cvt_pk_bf16(s[0 * 33], s[1 * 33]); o.y = pg8::cvt_pk_bf16(s[2 * 33], s[3 * 33]); o.z = pg8::cvt_pk_bf16(s[4 * 33], s[5 * 33]); o.w = pg8::cvt_pk_bf16(s[6 * 33], s[7 * 33]);
            *(GAS v4u*)(WT + (size_t)rm(n0 + 2 * nl + sub) * K + k0 + 8 * c) = o; }
        LDS_WAIT(); asm volatile("" ::: "memory");
    }
}
struct RmId  { __device__ __forceinline__ int operator()(int n) const { return n; } };
struct RmWin { __device__ __forceinline__ int operator()(int n) const { if (n < 2944) return n; if (n < 3456) return n + 128; const int i = n - 3456; return 3584 + (i < 32 ? 2 * i : 2 * (i - 32) + 1); } };
struct RmQ   { __device__ __forceinline__ int operator()(int n) const { const int r = n % 192, hb = n - r; if (r < 128) return n; const int i = r - 128; return hb + 128 + (i < 32 ? 2 * i : 2 * (i - 32) + 1); } };
struct RmKV  { __device__ __forceinline__ int operator()(int n) const { const int h = n >> 8, c = n & 255; return c < 128 ? h * 128 + c : 2048 + h * 128 + (c - 128); } };
struct RmUp  { __device__ __forceinline__ int operator()(int n) const { return (n >> 7) * 256 + (n & 127); } };
struct RmGate{ __device__ __forceinline__ int operator()(int n) const { return (n >> 7) * 256 + 128 + (n & 127); } };

__device__ __forceinline__ void sincos_d(double a, double& s, double& c) {
    const double kd = __builtin_rint(a * 0.63661977236758134308); const long k = (long)kd;
    double r = __builtin_fma(-kd, 1.57079632679489655800e+00, a); r = __builtin_fma(-kd, 6.12323399573676603587e-17, r);
    const double r2 = r * r;
    double sp = 1.0 / 6227020800.0; sp = sp * r2 - 1.0 / 39916800.0; sp = sp * r2 + 1.0 / 362880.0; sp = sp * r2 - 1.0 / 5040.0; sp = sp * r2 + 1.0 / 120.0; sp = sp * r2 - 1.0 / 6.0; sp = sp * r2 * r + r;
    double cp = 1.0 / 479001600.0; cp = cp * r2 - 1.0 / 3628800.0; cp = cp * r2 + 1.0 / 40320.0; cp = cp * r2 - 1.0 / 720.0; cp = cp * r2 + 1.0 / 24.0; cp = cp * r2 - 0.5; cp = cp * r2 + 1.0;
    const int q = (int)(k & 3);
    s = (q == 0) ? sp : (q == 1) ? cp : (q == 2) ? -sp : -cp;
    c = (q == 0) ? cp : (q == 1) ? -sp : (q == 2) ? -cp : sp;
}

__device__ __forceinline__ void ssm_weights_group(int g, const float* a_re, const float* a_im, const float* b_re, const float* b_im, const float* c_re, const float* c_im,
                                                  const float* log_dt, const float* dskip, bf16* W1t, bf16* W2t, LAS float* L, int tid) {
    LAS float* PW = L;
    LAS float* BB = PW + 2 * 17 * 64 * 2;
    LAS float* CC = BB + 2 * 64 * 16 * 2;
    LAS float* KT = CC + 2 * 16 * 64 * 2;
    for (int i = tid; i < 2 * 17 * 64; i += 512) { const int d = i / (17 * 64), e = (i / 64) % 17, p = i & 63;
        const double dt = exp((double)log_dt[d * 128 + g]); const double are = a_re[(d * 128 + g) * 64 + p], aim = a_im[(d * 128 + g) * 64 + p];
        const double mag = exp((double)e * dt * are); double s, c; sincos_d((double)e * dt * aim, s, c);
        PW[i * 2] = (float)(mag * c); PW[i * 2 + 1] = (float)(mag * s); }
    for (int i = tid; i < 2 * 64 * 16; i += 512) { const int d = i / 1024, p = (i >> 4) & 63, h = i & 15;
        const double dt = exp((double)log_dt[d * 128 + g]); const double are = a_re[(d * 128 + g) * 64 + p], aim = a_im[(d * 128 + g) * 64 + p];
        const double x = dt * are, y = dt * aim; double sy, cy, sh, ch; sincos_d(y, sy, cy); sincos_d(0.5 * y, sh, ch);
        const double em1 = expm1(x); const double re1 = em1 * cy - 2.0 * sh * sh, im1 = (em1 + 1.0) * sy;
        const double den = are * are + aim * aim; const double qre = (re1 * are + im1 * aim) / den, qim = (im1 * are - re1 * aim) / den;
        const size_t bi = ((size_t)((d * 128 + g) * 64 + p)) * 16 + h; const double br = b_re[bi], bim = b_im[bi];
        BB[i * 2] = (float)(qre * br - qim * bim); BB[i * 2 + 1] = (float)(qre * bim + qim * br); }
    for (int i = tid; i < 2 * 16 * 64; i += 512) { const int d = i / 1024, h = (i >> 6) & 15, p = i & 63; const size_t ci = ((size_t)((d * 128 + g) * 16 + h)) * 64 + p;
        CC[i * 2] = c_re[ci]; CC[i * 2 + 1] = c_im[ci]; }
    __syncthreads();
    { const int d = tid >> 8, e = (tid >> 4) & 15, h = tid & 15; float acc[16];
#pragma unroll
        for (int q = 0; q < 16; ++q) acc[q] = 0.f;
        for (int p = 0; p < 64; ++p) { const float cr = CC[((d * 16 + h) * 64 + p) * 2], ci = CC[((d * 16 + h) * 64 + p) * 2 + 1];
            const float pr = PW[((d * 17 + e) * 64 + p) * 2], pi = PW[((d * 17 + e) * 64 + p) * 2 + 1];
            const float tr = cr * pr - ci * pi, ti = cr * pi + ci * pr; const LAS f32x4* bp = (const LAS f32x4*)(BB + ((d * 64 + p) * 16) * 2);
#pragma unroll
            for (int q = 0; q < 8; ++q) { const f32x4 b = bp[q]; acc[2 * q] += tr * b[0] - ti * b[1]; acc[2 * q + 1] += tr * b[2] - ti * b[3]; } }
#pragma unroll
        for (int q = 0; q < 16; ++q) KT[((d * 16 + e) * 16 + h) * 16 + q] = acc[q]; }
    __syncthreads();
    for (int i = tid; i < 256 * 32; i += 512) { const int n = i >> 5, k0 = (i & 31) * 8; const int d = n >> 7, im = (n >> 6) & 1, p = n & 63; const int s = k0 >> 4, h0 = k0 & 15, e = d ? s : 15 - s;
        const float pr = PW[((d * 17 + e) * 64 + p) * 2], pi = PW[((d * 17 + e) * 64 + p) * 2 + 1]; float v[8];
#pragma unroll
        for (int j = 0; j < 8; ++j) { const float br = BB[((d * 64 + p) * 16 + h0 + j) * 2], bi = BB[((d * 64 + p) * 16 + h0 + j) * 2 + 1]; v[j] = im ? (pr * bi + pi * br) : (pr * br - pi * bi); }
        v4u o; o.x = pk2(v[0], v[1]); o.y = pk2(v[2], v[3]); o.z = pk2(v[4], v[5]); o.w = pk2(v[6], v[7]);
        *(GAS v4u*)(W1t + ((size_t)(g * 256 + n)) * 256 + k0) = o; }
    for (int i = tid; i < 256 * 64; i += 512) { const int n = i >> 6, k0 = (i & 63) * 8; const int j = n >> 4, h = n & 15; float v[8];
        if (k0 < 256) { const int d = k0 >> 7, im = (k0 >> 6) & 1, p0 = k0 & 63, e = d ? 16 - j : j + 1;
#pragma unroll
            for (int q = 0; q < 8; ++q) { const int p = p0 + q; const float cr = CC[((d * 16 + h) * 64 + p) * 2], ci = CC[((d * 16 + h) * 64 + p) * 2 + 1];
                const float pr = PW[((d * 17 + e) * 64 + p) * 2], pi = PW[((d * 17 + e) * 64 + p) * 2 + 1]; v[q] = im ? -(cr * pi + ci * pr) : (cr * pr - ci * pi); }
        } else { const int s = (k0 - 256) >> 4, h0 = (k0 - 256) & 15;
#pragma unroll
            for (int q = 0; q < 8; ++q) { const int hh = h0 + q; float val = 0.f;
                if (s <= j) val += KT[((0 * 16 + (j - s)) * 16 + h) * 16 + hh];
                if (s >= j) val += KT[((1 * 16 + (s - j)) * 16 + h) * 16 + hh];
                if (s == j && h == hh) val += dskip[g * 16 + h];
                v[q] = val; } }
        v4u o; o.x = pk2(v[0], v[1]); o.y = pk2(v[2], v[3]); o.z = pk2(v[4], v[5]); o.w = pk2(v[6], v[7]);
        *(GAS v4u*)(W2t + ((size_t)(g * 256 + n)) * 512 + k0) = o; }
    __syncthreads();
}
#ifndef PROBE_ATTN
#define PROBE_ATTN 1
#endif
#ifndef PROBE_P0
#define PROBE_P0 1
#endif
#ifndef PROBE_P1
#define PROBE_P1 1
#endif
#ifndef PROBE_P7
#define PROBE_P7 1
#endif
#ifndef PROBE_FA
#define PROBE_FA 1
#endif

struct Args { const float* in[27]; float* out; unsigned char* ws; int ph_lo, ph_hi; };

__global__ void __launch_bounds__(NWAVES * 64, 2) enc_fwd(Args args) {
    extern __shared__ __attribute__((aligned(16))) unsigned char lds[];
    LAS unsigned char* ldsb = (LAS unsigned char*)lds;
    volatile LAS unsigned* MISC = (volatile LAS unsigned*)(ldsb + MISC_OFF);
    const int wave0 = __builtin_amdgcn_readfirstlane(threadIdx.x >> 6);
    const int G = gridDim.x, bx = blockIdx.x; const int vcu = (G % 8 == 0) ? (bx % 8) * (G / 8) + bx / 8 : bx;
    const int NGW = G * NWAVES, NGT = G * NWAVES * 64;
    gu32* ctl = (gu32*)(args.ws + WS_CTL);
#define PHB unsigned char* wsl = args.ws; unsigned char* outl = (unsigned char*)args.out; asm volatile("" : "+s"(wsl), "+s"(outl)); \
    int tid = wave0 * 64 + (int)__builtin_amdgcn_mbcnt_hi(~0u, __builtin_amdgcn_mbcnt_lo(~0u, 0u)); asm volatile("" : "+v"(tid)); const int lane = tid & 63, wave = wave0; \
    const int gw = vcu * NWAVES + wave, gt = vcu * (NWAVES * 64) + tid; (void)lane; (void)gw; (void)gt; (void)wsl; (void)outl
#define x_p (args.in[0])
#define x_s (args.in[1])
#define rstd_x ((float*)(wsl + WS_RSTDX))
#define rstd_q ((float*)(wsl + WS_RSTDQ))
#define rstd_kv ((float*)(wsl + WS_RSTDKV))
#define r2v ((float*)(wsl + WS_R2))
#define ratio ((float*)(wsl + WS_RATIO))
#define rstd_x1 ((float*)(wsl + WS_RSTDX1))
#define stA ((float*)(wsl + WS_STA))
#define stB ((float*)(wsl + WS_STB))
#define stQ ((float*)(wsl + WS_STQ))
#define stKV ((float*)(wsl + WS_STKV))
#define ropetab ((float*)(wsl + WS_ROPE))
#define Wi ((bf16*)(wsl + WS_WIN))
#define Wglu ((bf16*)(wsl + WS_WGLU))
#define Wq ((bf16*)(wsl + WS_WQ))
#define Wkv ((bf16*)(wsl + WS_WKV))
#define Wout ((bf16*)(wsl + WS_WOUT))
#define Wug ((bf16*)(wsl + WS_WUG))
#define Wdn ((bf16*)(wsl + WS_WDN))
#define W1t ((bf16*)(wsl + WS_W1T))
#define W2t ((bf16*)(wsl + WS_W2T))
#define bufA ((bf16*)(wsl + WS_A))
#define bufB ((bf16*)(wsl + WS_B))
#define qlat ((bf16*)(wsl + WS_QLAT))
#define kvlat ((bf16*)(wsl + WS_KVLAT))
#define krope ((bf16*)(wsl + WS_KROPE))
#define gact ((bf16*)(wsl + WS_GACT))
#define hup ((bf16*)(wsl + WS_HUP))
#define hgate ((bf16*)(wsl + WS_HGATE))
#define X ((bf16*)(outl + OUT_X))
#define kvb ((bf16*)(outl + OUT_KV))
#define vtb ((bf16*)(outl + OUT_KV) + (size_t)T * 2048)
#define xoutf ((float*)outl)
    for (int u = threadIdx.x; u < (LDS_BYTES - LDSCTL_OFF) / 4; u += NWAVES * 64) ((LAS unsigned*)(ldsb + LDSCTL_OFF))[u] = 0u;
    __syncthreads();
    XcdBarrier bar = xcd_barrier_post((unsigned*)(ctl + CW_BAR), MISC + 8);
    const int lo = args.ph_lo, hi = args.ph_hi;
#ifndef PHMASK
#define PHMASK 0xfffffffu
#endif
#define IN(k) (((PHMASK >> ((k) < 9 ? (k) : ((k) >= 18 ? 12 : 9 + ((k) - 9) % 3))) & 1u) && lo <= (k) && (k) < hi)
#define SEAM(k) do { if (IN(k) && IN((k) + 1)) xcd_barrier(bar); } while (0)

#pragma unroll 1
    for (int rep = 0; rep < PROBE_P0; ++rep)
    if (IN(0)) {
        PHB;
        if (rep) __syncthreads();
        if (vcu < 128) ssm_weights_group(vcu, args.in[4], args.in[5], args.in[6], args.in[7], args.in[8], args.in[9], args.in[10], args.in[11], W1t, W2t, (LAS float*)ldsb, tid);
        LAS float* scr = (LAS float*)(ldsb + wave * 16384);
        constexpr int I_IN = 64 * 55, I_GLU = 32 * 32, I_Q = 14 * 48, I_KV = 8 * 64, I_OUT = 64 * 64, I_UP = 64 * 172, I_DN = 172 * 64;
        constexpr int NITEMS = I_IN + I_GLU + I_Q + I_KV + I_OUT + 2 * I_UP + I_DN;
#ifndef PROBE_TR
#define PROBE_TR 1
#endif
#ifndef PROBE_X
#define PROBE_X 1
#endif
        for (int it2 = gw; it2 < PROBE_TR * NITEMS; it2 += NGW) { const int it = it2 % NITEMS;
            int r = it;
            if (r < I_IN) { transpose_item(args.in[2], 4096, 3520, Wi, args.in[3], args.in[3], 4096, RmWin(), scr, r, lane); continue; } r -= I_IN;
            if (r < I_GLU) { transpose_item(args.in[12], 2048, 2048, Wglu, nullptr, nullptr, 0, RmId(), scr, r, lane); continue; } r -= I_GLU;
            if (r < I_Q) { transpose_item(args.in[14], 896, 3072, Wq, args.in[13], args.in[13], 896, RmQ(), scr, r, lane); continue; } r -= I_Q;
            if (r < I_KV) { transpose_item(args.in[16], 512, 4096, Wkv, args.in[15], args.in[15], 512, RmKV(), scr, r, lane); continue; } r -= I_KV;
            if (r < I_OUT) { transpose_item(args.in[19], 4096, 4096, Wout, args.in[17], args.in[18], 2048, RmId(), scr, r, lane); continue; } r -= I_OUT;
            if (r < I_UP) { transpose_item(args.in[21], 4096, 11008, Wug, args.in[20], args.in[20], 4096, RmUp(), scr, r, lane); continue; } r -= I_UP;
            if (r < I_UP) { transpose_item(args.in[22], 4096, 11008, Wug, args.in[20], args.in[20], 4096, RmGate(), scr, r, lane); continue; } r -= I_UP;
            transpose_item(args.in[25], 11008, 4096, Wdn, nullptr, nullptr, 0, RmId(), scr, r, lane);
        }
        for (int i = gt; i < 320 * 512; i += NGT) { const int rr = i >> 9, c8 = (i & 511) * 8; const int row = rr < 128 ? 2944 + rr : 3648 + (rr - 128);
            *(GAS v4u*)(Wi + (size_t)row * 4096 + c8) = (v4u){0u, 0u, 0u, 0u}; }
        for (int m2 = gw; m2 < PROBE_X * T; m2 += NGW) { const int m = m2 % T; const float* xr = m < 16384 ? x_p + (size_t)m * DM : x_s + (size_t)(m - 16384) * DM;
            f32x4 v[16]; float s = 0.f;
#pragma unroll
            for (int j = 0; j < 16; ++j) { v[j] = *((const GAS f32x4*)xr + lane + 64 * j); s += (v[j].x * v[j].x + v[j].y * v[j].y) + (v[j].z * v[j].z + v[j].w * v[j].w); }
            s = wave_sum(s); if (lane == 0) rstd_x[m] = 1.0f / sqrtf(s * (1.0f / DM) + EPS);
            GAS v2u* o8 = (GAS v2u*)(bufA + (size_t)m * DM) + lane;
#pragma unroll
            for (int j = 0; j < 16; ++j) o8[64 * j] = (v2u){pg8::cvt_pk_bf16(v[j].x, v[j].y), pg8::cvt_pk_bf16(v[j].z, v[j].w)}; }
        for (int i = gt; i < 8192 * 32; i += NGT) { const int pos = i >> 5, k = i & 31; const double inv = exp(-(double)k * (9.210340371976184 / 32.0));
            double s, c; sincos_d((double)pos * inv, s, c); *(GAS f32x2*)(ropetab + (size_t)i * 2) = (f32x2){(float)c, (float)s}; }
    }
    SEAM(0);

#pragma unroll 1
    for (int rep = 0; rep < PROBE_P1; ++rep)
    if (IN(1)) {
        PHB;
        pg8::Gemm g{bufA, Wi, DM, DM, DM}; pg8::StaticOrder S; S.init(T, 3840, G, bx);
        pg8::EpiWin E{rstd_x, X, qlat, kvlat, krope, stQ, stKV, ropetab};
        pg8::gemm_phase(ldsb, g, S, E, tid);
    }
    SEAM(1);

    if (IN(2)) {
        PHB;
        pg8::Gemm g{X + 256, W1t, 512, 256, 256}; pg8::GroupOrder S{768, 6, G, bx};
        pg8::EpiSsm1 E{X};
        pg8::gemm_phase(ldsb, g, S, E, tid);
        for (int r = gt; r < T; r += NGT) { float s = 0.f;
#pragma unroll
            for (int j = 0; j < 4; ++j) { const f32x4 v = *(const GAS f32x4*)(stQ + (size_t)r * 16 + 4 * j); s += (v.x + v.y) + (v.z + v.w); }
            rstd_q[r] = 1.0f / sqrtf(s * (1.0f / QLAT) + EPS); float s2 = 0.f;
#pragma unroll
            for (int j = 0; j < 2; ++j) { const f32x4 v = *(const GAS f32x4*)(stKV + (size_t)r * 8 + 4 * j); s2 += (v.x + v.y) + (v.z + v.w); }
            rstd_kv[r] = 1.0f / sqrtf(s2 * (1.0f / KVLAT) + EPS); }
    }
    SEAM(2);

    if (IN(3)) {
        PHB;
        const bool scan_cu = (G == 256) ? ((vcu & 1) == 0) : true;
        if (G == 256 ? scan_cu : (wave < 4)) { const int task = (G == 256) ? (vcu >> 1) * 8 + wave : vcu * 4 + wave;
            if (task < 1024) { const int seq = task >> 8, g = (task >> 1) & 127, dir = task & 1, p = lane;
                const int c0 = seq < 2 ? seq * 512 : 1024 + (seq - 2) * 256, nc = seq < 2 ? 512 : 256;
                const double dt = exp((double)args.in[10][dir * 128 + g]); const double are = args.in[4][(dir * 128 + g) * 64 + p], aim = args.in[5][(dir * 128 + g) * 64 + p];
                const double mag = exp(16.0 * dt * are); double sn, cs; sincos_d(16.0 * dt * aim, sn, cs);
                const float ar = (float)(mag * cs), ai = (float)(mag * sn);
                GAS bf16* Xg = (GAS bf16*)X + (size_t)g * NCHUNK * 512 + dir * 128 + p;
                float zr = 0.f, zi = 0.f;
                for (int cb = 0; cb < nc; cb += 16) {
                    unsigned short sre[16], sim[16];
#pragma unroll
                    for (int i = 0; i < 16; ++i) { const int c = dir ? (c0 + nc - 1 - (cb + i)) : (c0 + cb + i); sre[i] = Xg[(size_t)c * 512]; sim[i] = Xg[(size_t)c * 512 + 64]; }
#pragma unroll
                    for (int i = 0; i < 16; ++i) { const int c = dir ? (c0 + nc - 1 - (cb + i)) : (c0 + cb + i);
                        Xg[(size_t)c * 512] = (bf16)f2bf(zr); Xg[(size_t)c * 512 + 64] = (bf16)f2bf(zi);
                        const float sr = bf2f(sre[i]), si = bf2f(sim[i]); const float nr = ar * zr - ai * zi + sr, ni = ar * zi + ai * zr + si; zr = nr; zi = ni; }
                }
            }
        }
        __syncthreads();
        if (G == 256) { pg8::Gemm g{qlat, Wq, QLAT, QLAT, QLAT}; pg8::RangeOrder S{scan_cu ? (vcu >> 1) * 3 : 384 + (vcu >> 1) * 6, scan_cu ? 3 : 6, 12}; pg8::EpiQ E{rstd_q, bufA, ropetab}; pg8::gemm_phase(ldsb, g, S, E, tid); }
        else { pg8::Gemm g{qlat, Wq, QLAT, QLAT, QLAT}; pg8::StaticOrder S; S.init(T, QW, G, bx); pg8::EpiQ E{rstd_q, bufA, ropetab}; pg8::gemm_phase(ldsb, g, S, E, tid); }
        { pg8::Gemm g{kvlat, Wkv, KVLAT, KVLAT, KVLAT}; pg8::StaticOrder S; S.init(T, 2048, G, bx); pg8::EpiKV E{rstd_kv, kvb}; pg8::gemm_phase(ldsb, g, S, E, tid); }
        { pg8::Gemm g{Wkv + (size_t)2048 * KVLAT, kvlat, KVLAT, KVLAT, KVLAT}; pg8::StaticOrder S; S.init(2048, T, G, bx); pg8::EpiVT E{rstd_kv, vtb}; pg8::gemm_phase(ldsb, g, S, E, tid); }
    }
    SEAM(3);

    if (IN(4)) {
        PHB;
        pg8::Gemm g{X, W2t, 512, 512, 512}; pg8::GroupOrder S{768, 6, G, bx};
        pg8::EpiSsm2 E{gact};
        pg8::gemm_phase(ldsb, g, S, E, tid);
    }
    SEAM(4);

    if (IN(5)) {
        PHB;
#ifndef NO_GLU
        { pg8::Gemm g{gact, Wglu, MIXW, MIXW, MIXW}; pg8::StaticOrder S; S.init(T, MIXW, G, bx); pg8::EpiGlu E{gact, bufB, stA}; pg8::gemm_phase(ldsb, g, S, E, tid); }
#endif
#ifndef NO_ATTN
        const int xcd = vcu >> 5, cc = vcu & 31; const int nun = (G == 256) ? 6 : (1536 - bx + G - 1) / G;
#pragma unroll 1
        for (int i = 0; i < nun; ++i) {
            int bh, qb, seq, rowbase;
            if (G == 256) { if (i < 4) { bh = xcd * 4 + i; qb = cc; seq = 8192; } else { bh = xcd * 4 + 2 * (i - 4) + (cc >> 4); qb = cc & 15; seq = 4096; } }
            else { const int uidx = bx + i * G; if (uidx < 1024) { bh = uidx >> 5; qb = uidx & 31; seq = 8192; } else { const int v = uidx - 1024; bh = v >> 4; qb = v & 15; seq = 4096; } }
            const int b = bh >> 4, h = bh & 15; rowbase = (seq == 8192) ? b * 8192 : 16384 + b * 4096;
            __syncthreads();
            attn::attn_unit(bufA + (size_t)(rowbase + qb * 256) * QW + h * 192, kvb + (size_t)rowbase * 2048 + h * 128, vtb + (size_t)(h * 128) * T,
                            krope + (size_t)rowbase * 64, bufB + (size_t)(rowbase + qb * 256) * DM + 2048 + h * 128, stB + (size_t)(rowbase + qb * 256) * 16 + h, seq, rowbase, (char*)lds, wave0);
        }
#endif
    }
    SEAM(5);

    if (IN(6)) {
        PHB;
        for (int r = gt; r < T; r += NGT) { float s = 0.f;
#pragma unroll
            for (int j = 0; j < 8; ++j) { const f32x4 v = *(const GAS f32x4*)(stA + (size_t)r * 32 + 4 * j); s += (v.x + v.y) + (v.z + v.w); }
            const float r1 = 1.0f / sqrtf(s * (1.0f / MIXW) + EPS); float s2 = 0.f;
#pragma unroll
            for (int j = 0; j < 4; ++j) { const f32x4 v = *(const GAS f32x4*)(stB + (size_t)r * 16 + 4 * j); s2 += (v.x + v.y) + (v.z + v.w); }
            const float r2 = 1.0f / sqrtf(s2 * (1.0f / MIXW) + EPS); r2v[r] = r2; ratio[r] = r1 / r2; }
    }
    SEAM(6);

#pragma unroll 1
    for (int rep = 0; rep < PROBE_P7; ++rep)
    if (IN(7)) {
        PHB;
        pg8::Gemm g{bufB, Wout, DM, DM, DM}; pg8::StaticOrder S; S.init(T, DM, G, bx);
        pg8::EpiWout E{x_p, x_s, r2v, ratio, bufA, stA};
        pg8::gemm_phase(ldsb, g, S, E, tid);
    }
    SEAM(7);

    if (IN(8)) {
        PHB;
        for (int r = gt; r < T; r += NGT) { float s = 0.f;
#pragma unroll
            for (int j = 0; j < 16; ++j) { const f32x4 v = *(const GAS f32x4*)(stA + (size_t)r * 64 + 4 * j); s += (v.x + v.y) + (v.z + v.w); }
            rstd_x1[r] = 1.0f / sqrtf(s * (1.0f / DM) + EPS); }
    }
    SEAM(8);

#ifdef PROBE_DOWN
    if (IN(9)) { PHB;
#pragma unroll 1
        for (int ch = 0; ch < 3; ++ch) { pg8::Gemm g{bufB, Wdn, DFF, DFF, DFF}; pg8::StaticOrder S; S.init(8192, DM, G, bx); pg8::EpiNull E0; pg8::gemm_phase(ldsb, g, S, E0, tid); }
    }
#endif
#ifdef PROBE_KLOOP
    if (IN(9)) {
        PHB;
#pragma unroll 1
        for (int ch = 0; ch < 3; ++ch) { pg8::Gemm g{bufA + (size_t)(ch * 8192) * DM, Wug, DM, DM, DM}; pg8::StaticOrder S; S.init(8192, 2 * DFF, G, bx); pg8::EpiNull E0; pg8::gemm_phase(ldsb, g, S, E0, tid); }
    }
#endif
#pragma unroll 1
    for (int ch2 = 0; ch2 < 3 * PROBE_FA; ++ch2) {
        const int ch = ch2 / PROBE_FA; const bool lastrep = (ch2 % PROBE_FA) == PROBE_FA - 1;
        const int rb = ch * 8192;
        if (IN(9 + 3 * ch)) {
        PHB;
            pg8::Gemm g{bufA + (size_t)rb * DM, Wug, DM, DM, DM}; pg8::StaticOrder S; S.init(8192, 2 * DFF, G, bx);
            pg8::EpiFfnA E{rstd_x1, rb, bufB, hup, hgate, args.in[23], args.in[24]};
            pg8::gemm_phase(ldsb, g, S, E, tid);
        }
        SEAM(9 + 3 * ch);
        if (lastrep && IN(10 + 3 * ch)) {
        PHB;
            const float* cw = args.in[23]; const float* cb = args.in[24];
            for (int i = gt; i < 128 * 2 * (DFF / 8); i += NGT) { const int f0 = (i % (DFF / 8)) * 8, sw = i / (DFF / 8), strip = sw >> 1, which = sw & 1;
                const int lrow = strip * 64 + (which ? 63 : 0), grow = rb + lrow, pos = pos_of(grow), len = len_of(grow);
                v4u up0, up1, up2;
                if (which == 0) { up1 = *(const GAS v4u*)(hup + ((size_t)strip * 4 + 0) * DFF + f0); up2 = *(const GAS v4u*)(hup + ((size_t)strip * 4 + 1) * DFF + f0);
                    up0 = (pos == 0) ? (v4u){0u, 0u, 0u, 0u} : *(const GAS v4u*)(hup + ((size_t)(strip - 1) * 4 + 3) * DFF + f0); }
                else { up0 = *(const GAS v4u*)(hup + ((size_t)strip * 4 + 2) * DFF + f0); up1 = *(const GAS v4u*)(hup + ((size_t)strip * 4 + 3) * DFF + f0);
                    up2 = (pos == len - 1) ? (v4u){0u, 0u, 0u, 0u} : *(const GAS v4u*)(hup + ((size_t)(strip + 1) * 4 + 0) * DFF + f0); }
                const v4u gt4 = *(const GAS v4u*)(hgate + ((size_t)strip * 2 + which) * DFF + f0);
                unsigned ow[4];
#pragma unroll
                for (int k = 0; k < 4; ++k) { const int f = f0 + 2 * k;
                    const float a0 = bflo(up0[k]), a1 = bflo(up1[k]), a2 = bflo(up2[k]), b0 = bfhi(up0[k]), b1 = bfhi(up1[k]), b2 = bfhi(up2[k]);
                    const float c0 = cw[f] * a0 + cw[DFF + f] * a1 + cw[2 * DFF + f] * a2 + cb[f], c1 = cw[f + 1] * b0 + cw[DFF + f + 1] * b1 + cw[2 * DFF + f + 1] * b2 + cb[f + 1];
                    ow[k] = pk2(c0 * sigmoidf_fast(c0) * bflo(gt4[k]), c1 * sigmoidf_fast(c1) * bfhi(gt4[k])); }
                *(GAS v4u*)(bufB + (size_t)lrow * DFF + f0) = (v4u){ow[0], ow[1], ow[2], ow[3]}; }
        }
        if (lastrep) SEAM(10 + 3 * ch);
        if (lastrep && IN(11 + 3 * ch)) {
        PHB;
            pg8::Gemm g{bufB, Wdn, DFF, DFF, DFF}; pg8::StaticOrder S; S.init(8192, DM, G, bx);
            pg8::EpiDown E{bufA, rb, stA};
            pg8::gemm_phase(ldsb, g, S, E, tid);
        }
        if (lastrep) SEAM(11 + 3 * ch);
    }

    if (IN(18)) {
        PHB;
        const float* gf = args.in[26];
        for (int m = gw; m < T; m += NGW) { const float s = wave_sum(stA[(size_t)m * 64 + lane]); const float rs = 1.0f / sqrtf(s * (1.0f / DM) + EPS);
            const GAS v4u* xr = (const GAS v4u*)(bufA + (size_t)m * DM) + lane; GAS f32x4* orow = (GAS f32x4*)(xoutf + (size_t)m * DM) + 2 * lane; const GAS f32x4* gr = (const GAS f32x4*)gf + 2 * lane;
#pragma unroll
            for (int j = 0; j < 8; ++j) { const v4u w = xr[64 * j]; const f32x4 g0 = gr[128 * j], g1 = gr[128 * j + 1];
                orow[128 * j] = (f32x4){bflo(w.x) * rs * g0[0], bfhi(w.x) * rs * g0[1], bflo(w.y) * rs * g0[2], bfhi(w.y) * rs * g0[3]};
                orow[128 * j + 1] = (f32x4){bflo(w.z) * rs * g1[0], bfhi(w.z) * rs * g1[1], bflo(w.w) * rs * g1[2], bfhi(w.w) * rs * g1[3]}; } }
    }
#undef IN
#undef SEAM
}

constexpr int N_PHASES = 19;
extern "C" void kernel_launch(void* const* d_in, const int* in_sizes, int n_in, void* d_out, int out_size, void* d_ws, size_t ws_size, hipStream_t stream) {
    static int grid = 0;
    if (grid == 0) {
        if (n_in != 27 || out_size != T * DM || ws_size < WS_END) { fprintf(stderr, "kernel_launch: unexpected shapes (n_in %d out %d ws %zu)\n", n_in, out_size, ws_size); grid = -1; return; }
        int dev = 0, cus = 0, per_cu = 0;
        if (hipGetDevice(&dev) != hipSuccess || hipDeviceGetAttribute(&cus, hipDeviceAttributeMultiprocessorCount, dev) != hipSuccess) { grid = -1; return; }
        if (hipFuncSetAttribute((const void*)enc_fwd, hipFuncAttributeMaxDynamicSharedMemorySize, LDS_BYTES) != hipSuccess) { fprintf(stderr, "kernel_launch: hipFuncSetAttribute failed\n"); grid = -1; return; }
        if (hipOccupancyMaxActiveBlocksPerMultiprocessor(&per_cu, (const void*)enc_fwd, NWAVES * 64, LDS_BYTES) != hipSuccess || per_cu < 1) { fprintf(stderr, "kernel_launch: occupancy query says %d\n", per_cu); }
        (void)hipGetLastError();
        grid = cus;
    }
    if (grid < 0) return;
    if (hipMemsetAsync((char*)d_ws + WS_CTL, 0, CTL_ZERO_BYTES, stream) != hipSuccess) return;
    Args a{};
    for (int i = 0; i < 27; ++i) a.in[i] = (const float*)d_in[i];
    a.out = (float*)d_out; a.ws = (unsigned char*)d_ws;
#ifndef MK_N_LAUNCHES
#define MK_N_LAUNCHES 1
#endif
    if (MK_N_LAUNCHES == 1) { a.ph_lo = 0; a.ph_hi = N_PHASES; hipLaunchKernelGGL(enc_fwd, dim3(grid), dim3(NWAVES * 64), LDS_BYTES, stream, a); }
    else { for (int p = 0; p < N_PHASES; ++p) { a.ph_lo = p; a.ph_hi = p + 1; hipLaunchKernelGGL(enc_fwd, dim3(grid), dim3(NWAVES * 64), LDS_BYTES, stream, a); } }
    const hipError_t le = hipPeekAtLastError();
    if (le != hipSuccess) fprintf(stderr, "kernel_launch: launch failed: %s\n", hipGetErrorName(le));
}
```

```cpp
#include <hip/hip_runtime.h>
#include <hip/hip_bf16.h>
#include <cstdio>
#include <cstdint>

namespace pg8 {
#define PG8_LAS __attribute__((address_space(3)))
typedef unsigned short bf16_t;
typedef short bf16x8 __attribute__((ext_vector_type(8)));
typedef float f32x4 __attribute__((ext_vector_type(4)));
typedef float f32x2 __attribute__((ext_vector_type(2)));
typedef unsigned u32x4 __attribute__((ext_vector_type(4)));
typedef unsigned u32x2 __attribute__((ext_vector_type(2)));
constexpr int BM = 256, BK = 64, HALF = 128, HTB = HALF * BK * 2  , STAGE_BYTES = 8 * HTB, NXCD = 8, WGM = 8;

__host__ __device__ __forceinline__ int lds_byte(int r, int c) { const int st = (r >> 4) * 2 + (c >> 5), rr = r & 15, cc = c & 31, ob = rr * 64 + cc * 2; return st * 1024 + (ob ^ (((ob >> 9) & 1) << 5)); }
__host__ __device__ __forceinline__ void stage_rc(int b, int& R, int& C) { const int st = b / 1024, sb = b % 1024, swz = sb ^ (((sb >> 9) & 1) << 5); R = (st >> 1) * 16 + swz / 64; C = (st & 1) * 32 + (swz % 64) / 2; }
__host__ __device__ __forceinline__ int perm32(int rho) { const int n = rho >> 4, i = rho & 15; return 8 * (i >> 2) + 4 * n + (i & 3); }

struct Unit { int pm, pn; };
struct Gemm { const bf16_t* A; const bf16_t* Bt; int lda, ldb, K; };

struct StaticOrder {
    int nM, nN, nwg, G, c;
    __host__ __device__ void init(int M, int N, int G_, int c_) { nM = M / BM; nN = N / BM; nwg = nM * nN; G = G_; c = c_; }
    __host__ __device__ bool next(int i, Unit& u) const {
        const long L = (long)i * G + c; if (L >= nwg) return false;
        int wgid = (int)L; { const int q = nwg / NXCD, r = nwg % NXCD, xcd = wgid % NXCD, off = wgid / NXCD; wgid = (xcd < r ? xcd * (q + 1) : r * (q + 1) + (xcd - r) * q) + off; }
        const int nig = WGM * nN, gid = wgid / nig, fm = gid * WGM, gsz = (nM - fm) < WGM ? (nM - fm) : WGM;
        u.pm = fm + ((wgid % nig) % gsz); u.pn = (wgid % nig) / gsz; return true;
    }
};
struct ZeroOrder { int n, G, c; __host__ __device__ bool next(int i, Unit& u) const { const long L = (long)i * G + c; if (L >= n) return false; u.pm = 0; u.pn = 0; return true; } };
struct RangeOrder { int base, n, nN; __host__ __device__ bool next(int i, Unit& u) const { if (i >= n) return false; const int L = base + i; u.pm = L / nN; u.pn = L % nN; return true; } };
struct GroupOrder {
    int n, per, G, c;
    __host__ __device__ bool next(int i, Unit& u) const { const long L = (long)i * G + c; if (L >= n) return false; u.pm = (int)L; u.pn = (int)L / per; return true; }
};

__device__ __forceinline__ unsigned cvt_pk_bf16(float lo, float hi) { unsigned r; asm volatile("v_cvt_pk_bf16_f32 %0, %1, %2" : "=v"(r) : "v"(lo), "v"(hi)); return r; }
__device__ __forceinline__ u32x4 pack8(const f32x4 a, const f32x4 b) { u32x4 w; w.x = cvt_pk_bf16(a[0], a[1]); w.y = cvt_pk_bf16(a[2], a[3]); w.z = cvt_pk_bf16(b[0], b[1]); w.w = cvt_pk_bf16(b[2], b[3]); return w; }

template <class Epi, class Sched>
__device__ __forceinline__ void gemm_phase(PG8_LAS unsigned char* lds, const Gemm g, const Sched& S, const Epi& E, int tid_in) {
    int tid_l = tid_in; asm volatile("" : "+v"(tid_l));
    const int tid = tid_l, wid = __builtin_amdgcn_readfirstlane(tid >> 6), lane = tid & 63, wr = wid >> 2, wc = wid & 3, fr = lane & 15, fq = lane >> 4;
    const int K = g.K, nt = K / BK;
    unsigned voffA[2], voffB[2];
#pragma unroll
    for (int i = 0; i < 2; ++i) { int R, C; stage_rc(tid * 16 + i * 8192, R, C); const int Rb = Epi::PERM ? ((R & ~31) + perm32(R & 31)) : R;
        voffA[i] = (unsigned)(R * g.lda + C) * 2u; voffB[i] = (unsigned)(Rb * g.ldb + C) * 2u; }
    asm volatile("" : "+v"(voffA[0]), "+v"(voffA[1]), "+v"(voffB[0]), "+v"(voffB[1]));
    const size_t kstep = (size_t)(BK * 2);
    const size_t hstepA = (size_t)HALF * g.lda * 2, hstepB = (size_t)HALF * g.ldb * 2;
    const size_t tstepA = 2 * hstepA, tstepB = 2 * hstepB;
    const unsigned ldsw = (unsigned)wid * 1024u;
    const int aoff = lds_byte(wr * 64 + fr, fq * 8), boff = lds_byte(wc * 32 + fr, fq * 8);
#define PG8_SA(b, h) (((b) * 2 + (h)) * HTB)
#define PG8_SB(b, h) ((4 + (b) * 2 + (h)) * HTB)
#define PG8_STAGE(bufoff, gbase, voff) do { _Pragma("unroll") for (int _i = 0; _i < 2; ++_i) \
        __builtin_amdgcn_global_load_lds((const unsigned*)((const char*)(gbase) + (voff)[_i]), (PG8_LAS unsigned*)(lds + (bufoff) + ldsw + _i * 8192), 16, 0, 0); } while (0)
#define PG8_LDA(dst, b, h) do { _Pragma("unroll") for (int m = 0; m < 4; ++m) _Pragma("unroll") for (int k = 0; k < 2; ++k) dst[m][k] = *(const PG8_LAS bf16x8*)(lds + PG8_SA(b, h) + aoff + m * 2048 + k * 1024); } while (0)
#define PG8_LDB(dst, b, h) do { _Pragma("unroll") for (int n = 0; n < 2; ++n) _Pragma("unroll") for (int k = 0; k < 2; ++k) dst[n][k] = *(const PG8_LAS bf16x8*)(lds + PG8_SB(b, h) + boff + n * 2048 + k * 1024); } while (0)
#define PG8_MMA(ai, bj, At, Bt) do { __builtin_amdgcn_s_setprio(1); _Pragma("unroll") for (int m = 0; m < 4; ++m) _Pragma("unroll") for (int n = 0; n < 2; ++n) _Pragma("unroll") for (int k = 0; k < 2; ++k) \
        acc[ai][bj][m][n] = __builtin_amdgcn_mfma_f32_16x16x32_bf16(Bt[n][k], At[m][k], acc[ai][bj][m][n], 0, 0, 0); __builtin_amdgcn_s_setprio(0); } while (0)
#define PG8_WAIT_V(n) asm volatile("s_waitcnt vmcnt(" #n ")" ::: "memory")
#define PG8_WAIT_L(n) asm volatile("s_waitcnt lgkmcnt(" #n ")" ::: "memory")
#define PG8_BAR __builtin_amdgcn_s_barrier()
#define PG8_SCHED __builtin_amdgcn_sched_barrier(0)
    Unit cur, nxt; int ui = 0;
    if (!S.next(0, cur)) return;
    f32x4 acc[2][2][4][2];
#pragma unroll
    for (int a = 0; a < 2; ++a)
#pragma unroll
        for (int b = 0; b < 2; ++b)
#pragma unroll
            for (int m = 0; m < 4; ++m)
#pragma unroll
                for (int n = 0; n < 2; ++n) acc[a][b][m][n] = (f32x4){0.f, 0.f, 0.f, 0.f};
    bf16x8 At[4][2], B0[2][2], B1[2][2];
    const char* cA = (const char*)g.A + (size_t)cur.pm * tstepA; const char* cB = (const char*)g.Bt + (size_t)cur.pn * tstepB;
    PG8_STAGE(PG8_SB(0, 0), cB, voffB); PG8_STAGE(PG8_SB(0, 1), cB + hstepB, voffB); PG8_STAGE(PG8_SA(0, 0), cA, voffA); PG8_STAGE(PG8_SA(0, 1), cA + hstepA, voffA);
    if (wr == 1) PG8_BAR;
    PG8_WAIT_V(2); PG8_BAR;
    PG8_STAGE(PG8_SB(1, 0), cB + kstep, voffB); PG8_STAGE(PG8_SA(1, 0), cA + kstep, voffA); PG8_STAGE(PG8_SB(1, 1), cB + hstepB + kstep, voffB);
    PG8_WAIT_V(6); PG8_BAR;
    for (;;) {
        const bool has_next = S.next(ui + 1, nxt);
        const char* nA = has_next ? (const char*)g.A + (size_t)nxt.pm * tstepA : cA; const char* nB = has_next ? (const char*)g.Bt + (size_t)nxt.pn * tstepB : cB;
#pragma unroll 1
        for (int t = 0; t < nt; t += 2) {
            const bool last = (t == nt - 2);
            if constexpr (Epi::MIDK) { if (t == (nt >> 1)) E.midk(acc, cur, wr, fr); }
            const char* a1 = cA + (size_t)(t + 1) * kstep;
            const char* a2 = last ? nA : cA + (size_t)(t + 2) * kstep; const char* b2 = last ? nB : cB + (size_t)(t + 2) * kstep;
            const char* a3 = a2 + kstep; const char* b3 = b2 + kstep;
            PG8_LDB(B0, 0, 0); PG8_LDB(B1, 0, 1); PG8_SCHED; PG8_LDA(At, 0, 0); PG8_STAGE(PG8_SA(1, 1), a1 + hstepA, voffA);
            PG8_WAIT_V(8); PG8_WAIT_L(0); PG8_BAR; PG8_MMA(0, 0, At, B0); PG8_MMA(0, 1, At, B1); PG8_BAR; PG8_SCHED;
            PG8_LDA(At, 0, 1); PG8_STAGE(PG8_SB(0, 0), b2, voffB); PG8_STAGE(PG8_SB(0, 1), b2 + hstepB, voffB); PG8_STAGE(PG8_SA(0, 0), a2, voffA);
            PG8_WAIT_V(8); PG8_WAIT_L(0); PG8_BAR; PG8_MMA(1, 0, At, B0); PG8_MMA(1, 1, At, B1); PG8_BAR; PG8_SCHED;
            PG8_LDB(B0, 1, 0); PG8_LDB(B1, 1, 1); PG8_SCHED; PG8_LDA(At, 1, 0); PG8_STAGE(PG8_SA(0, 1), a2 + hstepA, voffA);
            PG8_WAIT_V(8); PG8_WAIT_L(0); PG8_BAR; PG8_MMA(0, 0, At, B0); PG8_MMA(0, 1, At, B1); PG8_BAR; PG8_SCHED;
            PG8_LDA(At, 1, 1); PG8_STAGE(PG8_SB(1, 0), b3, voffB); PG8_STAGE(PG8_SB(1, 1), b3 + hstepB, voffB); PG8_STAGE(PG8_SA(1, 0), a3, voffA);
            PG8_WAIT_V(8); PG8_WAIT_L(0); PG8_BAR; PG8_MMA(1, 0, At, B0); PG8_MMA(1, 1, At, B1); PG8_BAR; PG8_SCHED;
        }
        if (wr == 0) PG8_BAR;
        E(acc, cur, wr, wc, fr, fq);
        if (!has_next) break;
#pragma unroll
        for (int a = 0; a < 2; ++a)
#pragma unroll
            for (int b = 0; b < 2; ++b)
#pragma unroll
                for (int m = 0; m < 4; ++m)
#pragma unroll
                    for (int n = 0; n < 2; ++n) acc[a][b][m][n] = (f32x4){0.f, 0.f, 0.f, 0.f};
        cur = nxt; cA = nA; cB = nB; ++ui;
        if (wr == 1) PG8_BAR;
    }
    PG8_WAIT_V(0);
    PG8_BAR;
#undef PG8_SA
#undef PG8_SB
#undef PG8_STAGE
#undef PG8_LDA
#undef PG8_LDB
#undef PG8_MMA
#undef PG8_WAIT_V
#undef PG8_WAIT_L
#undef PG8_BAR
#undef PG8_SCHED
}
}

constexpr int T = 24576, DM = 4096, DFF = 11008;
constexpr int NCHUNK = T / 16;
constexpr int QLAT = 896, KVLAT = 512, QW = 3072, KVW = 4096, MIXW = 2048;
constexpr float EPS = 1e-6f;
__device__ __forceinline__ int pos_of(int r) { return r < 16384 ? (r & 8191) : (r & 4095); }
__device__ __forceinline__ int len_of(int r) { return r < 16384 ? 8192 : 4096; }

typedef unsigned short bf16;
#define GAS __attribute__((address_space(1)))
#define LAS __attribute__((address_space(3)))
typedef unsigned v4u __attribute__((ext_vector_type(4)));
typedef unsigned v2u __attribute__((ext_vector_type(2)));
typedef float f32x4 __attribute__((ext_vector_type(4)));
typedef float f32x2 __attribute__((ext_vector_type(2)));
typedef short bf16x8 __attribute__((ext_vector_type(8)));

__device__ __forceinline__ unsigned f2bf(float f) { unsigned u = __builtin_bit_cast(unsigned, f); return (u + 0x7fffu + ((u >> 16) & 1u)) >> 16; }
__device__ __forceinline__ unsigned pk2(float lo, float hi) { return f2bf(lo) | (f2bf(hi) << 16); }
__device__ __forceinline__ float bf2f(unsigned short b) { return __builtin_bit_cast(float, (unsigned)b << 16); }
__device__ __forceinline__ float bflo(unsigned w) { return __builtin_bit_cast(float, w << 16); }
__device__ __forceinline__ float bfhi(unsigned w) { return __builtin_bit_cast(float, w & 0xffff0000u); }
__device__ __forceinline__ float sigmoidf_fast(float x) { return __builtin_amdgcn_rcpf(1.0f + __builtin_amdgcn_exp2f(-1.4426950408889634f * x)); }
__device__ __forceinline__ float gelu_tanh(float y) { const float in = 1.5957691216057308f * (y + 0.044715f * y * y * y); return y * sigmoidf_fast(in); }

namespace pg8 {
#define EPI_ROWS const int row0 = u.pm * 256 + wr * 64 + fr
__device__ __forceinline__ float sq8(const f32x4 a, const f32x4 b) { return (a[0] * a[0] + a[1] * a[1]) + (a[2] * a[2] + a[3] * a[3]) + (b[0] * b[0] + b[1] * b[1]) + (b[2] * b[2] + b[3] * b[3]); }
__device__ __forceinline__ float red_fq(float s) { s += __shfl_xor(s, 16); s += __shfl_xor(s, 32); return s; }

__device__ __forceinline__ f32x4 rope4(const f32x4 v, const f32x4 cs) { f32x4 o; o[0] = v[0] * cs[0] - v[1] * cs[1]; o[1] = v[1] * cs[0] + v[0] * cs[1]; o[2] = v[2] * cs[2] - v[3] * cs[3]; o[3] = v[3] * cs[2] + v[2] * cs[3]; return o; }

#define LAUNDER(p) asm volatile("" : "+v"(p))
struct EpiNull { static constexpr bool PERM = true, MIDK = false;
    __device__ __forceinline__ void midk(f32x4 (&)[2][2][4][2], const Unit&, int, int) const {}
    __device__ __forceinline__ void operator()(const f32x4 (&acc)[2][2][4][2], const Unit& u, int wr, int wc, int fr, int fq) const {
#pragma unroll
        for (int ai = 0; ai < 2; ++ai)
#pragma unroll
            for (int bj = 0; bj < 2; ++bj)
                asm volatile("" :: "v"(acc[ai][bj][0][0]), "v"(acc[ai][bj][0][1]), "v"(acc[ai][bj][1][0]), "v"(acc[ai][bj][1][1]), "v"(acc[ai][bj][2][0]), "v"(acc[ai][bj][2][1]), "v"(acc[ai][bj][3][0]), "v"(acc[ai][bj][3][1]));
    } };
struct EpiWin {
    static constexpr bool PERM = true, MIDK = false;
    const float* rstd_x; bf16_t* X; bf16_t* qlat; bf16_t* kvlat; bf16_t* krope; float* stQ; float* stKV; const float* ropetab;
    __device__ __forceinline__ void midk(f32x4 (&)[2][2][4][2], const Unit&, int, int) const {}
    __device__ __forceinline__ void operator()(const f32x4 (&acc)[2][2][4][2], const Unit& u, int wr, int wc, int fr, int fq) const {
        EPI_ROWS; const int tile = u.pn;
        const GAS float* rsp = (const GAS float*)(rstd_x + row0); LAUNDER(rsp);
        if (tile < 8) {
            const int c0 = tile * 256 + wc * 32 + 8 * fq;
            GAS bf16_t* xp0 = (GAS bf16_t*)X + ((size_t)((c0 >> 4) * NCHUNK + (row0 >> 4)) * 512 + 256 + (row0 & 15) * 16 + (c0 & 15)); LAUNDER(xp0);
#pragma unroll
            for (int ai = 0; ai < 2; ++ai)
#pragma unroll
                for (int m = 0; m < 4; ++m) { const float rs = rsp[ai * 128 + m * 16];
#pragma unroll
                    for (int bj = 0; bj < 2; ++bj)
                        *(GAS u32x4*)(xp0 + ((size_t)(bj * 8) * NCHUNK + ai * 8 + m) * 512) = pack8(acc[ai][bj][m][0] * rs, acc[ai][bj][m][1] * rs); }
        } else if (tile < 14) {
            const bool isq = tile < 12; const int tl = isq ? tile - 8 : tile - 12; const int ld = isq ? QLAT : KVLAT;
            const int c0 = tl * 256 + wc * 32 + 8 * fq;
            GAS bf16_t* op = (GAS bf16_t*)(isq ? qlat : kvlat) + (size_t)row0 * ld + c0; GAS float* sp = (GAS float*)(isq ? stQ + (size_t)row0 * 16 : stKV + (size_t)row0 * 8) + tl * 4 + wc; LAUNDER(op); LAUNDER(sp);
#pragma unroll
            for (int ai = 0; ai < 2; ++ai)
#pragma unroll
                for (int m = 0; m < 4; ++m) { const float rs = rsp[ai * 128 + m * 16]; float ss = 0.f;
#pragma unroll
                    for (int bj = 0; bj < 2; ++bj) { const f32x4 v0 = acc[ai][bj][m][0] * rs, v1 = acc[ai][bj][m][1] * rs; ss += sq8(v0, v1);
                        if (c0 + bj * 128 < ld) *(GAS u32x4*)(op + (size_t)(ai * 128 + m * 16) * ld + bj * 128) = pack8(v0, v1); }
                    ss = red_fq(ss); if (fq == 0) sp[(size_t)(ai * 128 + m * 16) * (isq ? 16 : 8)] = ss; }
        } else {
            if (wc < 2) { const int c = wc * 32 + 8 * fq;
                GAS bf16_t* op = (GAS bf16_t*)krope + (size_t)row0 * 64 + c; LAUNDER(op);
#pragma unroll
                for (int ai = 0; ai < 2; ++ai)
#pragma unroll
                    for (int m = 0; m < 4; ++m) { const int row = row0 + ai * 128 + m * 16; const float rs = rsp[ai * 128 + m * 16]; const int pos = pos_of(row);
                        const f32x4 cs0 = *(const GAS f32x4*)((const GAS float*)ropetab + (size_t)pos * 64 + c), cs1 = *(const GAS f32x4*)((const GAS float*)ropetab + (size_t)pos * 64 + c + 4);
                        const f32x4 v0 = rope4(acc[ai][0][m][0] * rs, cs0), v1 = rope4(acc[ai][0][m][1] * rs, cs1);
                        *(GAS u32x4*)(op + (size_t)(ai * 128 + m * 16) * 64) = pack8(v0, v1); } }
        }
    }
};
struct EpiSsm1 {
    static constexpr bool PERM = true, MIDK = false;
    bf16_t* X;
    __device__ __forceinline__ void midk(f32x4 (&)[2][2][4][2], const Unit&, int, int) const {}
    __device__ __forceinline__ void operator()(const f32x4 (&acc)[2][2][4][2], const Unit& u, int wr, int wc, int fr, int fq) const {
        EPI_ROWS; GAS bf16_t* op = (GAS bf16_t*)X + (size_t)row0 * 512 + wc * 32 + 8 * fq; LAUNDER(op);
#pragma unroll
        for (int ai = 0; ai < 2; ++ai)
#pragma unroll
            for (int m = 0; m < 4; ++m)
#pragma unroll
                for (int bj = 0; bj < 2; ++bj) *(GAS u32x4*)(op + (size_t)(ai * 128 + m * 16) * 512 + bj * 128) = pack8(acc[ai][bj][m][0], acc[ai][bj][m][1]);
    }
};
struct EpiSsm2 {
    static constexpr bool PERM = true, MIDK = false;
    bf16_t* gact;
    __device__ __forceinline__ void midk(f32x4 (&)[2][2][4][2], const Unit&, int, int) const {}
    __device__ __forceinline__ void operator()(const f32x4 (&acc)[2][2][4][2], const Unit& u, int wr, int wc, int fr, int fq) const {
        EPI_ROWS; const int g = u.pn; const int c0 = wc * 32 + 8 * fq;
        GAS bf16_t* op = (GAS bf16_t*)gact + ((size_t)(row0 - g * NCHUNK) * 16 + (c0 >> 4)) * MIXW + g * 16 + (c0 & 15); LAUNDER(op);
#pragma unroll
        for (int ai = 0; ai < 2; ++ai)
#pragma unroll
            for (int m = 0; m < 4; ++m)
#pragma unroll
                for (int bj = 0; bj < 2; ++bj) { f32x4 v0 = acc[ai][bj][m][0], v1 = acc[ai][bj][m][1];
#pragma unroll
                    for (int e = 0; e < 4; ++e) { v0[e] = gelu_tanh(v0[e]); v1[e] = gelu_tanh(v1[e]); }
                    *(GAS u32x4*)(op + ((size_t)(ai * 128 + m * 16) * 16 + bj * 8) * MIXW) = pack8(v0, v1); }
    }
};
struct EpiQ {
    static constexpr bool PERM = true, MIDK = false;
    const float* rstd_q; bf16_t* q; const float* ropetab;
    __device__ __forceinline__ void midk(f32x4 (&)[2][2][4][2], const Unit&, int, int) const {}
    __device__ __forceinline__ void operator()(const f32x4 (&acc)[2][2][4][2], const Unit& u, int wr, int wc, int fr, int fq) const {
        EPI_ROWS; const GAS float* rsp = (const GAS float*)(rstd_q + row0); GAS bf16_t* op = (GAS bf16_t*)q + (size_t)row0 * QW + u.pn * 256 + wc * 32 + 8 * fq; LAUNDER(rsp); LAUNDER(op);
#pragma unroll
        for (int ai = 0; ai < 2; ++ai)
#pragma unroll
            for (int m = 0; m < 4; ++m) { const int row = row0 + ai * 128 + m * 16; const float rs = rsp[ai * 128 + m * 16] * 0.10411754627697264f;     const int pos = pos_of(row);
#pragma unroll
                for (int bj = 0; bj < 2; ++bj) { const int strip = 8 * u.pn + 4 * bj + wc, s6 = strip % 6;
                    f32x4 v0 = acc[ai][bj][m][0] * rs, v1 = acc[ai][bj][m][1] * rs;
                    if (s6 >= 4) { const int pc = (s6 - 4) * 32 + 8 * fq;
                        const f32x4 cs0 = *(const GAS f32x4*)((const GAS float*)ropetab + (size_t)pos * 64 + pc), cs1 = *(const GAS f32x4*)((const GAS float*)ropetab + (size_t)pos * 64 + pc + 4);
                        v0 = rope4(v0, cs0); v1 = rope4(v1, cs1); }
                    *(GAS u32x4*)(op + (size_t)(ai * 128 + m * 16) * QW + bj * 128) = pack8(v0, v1); } }
    }
};
struct EpiKV {
    static constexpr bool PERM = true, MIDK = false;
    const float* rstd_kv; bf16_t* kv;
    __device__ __forceinline__ void midk(f32x4 (&)[2][2][4][2], const Unit&, int, int) const {}
    __device__ __forceinline__ void operator()(const f32x4 (&acc)[2][2][4][2], const Unit& u, int wr, int wc, int fr, int fq) const {
        EPI_ROWS; const GAS float* rsp = (const GAS float*)(rstd_kv + row0); GAS bf16_t* op = (GAS bf16_t*)kv + (size_t)row0 * 2048 + u.pn * 256 + wc * 32 + 8 * fq; LAUNDER(rsp); LAUNDER(op);
#pragma unroll
        for (int ai = 0; ai < 2; ++ai)
#pragma unroll
            for (int m = 0; m < 4; ++m) { const float rs = rsp[ai * 128 + m * 16];
#pragma unroll
                for (int bj = 0; bj < 2; ++bj) *(GAS u32x4*)(op + (size_t)(ai * 128 + m * 16) * 2048 + bj * 128) = pack8(acc[ai][bj][m][0] * rs, acc[ai][bj][m][1] * rs); }
    }
};
struct EpiVT {
    static constexpr bool PERM = true, MIDK = false;
    const float* rstd_kv; bf16_t* vt;
    __device__ __forceinline__ void midk(f32x4 (&)[2][2][4][2], const Unit&, int, int) const {}
    __device__ __forceinline__ void operator()(const f32x4 (&acc)[2][2][4][2], const Unit& u, int wr, int wc, int fr, int fq) const {
        EPI_ROWS; const int c0 = u.pn * 256 + wc * 32 + 8 * fq; const GAS float* rsp = (const GAS float*)(rstd_kv + c0); GAS bf16_t* op = (GAS bf16_t*)vt + (size_t)row0 * T + c0; LAUNDER(rsp); LAUNDER(op);
        GAS bf16_t* opp = op - 8 * fq + 16 * (fq & 1) + 4 * (fq >> 1);
#pragma unroll
        for (int bj = 0; bj < 2; ++bj) { const f32x4 r0 = *(const GAS f32x4*)(rsp + bj * 128), r1 = *(const GAS f32x4*)(rsp + bj * 128 + 4);
#pragma unroll
            for (int ai = 0; ai < 2; ++ai)
#pragma unroll
                for (int m = 0; m < 4; ++m) { const u32x4 w = pack8(acc[ai][bj][m][0] * r0, acc[ai][bj][m][1] * r1); GAS bf16_t* q_ = opp + (size_t)(ai * 128 + m * 16) * T + bj * 128;
                    *(GAS u32x2*)q_ = (u32x2){w.x, w.y}; *(GAS u32x2*)(q_ + 8) = (u32x2){w.z, w.w}; } }
    }
};
struct EpiGlu {
    static constexpr bool PERM = true, MIDK = false;
    const bf16_t* gact; bf16_t* merged; float* stA;
    __device__ __forceinline__ void midk(f32x4 (&)[2][2][4][2], const Unit&, int, int) const {}
    __device__ __forceinline__ void operator()(const f32x4 (&acc)[2][2][4][2], const Unit& u, int wr, int wc, int fr, int fq) const {
        EPI_ROWS; const int c0 = u.pn * 256 + wc * 32 + 8 * fq;
        const GAS bf16_t* gp = (const GAS bf16_t*)gact + (size_t)row0 * MIXW + c0; GAS bf16_t* op = (GAS bf16_t*)merged + (size_t)row0 * DM + c0; GAS float* sp = (GAS float*)stA + (size_t)row0 * 32 + u.pn * 4 + wc; LAUNDER(gp); LAUNDER(op); LAUNDER(sp);
#pragma unroll
        for (int ai = 0; ai < 2; ++ai)
#pragma unroll
            for (int m = 0; m < 4; ++m) { float ss = 0.f;
#pragma unroll
                for (int bj = 0; bj < 2; ++bj) {
                    const u32x4 gw = *(const GAS u32x4*)(gp + (size_t)(ai * 128 + m * 16) * MIXW + bj * 128);
                    f32x4 v0, v1; const f32x4 a0 = acc[ai][bj][m][0], a1 = acc[ai][bj][m][1];
                    v0[0] = bflo(gw.x) * sigmoidf_fast(a0[0]); v0[1] = bfhi(gw.x) * sigmoidf_fast(a0[1]); v0[2] = bflo(gw.y) * sigmoidf_fast(a0[2]); v0[3] = bfhi(gw.y) * sigmoidf_fast(a0[3]);
                    v1[0] = bflo(gw.z) * sigmoidf_fast(a1[0]); v1[1] = bfhi(gw.z) * sigmoidf_fast(a1[1]); v1[2] = bflo(gw.w) * sigmoidf_fast(a1[2]); v1[3] = bfhi(gw.w) * sigmoidf_fast(a1[3]);
                    ss += sq8(v0, v1);
                    *(GAS u32x4*)(op + (size_t)(ai * 128 + m * 16) * DM + bj * 128) = pack8(v0, v1); }
                ss = red_fq(ss); if (fq == 0) sp[(size_t)(ai * 128 + m * 16) * 32] = ss; }
    }
};
struct EpiWout {
    static constexpr bool PERM = true, MIDK = true;
    const float* xp; const float* xs; const float* r2; const float* ratio; bf16_t* x1b; float* stA;
    __device__ __forceinline__ void midk(f32x4 (&acc)[2][2][4][2], const Unit& u, int wr, int fr) const {
        EPI_ROWS; const GAS float* rp = (const GAS float*)(ratio + row0); LAUNDER(rp);
#pragma unroll
        for (int ai = 0; ai < 2; ++ai)
#pragma unroll
            for (int m = 0; m < 4; ++m) { const float rt = rp[ai * 128 + m * 16];
#pragma unroll
                for (int bj = 0; bj < 2; ++bj)
#pragma unroll
                    for (int n = 0; n < 2; ++n) acc[ai][bj][m][n] *= rt; }
    }
    __device__ __forceinline__ void operator()(const f32x4 (&acc)[2][2][4][2], const Unit& u, int wr, int wc, int fr, int fq) const {
        EPI_ROWS; const int c0 = u.pn * 256 + wc * 32 + 8 * fq; const int rowt = u.pm * 256;
        const GAS float* xin = (const GAS float*)(rowt < 16384 ? xp + (size_t)row0 * DM : xs + (size_t)(row0 - 16384) * DM) + c0;
        const GAS float* rsp = (const GAS float*)(r2 + row0); GAS bf16_t* bo = (GAS bf16_t*)x1b + (size_t)row0 * DM + c0; GAS float* sp = (GAS float*)stA + (size_t)row0 * 64 + u.pn * 4 + wc;
        LAUNDER(xin); LAUNDER(rsp); LAUNDER(bo); LAUNDER(sp);
#pragma unroll
        for (int ai = 0; ai < 2; ++ai)
#pragma unroll
            for (int m = 0; m < 4; ++m) { const float rs = rsp[ai * 128 + m * 16]; float ss = 0.f; const size_t ro = (size_t)(ai * 128 + m * 16) * DM;
#pragma unroll
                for (int bj = 0; bj < 2; ++bj) {
                    const f32x4 v0 = *(const GAS f32x4*)(xin + ro + bj * 128) + acc[ai][bj][m][0] * rs, v1 = *(const GAS f32x4*)(xin + ro + bj * 128 + 4) + acc[ai][bj][m][1] * rs;
                    ss += sq8(v0, v1);
                    *(GAS u32x4*)(bo + ro + bj * 128) = pack8(v0, v1); }
                ss = red_fq(ss); if (fq == 0) sp[(size_t)(ai * 128 + m * 16) * 64] = ss; }
    }
};
__device__ __forceinline__ float dpp_ror1(float v) { return __builtin_bit_cast(float, __builtin_amdgcn_update_dpp(0, __builtin_bit_cast(int, v), 0x121, 0xf, 0xf, false)); }
__device__ __forceinline__ float dpp_rol1(float v) { return __builtin_bit_cast(float, __builtin_amdgcn_update_dpp(0, __builtin_bit_cast(int, v), 0x12f, 0xf, 0xf, false)); }
struct EpiFfnA {
    static constexpr bool PERM = true, MIDK = false;
    const float* rstd; int row_base; bf16_t* act; bf16_t* halo_up; bf16_t* halo_gate; const float* cw; const float* cb;
    __device__ __forceinline__ void midk(f32x4 (&)[2][2][4][2], const Unit&, int, int) const {}
    __device__ __forceinline__ void operator()(const f32x4 (&acc)[2][2][4][2], const Unit& u, int wr, int wc, int fr, int fq) const {
        EPI_ROWS; const int f0 = u.pn * 128 + wc * 32 + 8 * fq;
        const GAS float* rsp = (const GAS float*)(rstd + row_base + row0); GAS bf16_t* actp = (GAS bf16_t*)act + (size_t)row0 * DFF + f0;
        const int strip0 = u.pm * 4 + wr;
        GAS bf16_t* hup_p = (GAS bf16_t*)halo_up + (size_t)strip0 * 4 * DFF + f0; GAS bf16_t* hg_p = (GAS bf16_t*)halo_gate + (size_t)strip0 * 2 * DFF + f0;
        const GAS float* cwp = (const GAS float*)(cw + f0); const GAS float* cbp = (const GAS float*)(cb + f0);
        asm volatile("" : "+v"(rsp), "+v"(actp), "+v"(hup_p), "+v"(hg_p), "+v"(cwp), "+v"(cbp));
#pragma unroll
        for (int ai = 0; ai < 2; ++ai) {
            float rs[4];
#pragma unroll
            for (int m = 0; m < 4; ++m) rs[m] = rsp[ai * 128 + m * 16];
            u32x2 keep[4];
#pragma unroll
            for (int n = 0; n < 2; ++n) {
                const f32x4 w0 = *(const GAS f32x4*)(cwp + 4 * n), w1 = *(const GAS f32x4*)(cwp + DFF + 4 * n), w2 = *(const GAS f32x4*)(cwp + 2 * DFF + 4 * n), wb = *(const GAS f32x4*)(cbp + 4 * n);
                f32x4 res[4], Uu[4];
#pragma unroll
                for (int e = 0; e < 4; ++e) {
                    float U[4], R[4], L[4];
#pragma unroll
                    for (int m = 0; m < 4; ++m) { U[m] = acc[ai][0][m][n][e] * rs[m]; R[m] = dpp_ror1(U[m]); L[m] = dpp_rol1(U[m]); Uu[m][e] = U[m]; }
#pragma unroll
                    for (int m = 0; m < 4; ++m) {
                        const float prev = (fr == 0) ? R[m > 0 ? m - 1 : 0] : R[m];
                        const float next = (fr == 15) ? L[m < 3 ? m + 1 : 3] : L[m];
                        const float cv = w0[e] * prev + w1[e] * U[m] + w2[e] * next + wb[e];
                        res[m][e] = cv * sigmoidf_fast(cv) * (acc[ai][1][m][n][e] * rs[m]);
                    }
                }
#pragma unroll
                for (int m = 0; m < 4; ++m) {
                    const bool edge = (m == 0 && fr == 0) || (m == 3 && fr == 15);
                    { u32x2 w; w.x = cvt_pk_bf16(res[m][0], res[m][1]); w.y = cvt_pk_bf16(res[m][2], res[m][3]);
                      if (n == 0) keep[m] = w; else if (!edge) *(GAS u32x4*)(actp + (size_t)(ai * 128 + m * 16) * DFF) = (u32x4){keep[m].x, keep[m].y, w.x, w.y}; }
                    if (m == 0 || m == 3) {
                        const int hs = (m == 0) ? (fr == 0 ? 0 : (fr == 1 ? 1 : -1)) : (fr == 14 ? 2 : (fr == 15 ? 3 : -1));
                        if (hs >= 0) { u32x2 w; w.x = cvt_pk_bf16(Uu[m][0], Uu[m][1]); w.y = cvt_pk_bf16(Uu[m][2], Uu[m][3]);
                            *(GAS u32x2*)(hup_p + ((size_t)(ai * 2) * 4 + hs) * DFF + 4 * n) = w;
                            if (hs == 0 || hs == 3) { const f32x4 gv = acc[ai][1][m][n] * rs[m]; u32x2 wg; wg.x = cvt_pk_bf16(gv[0], gv[1]); wg.y = cvt_pk_bf16(gv[2], gv[3]);
                                *(GAS u32x2*)(hg_p + ((size_t)(ai * 2) * 2 + (hs == 3 ? 1 : 0)) * DFF + 4 * n) = wg; } }
                    }
                }
            }
        }
    }
};
struct EpiDown {
    static constexpr bool PERM = true, MIDK = false;
    bf16_t* xb; int row_base; float* stA;
    __device__ __forceinline__ void midk(f32x4 (&)[2][2][4][2], const Unit&, int, int) const {}
    __device__ __forceinline__ void operator()(const f32x4 (&acc)[2][2][4][2], const Unit& u, int wr, int wc, int fr, int fq) const {
        EPI_ROWS; GAS bf16_t* xo = (GAS bf16_t*)xb + (size_t)(row_base + row0) * DM + u.pn * 256 + wc * 32 + 8 * fq; GAS float* sp = (GAS float*)stA + (size_t)(row_base + row0) * 64 + u.pn * 4 + wc; LAUNDER(xo); LAUNDER(sp);
#pragma unroll
        for (int ai = 0; ai < 2; ++ai)
#pragma unroll
            for (int m = 0; m < 4; ++m) { float ss = 0.f; const size_t ro = (size_t)(ai * 128 + m * 16) * DM;
#pragma unroll
                for (int bj = 0; bj < 2; ++bj) { GAS bf16_t* p = xo + ro + bj * 128; const u32x4 w = *(const GAS u32x4*)p; const f32x4 a0 = acc[ai][bj][m][0], a1 = acc[ai][bj][m][1];
                    f32x4 v0, v1; v0[0] = bflo(w.x) + a0[0]; v0[1] = bfhi(w.x) + a0[1]; v0[2] = bflo(w.y) + a0[2]; v0[3] = bfhi(w.y) + a0[3];
                    v1[0] = bflo(w.z) + a1[0]; v1[1] = bfhi(w.z) + a1[1]; v1[2] = bflo(w.w) + a1[2]; v1[3] = bfhi(w.w) + a1[3];
                    ss += sq8(v0, v1); *(GAS u32x4*)p = pack8(v0, v1); }
                ss = red_fq(ss); if (fq == 0) sp[(size_t)(ai * 128 + m * 16) * 64] = ss; }
    }
};
#undef EPI_ROWS
}

namespace attn {
using f32x4v = __attribute__((ext_vector_type(4))) float;
using u32x2v = __attribute__((ext_vector_type(2))) unsigned;
using u32x4v = __attribute__((ext_vector_type(4))) unsigned;
constexpr int NW = 8, KVBLK = 64;
constexpr float SCALE = 0.07216878364870322f;
constexpr float THR = 8.f;
constexpr int LDQ = 3072, LDK = 2048, LDR = 64, LDVT = T, LDO = 4096;
constexpr int SHM_V = 128 * KVBLK * 2, SHM_K = KVBLK * 128 * 2, SHM_R = KVBLK * 64 * 2;
constexpr int OFF_V = 0, OFF_K = 2 * SHM_V, OFF_R = OFF_K + 2 * SHM_K, OFF_QR = OFF_R + 2 * SHM_R, SHM_ATTN = OFF_QR + NW * 4096;
#define SBAR() __builtin_amdgcn_sched_barrier(0)
#define PIN(x) asm volatile("" : "+v"(x))
__device__ __forceinline__ void glds16(const void* gsrc, unsigned lds_dst) { unsigned keep;
  asm volatile("s_mov_b32 %0, m0\n\ts_mov_b32 m0, %2\n\ts_nop 0\n\tglobal_load_lds_dwordx4 %1, off\n\ts_mov_b32 m0, %0" : "=&s"(keep) : "v"(gsrc), "s"(lds_dst) : "memory"); }
__device__ __forceinline__ unsigned cvtpk(float lo, float hi) { unsigned r; asm volatile("v_cvt_pk_bf16_f32 %0, %1, %2" : "=v"(r) : "v"(lo), "v"(hi)); return r; }
__device__ __forceinline__ float xmax16(float v) { auto r = __builtin_amdgcn_permlane16_swap(__float_as_uint(v), __float_as_uint(v), false, false); return fmaxf(__uint_as_float(r[0]), __uint_as_float(r[1])); }
__device__ __forceinline__ float xmax32(float v) { auto r = __builtin_amdgcn_permlane32_swap(__float_as_uint(v), __float_as_uint(v), false, false); return fmaxf(__uint_as_float(r[0]), __uint_as_float(r[1])); }
__device__ __forceinline__ float xsum16(float v) { auto r = __builtin_amdgcn_permlane16_swap(__float_as_uint(v), __float_as_uint(v), false, false); return __uint_as_float(r[0]) + __uint_as_float(r[1]); }
__device__ __forceinline__ float xsum32(float v) { auto r = __builtin_amdgcn_permlane32_swap(__float_as_uint(v), __float_as_uint(v), false, false); return __uint_as_float(r[0]) + __uint_as_float(r[1]); }
__device__ __forceinline__ float max3f(float a, float b, float c) { float r; asm("v_max3_f32 %0, %1, %2, %3" : "=v"(r) : "v"(a), "v"(b), "v"(c)); return r; }
#define MF16(A, B, C) __builtin_amdgcn_mfma_f32_16x16x32_bf16(A, B, C, 0, 0, 0)
struct Lane { const LAS char* Kl; const LAS char* Rl; const LAS char* Vl; const LAS char* qrl; int ky, rz, vz; };
template <int KB, int S> __device__ __forceinline__ bf16x8 kfrag(const Lane& L, int kst, int rst) {
  if constexpr (S < 4) return *(const LAS bf16x8*)(L.Kl + kst + KB * 4096 + ((64 * S) ^ L.ky));
  else return *(const LAS bf16x8*)(L.Rl + rst + KB * 2048 + ((64 * (S - 4)) ^ L.rz));
}
template <int DB, int C> __device__ __forceinline__ bf16x8 vfrag(const Lane& L, int vst) { return *(const LAS bf16x8*)(L.Vl + vst + DB * 2048 + ((64 * C) ^ L.rz)); }
template <int QB, int S> __device__ __forceinline__ bf16x8 qfrag(const bf16x8 (&qn)[2][6], const Lane& L) { return qn[QB][S]; }
template <int KB> __device__ __forceinline__ void qk_block_plain(f32x4v (&s)[2][4], const bf16x8 (&qn)[2][6], const Lane& L, int kst, int rst) {
  bf16x8 k = kfrag<KB, 0>(L, kst, rst); s[0][KB] = MF16(k, (qfrag<0, 0>(qn, L)), ((f32x4v){0.f, 0.f, 0.f, 0.f})); s[1][KB] = MF16(k, (qfrag<1, 0>(qn, L)), ((f32x4v){0.f, 0.f, 0.f, 0.f}));
  k = kfrag<KB, 1>(L, kst, rst); s[0][KB] = MF16(k, (qfrag<0, 1>(qn, L)), s[0][KB]); s[1][KB] = MF16(k, (qfrag<1, 1>(qn, L)), s[1][KB]);
  k = kfrag<KB, 2>(L, kst, rst); s[0][KB] = MF16(k, (qfrag<0, 2>(qn, L)), s[0][KB]); s[1][KB] = MF16(k, (qfrag<1, 2>(qn, L)), s[1][KB]);
  k = kfrag<KB, 3>(L, kst, rst); s[0][KB] = MF16(k, (qfrag<0, 3>(qn, L)), s[0][KB]); s[1][KB] = MF16(k, (qfrag<1, 3>(qn, L)), s[1][KB]);
  k = kfrag<KB, 4>(L, kst, rst); s[0][KB] = MF16(k, (qfrag<0, 4>(qn, L)), s[0][KB]); s[1][KB] = MF16(k, (qfrag<1, 4>(qn, L)), s[1][KB]);
  k = kfrag<KB, 5>(L, kst, rst); s[0][KB] = MF16(k, (qfrag<0, 5>(qn, L)), s[0][KB]); s[1][KB] = MF16(k, (qfrag<1, 5>(qn, L)), s[1][KB]);
}
template <int QB> __device__ __forceinline__ float rowmax(const f32x4v (&s)[2][4]) {
  float m = max3f(s[QB][0][0], s[QB][0][1], s[QB][0][2]); m = max3f(m, s[QB][0][3], s[QB][1][0]); m = max3f(m, s[QB][1][1], s[QB][1][2]); m = max3f(m, s[QB][1][3], s[QB][2][0]);
  m = max3f(m, s[QB][2][1], s[QB][2][2]); m = max3f(m, s[QB][2][3], s[QB][3][0]); m = max3f(m, s[QB][3][1], s[QB][3][2]); m = max3f(m, s[QB][3][3], s[QB][3][3]); return m;
}
constexpr float THRL = 11.541560327111707f;
__device__ __forceinline__ void decide(float pm0, float pm1, f32x4v (&c)[2][4], float (&mh)[2], f32x4v (&negm)[2], float (&al)[2]) {
  pm0 = xmax32(xmax16(pm0)); pm1 = xmax32(xmax16(pm1));
  if (__builtin_expect(__all((pm0 <= THRL) && (pm1 <= THRL)), 1)) { al[0] = 1.f; al[1] = 1.f; }
  else { const float d0 = fmaxf(pm0, 0.f), d1 = fmaxf(pm1, 0.f); mh[0] += d0; mh[1] += d1;
#pragma unroll
    for (int kb = 0; kb < 4; ++kb) { c[0][kb] = c[0][kb] - d0; c[1][kb] = c[1][kb] - d1; }
    al[0] = __builtin_amdgcn_exp2f(-d0); al[1] = __builtin_amdgcn_exp2f(-d1);
    negm[0] = (f32x4v){-mh[0], -mh[0], -mh[0], -mh[0]}; negm[1] = (f32x4v){-mh[1], -mh[1], -mh[1], -mh[1]}; }
}
__device__ __forceinline__ bf16x8 packp(const f32x4v a, const f32x4v b) { const u32x4v w = {cvtpk(a[0], a[1]), cvtpk(a[2], a[3]), cvtpk(b[0], b[1]), cvtpk(b[2], b[3])}; return __builtin_bit_cast(bf16x8, w); }

struct Dma { const char* k0; const char* k1; const char* r; const char* v0; const char* v1; unsigned dk, dr, dv; bool kr; };
__device__ __forceinline__ void attn_step(f32x4v (&c)[2][4], f32x4v (&p)[2][4], f32x4v (&o)[2][8], const bf16x8 (&qn)[2][6], const Lane& L, int kst, int rst, int vst,
                                          const float (&alp)[2], float (&l)[2], float (&mh)[2], f32x4v (&negm)[2], float (&alc)[2], const Dma& D) {
  bf16x8 ka, kb_, kc, kd, P00, P01, P10, P11;
#define QKR(KB, S, FIRST, KX, KY) do { \
    if (FIRST) { c[0][KB] = MF16(KX, (qfrag<0, S>(qn, L)), negm[0]); c[1][KB] = MF16(KX, (qfrag<1, S>(qn, L)), negm[1]); \
                 c[0][KB + 1] = MF16(KY, (qfrag<0, S>(qn, L)), negm[0]); c[1][KB + 1] = MF16(KY, (qfrag<1, S>(qn, L)), negm[1]); } \
    else { c[0][KB] = MF16(KX, (qfrag<0, S>(qn, L)), c[0][KB]); c[1][KB] = MF16(KX, (qfrag<1, S>(qn, L)), c[1][KB]); \
           c[0][KB + 1] = MF16(KY, (qfrag<0, S>(qn, L)), c[0][KB + 1]); c[1][KB + 1] = MF16(KY, (qfrag<1, S>(qn, L)), c[1][KB + 1]); } } while (0)
#define EXP4(V) do { V[0] = __builtin_amdgcn_exp2f(V[0]); V[1] = __builtin_amdgcn_exp2f(V[1]); V[2] = __builtin_amdgcn_exp2f(V[2]); V[3] = __builtin_amdgcn_exp2f(V[3]); } while (0)
  ka = kfrag<0, 0>(L, kst, rst); kb_ = kfrag<1, 0>(L, kst, rst); SBAR();
  kc = kfrag<0, 1>(L, kst, rst); kd = kfrag<1, 1>(L, kst, rst); QKR(0, 0, true, ka, kb_); EXP4(p[0][2]); PIN(p[0][2]); SBAR();
  if (D.kr) glds16(D.k0, D.dk);
  ka = kfrag<0, 2>(L, kst, rst); kb_ = kfrag<1, 2>(L, kst, rst); QKR(0, 1, false, kc, kd); EXP4(p[0][3]); PIN(p[0][3]); SBAR();
  kc = kfrag<0, 3>(L, kst, rst); kd = kfrag<1, 3>(L, kst, rst); QKR(0, 2, false, ka, kb_); EXP4(p[1][2]); PIN(p[1][2]); SBAR();
  if (D.kr) glds16(D.k1, D.dk + 8192);
  ka = kfrag<0, 4>(L, kst, rst); kb_ = kfrag<1, 4>(L, kst, rst); QKR(0, 3, false, kc, kd); EXP4(p[1][3]); PIN(p[1][3]); SBAR();
  kc = kfrag<0, 5>(L, kst, rst); kd = kfrag<1, 5>(L, kst, rst); QKR(0, 4, false, ka, kb_);
  { float s = (p[0][0][0] + p[0][0][1]) + (p[0][0][2] + p[0][0][3]); s += (p[0][1][0] + p[0][1][1]) + (p[0][1][2] + p[0][1][3]); s += (p[0][2][0] + p[0][2][1]) + (p[0][2][2] + p[0][2][3]); s += (p[0][3][0] + p[0][3][1]) + (p[0][3][2] + p[0][3][3]);
    l[0] = l[0] * alp[0] + s; PIN(l[0]); } SBAR();
  if (D.kr) glds16(D.r, D.dr);
  ka = kfrag<2, 0>(L, kst, rst); kb_ = kfrag<3, 0>(L, kst, rst); QKR(0, 5, false, kc, kd);
  { float s = (p[1][0][0] + p[1][0][1]) + (p[1][0][2] + p[1][0][3]); s += (p[1][1][0] + p[1][1][1]) + (p[1][1][2] + p[1][1][3]); s += (p[1][2][0] + p[1][2][1]) + (p[1][2][2] + p[1][2][3]); s += (p[1][3][0] + p[1][3][1]) + (p[1][3][2] + p[1][3][3]);
    l[1] = l[1] * alp[1] + s; PIN(l[1]); } SBAR();
  kc = kfrag<2, 1>(L, kst, rst); kd = kfrag<3, 1>(L, kst, rst); QKR(2, 0, true, ka, kb_); P00 = packp(p[0][0], p[0][1]); PIN(P00); SBAR();
  glds16(D.v0, D.dv);
  ka = kfrag<2, 2>(L, kst, rst); kb_ = kfrag<3, 2>(L, kst, rst); QKR(2, 1, false, kc, kd); P01 = packp(p[0][2], p[0][3]); PIN(P01); SBAR();
  kc = kfrag<2, 3>(L, kst, rst); kd = kfrag<3, 3>(L, kst, rst); QKR(2, 2, false, ka, kb_); P10 = packp(p[1][0], p[1][1]); PIN(P10); SBAR();
  glds16(D.v1, D.dv + 8192);
  ka = kfrag<2, 4>(L, kst, rst); kb_ = kfrag<3, 4>(L, kst, rst); QKR(2, 3, false, kc, kd); P11 = packp(p[1][2], p[1][3]); PIN(P11); SBAR();
  kc = kfrag<2, 5>(L, kst, rst); kd = kfrag<3, 5>(L, kst, rst); QKR(2, 4, false, ka, kb_); SBAR();
  ka = vfrag<0, 0>(L, vst); kb_ = vfrag<1, 0>(L, vst); QKR(2, 5, false, kc, kd); SBAR();
#define PVR(DB, VX, VY, PA, PB) do { o[0][DB] = MF16(VX, PA, o[0][DB]); o[1][DB] = MF16(VX, PB, o[1][DB]); o[0][DB + 1] = MF16(VY, PA, o[0][DB + 1]); o[1][DB + 1] = MF16(VY, PB, o[1][DB + 1]); } while (0)
  float pm0, pm1;
  kc = vfrag<2, 0>(L, vst); kd = vfrag<3, 0>(L, vst); PVR(0, ka, kb_, P00, P10); pm0 = rowmax<0>(c); PIN(pm0); SBAR();
  ka = vfrag<4, 0>(L, vst); kb_ = vfrag<5, 0>(L, vst); PVR(2, kc, kd, P00, P10); pm1 = rowmax<1>(c); PIN(pm1); SBAR();
  kc = vfrag<6, 0>(L, vst); kd = vfrag<7, 0>(L, vst); PVR(4, ka, kb_, P00, P10); decide(pm0, pm1, c, mh, negm, alc); SBAR();
  ka = vfrag<0, 1>(L, vst); kb_ = vfrag<1, 1>(L, vst); PVR(6, kc, kd, P00, P10); EXP4(c[0][0]); PIN(c[0][0]); SBAR();
  kc = vfrag<2, 1>(L, vst); kd = vfrag<3, 1>(L, vst); PVR(0, ka, kb_, P01, P11); EXP4(c[0][1]); PIN(c[0][1]); SBAR();
  ka = vfrag<4, 1>(L, vst); kb_ = vfrag<5, 1>(L, vst); PVR(2, kc, kd, P01, P11); EXP4(c[1][0]); PIN(c[1][0]); SBAR();
  kc = vfrag<6, 1>(L, vst); kd = vfrag<7, 1>(L, vst); PVR(4, ka, kb_, P01, P11); EXP4(c[1][1]); PIN(c[1][1]); SBAR();
  PVR(6, kc, kd, P01, P11); SBAR();
#undef QKR
#undef PVR
}

__device__ __forceinline__ void attn_unit(const bf16* __restrict__ Qb, const bf16* __restrict__ Kh, const bf16* __restrict__ VTh, const bf16* __restrict__ Rh,
                                          bf16* __restrict__ Ob, float* __restrict__ st, int seq, int k0g, char* lds, int wid) {
  int lane_l = (int)__builtin_amdgcn_mbcnt_hi(~0u, __builtin_amdgcn_mbcnt_lo(~0u, 0u)); asm volatile("" : "+v"(lane_l));
  const int lane = lane_l, l15 = lane & 15, kq = lane >> 4;
  bf16x8 qn[2][6]; Lane L;
  L.qrl = (const LAS char*)(lds + OFF_QR + wid * 4096 + lane * 16);
  { const bf16* Qw = Qb + (long)(wid * 32 + l15) * LDQ + kq * 8;
#pragma unroll
    for (int qb = 0; qb < 2; ++qb) {
#pragma unroll
      for (int s = 0; s < 6; ++s) qn[qb][s] = *(const GAS bf16x8*)(Qw + (long)qb * 16 * LDQ + s * 32); } }
  L.Kl = (const LAS char*)(lds + OFF_K) + l15 * 256; L.Rl = (const LAS char*)(lds + OFF_R) + l15 * 128; L.Vl = (const LAS char*)(lds + OFF_V) + l15 * 128;
  L.ky = (kq ^ l15) << 4; L.rz = (kq ^ ((l15 >> 1) & 7)) << 4; L.vz = 0;
  unsigned kof0, kof1, rof, vof0, vof1;
  { const int q0 = wid, q1 = wid + 8;
    { const int row = 4 * q0 + (lane >> 4), ch = (lane & 15) ^ (row & 15); kof0 = (unsigned)(row * LDK + ch * 8) * 2u; }
    { const int row = 4 * q1 + (lane >> 4), ch = (lane & 15) ^ (row & 15); kof1 = (unsigned)(row * LDK + ch * 8) * 2u; }
    { const int row = 8 * q0 + (lane >> 3), ch = (lane & 7) ^ ((row >> 1) & 7); rof = (unsigned)(row * LDR + ch * 8) * 2u; }
    { const int row = 8 * q0 + (lane >> 3), ch = (lane & 7) ^ ((row >> 1) & 7); vof0 = (unsigned)(row * LDVT + ch * 8) * 2u; }
    { const int row = 8 * q1 + (lane >> 3), ch = (lane & 7) ^ ((row >> 1) & 7); vof1 = (unsigned)(row * LDVT + ch * 8) * 2u; } }
  const unsigned lds0 = (unsigned)(uintptr_t)lds;
  const unsigned dK = (unsigned)__builtin_amdgcn_readfirstlane(lds0 + OFF_K + wid * 1024), dR = (unsigned)__builtin_amdgcn_readfirstlane(lds0 + OFF_R + wid * 1024), dV = (unsigned)__builtin_amdgcn_readfirstlane(lds0 + OFF_V + wid * 1024);
  const char* VTk = (const char*)VTh + (size_t)k0g * 2;
#define DMA_KR(t, s) do { const char* kb_ = (const char*)Kh + (size_t)(t) * (KVBLK * LDK * 2); const char* rb_ = (const char*)Rh + (size_t)(t) * (KVBLK * LDR * 2); \
    glds16(kb_ + kof0, dK + (s) * SHM_K); glds16(kb_ + kof1, dK + (s) * SHM_K + 8192); glds16(rb_ + rof, dR + (s) * SHM_R); } while (0)
#define DMA_V(t, s) do { const char* vb_ = VTk + (size_t)(t) * (KVBLK * 2); glds16(vb_ + vof0, dV + (s) * SHM_V); glds16(vb_ + vof1, dV + (s) * SHM_V + 8192); } while (0)
#define WAIT_BAR() asm volatile("s_waitcnt vmcnt(0) lgkmcnt(0)\n\ts_barrier" ::: "memory")
#define RESC(a) do { if (__any(((a)[0] < 1.f) || ((a)[1] < 1.f))) { _Pragma("unroll") for (int d_ = 0; d_ < 8; ++d_) { o[0][d_] *= (a)[0]; o[1][d_] *= (a)[1]; } } } while (0)
  f32x4v o[2][8], sA[2][4], sB[2][4], negm[2]; float mh[2], l[2] = {0.f, 0.f}, alA[2], alB[2];
#pragma unroll
  for (int d = 0; d < 8; ++d) { o[0][d] = (f32x4v){0.f, 0.f, 0.f, 0.f}; o[1][d] = (f32x4v){0.f, 0.f, 0.f, 0.f}; }
  const int NT = seq / KVBLK;
  DMA_KR(0, 0); DMA_V(0, 0); WAIT_BAR();
  DMA_KR(1, 1);
  qk_block_plain<0>(sA, qn, L, 0, 0); qk_block_plain<1>(sA, qn, L, 0, 0); qk_block_plain<2>(sA, qn, L, 0, 0); qk_block_plain<3>(sA, qn, L, 0, 0);
  { mh[0] = xmax32(xmax16(rowmax<0>(sA))); mh[1] = xmax32(xmax16(rowmax<1>(sA))); alA[0] = 1.f; alA[1] = 1.f;
    negm[0] = (f32x4v){-mh[0], -mh[0], -mh[0], -mh[0]}; negm[1] = (f32x4v){-mh[1], -mh[1], -mh[1], -mh[1]};
#pragma unroll
    for (int kb = 0; kb < 4; ++kb) { sA[0][kb] = sA[0][kb] - mh[0]; sA[1][kb] = sA[1][kb] - mh[1]; }
#pragma unroll
    for (int kb = 0; kb < 2; ++kb)
#pragma unroll
      for (int e = 0; e < 4; ++e) { sA[0][kb][e] = __builtin_amdgcn_exp2f(sA[0][kb][e]); sA[1][kb][e] = __builtin_amdgcn_exp2f(sA[1][kb][e]); } }
  WAIT_BAR();
#pragma unroll 1
  for (int j = 1; j + 1 < NT; j += 2) {
    { const char* kb_ = (const char*)Kh + (size_t)(j + 1) * (KVBLK * LDK * 2); const char* rb_ = (const char*)Rh + (size_t)(j + 1) * (KVBLK * LDR * 2); const char* vb_ = VTk + (size_t)j * (KVBLK * 2);
      const Dma D{kb_ + kof0, kb_ + kof1, rb_ + rof, vb_ + vof0, vb_ + vof1, dK, dR, dV + SHM_V, true};
      attn_step(sB, sA, o, qn, L, SHM_K, SHM_R, 0, alA, l, mh, negm, alB, D); }
    RESC(alB); WAIT_BAR();
    { const char* kb_ = (const char*)Kh + (size_t)(j + 2) * (KVBLK * LDK * 2); const char* rb_ = (const char*)Rh + (size_t)(j + 2) * (KVBLK * LDR * 2); const char* vb_ = VTk + (size_t)(j + 1) * (KVBLK * 2);
      const Dma D{kb_ + kof0, kb_ + kof1, rb_ + rof, vb_ + vof0, vb_ + vof1, dK + SHM_K, dR + SHM_R, dV, (j + 2 < NT)};
      attn_step(sA, sB, o, qn, L, 0, 0, SHM_V, alB, l, mh, negm, alA, D); }
    RESC(alA); WAIT_BAR();
  }
  { const char* vb_ = VTk + (size_t)(NT - 1) * (KVBLK * 2);
    const Dma D{vb_, vb_, vb_, vb_ + vof0, vb_ + vof1, dK, dR, dV + SHM_V, false};
    attn_step(sB, sA, o, qn, L, SHM_K, SHM_R, 0, alA, l, mh, negm, alB, D); }
  RESC(alB); WAIT_BAR();
  {
#pragma unroll
    for (int kb = 2; kb < 4; ++kb)
#pragma unroll
      for (int e = 0; e < 4; ++e) { sB[0][kb][e] = __builtin_amdgcn_exp2f(sB[0][kb][e]); sB[1][kb][e] = __builtin_amdgcn_exp2f(sB[1][kb][e]); }
    float s0 = 0.f, s1 = 0.f;
#pragma unroll
    for (int kb = 0; kb < 4; ++kb) { s0 += (sB[0][kb][0] + sB[0][kb][1]) + (sB[0][kb][2] + sB[0][kb][3]); s1 += (sB[1][kb][0] + sB[1][kb][1]) + (sB[1][kb][2] + sB[1][kb][3]); }
    l[0] = l[0] * alB[0] + s0; l[1] = l[1] * alB[1] + s1;
    const bf16x8 P00 = packp(sB[0][0], sB[0][1]), P01 = packp(sB[0][2], sB[0][3]), P10 = packp(sB[1][0], sB[1][1]), P11 = packp(sB[1][2], sB[1][3]);
#define PVD(DB) do { bf16x8 v0 = vfrag<DB, 0>(L, SHM_V), v1 = vfrag<DB, 1>(L, SHM_V); o[0][DB] = MF16(v0, P00, o[0][DB]); o[1][DB] = MF16(v0, P10, o[1][DB]); o[0][DB] = MF16(v1, P01, o[0][DB]); o[1][DB] = MF16(v1, P11, o[1][DB]); } while (0)
    PVD(0); PVD(1); PVD(2); PVD(3); PVD(4); PVD(5); PVD(6); PVD(7);
#undef PVD
  }
  int lane_e = (int)__builtin_amdgcn_mbcnt_hi(~0u, __builtin_amdgcn_mbcnt_lo(~0u, 0u)); asm volatile("" : "+v"(lane_e)); const int l15e = lane_e & 15, kqe = lane_e >> 4;
  GAS bf16* Ow = (GAS bf16*)Ob + (long)(wid * 32 + l15e) * LDO + 4 * kqe; GAS float* stw = (GAS float*)st + (long)(wid * 32 + l15e) * 16;
  asm volatile("" : "+v"(Ow), "+v"(stw));
#pragma unroll
  for (int qb = 0; qb < 2; ++qb) { const float lt = xsum32(xsum16(l[qb])); const float rl = __builtin_amdgcn_rcpf(lt); float ss = 0.f;
#pragma unroll
    for (int db = 0; db < 8; ++db) { const f32x4v v = o[qb][db] * rl; u32x2v w; w.x = cvtpk(v[0], v[1]); w.y = cvtpk(v[2], v[3]);
      const float a0 = bflo(w.x), a1 = bfhi(w.x), a2 = bflo(w.y), a3 = bfhi(w.y); ss += (a0 * a0 + a1 * a1) + (a2 * a2 + a3 * a3);
      *(GAS u32x2v*)(Ow + (long)(qb * 16) * LDO + db * 16) = w; }
    ss = xsum32(xsum16(ss)); if (kqe == 0) stw[(long)(qb * 16) * 16] = ss; }
  asm volatile("s_waitcnt lgkmcnt(0)\n\ts_barrier" ::: "memory");
#undef DMA_KR
#undef DMA_V
#undef WAIT_BAR
#undef RESC
}
#undef SBAR
#undef PIN
#undef MF16
#undef EXP4
}

constexpr size_t MiB = 1u << 20;
constexpr size_t WS_CTL = 0, CTL_ZERO_BYTES = 1 * MiB;
constexpr size_t WS_RSTDX = 1 * MiB, WS_RSTDQ = WS_RSTDX + 98304, WS_RSTDKV = WS_RSTDQ + 98304, WS_R2 = WS_RSTDKV + 98304, WS_RATIO = WS_R2 + 98304, WS_RSTDX1 = WS_RATIO + 98304;
constexpr size_t WS_STA = 2 * MiB;
constexpr size_t WS_STB = 8 * MiB;
constexpr size_t WS_STQ = 10 * MiB;
constexpr size_t WS_STKV = 12 * MiB;
constexpr size_t WS_ROPE = 13 * MiB;
constexpr size_t WS_WIN = 16 * MiB;
constexpr size_t WS_WGLU = 46 * MiB;
constexpr size_t WS_WQ = 54 * MiB;
constexpr size_t WS_WKV = 60 * MiB;
constexpr size_t WS_WOUT = 64 * MiB;
constexpr size_t WS_WUG = 96 * MiB;
constexpr size_t WS_WDN = 268 * MiB;
constexpr size_t WS_W1T = 354 * MiB;
constexpr size_t WS_W2T = 370 * MiB;
constexpr size_t WS_A = 402 * MiB;
constexpr size_t WS_B = 594 * MiB;
constexpr size_t WS_QLAT = 786 * MiB, WS_KVLAT = 828 * MiB, WS_KROPE = 852 * MiB;
constexpr size_t WS_GACT = 856 * MiB;
constexpr size_t WS_HUP = 952 * MiB, WS_HGATE = 964 * MiB, WS_END = 970 * MiB;
static_assert(WS_HUP + (size_t)128 * 4 * DFF * 2 <= WS_HGATE && WS_HGATE + (size_t)128 * 2 * DFF * 2 <= WS_END, "halo");
constexpr size_t OUT_X = 0, OUT_KV = 192 * MiB;
constexpr int CW_BAR = 4096;

constexpr int NWAVES = 8;
constexpr int RING_BYTES = 131072, LDSCTL_OFF = 143360, MISC_OFF = LDSCTL_OFF + 320, LDS_BYTES = 147456;

typedef GAS unsigned gu32;
#define RLX_AGENT __ATOMIC_RELAXED, __HIP_MEMORY_SCOPE_AGENT
#define LDS_WAIT() asm volatile("s_waitcnt lgkmcnt(0)" ::: "memory")

#define XB_TMO      128
#define XB_XCNT(j)  (256  + 64 * (j))
#define XB_XSUB(j)  (1280 + 64 * (j))
#define XB_XGEN(j)  (2304 + 64 * (j))
#define XB_TOP      3328
#define XB_TOPGEN   3392
#define XCD_BAR_WORDS 3456
#define XB_SPIN_CAP (1u << 18)
__device__ __forceinline__ unsigned xb_ld(unsigned* p)              { return __hip_atomic_load(p, __ATOMIC_RELAXED, __HIP_MEMORY_SCOPE_AGENT); }
__device__ __forceinline__ unsigned xb_add(unsigned* p, unsigned v) { return __hip_atomic_fetch_add(p, v, __ATOMIC_RELAXED, __HIP_MEMORY_SCOPE_AGENT); }
__device__ __forceinline__ unsigned xb_xcc_id() { return (unsigned)__builtin_amdgcn_s_getreg((3 << 11) | 20) & 0xFu; }
#define XB_SPIN(cond, bar) do { unsigned _sp = 0; while (cond) { __builtin_amdgcn_s_sleep(1); \
    if ((++_sp & 255u) == 0u) { if (xb_ld(&(bar)[XB_TMO])) break; if (_sp > XB_SPIN_CAP) { atomicAdd(&(bar)[XB_TMO], 1u); break; } } } } while (0)
struct XcdBarrier { unsigned* bar; unsigned x; volatile LAS unsigned* st; };
__device__ __forceinline__ XcdBarrier xcd_barrier_post(unsigned* bar, volatile LAS unsigned* st) {
    XcdBarrier b; b.bar = bar; b.x = xb_xcc_id(); b.st = st;
    if (threadIdx.x == 0) (void)xb_add(&bar[XB_XCNT(b.x)], 1u);
    return b;
}
__device__ __forceinline__ void xcd_barrier_complete(unsigned* bar, unsigned x, unsigned& nloc, unsigned& nx) {
    const unsigned G = gridDim.x * gridDim.y * gridDim.z;
    unsigned sum, cnt, mine, sp = 0u;
    for (;;) {
        sum = 0u; cnt = 0u; mine = 0u;
#pragma unroll
        for (unsigned j = 0; j < 16; ++j) { const unsigned c = xb_ld(&bar[XB_XCNT(j)]); sum += c; cnt += (c > 0u) ? 1u : 0u; mine = (j == x) ? c : mine; }
        if (sum == G) break;
        __builtin_amdgcn_s_sleep(1);
        if ((++sp & 255u) == 0u) { if (xb_ld(&bar[XB_TMO])) break; if (sp > XB_SPIN_CAP) { atomicAdd(&bar[XB_TMO], 1u); break; } }
    }
    nloc = mine > 0u ? mine : 1u; nx = cnt > 0u ? cnt : 1u;
}
__device__ __forceinline__ void xcd_barrier(const XcdBarrier& b) {
    asm volatile("s_waitcnt vmcnt(0)" ::: "memory");
    __syncthreads();
    if (threadIdx.x == 0) {
        unsigned* bar = b.bar;
        __builtin_amdgcn_s_waitcnt(0);
        unsigned nloc = b.st[0], nx = b.st[1];
        if (nloc == 0u) { xcd_barrier_complete(bar, b.x, nloc, nx); b.st[0] = nloc; b.st[1] = nx; }
        const unsigned old = xb_add(&bar[XB_XSUB(b.x)], 1u);
        const unsigned gen = old / nloc;
        if (old + 1u == (gen + 1u) * nloc) {
            __builtin_amdgcn_fence(__ATOMIC_RELEASE, "agent");
            asm volatile("s_waitcnt vmcnt(0)" ::: "memory");
            const unsigned og = xb_add(&bar[XB_TOP], 1u);
            const unsigned tg = og / nx;
            if (og + 1u == (tg + 1u) * nx) xb_add(&bar[XB_TOPGEN], 1u);
            else XB_SPIN(xb_ld(&bar[XB_TOPGEN]) == tg, bar);
            __builtin_amdgcn_fence(__ATOMIC_ACQUIRE, "agent");
            xb_add(&bar[XB_XGEN(b.x)], 1u);
            asm volatile("s_waitcnt vmcnt(0)" ::: "memory");
        } else {
            XB_SPIN(xb_ld(&bar[XB_XGEN(b.x)]) == gen, bar);
            __builtin_amdgcn_fence(__ATOMIC_ACQUIRE, "agent");
            asm volatile("s_waitcnt vmcnt(0)" ::: "memory");
        }
    }
    __syncthreads();
}

__device__ __forceinline__ float wave_sum(float v) {
#pragma unroll
    for (int o = 1; o < 64; o <<= 1) v += __shfl_xor(v, o);
    return v;
}
template <class RowMap>
__device__ __forceinline__ void transpose_item(const float* W, int K, int N, bf16* WT, const float* g1, const float* g2, int ksplit, RowMap rm, LAS float* scr, int item, int lane) {
    const int nblk = N / 64; int kb, nb;
    if ((nblk & 3) == 0) { const int w = item & 7, rest = item >> 3, q = nblk >> 2; nb = (rest % q) * 4 + (w & 3); kb = (rest / q) * 2 + (w >> 2); }
    else { kb = item / nblk; nb = item % nblk; }
    const int k0 = 64 * kb, n0 = 64 * nb;
    f32x2 wv[32];
    const GAS f32x2* wp = (const GAS f32x2*)((const GAS float*)W + (size_t)(k0 + (lane >> 5)) * N + n0) + (lane & 31);
#pragma unroll
    for (int i = 0; i < 32; ++i) wv[i] = *(const GAS f32x2*)((const GAS float*)wp + (size_t)(2 * i) * N);
    float gn[32];
#pragma unroll
    for (int i = 0; i < 32; ++i) { const int k = k0 + 2 * i + (lane >> 5); gn[i] = g1 ? (k < ksplit ? g1[k] : g2[k - ksplit]) : 1.0f; }
    const int c = lane & 7;
#pragma unroll
    for (int sub = 0; sub < 2; ++sub) {
#pragma unroll
        for (int i = 0; i < 32; ++i) { const int kk = 2 * i + (lane >> 5); scr[kk * 33 + (lane & 31)] = (sub ? wv[i].y : wv[i].x) * gn[i]; }
        LDS_WAIT(); asm volatile("" ::: "memory");
#pragma unroll
        for (int j = 0; j < 4; ++j) { const int nl = (lane >> 3) + 8 * j; const LAS float* s = scr + (8 * c) * 33 + nl;
            v4u o; o.x = pg8::cvt_pk_bf16(s[0 * 33], s[1 * 33]); o.y = pg8::cvt_pk_bf16(s[2 * 33], s[3 * 33]); o.z = pg8::cvt_pk_bf16(s[4 * 33], s[5 * 33]); o.w = pg8::cvt_pk_bf16(s[6 * 33], s[7 * 33]);
            *(GAS v4u*)(WT + (size_t)rm(n0 + 2 * nl + sub) * K + k0 + 8 * c) = o; }
        LDS_WAIT(); asm volatile("" ::: "memory");
    }
}
struct RmId  { __device__ __forceinline__ int operator()(int n) const { return n; } };
struct RmWin { __device__ __forceinline__ int operator()(int n) const { if (n < 2944) return n; if (n < 3456) return n + 128; const int i = n - 3456; return 3584 + (i < 32 ? 2 * i : 2 * (i - 32) + 1); } };
struct RmQ   { __device__ __forceinline__ int operator()(int n) const { const int r = n % 192, hb = n - r; if (r < 128) return n; const int i = r - 128; return hb + 128 + (i < 32 ? 2 * i : 2 * (i - 32) + 1); } };
struct RmKV  { __device__ __forceinline__ int operator()(int n) const { const int h = n >> 8, c = n & 255; return c < 128 ? h * 128 + c : 2048 + h * 128 + (c - 128); } };
struct RmUp  { __device__ __forceinline__ int operator()(int n) const { return (n >> 7) * 256 + (n & 127); } };
struct RmGate{ __device__ __forceinline__ int operator()(int n) const { return (n >> 7) * 256 + 128 + (n & 127); } };

__device__ __forceinline__ void sincos_d(double a, double& s, double& c) {
    const double kd = __builtin_rint(a * 0.63661977236758134308); const long k = (long)kd;
    double r = __builtin_fma(-kd, 1.57079632679489655800e+00, a); r = __builtin_fma(-kd, 6.12323399573676603587e-17, r);
    const double r2 = r * r;
    double sp = 1.0 / 6227020800.0; sp = sp * r2 - 1.0 / 39916800.0; sp = sp * r2 + 1.0 / 362880.0; sp = sp * r2 - 1.0 / 5040.0; sp = sp * r2 + 1.0 / 120.0; sp = sp * r2 - 1.0 / 6.0; sp = sp * r2 * r + r;
    double cp = 1.0 / 479001600.0; cp = cp * r2 - 1.0 / 3628800.0; cp = cp * r2 + 1.0 / 40320.0; cp = cp * r2 - 1.0 / 720.0; cp = cp * r2 + 1.0 / 24.0; cp = cp * r2 - 0.5; cp = cp * r2 + 1.0;
    const int q = (int)(k & 3);
    s = (q == 0) ? sp : (q == 1) ? cp : (q == 2) ? -sp : -cp;
    c = (q == 0) ? cp : (q == 1) ? -sp : (q == 2) ? -cp : sp;
}

__device__ __forceinline__ void ssm_weights_group(int g, const float* a_re, const float* a_im, const float* b_re, const float* b_im, const float* c_re, const float* c_im,
                                                  const float* log_dt, const float* dskip, bf16* W1t, bf16* W2t, LAS float* L, int tid) {
    LAS float* PW = L;
    LAS float* BB = PW + 2 * 17 * 64 * 2;
    LAS float* CC = BB + 2 * 64 * 16 * 2;
    LAS float* KT = CC + 2 * 16 * 64 * 2;
    for (int i = tid; i < 2 * 17 * 64; i += 512) { const int d = i / (17 * 64), e = (i / 64) % 17, p = i & 63;
        const double dt = exp((double)log_dt[d * 128 + g]); const double are = a_re[(d * 128 + g) * 64 + p], aim = a_im[(d * 128 + g) * 64 + p];
        const double mag = exp((double)e * dt * are); double s, c; sincos_d((double)e * dt * aim, s, c);
        PW[i * 2] = (float)(mag * c); PW[i * 2 + 1] = (float)(mag * s); }
    for (int i = tid; i < 2 * 64 * 16; i += 512) { const int d = i / 1024, p = (i >> 4) & 63, h = i & 15;
        const double dt = exp((double)log_dt[d * 128 + g]); const double are = a_re[(d * 128 + g) * 64 + p], aim = a_im[(d * 128 + g) * 64 + p];
        const double x = dt * are, y = dt * aim; double sy, cy, sh, ch; sincos_d(y, sy, cy); sincos_d(0.5 * y, sh, ch);
        const double em1 = expm1(x); const double re1 = em1 * cy - 2.0 * sh * sh, im1 = (em1 + 1.0) * sy;
        const double den = are * are + aim * aim; const double qre = (re1 * are + im1 * aim) / den, qim = (im1 * are - re1 * aim) / den;
        const size_t bi = ((size_t)((d * 128 + g) * 64 + p)) * 16 + h; const double br = b_re[bi], bim = b_im[bi];
        BB[i * 2] = (float)(qre * br - qim * bim); BB[i * 2 + 1] = (float)(qre * bim + qim * br); }
    for (int i = tid; i < 2 * 16 * 64; i += 512) { const int d = i / 1024, h = (i >> 6) & 15, p = i & 63; const size_t ci = ((size_t)((d * 128 + g) * 16 + h)) * 64 + p;
        CC[i * 2] = c_re[ci]; CC[i * 2 + 1] = c_im[ci]; }
    __syncthreads();
    { const int d = tid >> 8, e = (tid >> 4) & 15, h = tid & 15; float acc[16];
#pragma unroll
        for (int q = 0; q < 16; ++q) acc[q] = 0.f;
        for (int p = 0; p < 64; ++p) { const float cr = CC[((d * 16 + h) * 64 + p) * 2], ci = CC[((d * 16 + h) * 64 + p) * 2 + 1];
            const float pr = PW[((d * 17 + e) * 64 + p) * 2], pi = PW[((d * 17 + e) * 64 + p) * 2 + 1];
            const float tr = cr * pr - ci * pi, ti = cr * pi + ci * pr; const LAS f32x4* bp = (const LAS f32x4*)(BB + ((d * 64 + p) * 16) * 2);
#pragma unroll
            for (int q = 0; q < 8; ++q) { const f32x4 b = bp[q]; acc[2 * q] += tr * b[0] - ti * b[1]; acc[2 * q + 1] += tr * b[2] - ti * b[3]; } }
#pragma unroll
        for (int q = 0; q < 16; ++q) KT[((d * 16 + e) * 16 + h) * 16 + q] = acc[q]; }
    __syncthreads();
    for (int i = tid; i < 256 * 32; i += 512) { const int n = i >> 5, k0 = (i & 31) * 8; const int d = n >> 7, im = (n >> 6) & 1, p = n & 63; const int s = k0 >> 4, h0 = k0 & 15, e = d ? s : 15 - s;
        const float pr = PW[((d * 17 + e) * 64 + p) * 2], pi = PW[((d * 17 + e) * 64 + p) * 2 + 1]; float v[8];
#pragma unroll
        for (int j = 0; j < 8; ++j) { const float br = BB[((d * 64 + p) * 16 + h0 + j) * 2], bi = BB[((d * 64 + p) * 16 + h0 + j) * 2 + 1]; v[j] = im ? (pr * bi + pi * br) : (pr * br - pi * bi); }
        v4u o; o.x = pk2(v[0], v[1]); o.y = pk2(v[2], v[3]); o.z = pk2(v[4], v[5]); o.w = pk2(v[6], v[7]);
        *(GAS v4u*)(W1t + ((size_t)(g * 256 + n)) * 256 + k0) = o; }
    for (int i = tid; i < 256 * 64; i += 512) { const int n = i >> 6, k0 = (i & 63) * 8; const int j = n >> 4, h = n & 15; float v[8];
        if (k0 < 256) { const int d = k0 >> 7, im = (k0 >> 6) & 1, p0 = k0 & 63, e = d ? 16 - j : j + 1;
#pragma unroll
            for (int q = 0; q < 8; ++q) { const int p = p0 + q; const float cr = CC[((d * 16 + h) * 64 + p) * 2], ci = CC[((d * 16 + h) * 64 + p) * 2 + 1];
                const float pr = PW[((d * 17 + e) * 64 + p) * 2], pi = PW[((d * 17 + e) * 64 + p) * 2 + 1]; v[q] = im ? -(cr * pi + ci * pr) : (cr * pr - ci * pi); }
        } else { const int s = (k0 - 256) >> 4, h0 = (k0 - 256) & 15;
#pragma unroll
            for (int q = 0; q < 8; ++q) { const int hh = h0 + q; float val = 0.f;
                if (s <= j) val += KT[((0 * 16 + (j - s)) * 16 + h) * 16 + hh];
                if (s >= j) val += KT[((1 * 16 + (s - j)) * 16 + h) * 16 + hh];
                if (s == j && h == hh) val += dskip[g * 16 + h];
                v[q] = val; } }
        v4u o; o.x = pk2(v[0], v[1]); o.y = pk2(v[2], v[3]); o.z = pk2(v[4], v[5]); o.w = pk2(v[6], v[7]);
        *(GAS v4u*)(W2t + ((size_t)(g * 256 + n)) * 512 + k0) = o; }
    __syncthreads();
}
#ifndef PROBE_ATTN
#define PROBE_ATTN 1
#endif
#ifndef PROBE_P0
#define PROBE_P0 1
#endif
#ifndef PROBE_P1
#define PROBE_P1 1
#endif
#ifndef PROBE_P7
#define PROBE_P7 1
#endif
#ifndef PROBE_FA
#define PROBE_FA 1
#endif

struct Args { const float* in[27]; float* out; unsigned char* ws; int ph_lo, ph_hi; };

__global__ void __launch_bounds__(NWAVES * 64, 2) enc_fwd(Args args) {
    extern __shared__ __attribute__((aligned(16))) unsigned char lds[];
    LAS unsigned char* ldsb = (LAS unsigned char*)lds;
    volatile LAS unsigned* MISC = (volatile LAS unsigned*)(ldsb + MISC_OFF);
    const int wave0 = __builtin_amdgcn_readfirstlane(threadIdx.x >> 6);
    const int G = gridDim.x, bx = blockIdx.x; const int vcu = (G % 8 == 0) ? (bx % 8) * (G / 8) + bx / 8 : bx;
    const int NGW = G * NWAVES, NGT = G * NWAVES * 64;
    gu32* ctl = (gu32*)(args.ws + WS_CTL);
#define PHB unsigned char* wsl = args.ws; unsigned char* outl = (unsigned char*)args.out; asm volatile("" : "+s"(wsl), "+s"(outl)); \
    int tid = wave0 * 64 + (int)__builtin_amdgcn_mbcnt_hi(~0u, __builtin_amdgcn_mbcnt_lo(~0u, 0u)); asm volatile("" : "+v"(tid)); const int lane = tid & 63, wave = wave0; \
    const int gw = vcu * NWAVES + wave, gt = vcu * (NWAVES * 64) + tid; (void)lane; (void)gw; (void)gt; (void)wsl; (void)outl
#define x_p (args.in[0])
#define x_s (args.in[1])
#define rstd_x ((float*)(wsl + WS_RSTDX))
#define rstd_q ((float*)(wsl + WS_RSTDQ))
#define rstd_kv ((float*)(wsl + WS_RSTDKV))
#define r2v ((float*)(wsl + WS_R2))
#define ratio ((float*)(wsl + WS_RATIO))
#define rstd_x1 ((float*)(wsl + WS_RSTDX1))
#define stA ((float*)(wsl + WS_STA))
#define stB ((float*)(wsl + WS_STB))
#define stQ ((float*)(wsl + WS_STQ))
#define stKV ((float*)(wsl + WS_STKV))
#define ropetab ((float*)(wsl + WS_ROPE))
#define Wi ((bf16*)(wsl + WS_WIN))
#define Wglu ((bf16*)(wsl + WS_WGLU))
#define Wq ((bf16*)(wsl + WS_WQ))
#define Wkv ((bf16*)(wsl + WS_WKV))
#define Wout ((bf16*)(wsl + WS_WOUT))
#define Wug ((bf16*)(wsl + WS_WUG))
#define Wdn ((bf16*)(wsl + WS_WDN))
#define W1t ((bf16*)(wsl + WS_W1T))
#define W2t ((bf16*)(wsl + WS_W2T))
#define bufA ((bf16*)(wsl + WS_A))
#define bufB ((bf16*)(wsl + WS_B))
#define qlat ((bf16*)(wsl + WS_QLAT))
#define kvlat ((bf16*)(wsl + WS_KVLAT))
#define krope ((bf16*)(wsl + WS_KROPE))
#define gact ((bf16*)(wsl + WS_GACT))
#define hup ((bf16*)(wsl + WS_HUP))
#define hgate ((bf16*)(wsl + WS_HGATE))
#define X ((bf16*)(outl + OUT_X))
#define kvb ((bf16*)(outl + OUT_KV))
#define vtb ((bf16*)(outl + OUT_KV) + (size_t)T * 2048)
#define xoutf ((float*)outl)
    for (int u = threadIdx.x; u < (LDS_BYTES - LDSCTL_OFF) / 4; u += NWAVES * 64) ((LAS unsigned*)(ldsb + LDSCTL_OFF))[u] = 0u;
    __syncthreads();
    XcdBarrier bar = xcd_barrier_post((unsigned*)(ctl + CW_BAR), MISC + 8);
    const int lo = args.ph_lo, hi = args.ph_hi;
#ifndef PHMASK
#define PHMASK 0xfffffffu
#endif
#define IN(k) (((PHMASK >> ((k) < 9 ? (k) : ((k) >= 18 ? 12 : 9 + ((k) - 9) % 3))) & 1u) && lo <= (k) && (k) < hi)
#define SEAM(k) do { if (IN(k) && IN((k) + 1)) xcd_barrier(bar); } while (0)

#pragma unroll 1
    for (int rep = 0; rep < PROBE_P0; ++rep)
    if (IN(0)) {
        PHB;
        if (rep) __syncthreads();
        if (vcu < 128) ssm_weights_group(vcu, args.in[4], args.in[5], args.in[6], args.in[7], args.in[8], args.in[9], args.in[10], args.in[11], W1t, W2t, (LAS float*)ldsb, tid);
        LAS float* scr = (LAS float*)(ldsb + wave * 16384);
        constexpr int I_IN = 64 * 55, I_GLU = 32 * 32, I_Q = 14 * 48, I_KV = 8 * 64, I_OUT = 64 * 64, I_UP = 64 * 172, I_DN = 172 * 64;
        constexpr int NITEMS = I_IN + I_GLU + I_Q + I_KV + I_OUT + 2 * I_UP + I_DN;
#ifndef PROBE_TR
#define PROBE_TR 1
#endif
#ifndef PROBE_X
#define PROBE_X 1
#endif
        for (int it2 = gw; it2 < PROBE_TR * NITEMS; it2 += NGW) { const int it = it2 % NITEMS;
            int r = it;
            if (r < I_IN) { transpose_item(args.in[2], 4096, 3520, Wi, args.in[3], args.in[3], 4096, RmWin(), scr, r, lane); continue; } r -= I_IN;
            if (r < I_GLU) { transpose_item(args.in[12], 2048, 2048, Wglu, nullptr, nullptr, 0, RmId(), scr, r, lane); continue; } r -= I_GLU;
            if (r < I_Q) { transpose_item(args.in[14], 896, 3072, Wq, args.in[13], args.in[13], 896, RmQ(), scr, r, lane); continue; } r -= I_Q;
            if (r < I_KV) { transpose_item(args.in[16], 512, 4096, Wkv, args.in[15], args.in[15], 512, RmKV(), scr, r, lane); continue; } r -= I_KV;
            if (r < I_OUT) { transpose_item(args.in[19], 4096, 4096, Wout, args.in[17], args.in[18], 2048, RmId(), scr, r, lane); continue; } r -= I_OUT;
            if (r < I_UP) { transpose_item(args.in[21], 4096, 11008, Wug, args.in[20], args.in[20], 4096, RmUp(), scr, r, lane); continue; } r -= I_UP;
            if (r < I_UP) { transpose_item(args.in[22], 4096, 11008, Wug, args.in[20], args.in[20], 4096, RmGate(), scr, r, lane); continue; } r -= I_UP;
            transpose_item(args.in[25], 11008, 4096, Wdn, nullptr, nullptr, 0, RmId(), scr, r, lane);
        }
        for (int i = gt; i < 320 * 512; i += NGT) { const int rr = i >> 9, c8 = (i & 511) * 8; const int row = rr < 128 ? 2944 + rr : 3648 + (rr - 128);
            *(GAS v4u*)(Wi + (size_t)row * 4096 + c8) = (v4u){0u, 0u, 0u, 0u}; }
        for (int m2 = gw; m2 < PROBE_X * T; m2 += NGW) { const int m = m2 % T; const float* xr = m < 16384 ? x_p + (size_t)m * DM : x_s + (size_t)(m - 16384) * DM;
            f32x4 v[16]; float s = 0.f;
#pragma unroll
            for (int j = 0; j < 16; ++j) { v[j] = *((const GAS f32x4*)xr + lane + 64 * j); s += (v[j].x * v[j].x + v[j].y * v[j].y) + (v[j].z * v[j].z + v[j].w * v[j].w); }
            s = wave_sum(s); if (lane == 0) rstd_x[m] = 1.0f / sqrtf(s * (1.0f / DM) + EPS);
            GAS v2u* o8 = (GAS v2u*)(bufA + (size_t)m * DM) + lane;
#pragma unroll
            for (int j = 0; j < 16; ++j) o8[64 * j] = (v2u){pg8::cvt_pk_bf16(v[j].x, v[j].y), pg8::cvt_pk_bf16(v[j].z, v[j].w)}; }
        for (int i = gt; i < 8192 * 32; i += NGT) { const int pos = i >> 5, k = i & 31; const double inv = exp(-(double)k * (9.210340371976184 / 32.0));
            double s, c; sincos_d((double)pos * inv, s, c); *(GAS f32x2*)(ropetab + (size_t)i * 2) = (f32x2){(float)c, (float)s}; }
    }
    SEAM(0);

#pragma unroll 1
    for (int rep = 0; rep < PROBE_P1; ++rep)
    if (IN(1)) {
        PHB;
        pg8::Gemm g{bufA, Wi, DM, DM, DM}; pg8::StaticOrder S; S.init(T, 3840, G, bx);
        pg8::EpiWin E{rstd_x, X, qlat, kvlat, krope, stQ, stKV, ropetab};
        pg8::gemm_phase(ldsb, g, S, E, tid);
    }
    SEAM(1);

    if (IN(2)) {
        PHB;
        pg8::Gemm g{X + 256, W1t, 512, 256, 256}; pg8::GroupOrder S{768, 6, G, bx};
        pg8::EpiSsm1 E{X};
        pg8::gemm_phase(ldsb, g, S, E, tid);
        for (int r = gt; r < T; r += NGT) { float s = 0.f;
#pragma unroll
            for (int j = 0; j < 4; ++j) { const f32x4 v = *(const GAS f32x4*)(stQ + (size_t)r * 16 + 4 * j); s += (v.x + v.y) + (v.z + v.w); }
            rstd_q[r] = 1.0f / sqrtf(s * (1.0f / QLAT) + EPS); float s2 = 0.f;
#pragma unroll
            for (int j = 0; j < 2; ++j) { const f32x4 v = *(const GAS f32x4*)(stKV + (size_t)r * 8 + 4 * j); s2 += (v.x + v.y) + (v.z + v.w); }
            rstd_kv[r] = 1.0f / sqrtf(s2 * (1.0f / KVLAT) + EPS); }
    }
    SEAM(2);

    if (IN(3)) {
        PHB;
        const bool scan_cu = (G == 256) ? ((vcu & 1) == 0) : true;
        if (G == 256 ? scan_cu : (wave < 4)) { const int task = (G == 256) ? (vcu >> 1) * 8 + wave : vcu * 4 + wave;
            if (task < 1024) { const int seq = task >> 8, g = (task >> 1) & 127, dir = task & 1, p = lane;
                const int c0 = seq < 2 ? seq * 512 : 1024 + (seq - 2) * 256, nc = seq < 2 ? 512 : 256;
                const double dt = exp((double)args.in[10][dir * 128 + g]); const double are = args.in[4][(dir * 128 + g) * 64 + p], aim = args.in[5][(dir * 128 + g) * 64 + p];
                const double mag = exp(16.0 * dt * are); double sn, cs; sincos_d(16.0 * dt * aim, sn, cs);
                const float ar = (float)(mag * cs), ai = (float)(mag * sn);
                GAS bf16* Xg = (GAS bf16*)X + (size_t)g * NCHUNK * 512 + dir * 128 + p;
                float zr = 0.f, zi = 0.f;
                for (int cb = 0; cb < nc; cb += 16) {
                    unsigned short sre[16], sim[16];
#pragma unroll
                    for (int i = 0; i < 16; ++i) { const int c = dir ? (c0 + nc - 1 - (cb + i)) : (c0 + cb + i); sre[i] = Xg[(size_t)c * 512]; sim[i] = Xg[(size_t)c * 512 + 64]; }
#pragma unroll
                    for (int i = 0; i < 16; ++i) { const int c = dir ? (c0 + nc - 1 - (cb + i)) : (c0 + cb + i);
                        Xg[(size_t)c * 512] = (bf16)f2bf(zr); Xg[(size_t)c * 512 + 64] = (bf16)f2bf(zi);
                        const float sr = bf2f(sre[i]), si = bf2f(sim[i]); const float nr = ar * zr - ai * zi + sr, ni = ar * zi + ai * zr + si; zr = nr; zi = ni; }
                }
            }
        }
        __syncthreads();
        if (G == 256) { pg8::Gemm g{qlat, Wq, QLAT, QLAT, QLAT}; pg8::RangeOrder S{scan_cu ? (vcu >> 1) * 3 : 384 + (vcu >> 1) * 6, scan_cu ? 3 : 6, 12}; pg8::EpiQ E{rstd_q, bufA, ropetab}; pg8::gemm_phase(ldsb, g, S, E, tid); }
        else { pg8::Gemm g{qlat, Wq, QLAT, QLAT, QLAT}; pg8::StaticOrder S; S.init(T, QW, G, bx); pg8::EpiQ E{rstd_q, bufA, ropetab}; pg8::gemm_phase(ldsb, g, S, E, tid); }
        { pg8::Gemm g{kvlat, Wkv, KVLAT, KVLAT, KVLAT}; pg8::StaticOrder S; S.init(T, 2048, G, bx); pg8::EpiKV E{rstd_kv, kvb}; pg8::gemm_phase(ldsb, g, S, E, tid); }
        { pg8::Gemm g{Wkv + (size_t)2048 * KVLAT, kvlat, KVLAT, KVLAT, KVLAT}; pg8::StaticOrder S; S.init(2048, T, G, bx); pg8::EpiVT E{rstd_kv, vtb}; pg8::gemm_phase(ldsb, g, S, E, tid); }
    }
    SEAM(3);

    if (IN(4)) {
        PHB;
        pg8::Gemm g{X, W2t, 512, 512, 512}; pg8::GroupOrder S{768, 6, G, bx};
        pg8::EpiSsm2 E{gact};
        pg8::gemm_phase(ldsb, g, S, E, tid);
    }
    SEAM(4);

    if (IN(5)) {
        PHB;
#ifndef NO_GLU
        { pg8::Gemm g{gact, Wglu, MIXW, MIXW, MIXW}; pg8::StaticOrder S; S.init(T, MIXW, G, bx); pg8::EpiGlu E{gact, bufB, stA}; pg8::gemm_phase(ldsb, g, S, E, tid); }
#endif
#ifndef NO_ATTN
        const int xcd = vcu >> 5, cc = vcu & 31; const int nun = (G == 256) ? 6 : (1536 - bx + G - 1) / G;
#pragma unroll 1
        for (int i = 0; i < nun; ++i) {
            int bh, qb, seq, rowbase;
            if (G == 256) { if (i < 4) { bh = xcd * 4 + i; qb = cc; seq = 8192; } else { bh = xcd * 4 + 2 * (i - 4) + (cc >> 4); qb = cc & 15; seq = 4096; } }
            else { const int uidx = bx + i * G; if (uidx < 1024) { bh = uidx >> 5; qb = uidx & 31; seq = 8192; } else { const int v = uidx - 1024; bh = v >> 4; qb = v & 15; seq = 4096; } }
            const int b = bh >> 4, h = bh & 15; rowbase = (seq == 8192) ? b * 8192 : 16384 + b * 4096;
            __syncthreads();
            attn::attn_unit(bufA + (size_t)(rowbase + qb * 256) * QW + h * 192, kvb + (size_t)rowbase * 2048 + h * 128, vtb + (size_t)(h * 128) * T,
                            krope + (size_t)rowbase * 64, bufB + (size_t)(rowbase + qb * 256) * DM + 2048 + h * 128, stB + (size_t)(rowbase + qb * 256) * 16 + h, seq, rowbase, (char*)lds, wave0);
        }
#endif
    }
    SEAM(5);

    if (IN(6)) {
        PHB;
        for (int r = gt; r < T; r += NGT) { float s = 0.f;
#pragma unroll
            for (int j = 0; j < 8; ++j) { const f32x4 v = *(const GAS f32x4*)(stA + (size_t)r * 32 + 4 * j); s += (v.x + v.y) + (v.z + v.w); }
            const float r1 = 1.0f / sqrtf(s * (1.0f / MIXW) + EPS); float s2 = 0.f;
#pragma unroll
            for (int j = 0; j < 4; ++j) { const f32x4 v = *(const GAS f32x4*)(stB + (size_t)r * 16 + 4 * j); s2 += (v.x + v.y) + (v.z + v.w); }
            const float r2 = 1.0f / sqrtf(s2 * (1.0f / MIXW) + EPS); r2v[r] = r2; ratio[r] = r1 / r2; }
    }
    SEAM(6);

#pragma unroll 1
    for (int rep = 0; rep < PROBE_P7; ++rep)
    if (IN(7)) {
        PHB;
        pg8::Gemm g{bufB, Wout, DM, DM, DM}; pg8::StaticOrder S; S.init(T, DM, G, bx);
        pg8::EpiWout E{x_p, x_s, r2v, ratio, bufA, stA};
        pg8::gemm_phase(ldsb, g, S, E, tid);
    }
    SEAM(7);

    if (IN(8)) {
        PHB;
        for (int r = gt; r < T; r += NGT) { float s = 0.f;
#pragma unroll
            for (int j = 0; j < 16; ++j) { const f32x4 v = *(const GAS f32x4*)(stA + (size_t)r * 64 + 4 * j); s += (v.x + v.y) + (v.z + v.w); }
            rstd_x1[r] = 1.0f / sqrtf(s * (1.0f / DM) + EPS); }
    }
    SEAM(8);

#ifdef PROBE_DOWN
    if (IN(9)) { PHB;
#pragma unroll 1
        for (int ch = 0; ch < 3; ++ch) { pg8::Gemm g{bufB, Wdn, DFF, DFF, DFF}; pg8::StaticOrder S; S.init(8192, DM, G, bx); pg8::EpiNull E0; pg8::gemm_phase(ldsb, g, S, E0, tid); }
    }
#endif
#ifdef PROBE_KLOOP
    if (IN(9)) {
        PHB;
#pragma unroll 1
        for (int ch = 0; ch < 3; ++ch) { pg8::Gemm g{bufA + (size_t)(ch * 8192) * DM, Wug, DM, DM, DM}; pg8::StaticOrder S; S.init(8192, 2 * DFF, G, bx); pg8::EpiNull E0; pg8::gemm_phase(ldsb, g, S, E0, tid); }
    }
#endif
#pragma unroll 1
    for (int ch2 = 0; ch2 < 3 * PROBE_FA; ++ch2) {
        const int ch = ch2 / PROBE_FA; const bool lastrep = (ch2 % PROBE_FA) == PROBE_FA - 1;
        const int rb = ch * 8192;
        if (IN(9 + 3 * ch)) {
        PHB;
            pg8::Gemm g{bufA + (size_t)rb * DM, Wug, DM, DM, DM}; pg8::StaticOrder S; S.init(8192, 2 * DFF, G, bx);
            pg8::EpiFfnA E{rstd_x1, rb, bufB, hup, hgate, args.in[23], args.in[24]};
            pg8::gemm_phase(ldsb, g, S, E, tid);
        }
        SEAM(9 + 3 * ch);
        if (lastrep && IN(10 + 3 * ch)) {
        PHB;
            const float* cw = args.in[23]; const float* cb = args.in[24];
            for (int i = gt; i < 128 * 2 * (DFF / 8); i += NGT) { const int f0 = (i % (DFF / 8)) * 8, sw = i / (DFF / 8), strip = sw >> 1, which = sw & 1;
                const int lrow = strip * 64 + (which ? 63 : 0), grow = rb + lrow, pos = pos_of(grow), len = len_of(grow);
                v4u up0, up1, up2;
                if (which == 0) { up1 = *(const GAS v4u*)(hup + ((size_t)strip * 4 + 0) * DFF + f0); up2 = *(const GAS v4u*)(hup + ((size_t)strip * 4 + 1) * DFF + f0);
                    up0 = (pos == 0) ? (v4u){0u, 0u, 0u, 0u} : *(const GAS v4u*)(hup + ((size_t)(strip - 1) * 4 + 3) * DFF + f0); }
                else { up0 = *(const GAS v4u*)(hup + ((size_t)strip * 4 + 2) * DFF + f0); up1 = *(const GAS v4u*)(hup + ((size_t)strip * 4 + 3) * DFF + f0);
                    up2 = (pos == len - 1) ? (v4u){0u, 0u, 0u, 0u} : *(const GAS v4u*)(hup + ((size_t)(strip + 1) * 4 + 0) * DFF + f0); }
                const v4u gt4 = *(const GAS v4u*)(hgate + ((size_t)strip * 2 + which) * DFF + f0);
                unsigned ow[4];
#pragma unroll
                for (int k = 0; k < 4; ++k) { const int f = f0 + 2 * k;
                    const float a0 = bflo(up0[k]), a1 = bflo(up1[k]), a2 = bflo(up2[k]), b0 = bfhi(up0[k]), b1 = bfhi(up1[k]), b2 = bfhi(up2[k]);
                    const float c0 = cw[f] * a0 + cw[DFF + f] * a1 + cw[2 * DFF + f] * a2 + cb[f], c1 = cw[f + 1] * b0 + cw[DFF + f + 1] * b1 + cw[2 * DFF + f + 1] * b2 + cb[f + 1];
                    ow[k] = pk2(c0 * sigmoidf_fast(c0) * bflo(gt4[k]), c1 * sigmoidf_fast(c1) * bfhi(gt4[k])); }
                *(GAS v4u*)(bufB + (size_t)lrow * DFF + f0) = (v4u){ow[0], ow[1], ow[2], ow[3]}; }
        }
        if (lastrep) SEAM(10 + 3 * ch);
        if (lastrep && IN(11 + 3 * ch)) {
        PHB;
            pg8::Gemm g{bufB, Wdn, DFF, DFF, DFF}; pg8::StaticOrder S; S.init(8192, DM, G, bx);
            pg8::EpiDown E{bufA, rb, stA};
            pg8::gemm_phase(ldsb, g, S, E, tid);
        }
        if (lastrep) SEAM(11 + 3 * ch);
    }

    if (IN(18)) {
        PHB;
        const float* gf = args.in[26];
        for (int m = gw; m < T; m += NGW) { const float s = wave_sum(stA[(size_t)m * 64 + lane]); const float rs = 1.0f / sqrtf(s * (1.0f / DM) + EPS);
            const GAS v4u* xr = (const GAS v4u*)(bufA + (size_t)m * DM) + lane; GAS f32x4* orow = (GAS f32x4*)(xoutf + (size_t)m * DM) + 2 * lane; const GAS f32x4* gr = (const GAS f32x4*)gf + 2 * lane;
#pragma unroll
            for (int j = 0; j < 8; ++j) { const v4u w = xr[64 * j]; const f32x4 g0 = gr[128 * j], g1 = gr[128 * j + 1];
                orow[128 * j] = (f32x4){bflo(w.x) * rs * g0[0], bfhi(w.x) * rs * g0[1], bflo(w.y) * rs * g0[2], bfhi(w.y) * rs * g0[3]};
                orow[128 * j + 1] = (f32x4){bflo(w.z) * rs * g1[0], bfhi(w.z) * rs * g1[1], bflo(w.w) * rs * g1[2], bfhi(w.w) * rs * g1[3]}; } }
    }
#undef IN
#undef SEAM
}

constexpr int N_PHASES = 19;
extern "C" void kernel_launch(void* const* d_in, const int* in_sizes, int n_in, void* d_out, int out_size, void* d_ws, size_t ws_size, hipStream_t stream) {
    static int grid = 0;
    if (grid == 0) {
        if (n_in != 27 || out_size != T * DM || ws_size < WS_END) { fprintf(stderr, "kernel_launch: unexpected shapes (n_in %d out %d ws %zu)\n", n_in, out_size, ws_size); grid = -1; return; }
        int dev = 0, cus = 0, per_cu = 0;
        if (hipGetDevice(&dev) != hipSuccess || hipDeviceGetAttribute(&cus, hipDeviceAttributeMultiprocessorCount, dev) != hipSuccess) { grid = -1; return; }
        if (hipFuncSetAttribute((const void*)enc_fwd, hipFuncAttributeMaxDynamicSharedMemorySize, LDS_BYTES) != hipSuccess) { fprintf(stderr, "kernel_launch: hipFuncSetAttribute failed\n"); grid = -1; return; }
        if (hipOccupancyMaxActiveBlocksPerMultiprocessor(&per_cu, (const void*)enc_fwd, NWAVES * 64, LDS_BYTES) != hipSuccess || per_cu < 1) { fprintf(stderr, "kernel_launch: occupancy query says %d\n", per_cu); }
        (void)hipGetLastError();
        grid = cus;
    }
    if (grid < 0) return;
    if (hipMemsetAsync((char*)d_ws + WS_CTL, 0, CTL_ZERO_BYTES, stream) != hipSuccess) return;
    Args a{};
    for (int i = 0; i < 27; ++i) a.in[i] = (const float*)d_in[i];
    a.out = (float*)d_out; a.ws = (unsigned char*)d_ws;
#ifndef MK_N_LAUNCHES
#define MK_N_LAUNCHES 1
#endif
    if (MK_N_LAUNCHES == 1) { a.ph_lo = 0; a.ph_hi = N_PHASES; hipLaunchKernelGGL(enc_fwd, dim3(grid), dim3(NWAVES * 64), LDS_BYTES, stream, a); }
    else { for (int p = 0; p < N_PHASES; ++p) { a.ph_lo = p; a.ph_hi = p + 1; hipLaunchKernelGGL(enc_fwd, dim3(grid), dim3(NWAVES * 64), LDS_BYTES, stream, a); } }
    const hipError_t le = hipPeekAtLastError();
    if (le != hipSuccess) fprintf(stderr, "kernel_launch: launch failed: %s\n", hipGetErrorName(le));
}
```

```cpp
#include <hip/hip_runtime.h>
#include <hip/hip_bf16.h>
#include <cstdio>
#include <cstdint>

namespace pg8 {
#define PG8_LAS __attribute__((address_space(3)))
typedef unsigned short bf16_t;
typedef short bf16x8 __attribute__((ext_vector_type(8)));
typedef float f32x4 __attribute__((ext_vector_type(4)));
typedef float f32x2 __attribute__((ext_vector_type(2)));
typedef unsigned u32x4 __attribute__((ext_vector_type(4)));
typedef unsigned u32x2 __attribute__((ext_vector_type(2)));
constexpr int BM = 256, BK = 64, HALF = 128, HTB = HALF * BK * 2  , STAGE_BYTES = 8 * HTB, NXCD = 8, WGM = 8;

__host__ __device__ __forceinline__ int lds_byte(int r, int c) { const int st = (r >> 4) * 2 + (c >> 5), rr = r & 15, cc = c & 31, ob = rr * 64 + cc * 2; return st * 1024 + (ob ^ (((ob >> 9) & 1) << 5)); }
__host__ __device__ __forceinline__ void stage_rc(int b, int& R, int& C) { const int st = b / 1024, sb = b % 1024, swz = sb ^ (((sb >> 9) & 1) << 5); R = (st >> 1) * 16 + swz / 64; C = (st & 1) * 32 + (swz % 64) / 2; }
__host__ __device__ __forceinline__ int perm32(int rho) { const int n = rho >> 4, i = rho & 15; return 8 * (i >> 2) + 4 * n + (i & 3); }

struct Unit { int pm, pn; };
struct Gemm { const bf16_t* A; const bf16_t* Bt; int lda, ldb, K; };

struct StaticOrder {
    int nM, nN, nwg, G, c;
    __host__ __device__ void init(int M, int N, int G_, int c_) { nM = M / BM; nN = N / BM; nwg = nM * nN; G = G_; c = c_; }
    __host__ __device__ bool next(int i, Unit& u) const {
        const long L = (long)i * G + c; if (L >= nwg) return false;
        int wgid = (int)L; { const int q = nwg / NXCD, r = nwg % NXCD, xcd = wgid % NXCD, off = wgid / NXCD; wgid = (xcd < r ? xcd * (q + 1) : r * (q + 1) + (xcd - r) * q) + off; }
        const int nig = WGM * nN, gid = wgid / nig, fm = gid * WGM, gsz = (nM - fm) < WGM ? (nM - fm) : WGM;
        u.pm = fm + ((wgid % nig) % gsz); u.pn = (wgid % nig) / gsz; return true;
    }
};
struct ZeroOrder { int n, G, c; __host__ __device__ bool next(int i, Unit& u) const { const long L = (long)i * G + c; if (L >= n) return false; u.pm = 0; u.pn = 0; return true; } };
struct RangeOrder { int base, n, nN; __host__ __device__ bool next(int i, Unit& u) const { if (i >= n) return false; const int L = base + i; u.pm = L / nN; u.pn = L % nN; return true; } };
struct GroupOrder {
    int n, per, G, c;
    __host__ __device__ bool next(int i, Unit& u) const { const long L = (long)i * G + c; if (L >= n) return false; u.pm = (int)L; u.pn = (int)L / per; return true; }
};

__device__ __forceinline__ unsigned cvt_pk_bf16(float lo, float hi) { unsigned r; asm volatile("v_cvt_pk_bf16_f32 %0, %1, %2" : "=v"(r) : "v"(lo), "v"(hi)); return r; }
__device__ __forceinline__ u32x4 pack8(const f32x4 a, const f32x4 b) { u32x4 w; w.x = cvt_pk_bf16(a[0], a[1]); w.y = cvt_pk_bf16(a[2], a[3]); w.z = cvt_pk_bf16(b[0], b[1]); w.w = cvt_pk_bf16(b[2], b[3]); return w; }

template <class Epi, class Sched>
__device__ __forceinline__ void gemm_phase(PG8_LAS unsigned char* lds, const Gemm g, const Sched& S, const Epi& E, int tid_in) {
    int tid_l = tid_in; asm volatile("" : "+v"(tid_l));
    const int tid = tid_l, wid = __builtin_amdgcn_readfirstlane(tid >> 6), lane = tid & 63, wr = wid >> 2, wc = wid & 3, fr = lane & 15, fq = lane >> 4;
    const int K = g.K, nt = K / BK;
    unsigned voffA[2], voffB[2];
#pragma unroll
    for (int i = 0; i < 2; ++i) { int R, C; stage_rc(tid * 16 + i * 8192, R, C); const int Rb = Epi::PERM ? ((R & ~31) + perm32(R & 31)) : R;
        voffA[i] = (unsigned)(R * g.lda + C) * 2u; voffB[i] = (unsigned)(Rb * g.ldb + C) * 2u; }
    asm volatile("" : "+v"(voffA[0]), "+v"(voffA[1]), "+v"(voffB[0]), "+v"(voffB[1]));
    const size_t kstep = (size_t)(BK * 2);
    const size_t hstepA = (size_t)HALF * g.lda * 2, hstepB = (size_t)HALF * g.ldb * 2;
    const size_t tstepA = 2 * hstepA, tstepB = 2 * hstepB;
    const unsigned ldsw = (unsigned)wid * 1024u;
    const int aoff = lds_byte(wr * 64 + fr, fq * 8), boff = lds_byte(wc * 32 + fr, fq * 8);
#define PG8_SA(b, h) (((b) * 2 + (h)) * HTB)
#define PG8_SB(b, h) ((4 + (b) * 2 + (h)) * HTB)
#define PG8_STAGE(bufoff, gbase, voff) do { _Pragma("unroll") for (int _i = 0; _i < 2; ++_i) \
        __builtin_amdgcn_global_load_lds((const unsigned*)((const char*)(gbase) + (voff)[_i]), (PG8_LAS unsigned*)(lds + (bufoff) + ldsw + _i * 8192), 16, 0, 0); } while (0)
#define PG8_LDA(dst, b, h) do { _Pragma("unroll") for (int m = 0; m < 4; ++m) _Pragma("unroll") for (int k = 0; k < 2; ++k) dst[m][k] = *(const PG8_LAS bf16x8*)(lds + PG8_SA(b, h) + aoff + m * 2048 + k * 1024); } while (0)
#define PG8_LDB(dst, b, h) do { _Pragma("unroll") for (int n = 0; n < 2; ++n) _Pragma("unroll") for (int k = 0; k < 2; ++k) dst[n][k] = *(const PG8_LAS bf16x8*)(lds + PG8_SB(b, h) + boff + n * 2048 + k * 1024); } while (0)
#define PG8_MMA(ai, bj, At, Bt) do { __builtin_amdgcn_s_setprio(1); _Pragma("unroll") for (int m = 0; m < 4; ++m) _Pragma("unroll") for (int n = 0; n < 2; ++n) _Pragma("unroll") for (int k = 0; k < 2; ++k) \
        acc[ai][bj][m][n] = __builtin_amdgcn_mfma_f32_16x16x32_bf16(Bt[n][k], At[m][k], acc[ai][bj][m][n], 0, 0, 0); __builtin_amdgcn_s_setprio(0); } while (0)
#define PG8_WAIT_V(n) asm volatile("s_waitcnt vmcnt(" #n ")" ::: "memory")
#define PG8_WAIT_L(n) asm volatile("s_waitcnt lgkmcnt(" #n ")" ::: "memory")
#define PG8_BAR __builtin_amdgcn_s_barrier()
#define PG8_SCHED __builtin_amdgcn_sched_barrier(0)
    Unit cur, nxt; int ui = 0;
    if (!S.next(0, cur)) return;
    f32x4 acc[2][2][4][2];
#pragma unroll
    for (int a = 0; a < 2; ++a)
#pragma unroll
        for (int b = 0; b < 2; ++b)
#pragma unroll
            for (int m = 0; m < 4; ++m)
#pragma unroll
                for (int n = 0; n < 2; ++n) acc[a][b][m][n] = (f32x4){0.f, 0.f, 0.f, 0.f};
    bf16x8 At[4][2], B0[2][2], B1[2][2];
    const char* cA = (const char*)g.A + (size_t)cur.pm * tstepA; const char* cB = (const char*)g.Bt + (size_t)cur.pn * tstepB;
    PG8_STAGE(PG8_SB(0, 0), cB, voffB); PG8_STAGE(PG8_SB(0, 1), cB + hstepB, voffB); PG8_STAGE(PG8_SA(0, 0), cA, voffA); PG8_STAGE(PG8_SA(0, 1), cA + hstepA, voffA);
    if (wr == 1) PG8_BAR;
    PG8_WAIT_V(2); PG8_BAR;
    PG8_STAGE(PG8_SB(1, 0), cB + kstep, voffB); PG8_STAGE(PG8_SA(1, 0), cA + kstep, voffA); PG8_STAGE(PG8_SB(1, 1), cB + hstepB + kstep, voffB);
    PG8_WAIT_V(6); PG8_BAR;
    for (;;) {
        const bool has_next = S.next(ui + 1, nxt);
        const char* nA = has_next ? (const char*)g.A + (size_t)nxt.pm * tstepA : cA; const char* nB = has_next ? (const char*)g.Bt + (size_t)nxt.pn * tstepB : cB;
#pragma unroll 1
        for (int t = 0; t < nt; t += 2) {
            const bool last = (t == nt - 2);
            if constexpr (Epi::MIDK) { if (t == (nt >> 1)) E.midk(acc, cur, wr, fr); }
            const char* a1 = cA + (size_t)(t + 1) * kstep;
            const char* a2 = last ? nA : cA + (size_t)(t + 2) * kstep; const char* b2 = last ? nB : cB + (size_t)(t + 2) * kstep;
            const char* a3 = a2 + kstep; const char* b3 = b2 + kstep;
            PG8_LDB(B0, 0, 0); PG8_LDB(B1, 0, 1); PG8_SCHED; PG8_LDA(At, 0, 0); PG8_STAGE(PG8_SA(1, 1), a1 + hstepA, voffA);
            PG8_WAIT_V(8); PG8_WAIT_L(0); PG8_BAR; PG8_MMA(0, 0, At, B0); PG8_MMA(0, 1, At, B1); PG8_BAR; PG8_SCHED;
            PG8_LDA(At, 0, 1); PG8_STAGE(PG8_SB(0, 0), b2, voffB); PG8_STAGE(PG8_SB(0, 1), b2 + hstepB, voffB); PG8_STAGE(PG8_SA(0, 0), a2, voffA);
            PG8_WAIT_V(8); PG8_WAIT_L(0); PG8_BAR; PG8_MMA(1, 0, At, B0); PG8_MMA(1, 1, At, B1); PG8_BAR; PG8_SCHED;
            PG8_LDB(B0, 1, 0); PG8_LDB(B1, 1, 1); PG8_SCHED; PG8_LDA(At, 1, 0); PG8_STAGE(PG8_SA(0, 1), a2 + hstepA, voffA);
            PG8_WAIT_V(8); PG8_WAIT_L(0); PG8_BAR; PG8_MMA(0, 0, At, B0); PG8_MMA(0, 1, At, B1); PG8_BAR; PG8_SCHED;
            PG8_LDA(At, 1, 1); PG8_STAGE(PG8_SB(1, 0), b3, voffB); PG8_STAGE(PG8_SB(1, 1), b3 + hstepB, voffB); PG8_STAGE(PG8_SA(1, 0), a3, voffA);
            PG8_WAIT_V(8); PG8_WAIT_L(0); PG8_BAR; PG8_MMA(1, 0, At, B0); PG8_MMA(1, 1, At, B1); PG8_BAR; PG8_SCHED;
        }
        if (wr == 0) PG8_BAR;
        E(acc, cur, wr, wc, fr, fq);
        if (!has_next) break;
#pragma unroll
        for (int a = 0; a < 2; ++a)
#pragma unroll
            for (int b = 0; b < 2; ++b)
#pragma unroll
                for (int m = 0; m < 4; ++m)
#pragma unroll
                    for (int n = 0; n < 2; ++n) acc[a][b][m][n] = (f32x4){0.f, 0.f, 0.f, 0.f};
        cur = nxt; cA = nA; cB = nB; ++ui;
        if (wr == 1) PG8_BAR;
    }
    PG8_WAIT_V(0);
    PG8_BAR;
#undef PG8_SA
#undef PG8_SB
#undef PG8_STAGE
#undef PG8_LDA
#undef PG8_LDB
#undef PG8_MMA
#undef PG8_WAIT_V
#undef PG8_WAIT_L
#undef PG8_BAR
#undef PG8_SCHED
}
}

constexpr int T = 24576, DM = 4096, DFF = 11008;
constexpr int NCHUNK = T / 16;
constexpr int QLAT = 896, KVLAT = 512, QW = 3072, KVW = 4096, MIXW = 2048;
constexpr float EPS = 1e-6f;
__device__ __forceinline__ int pos_of(int r) { return r < 16384 ? (r & 8191) : (r & 4095); }
__device__ __forceinline__ int len_of(int r) { return r < 16384 ? 8192 : 4096; }

typedef unsigned short bf16;
#define GAS __attribute__((address_space(1)))
#define LAS __attribute__((address_space(3)))
typedef unsigned v4u __attribute__((ext_vector_type(4)));
typedef unsigned v2u __attribute__((ext_vector_type(2)));
typedef float f32x4 __attribute__((ext_vector_type(4)));
typedef float f32x2 __attribute__((ext_vector_type(2)));
typedef short bf16x8 __attribute__((ext_vector_type(8)));

__device__ __forceinline__ unsigned f2bf(float f) { unsigned u = __builtin_bit_cast(unsigned, f); return (u + 0x7fffu + ((u >> 16) & 1u)) >> 16; }
__device__ __forceinline__ unsigned pk2(float lo, float hi) { return f2bf(lo) | (f2bf(hi) << 16); }
__device__ __forceinline__ float bf2f(unsigned short b) { return __builtin_bit_cast(float, (unsigned)b << 16); }
__device__ __forceinline__ float bflo(unsigned w) { return __builtin_bit_cast(float, w << 16); }
__device__ __forceinline__ float bfhi(unsigned w) { return __builtin_bit_cast(float, w & 0xffff0000u); }
__device__ __forceinline__ float sigmoidf_fast(float x) { return __builtin_amdgcn_rcpf(1.0f + __builtin_amdgcn_exp2f(-1.4426950408889634f * x)); }
__device__ __forceinline__ float gelu_tanh(float y) { const float in = 1.5957691216057308f * (y + 0.044715f * y * y * y); return y * sigmoidf_fast(in); }

namespace pg8 {
#define EPI_ROWS const int row0 = u.pm * 256 + wr * 64 + fr
__device__ __forceinline__ float sq8(const f32x4 a, const f32x4 b) { return (a[0] * a[0] + a[1] * a[1]) + (a[2] * a[2] + a[3] * a[3]) + (b[0] * b[0] + b[1] * b[1]) + (b[2] * b[2] + b[3] * b[3]); }
__device__ __forceinline__ float red_fq(float s) { s += __shfl_xor(s, 16); s += __shfl_xor(s, 32); return s; }

__device__ __forceinline__ f32x4 rope4(const f32x4 v, const f32x4 cs) { f32x4 o; o[0] = v[0] * cs[0] - v[1] * cs[1]; o[1] = v[1] * cs[0] + v[0] * cs[1]; o[2] = v[2] * cs[2] - v[3] * cs[3]; o[3] = v[3] * cs[2] + v[2] * cs[3]; return o; }

#define LAUNDER(p) asm volatile("" : "+v"(p))
struct EpiNull { static constexpr bool PERM = true, MIDK = false;
    __device__ __forceinline__ void midk(f32x4 (&)[2][2][4][2], const Unit&, int, int) const {}
    __device__ __forceinline__ void operator()(const f32x4 (&acc)[2][2][4][2], const Unit& u, int wr, int wc, int fr, int fq) const {
#pragma unroll
        for (int ai = 0; ai < 2; ++ai)
#pragma unroll
            for (int bj = 0; bj < 2; ++bj)
                asm volatile("" :: "v"(acc[ai][bj][0][0]), "v"(acc[ai][bj][0][1]), "v"(acc[ai][bj][1][0]), "v"(acc[ai][bj][1][1]), "v"(acc[ai][bj][2][0]), "v"(acc[ai][bj][2][1]), "v"(acc[ai][bj][3][0]), "v"(acc[ai][bj][3][1]));
    } };
struct EpiWin {
    static constexpr bool PERM = true, MIDK = false;
    const float* rstd_x; bf16_t* X; bf16_t* qlat; bf16_t* kvlat; bf16_t* krope; float* stQ; float* stKV; const float* ropetab;
    __device__ __forceinline__ void midk(f32x4 (&)[2][2][4][2], const Unit&, int, int) const {}
    __device__ __forceinline__ void operator()(const f32x4 (&acc)[2][2][4][2], const Unit& u, int wr, int wc, int fr, int fq) const {
        EPI_ROWS; const int tile = u.pn;
        const GAS float* rsp = (const GAS float*)(rstd_x + row0); LAUNDER(rsp);
        if (tile < 8) {
            const int c0 = tile * 256 + wc * 32 + 8 * fq;
            GAS bf16_t* xp0 = (GAS bf16_t*)X + ((size_t)((c0 >> 4) * NCHUNK + (row0 >> 4)) * 512 + 256 + (row0 & 15) * 16 + (c0 & 15)); LAUNDER(xp0);
#pragma unroll
            for (int ai = 0; ai < 2; ++ai)
#pragma unroll
                for (int m = 0; m < 4; ++m) { const float rs = rsp[ai * 128 + m * 16];
#pragma unroll
                    for (int bj = 0; bj < 2; ++bj)
                        *(GAS u32x4*)(xp0 + ((size_t)(bj * 8) * NCHUNK + ai * 8 + m) * 512) = pack8(acc[ai][bj][m][0] * rs, acc[ai][bj][m][1] * rs); }
        } else if (tile < 14) {
            const bool isq = tile < 12; const int tl = isq ? tile - 8 : tile - 12; const int ld = isq ? QLAT : KVLAT;
            const int c0 = tl * 256 + wc * 32 + 8 * fq;
            GAS bf16_t* op = (GAS bf16_t*)(isq ? qlat : kvlat) + (size_t)row0 * ld + c0; GAS float* sp = (GAS float*)(isq ? stQ + (size_t)row0 * 16 : stKV + (size_t)row0 * 8) + tl * 4 + wc; LAUNDER(op); LAUNDER(sp);
#pragma unroll
            for (int ai = 0; ai < 2; ++ai)
#pragma unroll
                for (int m = 0; m < 4; ++m) { const float rs = rsp[ai * 128 + m * 16]; float ss = 0.f;
#pragma unroll
                    for (int bj = 0; bj < 2; ++bj) { const f32x4 v0 = acc[ai][bj][m][0] * rs, v1 = acc[ai][bj][m][1] * rs; ss += sq8(v0, v1);
                        if (c0 + bj * 128 < ld) *(GAS u32x4*)(op + (size_t)(ai * 128 + m * 16) * ld + bj * 128) = pack8(v0, v1); }
                    ss = red_fq(ss); if (fq == 0) sp[(size_t)(ai * 128 + m * 16) * (isq ? 16 : 8)] = ss; }
        } else {
            if (wc < 2) { const int c = wc * 32 + 8 * fq;
                GAS bf16_t* op = (GAS bf16_t*)krope + (size_t)row0 * 64 + c; LAUNDER(op);
#pragma unroll
                for (int ai = 0; ai < 2; ++ai)
#pragma unroll
                    for (int m = 0; m < 4; ++m) { const int row = row0 + ai * 128 + m * 16; const float rs = rsp[ai * 128 + m * 16]; const int pos = pos_of(row);
                        const f32x4 cs0 = *(const GAS f32x4*)((const GAS float*)ropetab + (size_t)pos * 64 + c), cs1 = *(const GAS f32x4*)((const GAS float*)ropetab + (size_t)pos * 64 + c + 4);
                        const f32x4 v0 = rope4(acc[ai][0][m][0] * rs, cs0), v1 = rope4(acc[ai][0][m][1] * rs, cs1);
                        *(GAS u32x4*)(op + (size_t)(ai * 128 + m * 16) * 64) = pack8(v0, v1); } }
        }
    }
};
struct EpiSsm1 {
    static constexpr bool PERM = true, MIDK = false;
    bf16_t* X;
    __device__ __forceinline__ void midk(f32x4 (&)[2][2][4][2], const Unit&, int, int) const {}
    __device__ __forceinline__ void operator()(const f32x4 (&acc)[2][2][4][2], const Unit& u, int wr, int wc, int fr, int fq) const {
        EPI_ROWS; GAS bf16_t* op = (GAS bf16_t*)X + (size_t)row0 * 512 + wc * 32 + 8 * fq; LAUNDER(op);
#pragma unroll
        for (int ai = 0; ai < 2; ++ai)
#pragma unroll
            for (int m = 0; m < 4; ++m)
#pragma unroll
                for (int bj = 0; bj < 2; ++bj) *(GAS u32x4*)(op + (size_t)(ai * 128 + m * 16) * 512 + bj * 128) = pack8(acc[ai][bj][m][0], acc[ai][bj][m][1]);
    }
};
struct EpiSsm2 {
    static constexpr bool PERM = true, MIDK = false;
    bf16_t* gact;
    __device__ __forceinline__ void midk(f32x4 (&)[2][2][4][2], const Unit&, int, int) const {}
    __device__ __forceinline__ void operator()(const f32x4 (&acc)[2][2][4][2], const Unit& u, int wr, int wc, int fr, int fq) const {
        EPI_ROWS; const int g = u.pn; const int c0 = wc * 32 + 8 * fq;
        GAS bf16_t* op = (GAS bf16_t*)gact + ((size_t)(row0 - g * NCHUNK) * 16 + (c0 >> 4)) * MIXW + g * 16 + (c0 & 15); LAUNDER(op);
#pragma unroll
        for (int ai = 0; ai < 2; ++ai)
#pragma unroll
            for (int m = 0; m < 4; ++m)
#pragma unroll
                for (int bj = 0; bj < 2; ++bj) { f32x4 v0 = acc[ai][bj][m][0], v1 = acc[ai][bj][m][1];
#pragma unroll
                    for (int e = 0; e < 4; ++e) { v0[e] = gelu_tanh(v0[e]); v1[e] = gelu_tanh(v1[e]); }
                    *(GAS u32x4*)(op + ((size_t)(ai * 128 + m * 16) * 16 + bj * 8) * MIXW) = pack8(v0, v1); }
    }
};
struct EpiQ {
    static constexpr bool PERM = true, MIDK = false;
    const float* rstd_q; bf16_t* q; const float* ropetab;
    __device__ __forceinline__ void midk(f32x4 (&)[2][2][4][2], const Unit&, int, int) const {}
    __device__ __forceinline__ void operator()(const f32x4 (&acc)[2][2][4][2], const Unit& u, int wr, int wc, int fr, int fq) const {
        EPI_ROWS; const GAS float* rsp = (const GAS float*)(rstd_q + row0); GAS bf16_t* op = (GAS bf16_t*)q + (size_t)row0 * QW + u.pn * 256 + wc * 32 + 8 * fq; LAUNDER(rsp); LAUNDER(op);
#pragma unroll
        for (int ai = 0; ai < 2; ++ai)
#pragma unroll
            for (int m = 0; m < 4; ++m) { const int row = row0 + ai * 128 + m * 16; const float rs = rsp[ai * 128 + m * 16] * 0.10411754627697264f;     const int pos = pos_of(row);
#pragma unroll
                for (int bj = 0; bj < 2; ++bj) { const int strip = 8 * u.pn + 4 * bj + wc, s6 = strip % 6;
                    f32x4 v0 = acc[ai][bj][m][0] * rs, v1 = acc[ai][bj][m][1] * rs;
                    if (s6 >= 4) { const int pc = (s6 - 4) * 32 + 8 * fq;
                        const f32x4 cs0 = *(const GAS f32x4*)((const GAS float*)ropetab + (size_t)pos * 64 + pc), cs1 = *(const GAS f32x4*)((const GAS float*)ropetab + (size_t)pos * 64 + pc + 4);
                        v0 = rope4(v0, cs0); v1 = rope4(v1, cs1); }
                    *(GAS u32x4*)(op + (size_t)(ai * 128 + m * 16) * QW + bj * 128) = pack8(v0, v1); } }
    }
};
struct EpiKV {
    static constexpr bool PERM = true, MIDK = false;
    const float* rstd_kv; bf16_t* kv;
    __device__ __forceinline__ void midk(f32x4 (&)[2][2][4][2], const Unit&, int, int) const {}
    __device__ __forceinline__ void operator()(const f32x4 (&acc)[2][2][4][2], const Unit& u, int wr, int wc, int fr, int fq) const {
        EPI_ROWS; const GAS float* rsp = (const GAS float*)(rstd_kv + row0); GAS bf16_t* op = (GAS bf16_t*)kv + (size_t)row0 * 2048 + u.pn * 256 + wc * 32 + 8 * fq; LAUNDER(rsp); LAUNDER(op);
#pragma unroll
        for (int ai = 0; ai < 2; ++ai)
#pragma unroll
            for (int m = 0; m < 4; ++m) { const float rs = rsp[ai * 128 + m * 16];
#pragma unroll
                for (int bj = 0; bj < 2; ++bj) *(GAS u32x4*)(op + (size_t)(ai * 128 + m * 16) * 2048 + bj * 128) = pack8(acc[ai][bj][m][0] * rs, acc[ai][bj][m][1] * rs); }
    }
};
struct EpiVT {
    static constexpr bool PERM = true, MIDK = false;
    const float* rstd_kv; bf16_t* vt;
    __device__ __forceinline__ void midk(f32x4 (&)[2][2][4][2], const Unit&, int, int) const {}
    __device__ __forceinline__ void operator()(const f32x4 (&acc)[2][2][4][2], const Unit& u, int wr, int wc, int fr, int fq) const {
        EPI_ROWS; const int c0 = u.pn * 256 + wc * 32 + 8 * fq; const GAS float* rsp = (const GAS float*)(rstd_kv + c0); GAS bf16_t* op = (GAS bf16_t*)vt + (size_t)row0 * T + c0; LAUNDER(rsp); LAUNDER(op);
        GAS bf16_t* opp = op - 8 * fq + 16 * (fq & 1) + 4 * (fq >> 1);
#pragma unroll
        for (int bj = 0; bj < 2; ++bj) { const f32x4 r0 = *(const GAS f32x4*)(rsp + bj * 128), r1 = *(const GAS f32x4*)(rsp + bj * 128 + 4);
#pragma unroll
            for (int ai = 0; ai < 2; ++ai)
#pragma unroll
                for (int m = 0; m < 4; ++m) { const u32x4 w = pack8(acc[ai][bj][m][0] * r0, acc[ai][bj][m][1] * r1); GAS bf16_t* q_ = opp + (size_t)(ai * 128 + m * 16) * T + bj * 128;
                    *(GAS u32x2*)q_ = (u32x2){w.x, w.y}; *(GAS u32x2*)(q_ + 8) = (u32x2){w.z, w.w}; } }
    }
};
struct EpiGlu {
    static constexpr bool PERM = true, MIDK = false;
    const bf16_t* gact; bf16_t* merged; float* stA;
    __device__ __forceinline__ void midk(f32x4 (&)[2][2][4][2], const Unit&, int, int) const {}
    __device__ __forceinline__ void operator()(const f32x4 (&acc)[2][2][4][2], const Unit& u, int wr, int wc, int fr, int fq) const {
        EPI_ROWS; const int c0 = u.pn * 256 + wc * 32 + 8 * fq;
        const GAS bf16_t* gp = (const GAS bf16_t*)gact + (size_t)row0 * MIXW + c0; GAS bf16_t* op = (GAS bf16_t*)merged + (size_t)row0 * DM + c0; GAS float* sp = (GAS float*)stA + (size_t)row0 * 32 + u.pn * 4 + wc; LAUNDER(gp); LAUNDER(op); LAUNDER(sp);
#pragma unroll
        for (int ai = 0; ai < 2; ++ai)
#pragma unroll
            for (int m = 0; m < 4; ++m) { float ss = 0.f;
#pragma unroll
                for (int bj = 0; bj < 2; ++bj) {
                    const u32x4 gw = *(const GAS u32x4*)(gp + (size_t)(ai * 128 + m * 16) * MIXW + bj * 128);
                    f32x4 v0, v1; const f32x4 a0 = acc[ai][bj][m][0], a1 = acc[ai][bj][m][1];
                    v0[0] = bflo(gw.x) * sigmoidf_fast(a0[0]); v0[1] = bfhi(gw.x) * sigmoidf_fast(a0[1]); v0[2] = bflo(gw.y) * sigmoidf_fast(a0[2]); v0[3] = bfhi(gw.y) * sigmoidf_fast(a0[3]);
                    v1[0] = bflo(gw.z) * sigmoidf_fast(a1[0]); v1[1] = bfhi(gw.z) * sigmoidf_fast(a1[1]); v1[2] = bflo(gw.w) * sigmoidf_fast(a1[2]); v1[3] = bfhi(gw.w) * sigmoidf_fast(a1[3]);
                    ss += sq8(v0, v1);
                    *(GAS u32x4*)(op + (size_t)(ai * 128 + m * 16) * DM + bj * 128) = pack8(v0, v1); }
                ss = red_fq(ss); if (fq == 0) sp[(size_t)(ai * 128 + m * 16) * 32] = ss; }
    }
};
struct EpiWout {
    static constexpr bool PERM = true, MIDK = true;
    const float* xp; const float* xs; const float* r2; const float* ratio; bf16_t* x1b; float* stA;
    __device__ __forceinline__ void midk(f32x4 (&acc)[2][2][4][2], const Unit& u, int wr, int fr) const {
        EPI_ROWS; const GAS float* rp = (const GAS float*)(ratio + row0); LAUNDER(rp);
#pragma unroll
        for (int ai = 0; ai < 2; ++ai)
#pragma unroll
            for (int m = 0; m < 4; ++m) { const float rt = rp[ai * 128 + m * 16];
#pragma unroll
                for (int bj = 0; bj < 2; ++bj)
#pragma unroll
                    for (int n = 0; n < 2; ++n) acc[ai][bj][m][n] *= rt; }
    }
    __device__ __forceinline__ void operator()(const f32x4 (&acc)[2][2][4][2], const Unit& u, int wr, int wc, int fr, int fq) const {
        EPI_ROWS; const int c0 = u.pn * 256 + wc * 32 + 8 * fq; const int rowt = u.pm * 256;
        const GAS float* xin = (const GAS float*)(rowt < 16384 ? xp + (size_t)row0 * DM : xs + (size_t)(row0 - 16384) * DM) + c0;
        const GAS float* rsp = (const GAS float*)(r2 + row0); GAS bf16_t* bo = (GAS bf16_t*)x1b + (size_t)row0 * DM + c0; GAS float* sp = (GAS float*)stA + (size_t)row0 * 64 + u.pn * 4 + wc;
        LAUNDER(xin); LAUNDER(rsp); LAUNDER(bo); LAUNDER(sp);
#pragma unroll
        for (int ai = 0; ai < 2; ++ai) {
            f32x4 xv[4][2][2]; float rs[4];
#pragma unroll
            for (int m = 0; m < 4; ++m) { const size_t ro = (size_t)(ai * 128 + m * 16) * DM; rs[m] = rsp[ai * 128 + m * 16];
#pragma unroll
                for (int bj = 0; bj < 2; ++bj) { xv[m][bj][0] = *(const GAS f32x4*)(xin + ro + bj * 128); xv[m][bj][1] = *(const GAS f32x4*)(xin + ro + bj * 128 + 4); } }
            __builtin_amdgcn_sched_barrier(0);
#pragma unroll
            for (int m = 0; m < 4; ++m) { float ss = 0.f; const size_t ro = (size_t)(ai * 128 + m * 16) * DM;
#pragma unroll
                for (int bj = 0; bj < 2; ++bj) {
                    const f32x4 v0 = xv[m][bj][0] + acc[ai][bj][m][0] * rs[m], v1 = xv[m][bj][1] + acc[ai][bj][m][1] * rs[m];
                    ss += sq8(v0, v1);
                    *(GAS u32x4*)(bo + ro + bj * 128) = pack8(v0, v1); }
                ss = red_fq(ss); if (fq == 0) sp[(size_t)(ai * 128 + m * 16) * 64] = ss; }
            __builtin_amdgcn_sched_barrier(0);
        }
    }
};
__device__ __forceinline__ float dpp_ror1(float v) { return __builtin_bit_cast(float, __builtin_amdgcn_mov_dpp(__builtin_bit_cast(int, v), 0x121, 0xf, 0xf, false)); }
__device__ __forceinline__ float dpp_rol1(float v) { return __builtin_bit_cast(float, __builtin_amdgcn_mov_dpp(__builtin_bit_cast(int, v), 0x12f, 0xf, 0xf, false)); }
struct EpiFfnA {
    static constexpr bool PERM = true, MIDK = false;
    const float* rstd; int row_base; bf16_t* act; bf16_t* halo_up; bf16_t* halo_gate; const float* cw; const float* cb;
    __device__ __forceinline__ void midk(f32x4 (&)[2][2][4][2], const Unit&, int, int) const {}
    __device__ __forceinline__ void operator()(const f32x4 (&acc)[2][2][4][2], const Unit& u, int wr, int wc, int fr, int fq) const {
        EPI_ROWS; const int f0 = u.pn * 128 + wc * 32 + 8 * fq;
        const GAS float* rsp = (const GAS float*)(rstd + row_base + row0); GAS bf16_t* actp = (GAS bf16_t*)act + (size_t)row0 * DFF + f0;
        const int strip0 = u.pm * 4 + wr;
        GAS bf16_t* hup_p = (GAS bf16_t*)halo_up + (size_t)strip0 * 4 * DFF + f0; GAS bf16_t* hg_p = (GAS bf16_t*)halo_gate + (size_t)strip0 * 2 * DFF + f0;
        const GAS float* cwp = (const GAS float*)(cw + f0); const GAS float* cbp = (const GAS float*)(cb + f0);
        asm volatile("" : "+v"(rsp), "+v"(actp), "+v"(hup_p), "+v"(hg_p), "+v"(cwp), "+v"(cbp));
#pragma unroll
        for (int ai = 0; ai < 2; ++ai) {
            float rs[4];
#pragma unroll
            for (int m = 0; m < 4; ++m) rs[m] = rsp[ai * 128 + m * 16];
            u32x2 keep[4];
#pragma unroll
            for (int n = 0; n < 2; ++n) {
                const f32x4 w0 = *(const GAS f32x4*)(cwp + 4 * n), w1 = *(const GAS f32x4*)(cwp + DFF + 4 * n), w2 = *(const GAS f32x4*)(cwp + 2 * DFF + 4 * n), wb = *(const GAS f32x4*)(cbp + 4 * n);
                f32x4 res[4], Uu[4];
#pragma unroll
                for (int e = 0; e < 4; ++e) {
                    float U[4], R[4], L[4];
#pragma unroll
                    for (int m = 0; m < 4; ++m) { U[m] = acc[ai][0][m][n][e] * rs[m]; R[m] = dpp_ror1(U[m]); L[m] = dpp_rol1(U[m]); Uu[m][e] = U[m]; }
#pragma unroll
                    for (int m = 0; m < 4; ++m) {
                        const float prev = (fr == 0) ? R[m > 0 ? m - 1 : 0] : R[m];
                        const float next = (fr == 15) ? L[m < 3 ? m + 1 : 3] : L[m];
                        const float cv = w0[e] * prev + w1[e] * U[m] + w2[e] * next + wb[e];
                        res[m][e] = cv * sigmoidf_fast(cv) * (acc[ai][1][m][n][e] * rs[m]);
                    }
                }
#pragma unroll
                for (int m = 0; m < 4; ++m) {
                    const bool edge = (m == 0 && fr == 0) || (m == 3 && fr == 15);
                    { u32x2 w; w.x = cvt_pk_bf16(res[m][0], res[m][1]); w.y = cvt_pk_bf16(res[m][2], res[m][3]);
                      if (n == 0) keep[m] = w; else if (!edge) *(GAS u32x4*)(actp + (size_t)(ai * 128 + m * 16) * DFF) = (u32x4){keep[m].x, keep[m].y, w.x, w.y}; }
                    if (m == 0 || m == 3) {
                        const int hs = (m == 0) ? (fr == 0 ? 0 : (fr == 1 ? 1 : -1)) : (fr == 14 ? 2 : (fr == 15 ? 3 : -1));
                        if (hs >= 0) { u32x2 w; w.x = cvt_pk_bf16(Uu[m][0], Uu[m][1]); w.y = cvt_pk_bf16(Uu[m][2], Uu[m][3]);
                            *(GAS u32x2*)(hup_p + ((size_t)(ai * 2) * 4 + hs) * DFF + 4 * n) = w;
                            if (hs == 0 || hs == 3) { const f32x4 gv = acc[ai][1][m][n] * rs[m]; u32x2 wg; wg.x = cvt_pk_bf16(gv[0], gv[1]); wg.y = cvt_pk_bf16(gv[2], gv[3]);
                                *(GAS u32x2*)(hg_p + ((size_t)(ai * 2) * 2 + (hs == 3 ? 1 : 0)) * DFF + 4 * n) = wg; } }
                    }
                }
            }
        }
    }
};
struct EpiDown {
    static constexpr bool PERM = true, MIDK = false;
    bf16_t* xb; int row_base; float* stA;
    __device__ __forceinline__ void midk(f32x4 (&)[2][2][4][2], const Unit&, int, int) const {}
    __device__ __forceinline__ void operator()(const f32x4 (&acc)[2][2][4][2], const Unit& u, int wr, int wc, int fr, int fq) const {
        EPI_ROWS; GAS bf16_t* xo = (GAS bf16_t*)xb + (size_t)(row_base + row0) * DM + u.pn * 256 + wc * 32 + 8 * fq; GAS float* sp = (GAS float*)stA + (size_t)(row_base + row0) * 64 + u.pn * 4 + wc; LAUNDER(xo); LAUNDER(sp);
#pragma unroll
        for (int ai = 0; ai < 2; ++ai)
#pragma unroll
            for (int m = 0; m < 4; ++m) { float ss = 0.f; const size_t ro = (size_t)(ai * 128 + m * 16) * DM;
#pragma unroll
                for (int bj = 0; bj < 2; ++bj) { GAS bf16_t* p = xo + ro + bj * 128; const u32x4 w = *(const GAS u32x4*)p; const f32x4 a0 = acc[ai][bj][m][0], a1 = acc[ai][bj][m][1];
                    f32x4 v0, v1; v0[0] = bflo(w.x) + a0[0]; v0[1] = bfhi(w.x) + a0[1]; v0[2] = bflo(w.y) + a0[2]; v0[3] = bfhi(w.y) + a0[3];
                    v1[0] = bflo(w.z) + a1[0]; v1[1] = bfhi(w.z) + a1[1]; v1[2] = bflo(w.w) + a1[2]; v1[3] = bfhi(w.w) + a1[3];
                    ss += sq8(v0, v1); *(GAS u32x4*)p = pack8(v0, v1); }
                ss = red_fq(ss); if (fq == 0) sp[(size_t)(ai * 128 + m * 16) * 64] = ss; }
    }
};
#undef EPI_ROWS
}

namespace attn {
using f32x4v = __attribute__((ext_vector_type(4))) float;
using u32x2v = __attribute__((ext_vector_type(2))) unsigned;
using u32x4v = __attribute__((ext_vector_type(4))) unsigned;
constexpr int NW = 8, KVBLK = 64;
constexpr float SCALE = 0.07216878364870322f;
constexpr float THR = 8.f;
constexpr int LDQ = 3072, LDK = 2048, LDR = 64, LDVT = T, LDO = 4096;
constexpr int SHM_V = 128 * KVBLK * 2, SHM_K = KVBLK * 128 * 2, SHM_R = KVBLK * 64 * 2;
constexpr int OFF_V = 0, OFF_K = 2 * SHM_V, OFF_R = OFF_K + 2 * SHM_K, OFF_QR = OFF_R + 2 * SHM_R, SHM_ATTN = OFF_QR + NW * 4096;
#define SBAR() __builtin_amdgcn_sched_barrier(0)
#define PIN(x) asm volatile("" : "+v"(x))
__device__ __forceinline__ void glds16(const void* gsrc, unsigned lds_dst) { unsigned keep;
  asm volatile("s_mov_b32 %0, m0\n\ts_mov_b32 m0, %2\n\ts_nop 0\n\tglobal_load_lds_dwordx4 %1, off\n\ts_mov_b32 m0, %0" : "=&s"(keep) : "v"(gsrc), "s"(lds_dst) : "memory"); }
__device__ __forceinline__ unsigned cvtpk(float lo, float hi) { unsigned r; asm volatile("v_cvt_pk_bf16_f32 %0, %1, %2" : "=v"(r) : "v"(lo), "v"(hi)); return r; }
__device__ __forceinline__ float xmax16(float v) { auto r = __builtin_amdgcn_permlane16_swap(__float_as_uint(v), __float_as_uint(v), false, false); return fmaxf(__uint_as_float(r[0]), __uint_as_float(r[1])); }
__device__ __forceinline__ float xmax32(float v) { auto r = __builtin_amdgcn_permlane32_swap(__float_as_uint(v), __float_as_uint(v), false, false); return fmaxf(__uint_as_float(r[0]), __uint_as_float(r[1])); }
__device__ __forceinline__ float xsum16(float v) { auto r = __builtin_amdgcn_permlane16_swap(__float_as_uint(v), __float_as_uint(v), false, false); return __uint_as_float(r[0]) + __uint_as_float(r[1]); }
__device__ __forceinline__ float xsum32(float v) { auto r = __builtin_amdgcn_permlane32_swap(__float_as_uint(v), __float_as_uint(v), false, false); return __uint_as_float(r[0]) + __uint_as_float(r[1]); }
__device__ __forceinline__ float max3f(float a, float b, float c) { float r; asm("v_max3_f32 %0, %1, %2, %3" : "=v"(r) : "v"(a), "v"(b), "v"(c)); return r; }
#define MF16(A, B, C) __builtin_amdgcn_mfma_f32_16x16x32_bf16(A, B, C, 0, 0, 0)
struct Lane { const LAS char* Kl; const LAS char* Rl; const LAS char* Vl; const LAS char* qrl; int ky, rz, vz; };
template <int KB, int S> __device__ __forceinline__ bf16x8 kfrag(const Lane& L, int kst, int rst) {
  if constexpr (S < 4) return *(const LAS bf16x8*)(L.Kl + kst + KB * 4096 + ((64 * S) ^ L.ky));
  else return *(const LAS bf16x8*)(L.Rl + rst + KB * 2048 + ((64 * (S - 4)) ^ L.rz));
}
template <int DB, int C> __device__ __forceinline__ bf16x8 vfrag(const Lane& L, int vst) { return *(const LAS bf16x8*)(L.Vl + vst + DB * 2048 + ((64 * C) ^ L.rz)); }
template <int QB, int S> __device__ __forceinline__ bf16x8 qfrag(const bf16x8 (&qn)[2][6], const Lane& L) { return qn[QB][S]; }
template <int KB> __device__ __forceinline__ void qk_block_plain(f32x4v (&s)[2][4], const bf16x8 (&qn)[2][6], const Lane& L, int kst, int rst) {
  bf16x8 k = kfrag<KB, 0>(L, kst, rst); s[0][KB] = MF16(k, (qfrag<0, 0>(qn, L)), ((f32x4v){0.f, 0.f, 0.f, 0.f})); s[1][KB] = MF16(k, (qfrag<1, 0>(qn, L)), ((f32x4v){0.f, 0.f, 0.f, 0.f}));
  k = kfrag<KB, 1>(L, kst, rst); s[0][KB] = MF16(k, (qfrag<0, 1>(qn, L)), s[0][KB]); s[1][KB] = MF16(k, (qfrag<1, 1>(qn, L)), s[1][KB]);
  k = kfrag<KB, 2>(L, kst, rst); s[0][KB] = MF16(k, (qfrag<0, 2>(qn, L)), s[0][KB]); s[1][KB] = MF16(k, (qfrag<1, 2>(qn, L)), s[1][KB]);
  k = kfrag<KB, 3>(L, kst, rst); s[0][KB] = MF16(k, (qfrag<0, 3>(qn, L)), s[0][KB]); s[1][KB] = MF16(k, (qfrag<1, 3>(qn, L)), s[1][KB]);
  k = kfrag<KB, 4>(L, kst, rst); s[0][KB] = MF16(k, (qfrag<0, 4>(qn, L)), s[0][KB]); s[1][KB] = MF16(k, (qfrag<1, 4>(qn, L)), s[1][KB]);
  k = kfrag<KB, 5>(L, kst, rst); s[0][KB] = MF16(k, (qfrag<0, 5>(qn, L)), s[0][KB]); s[1][KB] = MF16(k, (qfrag<1, 5>(qn, L)), s[1][KB]);
}
template <int QB> __device__ __forceinline__ float rowmax(const f32x4v (&s)[2][4]) {
  float m = max3f(s[QB][0][0], s[QB][0][1], s[QB][0][2]); m = max3f(m, s[QB][0][3], s[QB][1][0]); m = max3f(m, s[QB][1][1], s[QB][1][2]); m = max3f(m, s[QB][1][3], s[QB][2][0]);
  m = max3f(m, s[QB][2][1], s[QB][2][2]); m = max3f(m, s[QB][2][3], s[QB][3][0]); m = max3f(m, s[QB][3][1], s[QB][3][2]); m = max3f(m, s[QB][3][3], s[QB][3][3]); return m;
}
constexpr float THRL = 11.541560327111707f;
__device__ __forceinline__ void decide(float pm0, float pm1, f32x4v (&c)[2][4], float (&mh)[2], f32x4v (&negm)[2], float (&al)[2]) {
  pm0 = xmax32(xmax16(pm0)); pm1 = xmax32(xmax16(pm1));
  if (__builtin_expect(__all((pm0 <= THRL) && (pm1 <= THRL)), 1)) { al[0] = 1.f; al[1] = 1.f; }
  else { const float d0 = fmaxf(pm0, 0.f), d1 = fmaxf(pm1, 0.f); mh[0] += d0; mh[1] += d1;
#pragma unroll
    for (int kb = 0; kb < 4; ++kb) { c[0][kb] = c[0][kb] - d0; c[1][kb] = c[1][kb] - d1; }
    al[0] = __builtin_amdgcn_exp2f(-d0); al[1] = __builtin_amdgcn_exp2f(-d1);
    negm[0] = (f32x4v){-mh[0], -mh[0], -mh[0], -mh[0]}; negm[1] = (f32x4v){-mh[1], -mh[1], -mh[1], -mh[1]}; }
}
__device__ __forceinline__ bf16x8 packp(const f32x4v a, const f32x4v b) { const u32x4v w = {cvtpk(a[0], a[1]), cvtpk(a[2], a[3]), cvtpk(b[0], b[1]), cvtpk(b[2], b[3])}; return __builtin_bit_cast(bf16x8, w); }

struct Dma { const char* k0; const char* k1; const char* r; const char* v0; const char* v1; unsigned dk, dr, dv; bool kr; };
__device__ __forceinline__ void attn_step(f32x4v (&c)[2][4], f32x4v (&p)[2][4], f32x4v (&o)[2][8], const bf16x8 (&qn)[2][6], const Lane& L, int kst, int rst, int vst,
                                          const float (&alp)[2], float (&l)[2], float (&mh)[2], f32x4v (&negm)[2], float (&alc)[2], const Dma& D) {
  bf16x8 ka, kb_, kc, kd, P00, P01, P10, P11;
#define QKR(KB, S, FIRST, KX, KY) do { \
    if (FIRST) { c[0][KB] = MF16(KX, (qfrag<0, S>(qn, L)), negm[0]); c[1][KB] = MF16(KX, (qfrag<1, S>(qn, L)), negm[1]); \
                 c[0][KB + 1] = MF16(KY, (qfrag<0, S>(qn, L)), negm[0]); c[1][KB + 1] = MF16(KY, (qfrag<1, S>(qn, L)), negm[1]); } \
    else { c[0][KB] = MF16(KX, (qfrag<0, S>(qn, L)), c[0][KB]); c[1][KB] = MF16(KX, (qfrag<1, S>(qn, L)), c[1][KB]); \
           c[0][KB + 1] = MF16(KY, (qfrag<0, S>(qn, L)), c[0][KB + 1]); c[1][KB + 1] = MF16(KY, (qfrag<1, S>(qn, L)), c[1][KB + 1]); } } while (0)
#define EXP4(V) do { V[0] = __builtin_amdgcn_exp2f(V[0]); V[1] = __builtin_amdgcn_exp2f(V[1]); V[2] = __builtin_amdgcn_exp2f(V[2]); V[3] = __builtin_amdgcn_exp2f(V[3]); } while (0)
  ka = kfrag<0, 0>(L, kst, rst); kb_ = kfrag<1, 0>(L, kst, rst); SBAR();
  kc = kfrag<0, 1>(L, kst, rst); kd = kfrag<1, 1>(L, kst, rst); QKR(0, 0, true, ka, kb_); EXP4(p[0][2]); PIN(p[0][2]); SBAR();
  if (D.kr) glds16(D.k0, D.dk);
  ka = kfrag<0, 2>(L, kst, rst); kb_ = kfrag<1, 2>(L, kst, rst); QKR(0, 1, false, kc, kd); EXP4(p[0][3]); PIN(p[0][3]); SBAR();
  kc = kfrag<0, 3>(L, kst, rst); kd = kfrag<1, 3>(L, kst, rst); QKR(0, 2, false, ka, kb_); EXP4(p[1][2]); PIN(p[1][2]); SBAR();
  if (D.kr) glds16(D.k1, D.dk + 8192);
  ka = kfrag<0, 4>(L, kst, rst); kb_ = kfrag<1, 4>(L, kst, rst); QKR(0, 3, false, kc, kd); EXP4(p[1][3]); PIN(p[1][3]); SBAR();
  kc = kfrag<0, 5>(L, kst, rst); kd = kfrag<1, 5>(L, kst, rst); QKR(0, 4, false, ka, kb_);
  { float s = (p[0][0][0] + p[0][0][1]) + (p[0][0][2] + p[0][0][3]); s += (p[0][1][0] + p[0][1][1]) + (p[0][1][2] + p[0][1][3]); s += (p[0][2][0] + p[0][2][1]) + (p[0][2][2] + p[0][2][3]); s += (p[0][3][0] + p[0][3][1]) + (p[0][3][2] + p[0][3][3]);
    l[0] = l[0] * alp[0] + s; PIN(l[0]); } SBAR();
  if (D.kr) glds16(D.r, D.dr);
  ka = kfrag<2, 0>(L, kst, rst); kb_ = kfrag<3, 0>(L, kst, rst); QKR(0, 5, false, kc, kd);
  { float s = (p[1][0][0] + p[1][0][1]) + (p[1][0][2] + p[1][0][3]); s += (p[1][1][0] + p[1][1][1]) + (p[1][1][2] + p[1][1][3]); s += (p[1][2][0] + p[1][2][1]) + (p[1][2][2] + p[1][2][3]); s += (p[1][3][0] + p[1][3][1]) + (p[1][3][2] + p[1][3][3]);
    l[1] = l[1] * alp[1] + s; PIN(l[1]); } SBAR();
  kc = kfrag<2, 1>(L, kst, rst); kd = kfrag<3, 1>(L, kst, rst); QKR(2, 0, true, ka, kb_); P00 = packp(p[0][0], p[0][1]); PIN(P00); SBAR();
  glds16(D.v0, D.dv);
  ka = kfrag<2, 2>(L, kst, rst); kb_ = kfrag<3, 2>(L, kst, rst); QKR(2, 1, false, kc, kd); P01 = packp(p[0][2], p[0][3]); PIN(P01); SBAR();
  kc = kfrag<2, 3>(L, kst, rst); kd = kfrag<3, 3>(L, kst, rst); QKR(2, 2, false, ka, kb_); P10 = packp(p[1][0], p[1][1]); PIN(P10); SBAR();
  glds16(D.v1, D.dv + 8192);
  ka = kfrag<2, 4>(L, kst, rst); kb_ = kfrag<3, 4>(L, kst, rst); QKR(2, 3, false, kc, kd); P11 = packp(p[1][2], p[1][3]); PIN(P11); SBAR();
  kc = kfrag<2, 5>(L, kst, rst); kd = kfrag<3, 5>(L, kst, rst); QKR(2, 4, false, ka, kb_); SBAR();
  ka = vfrag<0, 0>(L, vst); kb_ = vfrag<1, 0>(L, vst); QKR(2, 5, false, kc, kd); SBAR();
#define PVR(DB, VX, VY, PA, PB) do { o[0][DB] = MF16(VX, PA, o[0][DB]); o[1][DB] = MF16(VX, PB, o[1][DB]); o[0][DB + 1] = MF16(VY, PA, o[0][DB + 1]); o[1][DB + 1] = MF16(VY, PB, o[1][DB + 1]); } while (0)
  float pm0, pm1;
  kc = vfrag<2, 0>(L, vst); kd = vfrag<3, 0>(L, vst); PVR(0, ka, kb_, P00, P10); pm0 = rowmax<0>(c); PIN(pm0); SBAR();
  ka = vfrag<4, 0>(L, vst); kb_ = vfrag<5, 0>(L, vst); PVR(2, kc, kd, P00, P10); pm1 = rowmax<1>(c); PIN(pm1); SBAR();
  kc = vfrag<6, 0>(L, vst); kd = vfrag<7, 0>(L, vst); PVR(4, ka, kb_, P00, P10); decide(pm0, pm1, c, mh, negm, alc); SBAR();
  ka = vfrag<0, 1>(L, vst); kb_ = vfrag<1, 1>(L, vst); PVR(6, kc, kd, P00, P10); EXP4(c[0][0]); PIN(c[0][0]); SBAR();
  kc = vfrag<2, 1>(L, vst); kd = vfrag<3, 1>(L, vst); PVR(0, ka, kb_, P01, P11); EXP4(c[0][1]); PIN(c[0][1]); SBAR();
  ka = vfrag<4, 1>(L, vst); kb_ = vfrag<5, 1>(L, vst); PVR(2, kc, kd, P01, P11); EXP4(c[1][0]); PIN(c[1][0]); SBAR();
  kc = vfrag<6, 1>(L, vst); kd = vfrag<7, 1>(L, vst); PVR(4, ka, kb_, P01, P11); EXP4(c[1][1]); PIN(c[1][1]); SBAR();
  PVR(6, kc, kd, P01, P11); SBAR();
#undef QKR
#undef PVR
}

__device__ __forceinline__ void attn_unit(const bf16* __restrict__ Qb, const bf16* __restrict__ Kh, const bf16* __restrict__ VTh, const bf16* __restrict__ Rh,
                                          bf16* __restrict__ Ob, float* __restrict__ st, int seq, int k0g, char* lds, int wid) {
  int lane_l = (int)__builtin_amdgcn_mbcnt_hi(~0u, __builtin_amdgcn_mbcnt_lo(~0u, 0u)); asm volatile("" : "+v"(lane_l));
  const int lane = lane_l, l15 = lane & 15, kq = lane >> 4;
  bf16x8 qn[2][6]; Lane L;
  L.qrl = (const LAS char*)(lds + OFF_QR + wid * 4096 + lane * 16);
  { const bf16* Qw = Qb + (long)(wid * 32 + l15) * LDQ + kq * 8;
#pragma unroll
    for (int qb = 0; qb < 2; ++qb) {
#pragma unroll
      for (int s = 0; s < 6; ++s) qn[qb][s] = *(const GAS bf16x8*)(Qw + (long)qb * 16 * LDQ + s * 32); } }
  L.Kl = (const LAS char*)(lds + OFF_K) + l15 * 256; L.Rl = (const LAS char*)(lds + OFF_R) + l15 * 128; L.Vl = (const LAS char*)(lds + OFF_V) + l15 * 128;
  L.ky = (kq ^ l15) << 4; L.rz = (kq ^ ((l15 >> 1) & 7)) << 4; L.vz = 0;
  unsigned kof0, kof1, rof, vof0, vof1;
  { const int q0 = wid, q1 = wid + 8;
    { const int row = 4 * q0 + (lane >> 4), ch = (lane & 15) ^ (row & 15); kof0 = (unsigned)(row * LDK + ch * 8) * 2u; }
    { const int row = 4 * q1 + (lane >> 4), ch = (lane & 15) ^ (row & 15); kof1 = (unsigned)(row * LDK + ch * 8) * 2u; }
    { const int row = 8 * q0 + (lane >> 3), ch = (lane & 7) ^ ((row >> 1) & 7); rof = (unsigned)(row * LDR + ch * 8) * 2u; }
    { const int row = 8 * q0 + (lane >> 3), ch = (lane & 7) ^ ((row >> 1) & 7); vof0 = (unsigned)(row * LDVT + ch * 8) * 2u; }
    { const int row = 8 * q1 + (lane >> 3), ch = (lane & 7) ^ ((row >> 1) & 7); vof1 = (unsigned)(row * LDVT + ch * 8) * 2u; } }
  const unsigned lds0 = (unsigned)(uintptr_t)lds;
  const unsigned dK = (unsigned)__builtin_amdgcn_readfirstlane(lds0 + OFF_K + wid * 1024), dR = (unsigned)__builtin_amdgcn_readfirstlane(lds0 + OFF_R + wid * 1024), dV = (unsigned)__builtin_amdgcn_readfirstlane(lds0 + OFF_V + wid * 1024);
  const char* VTk = (const char*)VTh + (size_t)k0g * 2;
#define DMA_KR(t, s) do { const char* kb_ = (const char*)Kh + (size_t)(t) * (KVBLK * LDK * 2); const char* rb_ = (const char*)Rh + (size_t)(t) * (KVBLK * LDR * 2); \
    glds16(kb_ + kof0, dK + (s) * SHM_K); glds16(kb_ + kof1, dK + (s) * SHM_K + 8192); glds16(rb_ + rof, dR + (s) * SHM_R); } while (0)
#define DMA_V(t, s) do { const char* vb_ = VTk + (size_t)(t) * (KVBLK * 2); glds16(vb_ + vof0, dV + (s) * SHM_V); glds16(vb_ + vof1, dV + (s) * SHM_V + 8192); } while (0)
#define WAIT_BAR() asm volatile("s_waitcnt vmcnt(0) lgkmcnt(0)\n\ts_barrier" ::: "memory")
#define RESC(a) do { if (__any(((a)[0] < 1.f) || ((a)[1] < 1.f))) { _Pragma("unroll") for (int d_ = 0; d_ < 8; ++d_) { o[0][d_] *= (a)[0]; o[1][d_] *= (a)[1]; } } } while (0)
  f32x4v o[2][8], sA[2][4], sB[2][4], negm[2]; float mh[2], l[2] = {0.f, 0.f}, alA[2], alB[2];
#pragma unroll
  for (int d = 0; d < 8; ++d) { o[0][d] = (f32x4v){0.f, 0.f, 0.f, 0.f}; o[1][d] = (f32x4v){0.f, 0.f, 0.f, 0.f}; }
  const int NT = seq / KVBLK;
  DMA_KR(0, 0); DMA_V(0, 0); WAIT_BAR();
  DMA_KR(1, 1);
  qk_block_plain<0>(sA, qn, L, 0, 0); qk_block_plain<1>(sA, qn, L, 0, 0); qk_block_plain<2>(sA, qn, L, 0, 0); qk_block_plain<3>(sA, qn, L, 0, 0);
  { mh[0] = xmax32(xmax16(rowmax<0>(sA))); mh[1] = xmax32(xmax16(rowmax<1>(sA))); alA[0] = 1.f; alA[1] = 1.f;
    negm[0] = (f32x4v){-mh[0], -mh[0], -mh[0], -mh[0]}; negm[1] = (f32x4v){-mh[1], -mh[1], -mh[1], -mh[1]};
#pragma unroll
    for (int kb = 0; kb < 4; ++kb) { sA[0][kb] = sA[0][kb] - mh[0]; sA[1][kb] = sA[1][kb] - mh[1]; }
#pragma unroll
    for (int kb = 0; kb < 2; ++kb)
#pragma unroll
      for (int e = 0; e < 4; ++e) { sA[0][kb][e] = __builtin_amdgcn_exp2f(sA[0][kb][e]); sA[1][kb][e] = __builtin_amdgcn_exp2f(sA[1][kb][e]); } }
  WAIT_BAR();
#pragma unroll 1
  for (int j = 1; j + 1 < NT; j += 2) {
    { const char* kb_ = (const char*)Kh + (size_t)(j + 1) * (KVBLK * LDK * 2); const char* rb_ = (const char*)Rh + (size_t)(j + 1) * (KVBLK * LDR * 2); const char* vb_ = VTk + (size_t)j * (KVBLK * 2);
      const Dma D{kb_ + kof0, kb_ + kof1, rb_ + rof, vb_ + vof0, vb_ + vof1, dK, dR, dV + SHM_V, true};
      attn_step(sB, sA, o, qn, L, SHM_K, SHM_R, 0, alA, l, mh, negm, alB, D); }
    RESC(alB); WAIT_BAR();
    { const char* kb_ = (const char*)Kh + (size_t)(j + 2) * (KVBLK * LDK * 2); const char* rb_ = (const char*)Rh + (size_t)(j + 2) * (KVBLK * LDR * 2); const char* vb_ = VTk + (size_t)(j + 1) * (KVBLK * 2);
      const Dma D{kb_ + kof0, kb_ + kof1, rb_ + rof, vb_ + vof0, vb_ + vof1, dK + SHM_K, dR + SHM_R, dV, (j + 2 < NT)};
      attn_step(sA, sB, o, qn, L, 0, 0, SHM_V, alB, l, mh, negm, alA, D); }
    RESC(alA); WAIT_BAR();
  }
  { const char* vb_ = VTk + (size_t)(NT - 1) * (KVBLK * 2);
    const Dma D{vb_, vb_, vb_, vb_ + vof0, vb_ + vof1, dK, dR, dV + SHM_V, false};
    attn_step(sB, sA, o, qn, L, SHM_K, SHM_R, 0, alA, l, mh, negm, alB, D); }
  RESC(alB); WAIT_BAR();
  {
#pragma unroll
    for (int kb = 2; kb < 4; ++kb)
#pragma unroll
      for (int e = 0; e < 4; ++e) { sB[0][kb][e] = __builtin_amdgcn_exp2f(sB[0][kb][e]); sB[1][kb][e] = __builtin_amdgcn_exp2f(sB[1][kb][e]); }
    float s0 = 0.f, s1 = 0.f;
#pragma unroll
    for (int kb = 0; kb < 4; ++kb) { s0 += (sB[0][kb][0] + sB[0][kb][1]) + (sB[0][kb][2] + sB[0][kb][3]); s1 += (sB[1][kb][0] + sB[1][kb][1]) + (sB[1][kb][2] + sB[1][kb][3]); }
    l[0] = l[0] * alB[0] + s0; l[1] = l[1] * alB[1] + s1;
    const bf16x8 P00 = packp(sB[0][0], sB[0][1]), P01 = packp(sB[0][2], sB[0][3]), P10 = packp(sB[1][0], sB[1][1]), P11 = packp(sB[1][2], sB[1][3]);
#define PVD(DB) do { bf16x8 v0 = vfrag<DB, 0>(L, SHM_V), v1 = vfrag<DB, 1>(L, SHM_V); o[0][DB] = MF16(v0, P00, o[0][DB]); o[1][DB] = MF16(v0, P10, o[1][DB]); o[0][DB] = MF16(v1, P01, o[0][DB]); o[1][DB] = MF16(v1, P11, o[1][DB]); } while (0)
    PVD(0); PVD(1); PVD(2); PVD(3); PVD(4); PVD(5); PVD(6); PVD(7);
#undef PVD
  }
  int lane_e = (int)__builtin_amdgcn_mbcnt_hi(~0u, __builtin_amdgcn_mbcnt_lo(~0u, 0u)); asm volatile("" : "+v"(lane_e)); const int l15e = lane_e & 15, kqe = lane_e >> 4;
  GAS bf16* Ow = (GAS bf16*)Ob + (long)(wid * 32 + l15e) * LDO + 4 * kqe; GAS float* stw = (GAS float*)st + (long)(wid * 32 + l15e) * 16;
  asm volatile("" : "+v"(Ow), "+v"(stw));
#pragma unroll
  for (int qb = 0; qb < 2; ++qb) { const float lt = xsum32(xsum16(l[qb])); const float rl = __builtin_amdgcn_rcpf(lt); float ss = 0.f;
#pragma unroll
    for (int db = 0; db < 8; ++db) { const f32x4v v = o[qb][db] * rl; u32x2v w; w.x = cvtpk(v[0], v[1]); w.y = cvtpk(v[2], v[3]);
      const float a0 = bflo(w.x), a1 = bfhi(w.x), a2 = bflo(w.y), a3 = bfhi(w.y); ss += (a0 * a0 + a1 * a1) + (a2 * a2 + a3 * a3);
      *(GAS u32x2v*)(Ow + (long)(qb * 16) * LDO + db * 16) = w; }
    ss = xsum32(xsum16(ss)); if (kqe == 0) stw[(long)(qb * 16) * 16] = ss; }
  asm volatile("s_waitcnt lgkmcnt(0)\n\ts_barrier" ::: "memory");
#undef DMA_KR
#undef DMA_V
#undef WAIT_BAR
#undef RESC
}
#undef SBAR
#undef PIN
#undef MF16
#undef EXP4
}

constexpr size_t MiB = 1u << 20;
constexpr size_t WS_CTL = 0, CTL_ZERO_BYTES = 1 * MiB;
constexpr size_t WS_RSTDX = 1 * MiB, WS_RSTDQ = WS_RSTDX + 98304, WS_RSTDKV = WS_RSTDQ + 98304, WS_R2 = WS_RSTDKV + 98304, WS_RATIO = WS_R2 + 98304, WS_RSTDX1 = WS_RATIO + 98304;
constexpr size_t WS_STA = 2 * MiB;
constexpr size_t WS_STB = 8 * MiB;
constexpr size_t WS_STQ = 10 * MiB;
constexpr size_t WS_STKV = 12 * MiB;
constexpr size_t WS_ROPE = 13 * MiB;
constexpr size_t WS_WIN = 16 * MiB;
constexpr size_t WS_WGLU = 46 * MiB;
constexpr size_t WS_WQ = 54 * MiB;
constexpr size_t WS_WKV = 60 * MiB;
constexpr size_t WS_WOUT = 64 * MiB;
constexpr size_t WS_WUG = 96 * MiB;
constexpr size_t WS_WDN = 268 * MiB;
constexpr size_t WS_W1T = 354 * MiB;
constexpr size_t WS_W2T = 370 * MiB;
constexpr size_t WS_A = 402 * MiB;
constexpr size_t WS_B = 594 * MiB;
constexpr size_t WS_QLAT = 786 * MiB, WS_KVLAT = 828 * MiB, WS_KROPE = 852 * MiB;
constexpr size_t WS_GACT = 856 * MiB;
constexpr size_t WS_HUP = 952 * MiB, WS_HGATE = 964 * MiB, WS_END = 970 * MiB;
static_assert(WS_HUP + (size_t)128 * 4 * DFF * 2 <= WS_HGATE && WS_HGATE + (size_t)128 * 2 * DFF * 2 <= WS_END, "halo");
constexpr size_t OUT_X = 0, OUT_KV = 192 * MiB;
constexpr int CW_BAR = 4096;

constexpr int NWAVES = 8;
constexpr int RING_BYTES = 131072, LDSCTL_OFF = 143360, MISC_OFF = LDSCTL_OFF + 320, LDS_BYTES = 147456;

typedef GAS unsigned gu32;
#define RLX_AGENT __ATOMIC_RELAXED, __HIP_MEMORY_SCOPE_AGENT
#define LDS_WAIT() asm volatile("s_waitcnt lgkmcnt(0)" ::: "memory")

#define XB_TMO      128
#define XB_XCNT(j)  (256  + 64 * (j))
#define XB_XSUB(j)  (1280 + 64 * (j))
#define XB_XGEN(j)  (2304 + 64 * (j))
#define XB_TOP      3328
#define XB_TOPGEN   3392
#define XCD_BAR_WORDS 3456
#define XB_SPIN_CAP (1u << 18)
__device__ __forceinline__ unsigned xb_ld(unsigned* p)              { return __hip_atomic_load(p, __ATOMIC_RELAXED, __HIP_MEMORY_SCOPE_AGENT); }
__device__ __forceinline__ unsigned xb_add(unsigned* p, unsigned v) { return __hip_atomic_fetch_add(p, v, __ATOMIC_RELAXED, __HIP_MEMORY_SCOPE_AGENT); }
__device__ __forceinline__ unsigned xb_xcc_id() { return (unsigned)__builtin_amdgcn_s_getreg((3 << 11) | 20) & 0xFu; }
#define XB_SPIN(cond, bar) do { unsigned _sp = 0; while (cond) { __builtin_amdgcn_s_sleep(1); \
    if ((++_sp & 255u) == 0u) { if (xb_ld(&(bar)[XB_TMO])) break; if (_sp > XB_SPIN_CAP) { atomicAdd(&(bar)[XB_TMO], 1u); break; } } } } while (0)
struct XcdBarrier { unsigned* bar; unsigned x; volatile LAS unsigned* st; };
__device__ __forceinline__ XcdBarrier xcd_barrier_post(unsigned* bar, volatile LAS unsigned* st) {
    XcdBarrier b; b.bar = bar; b.x = xb_xcc_id(); b.st = st;
    if (threadIdx.x == 0) (void)xb_add(&bar[XB_XCNT(b.x)], 1u);
    return b;
}
__device__ __forceinline__ void xcd_barrier_complete(unsigned* bar, unsigned x, unsigned& nloc, unsigned& nx) {
    const unsigned G = gridDim.x * gridDim.y * gridDim.z;
    unsigned sum, cnt, mine, sp = 0u;
    for (;;) {
        sum = 0u; cnt = 0u; mine = 0u;
#pragma unroll
        for (unsigned j = 0; j < 16; ++j) { const unsigned c = xb_ld(&bar[XB_XCNT(j)]); sum += c; cnt += (c > 0u) ? 1u : 0u; mine = (j == x) ? c : mine; }
        if (sum == G) break;
        __builtin_amdgcn_s_sleep(1);
        if ((++sp & 255u) == 0u) { if (xb_ld(&bar[XB_TMO])) break; if (sp > XB_SPIN_CAP) { atomicAdd(&bar[XB_TMO], 1u); break; } }
    }
    nloc = mine > 0u ? mine : 1u; nx = cnt > 0u ? cnt : 1u;
}
__device__ __forceinline__ void xcd_barrier(const XcdBarrier& b) {
    asm volatile("s_waitcnt vmcnt(0)" ::: "memory");
    __syncthreads();
    if (threadIdx.x == 0) {
        unsigned* bar = b.bar;
        __builtin_amdgcn_s_waitcnt(0);
        unsigned nloc = b.st[0], nx = b.st[1];
        if (nloc == 0u) { xcd_barrier_complete(bar, b.x, nloc, nx); b.st[0] = nloc; b.st[1] = nx; }
        const unsigned old = xb_add(&bar[XB_XSUB(b.x)], 1u);
        const unsigned gen = old / nloc;
        if (old + 1u == (gen + 1u) * nloc) {
            __builtin_amdgcn_fence(__ATOMIC_RELEASE, "agent");
            asm volatile("s_waitcnt vmcnt(0)" ::: "memory");
            const unsigned og = xb_add(&bar[XB_TOP], 1u);
            const unsigned tg = og / nx;
            if (og + 1u == (tg + 1u) * nx) xb_add(&bar[XB_TOPGEN], 1u);
            else XB_SPIN(xb_ld(&bar[XB_TOPGEN]) == tg, bar);
            __builtin_amdgcn_fence(__ATOMIC_ACQUIRE, "agent");
            xb_add(&bar[XB_XGEN(b.x)], 1u);
            asm volatile("s_waitcnt vmcnt(0)" ::: "memory");
        } else {
            XB_SPIN(xb_ld(&bar[XB_XGEN(b.x)]) == gen, bar);
            __builtin_amdgcn_fence(__ATOMIC_ACQUIRE, "agent");
            asm volatile("s_waitcnt vmcnt(0)" ::: "memory");
        }
    }
    __syncthreads();
}

__device__ __forceinline__ float wave_sum(float v) {
#pragma unroll
    for (int o = 1; o < 64; o <<= 1) v += __shfl_xor(v, o);
    return v;
}
template <class RowMap>
__device__ __forceinline__ void transpose_item(const float* W, int K, int N, bf16* WT, const float* g1, const float* g2, int ksplit, RowMap rm, LAS float* scr, int item, int lane) {
    const int nblk = N / 64; int kb, nb;
    if ((nblk & 3) == 0) { const int w = item & 7, rest = item >> 3, q = nblk >> 2; nb = (rest % q) * 4 + (w & 3); kb = (rest / q) * 2 + (w >> 2); }
    else { kb = item / nblk; nb = item % nblk; }
    const int k0 = 64 * kb, n0 = 64 * nb;
    f32x2 wv[32];
    const GAS f32x2* wp = (const GAS f32x2*)((const GAS float*)W + (size_t)(k0 + (lane >> 5)) * N + n0) + (lane & 31);
#pragma unroll
    for (int i = 0; i < 32; ++i) wv[i] = *(const GAS f32x2*)((const GAS float*)wp + (size_t)(2 * i) * N);
    float gn[32];
#pragma unroll
    for (int i = 0; i < 32; ++i) { const int k = k0 + 2 * i + (lane >> 5); gn[i] = g1 ? (k < ksplit ? g1[k] : g2[k - ksplit]) : 1.0f; }
    const int c = lane & 7;
#pragma unroll
    for (int sub = 0; sub < 2; ++sub) {
#pragma unroll
        for (int i = 0; i < 32; ++i) { const int kk = 2 * i + (lane >> 5); scr[kk * 33 + (lane & 31)] = (sub ? wv[i].y : wv[i].x) * gn[i]; }
        LDS_WAIT(); asm volatile("" ::: "memory");
#pragma unroll
        for (int j = 0; j < 4; ++j) { const int nl = (lane >> 3) + 8 * j; const LAS float* s = scr + (8 * c) * 33 + nl;
            v4u o; o.x = pg8::cvt_pk_bf16(s[0 * 33], s[1 * 33]); o.y = pg8::cvt_pk_bf16(s[2 * 33], s[3 * 33]); o.z = pg8::cvt_pk_bf16(s[4 * 33], s[5 * 33]); o.w = pg8::cvt_pk_bf16(s[6 * 33], s[7 * 33]);
            *(GAS v4u*)(WT + (size_t)rm(n0 + 2 * nl + sub) * K + k0 + 8 * c) = o; }
        LDS_WAIT(); asm volatile("" ::: "memory");
    }
}
__device__ __forceinline__ void tr_coords(int N, int item, int& k0, int& n0) { const int nblk = N / 64; int kb, nb;
    if ((nblk & 3) == 0) { const int w = item & 7, rest = item >> 3, q = nblk >> 2; nb = (rest % q) * 4 + (w & 3); kb = (rest / q) * 2 + (w >> 2); } else { kb = item / nblk; nb = item % nblk; }
    k0 = 64 * kb; n0 = 64 * nb; }
__device__ __forceinline__ void tr_load(const float* W, int N, const float* g1, const float* g2, int ksplit, int item, int lane, f32x4 (&wv)[16], f32x4 (&gq)[4]) {
    int k0, n0; tr_coords(N, item, k0, n0);
    const int kb = k0 + 16 * (lane >> 4);
    const GAS float* wp = (const GAS float*)W + (size_t)kb * N + n0 + 4 * (lane & 15);
#pragma unroll
    for (int i = 0; i < 16; ++i) wv[i] = *(const GAS f32x4*)(wp + (size_t)i * N);
    if (g1) { const GAS float* gp = (const GAS float*)(kb < ksplit ? g1 + kb : g2 + (kb - ksplit));
#pragma unroll
        for (int j = 0; j < 4; ++j) gq[j] = *(const GAS f32x4*)(gp + 4 * j); }
    else {
#pragma unroll
        for (int j = 0; j < 4; ++j) gq[j] = (f32x4){1.f, 1.f, 1.f, 1.f}; }
}
constexpr int TRS = 66;
template <class RowMap>
__device__ __forceinline__ void tr_emit(int K, int N, bf16* WT, RowMap rm, LAS float* scr, int item, int lane, const f32x4 (&wv)[16], const f32x4 (&gq)[4]) {
    int k0, n0; tr_coords(N, item, k0, n0);
    LAS float* wr_ = scr + (16 * (lane >> 4)) * TRS + 4 * (lane & 15);
#pragma unroll
    for (int i = 0; i < 16; ++i) { const float gg = gq[i >> 2][i & 3]; const f32x4 v = wv[i] * gg;
        *(LAS f32x2*)(wr_ + i * TRS) = (f32x2){v[0], v[1]}; *(LAS f32x2*)(wr_ + i * TRS + 2) = (f32x2){v[2], v[3]}; }
    LDS_WAIT(); asm volatile("" ::: "memory");
    const int c = lane & 7;
#pragma unroll
    for (int j = 0; j < 8; ++j) { const int nl = (lane >> 3) + 8 * j; const LAS float* s = scr + (8 * c) * TRS + nl;
        v4u o; o.x = pg8::cvt_pk_bf16(s[0 * TRS], s[1 * TRS]); o.y = pg8::cvt_pk_bf16(s[2 * TRS], s[3 * TRS]); o.z = pg8::cvt_pk_bf16(s[4 * TRS], s[5 * TRS]); o.w = pg8::cvt_pk_bf16(s[6 * TRS], s[7 * TRS]);
        *(GAS v4u*)(WT + (size_t)rm(n0 + nl) * K + k0 + 8 * c) = o; }
    LDS_WAIT(); asm volatile("" ::: "memory");
}
template <class RowMap>
__device__ __forceinline__ void transpose_range(const float* W, int K, int N, bf16* WT, const float* g1, const float* g2, int ksplit, RowMap rm, LAS float* scr, int first, int last, int stride, int lane) {
    if (first >= last) return;
    f32x4 wa[16], wb[16], ga[4], gb[4];
    int it = first; tr_load(W, N, g1, g2, ksplit, it, lane, wa, ga);
#pragma unroll 1
    for (;;) {
        const int n1 = it + stride; const bool h1 = n1 < last;
        if (h1) tr_load(W, N, g1, g2, ksplit, n1, lane, wb, gb);
        tr_emit(K, N, WT, rm, scr, it, lane, wa, ga);
        if (!h1) break;
        const int n2 = n1 + stride; const bool h2 = n2 < last;
        if (h2) tr_load(W, N, g1, g2, ksplit, n2, lane, wa, ga);
        tr_emit(K, N, WT, rm, scr, n1, lane, wb, gb);
        if (!h2) break;
        it = n2;
    }
}
struct RmId  { __device__ __forceinline__ int operator()(int n) const { return n; } };
struct RmWin { __device__ __forceinline__ int operator()(int n) const { if (n < 2944) return n; if (n < 3456) return n + 128; const int i = n - 3456; return 3584 + (i < 32 ? 2 * i : 2 * (i - 32) + 1); } };
struct RmQ   { __device__ __forceinline__ int operator()(int n) const { const int r = n % 192, hb = n - r; if (r < 128) return n; const int i = r - 128; return hb + 128 + (i < 32 ? 2 * i : 2 * (i - 32) + 1); } };
struct RmKV  { __device__ __forceinline__ int operator()(int n) const { const int h = n >> 8, c = n & 255; return c < 128 ? h * 128 + c : 2048 + h * 128 + (c - 128); } };
struct RmUp  { __device__ __forceinline__ int operator()(int n) const { return (n >> 7) * 256 + (n & 127); } };
struct RmGate{ __device__ __forceinline__ int operator()(int n) const { return (n >> 7) * 256 + 128 + (n & 127); } };

__device__ __forceinline__ void sincos_d(double a, double& s, double& c) {
    const double kd = __builtin_rint(a * 0.63661977236758134308); const long k = (long)kd;
    double r = __builtin_fma(-kd, 1.57079632679489655800e+00, a); r = __builtin_fma(-kd, 6.12323399573676603587e-17, r);
    const double r2 = r * r;
    double sp = 1.0 / 6227020800.0; sp = sp * r2 - 1.0 / 39916800.0; sp = sp * r2 + 1.0 / 362880.0; sp = sp * r2 - 1.0 / 5040.0; sp = sp * r2 + 1.0 / 120.0; sp = sp * r2 - 1.0 / 6.0; sp = sp * r2 * r + r;
    double cp = 1.0 / 479001600.0; cp = cp * r2 - 1.0 / 3628800.0; cp = cp * r2 + 1.0 / 40320.0; cp = cp * r2 - 1.0 / 720.0; cp = cp * r2 + 1.0 / 24.0; cp = cp * r2 - 0.5; cp = cp * r2 + 1.0;
    const int q = (int)(k & 3);
    s = (q == 0) ? sp : (q == 1) ? cp : (q == 2) ? -sp : -cp;
    c = (q == 0) ? cp : (q == 1) ? -sp : (q == 2) ? -cp : sp;
}

__device__ __forceinline__ void ssm_weights_group(int g, const float* a_re, const float* a_im, const float* b_re, const float* b_im, const float* c_re, const float* c_im,
                                                  const float* log_dt, const float* dskip, bf16* W1t, bf16* W2t, LAS float* L, int tid) {
    LAS float* PW = L;
    LAS float* BB = PW + 2 * 17 * 64 * 2;
    LAS float* CC = BB + 2 * 64 * 16 * 2;
    LAS float* KT = CC + 2 * 16 * 64 * 2;
    for (int i = tid; i < 2 * 17 * 64; i += 512) { const int d = i / (17 * 64), e = (i / 64) % 17, p = i & 63;
        const double dt = exp((double)log_dt[d * 128 + g]); const double are = a_re[(d * 128 + g) * 64 + p], aim = a_im[(d * 128 + g) * 64 + p];
        const double mag = exp((double)e * dt * are); double s, c; sincos_d((double)e * dt * aim, s, c);
        PW[i * 2] = (float)(mag * c); PW[i * 2 + 1] = (float)(mag * s); }
    for (int i = tid; i < 2 * 64 * 16; i += 512) { const int d = i / 1024, p = (i >> 4) & 63, h = i & 15;
        const double dt = exp((double)log_dt[d * 128 + g]); const double are = a_re[(d * 128 + g) * 64 + p], aim = a_im[(d * 128 + g) * 64 + p];
        const double x = dt * are, y = dt * aim; double sy, cy, sh, ch; sincos_d(y, sy, cy); sincos_d(0.5 * y, sh, ch);
        const double em1 = expm1(x); const double re1 = em1 * cy - 2.0 * sh * sh, im1 = (em1 + 1.0) * sy;
        const double den = are * are + aim * aim; const double qre = (re1 * are + im1 * aim) / den, qim = (im1 * are - re1 * aim) / den;
        const size_t bi = ((size_t)((d * 128 + g) * 64 + p)) * 16 + h; const double br = b_re[bi], bim = b_im[bi];
        BB[i * 2] = (float)(qre * br - qim * bim); BB[i * 2 + 1] = (float)(qre * bim + qim * br); }
    for (int i = tid; i < 2 * 16 * 64; i += 512) { const int d = i / 1024, h = (i >> 6) & 15, p = i & 63; const size_t ci = ((size_t)((d * 128 + g) * 16 + h)) * 64 + p;
        CC[i * 2] = c_re[ci]; CC[i * 2 + 1] = c_im[ci]; }
    __syncthreads();
    { const int d = tid >> 8, e = (tid >> 4) & 15, h = tid & 15; float acc[16];
#pragma unroll
        for (int q = 0; q < 16; ++q) acc[q] = 0.f;
        for (int p = 0; p < 64; ++p) { const float cr = CC[((d * 16 + h) * 64 + p) * 2], ci = CC[((d * 16 + h) * 64 + p) * 2 + 1];
            const float pr = PW[((d * 17 + e) * 64 + p) * 2], pi = PW[((d * 17 + e) * 64 + p) * 2 + 1];
            const float tr = cr * pr - ci * pi, ti = cr * pi + ci * pr; const LAS f32x4* bp = (const LAS f32x4*)(BB + ((d * 64 + p) * 16) * 2);
#pragma unroll
            for (int q = 0; q < 8; ++q) { const f32x4 b = bp[q]; acc[2 * q] += tr * b[0] - ti * b[1]; acc[2 * q + 1] += tr * b[2] - ti * b[3]; } }
#pragma unroll
        for (int q = 0; q < 16; ++q) KT[((d * 16 + e) * 16 + h) * 16 + q] = acc[q]; }
    __syncthreads();
    for (int i = tid; i < 256 * 32; i += 512) { const int n = i >> 5, k0 = (i & 31) * 8; const int d = n >> 7, im = (n >> 6) & 1, p = n & 63; const int s = k0 >> 4, h0 = k0 & 15, e = d ? s : 15 - s;
        const float pr = PW[((d * 17 + e) * 64 + p) * 2], pi = PW[((d * 17 + e) * 64 + p) * 2 + 1]; float v[8];
#pragma unroll
        for (int j = 0; j < 8; ++j) { const float br = BB[((d * 64 + p) * 16 + h0 + j) * 2], bi = BB[((d * 64 + p) * 16 + h0 + j) * 2 + 1]; v[j] = im ? (pr * bi + pi * br) : (pr * br - pi * bi); }
        v4u o; o.x = pk2(v[0], v[1]); o.y = pk2(v[2], v[3]); o.z = pk2(v[4], v[5]); o.w = pk2(v[6], v[7]);
        *(GAS v4u*)(W1t + ((size_t)(g * 256 + n)) * 256 + k0) = o; }
    for (int i = tid; i < 256 * 64; i += 512) { const int n = i >> 6, k0 = (i & 63) * 8; const int j = n >> 4, h = n & 15; float v[8];
        if (k0 < 256) { const int d = k0 >> 7, im = (k0 >> 6) & 1, p0 = k0 & 63, e = d ? 16 - j : j + 1;
#pragma unroll
            for (int q = 0; q < 8; ++q) { const int p = p0 + q; const float cr = CC[((d * 16 + h) * 64 + p) * 2], ci = CC[((d * 16 + h) * 64 + p) * 2 + 1];
                const float pr = PW[((d * 17 + e) * 64 + p) * 2], pi = PW[((d * 17 + e) * 64 + p) * 2 + 1]; v[q] = im ? -(cr * pi + ci * pr) : (cr * pr - ci * pi); }
        } else { const int s = (k0 - 256) >> 4, h0 = (k0 - 256) & 15;
#pragma unroll
            for (int q = 0; q < 8; ++q) { const int hh = h0 + q; float val = 0.f;
                if (s <= j) val += KT[((0 * 16 + (j - s)) * 16 + h) * 16 + hh];
                if (s >= j) val += KT[((1 * 16 + (s - j)) * 16 + h) * 16 + hh];
                if (s == j && h == hh) val += dskip[g * 16 + h];
                v[q] = val; } }
        v4u o; o.x = pk2(v[0], v[1]); o.y = pk2(v[2], v[3]); o.z = pk2(v[4], v[5]); o.w = pk2(v[6], v[7]);
        *(GAS v4u*)(W2t + ((size_t)(g * 256 + n)) * 512 + k0) = o; }
    __syncthreads();
}
#ifndef PROBE_ATTN
#define PROBE_ATTN 1
#endif
#ifndef PROBE_P0
#define PROBE_P0 1
#endif
#ifndef PROBE_P1
#define PROBE_P1 1
#endif
#ifndef PROBE_P7
#define PROBE_P7 1
#endif
#ifndef PROBE_FA
#define PROBE_FA 1
#endif

struct Args { const float* in[27]; float* out; unsigned char* ws; int ph_lo, ph_hi; };

__global__ void __launch_bounds__(NWAVES * 64, 2) enc_fwd(Args args) {
    extern __shared__ __attribute__((aligned(16))) unsigned char lds[];
    LAS unsigned char* ldsb = (LAS unsigned char*)lds;
    volatile LAS unsigned* MISC = (volatile LAS unsigned*)(ldsb + MISC_OFF);
    const int wave0 = __builtin_amdgcn_readfirstlane(threadIdx.x >> 6);
    const int G = gridDim.x, bx = blockIdx.x; const int vcu = (G % 8 == 0) ? (bx % 8) * (G / 8) + bx / 8 : bx;
    const int NGW = G * NWAVES, NGT = G * NWAVES * 64;
    gu32* ctl = (gu32*)(args.ws + WS_CTL);
#define PHB unsigned char* wsl = args.ws; unsigned char* outl = (unsigned char*)args.out; asm volatile("" : "+s"(wsl), "+s"(outl)); \
    int tid = wave0 * 64 + (int)__builtin_amdgcn_mbcnt_hi(~0u, __builtin_amdgcn_mbcnt_lo(~0u, 0u)); asm volatile("" : "+v"(tid)); const int lane = tid & 63, wave = wave0; \
    const int gw = vcu * NWAVES + wave, gt = vcu * (NWAVES * 64) + tid; (void)lane; (void)gw; (void)gt; (void)wsl; (void)outl
#define x_p (args.in[0])
#define x_s (args.in[1])
#define rstd_x ((float*)(wsl + WS_RSTDX))
#define rstd_q ((float*)(wsl + WS_RSTDQ))
#define rstd_kv ((float*)(wsl + WS_RSTDKV))
#define r2v ((float*)(wsl + WS_R2))
#define ratio ((float*)(wsl + WS_RATIO))
#define rstd_x1 ((float*)(wsl + WS_RSTDX1))
#define stA ((float*)(wsl + WS_STA))
#define stB ((float*)(wsl + WS_STB))
#define stQ ((float*)(wsl + WS_STQ))
#define stKV ((float*)(wsl + WS_STKV))
#define ropetab ((float*)(wsl + WS_ROPE))
#define Wi ((bf16*)(wsl + WS_WIN))
#define Wglu ((bf16*)(wsl + WS_WGLU))
#define Wq ((bf16*)(wsl + WS_WQ))
#define Wkv ((bf16*)(wsl + WS_WKV))
#define Wout ((bf16*)(wsl + WS_WOUT))
#define Wug ((bf16*)(wsl + WS_WUG))
#define Wdn ((bf16*)(wsl + WS_WDN))
#define W1t ((bf16*)(wsl + WS_W1T))
#define W2t ((bf16*)(wsl + WS_W2T))
#define bufA ((bf16*)(wsl + WS_A))
#define bufB ((bf16*)(wsl + WS_B))
#define qlat ((bf16*)(wsl + WS_QLAT))
#define kvlat ((bf16*)(wsl + WS_KVLAT))
#define krope ((bf16*)(wsl + WS_KROPE))
#define gact ((bf16*)(wsl + WS_GACT))
#define hup ((bf16*)(wsl + WS_HUP))
#define hgate ((bf16*)(wsl + WS_HGATE))
#define X ((bf16*)(outl + OUT_X))
#define kvb ((bf16*)(outl + OUT_KV))
#define vtb ((bf16*)(outl + OUT_KV) + (size_t)T * 2048)
#define xoutf ((float*)outl)
    for (int u = threadIdx.x; u < (LDS_BYTES - LDSCTL_OFF) / 4; u += NWAVES * 64) ((LAS unsigned*)(ldsb + LDSCTL_OFF))[u] = 0u;
    __syncthreads();
    XcdBarrier bar = xcd_barrier_post((unsigned*)(ctl + CW_BAR), MISC + 8);
    const int lo = args.ph_lo, hi = args.ph_hi;
#ifndef PHMASK
#define PHMASK 0xfffffffu
#endif
#define IN(k) (((PHMASK >> ((k) < 9 ? (k) : ((k) >= 18 ? 12 : 9 + ((k) - 9) % 3))) & 1u) && lo <= (k) && (k) < hi)
#define SEAM(k) do { if (IN(k) && IN((k) + 1)) xcd_barrier(bar); } while (0)

#pragma unroll 1
    for (int rep = 0; rep < PROBE_P0; ++rep)
    if (IN(0)) {
        PHB;
        if (rep) __syncthreads();
        if (vcu < 128) ssm_weights_group(vcu, args.in[4], args.in[5], args.in[6], args.in[7], args.in[8], args.in[9], args.in[10], args.in[11], W1t, W2t, (LAS float*)ldsb, tid);
        LAS float* scr = (LAS float*)(ldsb + wave * (64 * TRS * 4));
        constexpr int I_IN = 64 * 55, I_GLU = 32 * 32, I_Q = 14 * 48, I_KV = 8 * 64, I_OUT = 64 * 64, I_UP = 64 * 172, I_DN = 172 * 64;
#define TR_M(off, W_, K_, N_, WT_, G1, G2, KS, RM, CNT) transpose_range(W_, K_, N_, WT_, G1, G2, KS, RM, scr, ((gw - (off)) % NGW + NGW) % NGW, CNT, NGW, lane)
        TR_M(0, args.in[2], 4096, 3520, Wi, args.in[3], args.in[3], 4096, RmWin(), I_IN);
        TR_M(I_IN, args.in[12], 2048, 2048, Wglu, nullptr, nullptr, 0, RmId(), I_GLU);
        TR_M(I_IN + I_GLU, args.in[14], 896, 3072, Wq, args.in[13], args.in[13], 896, RmQ(), I_Q);
        TR_M(I_IN + I_GLU + I_Q, args.in[16], 512, 4096, Wkv, args.in[15], args.in[15], 512, RmKV(), I_KV);
        TR_M(I_IN + I_GLU + I_Q + I_KV, args.in[19], 4096, 4096, Wout, args.in[17], args.in[18], 2048, RmId(), I_OUT);
        TR_M(I_IN + I_GLU + I_Q + I_KV + I_OUT, args.in[21], 4096, 11008, Wug, args.in[20], args.in[20], 4096, RmUp(), I_UP);
        TR_M(I_IN + I_GLU + I_Q + I_KV + I_OUT + I_UP, args.in[22], 4096, 11008, Wug, args.in[20], args.in[20], 4096, RmGate(), I_UP);
        TR_M(I_IN + I_GLU + I_Q + I_KV + I_OUT + 2 * I_UP, args.in[25], 11008, 4096, Wdn, nullptr, nullptr, 0, RmId(), I_DN);
#undef TR_M
        for (int i = gt; i < 320 * 512; i += NGT) { const int rr = i >> 9, c8 = (i & 511) * 8; const int row = rr < 128 ? 2944 + rr : 3648 + (rr - 128);
            *(GAS v4u*)(Wi + (size_t)row * 4096 + c8) = (v4u){0u, 0u, 0u, 0u}; }
        for (int m = gw; m < T; m += 2 * NGW) {
            const int m1 = m + NGW; const bool h1 = m1 < T;
            const float* xr0 = m < 16384 ? x_p + (size_t)m * DM : x_s + (size_t)(m - 16384) * DM; const float* xr1 = !h1 ? xr0 : (m1 < 16384 ? x_p + (size_t)m1 * DM : x_s + (size_t)(m1 - 16384) * DM);
            f32x4 v[16], w[16]; float s = 0.f, s1 = 0.f;
#pragma unroll
            for (int j = 0; j < 16; ++j) v[j] = *((const GAS f32x4*)xr0 + lane + 64 * j);
#pragma unroll
            for (int j = 0; j < 16; ++j) w[j] = *((const GAS f32x4*)xr1 + lane + 64 * j);
#pragma unroll
            for (int j = 0; j < 16; ++j) s += (v[j].x * v[j].x + v[j].y * v[j].y) + (v[j].z * v[j].z + v[j].w * v[j].w);
            s = wave_sum(s); if (lane == 0) rstd_x[m] = 1.0f / sqrtf(s * (1.0f / DM) + EPS);
            { GAS v2u* o8 = (GAS v2u*)(bufA + (size_t)m * DM) + lane;
#pragma unroll
              for (int j = 0; j < 16; ++j) o8[64 * j] = (v2u){pg8::cvt_pk_bf16(v[j].x, v[j].y), pg8::cvt_pk_bf16(v[j].z, v[j].w)}; }
            if (h1) {
#pragma unroll
                for (int j = 0; j < 16; ++j) s1 += (w[j].x * w[j].x + w[j].y * w[j].y) + (w[j].z * w[j].z + w[j].w * w[j].w);
                s1 = wave_sum(s1); if (lane == 0) rstd_x[m1] = 1.0f / sqrtf(s1 * (1.0f / DM) + EPS);
                GAS v2u* o8 = (GAS v2u*)(bufA + (size_t)m1 * DM) + lane;
#pragma unroll
                for (int j = 0; j < 16; ++j) o8[64 * j] = (v2u){pg8::cvt_pk_bf16(w[j].x, w[j].y), pg8::cvt_pk_bf16(w[j].z, w[j].w)}; } }
        for (int i = gt; i < 8192 * 32; i += NGT) { const int pos = i >> 5, k = i & 31; const double inv = exp(-(double)k * (9.210340371976184 / 32.0));
            double s, c; sincos_d((double)pos * inv, s, c); *(GAS f32x2*)(ropetab + (size_t)i * 2) = (f32x2){(float)c, (float)s}; }
    }
    SEAM(0);

#pragma unroll 1
    for (int rep = 0; rep < PROBE_P1; ++rep)
    if (IN(1)) {
        PHB;
        pg8::Gemm g{bufA, Wi, DM, DM, DM}; pg8::StaticOrder S; S.init(T, 3840, G, bx);
        pg8::EpiWin E{rstd_x, X, qlat, kvlat, krope, stQ, stKV, ropetab};
        pg8::gemm_phase(ldsb, g, S, E, tid);
    }
    SEAM(1);

    if (IN(2)) {
        PHB;
        pg8::Gemm g{X + 256, W1t, 512, 256, 256}; pg8::GroupOrder S{768, 6, G, bx};
        pg8::EpiSsm1 E{X};
        pg8::gemm_phase(ldsb, g, S, E, tid);
        for (int r = gt; r < T; r += NGT) { float s = 0.f;
#pragma unroll
            for (int j = 0; j < 4; ++j) { const f32x4 v = *(const GAS f32x4*)(stQ + (size_t)r * 16 + 4 * j); s += (v.x + v.y) + (v.z + v.w); }
            rstd_q[r] = 1.0f / sqrtf(s * (1.0f / QLAT) + EPS); float s2 = 0.f;
#pragma unroll
            for (int j = 0; j < 2; ++j) { const f32x4 v = *(const GAS f32x4*)(stKV + (size_t)r * 8 + 4 * j); s2 += (v.x + v.y) + (v.z + v.w); }
            rstd_kv[r] = 1.0f / sqrtf(s2 * (1.0f / KVLAT) + EPS); }
    }
    SEAM(2);

    if (IN(3)) {
        PHB;
        const bool scan_cu = (G == 256) ? ((vcu & 1) == 0) : true;
        if (G == 256 ? scan_cu : (wave < 4)) { const int task = (G == 256) ? (vcu >> 1) * 8 + wave : vcu * 4 + wave;
            if (task < 1024) { const int seq = task >> 8, g = (task >> 1) & 127, dir = task & 1, p = lane;
                const int c0 = seq < 2 ? seq * 512 : 1024 + (seq - 2) * 256, nc = seq < 2 ? 512 : 256;
                const double dt = exp((double)args.in[10][dir * 128 + g]); const double are = args.in[4][(dir * 128 + g) * 64 + p], aim = args.in[5][(dir * 128 + g) * 64 + p];
                const double mag = exp(16.0 * dt * are); double sn, cs; sincos_d(16.0 * dt * aim, sn, cs);
                const float ar = (float)(mag * cs), ai = (float)(mag * sn);
                GAS bf16* Xg = (GAS bf16*)X + (size_t)g * NCHUNK * 512 + dir * 128 + p;
                float zr = 0.f, zi = 0.f;
                for (int cb = 0; cb < nc; cb += 16) {
                    unsigned short sre[16], sim[16];
#pragma unroll
                    for (int i = 0; i < 16; ++i) { const int c = dir ? (c0 + nc - 1 - (cb + i)) : (c0 + cb + i); sre[i] = Xg[(size_t)c * 512]; sim[i] = Xg[(size_t)c * 512 + 64]; }
#pragma unroll
                    for (int i = 0; i < 16; ++i) { const int c = dir ? (c0 + nc - 1 - (cb + i)) : (c0 + cb + i);
                        Xg[(size_t)c * 512] = (bf16)f2bf(zr); Xg[(size_t)c * 512 + 64] = (bf16)f2bf(zi);
                        const float sr = bf2f(sre[i]), si = bf2f(sim[i]); const float nr = ar * zr - ai * zi + sr, ni = ar * zi + ai * zr + si; zr = nr; zi = ni; }
                }
            }
        }
        __syncthreads();
        if (G == 256) { pg8::Gemm g{qlat, Wq, QLAT, QLAT, QLAT}; pg8::RangeOrder S{scan_cu ? (vcu >> 1) * 3 : 384 + (vcu >> 1) * 6, scan_cu ? 3 : 6, 12}; pg8::EpiQ E{rstd_q, bufA, ropetab}; pg8::gemm_phase(ldsb, g, S, E, tid); }
        else { pg8::Gemm g{qlat, Wq, QLAT, QLAT, QLAT}; pg8::StaticOrder S; S.init(T, QW, G, bx); pg8::EpiQ E{rstd_q, bufA, ropetab}; pg8::gemm_phase(ldsb, g, S, E, tid); }
        { pg8::Gemm g{kvlat, Wkv, KVLAT, KVLAT, KVLAT}; pg8::StaticOrder S; S.init(T, 2048, G, bx); pg8::EpiKV E{rstd_kv, kvb}; pg8::gemm_phase(ldsb, g, S, E, tid); }
        { pg8::Gemm g{Wkv + (size_t)2048 * KVLAT, kvlat, KVLAT, KVLAT, KVLAT}; pg8::StaticOrder S; S.init(2048, T, G, bx); pg8::EpiVT E{rstd_kv, vtb}; pg8::gemm_phase(ldsb, g, S, E, tid); }
    }
    SEAM(3);

    if (IN(4)) {
        PHB;
        pg8::Gemm g{X, W2t, 512, 512, 512}; pg8::GroupOrder S{768, 6, G, bx};
        pg8::EpiSsm2 E{gact};
        pg8::gemm_phase(ldsb, g, S, E, tid);
    }
    SEAM(4);

    if (IN(5)) {
        PHB;
#ifndef NO_GLU
        { pg8::Gemm g{gact, Wglu, MIXW, MIXW, MIXW}; pg8::StaticOrder S; S.init(T, MIXW, G, bx); pg8::EpiGlu E{gact, bufB, stA}; pg8::gemm_phase(ldsb, g, S, E, tid); }
#endif
#ifndef NO_ATTN
        const int xcd = vcu >> 5, cc = vcu & 31; const int nun = (G == 256) ? 6 : (1536 - bx + G - 1) / G;
#pragma unroll 1
        for (int i = 0; i < nun; ++i) {
            int bh, qb, seq, rowbase;
            if (G == 256) { if (i < 4) { bh = xcd * 4 + i; qb = cc; seq = 8192; } else { bh = xcd * 4 + 2 * (i - 4) + (cc >> 4); qb = cc & 15; seq = 4096; } }
            else { const int uidx = bx + i * G; if (uidx < 1024) { bh = uidx >> 5; qb = uidx & 31; seq = 8192; } else { const int v = uidx - 1024; bh = v >> 4; qb = v & 15; seq = 4096; } }
            const int b = bh >> 4, h = bh & 15; rowbase = (seq == 8192) ? b * 8192 : 16384 + b * 4096;
            __syncthreads();
            attn::attn_unit(bufA + (size_t)(rowbase + qb * 256) * QW + h * 192, kvb + (size_t)rowbase * 2048 + h * 128, vtb + (size_t)(h * 128) * T,
                            krope + (size_t)rowbase * 64, bufB + (size_t)(rowbase + qb * 256) * DM + 2048 + h * 128, stB + (size_t)(rowbase + qb * 256) * 16 + h, seq, rowbase, (char*)lds, wave0);
        }
#endif
    }
    SEAM(5);

    if (IN(6)) {
        PHB;
        for (int r = gt; r < T; r += NGT) { float s = 0.f;
#pragma unroll
            for (int j = 0; j < 8; ++j) { const f32x4 v = *(const GAS f32x4*)(stA + (size_t)r * 32 + 4 * j); s += (v.x + v.y) + (v.z + v.w); }
            const float r1 = 1.0f / sqrtf(s * (1.0f / MIXW) + EPS); float s2 = 0.f;
#pragma unroll
            for (int j = 0; j < 4; ++j) { const f32x4 v = *(const GAS f32x4*)(stB + (size_t)r * 16 + 4 * j); s2 += (v.x + v.y) + (v.z + v.w); }
            const float r2 = 1.0f / sqrtf(s2 * (1.0f / MIXW) + EPS); r2v[r] = r2; ratio[r] = r1 / r2; }
    }
    SEAM(6);

#pragma unroll 1
    for (int rep = 0; rep < PROBE_P7; ++rep)
    if (IN(7)) {
        PHB;
        pg8::Gemm g{bufB, Wout, DM, DM, DM}; pg8::StaticOrder S; S.init(T, DM, G, bx);
        pg8::EpiWout E{x_p, x_s, r2v, ratio, bufA, stA};
        pg8::gemm_phase(ldsb, g, S, E, tid);
    }
    SEAM(7);

    if (IN(8)) {
        PHB;
        for (int r = gt; r < T; r += NGT) { float s = 0.f;
#pragma unroll
            for (int j = 0; j < 16; ++j) { const f32x4 v = *(const GAS f32x4*)(stA + (size_t)r * 64 + 4 * j); s += (v.x + v.y) + (v.z + v.w); }
            rstd_x1[r] = 1.0f / sqrtf(s * (1.0f / DM) + EPS); }
    }
    SEAM(8);

#ifdef PROBE_DOWN
    if (IN(9)) { PHB;
#pragma unroll 1
        for (int ch = 0; ch < 3; ++ch) { pg8::Gemm g{bufB, Wdn, DFF, DFF, DFF}; pg8::StaticOrder S; S.init(8192, DM, G, bx); pg8::EpiNull E0; pg8::gemm_phase(ldsb, g, S, E0, tid); }
    }
#endif
#ifdef PROBE_KLOOP
    if (IN(9)) {
        PHB;
#pragma unroll 1
        for (int ch = 0; ch < 3; ++ch) { pg8::Gemm g{bufA + (size_t)(ch * 8192) * DM, Wug, DM, DM, DM}; pg8::StaticOrder S; S.init(8192, 2 * DFF, G, bx); pg8::EpiNull E0; pg8::gemm_phase(ldsb, g, S, E0, tid); }
    }
#endif
#pragma unroll 1
    for (int ch2 = 0; ch2 < 3 * PROBE_FA; ++ch2) {
        const int ch = ch2 / PROBE_FA; const bool lastrep = (ch2 % PROBE_FA) == PROBE_FA - 1;
        const int rb = ch * 8192;
        if (IN(9 + 3 * ch)) {
        PHB;
            pg8::Gemm g{bufA + (size_t)rb * DM, Wug, DM, DM, DM}; pg8::StaticOrder S; S.init(8192, 2 * DFF, G, bx);
            pg8::EpiFfnA E{rstd_x1, rb, bufB, hup, hgate, args.in[23], args.in[24]};
            pg8::gemm_phase(ldsb, g, S, E, tid);
        }
        SEAM(9 + 3 * ch);
        if (lastrep && IN(10 + 3 * ch)) {
        PHB;
            const float* cw = args.in[23]; const float* cb = args.in[24];
            for (int i = gt; i < 128 * 2 * (DFF / 8); i += NGT) { const int f0 = (i % (DFF / 8)) * 8, sw = i / (DFF / 8), strip = sw >> 1, which = sw & 1;
                const int lrow = strip * 64 + (which ? 63 : 0), grow = rb + lrow, pos = pos_of(grow), len = len_of(grow);
                v4u up0, up1, up2;
                if (which == 0) { up1 = *(const GAS v4u*)(hup + ((size_t)strip * 4 + 0) * DFF + f0); up2 = *(const GAS v4u*)(hup + ((size_t)strip * 4 + 1) * DFF + f0);
                    up0 = (pos == 0) ? (v4u){0u, 0u, 0u, 0u} : *(const GAS v4u*)(hup + ((size_t)(strip - 1) * 4 + 3) * DFF + f0); }
                else { up0 = *(const GAS v4u*)(hup + ((size_t)strip * 4 + 2) * DFF + f0); up1 = *(const GAS v4u*)(hup + ((size_t)strip * 4 + 3) * DFF + f0);
                    up2 = (pos == len - 1) ? (v4u){0u, 0u, 0u, 0u} : *(const GAS v4u*)(hup + ((size_t)(strip + 1) * 4 + 0) * DFF + f0); }
                const v4u gt4 = *(const GAS v4u*)(hgate + ((size_t)strip * 2 + which) * DFF + f0);
                unsigned ow[4];
#pragma unroll
                for (int k = 0; k < 4; ++k) { const int f = f0 + 2 * k;
                    const float a0 = bflo(up0[k]), a1 = bflo(up1[k]), a2 = bflo(up2[k]), b0 = bfhi(up0[k]), b1 = bfhi(up1[k]), b2 = bfhi(up2[k]);
                    const float c0 = cw[f] * a0 + cw[DFF + f] * a1 + cw[2 * DFF + f] * a2 + cb[f], c1 = cw[f + 1] * b0 + cw[DFF + f + 1] * b1 + cw[2 * DFF + f + 1] * b2 + cb[f + 1];
                    ow[k] = pk2(c0 * sigmoidf_fast(c0) * bflo(gt4[k]), c1 * sigmoidf_fast(c1) * bfhi(gt4[k])); }
                *(GAS v4u*)(bufB + (size_t)lrow * DFF + f0) = (v4u){ow[0], ow[1], ow[2], ow[3]}; }
        }
        if (lastrep) SEAM(10 + 3 * ch);
        if (lastrep && IN(11 + 3 * ch)) {
        PHB;
            pg8::Gemm g{bufB, Wdn, DFF, DFF, DFF}; pg8::StaticOrder S; S.init(8192, DM, G, bx);
            pg8::EpiDown E{bufA, rb, stA};
            pg8::gemm_phase(ldsb, g, S, E, tid);
        }
        if (lastrep) SEAM(11 + 3 * ch);
    }

    if (IN(18)) {
        PHB;
        const float* gf = args.in[26];
        for (int m = gw; m < T; m += NGW) { const float s = wave_sum(stA[(size_t)m * 64 + lane]); const float rs = 1.0f / sqrtf(s * (1.0f / DM) + EPS);
            const GAS v4u* xr = (const GAS v4u*)(bufA + (size_t)m * DM) + lane; GAS f32x4* orow = (GAS f32x4*)(xoutf + (size_t)m * DM) + 2 * lane; const GAS f32x4* gr = (const GAS f32x4*)gf + 2 * lane;
#pragma unroll
            for (int j = 0; j < 8; ++j) { const v4u w = xr[64 * j]; const f32x4 g0 = gr[128 * j], g1 = gr[128 * j + 1];
                orow[128 * j] = (f32x4){bflo(w.x) * rs * g0[0], bfhi(w.x) * rs * g0[1], bflo(w.y) * rs * g0[2], bfhi(w.y) * rs * g0[3]};
                orow[128 * j + 1] = (f32x4){bflo(w.z) * rs * g1[0], bfhi(w.z) * rs * g1[1], bflo(w.w) * rs * g1[2], bfhi(w.w) * rs * g1[3]}; } }
    }
#undef IN
#undef SEAM
}

constexpr int N_PHASES = 19;
extern "C" void kernel_launch(void* const* d_in, const int* in_sizes, int n_in, void* d_out, int out_size, void* d_ws, size_t ws_size, hipStream_t stream) {
    static int grid = 0;
    if (grid == 0) {
        if (n_in != 27 || out_size != T * DM || ws_size < WS_END) { fprintf(stderr, "kernel_launch: unexpected shapes (n_in %d out %d ws %zu)\n", n_in, out_size, ws_size); grid = -1; return; }
        int dev = 0, cus = 0, per_cu = 0;
        if (hipGetDevice(&dev) != hipSuccess || hipDeviceGetAttribute(&cus, hipDeviceAttributeMultiprocessorCount, dev) != hipSuccess) { grid = -1; return; }
        if (hipFuncSetAttribute((const void*)enc_fwd, hipFuncAttributeMaxDynamicSharedMemorySize, LDS_BYTES) != hipSuccess) { fprintf(stderr, "kernel_launch: hipFuncSetAttribute failed\n"); grid = -1; return; }
        if (hipOccupancyMaxActiveBlocksPerMultiprocessor(&per_cu, (const void*)enc_fwd, NWAVES * 64, LDS_BYTES) != hipSuccess || per_cu < 1) { fprintf(stderr, "kernel_launch: occupancy query says %d\n", per_cu); }
        (void)hipGetLastError();
        grid = cus;
    }
    if (grid < 0) return;
    if (hipMemsetAsync((char*)d_ws + WS_CTL, 0, CTL_ZERO_BYTES, stream) != hipSuccess) return;
    Args a{};
    for (int i = 0; i < 27; ++i) a.in[i] = (const float*)d_in[i];
    a.out = (float*)d_out; a.ws = (unsigned char*)d_ws;
#ifndef MK_N_LAUNCHES
#define MK_N_LAUNCHES 1
#endif
    if (MK_N_LAUNCHES == 1) { a.ph_lo = 0; a.ph_hi = N_PHASES; hipLaunchKernelGGL(enc_fwd, dim3(grid), dim3(NWAVES * 64), LDS_BYTES, stream, a); }
    else { for (int p = 0; p < N_PHASES; ++p) { a.ph_lo = p; a.ph_hi = p + 1; hipLaunchKernelGGL(enc_fwd, dim3(grid), dim3(NWAVES * 64), LDS_BYTES, stream, a); } }
    const hipError_t le = hipPeekAtLastError();
    if (le != hipSuccess) fprintf(stderr, "kernel_launch: launch failed: %s\n", hipGetErrorName(le));
}
```

```cpp
#include <hip/hip_runtime.h>
#include <hip/hip_bf16.h>
#include <cstdio>
#include <cstdint>

namespace pg8 {
#define PG8_LAS __attribute__((address_space(3)))
typedef unsigned short bf16_t;
typedef short bf16x8 __attribute__((ext_vector_type(8)));
typedef float f32x4 __attribute__((ext_vector_type(4)));
typedef float f32x2 __attribute__((ext_vector_type(2)));
typedef unsigned u32x4 __attribute__((ext_vector_type(4)));
typedef unsigned u32x2 __attribute__((ext_vector_type(2)));
constexpr int BM = 256, BK = 64, HALF = 128, HTB = HALF * BK * 2  , STAGE_BYTES = 8 * HTB, NXCD = 8, WGM = 8;

__host__ __device__ __forceinline__ int lds_byte(int r, int c) { const int st = (r >> 4) * 2 + (c >> 5), rr = r & 15, cc = c & 31, ob = rr * 64 + cc * 2; return st * 1024 + (ob ^ (((ob >> 9) & 1) << 5)); }
__host__ __device__ __forceinline__ void stage_rc(int b, int& R, int& C) { const int st = b / 1024, sb = b % 1024, swz = sb ^ (((sb >> 9) & 1) << 5); R = (st >> 1) * 16 + swz / 64; C = (st & 1) * 32 + (swz % 64) / 2; }
__host__ __device__ __forceinline__ int perm32(int rho) { const int n = rho >> 4, i = rho & 15; return 8 * (i >> 2) + 4 * n + (i & 3); }

struct Unit { int pm, pn; };
struct Gemm { const bf16_t* A; const bf16_t* Bt; int lda, ldb, K; };

struct StaticOrder {
    int nM, nN, nwg, G, c;
    __host__ __device__ void init(int M, int N, int G_, int c_) { nM = M / BM; nN = N / BM; nwg = nM * nN; G = G_; c = c_; }
    __host__ __device__ bool next(int i, Unit& u) const {
        const long L = (long)i * G + c; if (L >= nwg) return false;
        int wgid = (int)L; { const int q = nwg / NXCD, r = nwg % NXCD, xcd = wgid % NXCD, off = wgid / NXCD; wgid = (xcd < r ? xcd * (q + 1) : r * (q + 1) + (xcd - r) * q) + off; }
        const int nig = WGM * nN, gid = wgid / nig, fm = gid * WGM, gsz = (nM - fm) < WGM ? (nM - fm) : WGM;
        u.pm = fm + ((wgid % nig) % gsz); u.pn = (wgid % nig) / gsz; return true;
    }
};
struct ZeroOrder { int n, G, c; __host__ __device__ bool next(int i, Unit& u) const { const long L = (long)i * G + c; if (L >= n) return false; u.pm = 0; u.pn = 0; return true; } };
struct RangeOrder { int base, n, nN; __host__ __device__ bool next(int i, Unit& u) const { if (i >= n) return false; const int L = base + i; u.pm = L / nN; u.pn = L % nN; return true; } };
struct GroupOrder {
    int n, per, G, c;
    __host__ __device__ bool next(int i, Unit& u) const { const long L = (long)i * G + c; if (L >= n) return false; u.pm = (int)L; u.pn = (int)L / per; return true; }
};

__device__ __forceinline__ unsigned cvt_pk_bf16(float lo, float hi) { unsigned r; asm volatile("v_cvt_pk_bf16_f32 %0, %1, %2" : "=v"(r) : "v"(lo), "v"(hi)); return r; }
__device__ __forceinline__ u32x4 pack8(const f32x4 a, const f32x4 b) { u32x4 w; w.x = cvt_pk_bf16(a[0], a[1]); w.y = cvt_pk_bf16(a[2], a[3]); w.z = cvt_pk_bf16(b[0], b[1]); w.w = cvt_pk_bf16(b[2], b[3]); return w; }

template <class Epi, class Sched>
__device__ __forceinline__ void gemm_phase(PG8_LAS unsigned char* lds, const Gemm g, const Sched& S, const Epi& E, int tid_in) {
    int tid_l = tid_in; asm volatile("" : "+v"(tid_l));
    const int tid = tid_l, wid = __builtin_amdgcn_readfirstlane(tid >> 6), lane = tid & 63, wr = wid >> 2, wc = wid & 3, fr = lane & 15, fq = lane >> 4;
    const int K = g.K, nt = K / BK;
    unsigned voffA[2], voffB[2];
#pragma unroll
    for (int i = 0; i < 2; ++i) { int R, C; stage_rc(tid * 16 + i * 8192, R, C); const int Rb = Epi::PERM ? ((R & ~31) + perm32(R & 31)) : R;
        voffA[i] = (unsigned)(R * g.lda + C) * 2u; voffB[i] = (unsigned)(Rb * g.ldb + C) * 2u; }
    asm volatile("" : "+v"(voffA[0]), "+v"(voffA[1]), "+v"(voffB[0]), "+v"(voffB[1]));
    const size_t kstep = (size_t)(BK * 2);
    const size_t hstepA = (size_t)HALF * g.lda * 2, hstepB = (size_t)HALF * g.ldb * 2;
    const size_t tstepA = 2 * hstepA, tstepB = 2 * hstepB;
    const unsigned ldsw = (unsigned)wid * 1024u;
    const int aoff = lds_byte(wr * 64 + fr, fq * 8), boff = lds_byte(wc * 32 + fr, fq * 8);
#define PG8_SA(b, h) (((b) * 2 + (h)) * HTB)
#define PG8_SB(b, h) ((4 + (b) * 2 + (h)) * HTB)
#define PG8_STAGE(bufoff, gbase, voff) do { _Pragma("unroll") for (int _i = 0; _i < 2; ++_i) \
        __builtin_amdgcn_global_load_lds((const unsigned*)((const char*)(gbase) + (voff)[_i]), (PG8_LAS unsigned*)(lds + (bufoff) + ldsw + _i * 8192), 16, 0, 0); } while (0)
#define PG8_LDA(dst, b, h) do { _Pragma("unroll") for (int m = 0; m < 4; ++m) _Pragma("unroll") for (int k = 0; k < 2; ++k) dst[m][k] = *(const PG8_LAS bf16x8*)(lds + PG8_SA(b, h) + aoff + m * 2048 + k * 1024); } while (0)
#define PG8_LDB(dst, b, h) do { _Pragma("unroll") for (int n = 0; n < 2; ++n) _Pragma("unroll") for (int k = 0; k < 2; ++k) dst[n][k] = *(const PG8_LAS bf16x8*)(lds + PG8_SB(b, h) + boff + n * 2048 + k * 1024); } while (0)
#define PG8_MMA(ai, bj, At, Bt) do { __builtin_amdgcn_s_setprio(1); _Pragma("unroll") for (int m = 0; m < 4; ++m) _Pragma("unroll") for (int n = 0; n < 2; ++n) _Pragma("unroll") for (int k = 0; k < 2; ++k) \
        acc[ai][bj][m][n] = __builtin_amdgcn_mfma_f32_16x16x32_bf16(Bt[n][k], At[m][k], acc[ai][bj][m][n], 0, 0, 0); __builtin_amdgcn_s_setprio(0); } while (0)
#define PG8_WAIT_V(n) asm volatile("s_waitcnt vmcnt(" #n ")" ::: "memory")
#define PG8_WAIT_L(n) asm volatile("s_waitcnt lgkmcnt(" #n ")" ::: "memory")
#define PG8_BAR __builtin_amdgcn_s_barrier()
#define PG8_SCHED __builtin_amdgcn_sched_barrier(0)
    Unit cur, nxt; int ui = 0;
    if (!S.next(0, cur)) return;
    f32x4 acc[2][2][4][2];
#pragma unroll
    for (int a = 0; a < 2; ++a)
#pragma unroll
        for (int b = 0; b < 2; ++b)
#pragma unroll
            for (int m = 0; m < 4; ++m)
#pragma unroll
                for (int n = 0; n < 2; ++n) acc[a][b][m][n] = (f32x4){0.f, 0.f, 0.f, 0.f};
    bf16x8 At[4][2], B0[2][2], B1[2][2];
    const char* cA = (const char*)g.A + (size_t)cur.pm * tstepA; const char* cB = (const char*)g.Bt + (size_t)cur.pn * tstepB;
    PG8_STAGE(PG8_SB(0, 0), cB, voffB); PG8_STAGE(PG8_SB(0, 1), cB + hstepB, voffB); PG8_STAGE(PG8_SA(0, 0), cA, voffA); PG8_STAGE(PG8_SA(0, 1), cA + hstepA, voffA);
    if (wr == 1) PG8_BAR;
    PG8_WAIT_V(2); PG8_BAR;
    PG8_STAGE(PG8_SB(1, 0), cB + kstep, voffB); PG8_STAGE(PG8_SA(1, 0), cA + kstep, voffA); PG8_STAGE(PG8_SB(1, 1), cB + hstepB + kstep, voffB);
    PG8_WAIT_V(6); PG8_BAR;
    for (;;) {
        const bool has_next = S.next(ui + 1, nxt);
        const char* nA = has_next ? (const char*)g.A + (size_t)nxt.pm * tstepA : cA; const char* nB = has_next ? (const char*)g.Bt + (size_t)nxt.pn * tstepB : cB;
#pragma unroll 1
        for (int t = 0; t < nt; t += 2) {
            const bool last = (t == nt - 2);
            if constexpr (Epi::MIDK) { if (t == (nt >> 1)) E.midk(acc, cur, wr, fr); }
            const char* a1 = cA + (size_t)(t + 1) * kstep;
            const char* a2 = last ? nA : cA + (size_t)(t + 2) * kstep; const char* b2 = last ? nB : cB + (size_t)(t + 2) * kstep;
            const char* a3 = a2 + kstep; const char* b3 = b2 + kstep;
            PG8_LDB(B0, 0, 0); PG8_LDB(B1, 0, 1); PG8_SCHED; PG8_LDA(At, 0, 0); PG8_STAGE(PG8_SA(1, 1), a1 + hstepA, voffA);
            PG8_WAIT_V(8); PG8_WAIT_L(0); PG8_BAR; PG8_MMA(0, 0, At, B0); PG8_MMA(0, 1, At, B1); PG8_BAR; PG8_SCHED;
            PG8_LDA(At, 0, 1); PG8_STAGE(PG8_SB(0, 0), b2, voffB); PG8_STAGE(PG8_SB(0, 1), b2 + hstepB, voffB); PG8_STAGE(PG8_SA(0, 0), a2, voffA);
            PG8_WAIT_V(8); PG8_WAIT_L(0); PG8_BAR; PG8_MMA(1, 0, At, B0); PG8_MMA(1, 1, At, B1); PG8_BAR; PG8_SCHED;
            PG8_LDB(B0, 1, 0); PG8_LDB(B1, 1, 1); PG8_SCHED; PG8_LDA(At, 1, 0); PG8_STAGE(PG8_SA(0, 1), a2 + hstepA, voffA);
            PG8_WAIT_V(8); PG8_WAIT_L(0); PG8_BAR; PG8_MMA(0, 0, At, B0); PG8_MMA(0, 1, At, B1); PG8_BAR; PG8_SCHED;
            PG8_LDA(At, 1, 1); PG8_STAGE(PG8_SB(1, 0), b3, voffB); PG8_STAGE(PG8_SB(1, 1), b3 + hstepB, voffB); PG8_STAGE(PG8_SA(1, 0), a3, voffA);
            PG8_WAIT_V(8); PG8_WAIT_L(0); PG8_BAR; PG8_MMA(1, 0, At, B0); PG8_MMA(1, 1, At, B1); PG8_BAR; PG8_SCHED;
        }
        if (wr == 0) PG8_BAR;
        E(acc, cur, wr, wc, fr, fq);
        if (!has_next) break;
#pragma unroll
        for (int a = 0; a < 2; ++a)
#pragma unroll
            for (int b = 0; b < 2; ++b)
#pragma unroll
                for (int m = 0; m < 4; ++m)
#pragma unroll
                    for (int n = 0; n < 2; ++n) acc[a][b][m][n] = (f32x4){0.f, 0.f, 0.f, 0.f};
        cur = nxt; cA = nA; cB = nB; ++ui;
        if (wr == 1) PG8_BAR;
    }
    PG8_WAIT_V(0);
    PG8_BAR;
#undef PG8_SA
#undef PG8_SB
#undef PG8_STAGE
#undef PG8_LDA
#undef PG8_LDB
#undef PG8_MMA
#undef PG8_WAIT_V
#undef PG8_WAIT_L
#undef PG8_BAR
#undef PG8_SCHED
}
}

constexpr int T = 24576, DM = 4096, DFF = 11008;
constexpr int NCHUNK = T / 16;
constexpr int QLAT = 896, KVLAT = 512, QW = 3072, KVW = 4096, MIXW = 2048;
constexpr float EPS = 1e-6f;
__device__ __forceinline__ int pos_of(int r) { return r < 16384 ? (r & 8191) : (r & 4095); }
__device__ __forceinline__ int len_of(int r) { return r < 16384 ? 8192 : 4096; }

typedef unsigned short bf16;
#define GAS __attribute__((address_space(1)))
#define LAS __attribute__((address_space(3)))
typedef unsigned v4u __attribute__((ext_vector_type(4)));
typedef unsigned v2u __attribute__((ext_vector_type(2)));
typedef float f32x4 __attribute__((ext_vector_type(4)));
typedef float f32x2 __attribute__((ext_vector_type(2)));
typedef short bf16x8 __attribute__((ext_vector_type(8)));

__device__ __forceinline__ unsigned f2bf(float f) { unsigned u = __builtin_bit_cast(unsigned, f); return (u + 0x7fffu + ((u >> 16) & 1u)) >> 16; }
__device__ __forceinline__ unsigned pk2(float lo, float hi) { return f2bf(lo) | (f2bf(hi) << 16); }
__device__ __forceinline__ float bf2f(unsigned short b) { return __builtin_bit_cast(float, (unsigned)b << 16); }
__device__ __forceinline__ float bflo(unsigned w) { return __builtin_bit_cast(float, w << 16); }
__device__ __forceinline__ float bfhi(unsigned w) { return __builtin_bit_cast(float, w & 0xffff0000u); }
__device__ __forceinline__ float sigmoidf_fast(float x) { return __builtin_amdgcn_rcpf(1.0f + __builtin_amdgcn_exp2f(-1.4426950408889634f * x)); }
__device__ __forceinline__ float gelu_tanh(float y) { const float in = 1.5957691216057308f * (y + 0.044715f * y * y * y); return y * sigmoidf_fast(in); }

namespace pg8 {
#define EPI_ROWS const int row0 = u.pm * 256 + wr * 64 + fr
__device__ __forceinline__ float sq8(const f32x4 a, const f32x4 b) { return (a[0] * a[0] + a[1] * a[1]) + (a[2] * a[2] + a[3] * a[3]) + (b[0] * b[0] + b[1] * b[1]) + (b[2] * b[2] + b[3] * b[3]); }
__device__ __forceinline__ float red_fq(float s) { s += __shfl_xor(s, 16); s += __shfl_xor(s, 32); return s; }

__device__ __forceinline__ f32x4 rope4(const f32x4 v, const f32x4 cs) { f32x4 o; o[0] = v[0] * cs[0] - v[1] * cs[1]; o[1] = v[1] * cs[0] + v[0] * cs[1]; o[2] = v[2] * cs[2] - v[3] * cs[3]; o[3] = v[3] * cs[2] + v[2] * cs[3]; return o; }

#define LAUNDER(p) asm volatile("" : "+v"(p))
struct EpiNull { static constexpr bool PERM = true, MIDK = false;
    __device__ __forceinline__ void midk(f32x4 (&)[2][2][4][2], const Unit&, int, int) const {}
    __device__ __forceinline__ void operator()(const f32x4 (&acc)[2][2][4][2], const Unit& u, int wr, int wc, int fr, int fq) const {
#pragma unroll
        for (int ai = 0; ai < 2; ++ai)
#pragma unroll
            for (int bj = 0; bj < 2; ++bj)
                asm volatile("" :: "v"(acc[ai][bj][0][0]), "v"(acc[ai][bj][0][1]), "v"(acc[ai][bj][1][0]), "v"(acc[ai][bj][1][1]), "v"(acc[ai][bj][2][0]), "v"(acc[ai][bj][2][1]), "v"(acc[ai][bj][3][0]), "v"(acc[ai][bj][3][1]));
    } };
struct EpiWin {
    static constexpr bool PERM = true, MIDK = false;
    const float* rstd_x; bf16_t* X; bf16_t* qlat; bf16_t* kvlat; bf16_t* krope; float* stQ; float* stKV; const float* ropetab;
    __device__ __forceinline__ void midk(f32x4 (&)[2][2][4][2], const Unit&, int, int) const {}
    __device__ __forceinline__ void operator()(const f32x4 (&acc)[2][2][4][2], const Unit& u, int wr, int wc, int fr, int fq) const {
        EPI_ROWS; const int tile = u.pn;
        const GAS float* rsp = (const GAS float*)(rstd_x + row0); LAUNDER(rsp);
        if (tile < 8) {
            const int c0 = tile * 256 + wc * 32 + 8 * fq;
            GAS bf16_t* xp0 = (GAS bf16_t*)X + ((size_t)((c0 >> 4) * NCHUNK + (row0 >> 4)) * 512 + 256 + (row0 & 15) * 16 + (c0 & 15)); LAUNDER(xp0);
#pragma unroll
            for (int ai = 0; ai < 2; ++ai)
#pragma unroll
                for (int m = 0; m < 4; ++m) { const float rs = rsp[ai * 128 + m * 16];
#pragma unroll
                    for (int bj = 0; bj < 2; ++bj)
                        *(GAS u32x4*)(xp0 + ((size_t)(bj * 8) * NCHUNK + ai * 8 + m) * 512) = pack8(acc[ai][bj][m][0] * rs, acc[ai][bj][m][1] * rs); }
        } else if (tile < 14) {
            const bool isq = tile < 12; const int tl = isq ? tile - 8 : tile - 12; const int ld = isq ? QLAT : KVLAT;
            const int c0 = tl * 256 + wc * 32 + 8 * fq;
            GAS bf16_t* op = (GAS bf16_t*)(isq ? qlat : kvlat) + (size_t)row0 * ld + c0; GAS float* sp = (GAS float*)(isq ? stQ + (size_t)row0 * 16 : stKV + (size_t)row0 * 8) + tl * 4 + wc; LAUNDER(op); LAUNDER(sp);
#pragma unroll
            for (int ai = 0; ai < 2; ++ai)
#pragma unroll
                for (int m = 0; m < 4; ++m) { const float rs = rsp[ai * 128 + m * 16]; float ss = 0.f;
#pragma unroll
                    for (int bj = 0; bj < 2; ++bj) { const f32x4 v0 = acc[ai][bj][m][0] * rs, v1 = acc[ai][bj][m][1] * rs; ss += sq8(v0, v1);
                        if (c0 + bj * 128 < ld) *(GAS u32x4*)(op + (size_t)(ai * 128 + m * 16) * ld + bj * 128) = pack8(v0, v1); }
                    ss = red_fq(ss); if (fq == 0) sp[(size_t)(ai * 128 + m * 16) * (isq ? 16 : 8)] = ss; }
        } else {
            if (wc < 2) { const int c = wc * 32 + 8 * fq;
                GAS bf16_t* op = (GAS bf16_t*)krope + (size_t)row0 * 64 + c; LAUNDER(op);
#pragma unroll
                for (int ai = 0; ai < 2; ++ai)
#pragma unroll
                    for (int m = 0; m < 4; ++m) { const int row = row0 + ai * 128 + m * 16; const float rs = rsp[ai * 128 + m * 16]; const int pos = pos_of(row);
                        const f32x4 cs0 = *(const GAS f32x4*)((const GAS float*)ropetab + (size_t)pos * 64 + c), cs1 = *(const GAS f32x4*)((const GAS float*)ropetab + (size_t)pos * 64 + c + 4);
                        const f32x4 v0 = rope4(acc[ai][0][m][0] * rs, cs0), v1 = rope4(acc[ai][0][m][1] * rs, cs1);
                        *(GAS u32x4*)(op + (size_t)(ai * 128 + m * 16) * 64) = pack8(v0, v1); } }
        }
    }
};
struct EpiSsm1 {
    static constexpr bool PERM = true, MIDK = false;
    bf16_t* X;
    __device__ __forceinline__ void midk(f32x4 (&)[2][2][4][2], const Unit&, int, int) const {}
    __device__ __forceinline__ void operator()(const f32x4 (&acc)[2][2][4][2], const Unit& u, int wr, int wc, int fr, int fq) const {
        EPI_ROWS; GAS bf16_t* op = (GAS bf16_t*)X + (size_t)row0 * 512 + wc * 32 + 8 * fq; LAUNDER(op);
#pragma unroll
        for (int ai = 0; ai < 2; ++ai)
#pragma unroll
            for (int m = 0; m < 4; ++m)
#pragma unroll
                for (int bj = 0; bj < 2; ++bj) *(GAS u32x4*)(op + (size_t)(ai * 128 + m * 16) * 512 + bj * 128) = pack8(acc[ai][bj][m][0], acc[ai][bj][m][1]);
    }
};
struct EpiSsm2 {
    static constexpr bool PERM = true, MIDK = false;
    bf16_t* gact;
    __device__ __forceinline__ void midk(f32x4 (&)[2][2][4][2], const Unit&, int, int) const {}
    __device__ __forceinline__ void operator()(const f32x4 (&acc)[2][2][4][2], const Unit& u, int wr, int wc, int fr, int fq) const {
        EPI_ROWS; const int g = u.pn; const int c0 = wc * 32 + 8 * fq;
        GAS bf16_t* op = (GAS bf16_t*)gact + ((size_t)(row0 - g * NCHUNK) * 16 + (c0 >> 4)) * MIXW + g * 16 + (c0 & 15); LAUNDER(op);
#pragma unroll
        for (int ai = 0; ai < 2; ++ai)
#pragma unroll
            for (int m = 0; m < 4; ++m)
#pragma unroll
                for (int bj = 0; bj < 2; ++bj) { f32x4 v0 = acc[ai][bj][m][0], v1 = acc[ai][bj][m][1];
#pragma unroll
                    for (int e = 0; e < 4; ++e) { v0[e] = gelu_tanh(v0[e]); v1[e] = gelu_tanh(v1[e]); }
                    *(GAS u32x4*)(op + ((size_t)(ai * 128 + m * 16) * 16 + bj * 8) * MIXW) = pack8(v0, v1); }
    }
};
struct EpiQ {
    static constexpr bool PERM = true, MIDK = false;
    const float* rstd_q; bf16_t* q; const float* ropetab;
    __device__ __forceinline__ void midk(f32x4 (&)[2][2][4][2], const Unit&, int, int) const {}
    __device__ __forceinline__ void operator()(const f32x4 (&acc)[2][2][4][2], const Unit& u, int wr, int wc, int fr, int fq) const {
        EPI_ROWS; const GAS float* rsp = (const GAS float*)(rstd_q + row0); GAS bf16_t* op = (GAS bf16_t*)q + (size_t)row0 * QW + u.pn * 256 + wc * 32 + 8 * fq; LAUNDER(rsp); LAUNDER(op);
#pragma unroll
        for (int ai = 0; ai < 2; ++ai)
#pragma unroll
            for (int m = 0; m < 4; ++m) { const int row = row0 + ai * 128 + m * 16; const float rs = rsp[ai * 128 + m * 16] * 0.10411754627697264f;     const int pos = pos_of(row);
#pragma unroll
                for (int bj = 0; bj < 2; ++bj) { const int strip = 8 * u.pn + 4 * bj + wc, s6 = strip % 6;
                    f32x4 v0 = acc[ai][bj][m][0] * rs, v1 = acc[ai][bj][m][1] * rs;
                    if (s6 >= 4) { const int pc = (s6 - 4) * 32 + 8 * fq;
                        const f32x4 cs0 = *(const GAS f32x4*)((const GAS float*)ropetab + (size_t)pos * 64 + pc), cs1 = *(const GAS f32x4*)((const GAS float*)ropetab + (size_t)pos * 64 + pc + 4);
                        v0 = rope4(v0, cs0); v1 = rope4(v1, cs1); }
                    *(GAS u32x4*)(op + (size_t)(ai * 128 + m * 16) * QW + bj * 128) = pack8(v0, v1); } }
    }
};
struct EpiKV {
    static constexpr bool PERM = true, MIDK = false;
    const float* rstd_kv; bf16_t* kv;
    __device__ __forceinline__ void midk(f32x4 (&)[2][2][4][2], const Unit&, int, int) const {}
    __device__ __forceinline__ void operator()(const f32x4 (&acc)[2][2][4][2], const Unit& u, int wr, int wc, int fr, int fq) const {
        EPI_ROWS; const GAS float* rsp = (const GAS float*)(rstd_kv + row0); GAS bf16_t* op = (GAS bf16_t*)kv + (size_t)row0 * 2048 + u.pn * 256 + wc * 32 + 8 * fq; LAUNDER(rsp); LAUNDER(op);
#pragma unroll
        for (int ai = 0; ai < 2; ++ai)
#pragma unroll
            for (int m = 0; m < 4; ++m) { const float rs = rsp[ai * 128 + m * 16];
#pragma unroll
                for (int bj = 0; bj < 2; ++bj) *(GAS u32x4*)(op + (size_t)(ai * 128 + m * 16) * 2048 + bj * 128) = pack8(acc[ai][bj][m][0] * rs, acc[ai][bj][m][1] * rs); }
    }
};
struct EpiVT {
    static constexpr bool PERM = true, MIDK = false;
    const float* rstd_kv; bf16_t* vt;
    __device__ __forceinline__ void midk(f32x4 (&)[2][2][4][2], const Unit&, int, int) const {}
    __device__ __forceinline__ void operator()(const f32x4 (&acc)[2][2][4][2], const Unit& u, int wr, int wc, int fr, int fq) const {
        EPI_ROWS; const int c0 = u.pn * 256 + wc * 32 + 8 * fq; const GAS float* rsp = (const GAS float*)(rstd_kv + c0); GAS bf16_t* op = (GAS bf16_t*)vt + (size_t)row0 * T + c0; LAUNDER(rsp); LAUNDER(op);
        GAS bf16_t* opp = op - 8 * fq + 16 * (fq & 1) + 4 * (fq >> 1);
#pragma unroll
        for (int bj = 0; bj < 2; ++bj) { const f32x4 r0 = *(const GAS f32x4*)(rsp + bj * 128), r1 = *(const GAS f32x4*)(rsp + bj * 128 + 4);
#pragma unroll
            for (int ai = 0; ai < 2; ++ai)
#pragma unroll
                for (int m = 0; m < 4; ++m) { const u32x4 w = pack8(acc[ai][bj][m][0] * r0, acc[ai][bj][m][1] * r1); GAS bf16_t* q_ = opp + (size_t)(ai * 128 + m * 16) * T + bj * 128;
                    *(GAS u32x2*)q_ = (u32x2){w.x, w.y}; *(GAS u32x2*)(q_ + 8) = (u32x2){w.z, w.w}; } }
    }
};
struct EpiGlu {
    static constexpr bool PERM = true, MIDK = false;
    const bf16_t* gact; bf16_t* merged; float* stA;
    __device__ __forceinline__ void midk(f32x4 (&)[2][2][4][2], const Unit&, int, int) const {}
    __device__ __forceinline__ void operator()(const f32x4 (&acc)[2][2][4][2], const Unit& u, int wr, int wc, int fr, int fq) const {
        EPI_ROWS; const int c0 = u.pn * 256 + wc * 32 + 8 * fq;
        const GAS bf16_t* gp = (const GAS bf16_t*)gact + (size_t)row0 * MIXW + c0; GAS bf16_t* op = (GAS bf16_t*)merged + (size_t)row0 * DM + c0; GAS float* sp = (GAS float*)stA + (size_t)row0 * 32 + u.pn * 4 + wc; LAUNDER(gp); LAUNDER(op); LAUNDER(sp);
#pragma unroll
        for (int ai = 0; ai < 2; ++ai)
#pragma unroll
            for (int m = 0; m < 4; ++m) { float ss = 0.f;
#pragma unroll
                for (int bj = 0; bj < 2; ++bj) {
                    const u32x4 gw = *(const GAS u32x4*)(gp + (size_t)(ai * 128 + m * 16) * MIXW + bj * 128);
                    f32x4 v0, v1; const f32x4 a0 = acc[ai][bj][m][0], a1 = acc[ai][bj][m][1];
                    v0[0] = bflo(gw.x) * sigmoidf_fast(a0[0]); v0[1] = bfhi(gw.x) * sigmoidf_fast(a0[1]); v0[2] = bflo(gw.y) * sigmoidf_fast(a0[2]); v0[3] = bfhi(gw.y) * sigmoidf_fast(a0[3]);
                    v1[0] = bflo(gw.z) * sigmoidf_fast(a1[0]); v1[1] = bfhi(gw.z) * sigmoidf_fast(a1[1]); v1[2] = bflo(gw.w) * sigmoidf_fast(a1[2]); v1[3] = bfhi(gw.w) * sigmoidf_fast(a1[3]);
                    ss += sq8(v0, v1);
                    *(GAS u32x4*)(op + (size_t)(ai * 128 + m * 16) * DM + bj * 128) = pack8(v0, v1); }
                ss = red_fq(ss); if (fq == 0) sp[(size_t)(ai * 128 + m * 16) * 32] = ss; }
    }
};
struct EpiWout {
    static constexpr bool PERM = true, MIDK = true;
    const bf16_t* xb; const float* r2; const float* ratio; bf16_t* x1b; float* stA;
    __device__ __forceinline__ void midk(f32x4 (&acc)[2][2][4][2], const Unit& u, int wr, int fr) const {
        EPI_ROWS; const GAS float* rp = (const GAS float*)(ratio + row0); LAUNDER(rp);
#pragma unroll
        for (int ai = 0; ai < 2; ++ai)
#pragma unroll
            for (int m = 0; m < 4; ++m) { const float rt = rp[ai * 128 + m * 16];
#pragma unroll
                for (int bj = 0; bj < 2; ++bj)
#pragma unroll
                    for (int n = 0; n < 2; ++n) acc[ai][bj][m][n] *= rt; }
    }
    __device__ __forceinline__ void operator()(const f32x4 (&acc)[2][2][4][2], const Unit& u, int wr, int wc, int fr, int fq) const {
        EPI_ROWS; const int c0 = u.pn * 256 + wc * 32 + 8 * fq;
        const GAS float* rsp = (const GAS float*)(r2 + row0); const GAS bf16_t* bi = (const GAS bf16_t*)xb + (size_t)row0 * DM + c0; GAS bf16_t* bo = (GAS bf16_t*)x1b + (size_t)row0 * DM + c0;
        GAS float* sp = (GAS float*)stA + (size_t)row0 * 64 + u.pn * 4 + wc;
        LAUNDER(rsp); LAUNDER(bi); LAUNDER(bo); LAUNDER(sp);
#pragma unroll
        for (int ai = 0; ai < 2; ++ai)
#pragma unroll
            for (int m = 0; m < 4; ++m) { const float rs = rsp[ai * 128 + m * 16]; float ss = 0.f; const size_t ro = (size_t)(ai * 128 + m * 16) * DM;
#pragma unroll
                for (int bj = 0; bj < 2; ++bj) {
                    const u32x4 xr = *(const GAS u32x4*)(bi + ro + bj * 128);
                    const f32x4 v0 = (f32x4){bflo(xr.x), bfhi(xr.x), bflo(xr.y), bfhi(xr.y)} + acc[ai][bj][m][0] * rs, v1 = (f32x4){bflo(xr.z), bfhi(xr.z), bflo(xr.w), bfhi(xr.w)} + acc[ai][bj][m][1] * rs;
                    ss += sq8(v0, v1);
                    *(GAS u32x4*)(bo + ro + bj * 128) = pack8(v0, v1); }
                ss = red_fq(ss); if (fq == 0) sp[(size_t)(ai * 128 + m * 16) * 64] = ss; }
    }
};
__device__ __forceinline__ float dpp_ror1(float v) { return __builtin_bit_cast(float, __builtin_amdgcn_mov_dpp(__builtin_bit_cast(int, v), 0x121, 0xf, 0xf, false)); }
__device__ __forceinline__ float dpp_rol1(float v) { return __builtin_bit_cast(float, __builtin_amdgcn_mov_dpp(__builtin_bit_cast(int, v), 0x12f, 0xf, 0xf, false)); }
struct EpiFfnA {
    static constexpr bool PERM = true, MIDK = false;
    const float* rstd; int row_base; bf16_t* act; bf16_t* halo_up; bf16_t* halo_gate; const float* cw; const float* cb;
    __device__ __forceinline__ void midk(f32x4 (&)[2][2][4][2], const Unit&, int, int) const {}
    __device__ __forceinline__ void operator()(const f32x4 (&acc)[2][2][4][2], const Unit& u, int wr, int wc, int fr, int fq) const {
        EPI_ROWS; const int f0 = u.pn * 128 + wc * 32 + 8 * fq;
        const GAS float* rsp = (const GAS float*)(rstd + row_base + row0); GAS bf16_t* actp = (GAS bf16_t*)act + (size_t)row0 * DFF + f0;
        const int strip0 = u.pm * 4 + wr;
        GAS bf16_t* hup_p = (GAS bf16_t*)halo_up + (size_t)strip0 * 4 * DFF + f0; GAS bf16_t* hg_p = (GAS bf16_t*)halo_gate + (size_t)strip0 * 2 * DFF + f0;
        const GAS float* cwp = (const GAS float*)(cw + f0); const GAS float* cbp = (const GAS float*)(cb + f0);
        asm volatile("" : "+v"(rsp), "+v"(actp), "+v"(hup_p), "+v"(hg_p), "+v"(cwp), "+v"(cbp));
#pragma unroll
        for (int ai = 0; ai < 2; ++ai) {
            float rs[4];
#pragma unroll
            for (int m = 0; m < 4; ++m) rs[m] = rsp[ai * 128 + m * 16];
            u32x2 keep[4];
#pragma unroll
            for (int n = 0; n < 2; ++n) {
                const f32x4 w0 = *(const GAS f32x4*)(cwp + 4 * n), w1 = *(const GAS f32x4*)(cwp + DFF + 4 * n), w2 = *(const GAS f32x4*)(cwp + 2 * DFF + 4 * n), wb = *(const GAS f32x4*)(cbp + 4 * n);
                f32x4 res[4], Uu[4];
#pragma unroll
                for (int e = 0; e < 4; ++e) {
                    float U[4], R[4], L[4];
#pragma unroll
                    for (int m = 0; m < 4; ++m) { U[m] = acc[ai][0][m][n][e] * rs[m]; R[m] = dpp_ror1(U[m]); L[m] = dpp_rol1(U[m]); Uu[m][e] = U[m]; }
#pragma unroll
                    for (int m = 0; m < 4; ++m) {
                        const float prev = (fr == 0) ? R[m > 0 ? m - 1 : 0] : R[m];
                        const float next = (fr == 15) ? L[m < 3 ? m + 1 : 3] : L[m];
                        const float cv = w0[e] * prev + w1[e] * U[m] + w2[e] * next + wb[e];
                        res[m][e] = cv * sigmoidf_fast(cv) * (acc[ai][1][m][n][e] * rs[m]);
                    }
                }
#pragma unroll
                for (int m = 0; m < 4; ++m) {
                    const bool edge = (m == 0 && fr == 0) || (m == 3 && fr == 15);
                    { u32x2 w; w.x = cvt_pk_bf16(res[m][0], res[m][1]); w.y = cvt_pk_bf16(res[m][2], res[m][3]);
                      if (n == 0) keep[m] = w; else if (!edge) *(GAS u32x4*)(actp + (size_t)(ai * 128 + m * 16) * DFF) = (u32x4){keep[m].x, keep[m].y, w.x, w.y}; }
                    if (m == 0 || m == 3) {
                        const int hs = (m == 0) ? (fr == 0 ? 0 : (fr == 1 ? 1 : -1)) : (fr == 14 ? 2 : (fr == 15 ? 3 : -1));
                        if (hs >= 0) { u32x2 w; w.x = cvt_pk_bf16(Uu[m][0], Uu[m][1]); w.y = cvt_pk_bf16(Uu[m][2], Uu[m][3]);
                            *(GAS u32x2*)(hup_p + ((size_t)(ai * 2) * 4 + hs) * DFF + 4 * n) = w;
                            if (hs == 0 || hs == 3) { const f32x4 gv = acc[ai][1][m][n] * rs[m]; u32x2 wg; wg.x = cvt_pk_bf16(gv[0], gv[1]); wg.y = cvt_pk_bf16(gv[2], gv[3]);
                                *(GAS u32x2*)(hg_p + ((size_t)(ai * 2) * 2 + (hs == 3 ? 1 : 0)) * DFF + 4 * n) = wg; } }
                    }
                }
            }
        }
    }
};
struct EpiDown {
    static constexpr bool PERM = true, MIDK = false;
    bf16_t* xb; int row_base; float* stA;
    __device__ __forceinline__ void midk(f32x4 (&)[2][2][4][2], const Unit&, int, int) const {}
    __device__ __forceinline__ void operator()(const f32x4 (&acc)[2][2][4][2], const Unit& u, int wr, int wc, int fr, int fq) const {
        EPI_ROWS; GAS bf16_t* xo = (GAS bf16_t*)xb + (size_t)(row_base + row0) * DM + u.pn * 256 + wc * 32 + 8 * fq; GAS float* sp = (GAS float*)stA + (size_t)(row_base + row0) * 64 + u.pn * 4 + wc; LAUNDER(xo); LAUNDER(sp);
#pragma unroll
        for (int ai = 0; ai < 2; ++ai)
#pragma unroll
            for (int m = 0; m < 4; ++m) { float ss = 0.f; const size_t ro = (size_t)(ai * 128 + m * 16) * DM;
#pragma unroll
                for (int bj = 0; bj < 2; ++bj) { GAS bf16_t* p = xo + ro + bj * 128; const u32x4 w = *(const GAS u32x4*)p; const f32x4 a0 = acc[ai][bj][m][0], a1 = acc[ai][bj][m][1];
                    f32x4 v0, v1; v0[0] = bflo(w.x) + a0[0]; v0[1] = bfhi(w.x) + a0[1]; v0[2] = bflo(w.y) + a0[2]; v0[3] = bfhi(w.y) + a0[3];
                    v1[0] = bflo(w.z) + a1[0]; v1[1] = bfhi(w.z) + a1[1]; v1[2] = bflo(w.w) + a1[2]; v1[3] = bfhi(w.w) + a1[3];
                    ss += sq8(v0, v1); *(GAS u32x4*)p = pack8(v0, v1); }
                ss = red_fq(ss); if (fq == 0) sp[(size_t)(ai * 128 + m * 16) * 64] = ss; }
    }
};
#undef EPI_ROWS
}

namespace attn {
using f32x4v = __attribute__((ext_vector_type(4))) float;
using u32x2v = __attribute__((ext_vector_type(2))) unsigned;
using u32x4v = __attribute__((ext_vector_type(4))) unsigned;
constexpr int NW = 8, KVBLK = 64;
constexpr float SCALE = 0.07216878364870322f;
constexpr float THR = 8.f;
constexpr int LDQ = 3072, LDK = 2048, LDR = 64, LDVT = T, LDO = 4096;
constexpr int SHM_V = 128 * KVBLK * 2, SHM_K = KVBLK * 128 * 2, SHM_R = KVBLK * 64 * 2;
constexpr int OFF_V = 0, OFF_K = 2 * SHM_V, OFF_R = OFF_K + 2 * SHM_K, OFF_QR = OFF_R + 2 * SHM_R, SHM_ATTN = OFF_QR + NW * 4096;
#define SBAR() __builtin_amdgcn_sched_barrier(0)
#define PIN(x) asm volatile("" : "+v"(x))
__device__ __forceinline__ void glds16(const void* gsrc, unsigned lds_dst) { unsigned keep;
  asm volatile("s_mov_b32 %0, m0\n\ts_mov_b32 m0, %2\n\ts_nop 0\n\tglobal_load_lds_dwordx4 %1, off\n\ts_mov_b32 m0, %0" : "=&s"(keep) : "v"(gsrc), "s"(lds_dst) : "memory"); }
__device__ __forceinline__ unsigned cvtpk(float lo, float hi) { unsigned r; asm volatile("v_cvt_pk_bf16_f32 %0, %1, %2" : "=v"(r) : "v"(lo), "v"(hi)); return r; }
__device__ __forceinline__ float xmax16(float v) { auto r = __builtin_amdgcn_permlane16_swap(__float_as_uint(v), __float_as_uint(v), false, false); return fmaxf(__uint_as_float(r[0]), __uint_as_float(r[1])); }
__device__ __forceinline__ float xmax32(float v) { auto r = __builtin_amdgcn_permlane32_swap(__float_as_uint(v), __float_as_uint(v), false, false); return fmaxf(__uint_as_float(r[0]), __uint_as_float(r[1])); }
__device__ __forceinline__ float xsum16(float v) { auto r = __builtin_amdgcn_permlane16_swap(__float_as_uint(v), __float_as_uint(v), false, false); return __uint_as_float(r[0]) + __uint_as_float(r[1]); }
__device__ __forceinline__ float xsum32(float v) { auto r = __builtin_amdgcn_permlane32_swap(__float_as_uint(v), __float_as_uint(v), false, false); return __uint_as_float(r[0]) + __uint_as_float(r[1]); }
__device__ __forceinline__ float max3f(float a, float b, float c) { float r; asm("v_max3_f32 %0, %1, %2, %3" : "=v"(r) : "v"(a), "v"(b), "v"(c)); return r; }
#define MF16(A, B, C) __builtin_amdgcn_mfma_f32_16x16x32_bf16(A, B, C, 0, 0, 0)
struct Lane { const LAS char* Kl; const LAS char* Rl; const LAS char* Vl; const LAS char* qrl; int ky, rz, vz; };
template <int KB, int S> __device__ __forceinline__ bf16x8 kfrag(const Lane& L, int kst, int rst) {
  if constexpr (S < 4) return *(const LAS bf16x8*)(L.Kl + kst + KB * 4096 + ((64 * S) ^ L.ky));
  else return *(const LAS bf16x8*)(L.Rl + rst + KB * 2048 + ((64 * (S - 4)) ^ L.rz));
}
template <int DB, int C> __device__ __forceinline__ bf16x8 vfrag(const Lane& L, int vst) { return *(const LAS bf16x8*)(L.Vl + vst + DB * 2048 + ((64 * C) ^ L.rz)); }
template <int QB, int S> __device__ __forceinline__ bf16x8 qfrag(const bf16x8 (&qn)[2][6], const Lane& L) { return qn[QB][S]; }
template <int KB> __device__ __forceinline__ void qk_block_plain(f32x4v (&s)[2][4], const bf16x8 (&qn)[2][6], const Lane& L, int kst, int rst) {
  bf16x8 k = kfrag<KB, 0>(L, kst, rst); s[0][KB] = MF16(k, (qfrag<0, 0>(qn, L)), ((f32x4v){0.f, 0.f, 0.f, 0.f})); s[1][KB] = MF16(k, (qfrag<1, 0>(qn, L)), ((f32x4v){0.f, 0.f, 0.f, 0.f}));
  k = kfrag<KB, 1>(L, kst, rst); s[0][KB] = MF16(k, (qfrag<0, 1>(qn, L)), s[0][KB]); s[1][KB] = MF16(k, (qfrag<1, 1>(qn, L)), s[1][KB]);
  k = kfrag<KB, 2>(L, kst, rst); s[0][KB] = MF16(k, (qfrag<0, 2>(qn, L)), s[0][KB]); s[1][KB] = MF16(k, (qfrag<1, 2>(qn, L)), s[1][KB]);
  k = kfrag<KB, 3>(L, kst, rst); s[0][KB] = MF16(k, (qfrag<0, 3>(qn, L)), s[0][KB]); s[1][KB] = MF16(k, (qfrag<1, 3>(qn, L)), s[1][KB]);
  k = kfrag<KB, 4>(L, kst, rst); s[0][KB] = MF16(k, (qfrag<0, 4>(qn, L)), s[0][KB]); s[1][KB] = MF16(k, (qfrag<1, 4>(qn, L)), s[1][KB]);
  k = kfrag<KB, 5>(L, kst, rst); s[0][KB] = MF16(k, (qfrag<0, 5>(qn, L)), s[0][KB]); s[1][KB] = MF16(k, (qfrag<1, 5>(qn, L)), s[1][KB]);
}
template <int QB> __device__ __forceinline__ float rowmax(const f32x4v (&s)[2][4]) {
  float m = max3f(s[QB][0][0], s[QB][0][1], s[QB][0][2]); m = max3f(m, s[QB][0][3], s[QB][1][0]); m = max3f(m, s[QB][1][1], s[QB][1][2]); m = max3f(m, s[QB][1][3], s[QB][2][0]);
  m = max3f(m, s[QB][2][1], s[QB][2][2]); m = max3f(m, s[QB][2][3], s[QB][3][0]); m = max3f(m, s[QB][3][1], s[QB][3][2]); m = max3f(m, s[QB][3][3], s[QB][3][3]); return m;
}
constexpr float THRL = 11.541560327111707f;
__device__ __forceinline__ void decide(float pm0, float pm1, f32x4v (&c)[2][4], float (&mh)[2], f32x4v (&negm)[2], float (&al)[2]) {
  pm0 = xmax32(xmax16(pm0)); pm1 = xmax32(xmax16(pm1));
  if (__builtin_expect(__all((pm0 <= THRL) && (pm1 <= THRL)), 1)) { al[0] = 1.f; al[1] = 1.f; }
  else { const float d0 = fmaxf(pm0, 0.f), d1 = fmaxf(pm1, 0.f); mh[0] += d0; mh[1] += d1;
#pragma unroll
    for (int kb = 0; kb < 4; ++kb) { c[0][kb] = c[0][kb] - d0; c[1][kb] = c[1][kb] - d1; }
    al[0] = __builtin_amdgcn_exp2f(-d0); al[1] = __builtin_amdgcn_exp2f(-d1);
    negm[0] = (f32x4v){-mh[0], -mh[0], -mh[0], -mh[0]}; negm[1] = (f32x4v){-mh[1], -mh[1], -mh[1], -mh[1]}; }
}
__device__ __forceinline__ bf16x8 packp(const f32x4v a, const f32x4v b) { const u32x4v w = {cvtpk(a[0], a[1]), cvtpk(a[2], a[3]), cvtpk(b[0], b[1]), cvtpk(b[2], b[3])}; return __builtin_bit_cast(bf16x8, w); }

struct Dma { const char* k0; const char* k1; const char* r; const char* v0; const char* v1; unsigned dk, dr, dv; bool kr; };
__device__ __forceinline__ void attn_step(f32x4v (&c)[2][4], f32x4v (&p)[2][4], f32x4v (&o)[2][8], const bf16x8 (&qn)[2][6], const Lane& L, int kst, int rst, int vst,
                                          const float (&alp)[2], float (&l)[2], float (&mh)[2], f32x4v (&negm)[2], float (&alc)[2], const Dma& D) {
  bf16x8 ka, kb_, kc, kd, P00, P01, P10, P11;
#define QKR(KB, S, FIRST, KX, KY) do { \
    if (FIRST) { c[0][KB] = MF16(KX, (qfrag<0, S>(qn, L)), negm[0]); c[1][KB] = MF16(KX, (qfrag<1, S>(qn, L)), negm[1]); \
                 c[0][KB + 1] = MF16(KY, (qfrag<0, S>(qn, L)), negm[0]); c[1][KB + 1] = MF16(KY, (qfrag<1, S>(qn, L)), negm[1]); } \
    else { c[0][KB] = MF16(KX, (qfrag<0, S>(qn, L)), c[0][KB]); c[1][KB] = MF16(KX, (qfrag<1, S>(qn, L)), c[1][KB]); \
           c[0][KB + 1] = MF16(KY, (qfrag<0, S>(qn, L)), c[0][KB + 1]); c[1][KB + 1] = MF16(KY, (qfrag<1, S>(qn, L)), c[1][KB + 1]); } } while (0)
#define EXP4(V) do { V[0] = __builtin_amdgcn_exp2f(V[0]); V[1] = __builtin_amdgcn_exp2f(V[1]); V[2] = __builtin_amdgcn_exp2f(V[2]); V[3] = __builtin_amdgcn_exp2f(V[3]); } while (0)
  ka = kfrag<0, 0>(L, kst, rst); kb_ = kfrag<1, 0>(L, kst, rst); SBAR();
  kc = kfrag<0, 1>(L, kst, rst); kd = kfrag<1, 1>(L, kst, rst); QKR(0, 0, true, ka, kb_); EXP4(p[0][2]); PIN(p[0][2]); SBAR();
  if (D.kr) glds16(D.k0, D.dk);
  ka = kfrag<0, 2>(L, kst, rst); kb_ = kfrag<1, 2>(L, kst, rst); QKR(0, 1, false, kc, kd); EXP4(p[0][3]); PIN(p[0][3]); SBAR();
  kc = kfrag<0, 3>(L, kst, rst); kd = kfrag<1, 3>(L, kst, rst); QKR(0, 2, false, ka, kb_); EXP4(p[1][2]); PIN(p[1][2]); SBAR();
  if (D.kr) glds16(D.k1, D.dk + 8192);
  ka = kfrag<0, 4>(L, kst, rst); kb_ = kfrag<1, 4>(L, kst, rst); QKR(0, 3, false, kc, kd); EXP4(p[1][3]); PIN(p[1][3]); SBAR();
  kc = kfrag<0, 5>(L, kst, rst); kd = kfrag<1, 5>(L, kst, rst); QKR(0, 4, false, ka, kb_);
  { float s = (p[0][0][0] + p[0][0][1]) + (p[0][0][2] + p[0][0][3]); s += (p[0][1][0] + p[0][1][1]) + (p[0][1][2] + p[0][1][3]); s += (p[0][2][0] + p[0][2][1]) + (p[0][2][2] + p[0][2][3]); s += (p[0][3][0] + p[0][3][1]) + (p[0][3][2] + p[0][3][3]);
    l[0] = l[0] * alp[0] + s; PIN(l[0]); } SBAR();
  if (D.kr) glds16(D.r, D.dr);
  ka = kfrag<2, 0>(L, kst, rst); kb_ = kfrag<3, 0>(L, kst, rst); QKR(0, 5, false, kc, kd);
  { float s = (p[1][0][0] + p[1][0][1]) + (p[1][0][2] + p[1][0][3]); s += (p[1][1][0] + p[1][1][1]) + (p[1][1][2] + p[1][1][3]); s += (p[1][2][0] + p[1][2][1]) + (p[1][2][2] + p[1][2][3]); s += (p[1][3][0] + p[1][3][1]) + (p[1][3][2] + p[1][3][3]);
    l[1] = l[1] * alp[1] + s; PIN(l[1]); } SBAR();
  kc = kfrag<2, 1>(L, kst, rst); kd = kfrag<3, 1>(L, kst, rst); QKR(2, 0, true, ka, kb_); P00 = packp(p[0][0], p[0][1]); PIN(P00); SBAR();
  glds16(D.v0, D.dv);
  ka = kfrag<2, 2>(L, kst, rst); kb_ = kfrag<3, 2>(L, kst, rst); QKR(2, 1, false, kc, kd); P01 = packp(p[0][2], p[0][3]); PIN(P01); SBAR();
  kc = kfrag<2, 3>(L, kst, rst); kd = kfrag<3, 3>(L, kst, rst); QKR(2, 2, false, ka, kb_); P10 = packp(p[1][0], p[1][1]); PIN(P10); SBAR();
  glds16(D.v1, D.dv + 8192);
  ka = kfrag<2, 4>(L, kst, rst); kb_ = kfrag<3, 4>(L, kst, rst); QKR(2, 3, false, kc, kd); P11 = packp(p[1][2], p[1][3]); PIN(P11); SBAR();
  kc = kfrag<2, 5>(L, kst, rst); kd = kfrag<3, 5>(L, kst, rst); QKR(2, 4, false, ka, kb_); SBAR();
  ka = vfrag<0, 0>(L, vst); kb_ = vfrag<1, 0>(L, vst); QKR(2, 5, false, kc, kd); SBAR();
#define PVR(DB, VX, VY, PA, PB) do { o[0][DB] = MF16(VX, PA, o[0][DB]); o[1][DB] = MF16(VX, PB, o[1][DB]); o[0][DB + 1] = MF16(VY, PA, o[0][DB + 1]); o[1][DB + 1] = MF16(VY, PB, o[1][DB + 1]); } while (0)
  float pm0, pm1;
  kc = vfrag<2, 0>(L, vst); kd = vfrag<3, 0>(L, vst); PVR(0, ka, kb_, P00, P10); pm0 = rowmax<0>(c); PIN(pm0); SBAR();
  ka = vfrag<4, 0>(L, vst); kb_ = vfrag<5, 0>(L, vst); PVR(2, kc, kd, P00, P10); pm1 = rowmax<1>(c); PIN(pm1); SBAR();
  kc = vfrag<6, 0>(L, vst); kd = vfrag<7, 0>(L, vst); PVR(4, ka, kb_, P00, P10); decide(pm0, pm1, c, mh, negm, alc); SBAR();
  ka = vfrag<0, 1>(L, vst); kb_ = vfrag<1, 1>(L, vst); PVR(6, kc, kd, P00, P10); EXP4(c[0][0]); PIN(c[0][0]); SBAR();
  kc = vfrag<2, 1>(L, vst); kd = vfrag<3, 1>(L, vst); PVR(0, ka, kb_, P01, P11); EXP4(c[0][1]); PIN(c[0][1]); SBAR();
  ka = vfrag<4, 1>(L, vst); kb_ = vfrag<5, 1>(L, vst); PVR(2, kc, kd, P01, P11); EXP4(c[1][0]); PIN(c[1][0]); SBAR();
  kc = vfrag<6, 1>(L, vst); kd = vfrag<7, 1>(L, vst); PVR(4, ka, kb_, P01, P11); EXP4(c[1][1]); PIN(c[1][1]); SBAR();
  PVR(6, kc, kd, P01, P11); SBAR();
#undef QKR
#undef PVR
}

__device__ __forceinline__ void attn_unit(const bf16* __restrict__ Qb, const bf16* __restrict__ Kh, const bf16* __restrict__ VTh, const bf16* __restrict__ Rh,
                                          bf16* __restrict__ Ob, float* __restrict__ st, int seq, int k0g, char* lds, int wid) {
  int lane_l = (int)__builtin_amdgcn_mbcnt_hi(~0u, __builtin_amdgcn_mbcnt_lo(~0u, 0u)); asm volatile("" : "+v"(lane_l));
  const int lane = lane_l, l15 = lane & 15, kq = lane >> 4;
  bf16x8 qn[2][6]; Lane L;
  L.qrl = (const LAS char*)(lds + OFF_QR + wid * 4096 + lane * 16);
  { const bf16* Qw = Qb + (long)(wid * 32 + l15) * LDQ + kq * 8;
#pragma unroll
    for (int qb = 0; qb < 2; ++qb) {
#pragma unroll
      for (int s = 0; s < 6; ++s) qn[qb][s] = *(const GAS bf16x8*)(Qw + (long)qb * 16 * LDQ + s * 32); } }
  L.Kl = (const LAS char*)(lds + OFF_K) + l15 * 256; L.Rl = (const LAS char*)(lds + OFF_R) + l15 * 128; L.Vl = (const LAS char*)(lds + OFF_V) + l15 * 128;
  L.ky = (kq ^ l15) << 4; L.rz = (kq ^ ((l15 >> 1) & 7)) << 4; L.vz = 0;
  unsigned kof0, kof1, rof, vof0, vof1;
  { const int q0 = wid, q1 = wid + 8;
    { const int row = 4 * q0 + (lane >> 4), ch = (lane & 15) ^ (row & 15); kof0 = (unsigned)(row * LDK + ch * 8) * 2u; }
    { const int row = 4 * q1 + (lane >> 4), ch = (lane & 15) ^ (row & 15); kof1 = (unsigned)(row * LDK + ch * 8) * 2u; }
    { const int row = 8 * q0 + (lane >> 3), ch = (lane & 7) ^ ((row >> 1) & 7); rof = (unsigned)(row * LDR + ch * 8) * 2u; }
    { const int row = 8 * q0 + (lane >> 3), ch = (lane & 7) ^ ((row >> 1) & 7); vof0 = (unsigned)(row * LDVT + ch * 8) * 2u; }
    { const int row = 8 * q1 + (lane >> 3), ch = (lane & 7) ^ ((row >> 1) & 7); vof1 = (unsigned)(row * LDVT + ch * 8) * 2u; } }
  const unsigned lds0 = (unsigned)(uintptr_t)lds;
  const unsigned dK = (unsigned)__builtin_amdgcn_readfirstlane(lds0 + OFF_K + wid * 1024), dR = (unsigned)__builtin_amdgcn_readfirstlane(lds0 + OFF_R + wid * 1024), dV = (unsigned)__builtin_amdgcn_readfirstlane(lds0 + OFF_V + wid * 1024);
  const char* VTk = (const char*)VTh + (size_t)k0g * 2;
#define DMA_KR(t, s) do { const char* kb_ = (const char*)Kh + (size_t)(t) * (KVBLK * LDK * 2); const char* rb_ = (const char*)Rh + (size_t)(t) * (KVBLK * LDR * 2); \
    glds16(kb_ + kof0, dK + (s) * SHM_K); glds16(kb_ + kof1, dK + (s) * SHM_K + 8192); glds16(rb_ + rof, dR + (s) * SHM_R); } while (0)
#define DMA_V(t, s) do { const char* vb_ = VTk + (size_t)(t) * (KVBLK * 2); glds16(vb_ + vof0, dV + (s) * SHM_V); glds16(vb_ + vof1, dV + (s) * SHM_V + 8192); } while (0)
#define WAIT_BAR() asm volatile("s_waitcnt vmcnt(0) lgkmcnt(0)\n\ts_barrier" ::: "memory")
#define RESC(a) do { if (__any(((a)[0] < 1.f) || ((a)[1] < 1.f))) { _Pragma("unroll") for (int d_ = 0; d_ < 8; ++d_) { o[0][d_] *= (a)[0]; o[1][d_] *= (a)[1]; } } } while (0)
  f32x4v o[2][8], sA[2][4], sB[2][4], negm[2]; float mh[2], l[2] = {0.f, 0.f}, alA[2], alB[2];
#pragma unroll
  for (int d = 0; d < 8; ++d) { o[0][d] = (f32x4v){0.f, 0.f, 0.f, 0.f}; o[1][d] = (f32x4v){0.f, 0.f, 0.f, 0.f}; }
  const int NT = seq / KVBLK;
  DMA_KR(0, 0); DMA_V(0, 0); WAIT_BAR();
  DMA_KR(1, 1);
  qk_block_plain<0>(sA, qn, L, 0, 0); qk_block_plain<1>(sA, qn, L, 0, 0); qk_block_plain<2>(sA, qn, L, 0, 0); qk_block_plain<3>(sA, qn, L, 0, 0);
  { mh[0] = xmax32(xmax16(rowmax<0>(sA))); mh[1] = xmax32(xmax16(rowmax<1>(sA))); alA[0] = 1.f; alA[1] = 1.f;
    negm[0] = (f32x4v){-mh[0], -mh[0], -mh[0], -mh[0]}; negm[1] = (f32x4v){-mh[1], -mh[1], -mh[1], -mh[1]};
#pragma unroll
    for (int kb = 0; kb < 4; ++kb) { sA[0][kb] = sA[0][kb] - mh[0]; sA[1][kb] = sA[1][kb] - mh[1]; }
#pragma unroll
    for (int kb = 0; kb < 2; ++kb)
#pragma unroll
      for (int e = 0; e < 4; ++e) { sA[0][kb][e] = __builtin_amdgcn_exp2f(sA[0][kb][e]); sA[1][kb][e] = __builtin_amdgcn_exp2f(sA[1][kb][e]); } }
  WAIT_BAR();
#pragma unroll 1
  for (int j = 1; j + 1 < NT; j += 2) {
    { const char* kb_ = (const char*)Kh + (size_t)(j + 1) * (KVBLK * LDK * 2); const char* rb_ = (const char*)Rh + (size_t)(j + 1) * (KVBLK * LDR * 2); const char* vb_ = VTk + (size_t)j * (KVBLK * 2);
      const Dma D{kb_ + kof0, kb_ + kof1, rb_ + rof, vb_ + vof0, vb_ + vof1, dK, dR, dV + SHM_V, true};
      attn_step(sB, sA, o, qn, L, SHM_K, SHM_R, 0, alA, l, mh, negm, alB, D); }
    RESC(alB); WAIT_BAR();
    { const char* kb_ = (const char*)Kh + (size_t)(j + 2) * (KVBLK * LDK * 2); const char* rb_ = (const char*)Rh + (size_t)(j + 2) * (KVBLK * LDR * 2); const char* vb_ = VTk + (size_t)(j + 1) * (KVBLK * 2);
      const Dma D{kb_ + kof0, kb_ + kof1, rb_ + rof, vb_ + vof0, vb_ + vof1, dK + SHM_K, dR + SHM_R, dV, (j + 2 < NT)};
      attn_step(sA, sB, o, qn, L, 0, 0, SHM_V, alB, l, mh, negm, alA, D); }
    RESC(alA); WAIT_BAR();
  }
  { const char* vb_ = VTk + (size_t)(NT - 1) * (KVBLK * 2);
    const Dma D{vb_, vb_, vb_, vb_ + vof0, vb_ + vof1, dK, dR, dV + SHM_V, false};
    attn_step(sB, sA, o, qn, L, SHM_K, SHM_R, 0, alA, l, mh, negm, alB, D); }
  RESC(alB); WAIT_BAR();
  {
#pragma unroll
    for (int kb = 2; kb < 4; ++kb)
#pragma unroll
      for (int e = 0; e < 4; ++e) { sB[0][kb][e] = __builtin_amdgcn_exp2f(sB[0][kb][e]); sB[1][kb][e] = __builtin_amdgcn_exp2f(sB[1][kb][e]); }
    float s0 = 0.f, s1 = 0.f;
#pragma unroll
    for (int kb = 0; kb < 4; ++kb) { s0 += (sB[0][kb][0] + sB[0][kb][1]) + (sB[0][kb][2] + sB[0][kb][3]); s1 += (sB[1][kb][0] + sB[1][kb][1]) + (sB[1][kb][2] + sB[1][kb][3]); }
    l[0] = l[0] * alB[0] + s0; l[1] = l[1] * alB[1] + s1;
    const bf16x8 P00 = packp(sB[0][0], sB[0][1]), P01 = packp(sB[0][2], sB[0][3]), P10 = packp(sB[1][0], sB[1][1]), P11 = packp(sB[1][2], sB[1][3]);
#define PVD(DB) do { bf16x8 v0 = vfrag<DB, 0>(L, SHM_V), v1 = vfrag<DB, 1>(L, SHM_V); o[0][DB] = MF16(v0, P00, o[0][DB]); o[1][DB] = MF16(v0, P10, o[1][DB]); o[0][DB] = MF16(v1, P01, o[0][DB]); o[1][DB] = MF16(v1, P11, o[1][DB]); } while (0)
    PVD(0); PVD(1); PVD(2); PVD(3); PVD(4); PVD(5); PVD(6); PVD(7);
#undef PVD
  }
  int lane_e = (int)__builtin_amdgcn_mbcnt_hi(~0u, __builtin_amdgcn_mbcnt_lo(~0u, 0u)); asm volatile("" : "+v"(lane_e)); const int l15e = lane_e & 15, kqe = lane_e >> 4;
  GAS bf16* Ow = (GAS bf16*)Ob + (long)(wid * 32 + l15e) * LDO + 4 * kqe; GAS float* stw = (GAS float*)st + (long)(wid * 32 + l15e) * 16;
  asm volatile("" : "+v"(Ow), "+v"(stw));
#pragma unroll
  for (int qb = 0; qb < 2; ++qb) { const float lt = xsum32(xsum16(l[qb])); const float rl = __builtin_amdgcn_rcpf(lt); float ss = 0.f;
#pragma unroll
    for (int db = 0; db < 8; ++db) { const f32x4v v = o[qb][db] * rl; u32x2v w; w.x = cvtpk(v[0], v[1]); w.y = cvtpk(v[2], v[3]);
      const float a0 = bflo(w.x), a1 = bfhi(w.x), a2 = bflo(w.y), a3 = bfhi(w.y); ss += (a0 * a0 + a1 * a1) + (a2 * a2 + a3 * a3);
      *(GAS u32x2v*)(Ow + (long)(qb * 16) * LDO + db * 16) = w; }
    ss = xsum32(xsum16(ss)); if (kqe == 0) stw[(long)(qb * 16) * 16] = ss; }
  asm volatile("s_waitcnt lgkmcnt(0)\n\ts_barrier" ::: "memory");
#undef DMA_KR
#undef DMA_V
#undef WAIT_BAR
#undef RESC
}
#undef SBAR
#undef PIN
#undef MF16
#undef EXP4
}

constexpr size_t MiB = 1u << 20;
constexpr size_t WS_CTL = 0, CTL_ZERO_BYTES = 1 * MiB;
constexpr size_t WS_RSTDX = 1 * MiB, WS_RSTDQ = WS_RSTDX + 98304, WS_RSTDKV = WS_RSTDQ + 98304, WS_R2 = WS_RSTDKV + 98304, WS_RATIO = WS_R2 + 98304, WS_RSTDX1 = WS_RATIO + 98304;
constexpr size_t WS_STA = 2 * MiB;
constexpr size_t WS_STB = 8 * MiB;
constexpr size_t WS_STQ = 10 * MiB;
constexpr size_t WS_STKV = 12 * MiB;
constexpr size_t WS_ROPE = 13 * MiB;
constexpr size_t WS_WIN = 16 * MiB;
constexpr size_t WS_WGLU = 46 * MiB;
constexpr size_t WS_WQ = 54 * MiB;
constexpr size_t WS_WKV = 60 * MiB;
constexpr size_t WS_WOUT = 64 * MiB;
constexpr size_t WS_WUG = 96 * MiB;
constexpr size_t WS_WDN = 268 * MiB;
constexpr size_t WS_W1T = 354 * MiB;
constexpr size_t WS_W2T = 370 * MiB;
constexpr size_t WS_A = 402 * MiB;
constexpr size_t WS_B = 594 * MiB;
constexpr size_t WS_QLAT = 786 * MiB, WS_KVLAT = 828 * MiB, WS_KROPE = 852 * MiB;
constexpr size_t WS_GACT = 856 * MiB;
constexpr size_t WS_HUP = 952 * MiB, WS_HGATE = 964 * MiB, WS_END = 970 * MiB;
static_assert(WS_HUP + (size_t)128 * 4 * DFF * 2 <= WS_HGATE && WS_HGATE + (size_t)128 * 2 * DFF * 2 <= WS_END, "halo");
constexpr size_t OUT_X = 0, OUT_KV = 192 * MiB;
constexpr int CW_BAR = 4096;

constexpr int NWAVES = 8;
constexpr int RING_BYTES = 131072, LDSCTL_OFF = 143360, MISC_OFF = LDSCTL_OFF + 320, LDS_BYTES = 147456;

typedef GAS unsigned gu32;
#define RLX_AGENT __ATOMIC_RELAXED, __HIP_MEMORY_SCOPE_AGENT
#define LDS_WAIT() asm volatile("s_waitcnt lgkmcnt(0)" ::: "memory")

#define XB_TMO      128
#define XB_XCNT(j)  (256  + 64 * (j))
#define XB_XSUB(j)  (1280 + 64 * (j))
#define XB_XGEN(j)  (2304 + 64 * (j))
#define XB_TOP      3328
#define XB_TOPGEN   3392
#define XCD_BAR_WORDS 3456
#define XB_SPIN_CAP (1u << 18)
__device__ __forceinline__ unsigned xb_ld(unsigned* p)              { return __hip_atomic_load(p, __ATOMIC_RELAXED, __HIP_MEMORY_SCOPE_AGENT); }
__device__ __forceinline__ unsigned xb_add(unsigned* p, unsigned v) { return __hip_atomic_fetch_add(p, v, __ATOMIC_RELAXED, __HIP_MEMORY_SCOPE_AGENT); }
__device__ __forceinline__ unsigned xb_xcc_id() { return (unsigned)__builtin_amdgcn_s_getreg((3 << 11) | 20) & 0xFu; }
#define XB_SPIN(cond, bar) do { unsigned _sp = 0; while (cond) { __builtin_amdgcn_s_sleep(1); \
    if ((++_sp & 255u) == 0u) { if (xb_ld(&(bar)[XB_TMO])) break; if (_sp > XB_SPIN_CAP) { atomicAdd(&(bar)[XB_TMO], 1u); break; } } } } while (0)
struct XcdBarrier { unsigned* bar; unsigned x; volatile LAS unsigned* st; };
__device__ __forceinline__ XcdBarrier xcd_barrier_post(unsigned* bar, volatile LAS unsigned* st) {
    XcdBarrier b; b.bar = bar; b.x = xb_xcc_id(); b.st = st;
    if (threadIdx.x == 0) (void)xb_add(&bar[XB_XCNT(b.x)], 1u);
    return b;
}
__device__ __forceinline__ void xcd_barrier_complete(unsigned* bar, unsigned x, unsigned& nloc, unsigned& nx) {
    const unsigned G = gridDim.x * gridDim.y * gridDim.z;
    unsigned sum, cnt, mine, sp = 0u;
    for (;;) {
        sum = 0u; cnt = 0u; mine = 0u;
#pragma unroll
        for (unsigned j = 0; j < 16; ++j) { const unsigned c = xb_ld(&bar[XB_XCNT(j)]); sum += c; cnt += (c > 0u) ? 1u : 0u; mine = (j == x) ? c : mine; }
        if (sum == G) break;
        __builtin_amdgcn_s_sleep(1);
        if ((++sp & 255u) == 0u) { if (xb_ld(&bar[XB_TMO])) break; if (sp > XB_SPIN_CAP) { atomicAdd(&bar[XB_TMO], 1u); break; } }
    }
    nloc = mine > 0u ? mine : 1u; nx = cnt > 0u ? cnt : 1u;
}
__device__ __forceinline__ void xcd_barrier(const XcdBarrier& b) {
    asm volatile("s_waitcnt vmcnt(0)" ::: "memory");
    __syncthreads();
    if (threadIdx.x == 0) {
        unsigned* bar = b.bar;
        __builtin_amdgcn_s_waitcnt(0);
        unsigned nloc = b.st[0], nx = b.st[1];
        if (nloc == 0u) { xcd_barrier_complete(bar, b.x, nloc, nx); b.st[0] = nloc; b.st[1] = nx; }
        const unsigned old = xb_add(&bar[XB_XSUB(b.x)], 1u);
        const unsigned gen = old / nloc;
        if (old + 1u == (gen + 1u) * nloc) {
            __builtin_amdgcn_fence(__ATOMIC_RELEASE, "agent");
            asm volatile("s_waitcnt vmcnt(0)" ::: "memory");
            const unsigned og = xb_add(&bar[XB_TOP], 1u);
            const unsigned tg = og / nx;
            if (og + 1u == (tg + 1u) * nx) xb_add(&bar[XB_TOPGEN], 1u);
            else XB_SPIN(xb_ld(&bar[XB_TOPGEN]) == tg, bar);
            __builtin_amdgcn_fence(__ATOMIC_ACQUIRE, "agent");
            xb_add(&bar[XB_XGEN(b.x)], 1u);
            asm volatile("s_waitcnt vmcnt(0)" ::: "memory");
        } else {
            XB_SPIN(xb_ld(&bar[XB_XGEN(b.x)]) == gen, bar);
            __builtin_amdgcn_fence(__ATOMIC_ACQUIRE, "agent");
            asm volatile("s_waitcnt vmcnt(0)" ::: "memory");
        }
    }
    __syncthreads();
}

__device__ __forceinline__ float wave_sum(float v) {
#pragma unroll
    for (int o = 1; o < 64; o <<= 1) v += __shfl_xor(v, o);
    return v;
}
template <class RowMap>
__device__ __forceinline__ void transpose_item(const float* W, int K, int N, bf16* WT, const float* g1, const float* g2, int ksplit, RowMap rm, LAS float* scr, int item, int lane) {
    const int nblk = N / 64; int kb, nb;
    if ((nblk & 3) == 0) { const int w = item & 7, rest = item >> 3, q = nblk >> 2; nb = (rest % q) * 4 + (w & 3); kb = (rest / q) * 2 + (w >> 2); }
    else { kb = item / nblk; nb = item % nblk; }
    const int k0 = 64 * kb, n0 = 64 * nb;
    f32x2 wv[32];
    const GAS f32x2* wp = (const GAS f32x2*)((const GAS float*)W + (size_t)(k0 + (lane >> 5)) * N + n0) + (lane & 31);
#pragma unroll
    for (int i = 0; i < 32; ++i) wv[i] = *(const GAS f32x2*)((const GAS float*)wp + (size_t)(2 * i) * N);
    float gn[32];
#pragma unroll
    for (int i = 0; i < 32; ++i) { const int k = k0 + 2 * i + (lane >> 5); gn[i] = g1 ? (k < ksplit ? g1[k] : g2[k - ksplit]) : 1.0f; }
    const int c = lane & 7;
#pragma unroll
    for (int sub = 0; sub < 2; ++sub) {
#pragma unroll
        for (int i = 0; i < 32; ++i) { const int kk = 2 * i + (lane >> 5); scr[kk * 33 + (lane & 31)] = (sub ? wv[i].y : wv[i].x) * gn[i]; }
        LDS_WAIT(); asm volatile("" ::: "memory");
#pragma unroll
        for (int j = 0; j < 4; ++j) { const int nl = (lane >> 3) + 8 * j; const LAS float* s = scr + (8 * c) * 33 + nl;
            v4u o; o.x = pg8::cvt_pk_bf16(s[0 * 33], s[1 * 33]); o.y = pg8::cvt_pk_bf16(s[2 * 33], s[3 * 33]); o.z = pg8::cvt_pk_bf16(s[4 * 33], s[5 * 33]); o.w = pg8::cvt_pk_bf16(s[6 * 33], s[7 * 33]);
            *(GAS v4u*)(WT + (size_t)rm(n0 + 2 * nl + sub) * K + k0 + 8 * c) = o; }
        LDS_WAIT(); asm volatile("" ::: "memory");
    }
}
__device__ __forceinline__ void tr_coords(int N, int item, int& k0, int& n0) { const int nblk = N / 64; int kb, nb;
    if ((nblk & 3) == 0) { const int w = item & 7, rest = item >> 3, q = nblk >> 2; nb = (rest % q) * 4 + (w & 3); kb = (rest / q) * 2 + (w >> 2); } else { kb = item / nblk; nb = item % nblk; }
    k0 = 64 * kb; n0 = 64 * nb; }
__device__ __forceinline__ void tr_load(const float* W, int N, const float* g1, const float* g2, int ksplit, int item, int lane, f32x4 (&wv)[16], f32x4 (&gq)[4]) {
    int k0, n0; tr_coords(N, item, k0, n0);
    const int kb = k0 + 16 * (lane >> 4);
    const GAS float* wp = (const GAS float*)W + (size_t)kb * N + n0 + 4 * (lane & 15);
#pragma unroll
    for (int i = 0; i < 16; ++i) wv[i] = *(const GAS f32x4*)(wp + (size_t)i * N);
    if (g1) { const GAS float* gp = (const GAS float*)(kb < ksplit ? g1 + kb : g2 + (kb - ksplit));
#pragma unroll
        for (int j = 0; j < 4; ++j) gq[j] = *(const GAS f32x4*)(gp + 4 * j); }
    else {
#pragma unroll
        for (int j = 0; j < 4; ++j) gq[j] = (f32x4){1.f, 1.f, 1.f, 1.f}; }
}
constexpr int TRS = 66;
template <class RowMap>
__device__ __forceinline__ void tr_emit(int K, int N, bf16* WT, RowMap rm, LAS float* scr, int item, int lane, const f32x4 (&wv)[16], const f32x4 (&gq)[4]) {
    int k0, n0; tr_coords(N, item, k0, n0);
    LAS float* wr_ = scr + (16 * (lane >> 4)) * TRS + 4 * (lane & 15);
#pragma unroll
    for (int i = 0; i < 16; ++i) { const float gg = gq[i >> 2][i & 3]; const f32x4 v = wv[i] * gg;
        *(LAS f32x2*)(wr_ + i * TRS) = (f32x2){v[0], v[1]}; *(LAS f32x2*)(wr_ + i * TRS + 2) = (f32x2){v[2], v[3]}; }
    LDS_WAIT(); asm volatile("" ::: "memory");
    const int c = lane & 7;
#pragma unroll
    for (int j = 0; j < 8; ++j) { const int nl = (lane >> 3) + 8 * j; const LAS float* s = scr + (8 * c) * TRS + nl;
        v4u o; o.x = pg8::cvt_pk_bf16(s[0 * TRS], s[1 * TRS]); o.y = pg8::cvt_pk_bf16(s[2 * TRS], s[3 * TRS]); o.z = pg8::cvt_pk_bf16(s[4 * TRS], s[5 * TRS]); o.w = pg8::cvt_pk_bf16(s[6 * TRS], s[7 * TRS]);
        *(GAS v4u*)(WT + (size_t)rm(n0 + nl) * K + k0 + 8 * c) = o; }
    LDS_WAIT(); asm volatile("" ::: "memory");
}
template <class RowMap>
__device__ __forceinline__ void transpose_range(const float* W, int K, int N, bf16* WT, const float* g1, const float* g2, int ksplit, RowMap rm, LAS float* scr, int first, int last, int stride, int lane) {
    if (first >= last) return;
    f32x4 wa[16], wb[16], ga[4], gb[4];
    int it = first; tr_load(W, N, g1, g2, ksplit, it, lane, wa, ga);
#pragma unroll 1
    for (;;) {
        const int n1 = it + stride; const bool h1 = n1 < last;
        if (h1) tr_load(W, N, g1, g2, ksplit, n1, lane, wb, gb);
        tr_emit(K, N, WT, rm, scr, it, lane, wa, ga);
        if (!h1) break;
        const int n2 = n1 + stride; const bool h2 = n2 < last;
        if (h2) tr_load(W, N, g1, g2, ksplit, n2, lane, wa, ga);
        tr_emit(K, N, WT, rm, scr, n1, lane, wb, gb);
        if (!h2) break;
        it = n2;
    }
}
struct RmId  { __device__ __forceinline__ int operator()(int n) const { return n; } };
struct RmWin { __device__ __forceinline__ int operator()(int n) const { if (n < 2944) return n; if (n < 3456) return n + 128; const int i = n - 3456; return 3584 + (i < 32 ? 2 * i : 2 * (i - 32) + 1); } };
struct RmQ   { __device__ __forceinline__ int operator()(int n) const { const int r = n % 192, hb = n - r; if (r < 128) return n; const int i = r - 128; return hb + 128 + (i < 32 ? 2 * i : 2 * (i - 32) + 1); } };
struct RmKV  { __device__ __forceinline__ int operator()(int n) const { const int h = n >> 8, c = n & 255; return c < 128 ? h * 128 + c : 2048 + h * 128 + (c - 128); } };
struct RmUp  { __device__ __forceinline__ int operator()(int n) const { return (n >> 7) * 256 + (n & 127); } };
struct RmGate{ __device__ __forceinline__ int operator()(int n) const { return (n >> 7) * 256 + 128 + (n & 127); } };

__device__ __forceinline__ void sincos_d(double a, double& s, double& c) {
    const double kd = __builtin_rint(a * 0.63661977236758134308); const long k = (long)kd;
    double r = __builtin_fma(-kd, 1.57079632679489655800e+00, a); r = __builtin_fma(-kd, 6.12323399573676603587e-17, r);
    const double r2 = r * r;
    double sp = 1.0 / 6227020800.0; sp = sp * r2 - 1.0 / 39916800.0; sp = sp * r2 + 1.0 / 362880.0; sp = sp * r2 - 1.0 / 5040.0; sp = sp * r2 + 1.0 / 120.0; sp = sp * r2 - 1.0 / 6.0; sp = sp * r2 * r + r;
    double cp = 1.0 / 479001600.0; cp = cp * r2 - 1.0 / 3628800.0; cp = cp * r2 + 1.0 / 40320.0; cp = cp * r2 - 1.0 / 720.0; cp = cp * r2 + 1.0 / 24.0; cp = cp * r2 - 0.5; cp = cp * r2 + 1.0;
    const int q = (int)(k & 3);
    s = (q == 0) ? sp : (q == 1) ? cp : (q == 2) ? -sp : -cp;
    c = (q == 0) ? cp : (q == 1) ? -sp : (q == 2) ? -cp : sp;
}

__device__ __forceinline__ void ssm_weights_group(int g, const float* a_re, const float* a_im, const float* b_re, const float* b_im, const float* c_re, const float* c_im,
                                                  const float* log_dt, const float* dskip, bf16* W1t, bf16* W2t, LAS float* L, int tid) {
    LAS float* PW = L;
    LAS float* BB = PW + 2 * 17 * 64 * 2;
    LAS float* CC = BB + 2 * 64 * 16 * 2;
    LAS float* KT = CC + 2 * 16 * 64 * 2;
    for (int i = tid; i < 2 * 17 * 64; i += 512) { const int d = i / (17 * 64), e = (i / 64) % 17, p = i & 63;
        const double dt = exp((double)log_dt[d * 128 + g]); const double are = a_re[(d * 128 + g) * 64 + p], aim = a_im[(d * 128 + g) * 64 + p];
        const double mag = exp((double)e * dt * are); double s, c; sincos_d((double)e * dt * aim, s, c);
        PW[i * 2] = (float)(mag * c); PW[i * 2 + 1] = (float)(mag * s); }
    for (int i = tid; i < 2 * 64 * 16; i += 512) { const int d = i / 1024, p = (i >> 4) & 63, h = i & 15;
        const double dt = exp((double)log_dt[d * 128 + g]); const double are = a_re[(d * 128 + g) * 64 + p], aim = a_im[(d * 128 + g) * 64 + p];
        const double x = dt * are, y = dt * aim; double sy, cy, sh, ch; sincos_d(y, sy, cy); sincos_d(0.5 * y, sh, ch);
        const double em1 = expm1(x); const double re1 = em1 * cy - 2.0 * sh * sh, im1 = (em1 + 1.0) * sy;
        const double den = are * are + aim * aim; const double qre = (re1 * are + im1 * aim) / den, qim = (im1 * are - re1 * aim) / den;
        const size_t bi = ((size_t)((d * 128 + g) * 64 + p)) * 16 + h; const double br = b_re[bi], bim = b_im[bi];
        BB[i * 2] = (float)(qre * br - qim * bim); BB[i * 2 + 1] = (float)(qre * bim + qim * br); }
    for (int i = tid; i < 2 * 16 * 64; i += 512) { const int d = i / 1024, h = (i >> 6) & 15, p = i & 63; const size_t ci = ((size_t)((d * 128 + g) * 16 + h)) * 64 + p;
        CC[i * 2] = c_re[ci]; CC[i * 2 + 1] = c_im[ci]; }
    __syncthreads();
    { const int d = tid >> 8, e = (tid >> 4) & 15, h = tid & 15; float acc[16];
#pragma unroll
        for (int q = 0; q < 16; ++q) acc[q] = 0.f;
        for (int p = 0; p < 64; ++p) { const float cr = CC[((d * 16 + h) * 64 + p) * 2], ci = CC[((d * 16 + h) * 64 + p) * 2 + 1];
            const float pr = PW[((d * 17 + e) * 64 + p) * 2], pi = PW[((d * 17 + e) * 64 + p) * 2 + 1];
            const float tr = cr * pr - ci * pi, ti = cr * pi + ci * pr; const LAS f32x4* bp = (const LAS f32x4*)(BB + ((d * 64 + p) * 16) * 2);
#pragma unroll
            for (int q = 0; q < 8; ++q) { const f32x4 b = bp[q]; acc[2 * q] += tr * b[0] - ti * b[1]; acc[2 * q + 1] += tr * b[2] - ti * b[3]; } }
#pragma unroll
        for (int q = 0; q < 16; ++q) KT[((d * 16 + e) * 16 + h) * 16 + q] = acc[q]; }
    __syncthreads();
    for (int i = tid; i < 256 * 32; i += 512) { const int n = i >> 5, k0 = (i & 31) * 8; const int d = n >> 7, im = (n >> 6) & 1, p = n & 63; const int s = k0 >> 4, h0 = k0 & 15, e = d ? s : 15 - s;
        const float pr = PW[((d * 17 + e) * 64 + p) * 2], pi = PW[((d * 17 + e) * 64 + p) * 2 + 1]; float v[8];
#pragma unroll
        for (int j = 0; j < 8; ++j) { const float br = BB[((d * 64 + p) * 16 + h0 + j) * 2], bi = BB[((d * 64 + p) * 16 + h0 + j) * 2 + 1]; v[j] = im ? (pr * bi + pi * br) : (pr * br - pi * bi); }
        v4u o; o.x = pk2(v[0], v[1]); o.y = pk2(v[2], v[3]); o.z = pk2(v[4], v[5]); o.w = pk2(v[6], v[7]);
        *(GAS v4u*)(W1t + ((size_t)(g * 256 + n)) * 256 + k0) = o; }
    for (int i = tid; i < 256 * 64; i += 512) { const int n = i >> 6, k0 = (i & 63) * 8; const int j = n >> 4, h = n & 15; float v[8];
        if (k0 < 256) { const int d = k0 >> 7, im = (k0 >> 6) & 1, p0 = k0 & 63, e = d ? 16 - j : j + 1;
#pragma unroll
            for (int q = 0; q < 8; ++q) { const int p = p0 + q; const float cr = CC[((d * 16 + h) * 64 + p) * 2], ci = CC[((d * 16 + h) * 64 + p) * 2 + 1];
                const float pr = PW[((d * 17 + e) * 64 + p) * 2], pi = PW[((d * 17 + e) * 64 + p) * 2 + 1]; v[q] = im ? -(cr * pi + ci * pr) : (cr * pr - ci * pi); }
        } else { const int s = (k0 - 256) >> 4, h0 = (k0 - 256) & 15;
#pragma unroll
            for (int q = 0; q < 8; ++q) { const int hh = h0 + q; float val = 0.f;
                if (s <= j) val += KT[((0 * 16 + (j - s)) * 16 + h) * 16 + hh];
                if (s >= j) val += KT[((1 * 16 + (s - j)) * 16 + h) * 16 + hh];
                if (s == j && h == hh) val += dskip[g * 16 + h];
                v[q] = val; } }
        v4u o; o.x = pk2(v[0], v[1]); o.y = pk2(v[2], v[3]); o.z = pk2(v[4], v[5]); o.w = pk2(v[6], v[7]);
        *(GAS v4u*)(W2t + ((size_t)(g * 256 + n)) * 512 + k0) = o; }
    __syncthreads();
}
#ifndef PROBE_ATTN
#define PROBE_ATTN 1
#endif
#ifndef PROBE_P0
#define PROBE_P0 1
#endif
#ifndef PROBE_P1
#define PROBE_P1 1
#endif
#ifndef PROBE_P7
#define PROBE_P7 1
#endif
#ifndef PROBE_FA
#define PROBE_FA 1
#endif

struct Args { const float* in[27]; float* out; unsigned char* ws; int ph_lo, ph_hi; };

__global__ void __launch_bounds__(NWAVES * 64, 2) enc_fwd(Args args) {
    extern __shared__ __attribute__((aligned(16))) unsigned char lds[];
    LAS unsigned char* ldsb = (LAS unsigned char*)lds;
    volatile LAS unsigned* MISC = (volatile LAS unsigned*)(ldsb + MISC_OFF);
    const int wave0 = __builtin_amdgcn_readfirstlane(threadIdx.x >> 6);
    const int G = gridDim.x, bx = blockIdx.x; const int vcu = (G % 8 == 0) ? (bx % 8) * (G / 8) + bx / 8 : bx;
    const int NGW = G * NWAVES, NGT = G * NWAVES * 64;
    gu32* ctl = (gu32*)(args.ws + WS_CTL);
#define PHB unsigned char* wsl = args.ws; unsigned char* outl = (unsigned char*)args.out; asm volatile("" : "+s"(wsl), "+s"(outl)); \
    int tid = wave0 * 64 + (int)__builtin_amdgcn_mbcnt_hi(~0u, __builtin_amdgcn_mbcnt_lo(~0u, 0u)); asm volatile("" : "+v"(tid)); const int lane = tid & 63, wave = wave0; \
    const int gw = vcu * NWAVES + wave, gt = vcu * (NWAVES * 64) + tid; (void)lane; (void)gw; (void)gt; (void)wsl; (void)outl
#define x_p (args.in[0])
#define x_s (args.in[1])
#define rstd_x ((float*)(wsl + WS_RSTDX))
#define rstd_q ((float*)(wsl + WS_RSTDQ))
#define rstd_kv ((float*)(wsl + WS_RSTDKV))
#define r2v ((float*)(wsl + WS_R2))
#define ratio ((float*)(wsl + WS_RATIO))
#define rstd_x1 ((float*)(wsl + WS_RSTDX1))
#define stA ((float*)(wsl + WS_STA))
#define stB ((float*)(wsl + WS_STB))
#define stQ ((float*)(wsl + WS_STQ))
#define stKV ((float*)(wsl + WS_STKV))
#define ropetab ((float*)(wsl + WS_ROPE))
#define Wi ((bf16*)(wsl + WS_WIN))
#define Wglu ((bf16*)(wsl + WS_WGLU))
#define Wq ((bf16*)(wsl + WS_WQ))
#define Wkv ((bf16*)(wsl + WS_WKV))
#define Wout ((bf16*)(wsl + WS_WOUT))
#define Wug ((bf16*)(wsl + WS_WUG))
#define Wdn ((bf16*)(wsl + WS_WDN))
#define W1t ((bf16*)(wsl + WS_W1T))
#define W2t ((bf16*)(wsl + WS_W2T))
#define bufA ((bf16*)(wsl + WS_A))
#define bufB ((bf16*)(wsl + WS_B))
#define qlat ((bf16*)(wsl + WS_QLAT))
#define kvlat ((bf16*)(wsl + WS_KVLAT))
#define krope ((bf16*)(wsl + WS_KROPE))
#define gact ((bf16*)(wsl + WS_GACT))
#define hup ((bf16*)(wsl + WS_HUP))
#define hgate ((bf16*)(wsl + WS_HGATE))
#define X ((bf16*)(outl + OUT_X))
#define mrg ((bf16*)(outl + OUT_X))
#define kvb ((bf16*)(outl + OUT_KV))
#define vtb ((bf16*)(outl + OUT_KV) + (size_t)T * 2048)
#define xoutf ((float*)outl)
    for (int u = threadIdx.x; u < (LDS_BYTES - LDSCTL_OFF) / 4; u += NWAVES * 64) ((LAS unsigned*)(ldsb + LDSCTL_OFF))[u] = 0u;
    __syncthreads();
    XcdBarrier bar = xcd_barrier_post((unsigned*)(ctl + CW_BAR), MISC + 8);
    const int lo = args.ph_lo, hi = args.ph_hi;
#ifndef PHMASK
#define PHMASK 0xfffffffu
#endif
#define IN(k) (((PHMASK >> ((k) < 9 ? (k) : ((k) >= 18 ? 12 : 9 + ((k) - 9) % 3))) & 1u) && lo <= (k) && (k) < hi)
#define SEAM(k) do { if (IN(k) && IN((k) + 1)) xcd_barrier(bar); } while (0)

#pragma unroll 1
    for (int rep = 0; rep < PROBE_P0; ++rep)
    if (IN(0)) {
        PHB;
        if (rep) __syncthreads();
        if (vcu < 128) ssm_weights_group(vcu, args.in[4], args.in[5], args.in[6], args.in[7], args.in[8], args.in[9], args.in[10], args.in[11], W1t, W2t, (LAS float*)ldsb, tid);
        LAS float* scr = (LAS float*)(ldsb + wave * (64 * TRS * 4));
        constexpr int I_IN = 64 * 55, I_GLU = 32 * 32, I_Q = 14 * 48, I_KV = 8 * 64, I_OUT = 64 * 64, I_UP = 64 * 172, I_DN = 172 * 64;
#define TR_M(off, W_, K_, N_, WT_, G1, G2, KS, RM, CNT) transpose_range(W_, K_, N_, WT_, G1, G2, KS, RM, scr, ((gw - (off)) % NGW + NGW) % NGW, CNT, NGW, lane)
        TR_M(0, args.in[2], 4096, 3520, Wi, args.in[3], args.in[3], 4096, RmWin(), I_IN);
        TR_M(I_IN, args.in[12], 2048, 2048, Wglu, nullptr, nullptr, 0, RmId(), I_GLU);
        TR_M(I_IN + I_GLU, args.in[14], 896, 3072, Wq, args.in[13], args.in[13], 896, RmQ(), I_Q);
        TR_M(I_IN + I_GLU + I_Q, args.in[16], 512, 4096, Wkv, args.in[15], args.in[15], 512, RmKV(), I_KV);
        TR_M(I_IN + I_GLU + I_Q + I_KV, args.in[19], 4096, 4096, Wout, args.in[17], args.in[18], 2048, RmId(), I_OUT);
        TR_M(I_IN + I_GLU + I_Q + I_KV + I_OUT, args.in[21], 4096, 11008, Wug, args.in[20], args.in[20], 4096, RmUp(), I_UP);
        TR_M(I_IN + I_GLU + I_Q + I_KV + I_OUT + I_UP, args.in[22], 4096, 11008, Wug, args.in[20], args.in[20], 4096, RmGate(), I_UP);
        TR_M(I_IN + I_GLU + I_Q + I_KV + I_OUT + 2 * I_UP, args.in[25], 11008, 4096, Wdn, nullptr, nullptr, 0, RmId(), I_DN);
#undef TR_M
        for (int i = gt; i < 320 * 512; i += NGT) { const int rr = i >> 9, c8 = (i & 511) * 8; const int row = rr < 128 ? 2944 + rr : 3648 + (rr - 128);
            *(GAS v4u*)(Wi + (size_t)row * 4096 + c8) = (v4u){0u, 0u, 0u, 0u}; }
        for (int m = gw; m < T; m += 2 * NGW) {
            const int m1 = m + NGW; const bool h1 = m1 < T;
            const float* xr0 = m < 16384 ? x_p + (size_t)m * DM : x_s + (size_t)(m - 16384) * DM; const float* xr1 = !h1 ? xr0 : (m1 < 16384 ? x_p + (size_t)m1 * DM : x_s + (size_t)(m1 - 16384) * DM);
            f32x4 v[16], w[16]; float s = 0.f, s1 = 0.f;
#pragma unroll
            for (int j = 0; j < 16; ++j) v[j] = *((const GAS f32x4*)xr0 + lane + 64 * j);
#pragma unroll
            for (int j = 0; j < 16; ++j) w[j] = *((const GAS f32x4*)xr1 + lane + 64 * j);
#pragma unroll
            for (int j = 0; j < 16; ++j) s += (v[j].x * v[j].x + v[j].y * v[j].y) + (v[j].z * v[j].z + v[j].w * v[j].w);
            s = wave_sum(s); if (lane == 0) rstd_x[m] = 1.0f / sqrtf(s * (1.0f / DM) + EPS);
            { GAS v2u* o8 = (GAS v2u*)(bufA + (size_t)m * DM) + lane;
#pragma unroll
              for (int j = 0; j < 16; ++j) o8[64 * j] = (v2u){pg8::cvt_pk_bf16(v[j].x, v[j].y), pg8::cvt_pk_bf16(v[j].z, v[j].w)}; }
            if (h1) {
#pragma unroll
                for (int j = 0; j < 16; ++j) s1 += (w[j].x * w[j].x + w[j].y * w[j].y) + (w[j].z * w[j].z + w[j].w * w[j].w);
                s1 = wave_sum(s1); if (lane == 0) rstd_x[m1] = 1.0f / sqrtf(s1 * (1.0f / DM) + EPS);
                GAS v2u* o8 = (GAS v2u*)(bufA + (size_t)m1 * DM) + lane;
#pragma unroll
                for (int j = 0; j < 16; ++j) o8[64 * j] = (v2u){pg8::cvt_pk_bf16(w[j].x, w[j].y), pg8::cvt_pk_bf16(w[j].z, w[j].w)}; } }
        for (int i = gt; i < 8192 * 32; i += NGT) { const int pos = i >> 5, k = i & 31; const double inv = exp(-(double)k * (9.210340371976184 / 32.0));
            double s, c; sincos_d((double)pos * inv, s, c); *(GAS f32x2*)(ropetab + (size_t)i * 2) = (f32x2){(float)c, (float)s}; }
    }
    SEAM(0);

#pragma unroll 1
    for (int rep = 0; rep < PROBE_P1; ++rep)
    if (IN(1)) {
        PHB;
        pg8::Gemm g{bufA, Wi, DM, DM, DM}; pg8::StaticOrder S; S.init(T, 3840, G, bx);
        pg8::EpiWin E{rstd_x, X, qlat, kvlat, krope, stQ, stKV, ropetab};
        pg8::gemm_phase(ldsb, g, S, E, tid);
    }
    SEAM(1);

    if (IN(2)) {
        PHB;
        pg8::Gemm g{X + 256, W1t, 512, 256, 256}; pg8::GroupOrder S{768, 6, G, bx};
        pg8::EpiSsm1 E{X};
        pg8::gemm_phase(ldsb, g, S, E, tid);
        for (int r = gt; r < T; r += NGT) { float s = 0.f;
#pragma unroll
            for (int j = 0; j < 4; ++j) { const f32x4 v = *(const GAS f32x4*)(stQ + (size_t)r * 16 + 4 * j); s += (v.x + v.y) + (v.z + v.w); }
            rstd_q[r] = 1.0f / sqrtf(s * (1.0f / QLAT) + EPS); float s2 = 0.f;
#pragma unroll
            for (int j = 0; j < 2; ++j) { const f32x4 v = *(const GAS f32x4*)(stKV + (size_t)r * 8 + 4 * j); s2 += (v.x + v.y) + (v.z + v.w); }
            rstd_kv[r] = 1.0f / sqrtf(s2 * (1.0f / KVLAT) + EPS); }
    }
    SEAM(2);

    if (IN(3)) {
        PHB;
        const bool scan_cu = (G == 256) ? ((vcu & 1) == 0) : true;
        if (G == 256 ? scan_cu : (wave < 4)) { const int task = (G == 256) ? (vcu >> 1) * 8 + wave : vcu * 4 + wave;
            if (task < 1024) { const int seq = task >> 8, g = (task >> 1) & 127, dir = task & 1, p = lane;
                const int c0 = seq < 2 ? seq * 512 : 1024 + (seq - 2) * 256, nc = seq < 2 ? 512 : 256;
                const double dt = exp((double)args.in[10][dir * 128 + g]); const double are = args.in[4][(dir * 128 + g) * 64 + p], aim = args.in[5][(dir * 128 + g) * 64 + p];
                const double mag = exp(16.0 * dt * are); double sn, cs; sincos_d(16.0 * dt * aim, sn, cs);
                const float ar = (float)(mag * cs), ai = (float)(mag * sn);
                GAS bf16* Xg = (GAS bf16*)X + (size_t)g * NCHUNK * 512 + dir * 128 + p;
                float zr = 0.f, zi = 0.f;
                for (int cb = 0; cb < nc; cb += 16) {
                    unsigned short sre[16], sim[16];
#pragma unroll
                    for (int i = 0; i < 16; ++i) { const int c = dir ? (c0 + nc - 1 - (cb + i)) : (c0 + cb + i); sre[i] = Xg[(size_t)c * 512]; sim[i] = Xg[(size_t)c * 512 + 64]; }
#pragma unroll
                    for (int i = 0; i < 16; ++i) { const int c = dir ? (c0 + nc - 1 - (cb + i)) : (c0 + cb + i);
                        Xg[(size_t)c * 512] = (bf16)f2bf(zr); Xg[(size_t)c * 512 + 64] = (bf16)f2bf(zi);
                        const float sr = bf2f(sre[i]), si = bf2f(sim[i]); const float nr = ar * zr - ai * zi + sr, ni = ar * zi + ai * zr + si; zr = nr; zi = ni; }
                }
            }
        }
        __syncthreads();
        if (G == 256) { pg8::Gemm g{qlat, Wq, QLAT, QLAT, QLAT}; pg8::RangeOrder S{scan_cu ? (vcu >> 1) * 3 : 384 + (vcu >> 1) * 6, scan_cu ? 3 : 6, 12}; pg8::EpiQ E{rstd_q, bufB, ropetab}; pg8::gemm_phase(ldsb, g, S, E, tid); }
        else { pg8::Gemm g{qlat, Wq, QLAT, QLAT, QLAT}; pg8::StaticOrder S; S.init(T, QW, G, bx); pg8::EpiQ E{rstd_q, bufB, ropetab}; pg8::gemm_phase(ldsb, g, S, E, tid); }
        { pg8::Gemm g{kvlat, Wkv, KVLAT, KVLAT, KVLAT}; pg8::StaticOrder S; S.init(T, 2048, G, bx); pg8::EpiKV E{rstd_kv, kvb}; pg8::gemm_phase(ldsb, g, S, E, tid); }
        { pg8::Gemm g{Wkv + (size_t)2048 * KVLAT, kvlat, KVLAT, KVLAT, KVLAT}; pg8::StaticOrder S; S.init(2048, T, G, bx); pg8::EpiVT E{rstd_kv, vtb}; pg8::gemm_phase(ldsb, g, S, E, tid); }
    }
    SEAM(3);

    if (IN(4)) {
        PHB;
        pg8::Gemm g{X, W2t, 512, 512, 512}; pg8::GroupOrder S{768, 6, G, bx};
        pg8::EpiSsm2 E{gact};
        pg8::gemm_phase(ldsb, g, S, E, tid);
    }
    SEAM(4);

    if (IN(5)) {
        PHB;
#ifndef NO_GLU
        { pg8::Gemm g{gact, Wglu, MIXW, MIXW, MIXW}; pg8::StaticOrder S; S.init(T, MIXW, G, bx); pg8::EpiGlu E{gact, mrg, stA}; pg8::gemm_phase(ldsb, g, S, E, tid); }
#endif
#ifndef NO_ATTN
        const int xcd = vcu >> 5, cc = vcu & 31; const int nun = (G == 256) ? 6 : (1536 - bx + G - 1) / G;
#pragma unroll 1
        for (int i = 0; i < nun; ++i) {
            int bh, qb, seq, rowbase;
            if (G == 256) { if (i < 4) { bh = xcd * 4 + i; qb = cc; seq = 8192; } else { bh = xcd * 4 + 2 * (i - 4) + (cc >> 4); qb = cc & 15; seq = 4096; } }
            else { const int uidx = bx + i * G; if (uidx < 1024) { bh = uidx >> 5; qb = uidx & 31; seq = 8192; } else { const int v = uidx - 1024; bh = v >> 4; qb = v & 15; seq = 4096; } }
            const int b = bh >> 4, h = bh & 15; rowbase = (seq == 8192) ? b * 8192 : 16384 + b * 4096;
            __syncthreads();
            attn::attn_unit(bufB + (size_t)(rowbase + qb * 256) * QW + h * 192, kvb + (size_t)rowbase * 2048 + h * 128, vtb + (size_t)(h * 128) * T,
                            krope + (size_t)rowbase * 64, mrg + (size_t)(rowbase + qb * 256) * DM + 2048 + h * 128, stB + (size_t)(rowbase + qb * 256) * 16 + h, seq, rowbase, (char*)lds, wave0);
        }
#endif
    }
    SEAM(5);

    if (IN(6)) {
        PHB;
        for (int r = gt; r < T; r += NGT) { float s = 0.f;
#pragma unroll
            for (int j = 0; j < 8; ++j) { const f32x4 v = *(const GAS f32x4*)(stA + (size_t)r * 32 + 4 * j); s += (v.x + v.y) + (v.z + v.w); }
            const float r1 = 1.0f / sqrtf(s * (1.0f / MIXW) + EPS); float s2 = 0.f;
#pragma unroll
            for (int j = 0; j < 4; ++j) { const f32x4 v = *(const GAS f32x4*)(stB + (size_t)r * 16 + 4 * j); s2 += (v.x + v.y) + (v.z + v.w); }
            const float r2 = 1.0f / sqrtf(s2 * (1.0f / MIXW) + EPS); r2v[r] = r2; ratio[r] = r1 / r2; }
    }
    SEAM(6);

#pragma unroll 1
    for (int rep = 0; rep < PROBE_P7; ++rep)
    if (IN(7)) {
        PHB;
        pg8::Gemm g{mrg, Wout, DM, DM, DM}; pg8::StaticOrder S; S.init(T, DM, G, bx);
        pg8::EpiWout E{bufA, r2v, ratio, bufA, stA};
        pg8::gemm_phase(ldsb, g, S, E, tid);
    }
    SEAM(7);

    if (IN(8)) {
        PHB;
        for (int r = gt; r < T; r += NGT) { float s = 0.f;
#pragma unroll
            for (int j = 0; j < 16; ++j) { const f32x4 v = *(const GAS f32x4*)(stA + (size_t)r * 64 + 4 * j); s += (v.x + v.y) + (v.z + v.w); }
            rstd_x1[r] = 1.0f / sqrtf(s * (1.0f / DM) + EPS); }
    }
    SEAM(8);

#ifdef PROBE_DOWN
    if (IN(9)) { PHB;
#pragma unroll 1
        for (int ch = 0; ch < 3; ++ch) { pg8::Gemm g{bufB, Wdn, DFF, DFF, DFF}; pg8::StaticOrder S; S.init(8192, DM, G, bx); pg8::EpiNull E0; pg8::gemm_phase(ldsb, g, S, E0, tid); }
    }
#endif
#ifdef PROBE_KLOOP
    if (IN(9)) {
        PHB;
#pragma unroll 1
        for (int ch = 0; ch < 3; ++ch) { pg8::Gemm g{bufA + (size_t)(ch * 8192) * DM, Wug, DM, DM, DM}; pg8::StaticOrder S; S.init(8192, 2 * DFF, G, bx); pg8::EpiNull E0; pg8::gemm_phase(ldsb, g, S, E0, tid); }
    }
#endif
#pragma unroll 1
    for (int ch2 = 0; ch2 < 3 * PROBE_FA; ++ch2) {
        const int ch = ch2 / PROBE_FA; const bool lastrep = (ch2 % PROBE_FA) == PROBE_FA - 1;
        const int rb = ch * 8192;
        if (IN(9 + 3 * ch)) {
        PHB;
            pg8::Gemm g{bufA + (size_t)rb * DM, Wug, DM, DM, DM}; pg8::StaticOrder S; S.init(8192, 2 * DFF, G, bx);
            pg8::EpiFfnA E{rstd_x1, rb, bufB, hup, hgate, args.in[23], args.in[24]};
            pg8::gemm_phase(ldsb, g, S, E, tid);
        }
        SEAM(9 + 3 * ch);
        if (lastrep && IN(10 + 3 * ch)) {
        PHB;
            const float* cw = args.in[23]; const float* cb = args.in[24];
            for (int i = gt; i < 128 * 2 * (DFF / 8); i += NGT) { const int f0 = (i % (DFF / 8)) * 8, sw = i / (DFF / 8), strip = sw >> 1, which = sw & 1;
                const int lrow = strip * 64 + (which ? 63 : 0), grow = rb + lrow, pos = pos_of(grow), len = len_of(grow);
                v4u up0, up1, up2;
                if (which == 0) { up1 = *(const GAS v4u*)(hup + ((size_t)strip * 4 + 0) * DFF + f0); up2 = *(const GAS v4u*)(hup + ((size_t)strip * 4 + 1) * DFF + f0);
                    up0 = (pos == 0) ? (v4u){0u, 0u, 0u, 0u} : *(const GAS v4u*)(hup + ((size_t)(strip - 1) * 4 + 3) * DFF + f0); }
                else { up0 = *(const GAS v4u*)(hup + ((size_t)strip * 4 + 2) * DFF + f0); up1 = *(const GAS v4u*)(hup + ((size_t)strip * 4 + 3) * DFF + f0);
                    up2 = (pos == len - 1) ? (v4u){0u, 0u, 0u, 0u} : *(const GAS v4u*)(hup + ((size_t)(strip + 1) * 4 + 0) * DFF + f0); }
                const v4u gt4 = *(const GAS v4u*)(hgate + ((size_t)strip * 2 + which) * DFF + f0);
                unsigned ow[4];
#pragma unroll
                for (int k = 0; k < 4; ++k) { const int f = f0 + 2 * k;
                    const float a0 = bflo(up0[k]), a1 = bflo(up1[k]), a2 = bflo(up2[k]), b0 = bfhi(up0[k]), b1 = bfhi(up1[k]), b2 = bfhi(up2[k]);
                    const float c0 = cw[f] * a0 + cw[DFF + f] * a1 + cw[2 * DFF + f] * a2 + cb[f], c1 = cw[f + 1] * b0 + cw[DFF + f + 1] * b1 + cw[2 * DFF + f + 1] * b2 + cb[f + 1];
                    ow[k] = pk2(c0 * sigmoidf_fast(c0) * bflo(gt4[k]), c1 * sigmoidf_fast(c1) * bfhi(gt4[k])); }
                *(GAS v4u*)(bufB + (size_t)lrow * DFF + f0) = (v4u){ow[0], ow[1], ow[2], ow[3]}; }
        }
        if (lastrep) SEAM(10 + 3 * ch);
        if (lastrep && IN(11 + 3 * ch)) {
        PHB;
            pg8::Gemm g{bufB, Wdn, DFF, DFF, DFF}; pg8::StaticOrder S; S.init(8192, DM, G, bx);
            pg8::EpiDown E{bufA, rb, stA};
            pg8::gemm_phase(ldsb, g, S, E, tid);
        }
        if (lastrep) SEAM(11 + 3 * ch);
    }

    if (IN(18)) {
        PHB;
        const float* gf = args.in[26];
        for (int m = gw; m < T; m += NGW) { const float s = wave_sum(stA[(size_t)m * 64 + lane]); const float rs = 1.0f / sqrtf(s * (1.0f / DM) + EPS);
            const GAS v4u* xr = (const GAS v4u*)(bufA + (size_t)m * DM) + lane; GAS f32x4* orow = (GAS f32x4*)(xoutf + (size_t)m * DM) + 2 * lane; const GAS f32x4* gr = (const GAS f32x4*)gf + 2 * lane;
#pragma unroll
            for (int j = 0; j < 8; ++j) { const v4u w = xr[64 * j]; const f32x4 g0 = gr[128 * j], g1 = gr[128 * j + 1];
                orow[128 * j] = (f32x4){bflo(w.x) * rs * g0[0], bfhi(w.x) * rs * g0[1], bflo(w.y) * rs * g0[2], bfhi(w.y) * rs * g0[3]};
                orow[128 * j + 1] = (f32x4){bflo(w.z) * rs * g1[0], bfhi(w.z) * rs * g1[1], bflo(w.w) * rs * g1[2], bfhi(w.w) * rs * g1[3]}; } }
    }
#undef IN
#undef SEAM
}

constexpr int N_PHASES = 19;
extern "C" void kernel_launch(void* const* d_in, const int* in_sizes, int n_in, void* d_out, int out_size, void* d_ws, size_t ws_size, hipStream_t stream) {
    static int grid = 0;
    if (grid == 0) {
        if (n_in != 27 || out_size != T * DM || ws_size < WS_END) { fprintf(stderr, "kernel_launch: unexpected shapes (n_in %d out %d ws %zu)\n", n_in, out_size, ws_size); grid = -1; return; }
        int dev = 0, cus = 0, per_cu = 0;
        if (hipGetDevice(&dev) != hipSuccess || hipDeviceGetAttribute(&cus, hipDeviceAttributeMultiprocessorCount, dev) != hipSuccess) { grid = -1; return; }
        if (hipFuncSetAttribute((const void*)enc_fwd, hipFuncAttributeMaxDynamicSharedMemorySize, LDS_BYTES) != hipSuccess) { fprintf(stderr, "kernel_launch: hipFuncSetAttribute failed\n"); grid = -1; return; }
        if (hipOccupancyMaxActiveBlocksPerMultiprocessor(&per_cu, (const void*)enc_fwd, NWAVES * 64, LDS_BYTES) != hipSuccess || per_cu < 1) { fprintf(stderr, "kernel_launch: occupancy query says %d\n", per_cu); }
        (void)hipGetLastError();
        grid = cus;
    }
    if (grid < 0) return;
    if (hipMemsetAsync((char*)d_ws + WS_CTL, 0, CTL_ZERO_BYTES, stream) != hipSuccess) return;
    Args a{};
    for (int i = 0; i < 27; ++i) a.in[i] = (const float*)d_in[i];
    a.out = (float*)d_out; a.ws = (unsigned char*)d_ws;
#ifndef MK_N_LAUNCHES
#define MK_N_LAUNCHES 1
#endif
    if (MK_N_LAUNCHES == 1) { a.ph_lo = 0; a.ph_hi = N_PHASES; hipLaunchKernelGGL(enc_fwd, dim3(grid), dim3(NWAVES * 64), LDS_BYTES, stream, a); }
    else { for (int p = 0; p < N_PHASES; ++p) { a.ph_lo = p; a.ph_hi = p + 1; hipLaunchKernelGGL(enc_fwd, dim3(grid), dim3(NWAVES * 64), LDS_BYTES, stream, a); } }
    const hipError_t le = hipPeekAtLastError();
    if (le != hipSuccess) fprintf(stderr, "kernel_launch: launch failed: %s\n", hipGetErrorName(le));
}
```

```cpp
#include <hip/hip_runtime.h>
#include <hip/hip_bf16.h>
#include <cstdio>
#include <cstdint>

namespace pg8 {
#define PG8_LAS __attribute__((address_space(3)))
typedef unsigned short bf16_t;
typedef short bf16x8 __attribute__((ext_vector_type(8)));
typedef float f32x4 __attribute__((ext_vector_type(4)));
typedef float f32x2 __attribute__((ext_vector_type(2)));
typedef unsigned u32x4 __attribute__((ext_vector_type(4)));
typedef unsigned u32x2 __attribute__((ext_vector_type(2)));
constexpr int BM = 256, BK = 64, HALF = 128, HTB = HALF * BK * 2  , STAGE_BYTES = 8 * HTB, NXCD = 8, WGM = 8;

__host__ __device__ __forceinline__ int lds_byte(int r, int c) { const int st = (r >> 4) * 2 + (c >> 5), rr = r & 15, cc = c & 31, ob = rr * 64 + cc * 2; return st * 1024 + (ob ^ (((ob >> 9) & 1) << 5)); }
__host__ __device__ __forceinline__ void stage_rc(int b, int& R, int& C) { const int st = b / 1024, sb = b % 1024, swz = sb ^ (((sb >> 9) & 1) << 5); R = (st >> 1) * 16 + swz / 64; C = (st & 1) * 32 + (swz % 64) / 2; }
__host__ __device__ __forceinline__ int perm32(int rho) { const int n = rho >> 4, i = rho & 15; return 8 * (i >> 2) + 4 * n + (i & 3); }

struct Unit { int pm, pn; };
struct Gemm { const bf16_t* A; const bf16_t* Bt; int lda, ldb, K; };

struct StaticOrder {
    int nM, nN, nwg, G, c;
    __host__ __device__ void init(int M, int N, int G_, int c_) { nM = M / BM; nN = N / BM; nwg = nM * nN; G = G_; c = c_; }
    __host__ __device__ bool next(int i, Unit& u) const {
        const long L = (long)i * G + c; if (L >= nwg) return false;
        int wgid = (int)L; { const int q = nwg / NXCD, r = nwg % NXCD, xcd = wgid % NXCD, off = wgid / NXCD; wgid = (xcd < r ? xcd * (q + 1) : r * (q + 1) + (xcd - r) * q) + off; }
        const int nig = WGM * nN, gid = wgid / nig, fm = gid * WGM, gsz = (nM - fm) < WGM ? (nM - fm) : WGM;
        u.pm = fm + ((wgid % nig) % gsz); u.pn = (wgid % nig) / gsz; return true;
    }
};
struct ZeroOrder { int n, G, c; __host__ __device__ bool next(int i, Unit& u) const { const long L = (long)i * G + c; if (L >= n) return false; u.pm = 0; u.pn = 0; return true; } };
struct RangeOrder { int base, n, nN; __host__ __device__ bool next(int i, Unit& u) const { if (i >= n) return false; const int L = base + i; u.pm = L / nN; u.pn = L % nN; return true; } };
struct GroupOrder {
    int n, per, G, c;
    __host__ __device__ bool next(int i, Unit& u) const { const long L = (long)i * G + c; if (L >= n) return false; u.pm = (int)L; u.pn = (int)L / per; return true; }
};

__device__ __forceinline__ unsigned cvt_pk_bf16(float lo, float hi) { unsigned r; asm volatile("v_cvt_pk_bf16_f32 %0, %1, %2" : "=v"(r) : "v"(lo), "v"(hi)); return r; }
__device__ __forceinline__ u32x4 pack8(const f32x4 a, const f32x4 b) { u32x4 w; w.x = cvt_pk_bf16(a[0], a[1]); w.y = cvt_pk_bf16(a[2], a[3]); w.z = cvt_pk_bf16(b[0], b[1]); w.w = cvt_pk_bf16(b[2], b[3]); return w; }

template <class Epi, class Sched>
__device__ __forceinline__ void gemm_phase(PG8_LAS unsigned char* lds, const Gemm g, const Sched& S, const Epi& E, int tid_in) {
    int tid_l = tid_in; asm volatile("" : "+v"(tid_l));
    const int tid = tid_l, wid = __builtin_amdgcn_readfirstlane(tid >> 6), lane = tid & 63, wr = wid >> 2, wc = wid & 3, fr = lane & 15, fq = lane >> 4;
    const int K = g.K, nt = K / BK;
    unsigned voffA[2], voffB[2];
#pragma unroll
    for (int i = 0; i < 2; ++i) { int R, C; stage_rc(tid * 16 + i * 8192, R, C); const int Rb = Epi::PERM ? ((R & ~31) + perm32(R & 31)) : R;
        voffA[i] = (unsigned)(R * g.lda + C) * 2u; voffB[i] = (unsigned)(Rb * g.ldb + C) * 2u; }
    asm volatile("" : "+v"(voffA[0]), "+v"(voffA[1]), "+v"(voffB[0]), "+v"(voffB[1]));
    const size_t kstep = (size_t)(BK * 2);
    const size_t hstepA = (size_t)HALF * g.lda * 2, hstepB = (size_t)HALF * g.ldb * 2;
    const size_t tstepA = 2 * hstepA, tstepB = 2 * hstepB;
    const unsigned ldsw = (unsigned)wid * 1024u;
    const int aoff = lds_byte(wr * 64 + fr, fq * 8), boff = lds_byte(wc * 32 + fr, fq * 8);
#define PG8_SA(b, h) (((b) * 2 + (h)) * HTB)
#define PG8_SB(b, h) ((4 + (b) * 2 + (h)) * HTB)
#define PG8_STAGE(bufoff, gbase, voff) do { _Pragma("unroll") for (int _i = 0; _i < 2; ++_i) \
        __builtin_amdgcn_global_load_lds((const unsigned*)((const char*)(gbase) + (voff)[_i]), (PG8_LAS unsigned*)(lds + (bufoff) + ldsw + _i * 8192), 16, 0, 0); } while (0)
#define PG8_LDA(dst, b, h) do { _Pragma("unroll") for (int m = 0; m < 4; ++m) _Pragma("unroll") for (int k = 0; k < 2; ++k) dst[m][k] = *(const PG8_LAS bf16x8*)(lds + PG8_SA(b, h) + aoff + m * 2048 + k * 1024); } while (0)
#define PG8_LDB(dst, b, h) do { _Pragma("unroll") for (int n = 0; n < 2; ++n) _Pragma("unroll") for (int k = 0; k < 2; ++k) dst[n][k] = *(const PG8_LAS bf16x8*)(lds + PG8_SB(b, h) + boff + n * 2048 + k * 1024); } while (0)
#define PG8_MMA(ai, bj, At, Bt) do { __builtin_amdgcn_s_setprio(1); _Pragma("unroll") for (int m = 0; m < 4; ++m) _Pragma("unroll") for (int n = 0; n < 2; ++n) _Pragma("unroll") for (int k = 0; k < 2; ++k) \
        acc[ai][bj][m][n] = __builtin_amdgcn_mfma_f32_16x16x32_bf16(Bt[n][k], At[m][k], acc[ai][bj][m][n], 0, 0, 0); __builtin_amdgcn_s_setprio(0); } while (0)
#define PG8_WAIT_V(n) asm volatile("s_waitcnt vmcnt(" #n ")" ::: "memory")
#define PG8_WAIT_L(n) asm volatile("s_waitcnt lgkmcnt(" #n ")" ::: "memory")
#define PG8_BAR __builtin_amdgcn_s_barrier()
#define PG8_SCHED __builtin_amdgcn_sched_barrier(0)
    Unit cur, nxt; int ui = 0;
    if (!S.next(0, cur)) return;
    f32x4 acc[2][2][4][2];
#pragma unroll
    for (int a = 0; a < 2; ++a)
#pragma unroll
        for (int b = 0; b < 2; ++b)
#pragma unroll
            for (int m = 0; m < 4; ++m)
#pragma unroll
                for (int n = 0; n < 2; ++n) acc[a][b][m][n] = (f32x4){0.f, 0.f, 0.f, 0.f};
    bf16x8 At[4][2], B0[2][2], B1[2][2];
    const char* cA = (const char*)g.A + (size_t)cur.pm * tstepA; const char* cB = (const char*)g.Bt + (size_t)cur.pn * tstepB;
    PG8_STAGE(PG8_SB(0, 0), cB, voffB); PG8_STAGE(PG8_SB(0, 1), cB + hstepB, voffB); PG8_STAGE(PG8_SA(0, 0), cA, voffA); PG8_STAGE(PG8_SA(0, 1), cA + hstepA, voffA);
    if (wr == 1) PG8_BAR;
    PG8_WAIT_V(2); PG8_BAR;
    PG8_STAGE(PG8_SB(1, 0), cB + kstep, voffB); PG8_STAGE(PG8_SA(1, 0), cA + kstep, voffA); PG8_STAGE(PG8_SB(1, 1), cB + hstepB + kstep, voffB);
    PG8_WAIT_V(6); PG8_BAR;
    for (;;) {
        const bool has_next = S.next(ui + 1, nxt);
        const char* nA = has_next ? (const char*)g.A + (size_t)nxt.pm * tstepA : cA; const char* nB = has_next ? (const char*)g.Bt + (size_t)nxt.pn * tstepB : cB;
#pragma unroll 1
        for (int t = 0; t < nt; t += 2) {
            const bool last = (t == nt - 2);
            if constexpr (Epi::MIDK) { if (t == (nt >> 1)) E.midk(acc, cur, wr, fr); }
            const char* a1 = cA + (size_t)(t + 1) * kstep;
            const char* a2 = last ? nA : cA + (size_t)(t + 2) * kstep; const char* b2 = last ? nB : cB + (size_t)(t + 2) * kstep;
            const char* a3 = a2 + kstep; const char* b3 = b2 + kstep;
            PG8_LDB(B0, 0, 0); PG8_LDB(B1, 0, 1); PG8_SCHED; PG8_LDA(At, 0, 0); PG8_STAGE(PG8_SA(1, 1), a1 + hstepA, voffA);
            PG8_WAIT_V(8); PG8_WAIT_L(0); PG8_BAR; PG8_MMA(0, 0, At, B0); PG8_MMA(0, 1, At, B1); PG8_BAR; PG8_SCHED;
            PG8_LDA(At, 0, 1); PG8_STAGE(PG8_SB(0, 0), b2, voffB); PG8_STAGE(PG8_SB(0, 1), b2 + hstepB, voffB); PG8_STAGE(PG8_SA(0, 0), a2, voffA);
            PG8_WAIT_V(8); PG8_WAIT_L(0); PG8_BAR; PG8_MMA(1, 0, At, B0); PG8_MMA(1, 1, At, B1); PG8_BAR; PG8_SCHED;
            PG8_LDB(B0, 1, 0); PG8_LDB(B1, 1, 1); PG8_SCHED; PG8_LDA(At, 1, 0); PG8_STAGE(PG8_SA(0, 1), a2 + hstepA, voffA);
            PG8_WAIT_V(8); PG8_WAIT_L(0); PG8_BAR; PG8_MMA(0, 0, At, B0); PG8_MMA(0, 1, At, B1); PG8_BAR; PG8_SCHED;
            PG8_LDA(At, 1, 1); PG8_STAGE(PG8_SB(1, 0), b3, voffB); PG8_STAGE(PG8_SB(1, 1), b3 + hstepB, voffB); PG8_STAGE(PG8_SA(1, 0), a3, voffA);
            PG8_WAIT_V(8); PG8_WAIT_L(0); PG8_BAR; PG8_MMA(1, 0, At, B0); PG8_MMA(1, 1, At, B1); PG8_BAR; PG8_SCHED;
        }
        if (wr == 0) PG8_BAR;
        E(acc, cur, wr, wc, fr, fq);
        if (!has_next) break;
#pragma unroll
        for (int a = 0; a < 2; ++a)
#pragma unroll
            for (int b = 0; b < 2; ++b)
#pragma unroll
                for (int m = 0; m < 4; ++m)
#pragma unroll
                    for (int n = 0; n < 2; ++n) acc[a][b][m][n] = (f32x4){0.f, 0.f, 0.f, 0.f};
        cur = nxt; cA = nA; cB = nB; ++ui;
        if (wr == 1) PG8_BAR;
    }
    PG8_WAIT_V(0);
    PG8_BAR;
#undef PG8_SA
#undef PG8_SB
#undef PG8_STAGE
#undef PG8_LDA
#undef PG8_LDB
#undef PG8_MMA
#undef PG8_WAIT_V
#undef PG8_WAIT_L
#undef PG8_BAR
#undef PG8_SCHED
}
}

constexpr int T = 24576, DM = 4096, DFF = 11008;
constexpr int NCHUNK = T / 16;
constexpr int QLAT = 896, KVLAT = 512, QW = 3072, KVW = 4096, MIXW = 2048;
constexpr float EPS = 1e-6f;
__device__ __forceinline__ int pos_of(int r) { return r < 16384 ? (r & 8191) : (r & 4095); }
__device__ __forceinline__ int len_of(int r) { return r < 16384 ? 8192 : 4096; }

typedef unsigned short bf16;
#define GAS __attribute__((address_space(1)))
#define LAS __attribute__((address_space(3)))
typedef unsigned v4u __attribute__((ext_vector_type(4)));
typedef unsigned v2u __attribute__((ext_vector_type(2)));
typedef float f32x4 __attribute__((ext_vector_type(4)));
typedef float f32x2 __attribute__((ext_vector_type(2)));
typedef short bf16x8 __attribute__((ext_vector_type(8)));

__device__ __forceinline__ unsigned f2bf(float f) { unsigned u = __builtin_bit_cast(unsigned, f); return (u + 0x7fffu + ((u >> 16) & 1u)) >> 16; }
__device__ __forceinline__ unsigned pk2(float lo, float hi) { return f2bf(lo) | (f2bf(hi) << 16); }
__device__ __forceinline__ float bf2f(unsigned short b) { return __builtin_bit_cast(float, (unsigned)b << 16); }
__device__ __forceinline__ float bflo(unsigned w) { return __builtin_bit_cast(float, w << 16); }
__device__ __forceinline__ float bfhi(unsigned w) { return __builtin_bit_cast(float, w & 0xffff0000u); }
__device__ __forceinline__ float sigmoidf_fast(float x) { return __builtin_amdgcn_rcpf(1.0f + __builtin_amdgcn_exp2f(-1.4426950408889634f * x)); }
__device__ __forceinline__ float gelu_tanh(float y) { const float in = 1.5957691216057308f * (y + 0.044715f * y * y * y); return y * sigmoidf_fast(in); }

namespace pg8 {
#define EPI_ROWS const int row0 = u.pm * 256 + wr * 64 + fr
__device__ __forceinline__ float sq8(const f32x4 a, const f32x4 b) { return (a[0] * a[0] + a[1] * a[1]) + (a[2] * a[2] + a[3] * a[3]) + (b[0] * b[0] + b[1] * b[1]) + (b[2] * b[2] + b[3] * b[3]); }
__device__ __forceinline__ float red_fq(float s) { s += __shfl_xor(s, 16); s += __shfl_xor(s, 32); return s; }

__device__ __forceinline__ f32x4 rope4(const f32x4 v, const f32x4 cs) { f32x4 o; o[0] = v[0] * cs[0] - v[1] * cs[1]; o[1] = v[1] * cs[0] + v[0] * cs[1]; o[2] = v[2] * cs[2] - v[3] * cs[3]; o[3] = v[3] * cs[2] + v[2] * cs[3]; return o; }

#define LAUNDER(p) asm volatile("" : "+v"(p))
struct EpiNull { static constexpr bool PERM = true, MIDK = false;
    __device__ __forceinline__ void midk(f32x4 (&)[2][2][4][2], const Unit&, int, int) const {}
    __device__ __forceinline__ void operator()(const f32x4 (&acc)[2][2][4][2], const Unit& u, int wr, int wc, int fr, int fq) const {
#pragma unroll
        for (int ai = 0; ai < 2; ++ai)
#pragma unroll
            for (int bj = 0; bj < 2; ++bj)
                asm volatile("" :: "v"(acc[ai][bj][0][0]), "v"(acc[ai][bj][0][1]), "v"(acc[ai][bj][1][0]), "v"(acc[ai][bj][1][1]), "v"(acc[ai][bj][2][0]), "v"(acc[ai][bj][2][1]), "v"(acc[ai][bj][3][0]), "v"(acc[ai][bj][3][1]));
    } };
struct EpiWin {
    static constexpr bool PERM = true, MIDK = false;
    const float* rstd_x; bf16_t* X; bf16_t* qlat; bf16_t* kvlat; bf16_t* krope; float* stQ; float* stKV; const float* ropetab;
    __device__ __forceinline__ void midk(f32x4 (&)[2][2][4][2], const Unit&, int, int) const {}
    __device__ __forceinline__ void operator()(const f32x4 (&acc)[2][2][4][2], const Unit& u, int wr, int wc, int fr, int fq) const {
        EPI_ROWS; const int tile = u.pn;
        const GAS float* rsp = (const GAS float*)(rstd_x + row0); LAUNDER(rsp);
        if (tile < 8) {
            const int c0 = tile * 256 + wc * 32 + 8 * fq;
            GAS bf16_t* xp0 = (GAS bf16_t*)X + ((size_t)((c0 >> 4) * NCHUNK + (row0 >> 4)) * 512 + 256 + (row0 & 15) * 16 + (c0 & 15)); LAUNDER(xp0);
#pragma unroll
            for (int ai = 0; ai < 2; ++ai)
#pragma unroll
                for (int m = 0; m < 4; ++m) { const float rs = rsp[ai * 128 + m * 16];
#pragma unroll
                    for (int bj = 0; bj < 2; ++bj)
                        *(GAS u32x4*)(xp0 + ((size_t)(bj * 8) * NCHUNK + ai * 8 + m) * 512) = pack8(acc[ai][bj][m][0] * rs, acc[ai][bj][m][1] * rs); }
        } else if (tile < 14) {
            const bool isq = tile < 12; const int tl = isq ? tile - 8 : tile - 12; const int ld = isq ? QLAT : KVLAT;
            const int c0 = tl * 256 + wc * 32 + 8 * fq;
            GAS bf16_t* op = (GAS bf16_t*)(isq ? qlat : kvlat) + (size_t)row0 * ld + c0; GAS float* sp = (GAS float*)(isq ? stQ + (size_t)row0 * 16 : stKV + (size_t)row0 * 8) + tl * 4 + wc; LAUNDER(op); LAUNDER(sp);
#pragma unroll
            for (int ai = 0; ai < 2; ++ai)
#pragma unroll
                for (int m = 0; m < 4; ++m) { const float rs = rsp[ai * 128 + m * 16]; float ss = 0.f;
#pragma unroll
                    for (int bj = 0; bj < 2; ++bj) { const f32x4 v0 = acc[ai][bj][m][0] * rs, v1 = acc[ai][bj][m][1] * rs; ss += sq8(v0, v1);
                        if (c0 + bj * 128 < ld) *(GAS u32x4*)(op + (size_t)(ai * 128 + m * 16) * ld + bj * 128) = pack8(v0, v1); }
                    ss = red_fq(ss); if (fq == 0) sp[(size_t)(ai * 128 + m * 16) * (isq ? 16 : 8)] = ss; }
        } else {
            if (wc < 2) { const int c = wc * 32 + 8 * fq;
                GAS bf16_t* op = (GAS bf16_t*)krope + (size_t)row0 * 64 + c; LAUNDER(op);
#pragma unroll
                for (int ai = 0; ai < 2; ++ai)
#pragma unroll
                    for (int m = 0; m < 4; ++m) { const int row = row0 + ai * 128 + m * 16; const float rs = rsp[ai * 128 + m * 16]; const int pos = pos_of(row);
                        const f32x4 cs0 = *(const GAS f32x4*)((const GAS float*)ropetab + (size_t)pos * 64 + c), cs1 = *(const GAS f32x4*)((const GAS float*)ropetab + (size_t)pos * 64 + c + 4);
                        const f32x4 v0 = rope4(acc[ai][0][m][0] * rs, cs0), v1 = rope4(acc[ai][0][m][1] * rs, cs1);
                        *(GAS u32x4*)(op + (size_t)(ai * 128 + m * 16) * 64) = pack8(v0, v1); } }
        }
    }
};
struct EpiSsm1 {
    static constexpr bool PERM = true, MIDK = false;
    bf16_t* X;
    __device__ __forceinline__ void midk(f32x4 (&)[2][2][4][2], const Unit&, int, int) const {}
    __device__ __forceinline__ void operator()(const f32x4 (&acc)[2][2][4][2], const Unit& u, int wr, int wc, int fr, int fq) const {
        EPI_ROWS; GAS bf16_t* op = (GAS bf16_t*)X + (size_t)row0 * 512 + wc * 32 + 8 * fq; LAUNDER(op);
#pragma unroll
        for (int ai = 0; ai < 2; ++ai)
#pragma unroll
            for (int m = 0; m < 4; ++m)
#pragma unroll
                for (int bj = 0; bj < 2; ++bj) *(GAS u32x4*)(op + (size_t)(ai * 128 + m * 16) * 512 + bj * 128) = pack8(acc[ai][bj][m][0], acc[ai][bj][m][1]);
    }
};
struct EpiSsm2 {
    static constexpr bool PERM = true, MIDK = false;
    bf16_t* gact;
    __device__ __forceinline__ void midk(f32x4 (&)[2][2][4][2], const Unit&, int, int) const {}
    __device__ __forceinline__ void operator()(const f32x4 (&acc)[2][2][4][2], const Unit& u, int wr, int wc, int fr, int fq) const {
        EPI_ROWS; const int g = u.pn; const int c0 = wc * 32 + 8 * fq;
        GAS bf16_t* op = (GAS bf16_t*)gact + ((size_t)(row0 - g * NCHUNK) * 16 + (c0 >> 4)) * MIXW + g * 16 + (c0 & 15); LAUNDER(op);
#pragma unroll
        for (int ai = 0; ai < 2; ++ai)
#pragma unroll
            for (int m = 0; m < 4; ++m)
#pragma unroll
                for (int bj = 0; bj < 2; ++bj) { f32x4 v0 = acc[ai][bj][m][0], v1 = acc[ai][bj][m][1];
#pragma unroll
                    for (int e = 0; e < 4; ++e) { v0[e] = gelu_tanh(v0[e]); v1[e] = gelu_tanh(v1[e]); }
                    *(GAS u32x4*)(op + ((size_t)(ai * 128 + m * 16) * 16 + bj * 8) * MIXW) = pack8(v0, v1); }
    }
};
struct EpiQ {
    static constexpr bool PERM = true, MIDK = false;
    const float* rstd_q; bf16_t* q; const float* ropetab;
    __device__ __forceinline__ void midk(f32x4 (&)[2][2][4][2], const Unit&, int, int) const {}
    __device__ __forceinline__ void operator()(const f32x4 (&acc)[2][2][4][2], const Unit& u, int wr, int wc, int fr, int fq) const {
        EPI_ROWS; const GAS float* rsp = (const GAS float*)(rstd_q + row0); GAS bf16_t* op = (GAS bf16_t*)q + (size_t)row0 * QW + u.pn * 256 + wc * 32 + 8 * fq; LAUNDER(rsp); LAUNDER(op);
#pragma unroll
        for (int ai = 0; ai < 2; ++ai)
#pragma unroll
            for (int m = 0; m < 4; ++m) { const int row = row0 + ai * 128 + m * 16; const float rs = rsp[ai * 128 + m * 16] * 0.10411754627697264f;     const int pos = pos_of(row);
#pragma unroll
                for (int bj = 0; bj < 2; ++bj) { const int strip = 8 * u.pn + 4 * bj + wc, s6 = strip % 6;
                    f32x4 v0 = acc[ai][bj][m][0] * rs, v1 = acc[ai][bj][m][1] * rs;
                    if (s6 >= 4) { const int pc = (s6 - 4) * 32 + 8 * fq;
                        const f32x4 cs0 = *(const GAS f32x4*)((const GAS float*)ropetab + (size_t)pos * 64 + pc), cs1 = *(const GAS f32x4*)((const GAS float*)ropetab + (size_t)pos * 64 + pc + 4);
                        v0 = rope4(v0, cs0); v1 = rope4(v1, cs1); }
                    *(GAS u32x4*)(op + (size_t)(ai * 128 + m * 16) * QW + bj * 128) = pack8(v0, v1); } }
    }
};
struct EpiKV {
    static constexpr bool PERM = true, MIDK = false;
    const float* rstd_kv; bf16_t* kv;
    __device__ __forceinline__ void midk(f32x4 (&)[2][2][4][2], const Unit&, int, int) const {}
    __device__ __forceinline__ void operator()(const f32x4 (&acc)[2][2][4][2], const Unit& u, int wr, int wc, int fr, int fq) const {
        EPI_ROWS; const GAS float* rsp = (const GAS float*)(rstd_kv + row0); GAS bf16_t* op = (GAS bf16_t*)kv + (size_t)row0 * 2048 + u.pn * 256 + wc * 32 + 8 * fq; LAUNDER(rsp); LAUNDER(op);
#pragma unroll
        for (int ai = 0; ai < 2; ++ai)
#pragma unroll
            for (int m = 0; m < 4; ++m) { const float rs = rsp[ai * 128 + m * 16];
#pragma unroll
                for (int bj = 0; bj < 2; ++bj) *(GAS u32x4*)(op + (size_t)(ai * 128 + m * 16) * 2048 + bj * 128) = pack8(acc[ai][bj][m][0] * rs, acc[ai][bj][m][1] * rs); }
    }
};
struct EpiVT {
    static constexpr bool PERM = true, MIDK = false;
    const float* rstd_kv; bf16_t* vt;
    __device__ __forceinline__ void midk(f32x4 (&)[2][2][4][2], const Unit&, int, int) const {}
    __device__ __forceinline__ void operator()(const f32x4 (&acc)[2][2][4][2], const Unit& u, int wr, int wc, int fr, int fq) const {
        EPI_ROWS; const int c0 = u.pn * 256 + wc * 32 + 8 * fq; const GAS float* rsp = (const GAS float*)(rstd_kv + c0); GAS bf16_t* op = (GAS bf16_t*)vt + (size_t)row0 * T + c0; LAUNDER(rsp); LAUNDER(op);
        GAS bf16_t* opp = op - 8 * fq + 16 * (fq & 1) + 4 * (fq >> 1);
#pragma unroll
        for (int bj = 0; bj < 2; ++bj) { const f32x4 r0 = *(const GAS f32x4*)(rsp + bj * 128), r1 = *(const GAS f32x4*)(rsp + bj * 128 + 4);
#pragma unroll
            for (int ai = 0; ai < 2; ++ai)
#pragma unroll
                for (int m = 0; m < 4; ++m) { const u32x4 w = pack8(acc[ai][bj][m][0] * r0, acc[ai][bj][m][1] * r1); GAS bf16_t* q_ = opp + (size_t)(ai * 128 + m * 16) * T + bj * 128;
                    *(GAS u32x2*)q_ = (u32x2){w.x, w.y}; *(GAS u32x2*)(q_ + 8) = (u32x2){w.z, w.w}; } }
    }
};
struct EpiGlu {
    static constexpr bool PERM = true, MIDK = false;
    const bf16_t* gact; bf16_t* merged; float* stA;
    __device__ __forceinline__ void midk(f32x4 (&)[2][2][4][2], const Unit&, int, int) const {}
    __device__ __forceinline__ void operator()(const f32x4 (&acc)[2][2][4][2], const Unit& u, int wr, int wc, int fr, int fq) const {
        EPI_ROWS; const int c0 = u.pn * 256 + wc * 32 + 8 * fq;
        const GAS bf16_t* gp = (const GAS bf16_t*)gact + (size_t)row0 * MIXW + c0; GAS bf16_t* op = (GAS bf16_t*)merged + (size_t)row0 * DM + c0; GAS float* sp = (GAS float*)stA + (size_t)row0 * 32 + u.pn * 4 + wc; LAUNDER(gp); LAUNDER(op); LAUNDER(sp);
#pragma unroll
        for (int ai = 0; ai < 2; ++ai)
#pragma unroll
            for (int m = 0; m < 4; ++m) { float ss = 0.f;
#pragma unroll
                for (int bj = 0; bj < 2; ++bj) {
                    const u32x4 gw = *(const GAS u32x4*)(gp + (size_t)(ai * 128 + m * 16) * MIXW + bj * 128);
                    f32x4 v0, v1; const f32x4 a0 = acc[ai][bj][m][0], a1 = acc[ai][bj][m][1];
                    v0[0] = bflo(gw.x) * sigmoidf_fast(a0[0]); v0[1] = bfhi(gw.x) * sigmoidf_fast(a0[1]); v0[2] = bflo(gw.y) * sigmoidf_fast(a0[2]); v0[3] = bfhi(gw.y) * sigmoidf_fast(a0[3]);
                    v1[0] = bflo(gw.z) * sigmoidf_fast(a1[0]); v1[1] = bfhi(gw.z) * sigmoidf_fast(a1[1]); v1[2] = bflo(gw.w) * sigmoidf_fast(a1[2]); v1[3] = bfhi(gw.w) * sigmoidf_fast(a1[3]);
                    ss += sq8(v0, v1);
                    *(GAS u32x4*)(op + (size_t)(ai * 128 + m * 16) * DM + bj * 128) = pack8(v0, v1); }
                ss = red_fq(ss); if (fq == 0) sp[(size_t)(ai * 128 + m * 16) * 32] = ss; }
    }
};
struct EpiWout {
    static constexpr bool PERM = true, MIDK = true;
    const bf16_t* xb; const float* r2; const float* ratio; bf16_t* x1b; float* stA;
    __device__ __forceinline__ void midk(f32x4 (&acc)[2][2][4][2], const Unit& u, int wr, int fr) const {
        EPI_ROWS; const GAS float* rp = (const GAS float*)(ratio + row0); LAUNDER(rp);
#pragma unroll
        for (int ai = 0; ai < 2; ++ai)
#pragma unroll
            for (int m = 0; m < 4; ++m) { const float rt = rp[ai * 128 + m * 16];
#pragma unroll
                for (int bj = 0; bj < 2; ++bj)
#pragma unroll
                    for (int n = 0; n < 2; ++n) acc[ai][bj][m][n] *= rt; }
    }
    __device__ __forceinline__ void operator()(const f32x4 (&acc)[2][2][4][2], const Unit& u, int wr, int wc, int fr, int fq) const {
        EPI_ROWS; const int c0 = u.pn * 256 + wc * 32 + 8 * fq;
        const GAS float* rsp = (const GAS float*)(r2 + row0); const GAS bf16_t* bi = (const GAS bf16_t*)xb + (size_t)row0 * DM + c0; GAS bf16_t* bo = (GAS bf16_t*)x1b + (size_t)row0 * DM + c0;
        GAS float* sp = (GAS float*)stA + (size_t)row0 * 64 + u.pn * 4 + wc;
        LAUNDER(rsp); LAUNDER(bi); LAUNDER(bo); LAUNDER(sp);
#pragma unroll
        for (int ai = 0; ai < 2; ++ai)
#pragma unroll
            for (int m = 0; m < 4; ++m) { const float rs = rsp[ai * 128 + m * 16]; float ss = 0.f; const size_t ro = (size_t)(ai * 128 + m * 16) * DM;
#pragma unroll
                for (int bj = 0; bj < 2; ++bj) {
                    const u32x4 xr = *(const GAS u32x4*)(bi + ro + bj * 128);
                    const f32x4 v0 = (f32x4){bflo(xr.x), bfhi(xr.x), bflo(xr.y), bfhi(xr.y)} + acc[ai][bj][m][0] * rs, v1 = (f32x4){bflo(xr.z), bfhi(xr.z), bflo(xr.w), bfhi(xr.w)} + acc[ai][bj][m][1] * rs;
                    ss += sq8(v0, v1);
                    *(GAS u32x4*)(bo + ro + bj * 128) = pack8(v0, v1); }
                ss = red_fq(ss); if (fq == 0) sp[(size_t)(ai * 128 + m * 16) * 64] = ss; }
    }
};
__device__ __forceinline__ float dpp_ror1(float v) { return __builtin_bit_cast(float, __builtin_amdgcn_mov_dpp(__builtin_bit_cast(int, v), 0x121, 0xf, 0xf, false)); }
__device__ __forceinline__ float dpp_rol1(float v) { return __builtin_bit_cast(float, __builtin_amdgcn_mov_dpp(__builtin_bit_cast(int, v), 0x12f, 0xf, 0xf, false)); }
struct EpiFfnA {
    static constexpr bool PERM = true, MIDK = false;
    const float* rstd; int row_base; bf16_t* act; bf16_t* halo_up; bf16_t* halo_gate; const float* cw; const float* cb;
    __device__ __forceinline__ void midk(f32x4 (&)[2][2][4][2], const Unit&, int, int) const {}
    __device__ __forceinline__ void operator()(const f32x4 (&acc)[2][2][4][2], const Unit& u, int wr, int wc, int fr, int fq) const {
        EPI_ROWS; const int f0 = u.pn * 128 + wc * 32 + 8 * fq;
        const GAS float* rsp = (const GAS float*)(rstd + row_base + row0); GAS bf16_t* actp = (GAS bf16_t*)act + (size_t)row0 * DFF + f0;
        const int strip0 = u.pm * 4 + wr;
        GAS bf16_t* hup_p = (GAS bf16_t*)halo_up + (size_t)strip0 * 4 * DFF + f0; GAS bf16_t* hg_p = (GAS bf16_t*)halo_gate + (size_t)strip0 * 2 * DFF + f0;
        const GAS float* cwp = (const GAS float*)(cw + f0); const GAS float* cbp = (const GAS float*)(cb + f0);
        asm volatile("" : "+v"(rsp), "+v"(actp), "+v"(hup_p), "+v"(hg_p), "+v"(cwp), "+v"(cbp));
#pragma unroll
        for (int ai = 0; ai < 2; ++ai) {
            float rs[4];
#pragma unroll
            for (int m = 0; m < 4; ++m) rs[m] = rsp[ai * 128 + m * 16];
            u32x2 keep[4];
#pragma unroll
            for (int n = 0; n < 2; ++n) {
                const f32x4 w0 = *(const GAS f32x4*)(cwp + 4 * n), w1 = *(const GAS f32x4*)(cwp + DFF + 4 * n), w2 = *(const GAS f32x4*)(cwp + 2 * DFF + 4 * n), wb = *(const GAS f32x4*)(cbp + 4 * n);
                f32x4 res[4], Uu[4];
#pragma unroll
                for (int e = 0; e < 4; ++e) {
                    float U[4], R[4], L[4];
#pragma unroll
                    for (int m = 0; m < 4; ++m) { U[m] = acc[ai][0][m][n][e] * rs[m]; R[m] = dpp_ror1(U[m]); L[m] = dpp_rol1(U[m]); Uu[m][e] = U[m]; }
#pragma unroll
                    for (int m = 0; m < 4; ++m) {
                        const float prev = (fr == 0) ? R[m > 0 ? m - 1 : 0] : R[m];
                        const float next = (fr == 15) ? L[m < 3 ? m + 1 : 3] : L[m];
                        const float cv = w0[e] * prev + w1[e] * U[m] + w2[e] * next + wb[e];
                        res[m][e] = cv * sigmoidf_fast(cv) * (acc[ai][1][m][n][e] * rs[m]);
                    }
                }
#pragma unroll
                for (int m = 0; m < 4; ++m) {
                    const bool edge = (m == 0 && fr == 0) || (m == 3 && fr == 15);
                    { u32x2 w; w.x = cvt_pk_bf16(res[m][0], res[m][1]); w.y = cvt_pk_bf16(res[m][2], res[m][3]);
                      if (n == 0) keep[m] = w; else if (!edge) *(GAS u32x4*)(actp + (size_t)(ai * 128 + m * 16) * DFF) = (u32x4){keep[m].x, keep[m].y, w.x, w.y}; }
                    if (m == 0 || m == 3) {
                        const int hs = (m == 0) ? (fr == 0 ? 0 : (fr == 1 ? 1 : -1)) : (fr == 14 ? 2 : (fr == 15 ? 3 : -1));
                        if (hs >= 0) { u32x2 w; w.x = cvt_pk_bf16(Uu[m][0], Uu[m][1]); w.y = cvt_pk_bf16(Uu[m][2], Uu[m][3]);
                            *(GAS u32x2*)(hup_p + ((size_t)(ai * 2) * 4 + hs) * DFF + 4 * n) = w;
                            if (hs == 0 || hs == 3) { const f32x4 gv = acc[ai][1][m][n] * rs[m]; u32x2 wg; wg.x = cvt_pk_bf16(gv[0], gv[1]); wg.y = cvt_pk_bf16(gv[2], gv[3]);
                                *(GAS u32x2*)(hg_p + ((size_t)(ai * 2) * 2 + (hs == 3 ? 1 : 0)) * DFF + 4 * n) = wg; } }
                    }
                }
            }
        }
    }
};
struct EpiDown {
    static constexpr bool PERM = true, MIDK = false;
    bf16_t* xb; int row_base; float* stA;
    __device__ __forceinline__ void midk(f32x4 (&)[2][2][4][2], const Unit&, int, int) const {}
    __device__ __forceinline__ void operator()(const f32x4 (&acc)[2][2][4][2], const Unit& u, int wr, int wc, int fr, int fq) const {
        EPI_ROWS; GAS bf16_t* xo = (GAS bf16_t*)xb + (size_t)(row_base + row0) * DM + u.pn * 256 + wc * 32 + 8 * fq; GAS float* sp = (GAS float*)stA + (size_t)(row_base + row0) * 64 + u.pn * 4 + wc; LAUNDER(xo); LAUNDER(sp);
#pragma unroll
        for (int ai = 0; ai < 2; ++ai)
#pragma unroll
            for (int m = 0; m < 4; ++m) { float ss = 0.f; const size_t ro = (size_t)(ai * 128 + m * 16) * DM;
#pragma unroll
                for (int bj = 0; bj < 2; ++bj) { GAS bf16_t* p = xo + ro + bj * 128; const u32x4 w = *(const GAS u32x4*)p; const f32x4 a0 = acc[ai][bj][m][0], a1 = acc[ai][bj][m][1];
                    f32x4 v0, v1; v0[0] = bflo(w.x) + a0[0]; v0[1] = bfhi(w.x) + a0[1]; v0[2] = bflo(w.y) + a0[2]; v0[3] = bfhi(w.y) + a0[3];
                    v1[0] = bflo(w.z) + a1[0]; v1[1] = bfhi(w.z) + a1[1]; v1[2] = bflo(w.w) + a1[2]; v1[3] = bfhi(w.w) + a1[3];
                    ss += sq8(v0, v1); *(GAS u32x4*)p = pack8(v0, v1); }
                ss = red_fq(ss); if (fq == 0) sp[(size_t)(ai * 128 + m * 16) * 64] = ss; }
    }
};
#undef EPI_ROWS
}

namespace attn {
using f32x4v = __attribute__((ext_vector_type(4))) float;
using u32x2v = __attribute__((ext_vector_type(2))) unsigned;
using u32x4v = __attribute__((ext_vector_type(4))) unsigned;
constexpr int NW = 8, KVBLK = 64;
constexpr float SCALE = 0.07216878364870322f;
constexpr float THR = 8.f;
constexpr int LDQ = 3072, LDK = 2048, LDR = 64, LDVT = T, LDO = 4096;
constexpr int SHM_V = 128 * KVBLK * 2, SHM_K = KVBLK * 128 * 2, SHM_R = KVBLK * 64 * 2;
constexpr int OFF_V = 0, OFF_K = 2 * SHM_V, OFF_R = OFF_K + 2 * SHM_K, OFF_QR = OFF_R + 2 * SHM_R, SHM_ATTN = OFF_QR + NW * 4096;
#define SBAR() __builtin_amdgcn_sched_barrier(0)
#define PIN(x) asm volatile("" : "+v"(x))
__device__ __forceinline__ void glds16(const void* gsrc, unsigned lds_dst) { unsigned keep;
  asm volatile("s_mov_b32 %0, m0\n\ts_mov_b32 m0, %2\n\ts_nop 0\n\tglobal_load_lds_dwordx4 %1, off\n\ts_mov_b32 m0, %0" : "=&s"(keep) : "v"(gsrc), "s"(lds_dst) : "memory"); }
__device__ __forceinline__ unsigned cvtpk(float lo, float hi) { unsigned r; asm volatile("v_cvt_pk_bf16_f32 %0, %1, %2" : "=v"(r) : "v"(lo), "v"(hi)); return r; }
__device__ __forceinline__ float xmax16(float v) { auto r = __builtin_amdgcn_permlane16_swap(__float_as_uint(v), __float_as_uint(v), false, false); return fmaxf(__uint_as_float(r[0]), __uint_as_float(r[1])); }
__device__ __forceinline__ float xmax32(float v) { auto r = __builtin_amdgcn_permlane32_swap(__float_as_uint(v), __float_as_uint(v), false, false); return fmaxf(__uint_as_float(r[0]), __uint_as_float(r[1])); }
__device__ __forceinline__ float xsum16(float v) { auto r = __builtin_amdgcn_permlane16_swap(__float_as_uint(v), __float_as_uint(v), false, false); return __uint_as_float(r[0]) + __uint_as_float(r[1]); }
__device__ __forceinline__ float xsum32(float v) { auto r = __builtin_amdgcn_permlane32_swap(__float_as_uint(v), __float_as_uint(v), false, false); return __uint_as_float(r[0]) + __uint_as_float(r[1]); }
__device__ __forceinline__ float max3f(float a, float b, float c) { float r; asm("v_max3_f32 %0, %1, %2, %3" : "=v"(r) : "v"(a), "v"(b), "v"(c)); return r; }
#define MF16(A, B, C) __builtin_amdgcn_mfma_f32_16x16x32_bf16(A, B, C, 0, 0, 0)
struct Lane { const LAS char* Kl; const LAS char* Rl; const LAS char* Vl; const LAS char* qrl; int ky, rz, vz; };
template <int KB, int S> __device__ __forceinline__ bf16x8 kfrag(const Lane& L, int kst, int rst) {
  if constexpr (S < 4) return *(const LAS bf16x8*)(L.Kl + kst + KB * 4096 + ((64 * S) ^ L.ky));
  else return *(const LAS bf16x8*)(L.Rl + rst + KB * 2048 + ((64 * (S - 4)) ^ L.rz));
}
template <int DB, int C> __device__ __forceinline__ bf16x8 vfrag(const Lane& L, int vst) { return *(const LAS bf16x8*)(L.Vl + vst + DB * 2048 + ((64 * C) ^ L.rz)); }
template <int QB, int S> __device__ __forceinline__ bf16x8 qfrag(const bf16x8 (&qn)[2][6], const Lane& L) { return qn[QB][S]; }
template <int KB> __device__ __forceinline__ void qk_block_plain(f32x4v (&s)[2][4], const bf16x8 (&qn)[2][6], const Lane& L, int kst, int rst) {
  bf16x8 k = kfrag<KB, 0>(L, kst, rst); s[0][KB] = MF16(k, (qfrag<0, 0>(qn, L)), ((f32x4v){0.f, 0.f, 0.f, 0.f})); s[1][KB] = MF16(k, (qfrag<1, 0>(qn, L)), ((f32x4v){0.f, 0.f, 0.f, 0.f}));
  k = kfrag<KB, 1>(L, kst, rst); s[0][KB] = MF16(k, (qfrag<0, 1>(qn, L)), s[0][KB]); s[1][KB] = MF16(k, (qfrag<1, 1>(qn, L)), s[1][KB]);
  k = kfrag<KB, 2>(L, kst, rst); s[0][KB] = MF16(k, (qfrag<0, 2>(qn, L)), s[0][KB]); s[1][KB] = MF16(k, (qfrag<1, 2>(qn, L)), s[1][KB]);
  k = kfrag<KB, 3>(L, kst, rst); s[0][KB] = MF16(k, (qfrag<0, 3>(qn, L)), s[0][KB]); s[1][KB] = MF16(k, (qfrag<1, 3>(qn, L)), s[1][KB]);
  k = kfrag<KB, 4>(L, kst, rst); s[0][KB] = MF16(k, (qfrag<0, 4>(qn, L)), s[0][KB]); s[1][KB] = MF16(k, (qfrag<1, 4>(qn, L)), s[1][KB]);
  k = kfrag<KB, 5>(L, kst, rst); s[0][KB] = MF16(k, (qfrag<0, 5>(qn, L)), s[0][KB]); s[1][KB] = MF16(k, (qfrag<1, 5>(qn, L)), s[1][KB]);
}
template <int QB> __device__ __forceinline__ float rowmax(const f32x4v (&s)[2][4]) {
  float m = max3f(s[QB][0][0], s[QB][0][1], s[QB][0][2]); m = max3f(m, s[QB][0][3], s[QB][1][0]); m = max3f(m, s[QB][1][1], s[QB][1][2]); m = max3f(m, s[QB][1][3], s[QB][2][0]);
  m = max3f(m, s[QB][2][1], s[QB][2][2]); m = max3f(m, s[QB][2][3], s[QB][3][0]); m = max3f(m, s[QB][3][1], s[QB][3][2]); m = max3f(m, s[QB][3][3], s[QB][3][3]); return m;
}
constexpr float THRL = 11.541560327111707f;
__device__ __forceinline__ void decide(float pm0, float pm1, f32x4v (&c)[2][4], float (&mh)[2], f32x4v (&negm)[2], float (&al)[2]) {
  pm0 = xmax32(xmax16(pm0)); pm1 = xmax32(xmax16(pm1));
  if (__builtin_expect(__all((pm0 <= THRL) && (pm1 <= THRL)), 1)) { al[0] = 1.f; al[1] = 1.f; }
  else { const float d0 = fmaxf(pm0, 0.f), d1 = fmaxf(pm1, 0.f); mh[0] += d0; mh[1] += d1;
#pragma unroll
    for (int kb = 0; kb < 4; ++kb) { c[0][kb] = c[0][kb] - d0; c[1][kb] = c[1][kb] - d1; }
    al[0] = __builtin_amdgcn_exp2f(-d0); al[1] = __builtin_amdgcn_exp2f(-d1);
    negm[0] = (f32x4v){-mh[0], -mh[0], -mh[0], -mh[0]}; negm[1] = (f32x4v){-mh[1], -mh[1], -mh[1], -mh[1]}; }
}
__device__ __forceinline__ bf16x8 packp(const f32x4v a, const f32x4v b) { const u32x4v w = {cvtpk(a[0], a[1]), cvtpk(a[2], a[3]), cvtpk(b[0], b[1]), cvtpk(b[2], b[3])}; return __builtin_bit_cast(bf16x8, w); }

struct Dma { const char* k0; const char* k1; const char* r; const char* v0; const char* v1; unsigned dk, dr, dv; bool kr; };
__device__ __forceinline__ void attn_step(f32x4v (&c)[2][4], f32x4v (&p)[2][4], f32x4v (&o)[2][8], const bf16x8 (&qn)[2][6], const Lane& L, int kst, int rst, int vst,
                                          const float (&alp)[2], float (&l)[2], float (&mh)[2], f32x4v (&negm)[2], float (&alc)[2], const Dma& D) {
  bf16x8 ka, kb_, kc, kd, P00, P01, P10, P11;
#define QKR(KB, S, FIRST, KX, KY) do { \
    if (FIRST) { c[0][KB] = MF16(KX, (qfrag<0, S>(qn, L)), negm[0]); c[1][KB] = MF16(KX, (qfrag<1, S>(qn, L)), negm[1]); \
                 c[0][KB + 1] = MF16(KY, (qfrag<0, S>(qn, L)), negm[0]); c[1][KB + 1] = MF16(KY, (qfrag<1, S>(qn, L)), negm[1]); } \
    else { c[0][KB] = MF16(KX, (qfrag<0, S>(qn, L)), c[0][KB]); c[1][KB] = MF16(KX, (qfrag<1, S>(qn, L)), c[1][KB]); \
           c[0][KB + 1] = MF16(KY, (qfrag<0, S>(qn, L)), c[0][KB + 1]); c[1][KB + 1] = MF16(KY, (qfrag<1, S>(qn, L)), c[1][KB + 1]); } } while (0)
#define EXP4(V) do { V[0] = __builtin_amdgcn_exp2f(V[0]); V[1] = __builtin_amdgcn_exp2f(V[1]); V[2] = __builtin_amdgcn_exp2f(V[2]); V[3] = __builtin_amdgcn_exp2f(V[3]); } while (0)
  ka = kfrag<0, 0>(L, kst, rst); kb_ = kfrag<1, 0>(L, kst, rst); SBAR();
  kc = kfrag<0, 1>(L, kst, rst); kd = kfrag<1, 1>(L, kst, rst); QKR(0, 0, true, ka, kb_); EXP4(p[0][2]); PIN(p[0][2]); SBAR();
  if (D.kr) glds16(D.k0, D.dk);
  ka = kfrag<0, 2>(L, kst, rst); kb_ = kfrag<1, 2>(L, kst, rst); QKR(0, 1, false, kc, kd); EXP4(p[0][3]); PIN(p[0][3]); SBAR();
  kc = kfrag<0, 3>(L, kst, rst); kd = kfrag<1, 3>(L, kst, rst); QKR(0, 2, false, ka, kb_); EXP4(p[1][2]); PIN(p[1][2]); SBAR();
  if (D.kr) glds16(D.k1, D.dk + 8192);
  ka = kfrag<0, 4>(L, kst, rst); kb_ = kfrag<1, 4>(L, kst, rst); QKR(0, 3, false, kc, kd); EXP4(p[1][3]); PIN(p[1][3]); SBAR();
  kc = kfrag<0, 5>(L, kst, rst); kd = kfrag<1, 5>(L, kst, rst); QKR(0, 4, false, ka, kb_);
  { float s = (p[0][0][0] + p[0][0][1]) + (p[0][0][2] + p[0][0][3]); s += (p[0][1][0] + p[0][1][1]) + (p[0][1][2] + p[0][1][3]); s += (p[0][2][0] + p[0][2][1]) + (p[0][2][2] + p[0][2][3]); s += (p[0][3][0] + p[0][3][1]) + (p[0][3][2] + p[0][3][3]);
    l[0] = l[0] * alp[0] + s; PIN(l[0]); } SBAR();
  if (D.kr) glds16(D.r, D.dr);
  ka = kfrag<2, 0>(L, kst, rst); kb_ = kfrag<3, 0>(L, kst, rst); QKR(0, 5, false, kc, kd);
  { float s = (p[1][0][0] + p[1][0][1]) + (p[1][0][2] + p[1][0][3]); s += (p[1][1][0] + p[1][1][1]) + (p[1][1][2] + p[1][1][3]); s += (p[1][2][0] + p[1][2][1]) + (p[1][2][2] + p[1][2][3]); s += (p[1][3][0] + p[1][3][1]) + (p[1][3][2] + p[1][3][3]);
    l[1] = l[1] * alp[1] + s; PIN(l[1]); } SBAR();
  kc = kfrag<2, 1>(L, kst, rst); kd = kfrag<3, 1>(L, kst, rst); QKR(2, 0, true, ka, kb_); P00 = packp(p[0][0], p[0][1]); PIN(P00); SBAR();
  glds16(D.v0, D.dv);
  ka = kfrag<2, 2>(L, kst, rst); kb_ = kfrag<3, 2>(L, kst, rst); QKR(2, 1, false, kc, kd); P01 = packp(p[0][2], p[0][3]); PIN(P01); SBAR();
  kc = kfrag<2, 3>(L, kst, rst); kd = kfrag<3, 3>(L, kst, rst); QKR(2, 2, false, ka, kb_); P10 = packp(p[1][0], p[1][1]); PIN(P10); SBAR();
  glds16(D.v1, D.dv + 8192);
  ka = kfrag<2, 4>(L, kst, rst); kb_ = kfrag<3, 4>(L, kst, rst); QKR(2, 3, false, kc, kd); P11 = packp(p[1][2], p[1][3]); PIN(P11); SBAR();
  kc = kfrag<2, 5>(L, kst, rst); kd = kfrag<3, 5>(L, kst, rst); QKR(2, 4, false, ka, kb_); SBAR();
  ka = vfrag<0, 0>(L, vst); kb_ = vfrag<1, 0>(L, vst); QKR(2, 5, false, kc, kd); SBAR();
#define PVR(DB, VX, VY, PA, PB) do { o[0][DB] = MF16(VX, PA, o[0][DB]); o[1][DB] = MF16(VX, PB, o[1][DB]); o[0][DB + 1] = MF16(VY, PA, o[0][DB + 1]); o[1][DB + 1] = MF16(VY, PB, o[1][DB + 1]); } while (0)
  float pm0, pm1;
  kc = vfrag<2, 0>(L, vst); kd = vfrag<3, 0>(L, vst); PVR(0, ka, kb_, P00, P10); pm0 = rowmax<0>(c); PIN(pm0); SBAR();
  ka = vfrag<4, 0>(L, vst); kb_ = vfrag<5, 0>(L, vst); PVR(2, kc, kd, P00, P10); pm1 = rowmax<1>(c); PIN(pm1); SBAR();
  kc = vfrag<6, 0>(L, vst); kd = vfrag<7, 0>(L, vst); PVR(4, ka, kb_, P00, P10); decide(pm0, pm1, c, mh, negm, alc); SBAR();
  ka = vfrag<0, 1>(L, vst); kb_ = vfrag<1, 1>(L, vst); PVR(6, kc, kd, P00, P10); EXP4(c[0][0]); PIN(c[0][0]); SBAR();
  kc = vfrag<2, 1>(L, vst); kd = vfrag<3, 1>(L, vst); PVR(0, ka, kb_, P01, P11); EXP4(c[0][1]); PIN(c[0][1]); SBAR();
  ka = vfrag<4, 1>(L, vst); kb_ = vfrag<5, 1>(L, vst); PVR(2, kc, kd, P01, P11); EXP4(c[1][0]); PIN(c[1][0]); SBAR();
  kc = vfrag<6, 1>(L, vst); kd = vfrag<7, 1>(L, vst); PVR(4, ka, kb_, P01, P11); EXP4(c[1][1]); PIN(c[1][1]); SBAR();
  PVR(6, kc, kd, P01, P11); SBAR();
#undef QKR
#undef PVR
}

__device__ __forceinline__ void attn_unit(const bf16* __restrict__ Qb, const bf16* __restrict__ Kh, const bf16* __restrict__ VTh, const bf16* __restrict__ Rh,
                                          bf16* __restrict__ Ob, float* __restrict__ st, int seq, int k0g, char* lds, int wid) {
  int lane_l = (int)__builtin_amdgcn_mbcnt_hi(~0u, __builtin_amdgcn_mbcnt_lo(~0u, 0u)); asm volatile("" : "+v"(lane_l));
  const int lane = lane_l, l15 = lane & 15, kq = lane >> 4;
  bf16x8 qn[2][6]; Lane L;
  L.qrl = (const LAS char*)(lds + OFF_QR + wid * 4096 + lane * 16);
  { const bf16* Qw = Qb + (long)(wid * 32 + l15) * LDQ + kq * 8;
#pragma unroll
    for (int qb = 0; qb < 2; ++qb) {
#pragma unroll
      for (int s = 0; s < 6; ++s) qn[qb][s] = *(const GAS bf16x8*)(Qw + (long)qb * 16 * LDQ + s * 32); } }
  L.Kl = (const LAS char*)(lds + OFF_K) + l15 * 256; L.Rl = (const LAS char*)(lds + OFF_R) + l15 * 128; L.Vl = (const LAS char*)(lds + OFF_V) + l15 * 128;
  L.ky = (kq ^ l15) << 4; L.rz = (kq ^ ((l15 >> 1) & 7)) << 4; L.vz = 0;
  unsigned kof0, kof1, rof, vof0, vof1;
  { const int q0 = wid, q1 = wid + 8;
    { const int row = 4 * q0 + (lane >> 4), ch = (lane & 15) ^ (row & 15); kof0 = (unsigned)(row * LDK + ch * 8) * 2u; }
    { const int row = 4 * q1 + (lane >> 4), ch = (lane & 15) ^ (row & 15); kof1 = (unsigned)(row * LDK + ch * 8) * 2u; }
    { const int row = 8 * q0 + (lane >> 3), ch = (lane & 7) ^ ((row >> 1) & 7); rof = (unsigned)(row * LDR + ch * 8) * 2u; }
    { const int row = 8 * q0 + (lane >> 3), ch = (lane & 7) ^ ((row >> 1) & 7); vof0 = (unsigned)(row * LDVT + ch * 8) * 2u; }
    { const int row = 8 * q1 + (lane >> 3), ch = (lane & 7) ^ ((row >> 1) & 7); vof1 = (unsigned)(row * LDVT + ch * 8) * 2u; } }
  const unsigned lds0 = (unsigned)(uintptr_t)lds;
  const unsigned dK = (unsigned)__builtin_amdgcn_readfirstlane(lds0 + OFF_K + wid * 1024), dR = (unsigned)__builtin_amdgcn_readfirstlane(lds0 + OFF_R + wid * 1024), dV = (unsigned)__builtin_amdgcn_readfirstlane(lds0 + OFF_V + wid * 1024);
  const char* VTk = (const char*)VTh + (size_t)k0g * 2;
#define DMA_KR(t, s) do { const char* kb_ = (const char*)Kh + (size_t)(t) * (KVBLK * LDK * 2); const char* rb_ = (const char*)Rh + (size_t)(t) * (KVBLK * LDR * 2); \
    glds16(kb_ + kof0, dK + (s) * SHM_K); glds16(kb_ + kof1, dK + (s) * SHM_K + 8192); glds16(rb_ + rof, dR + (s) * SHM_R); } while (0)
#define DMA_V(t, s) do { const char* vb_ = VTk + (size_t)(t) * (KVBLK * 2); glds16(vb_ + vof0, dV + (s) * SHM_V); glds16(vb_ + vof1, dV + (s) * SHM_V + 8192); } while (0)
#define WAIT_BAR() asm volatile("s_waitcnt vmcnt(0) lgkmcnt(0)\n\ts_barrier" ::: "memory")
#define RESC(a) do { if (__any(((a)[0] < 1.f) || ((a)[1] < 1.f))) { _Pragma("unroll") for (int d_ = 0; d_ < 8; ++d_) { o[0][d_] *= (a)[0]; o[1][d_] *= (a)[1]; } } } while (0)
  f32x4v o[2][8], sA[2][4], sB[2][4], negm[2]; float mh[2], l[2] = {0.f, 0.f}, alA[2], alB[2];
#pragma unroll
  for (int d = 0; d < 8; ++d) { o[0][d] = (f32x4v){0.f, 0.f, 0.f, 0.f}; o[1][d] = (f32x4v){0.f, 0.f, 0.f, 0.f}; }
  const int NT = seq / KVBLK;
  DMA_KR(0, 0); DMA_V(0, 0); WAIT_BAR();
  DMA_KR(1, 1);
  qk_block_plain<0>(sA, qn, L, 0, 0); qk_block_plain<1>(sA, qn, L, 0, 0); qk_block_plain<2>(sA, qn, L, 0, 0); qk_block_plain<3>(sA, qn, L, 0, 0);
  { mh[0] = xmax32(xmax16(rowmax<0>(sA))); mh[1] = xmax32(xmax16(rowmax<1>(sA))); alA[0] = 1.f; alA[1] = 1.f;
    negm[0] = (f32x4v){-mh[0], -mh[0], -mh[0], -mh[0]}; negm[1] = (f32x4v){-mh[1], -mh[1], -mh[1], -mh[1]};
#pragma unroll
    for (int kb = 0; kb < 4; ++kb) { sA[0][kb] = sA[0][kb] - mh[0]; sA[1][kb] = sA[1][kb] - mh[1]; }
#pragma unroll
    for (int kb = 0; kb < 2; ++kb)
#pragma unroll
      for (int e = 0; e < 4; ++e) { sA[0][kb][e] = __builtin_amdgcn_exp2f(sA[0][kb][e]); sA[1][kb][e] = __builtin_amdgcn_exp2f(sA[1][kb][e]); } }
  WAIT_BAR();
#pragma unroll 1
  for (int j = 1; j + 1 < NT; j += 2) {
    { const char* kb_ = (const char*)Kh + (size_t)(j + 1) * (KVBLK * LDK * 2); const char* rb_ = (const char*)Rh + (size_t)(j + 1) * (KVBLK * LDR * 2); const char* vb_ = VTk + (size_t)j * (KVBLK * 2);
      const Dma D{kb_ + kof0, kb_ + kof1, rb_ + rof, vb_ + vof0, vb_ + vof1, dK, dR, dV + SHM_V, true};
      attn_step(sB, sA, o, qn, L, SHM_K, SHM_R, 0, alA, l, mh, negm, alB, D); }
    RESC(alB); WAIT_BAR();
    { const char* kb_ = (const char*)Kh + (size_t)(j + 2) * (KVBLK * LDK * 2); const char* rb_ = (const char*)Rh + (size_t)(j + 2) * (KVBLK * LDR * 2); const char* vb_ = VTk + (size_t)(j + 1) * (KVBLK * 2);
      const Dma D{kb_ + kof0, kb_ + kof1, rb_ + rof, vb_ + vof0, vb_ + vof1, dK + SHM_K, dR + SHM_R, dV, (j + 2 < NT)};
      attn_step(sA, sB, o, qn, L, 0, 0, SHM_V, alB, l, mh, negm, alA, D); }
    RESC(alA); WAIT_BAR();
  }
  { const char* vb_ = VTk + (size_t)(NT - 1) * (KVBLK * 2);
    const Dma D{vb_, vb_, vb_, vb_ + vof0, vb_ + vof1, dK, dR, dV + SHM_V, false};
    attn_step(sB, sA, o, qn, L, SHM_K, SHM_R, 0, alA, l, mh, negm, alB, D); }
  RESC(alB); WAIT_BAR();
  {
#pragma unroll
    for (int kb = 2; kb < 4; ++kb)
#pragma unroll
      for (int e = 0; e < 4; ++e) { sB[0][kb][e] = __builtin_amdgcn_exp2f(sB[0][kb][e]); sB[1][kb][e] = __builtin_amdgcn_exp2f(sB[1][kb][e]); }
    float s0 = 0.f, s1 = 0.f;
#pragma unroll
    for (int kb = 0; kb < 4; ++kb) { s0 += (sB[0][kb][0] + sB[0][kb][1]) + (sB[0][kb][2] + sB[0][kb][3]); s1 += (sB[1][kb][0] + sB[1][kb][1]) + (sB[1][kb][2] + sB[1][kb][3]); }
    l[0] = l[0] * alB[0] + s0; l[1] = l[1] * alB[1] + s1;
    const bf16x8 P00 = packp(sB[0][0], sB[0][1]), P01 = packp(sB[0][2], sB[0][3]), P10 = packp(sB[1][0], sB[1][1]), P11 = packp(sB[1][2], sB[1][3]);
#define PVD(DB) do { bf16x8 v0 = vfrag<DB, 0>(L, SHM_V), v1 = vfrag<DB, 1>(L, SHM_V); o[0][DB] = MF16(v0, P00, o[0][DB]); o[1][DB] = MF16(v0, P10, o[1][DB]); o[0][DB] = MF16(v1, P01, o[0][DB]); o[1][DB] = MF16(v1, P11, o[1][DB]); } while (0)
    PVD(0); PVD(1); PVD(2); PVD(3); PVD(4); PVD(5); PVD(6); PVD(7);
#undef PVD
  }
  int lane_e = (int)__builtin_amdgcn_mbcnt_hi(~0u, __builtin_amdgcn_mbcnt_lo(~0u, 0u)); asm volatile("" : "+v"(lane_e)); const int l15e = lane_e & 15, kqe = lane_e >> 4;
  GAS bf16* Ow = (GAS bf16*)Ob + (long)(wid * 32 + l15e) * LDO + 4 * kqe; GAS float* stw = (GAS float*)st + (long)(wid * 32 + l15e) * 16;
  asm volatile("" : "+v"(Ow), "+v"(stw));
#pragma unroll
  for (int qb = 0; qb < 2; ++qb) { const float lt = xsum32(xsum16(l[qb])); const float rl = __builtin_amdgcn_rcpf(lt); float ss = 0.f;
#pragma unroll
    for (int db = 0; db < 8; ++db) { const f32x4v v = o[qb][db] * rl; u32x2v w; w.x = cvtpk(v[0], v[1]); w.y = cvtpk(v[2], v[3]);
      const float a0 = bflo(w.x), a1 = bfhi(w.x), a2 = bflo(w.y), a3 = bfhi(w.y); ss += (a0 * a0 + a1 * a1) + (a2 * a2 + a3 * a3);
      *(GAS u32x2v*)(Ow + (long)(qb * 16) * LDO + db * 16) = w; }
    ss = xsum32(xsum16(ss)); if (kqe == 0) stw[(long)(qb * 16) * 16] = ss; }
  asm volatile("s_waitcnt lgkmcnt(0)\n\ts_barrier" ::: "memory");
#undef DMA_KR
#undef DMA_V
#undef WAIT_BAR
#undef RESC
}
#undef SBAR
#undef PIN
#undef MF16
#undef EXP4
}

constexpr size_t MiB = 1u << 20;
constexpr size_t WS_CTL = 0, CTL_ZERO_BYTES = 1 * MiB;
constexpr size_t WS_RSTDX = 1 * MiB, WS_RSTDQ = WS_RSTDX + 98304, WS_RSTDKV = WS_RSTDQ + 98304, WS_R2 = WS_RSTDKV + 98304, WS_RATIO = WS_R2 + 98304, WS_RSTDX1 = WS_RATIO + 98304;
constexpr size_t WS_STA = 2 * MiB;
constexpr size_t WS_STB = 8 * MiB;
constexpr size_t WS_STQ = 10 * MiB;
constexpr size_t WS_STKV = 12 * MiB;
constexpr size_t WS_ROPE = 13 * MiB;
constexpr size_t WS_WIN = 16 * MiB;
constexpr size_t WS_WGLU = 46 * MiB;
constexpr size_t WS_WQ = 54 * MiB;
constexpr size_t WS_WKV = 60 * MiB;
constexpr size_t WS_WOUT = 64 * MiB;
constexpr size_t WS_WUG = 96 * MiB;
constexpr size_t WS_WDN = 268 * MiB;
constexpr size_t WS_W1T = 354 * MiB;
constexpr size_t WS_W2T = 370 * MiB;
constexpr size_t WS_A = 402 * MiB;
constexpr size_t WS_B = 594 * MiB;
constexpr size_t WS_QLAT = 786 * MiB, WS_KVLAT = 828 * MiB, WS_KROPE = 852 * MiB;
constexpr size_t WS_GACT = 856 * MiB;
constexpr size_t WS_HUP = 952 * MiB, WS_HGATE = 964 * MiB, WS_END = 970 * MiB;
static_assert(WS_HUP + (size_t)128 * 4 * DFF * 2 <= WS_HGATE && WS_HGATE + (size_t)128 * 2 * DFF * 2 <= WS_END, "halo");
constexpr size_t OUT_X = 0, OUT_KV = 192 * MiB;
constexpr int CW_BAR = 4096;

constexpr int NWAVES = 8;
constexpr int RING_BYTES = 131072, LDSCTL_OFF = 143360, MISC_OFF = LDSCTL_OFF + 320, LDS_BYTES = 147456;

typedef GAS unsigned gu32;
#define RLX_AGENT __ATOMIC_RELAXED, __HIP_MEMORY_SCOPE_AGENT
#define LDS_WAIT() asm volatile("s_waitcnt lgkmcnt(0)" ::: "memory")

#define XB_TMO      128
#define XB_XCNT(j)  (256  + 64 * (j))
#define XB_XSUB(j)  (1280 + 64 * (j))
#define XB_XGEN(j)  (2304 + 64 * (j))
#define XB_TOP      3328
#define XB_TOPGEN   3392
#define XCD_BAR_WORDS 3456
#define XB_SPIN_CAP (1u << 18)
__device__ __forceinline__ unsigned xb_ld(unsigned* p)              { return __hip_atomic_load(p, __ATOMIC_RELAXED, __HIP_MEMORY_SCOPE_AGENT); }
__device__ __forceinline__ unsigned xb_add(unsigned* p, unsigned v) { return __hip_atomic_fetch_add(p, v, __ATOMIC_RELAXED, __HIP_MEMORY_SCOPE_AGENT); }
__device__ __forceinline__ unsigned xb_xcc_id() { return (unsigned)__builtin_amdgcn_s_getreg((3 << 11) | 20) & 0xFu; }
#define XB_SPIN(cond, bar) do { unsigned _sp = 0; while (cond) { __builtin_amdgcn_s_sleep(1); \
    if ((++_sp & 255u) == 0u) { if (xb_ld(&(bar)[XB_TMO])) break; if (_sp > XB_SPIN_CAP) { atomicAdd(&(bar)[XB_TMO], 1u); break; } } } } while (0)
struct XcdBarrier { unsigned* bar; unsigned x; volatile LAS unsigned* st; };
__device__ __forceinline__ XcdBarrier xcd_barrier_post(unsigned* bar, volatile LAS unsigned* st) {
    XcdBarrier b; b.bar = bar; b.x = xb_xcc_id(); b.st = st;
    if (threadIdx.x == 0) (void)xb_add(&bar[XB_XCNT(b.x)], 1u);
    return b;
}
__device__ __forceinline__ void xcd_barrier_complete(unsigned* bar, unsigned x, unsigned& nloc, unsigned& nx) {
    const unsigned G = gridDim.x * gridDim.y * gridDim.z;
    unsigned sum, cnt, mine, sp = 0u;
    for (;;) {
        sum = 0u; cnt = 0u; mine = 0u;
#pragma unroll
        for (unsigned j = 0; j < 16; ++j) { const unsigned c = xb_ld(&bar[XB_XCNT(j)]); sum += c; cnt += (c > 0u) ? 1u : 0u; mine = (j == x) ? c : mine; }
        if (sum == G) break;
        __builtin_amdgcn_s_sleep(1);
        if ((++sp & 255u) == 0u) { if (xb_ld(&bar[XB_TMO])) break; if (sp > XB_SPIN_CAP) { atomicAdd(&bar[XB_TMO], 1u); break; } }
    }
    nloc = mine > 0u ? mine : 1u; nx = cnt > 0u ? cnt : 1u;
}
__device__ __forceinline__ void xcd_barrier(const XcdBarrier& b) {
    asm volatile("s_waitcnt vmcnt(0)" ::: "memory");
    __syncthreads();
    if (threadIdx.x == 0) {
        unsigned* bar = b.bar;
        __builtin_amdgcn_s_waitcnt(0);
        unsigned nloc = b.st[0], nx = b.st[1];
        if (nloc == 0u) { xcd_barrier_complete(bar, b.x, nloc, nx); b.st[0] = nloc; b.st[1] = nx; }
        const unsigned old = xb_add(&bar[XB_XSUB(b.x)], 1u);
        const unsigned gen = old / nloc;
        if (old + 1u == (gen + 1u) * nloc) {
            __builtin_amdgcn_fence(__ATOMIC_RELEASE, "agent");
            asm volatile("s_waitcnt vmcnt(0)" ::: "memory");
            const unsigned og = xb_add(&bar[XB_TOP], 1u);
            const unsigned tg = og / nx;
            if (og + 1u == (tg + 1u) * nx) xb_add(&bar[XB_TOPGEN], 1u);
            else XB_SPIN(xb_ld(&bar[XB_TOPGEN]) == tg, bar);
            __builtin_amdgcn_fence(__ATOMIC_ACQUIRE, "agent");
            xb_add(&bar[XB_XGEN(b.x)], 1u);
            asm volatile("s_waitcnt vmcnt(0)" ::: "memory");
        } else {
            XB_SPIN(xb_ld(&bar[XB_XGEN(b.x)]) == gen, bar);
            __builtin_amdgcn_fence(__ATOMIC_ACQUIRE, "agent");
            asm volatile("s_waitcnt vmcnt(0)" ::: "memory");
        }
    }
    __syncthreads();
}

__device__ __forceinline__ float wave_sum(float v) {
#pragma unroll
    for (int o = 1; o < 64; o <<= 1) v += __shfl_xor(v, o);
    return v;
}
template <class RowMap>
__device__ __forceinline__ void transpose_item(const float* W, int K, int N, bf16* WT, const float* g1, const float* g2, int ksplit, RowMap rm, LAS float* scr, int item, int lane) {
    const int nblk = N / 64; int kb, nb;
    if ((nblk & 3) == 0) { const int w = item & 7, rest = item >> 3, q = nblk >> 2; nb = (rest % q) * 4 + (w & 3); kb = (rest / q) * 2 + (w >> 2); }
    else { kb = item / nblk; nb = item % nblk; }
    const int k0 = 64 * kb, n0 = 64 * nb;
    f32x2 wv[32];
    const GAS f32x2* wp = (const GAS f32x2*)((const GAS float*)W + (size_t)(k0 + (lane >> 5)) * N + n0) + (lane & 31);
#pragma unroll
    for (int i = 0; i < 32; ++i) wv[i] = *(const GAS f32x2*)((const GAS float*)wp + (size_t)(2 * i) * N);
    float gn[32];
#pragma unroll
    for (int i = 0; i < 32; ++i) { const int k = k0 + 2 * i + (lane >> 5); gn[i] = g1 ? (k < ksplit ? g1[k] : g2[k - ksplit]) : 1.0f; }
    const int c = lane & 7;
#pragma unroll
    for (int sub = 0; sub < 2; ++sub) {
#pragma unroll
        for (int i = 0; i < 32; ++i) { const int kk = 2 * i + (lane >> 5); scr[kk * 33 + (lane & 31)] = (sub ? wv[i].y : wv[i].x) * gn[i]; }
        LDS_WAIT(); asm volatile("" ::: "memory");
#pragma unroll
        for (int j = 0; j < 4; ++j) { const int nl = (lane >> 3) + 8 * j; const LAS float* s = scr + (8 * c) * 33 + nl;
            v4u o; o.x = pg8::cvt_pk_bf16(s[0 * 33], s[1 * 33]); o.y = pg8::cvt_pk_bf16(s[2 * 33], s[3 * 33]); o.z = pg8::cvt_pk_bf16(s[4 * 33], s[5 * 33]); o.w = pg8::cvt_pk_bf16(s[6 * 33], s[7 * 33]);
            *(GAS v4u*)(WT + (size_t)rm(n0 + 2 * nl + sub) * K + k0 + 8 * c) = o; }
        LDS_WAIT(); asm volatile("" ::: "memory");
    }
}
__device__ __forceinline__ void tr_coords(int N, int item, int& k0, int& n0) { const int nblk = N / 64; int kb, nb;
    if ((nblk & 3) == 0) { const int w = item & 7, rest = item >> 3, q = nblk >> 2; nb = (rest % q) * 4 + (w & 3); kb = (rest / q) * 2 + (w >> 2); } else { kb = item / nblk; nb = item % nblk; }
    k0 = 64 * kb; n0 = 64 * nb; }
__device__ __forceinline__ void tr_load(const float* W, int N, const float* g1, const float* g2, int ksplit, int item, int lane, f32x4 (&wv)[16], f32x4 (&gq)[4]) {
    int k0, n0; tr_coords(N, item, k0, n0);
    const int kb = k0 + 16 * (lane >> 4);
    const GAS float* wp = (const GAS float*)W + (size_t)kb * N + n0 + 4 * (lane & 15);
#pragma unroll
    for (int i = 0; i < 16; ++i) wv[i] = *(const GAS f32x4*)(wp + (size_t)i * N);
    if (g1) { const GAS float* gp = (const GAS float*)(kb < ksplit ? g1 + kb : g2 + (kb - ksplit));
#pragma unroll
        for (int j = 0; j < 4; ++j) gq[j] = *(const GAS f32x4*)(gp + 4 * j); }
    else {
#pragma unroll
        for (int j = 0; j < 4; ++j) gq[j] = (f32x4){1.f, 1.f, 1.f, 1.f}; }
}
constexpr int TRS = 66;
template <class RowMap>
__device__ __forceinline__ void tr_emit(int K, int N, bf16* WT, RowMap rm, LAS float* scr, int item, int lane, const f32x4 (&wv)[16], const f32x4 (&gq)[4]) {
    int k0, n0; tr_coords(N, item, k0, n0);
    LAS float* wr_ = scr + (16 * (lane >> 4)) * TRS + 4 * (lane & 15);
#pragma unroll
    for (int i = 0; i < 16; ++i) { const float gg = gq[i >> 2][i & 3]; const f32x4 v = wv[i] * gg;
        *(LAS f32x2*)(wr_ + i * TRS) = (f32x2){v[0], v[1]}; *(LAS f32x2*)(wr_ + i * TRS + 2) = (f32x2){v[2], v[3]}; }
    LDS_WAIT(); asm volatile("" ::: "memory");
    const int c = lane & 7;
#pragma unroll
    for (int j = 0; j < 8; ++j) { const int nl = (lane >> 3) + 8 * j; const LAS float* s = scr + (8 * c) * TRS + nl;
        v4u o; o.x = pg8::cvt_pk_bf16(s[0 * TRS], s[1 * TRS]); o.y = pg8::cvt_pk_bf16(s[2 * TRS], s[3 * TRS]); o.z = pg8::cvt_pk_bf16(s[4 * TRS], s[5 * TRS]); o.w = pg8::cvt_pk_bf16(s[6 * TRS], s[7 * TRS]);
        *(GAS v4u*)(WT + (size_t)rm(n0 + nl) * K + k0 + 8 * c) = o; }
    LDS_WAIT(); asm volatile("" ::: "memory");
}
template <class RowMap>
__device__ __forceinline__ void transpose_range(const float* W, int K, int N, bf16* WT, const float* g1, const float* g2, int ksplit, RowMap rm, LAS float* scr, int first, int last, int stride, int lane) {
    if (first >= last) return;
    f32x4 wa[16], wb[16], ga[4], gb[4];
    int it = first; tr_load(W, N, g1, g2, ksplit, it, lane, wa, ga);
#pragma unroll 1
    for (;;) {
        const int n1 = it + stride; const bool h1 = n1 < last;
        if (h1) tr_load(W, N, g1, g2, ksplit, n1, lane, wb, gb);
        tr_emit(K, N, WT, rm, scr, it, lane, wa, ga);
        if (!h1) break;
        const int n2 = n1 + stride; const bool h2 = n2 < last;
        if (h2) tr_load(W, N, g1, g2, ksplit, n2, lane, wa, ga);
        tr_emit(K, N, WT, rm, scr, n1, lane, wb, gb);
        if (!h2) break;
        it = n2;
    }
}
struct RmId  { __device__ __forceinline__ int operator()(int n) const { return n; } };
struct RmWin { __device__ __forceinline__ int operator()(int n) const { if (n < 2944) return n; if (n < 3456) return n + 128; const int i = n - 3456; return 3584 + (i < 32 ? 2 * i : 2 * (i - 32) + 1); } };
struct RmQ   { __device__ __forceinline__ int operator()(int n) const { const int r = n % 192, hb = n - r; if (r < 128) return n; const int i = r - 128; return hb + 128 + (i < 32 ? 2 * i : 2 * (i - 32) + 1); } };
struct RmKV  { __device__ __forceinline__ int operator()(int n) const { const int h = n >> 8, c = n & 255; return c < 128 ? h * 128 + c : 2048 + h * 128 + (c - 128); } };
struct RmUp  { __device__ __forceinline__ int operator()(int n) const { return (n >> 7) * 256 + (n & 127); } };
struct RmGate{ __device__ __forceinline__ int operator()(int n) const { return (n >> 7) * 256 + 128 + (n & 127); } };

__device__ __forceinline__ void sincos_d(double a, double& s, double& c) {
    const double kd = __builtin_rint(a * 0.63661977236758134308); const long k = (long)kd;
    double r = __builtin_fma(-kd, 1.57079632679489655800e+00, a); r = __builtin_fma(-kd, 6.12323399573676603587e-17, r);
    const double r2 = r * r;
    double sp = 1.0 / 6227020800.0; sp = sp * r2 - 1.0 / 39916800.0; sp = sp * r2 + 1.0 / 362880.0; sp = sp * r2 - 1.0 / 5040.0; sp = sp * r2 + 1.0 / 120.0; sp = sp * r2 - 1.0 / 6.0; sp = sp * r2 * r + r;
    double cp = 1.0 / 479001600.0; cp = cp * r2 - 1.0 / 3628800.0; cp = cp * r2 + 1.0 / 40320.0; cp = cp * r2 - 1.0 / 720.0; cp = cp * r2 + 1.0 / 24.0; cp = cp * r2 - 0.5; cp = cp * r2 + 1.0;
    const int q = (int)(k & 3);
    s = (q == 0) ? sp : (q == 1) ? cp : (q == 2) ? -sp : -cp;
    c = (q == 0) ? cp : (q == 1) ? -sp : (q == 2) ? -cp : sp;
}

__device__ __forceinline__ void ssm_weights_group(int g, const float* a_re, const float* a_im, const float* b_re, const float* b_im, const float* c_re, const float* c_im,
                                                  const float* log_dt, const float* dskip, bf16* W1t, bf16* W2t, LAS float* L, int tid) {
    LAS float* PW = L;
    LAS float* BB = PW + 2 * 17 * 64 * 2;
    LAS float* CC = BB + 2 * 64 * 16 * 2;
    LAS float* KT = CC + 2 * 16 * 64 * 2;
    for (int i = tid; i < 2 * 17 * 64; i += 512) { const int d = i / (17 * 64), e = (i / 64) % 17, p = i & 63;
        const double dt = exp((double)log_dt[d * 128 + g]); const double are = a_re[(d * 128 + g) * 64 + p], aim = a_im[(d * 128 + g) * 64 + p];
        const double mag = exp((double)e * dt * are); double s, c; sincos_d((double)e * dt * aim, s, c);
        PW[i * 2] = (float)(mag * c); PW[i * 2 + 1] = (float)(mag * s); }
    for (int i = tid; i < 2 * 64 * 16; i += 512) { const int d = i / 1024, p = (i >> 4) & 63, h = i & 15;
        const double dt = exp((double)log_dt[d * 128 + g]); const double are = a_re[(d * 128 + g) * 64 + p], aim = a_im[(d * 128 + g) * 64 + p];
        const double x = dt * are, y = dt * aim; double sy, cy, sh, ch; sincos_d(y, sy, cy); sincos_d(0.5 * y, sh, ch);
        const double em1 = expm1(x); const double re1 = em1 * cy - 2.0 * sh * sh, im1 = (em1 + 1.0) * sy;
        const double den = are * are + aim * aim; const double qre = (re1 * are + im1 * aim) / den, qim = (im1 * are - re1 * aim) / den;
        const size_t bi = ((size_t)((d * 128 + g) * 64 + p)) * 16 + h; const double br = b_re[bi], bim = b_im[bi];
        BB[i * 2] = (float)(qre * br - qim * bim); BB[i * 2 + 1] = (float)(qre * bim + qim * br); }
    for (int i = tid; i < 2 * 16 * 64; i += 512) { const int d = i / 1024, h = (i >> 6) & 15, p = i & 63; const size_t ci = ((size_t)((d * 128 + g) * 16 + h)) * 64 + p;
        CC[i * 2] = c_re[ci]; CC[i * 2 + 1] = c_im[ci]; }
    __syncthreads();
    { const int d = tid >> 8, e = (tid >> 4) & 15, h = tid & 15; float acc[16];
#pragma unroll
        for (int q = 0; q < 16; ++q) acc[q] = 0.f;
        for (int p = 0; p < 64; ++p) { const float cr = CC[((d * 16 + h) * 64 + p) * 2], ci = CC[((d * 16 + h) * 64 + p) * 2 + 1];
            const float pr = PW[((d * 17 + e) * 64 + p) * 2], pi = PW[((d * 17 + e) * 64 + p) * 2 + 1];
            const float tr = cr * pr - ci * pi, ti = cr * pi + ci * pr; const LAS f32x4* bp = (const LAS f32x4*)(BB + ((d * 64 + p) * 16) * 2);
#pragma unroll
            for (int q = 0; q < 8; ++q) { const f32x4 b = bp[q]; acc[2 * q] += tr * b[0] - ti * b[1]; acc[2 * q + 1] += tr * b[2] - ti * b[3]; } }
#pragma unroll
        for (int q = 0; q < 16; ++q) KT[((d * 16 + e) * 16 + h) * 16 + q] = acc[q]; }
    __syncthreads();
    for (int i = tid; i < 256 * 32; i += 512) { const int n = i >> 5, k0 = (i & 31) * 8; const int d = n >> 7, im = (n >> 6) & 1, p = n & 63; const int s = k0 >> 4, h0 = k0 & 15, e = d ? s : 15 - s;
        const float pr = PW[((d * 17 + e) * 64 + p) * 2], pi = PW[((d * 17 + e) * 64 + p) * 2 + 1]; float v[8];
#pragma unroll
        for (int j = 0; j < 8; ++j) { const float br = BB[((d * 64 + p) * 16 + h0 + j) * 2], bi = BB[((d * 64 + p) * 16 + h0 + j) * 2 + 1]; v[j] = im ? (pr * bi + pi * br) : (pr * br - pi * bi); }
        v4u o; o.x = pk2(v[0], v[1]); o.y = pk2(v[2], v[3]); o.z = pk2(v[4], v[5]); o.w = pk2(v[6], v[7]);
        *(GAS v4u*)(W1t + ((size_t)(g * 256 + n)) * 256 + k0) = o; }
    for (int i = tid; i < 256 * 64; i += 512) { const int n = i >> 6, k0 = (i & 63) * 8; const int j = n >> 4, h = n & 15; float v[8];
        if (k0 < 256) { const int d = k0 >> 7, im = (k0 >> 6) & 1, p0 = k0 & 63, e = d ? 16 - j : j + 1;
#pragma unroll
            for (int q = 0; q < 8; ++q) { const int p = p0 + q; const float cr = CC[((d * 16 + h) * 64 + p) * 2], ci = CC[((d * 16 + h) * 64 + p) * 2 + 1];
                const float pr = PW[((d * 17 + e) * 64 + p) * 2], pi = PW[((d * 17 + e) * 64 + p) * 2 + 1]; v[q] = im ? -(cr * pi + ci * pr) : (cr * pr - ci * pi); }
        } else { const int s = (k0 - 256) >> 4, h0 = (k0 - 256) & 15;
#pragma unroll
            for (int q = 0; q < 8; ++q) { const int hh = h0 + q; float val = 0.f;
                if (s <= j) val += KT[((0 * 16 + (j - s)) * 16 + h) * 16 + hh];
                if (s >= j) val += KT[((1 * 16 + (s - j)) * 16 + h) * 16 + hh];
                if (s == j && h == hh) val += dskip[g * 16 + h];
                v[q] = val; } }
        v4u o; o.x = pk2(v[0], v[1]); o.y = pk2(v[2], v[3]); o.z = pk2(v[4], v[5]); o.w = pk2(v[6], v[7]);
        *(GAS v4u*)(W2t + ((size_t)(g * 256 + n)) * 512 + k0) = o; }
    __syncthreads();
}
#ifndef PROBE_ATTN
#define PROBE_ATTN 1
#endif
#ifndef PROBE_P0
#define PROBE_P0 1
#endif
#ifndef PROBE_P1
#define PROBE_P1 1
#endif
#ifndef PROBE_P7
#define PROBE_P7 1
#endif
#ifndef PROBE_FA
#define PROBE_FA 1
#endif

struct Args { const float* in[27]; float* out; unsigned char* ws; int ph_lo, ph_hi; };

__global__ void __launch_bounds__(NWAVES * 64, 2) enc_fwd(Args args) {
    extern __shared__ __attribute__((aligned(16))) unsigned char lds[];
    LAS unsigned char* ldsb = (LAS unsigned char*)lds;
    volatile LAS unsigned* MISC = (volatile LAS unsigned*)(ldsb + MISC_OFF);
    const int wave0 = __builtin_amdgcn_readfirstlane(threadIdx.x >> 6);
    const int G = gridDim.x, bx = blockIdx.x; const int vcu = (G % 8 == 0) ? (bx % 8) * (G / 8) + bx / 8 : bx;
    const int NGW = G * NWAVES, NGT = G * NWAVES * 64;
    gu32* ctl = (gu32*)(args.ws + WS_CTL);
#define PHB unsigned char* wsl = args.ws; unsigned char* outl = (unsigned char*)args.out; asm volatile("" : "+s"(wsl), "+s"(outl)); \
    int tid = wave0 * 64 + (int)__builtin_amdgcn_mbcnt_hi(~0u, __builtin_amdgcn_mbcnt_lo(~0u, 0u)); asm volatile("" : "+v"(tid)); const int lane = tid & 63, wave = wave0; \
    const int gw = vcu * NWAVES + wave, gt = vcu * (NWAVES * 64) + tid; (void)lane; (void)gw; (void)gt; (void)wsl; (void)outl
#define x_p (args.in[0])
#define x_s (args.in[1])
#define rstd_x ((float*)(wsl + WS_RSTDX))
#define rstd_q ((float*)(wsl + WS_RSTDQ))
#define rstd_kv ((float*)(wsl + WS_RSTDKV))
#define r2v ((float*)(wsl + WS_R2))
#define ratio ((float*)(wsl + WS_RATIO))
#define rstd_x1 ((float*)(wsl + WS_RSTDX1))
#define stA ((float*)(wsl + WS_STA))
#define stB ((float*)(wsl + WS_STB))
#define stQ ((float*)(wsl + WS_STQ))
#define stKV ((float*)(wsl + WS_STKV))
#define ropetab ((float*)(wsl + WS_ROPE))
#define Wi ((bf16*)(wsl + WS_WIN))
#define Wglu ((bf16*)(wsl + WS_WGLU))
#define Wq ((bf16*)(wsl + WS_WQ))
#define Wkv ((bf16*)(wsl + WS_WKV))
#define Wout ((bf16*)(wsl + WS_WOUT))
#define Wug ((bf16*)(wsl + WS_WUG))
#define Wdn ((bf16*)(wsl + WS_WDN))
#define W1t ((bf16*)(wsl + WS_W1T))
#define W2t ((bf16*)(wsl + WS_W2T))
#define bufA ((bf16*)(wsl + WS_A))
#define bufB ((bf16*)(wsl + WS_B))
#define qlat ((bf16*)(wsl + WS_QLAT))
#define kvlat ((bf16*)(wsl + WS_KVLAT))
#define krope ((bf16*)(wsl + WS_KROPE))
#define gact ((bf16*)(wsl + WS_GACT))
#define hup ((bf16*)(wsl + WS_HUP))
#define hgate ((bf16*)(wsl + WS_HGATE))
#define X ((bf16*)(outl + OUT_X))
#define mrg ((bf16*)(outl + OUT_X))
#define kvb ((bf16*)(outl + OUT_KV))
#define vtb ((bf16*)(outl + OUT_KV) + (size_t)T * 2048)
#define xoutf ((float*)outl)
    for (int u = threadIdx.x; u < (LDS_BYTES - LDSCTL_OFF) / 4; u += NWAVES * 64) ((LAS unsigned*)(ldsb + LDSCTL_OFF))[u] = 0u;
    __syncthreads();
    XcdBarrier bar = xcd_barrier_post((unsigned*)(ctl + CW_BAR), MISC + 8);
    const int lo = args.ph_lo, hi = args.ph_hi;
#ifndef PHMASK
#define PHMASK 0xfffffffu
#endif
#define IN(k) (((PHMASK >> ((k) < 9 ? (k) : ((k) >= 18 ? 12 : 9 + ((k) - 9) % 3))) & 1u) && lo <= (k) && (k) < hi)
#define SEAM(k) do { if (IN(k) && IN((k) + 1)) xcd_barrier(bar); } while (0)

#pragma unroll 1
    for (int rep = 0; rep < PROBE_P0; ++rep)
    if (IN(0)) {
        PHB;
        if (rep) __syncthreads();
        if (vcu < 128) ssm_weights_group(vcu, args.in[4], args.in[5], args.in[6], args.in[7], args.in[8], args.in[9], args.in[10], args.in[11], W1t, W2t, (LAS float*)ldsb, tid);
        LAS float* scr = (LAS float*)(ldsb + wave * (64 * TRS * 4));
        constexpr int I_IN = 64 * 55, I_GLU = 32 * 32, I_Q = 14 * 48, I_KV = 8 * 64, I_OUT = 64 * 64, I_UP = 64 * 172, I_DN = 172 * 64;
#define TR_M(off, W_, K_, N_, WT_, G1, G2, KS, RM, CNT) transpose_range(W_, K_, N_, WT_, G1, G2, KS, RM, scr, ((gw - (off)) % NGW + NGW) % NGW, CNT, NGW, lane)
        TR_M(0, args.in[2], 4096, 3520, Wi, args.in[3], args.in[3], 4096, RmWin(), I_IN);
        TR_M(I_IN, args.in[12], 2048, 2048, Wglu, nullptr, nullptr, 0, RmId(), I_GLU);
        TR_M(I_IN + I_GLU, args.in[14], 896, 3072, Wq, args.in[13], args.in[13], 896, RmQ(), I_Q);
        TR_M(I_IN + I_GLU + I_Q, args.in[16], 512, 4096, Wkv, args.in[15], args.in[15], 512, RmKV(), I_KV);
        TR_M(I_IN + I_GLU + I_Q + I_KV, args.in[19], 4096, 4096, Wout, args.in[17], args.in[18], 2048, RmId(), I_OUT);
        TR_M(I_IN + I_GLU + I_Q + I_KV + I_OUT, args.in[21], 4096, 11008, Wug, args.in[20], args.in[20], 4096, RmUp(), I_UP);
        TR_M(I_IN + I_GLU + I_Q + I_KV + I_OUT + I_UP, args.in[22], 4096, 11008, Wug, args.in[20], args.in[20], 4096, RmGate(), I_UP);
        TR_M(I_IN + I_GLU + I_Q + I_KV + I_OUT + 2 * I_UP, args.in[25], 11008, 4096, Wdn, nullptr, nullptr, 0, RmId(), I_DN);
#undef TR_M
        for (int i = gt; i < 320 * 512; i += NGT) { const int rr = i >> 9, c8 = (i & 511) * 8; const int row = rr < 128 ? 2944 + rr : 3648 + (rr - 128);
            *(GAS v4u*)(Wi + (size_t)row * 4096 + c8) = (v4u){0u, 0u, 0u, 0u}; }
        for (int m = gw; m < T; m += 2 * NGW) {
            const int m1 = m + NGW; const bool h1 = m1 < T;
            const float* xr0 = m < 16384 ? x_p + (size_t)m * DM : x_s + (size_t)(m - 16384) * DM; const float* xr1 = !h1 ? xr0 : (m1 < 16384 ? x_p + (size_t)m1 * DM : x_s + (size_t)(m1 - 16384) * DM);
            f32x4 v[16], w[16]; float s = 0.f, s1 = 0.f;
#pragma unroll
            for (int j = 0; j < 16; ++j) v[j] = *((const GAS f32x4*)xr0 + lane + 64 * j);
#pragma unroll
            for (int j = 0; j < 16; ++j) w[j] = *((const GAS f32x4*)xr1 + lane + 64 * j);
#pragma unroll
            for (int j = 0; j < 16; ++j) s += (v[j].x * v[j].x + v[j].y * v[j].y) + (v[j].z * v[j].z + v[j].w * v[j].w);
            s = wave_sum(s); if (lane == 0) rstd_x[m] = 1.0f / sqrtf(s * (1.0f / DM) + EPS);
            { GAS v2u* o8 = (GAS v2u*)(bufA + (size_t)m * DM) + lane;
#pragma unroll
              for (int j = 0; j < 16; ++j) o8[64 * j] = (v2u){pg8::cvt_pk_bf16(v[j].x, v[j].y), pg8::cvt_pk_bf16(v[j].z, v[j].w)}; }
            if (h1) {
#pragma unroll
                for (int j = 0; j < 16; ++j) s1 += (w[j].x * w[j].x + w[j].y * w[j].y) + (w[j].z * w[j].z + w[j].w * w[j].w);
                s1 = wave_sum(s1); if (lane == 0) rstd_x[m1] = 1.0f / sqrtf(s1 * (1.0f / DM) + EPS);
                GAS v2u* o8 = (GAS v2u*)(bufA + (size_t)m1 * DM) + lane;
#pragma unroll
                for (int j = 0; j < 16; ++j) o8[64 * j] = (v2u){pg8::cvt_pk_bf16(w[j].x, w[j].y), pg8::cvt_pk_bf16(w[j].z, w[j].w)}; } }
        for (int i = gt; i < 8192 * 32; i += NGT) { const int pos = i >> 5, k = i & 31; const double inv = exp(-(double)k * (9.210340371976184 / 32.0));
            double s, c; sincos_d((double)pos * inv, s, c); *(GAS f32x2*)(ropetab + (size_t)i * 2) = (f32x2){(float)c, (float)s}; }
    }
    SEAM(0);

#pragma unroll 1
    for (int rep = 0; rep < PROBE_P1; ++rep)
    if (IN(1)) {
        PHB;
        pg8::Gemm g{bufA, Wi, DM, DM, DM}; pg8::StaticOrder S; S.init(T, 3840, G, bx);
        pg8::EpiWin E{rstd_x, X, qlat, kvlat, krope, stQ, stKV, ropetab};
        pg8::gemm_phase(ldsb, g, S, E, tid);
    }
    SEAM(1);

    if (IN(2)) {
        PHB;
        pg8::Gemm g{X + 256, W1t, 512, 256, 256}; pg8::GroupOrder S{768, 6, G, bx};
        pg8::EpiSsm1 E{X};
        pg8::gemm_phase(ldsb, g, S, E, tid);
        for (int r = gt; r < T; r += NGT) { float s = 0.f;
#pragma unroll
            for (int j = 0; j < 4; ++j) { const f32x4 v = *(const GAS f32x4*)(stQ + (size_t)r * 16 + 4 * j); s += (v.x + v.y) + (v.z + v.w); }
            rstd_q[r] = 1.0f / sqrtf(s * (1.0f / QLAT) + EPS); float s2 = 0.f;
#pragma unroll
            for (int j = 0; j < 2; ++j) { const f32x4 v = *(const GAS f32x4*)(stKV + (size_t)r * 8 + 4 * j); s2 += (v.x + v.y) + (v.z + v.w); }
            rstd_kv[r] = 1.0f / sqrtf(s2 * (1.0f / KVLAT) + EPS); }
    }
    SEAM(2);

    if (IN(3)) {
        PHB;
        const bool scan_cu = (G == 256) ? ((vcu & 1) == 0) : true;
        if (G == 256 ? scan_cu : (wave < 4)) { const int task = (G == 256) ? (vcu >> 1) * 8 + wave : vcu * 4 + wave;
            if (task < 1024) { const int seq = task >> 8, g = (task >> 1) & 127, dir = task & 1, p = lane;
                const int c0 = seq < 2 ? seq * 512 : 1024 + (seq - 2) * 256, nc = seq < 2 ? 512 : 256;
                const double dt = exp((double)args.in[10][dir * 128 + g]); const double are = args.in[4][(dir * 128 + g) * 64 + p], aim = args.in[5][(dir * 128 + g) * 64 + p];
                const double mag = exp(16.0 * dt * are); double sn, cs; sincos_d(16.0 * dt * aim, sn, cs);
                const float ar = (float)(mag * cs), ai = (float)(mag * sn);
                GAS bf16* Xg = (GAS bf16*)X + (size_t)g * NCHUNK * 512 + dir * 128 + p;
                float zr = 0.f, zi = 0.f;
                for (int cb = 0; cb < nc; cb += 16) {
                    unsigned short sre[16], sim[16];
#pragma unroll
                    for (int i = 0; i < 16; ++i) { const int c = dir ? (c0 + nc - 1 - (cb + i)) : (c0 + cb + i); sre[i] = Xg[(size_t)c * 512]; sim[i] = Xg[(size_t)c * 512 + 64]; }
#pragma unroll
                    for (int i = 0; i < 16; ++i) { const int c = dir ? (c0 + nc - 1 - (cb + i)) : (c0 + cb + i);
                        Xg[(size_t)c * 512] = (bf16)f2bf(zr); Xg[(size_t)c * 512 + 64] = (bf16)f2bf(zi);
                        const float sr = bf2f(sre[i]), si = bf2f(sim[i]); const float nr = ar * zr - ai * zi + sr, ni = ar * zi + ai * zr + si; zr = nr; zi = ni; }
                }
            }
        }
        __syncthreads();
        if (G == 256) { pg8::Gemm g{qlat, Wq, QLAT, QLAT, QLAT}; pg8::RangeOrder S{scan_cu ? (vcu >> 1) * 3 : 384 + (vcu >> 1) * 6, scan_cu ? 3 : 6, 12}; pg8::EpiQ E{rstd_q, bufB, ropetab}; pg8::gemm_phase(ldsb, g, S, E, tid); }
        else { pg8::Gemm g{qlat, Wq, QLAT, QLAT, QLAT}; pg8::StaticOrder S; S.init(T, QW, G, bx); pg8::EpiQ E{rstd_q, bufB, ropetab}; pg8::gemm_phase(ldsb, g, S, E, tid); }
        { pg8::Gemm g{kvlat, Wkv, KVLAT, KVLAT, KVLAT}; pg8::StaticOrder S; S.init(T, 2048, G, bx); pg8::EpiKV E{rstd_kv, kvb}; pg8::gemm_phase(ldsb, g, S, E, tid); }
        { pg8::Gemm g{Wkv + (size_t)2048 * KVLAT, kvlat, KVLAT, KVLAT, KVLAT}; pg8::StaticOrder S; S.init(2048, T, G, bx); pg8::EpiVT E{rstd_kv, vtb}; pg8::gemm_phase(ldsb, g, S, E, tid); }
    }
    SEAM(3);

    if (IN(4)) {
        PHB;
        pg8::Gemm g{X, W2t, 512, 512, 512}; pg8::GroupOrder S{768, 6, G, bx};
        pg8::EpiSsm2 E{gact};
        pg8::gemm_phase(ldsb, g, S, E, tid);
    }
    SEAM(4);

    if (IN(5)) {
        PHB;
#ifndef NO_GLU
        { pg8::Gemm g{gact, Wglu, MIXW, MIXW, MIXW}; pg8::StaticOrder S; S.init(T, MIXW, G, bx); pg8::EpiGlu E{gact, mrg, stA}; pg8::gemm_phase(ldsb, g, S, E, tid); }
#endif
#ifndef NO_ATTN
        const int xcd = vcu >> 5, cc = vcu & 31; const int nun = (G == 256) ? 6 : (1536 - bx + G - 1) / G;
#pragma unroll 1
        for (int i = 0; i < nun; ++i) {
            int bh, qb, seq, rowbase;
            if (G == 256) { if (i < 4) { bh = xcd * 4 + i; qb = cc; seq = 8192; } else { bh = xcd * 4 + 2 * (i - 4) + (cc >> 4); qb = cc & 15; seq = 4096; } }
            else { const int uidx = bx + i * G; if (uidx < 1024) { bh = uidx >> 5; qb = uidx & 31; seq = 8192; } else { const int v = uidx - 1024; bh = v >> 4; qb = v & 15; seq = 4096; } }
            const int b = bh >> 4, h = bh & 15; rowbase = (seq == 8192) ? b * 8192 : 16384 + b * 4096;
            __syncthreads();
            attn::attn_unit(bufB + (size_t)(rowbase + qb * 256) * QW + h * 192, kvb + (size_t)rowbase * 2048 + h * 128, vtb + (size_t)(h * 128) * T,
                            krope + (size_t)rowbase * 64, mrg + (size_t)(rowbase + qb * 256) * DM + 2048 + h * 128, stB + (size_t)(rowbase + qb * 256) * 16 + h, seq, rowbase, (char*)lds, wave0);
        }
#endif
    }
    SEAM(5);

    if (IN(6)) {
        PHB;
        for (int r = gt; r < T; r += NGT) { float s = 0.f;
#pragma unroll
            for (int j = 0; j < 8; ++j) { const f32x4 v = *(const GAS f32x4*)(stA + (size_t)r * 32 + 4 * j); s += (v.x + v.y) + (v.z + v.w); }
            const float r1 = 1.0f / sqrtf(s * (1.0f / MIXW) + EPS); float s2 = 0.f;
#pragma unroll
            for (int j = 0; j < 4; ++j) { const f32x4 v = *(const GAS f32x4*)(stB + (size_t)r * 16 + 4 * j); s2 += (v.x + v.y) + (v.z + v.w); }
            const float r2 = 1.0f / sqrtf(s2 * (1.0f / MIXW) + EPS); r2v[r] = r2; ratio[r] = r1 / r2; }
    }
    SEAM(6);

#pragma unroll 1
    for (int rep = 0; rep < PROBE_P7; ++rep)
    if (IN(7)) {
        PHB;
        pg8::Gemm g{mrg, Wout, DM, DM, DM}; pg8::StaticOrder S; S.init(T, DM, G, bx);
        pg8::EpiWout E{bufA, r2v, ratio, bufA, stA};
        pg8::gemm_phase(ldsb, g, S, E, tid);
    }
    SEAM(7);

    if (IN(8)) {
        PHB;
        for (int r = gt; r < T; r += NGT) { float s = 0.f;
#pragma unroll
            for (int j = 0; j < 16; ++j) { const f32x4 v = *(const GAS f32x4*)(stA + (size_t)r * 64 + 4 * j); s += (v.x + v.y) + (v.z + v.w); }
            rstd_x1[r] = 1.0f / sqrtf(s * (1.0f / DM) + EPS); }
    }
    SEAM(8);

#ifdef PROBE_DOWN
    if (IN(9)) { PHB;
#pragma unroll 1
        for (int ch = 0; ch < 3; ++ch) { pg8::Gemm g{bufB, Wdn, DFF, DFF, DFF}; pg8::StaticOrder S; S.init(8192, DM, G, bx); pg8::EpiNull E0; pg8::gemm_phase(ldsb, g, S, E0, tid); }
    }
#endif
#ifdef PROBE_KLOOP
    if (IN(9)) {
        PHB;
#pragma unroll 1
        for (int ch = 0; ch < 3; ++ch) { pg8::Gemm g{bufA + (size_t)(ch * 8192) * DM, Wug, DM, DM, DM}; pg8::StaticOrder S; S.init(8192, 2 * DFF, G, bx); pg8::EpiNull E0; pg8::gemm_phase(ldsb, g, S, E0, tid); }
    }
#endif
#pragma unroll 1
    for (int ch2 = 0; ch2 < 3 * PROBE_FA; ++ch2) {
        const int ch = ch2 / PROBE_FA; const bool lastrep = (ch2 % PROBE_FA) == PROBE_FA - 1;
        const int rb = ch * 8192;
        if (IN(9 + 3 * ch)) {
        PHB;
            pg8::Gemm g{bufA + (size_t)rb * DM, Wug, DM, DM, DM}; pg8::StaticOrder S; S.init(8192, 2 * DFF, G, bx);
            pg8::EpiFfnA E{rstd_x1, rb, bufB, hup, hgate, args.in[23], args.in[24]};
            pg8::gemm_phase(ldsb, g, S, E, tid);
        }
        SEAM(9 + 3 * ch);
        if (lastrep && IN(10 + 3 * ch)) {
        PHB;
            const float* cw = args.in[23]; const float* cb = args.in[24];
            for (int i = gt; i < 128 * 2 * (DFF / 8); i += NGT) { const int f0 = (i % (DFF / 8)) * 8, sw = i / (DFF / 8), strip = sw >> 1, which = sw & 1;
                const int lrow = strip * 64 + (which ? 63 : 0), grow = rb + lrow, pos = pos_of(grow), len = len_of(grow);
                v4u up0, up1, up2;
                if (which == 0) { up1 = *(const GAS v4u*)(hup + ((size_t)strip * 4 + 0) * DFF + f0); up2 = *(const GAS v4u*)(hup + ((size_t)strip * 4 + 1) * DFF + f0);
                    up0 = (pos == 0) ? (v4u){0u, 0u, 0u, 0u} : *(const GAS v4u*)(hup + ((size_t)(strip - 1) * 4 + 3) * DFF + f0); }
                else { up0 = *(const GAS v4u*)(hup + ((size_t)strip * 4 + 2) * DFF + f0); up1 = *(const GAS v4u*)(hup + ((size_t)strip * 4 + 3) * DFF + f0);
                    up2 = (pos == len - 1) ? (v4u){0u, 0u, 0u, 0u} : *(const GAS v4u*)(hup + ((size_t)(strip + 1) * 4 + 0) * DFF + f0); }
                const v4u gt4 = *(const GAS v4u*)(hgate + ((size_t)strip * 2 + which) * DFF + f0);
                unsigned ow[4];
#pragma unroll
                for (int k = 0; k < 4; ++k) { const int f = f0 + 2 * k;
                    const float a0 = bflo(up0[k]), a1 = bflo(up1[k]), a2 = bflo(up2[k]), b0 = bfhi(up0[k]), b1 = bfhi(up1[k]), b2 = bfhi(up2[k]);
                    const float c0 = cw[f] * a0 + cw[DFF + f] * a1 + cw[2 * DFF + f] * a2 + cb[f], c1 = cw[f + 1] * b0 + cw[DFF + f + 1] * b1 + cw[2 * DFF + f + 1] * b2 + cb[f + 1];
                    ow[k] = pk2(c0 * sigmoidf_fast(c0) * bflo(gt4[k]), c1 * sigmoidf_fast(c1) * bfhi(gt4[k])); }
                *(GAS v4u*)(bufB + (size_t)lrow * DFF + f0) = (v4u){ow[0], ow[1], ow[2], ow[3]}; }
        }
        if (lastrep) SEAM(10 + 3 * ch);
        if (lastrep && IN(11 + 3 * ch)) {
        PHB;
            pg8::Gemm g{bufB, Wdn, DFF, DFF, DFF}; pg8::StaticOrder S; S.init(8192, DM, G, bx);
            pg8::EpiDown E{bufA, rb, stA};
            pg8::gemm_phase(ldsb, g, S, E, tid);
        }
        if (lastrep) SEAM(11 + 3 * ch);
    }

    if (IN(18)) {
        PHB;
        const GAS f32x4* gr = (const GAS f32x4*)args.in[26] + 2 * lane; f32x4 gv[16];
#pragma unroll
        for (int j = 0; j < 8; ++j) { gv[2 * j] = gr[128 * j]; gv[2 * j + 1] = gr[128 * j + 1]; }
        for (int m = gw; m < T; m += 2 * NGW) { const int m1 = m + NGW; const bool h1 = m1 < T; const int mb = h1 ? m1 : m;
            const GAS v4u* xr0 = (const GAS v4u*)(bufA + (size_t)m * DM) + lane; const GAS v4u* xr1 = (const GAS v4u*)(bufA + (size_t)mb * DM) + lane;
            v4u w0[8], w1[8];
#pragma unroll
            for (int j = 0; j < 8; ++j) w0[j] = xr0[64 * j];
#pragma unroll
            for (int j = 0; j < 8; ++j) w1[j] = xr1[64 * j];
            const float s0 = wave_sum(stA[(size_t)m * 64 + lane]), s1 = wave_sum(stA[(size_t)mb * 64 + lane]);
            const float rs0 = 1.0f / sqrtf(s0 * (1.0f / DM) + EPS), rs1 = 1.0f / sqrtf(s1 * (1.0f / DM) + EPS);
            { GAS f32x4* orow = (GAS f32x4*)(xoutf + (size_t)m * DM) + 2 * lane;
#pragma unroll
              for (int j = 0; j < 8; ++j) { const v4u w = w0[j]; const f32x4 g0 = gv[2 * j], g1 = gv[2 * j + 1];
                orow[128 * j] = (f32x4){bflo(w.x) * rs0 * g0[0], bfhi(w.x) * rs0 * g0[1], bflo(w.y) * rs0 * g0[2], bfhi(w.y) * rs0 * g0[3]};
                orow[128 * j + 1] = (f32x4){bflo(w.z) * rs0 * g1[0], bfhi(w.z) * rs0 * g1[1], bflo(w.w) * rs0 * g1[2], bfhi(w.w) * rs0 * g1[3]}; } }
            if (h1) { GAS f32x4* orow = (GAS f32x4*)(xoutf + (size_t)m1 * DM) + 2 * lane;
#pragma unroll
              for (int j = 0; j < 8; ++j) { const v4u w = w1[j]; const f32x4 g0 = gv[2 * j], g1 = gv[2 * j + 1];
                orow[128 * j] = (f32x4){bflo(w.x) * rs1 * g0[0], bfhi(w.x) * rs1 * g0[1], bflo(w.y) * rs1 * g0[2], bfhi(w.y) * rs1 * g0[3]};
                orow[128 * j + 1] = (f32x4){bflo(w.z) * rs1 * g1[0], bfhi(w.z) * rs1 * g1[1], bflo(w.w) * rs1 * g1[2], bfhi(w.w) * rs1 * g1[3]}; } }
        }
    }
#undef IN
#undef SEAM
}

constexpr int N_PHASES = 19;
extern "C" void kernel_launch(void* const* d_in, const int* in_sizes, int n_in, void* d_out, int out_size, void* d_ws, size_t ws_size, hipStream_t stream) {
    static int grid = 0;
    if (grid == 0) {
        if (n_in != 27 || out_size != T * DM || ws_size < WS_END) { fprintf(stderr, "kernel_launch: unexpected shapes (n_in %d out %d ws %zu)\n", n_in, out_size, ws_size); grid = -1; return; }
        int dev = 0, cus = 0, per_cu = 0;
        if (hipGetDevice(&dev) != hipSuccess || hipDeviceGetAttribute(&cus, hipDeviceAttributeMultiprocessorCount, dev) != hipSuccess) { grid = -1; return; }
        if (hipFuncSetAttribute((const void*)enc_fwd, hipFuncAttributeMaxDynamicSharedMemorySize, LDS_BYTES) != hipSuccess) { fprintf(stderr, "kernel_launch: hipFuncSetAttribute failed\n"); grid = -1; return; }
        if (hipOccupancyMaxActiveBlocksPerMultiprocessor(&per_cu, (const void*)enc_fwd, NWAVES * 64, LDS_BYTES) != hipSuccess || per_cu < 1) { fprintf(stderr, "kernel_launch: occupancy query says %d\n", per_cu); }
        (void)hipGetLastError();
        grid = cus;
    }
    if (grid < 0) return;
    if (hipMemsetAsync((char*)d_ws + WS_CTL, 0, CTL_ZERO_BYTES, stream) != hipSuccess) return;
    Args a{};
    for (int i = 0; i < 27; ++i) a.in[i] = (const float*)d_in[i];
    a.out = (float*)d_out; a.ws = (unsigned char*)d_ws;
#ifndef MK_N_LAUNCHES
#define MK_N_LAUNCHES 1
#endif
    if (MK_N_LAUNCHES == 1) { a.ph_lo = 0; a.ph_hi = N_PHASES; hipLaunchKernelGGL(enc_fwd, dim3(grid), dim3(NWAVES * 64), LDS_BYTES, stream, a); }
    else { for (int p = 0; p < N_PHASES; ++p) { a.ph_lo = p; a.ph_hi = p + 1; hipLaunchKernelGGL(enc_fwd, dim3(grid), dim3(NWAVES * 64), LDS_BYTES, stream, a); } }
    const hipError_t le = hipPeekAtLastError();
    if (le != hipSuccess) fprintf(stderr, "kernel_launch: launch failed: %s\n", hipGetErrorName(le));
}
```

```cpp
#include <hip/hip_runtime.h>
#include <hip/hip_bf16.h>
#include <cstdio>
#include <cstdint>

namespace pg8 {
#define PG8_LAS __attribute__((address_space(3)))
typedef unsigned short bf16_t;
typedef short bf16x8 __attribute__((ext_vector_type(8)));
typedef float f32x4 __attribute__((ext_vector_type(4)));
typedef float f32x2 __attribute__((ext_vector_type(2)));
typedef unsigned u32x4 __attribute__((ext_vector_type(4)));
typedef unsigned u32x2 __attribute__((ext_vector_type(2)));
constexpr int BM = 256, BK = 64, HALF = 128, HTB = HALF * BK * 2  , STAGE_BYTES = 8 * HTB, NXCD = 8, WGM = 8;

__host__ __device__ __forceinline__ int lds_byte(int r, int c) { const int st = (r >> 4) * 2 + (c >> 5), rr = r & 15, cc = c & 31, ob = rr * 64 + cc * 2; return st * 1024 + (ob ^ (((ob >> 9) & 1) << 5)); }
__host__ __device__ __forceinline__ void stage_rc(int b, int& R, int& C) { const int st = b / 1024, sb = b % 1024, swz = sb ^ (((sb >> 9) & 1) << 5); R = (st >> 1) * 16 + swz / 64; C = (st & 1) * 32 + (swz % 64) / 2; }
__host__ __device__ __forceinline__ int perm32(int rho) { const int n = rho >> 4, i = rho & 15; return 8 * (i >> 2) + 4 * n + (i & 3); }

struct Unit { int pm, pn; };
struct Gemm { const bf16_t* A; const bf16_t* Bt; int lda, ldb, K; };

struct StaticOrder {
    int nM, nN, nwg, G, c;
    __host__ __device__ void init(int M, int N, int G_, int c_) { nM = M / BM; nN = N / BM; nwg = nM * nN; G = G_; c = c_; }
    __host__ __device__ bool next(int i, Unit& u) const {
        const long L = (long)i * G + c; if (L >= nwg) return false;
        int wgid = (int)L; { const int q = nwg / NXCD, r = nwg % NXCD, xcd = wgid % NXCD, off = wgid / NXCD; wgid = (xcd < r ? xcd * (q + 1) : r * (q + 1) + (xcd - r) * q) + off; }
        const int nig = WGM * nN, gid = wgid / nig, fm = gid * WGM, gsz = (nM - fm) < WGM ? (nM - fm) : WGM;
        u.pm = fm + ((wgid % nig) % gsz); u.pn = (wgid % nig) / gsz; return true;
    }
};
struct ZeroOrder { int n, G, c; __host__ __device__ bool next(int i, Unit& u) const { const long L = (long)i * G + c; if (L >= n) return false; u.pm = 0; u.pn = 0; return true; } };
struct RangeOrder { int base, n, nN; __host__ __device__ bool next(int i, Unit& u) const { if (i >= n) return false; const int L = base + i; u.pm = L / nN; u.pn = L % nN; return true; } };
struct GroupOrder {
    int n, per, G, c;
    __host__ __device__ bool next(int i, Unit& u) const { const long L = (long)i * G + c; if (L >= n) return false; u.pm = (int)L; u.pn = (int)L / per; return true; }
};

__device__ __forceinline__ unsigned cvt_pk_bf16(float lo, float hi) { unsigned r; asm volatile("v_cvt_pk_bf16_f32 %0, %1, %2" : "=v"(r) : "v"(lo), "v"(hi)); return r; }
__device__ __forceinline__ u32x4 pack8(const f32x4 a, const f32x4 b) { u32x4 w; w.x = cvt_pk_bf16(a[0], a[1]); w.y = cvt_pk_bf16(a[2], a[3]); w.z = cvt_pk_bf16(b[0], b[1]); w.w = cvt_pk_bf16(b[2], b[3]); return w; }

template <class Epi, class Sched>
__device__ __forceinline__ void gemm_phase(PG8_LAS unsigned char* lds, const Gemm g, const Sched& S, const Epi& E, int tid_in) {
    int tid_l = tid_in; asm volatile("" : "+v"(tid_l));
    const int tid = tid_l, wid = __builtin_amdgcn_readfirstlane(tid >> 6), lane = tid & 63, wr = wid >> 2, wc = wid & 3, fr = lane & 15, fq = lane >> 4;
    const int K = g.K, nt = K / BK;
    unsigned voffA[2], voffB[2];
#pragma unroll
    for (int i = 0; i < 2; ++i) { int R, C; stage_rc(tid * 16 + i * 8192, R, C); const int Rb = Epi::PERM ? ((R & ~31) + perm32(R & 31)) : R;
        voffA[i] = (unsigned)(R * g.lda + C) * 2u; voffB[i] = (unsigned)(Rb * g.ldb + C) * 2u; }
    asm volatile("" : "+v"(voffA[0]), "+v"(voffA[1]), "+v"(voffB[0]), "+v"(voffB[1]));
    const size_t kstep = (size_t)(BK * 2);
    const size_t hstepA = (size_t)HALF * g.lda * 2, hstepB = (size_t)HALF * g.ldb * 2;
    const size_t tstepA = 2 * hstepA, tstepB = 2 * hstepB;
    const unsigned ldsw = (unsigned)wid * 1024u;
    const int aoff = lds_byte(wr * 64 + fr, fq * 8), boff = lds_byte(wc * 32 + fr, fq * 8);
#define PG8_SA(b, h) (((b) * 2 + (h)) * HTB)
#define PG8_SB(b, h) ((4 + (b) * 2 + (h)) * HTB)
#define PG8_STAGE(bufoff, gbase, voff) do { _Pragma("unroll") for (int _i = 0; _i < 2; ++_i) \
        __builtin_amdgcn_global_load_lds((const unsigned*)((const char*)(gbase) + (voff)[_i]), (PG8_LAS unsigned*)(lds + (bufoff) + ldsw + _i * 8192), 16, 0, 0); } while (0)
#define PG8_LDA(dst, b, h) do { _Pragma("unroll") for (int m = 0; m < 4; ++m) _Pragma("unroll") for (int k = 0; k < 2; ++k) dst[m][k] = *(const PG8_LAS bf16x8*)(lds + PG8_SA(b, h) + aoff + m * 2048 + k * 1024); } while (0)
#define PG8_LDB(dst, b, h) do { _Pragma("unroll") for (int n = 0; n < 2; ++n) _Pragma("unroll") for (int k = 0; k < 2; ++k) dst[n][k] = *(const PG8_LAS bf16x8*)(lds + PG8_SB(b, h) + boff + n * 2048 + k * 1024); } while (0)
#define PG8_MMA(ai, bj, At, Bt) do { __builtin_amdgcn_s_setprio(1); _Pragma("unroll") for (int m = 0; m < 4; ++m) _Pragma("unroll") for (int n = 0; n < 2; ++n) _Pragma("unroll") for (int k = 0; k < 2; ++k) \
        acc[ai][bj][m][n] = __builtin_amdgcn_mfma_f32_16x16x32_bf16(Bt[n][k], At[m][k], acc[ai][bj][m][n], 0, 0, 0); __builtin_amdgcn_s_setprio(0); } while (0)
#define PG8_WAIT_V(n) asm volatile("s_waitcnt vmcnt(" #n ")" ::: "memory")
#define PG8_WAIT_L(n) asm volatile("s_waitcnt lgkmcnt(" #n ")" ::: "memory")
#define PG8_BAR __builtin_amdgcn_s_barrier()
#define PG8_SCHED __builtin_amdgcn_sched_barrier(0)
    Unit cur, nxt; int ui = 0;
    if (!S.next(0, cur)) return;
    f32x4 acc[2][2][4][2];
#pragma unroll
    for (int a = 0; a < 2; ++a)
#pragma unroll
        for (int b = 0; b < 2; ++b)
#pragma unroll
            for (int m = 0; m < 4; ++m)
#pragma unroll
                for (int n = 0; n < 2; ++n) acc[a][b][m][n] = (f32x4){0.f, 0.f, 0.f, 0.f};
    bf16x8 At[4][2], B0[2][2], B1[2][2];
    const char* cA = (const char*)g.A + (size_t)cur.pm * tstepA; const char* cB = (const char*)g.Bt + (size_t)cur.pn * tstepB;
    PG8_STAGE(PG8_SB(0, 0), cB, voffB); PG8_STAGE(PG8_SB(0, 1), cB + hstepB, voffB); PG8_STAGE(PG8_SA(0, 0), cA, voffA); PG8_STAGE(PG8_SA(0, 1), cA + hstepA, voffA);
    if (wr == 1) PG8_BAR;
    PG8_WAIT_V(2); PG8_BAR;
    PG8_STAGE(PG8_SB(1, 0), cB + kstep, voffB); PG8_STAGE(PG8_SA(1, 0), cA + kstep, voffA); PG8_STAGE(PG8_SB(1, 1), cB + hstepB + kstep, voffB);
    PG8_WAIT_V(6); PG8_BAR;
    for (;;) {
        const bool has_next = S.next(ui + 1, nxt);
        const char* nA = has_next ? (const char*)g.A + (size_t)nxt.pm * tstepA : cA; const char* nB = has_next ? (const char*)g.Bt + (size_t)nxt.pn * tstepB : cB;
#pragma unroll 1
        for (int t = 0; t < nt; t += 2) {
            const bool last = (t == nt - 2);
            if constexpr (Epi::MIDK) { if (t == (nt >> 1)) E.midk(acc, cur, wr, fr); }
            const char* a1 = cA + (size_t)(t + 1) * kstep;
            const char* a2 = last ? nA : cA + (size_t)(t + 2) * kstep; const char* b2 = last ? nB : cB + (size_t)(t + 2) * kstep;
            const char* a3 = a2 + kstep; const char* b3 = b2 + kstep;
            PG8_LDB(B0, 0, 0); PG8_LDB(B1, 0, 1); PG8_SCHED; PG8_LDA(At, 0, 0); PG8_STAGE(PG8_SA(1, 1), a1 + hstepA, voffA);
            PG8_WAIT_V(8); PG8_WAIT_L(0); PG8_BAR; PG8_MMA(0, 0, At, B0); PG8_MMA(0, 1, At, B1); PG8_BAR; PG8_SCHED;
            PG8_LDA(At, 0, 1); PG8_STAGE(PG8_SB(0, 0), b2, voffB); PG8_STAGE(PG8_SB(0, 1), b2 + hstepB, voffB); PG8_STAGE(PG8_SA(0, 0), a2, voffA);
            PG8_WAIT_V(8); PG8_WAIT_L(0); PG8_BAR; PG8_MMA(1, 0, At, B0); PG8_MMA(1, 1, At, B1); PG8_BAR; PG8_SCHED;
            PG8_LDB(B0, 1, 0); PG8_LDB(B1, 1, 1); PG8_SCHED; PG8_LDA(At, 1, 0); PG8_STAGE(PG8_SA(0, 1), a2 + hstepA, voffA);
            PG8_WAIT_V(8); PG8_WAIT_L(0); PG8_BAR; PG8_MMA(0, 0, At, B0); PG8_MMA(0, 1, At, B1); PG8_BAR; PG8_SCHED;
            PG8_LDA(At, 1, 1); PG8_STAGE(PG8_SB(1, 0), b3, voffB); PG8_STAGE(PG8_SB(1, 1), b3 + hstepB, voffB); PG8_STAGE(PG8_SA(1, 0), a3, voffA);
            PG8_WAIT_V(8); PG8_WAIT_L(0); PG8_BAR; PG8_MMA(1, 0, At, B0); PG8_MMA(1, 1, At, B1); PG8_BAR; PG8_SCHED;
        }
        if (wr == 0) PG8_BAR;
        E(acc, cur, wr, wc, fr, fq);
        if (!has_next) break;
#pragma unroll
        for (int a = 0; a < 2; ++a)
#pragma unroll
            for (int b = 0; b < 2; ++b)
#pragma unroll
                for (int m = 0; m < 4; ++m)
#pragma unroll
                    for (int n = 0; n < 2; ++n) acc[a][b][m][n] = (f32x4){0.f, 0.f, 0.f, 0.f};
        cur = nxt; cA = nA; cB = nB; ++ui;
        if (wr == 1) PG8_BAR;
    }
    PG8_WAIT_V(0);
    PG8_BAR;
#undef PG8_SA
#undef PG8_SB
#undef PG8_STAGE
#undef PG8_LDA
#undef PG8_LDB
#undef PG8_MMA
#undef PG8_WAIT_V
#undef PG8_WAIT_L
#undef PG8_BAR
#undef PG8_SCHED
}
}

constexpr int T = 24576, DM = 4096, DFF = 11008;
constexpr int NCHUNK = T / 16;
constexpr int QLAT = 896, KVLAT = 512, QW = 3072, KVW = 4096, MIXW = 2048;
constexpr float EPS = 1e-6f;
__device__ __forceinline__ int pos_of(int r) { return r < 16384 ? (r & 8191) : (r & 4095); }
__device__ __forceinline__ int len_of(int r) { return r < 16384 ? 8192 : 4096; }

typedef unsigned short bf16;
#define GAS __attribute__((address_space(1)))
#define LAS __attribute__((address_space(3)))
typedef unsigned v4u __attribute__((ext_vector_type(4)));
typedef unsigned v2u __attribute__((ext_vector_type(2)));
typedef float f32x4 __attribute__((ext_vector_type(4)));
typedef float f32x2 __attribute__((ext_vector_type(2)));
typedef short bf16x8 __attribute__((ext_vector_type(8)));

__device__ __forceinline__ unsigned f2bf(float f) { unsigned u = __builtin_bit_cast(unsigned, f); return (u + 0x7fffu + ((u >> 16) & 1u)) >> 16; }
__device__ __forceinline__ unsigned pk2(float lo, float hi) { return f2bf(lo) | (f2bf(hi) << 16); }
__device__ __forceinline__ float bf2f(unsigned short b) { return __builtin_bit_cast(float, (unsigned)b << 16); }
__device__ __forceinline__ float bflo(unsigned w) { return __builtin_bit_cast(float, w << 16); }
__device__ __forceinline__ float bfhi(unsigned w) { return __builtin_bit_cast(float, w & 0xffff0000u); }
__device__ __forceinline__ float sigmoidf_fast(float x) { return __builtin_amdgcn_rcpf(1.0f + __builtin_amdgcn_exp2f(-1.4426950408889634f * x)); }
__device__ __forceinline__ float gelu_tanh(float y) { const float in = 1.5957691216057308f * (y + 0.044715f * y * y * y); return y * sigmoidf_fast(in); }

namespace pg8 {
#define EPI_ROWS const int row0 = u.pm * 256 + wr * 64 + fr
__device__ __forceinline__ float sq8(const f32x4 a, const f32x4 b) { return (a[0] * a[0] + a[1] * a[1]) + (a[2] * a[2] + a[3] * a[3]) + (b[0] * b[0] + b[1] * b[1]) + (b[2] * b[2] + b[3] * b[3]); }
__device__ __forceinline__ float red_fq(float s) { s += __shfl_xor(s, 16); s += __shfl_xor(s, 32); return s; }

__device__ __forceinline__ f32x4 rope4(const f32x4 v, const f32x4 cs) { f32x4 o; o[0] = v[0] * cs[0] - v[1] * cs[1]; o[1] = v[1] * cs[0] + v[0] * cs[1]; o[2] = v[2] * cs[2] - v[3] * cs[3]; o[3] = v[3] * cs[2] + v[2] * cs[3]; return o; }

#define LAUNDER(p) asm volatile("" : "+v"(p))
struct EpiNull { static constexpr bool PERM = true, MIDK = false;
    __device__ __forceinline__ void midk(f32x4 (&)[2][2][4][2], const Unit&, int, int) const {}
    __device__ __forceinline__ void operator()(const f32x4 (&acc)[2][2][4][2], const Unit& u, int wr, int wc, int fr, int fq) const {
#pragma unroll
        for (int ai = 0; ai < 2; ++ai)
#pragma unroll
            for (int bj = 0; bj < 2; ++bj)
                asm volatile("" :: "v"(acc[ai][bj][0][0]), "v"(acc[ai][bj][0][1]), "v"(acc[ai][bj][1][0]), "v"(acc[ai][bj][1][1]), "v"(acc[ai][bj][2][0]), "v"(acc[ai][bj][2][1]), "v"(acc[ai][bj][3][0]), "v"(acc[ai][bj][3][1]));
    } };
struct EpiWin {
    static constexpr bool PERM = true, MIDK = false;
    const float* rstd_x; bf16_t* X; bf16_t* qlat; bf16_t* kvlat; bf16_t* krope; float* stQ; float* stKV; const float* ropetab;
    __device__ __forceinline__ void midk(f32x4 (&)[2][2][4][2], const Unit&, int, int) const {}
    __device__ __forceinline__ void operator()(const f32x4 (&acc)[2][2][4][2], const Unit& u, int wr, int wc, int fr, int fq) const {
        EPI_ROWS; const int tile = u.pn;
        const GAS float* rsp = (const GAS float*)(rstd_x + row0); LAUNDER(rsp);
        if (tile < 8) {
            const int c0 = tile * 256 + wc * 32 + 8 * fq;
            GAS bf16_t* xp0 = (GAS bf16_t*)X + ((size_t)((c0 >> 4) * NCHUNK + (row0 >> 4)) * 512 + 256 + (row0 & 15) * 16 + (c0 & 15)); LAUNDER(xp0);
#pragma unroll
            for (int ai = 0; ai < 2; ++ai)
#pragma unroll
                for (int m = 0; m < 4; ++m) { const float rs = rsp[ai * 128 + m * 16];
#pragma unroll
                    for (int bj = 0; bj < 2; ++bj)
                        *(GAS u32x4*)(xp0 + ((size_t)(bj * 8) * NCHUNK + ai * 8 + m) * 512) = pack8(acc[ai][bj][m][0] * rs, acc[ai][bj][m][1] * rs); }
        } else if (tile < 14) {
            const bool isq = tile < 12; const int tl = isq ? tile - 8 : tile - 12; const int ld = isq ? QLAT : KVLAT;
            const int c0 = tl * 256 + wc * 32 + 8 * fq;
            GAS bf16_t* op = (GAS bf16_t*)(isq ? qlat : kvlat) + (size_t)row0 * ld + c0; GAS float* sp = (GAS float*)(isq ? stQ + (size_t)row0 * 16 : stKV + (size_t)row0 * 8) + tl * 4 + wc; LAUNDER(op); LAUNDER(sp);
#pragma unroll
            for (int ai = 0; ai < 2; ++ai)
#pragma unroll
                for (int m = 0; m < 4; ++m) { const float rs = rsp[ai * 128 + m * 16]; float ss = 0.f;
#pragma unroll
                    for (int bj = 0; bj < 2; ++bj) { const f32x4 v0 = acc[ai][bj][m][0] * rs, v1 = acc[ai][bj][m][1] * rs; ss += sq8(v0, v1);
                        if (c0 + bj * 128 < ld) *(GAS u32x4*)(op + (size_t)(ai * 128 + m * 16) * ld + bj * 128) = pack8(v0, v1); }
                    ss = red_fq(ss); if (fq == 0) sp[(size_t)(ai * 128 + m * 16) * (isq ? 16 : 8)] = ss; }
        } else {
            if (wc < 2) { const int c = wc * 32 + 8 * fq;
                GAS bf16_t* op = (GAS bf16_t*)krope + (size_t)row0 * 64 + c; LAUNDER(op);
#pragma unroll
                for (int ai = 0; ai < 2; ++ai)
#pragma unroll
                    for (int m = 0; m < 4; ++m) { const int row = row0 + ai * 128 + m * 16; const float rs = rsp[ai * 128 + m * 16]; const int pos = pos_of(row);
                        const f32x4 cs0 = *(const GAS f32x4*)((const GAS float*)ropetab + (size_t)pos * 64 + c), cs1 = *(const GAS f32x4*)((const GAS float*)ropetab + (size_t)pos * 64 + c + 4);
                        const f32x4 v0 = rope4(acc[ai][0][m][0] * rs, cs0), v1 = rope4(acc[ai][0][m][1] * rs, cs1);
                        *(GAS u32x4*)(op + (size_t)(ai * 128 + m * 16) * 64) = pack8(v0, v1); } }
        }
    }
};
struct EpiSsm1 {
    static constexpr bool PERM = true, MIDK = false;
    bf16_t* X;
    __device__ __forceinline__ void midk(f32x4 (&)[2][2][4][2], const Unit&, int, int) const {}
    __device__ __forceinline__ void operator()(const f32x4 (&acc)[2][2][4][2], const Unit& u, int wr, int wc, int fr, int fq) const {
        EPI_ROWS; GAS bf16_t* op = (GAS bf16_t*)X + (size_t)row0 * 512 + wc * 32 + 8 * fq; LAUNDER(op);
#pragma unroll
        for (int ai = 0; ai < 2; ++ai)
#pragma unroll
            for (int m = 0; m < 4; ++m)
#pragma unroll
                for (int bj = 0; bj < 2; ++bj) *(GAS u32x4*)(op + (size_t)(ai * 128 + m * 16) * 512 + bj * 128) = pack8(acc[ai][bj][m][0], acc[ai][bj][m][1]);
    }
};
struct EpiSsm2 {
    static constexpr bool PERM = true, MIDK = false;
    bf16_t* gact;
    __device__ __forceinline__ void midk(f32x4 (&)[2][2][4][2], const Unit&, int, int) const {}
    __device__ __forceinline__ void operator()(const f32x4 (&acc)[2][2][4][2], const Unit& u, int wr, int wc, int fr, int fq) const {
        EPI_ROWS; const int g = u.pn; const int c0 = wc * 32 + 8 * fq;
        GAS bf16_t* op = (GAS bf16_t*)gact + ((size_t)(row0 - g * NCHUNK) * 16 + (c0 >> 4)) * MIXW + g * 16 + (c0 & 15); LAUNDER(op);
#pragma unroll
        for (int ai = 0; ai < 2; ++ai)
#pragma unroll
            for (int m = 0; m < 4; ++m)
#pragma unroll
                for (int bj = 0; bj < 2; ++bj) { f32x4 v0 = acc[ai][bj][m][0], v1 = acc[ai][bj][m][1];
#pragma unroll
                    for (int e = 0; e < 4; ++e) { v0[e] = gelu_tanh(v0[e]); v1[e] = gelu_tanh(v1[e]); }
                    *(GAS u32x4*)(op + ((size_t)(ai * 128 + m * 16) * 16 + bj * 8) * MIXW) = pack8(v0, v1); }
    }
};
struct EpiQ {
    static constexpr bool PERM = true, MIDK = false;
    const float* rstd_q; bf16_t* q; const float* ropetab;
    __device__ __forceinline__ void midk(f32x4 (&)[2][2][4][2], const Unit&, int, int) const {}
    __device__ __forceinline__ void operator()(const f32x4 (&acc)[2][2][4][2], const Unit& u, int wr, int wc, int fr, int fq) const {
        EPI_ROWS; const GAS float* rsp = (const GAS float*)(rstd_q + row0); GAS bf16_t* op = (GAS bf16_t*)q + (size_t)row0 * QW + u.pn * 256 + wc * 32 + 8 * fq; LAUNDER(rsp); LAUNDER(op);
#pragma unroll
        for (int ai = 0; ai < 2; ++ai)
#pragma unroll
            for (int m = 0; m < 4; ++m) { const int row = row0 + ai * 128 + m * 16; const float rs = rsp[ai * 128 + m * 16] * 0.10411754627697264f;     const int pos = pos_of(row);
#pragma unroll
                for (int bj = 0; bj < 2; ++bj) { const int strip = 8 * u.pn + 4 * bj + wc, s6 = strip % 6;
                    f32x4 v0 = acc[ai][bj][m][0] * rs, v1 = acc[ai][bj][m][1] * rs;
                    if (s6 >= 4) { const int pc = (s6 - 4) * 32 + 8 * fq;
                        const f32x4 cs0 = *(const GAS f32x4*)((const GAS float*)ropetab + (size_t)pos * 64 + pc), cs1 = *(const GAS f32x4*)((const GAS float*)ropetab + (size_t)pos * 64 + pc + 4);
                        v0 = rope4(v0, cs0); v1 = rope4(v1, cs1); }
                    *(GAS u32x4*)(op + (size_t)(ai * 128 + m * 16) * QW + bj * 128) = pack8(v0, v1); } }
    }
};
struct EpiKV {
    static constexpr bool PERM = true, MIDK = false;
    const float* rstd_kv; bf16_t* kv;
    __device__ __forceinline__ void midk(f32x4 (&)[2][2][4][2], const Unit&, int, int) const {}
    __device__ __forceinline__ void operator()(const f32x4 (&acc)[2][2][4][2], const Unit& u, int wr, int wc, int fr, int fq) const {
        EPI_ROWS; const GAS float* rsp = (const GAS float*)(rstd_kv + row0); GAS bf16_t* op = (GAS bf16_t*)kv + (size_t)row0 * 2048 + u.pn * 256 + wc * 32 + 8 * fq; LAUNDER(rsp); LAUNDER(op);
#pragma unroll
        for (int ai = 0; ai < 2; ++ai)
#pragma unroll
            for (int m = 0; m < 4; ++m) { const float rs = rsp[ai * 128 + m * 16];
#pragma unroll
                for (int bj = 0; bj < 2; ++bj) *(GAS u32x4*)(op + (size_t)(ai * 128 + m * 16) * 2048 + bj * 128) = pack8(acc[ai][bj][m][0] * rs, acc[ai][bj][m][1] * rs); }
    }
};
struct EpiVT {
    static constexpr bool PERM = true, MIDK = false;
    const float* rstd_kv; bf16_t* vt;
    __device__ __forceinline__ void midk(f32x4 (&)[2][2][4][2], const Unit&, int, int) const {}
    __device__ __forceinline__ void operator()(const f32x4 (&acc)[2][2][4][2], const Unit& u, int wr, int wc, int fr, int fq) const {
        EPI_ROWS; const int c0 = u.pn * 256 + wc * 32 + 8 * fq; const GAS float* rsp = (const GAS float*)(rstd_kv + c0); GAS bf16_t* op = (GAS bf16_t*)vt + (size_t)row0 * T + c0; LAUNDER(rsp); LAUNDER(op);
        GAS bf16_t* opp = op - 8 * fq + 16 * (fq & 1) + 4 * (fq >> 1);
#pragma unroll
        for (int bj = 0; bj < 2; ++bj) { const f32x4 r0 = *(const GAS f32x4*)(rsp + bj * 128), r1 = *(const GAS f32x4*)(rsp + bj * 128 + 4);
#pragma unroll
            for (int ai = 0; ai < 2; ++ai)
#pragma unroll
                for (int m = 0; m < 4; ++m) { const u32x4 w = pack8(acc[ai][bj][m][0] * r0, acc[ai][bj][m][1] * r1); GAS bf16_t* q_ = opp + (size_t)(ai * 128 + m * 16) * T + bj * 128;
                    *(GAS u32x2*)q_ = (u32x2){w.x, w.y}; *(GAS u32x2*)(q_ + 8) = (u32x2){w.z, w.w}; } }
    }
};
struct EpiGlu {
    static constexpr bool PERM = true, MIDK = false;
    const bf16_t* gact; bf16_t* merged; float* stA;
    __device__ __forceinline__ void midk(f32x4 (&)[2][2][4][2], const Unit&, int, int) const {}
    __device__ __forceinline__ void operator()(const f32x4 (&acc)[2][2][4][2], const Unit& u, int wr, int wc, int fr, int fq) const {
        EPI_ROWS; const int c0 = u.pn * 256 + wc * 32 + 8 * fq;
        const GAS bf16_t* gp = (const GAS bf16_t*)gact + (size_t)row0 * MIXW + c0; GAS bf16_t* op = (GAS bf16_t*)merged + (size_t)row0 * DM + c0; GAS float* sp = (GAS float*)stA + (size_t)row0 * 32 + u.pn * 4 + wc; LAUNDER(gp); LAUNDER(op); LAUNDER(sp);
#pragma unroll
        for (int ai = 0; ai < 2; ++ai)
#pragma unroll
            for (int m = 0; m < 4; ++m) { float ss = 0.f;
#pragma unroll
                for (int bj = 0; bj < 2; ++bj) {
                    const u32x4 gw = *(const GAS u32x4*)(gp + (size_t)(ai * 128 + m * 16) * MIXW + bj * 128);
                    f32x4 v0, v1; const f32x4 a0 = acc[ai][bj][m][0], a1 = acc[ai][bj][m][1];
                    v0[0] = bflo(gw.x) * sigmoidf_fast(a0[0]); v0[1] = bfhi(gw.x) * sigmoidf_fast(a0[1]); v0[2] = bflo(gw.y) * sigmoidf_fast(a0[2]); v0[3] = bfhi(gw.y) * sigmoidf_fast(a0[3]);
                    v1[0] = bflo(gw.z) * sigmoidf_fast(a1[0]); v1[1] = bfhi(gw.z) * sigmoidf_fast(a1[1]); v1[2] = bflo(gw.w) * sigmoidf_fast(a1[2]); v1[3] = bfhi(gw.w) * sigmoidf_fast(a1[3]);
                    ss += sq8(v0, v1);
                    *(GAS u32x4*)(op + (size_t)(ai * 128 + m * 16) * DM + bj * 128) = pack8(v0, v1); }
                ss = red_fq(ss); if (fq == 0) sp[(size_t)(ai * 128 + m * 16) * 32] = ss; }
    }
};
struct EpiWout {
    static constexpr bool PERM = true, MIDK = true;
    const bf16_t* xb; const float* r2; const float* ratio; bf16_t* x1b; float* stA;
    __device__ __forceinline__ void midk(f32x4 (&acc)[2][2][4][2], const Unit& u, int wr, int fr) const {
        EPI_ROWS; const GAS float* rp = (const GAS float*)(ratio + row0); LAUNDER(rp);
#pragma unroll
        for (int ai = 0; ai < 2; ++ai)
#pragma unroll
            for (int m = 0; m < 4; ++m) { const float rt = rp[ai * 128 + m * 16];
#pragma unroll
                for (int bj = 0; bj < 2; ++bj)
#pragma unroll
                    for (int n = 0; n < 2; ++n) acc[ai][bj][m][n] *= rt; }
    }
    __device__ __forceinline__ void operator()(const f32x4 (&acc)[2][2][4][2], const Unit& u, int wr, int wc, int fr, int fq) const {
        EPI_ROWS; const int c0 = u.pn * 256 + wc * 32 + 8 * fq;
        const GAS float* rsp = (const GAS float*)(r2 + row0); const GAS bf16_t* bi = (const GAS bf16_t*)xb + (size_t)row0 * DM + c0; GAS bf16_t* bo = (GAS bf16_t*)x1b + (size_t)row0 * DM + c0;
        GAS float* sp = (GAS float*)stA + (size_t)row0 * 64 + u.pn * 4 + wc;
        LAUNDER(rsp); LAUNDER(bi); LAUNDER(bo); LAUNDER(sp);
#pragma unroll
        for (int ai = 0; ai < 2; ++ai)
#pragma unroll
            for (int m = 0; m < 4; ++m) { const float rs = rsp[ai * 128 + m * 16]; float ss = 0.f; const size_t ro = (size_t)(ai * 128 + m * 16) * DM;
#pragma unroll
                for (int bj = 0; bj < 2; ++bj) {
                    const u32x4 xr = *(const GAS u32x4*)(bi + ro + bj * 128);
                    const f32x4 v0 = (f32x4){bflo(xr.x), bfhi(xr.x), bflo(xr.y), bfhi(xr.y)} + acc[ai][bj][m][0] * rs, v1 = (f32x4){bflo(xr.z), bfhi(xr.z), bflo(xr.w), bfhi(xr.w)} + acc[ai][bj][m][1] * rs;
                    ss += sq8(v0, v1);
                    *(GAS u32x4*)(bo + ro + bj * 128) = pack8(v0, v1); }
                ss = red_fq(ss); if (fq == 0) sp[(size_t)(ai * 128 + m * 16) * 64] = ss; }
    }
};
__device__ __forceinline__ float dpp_ror1(float v) { return __builtin_bit_cast(float, __builtin_amdgcn_mov_dpp(__builtin_bit_cast(int, v), 0x121, 0xf, 0xf, false)); }
__device__ __forceinline__ float dpp_rol1(float v) { return __builtin_bit_cast(float, __builtin_amdgcn_mov_dpp(__builtin_bit_cast(int, v), 0x12f, 0xf, 0xf, false)); }
struct EpiFfnA {
    static constexpr bool PERM = true, MIDK = false;
    const float* rstd; int row_base; bf16_t* act; bf16_t* halo_up; bf16_t* halo_gate; const float* cw; const float* cb;
    __device__ __forceinline__ void midk(f32x4 (&)[2][2][4][2], const Unit&, int, int) const {}
    __device__ __forceinline__ void operator()(const f32x4 (&acc)[2][2][4][2], const Unit& u, int wr, int wc, int fr, int fq) const {
        EPI_ROWS; const int f0 = u.pn * 128 + wc * 32 + 8 * fq;
        const GAS float* rsp = (const GAS float*)(rstd + row_base + row0); GAS bf16_t* actp = (GAS bf16_t*)act + (size_t)row0 * DFF + f0;
        const int strip0 = u.pm * 4 + wr;
        GAS bf16_t* hup_p = (GAS bf16_t*)halo_up + (size_t)strip0 * 4 * DFF + f0; GAS bf16_t* hg_p = (GAS bf16_t*)halo_gate + (size_t)strip0 * 2 * DFF + f0;
        const GAS float* cwp = (const GAS float*)(cw + f0); const GAS float* cbp = (const GAS float*)(cb + f0);
        asm volatile("" : "+v"(rsp), "+v"(actp), "+v"(hup_p), "+v"(hg_p), "+v"(cwp), "+v"(cbp));
#pragma unroll
        for (int ai = 0; ai < 2; ++ai) {
            float rs[4];
#pragma unroll
            for (int m = 0; m < 4; ++m) rs[m] = rsp[ai * 128 + m * 16];
            u32x2 keep[4];
#pragma unroll
            for (int n = 0; n < 2; ++n) {
                const f32x4 w0 = *(const GAS f32x4*)(cwp + 4 * n), w1 = *(const GAS f32x4*)(cwp + DFF + 4 * n), w2 = *(const GAS f32x4*)(cwp + 2 * DFF + 4 * n), wb = *(const GAS f32x4*)(cbp + 4 * n);
                f32x4 res[4], Uu[4];
#pragma unroll
                for (int e = 0; e < 4; ++e) {
                    float U[4], R[4], L[4];
#pragma unroll
                    for (int m = 0; m < 4; ++m) { U[m] = acc[ai][0][m][n][e] * rs[m]; R[m] = dpp_ror1(U[m]); L[m] = dpp_rol1(U[m]); Uu[m][e] = U[m]; }
#pragma unroll
                    for (int m = 0; m < 4; ++m) {
                        const float prev = (fr == 0) ? R[m > 0 ? m - 1 : 0] : R[m];
                        const float next = (fr == 15) ? L[m < 3 ? m + 1 : 3] : L[m];
                        const float cv = w0[e] * prev + w1[e] * U[m] + w2[e] * next + wb[e];
                        res[m][e] = cv * sigmoidf_fast(cv) * (acc[ai][1][m][n][e] * rs[m]);
                    }
                }
#pragma unroll
                for (int m = 0; m < 4; ++m) {
                    const bool edge = (m == 0 && fr == 0) || (m == 3 && fr == 15);
                    { u32x2 w; w.x = cvt_pk_bf16(res[m][0], res[m][1]); w.y = cvt_pk_bf16(res[m][2], res[m][3]);
                      if (n == 0) keep[m] = w; else if (!edge) *(GAS u32x4*)(actp + (size_t)(ai * 128 + m * 16) * DFF) = (u32x4){keep[m].x, keep[m].y, w.x, w.y}; }
                    if (m == 0 || m == 3) {
                        const int hs = (m == 0) ? (fr == 0 ? 0 : (fr == 1 ? 1 : -1)) : (fr == 14 ? 2 : (fr == 15 ? 3 : -1));
                        if (hs >= 0) { u32x2 w; w.x = cvt_pk_bf16(Uu[m][0], Uu[m][1]); w.y = cvt_pk_bf16(Uu[m][2], Uu[m][3]);
                            *(GAS u32x2*)(hup_p + ((size_t)(ai * 2) * 4 + hs) * DFF + 4 * n) = w;
                            if (hs == 0 || hs == 3) { const f32x4 gv = acc[ai][1][m][n] * rs[m]; u32x2 wg; wg.x = cvt_pk_bf16(gv[0], gv[1]); wg.y = cvt_pk_bf16(gv[2], gv[3]);
                                *(GAS u32x2*)(hg_p + ((size_t)(ai * 2) * 2 + (hs == 3 ? 1 : 0)) * DFF + 4 * n) = wg; } }
                    }
                }
            }
        }
    }
};
struct EpiDown {
    static constexpr bool PERM = true, MIDK = false;
    bf16_t* xb; int row_base; float* stA;
    __device__ __forceinline__ void midk(f32x4 (&)[2][2][4][2], const Unit&, int, int) const {}
    __device__ __forceinline__ void operator()(const f32x4 (&acc)[2][2][4][2], const Unit& u, int wr, int wc, int fr, int fq) const {
        EPI_ROWS; GAS bf16_t* xo = (GAS bf16_t*)xb + (size_t)(row_base + row0) * DM + u.pn * 256 + wc * 32 + 8 * fq; GAS float* sp = (GAS float*)stA + (size_t)(row_base + row0) * 64 + u.pn * 4 + wc; LAUNDER(xo); LAUNDER(sp);
#pragma unroll
        for (int ai = 0; ai < 2; ++ai)
#pragma unroll
            for (int m = 0; m < 4; ++m) { float ss = 0.f; const size_t ro = (size_t)(ai * 128 + m * 16) * DM;
#pragma unroll
                for (int bj = 0; bj < 2; ++bj) { GAS bf16_t* p = xo + ro + bj * 128; const u32x4 w = *(const GAS u32x4*)p; const f32x4 a0 = acc[ai][bj][m][0], a1 = acc[ai][bj][m][1];
                    f32x4 v0, v1; v0[0] = bflo(w.x) + a0[0]; v0[1] = bfhi(w.x) + a0[1]; v0[2] = bflo(w.y) + a0[2]; v0[3] = bfhi(w.y) + a0[3];
                    v1[0] = bflo(w.z) + a1[0]; v1[1] = bfhi(w.z) + a1[1]; v1[2] = bflo(w.w) + a1[2]; v1[3] = bfhi(w.w) + a1[3];
                    ss += sq8(v0, v1); *(GAS u32x4*)p = pack8(v0, v1); }
                ss = red_fq(ss); if (fq == 0) sp[(size_t)(ai * 128 + m * 16) * 64] = ss; }
    }
};
#undef EPI_ROWS
}

namespace attn {
using f32x4v = __attribute__((ext_vector_type(4))) float;
using u32x2v = __attribute__((ext_vector_type(2))) unsigned;
using u32x4v = __attribute__((ext_vector_type(4))) unsigned;
constexpr int NW = 8, KVBLK = 64;
constexpr float SCALE = 0.07216878364870322f;
constexpr float THR = 8.f;
constexpr int LDQ = 3072, LDK = 2048, LDR = 64, LDVT = T, LDO = 4096;
constexpr int SHM_V = 128 * KVBLK * 2, SHM_K = KVBLK * 128 * 2, SHM_R = KVBLK * 64 * 2;
constexpr int OFF_V = 0, OFF_K = 2 * SHM_V, OFF_R = OFF_K + 2 * SHM_K, OFF_QR = OFF_R + 2 * SHM_R, SHM_ATTN = OFF_QR + NW * 4096;
#define SBAR() __builtin_amdgcn_sched_barrier(0)
#define PIN(x) asm volatile("" : "+v"(x))
__device__ __forceinline__ void glds16(const void* gsrc, unsigned lds_dst) { unsigned keep;
  asm volatile("s_mov_b32 %0, m0\n\ts_mov_b32 m0, %2\n\ts_nop 0\n\tglobal_load_lds_dwordx4 %1, off\n\ts_mov_b32 m0, %0" : "=&s"(keep) : "v"(gsrc), "s"(lds_dst) : "memory"); }
__device__ __forceinline__ unsigned cvtpk(float lo, float hi) { unsigned r; asm volatile("v_cvt_pk_bf16_f32 %0, %1, %2" : "=v"(r) : "v"(lo), "v"(hi)); return r; }
__device__ __forceinline__ float xmax16(float v) { auto r = __builtin_amdgcn_permlane16_swap(__float_as_uint(v), __float_as_uint(v), false, false); return fmaxf(__uint_as_float(r[0]), __uint_as_float(r[1])); }
__device__ __forceinline__ float xmax32(float v) { auto r = __builtin_amdgcn_permlane32_swap(__float_as_uint(v), __float_as_uint(v), false, false); return fmaxf(__uint_as_float(r[0]), __uint_as_float(r[1])); }
__device__ __forceinline__ float xsum16(float v) { auto r = __builtin_amdgcn_permlane16_swap(__float_as_uint(v), __float_as_uint(v), false, false); return __uint_as_float(r[0]) + __uint_as_float(r[1]); }
__device__ __forceinline__ float xsum32(float v) { auto r = __builtin_amdgcn_permlane32_swap(__float_as_uint(v), __float_as_uint(v), false, false); return __uint_as_float(r[0]) + __uint_as_float(r[1]); }
__device__ __forceinline__ float max3f(float a, float b, float c) { float r; asm("v_max3_f32 %0, %1, %2, %3" : "=v"(r) : "v"(a), "v"(b), "v"(c)); return r; }
#define MF16(A, B, C) __builtin_amdgcn_mfma_f32_16x16x32_bf16(A, B, C, 0, 0, 0)
struct Lane { const LAS char* Kl; const LAS char* Rl; const LAS char* Vl; const LAS char* qrl; int ky, rz, vz; };
template <int KB, int S> __device__ __forceinline__ bf16x8 kfrag(const Lane& L, int kst, int rst) {
  if constexpr (S < 4) return *(const LAS bf16x8*)(L.Kl + kst + KB * 4096 + ((64 * S) ^ L.ky));
  else return *(const LAS bf16x8*)(L.Rl + rst + KB * 2048 + ((64 * (S - 4)) ^ L.rz));
}
template <int DB, int C> __device__ __forceinline__ bf16x8 vfrag(const Lane& L, int vst) { return *(const LAS bf16x8*)(L.Vl + vst + DB * 2048 + ((64 * C) ^ L.rz)); }
template <int QB, int S> __device__ __forceinline__ bf16x8 qfrag(const bf16x8 (&qn)[2][6], const Lane& L) { return qn[QB][S]; }
template <int KB> __device__ __forceinline__ void qk_block_plain(f32x4v (&s)[2][4], const bf16x8 (&qn)[2][6], const Lane& L, int kst, int rst) {
  bf16x8 k = kfrag<KB, 0>(L, kst, rst); s[0][KB] = MF16(k, (qfrag<0, 0>(qn, L)), ((f32x4v){0.f, 0.f, 0.f, 0.f})); s[1][KB] = MF16(k, (qfrag<1, 0>(qn, L)), ((f32x4v){0.f, 0.f, 0.f, 0.f}));
  k = kfrag<KB, 1>(L, kst, rst); s[0][KB] = MF16(k, (qfrag<0, 1>(qn, L)), s[0][KB]); s[1][KB] = MF16(k, (qfrag<1, 1>(qn, L)), s[1][KB]);
  k = kfrag<KB, 2>(L, kst, rst); s[0][KB] = MF16(k, (qfrag<0, 2>(qn, L)), s[0][KB]); s[1][KB] = MF16(k, (qfrag<1, 2>(qn, L)), s[1][KB]);
  k = kfrag<KB, 3>(L, kst, rst); s[0][KB] = MF16(k, (qfrag<0, 3>(qn, L)), s[0][KB]); s[1][KB] = MF16(k, (qfrag<1, 3>(qn, L)), s[1][KB]);
  k = kfrag<KB, 4>(L, kst, rst); s[0][KB] = MF16(k, (qfrag<0, 4>(qn, L)), s[0][KB]); s[1][KB] = MF16(k, (qfrag<1, 4>(qn, L)), s[1][KB]);
  k = kfrag<KB, 5>(L, kst, rst); s[0][KB] = MF16(k, (qfrag<0, 5>(qn, L)), s[0][KB]); s[1][KB] = MF16(k, (qfrag<1, 5>(qn, L)), s[1][KB]);
}
template <int QB> __device__ __forceinline__ float rowmax(const f32x4v (&s)[2][4]) {
  float m = max3f(s[QB][0][0], s[QB][0][1], s[QB][0][2]); m = max3f(m, s[QB][0][3], s[QB][1][0]); m = max3f(m, s[QB][1][1], s[QB][1][2]); m = max3f(m, s[QB][1][3], s[QB][2][0]);
  m = max3f(m, s[QB][2][1], s[QB][2][2]); m = max3f(m, s[QB][2][3], s[QB][3][0]); m = max3f(m, s[QB][3][1], s[QB][3][2]); m = max3f(m, s[QB][3][3], s[QB][3][3]); return m;
}
constexpr float THRL = 11.541560327111707f;
__device__ __forceinline__ void decide(float pm0, float pm1, f32x4v (&c)[2][4], float (&mh)[2], f32x4v (&negm)[2], float (&al)[2]) {
  pm0 = xmax32(xmax16(pm0)); pm1 = xmax32(xmax16(pm1));
  if (__builtin_expect(__all((pm0 <= THRL) && (pm1 <= THRL)), 1)) { al[0] = 1.f; al[1] = 1.f; }
  else { const float d0 = fmaxf(pm0, 0.f), d1 = fmaxf(pm1, 0.f); mh[0] += d0; mh[1] += d1;
#pragma unroll
    for (int kb = 0; kb < 4; ++kb) { c[0][kb] = c[0][kb] - d0; c[1][kb] = c[1][kb] - d1; }
    al[0] = __builtin_amdgcn_exp2f(-d0); al[1] = __builtin_amdgcn_exp2f(-d1);
    negm[0] = (f32x4v){-mh[0], -mh[0], -mh[0], -mh[0]}; negm[1] = (f32x4v){-mh[1], -mh[1], -mh[1], -mh[1]}; }
}
__device__ __forceinline__ bf16x8 packp(const f32x4v a, const f32x4v b) { const u32x4v w = {cvtpk(a[0], a[1]), cvtpk(a[2], a[3]), cvtpk(b[0], b[1]), cvtpk(b[2], b[3])}; return __builtin_bit_cast(bf16x8, w); }

struct Dma { const char* k0; const char* k1; const char* r; const char* v0; const char* v1; unsigned dk, dr, dv; bool kr; };
__device__ __forceinline__ void attn_step(f32x4v (&c)[2][4], f32x4v (&p)[2][4], f32x4v (&o)[2][8], const bf16x8 (&qn)[2][6], const Lane& L, int kst, int rst, int vst,
                                          const float (&alp)[2], float (&l)[2], float (&mh)[2], f32x4v (&negm)[2], float (&alc)[2], const Dma& D) {
  bf16x8 ka, kb_, kc, kd, P00, P01, P10, P11;
#define QKR(KB, S, FIRST, KX, KY) do { \
    if (FIRST) { c[0][KB] = MF16(KX, (qfrag<0, S>(qn, L)), negm[0]); c[1][KB] = MF16(KX, (qfrag<1, S>(qn, L)), negm[1]); \
                 c[0][KB + 1] = MF16(KY, (qfrag<0, S>(qn, L)), negm[0]); c[1][KB + 1] = MF16(KY, (qfrag<1, S>(qn, L)), negm[1]); } \
    else { c[0][KB] = MF16(KX, (qfrag<0, S>(qn, L)), c[0][KB]); c[1][KB] = MF16(KX, (qfrag<1, S>(qn, L)), c[1][KB]); \
           c[0][KB + 1] = MF16(KY, (qfrag<0, S>(qn, L)), c[0][KB + 1]); c[1][KB + 1] = MF16(KY, (qfrag<1, S>(qn, L)), c[1][KB + 1]); } } while (0)
#define EXP4(V) do { V[0] = __builtin_amdgcn_exp2f(V[0]); V[1] = __builtin_amdgcn_exp2f(V[1]); V[2] = __builtin_amdgcn_exp2f(V[2]); V[3] = __builtin_amdgcn_exp2f(V[3]); } while (0)
  ka = kfrag<0, 0>(L, kst, rst); kb_ = kfrag<1, 0>(L, kst, rst); SBAR();
  kc = kfrag<0, 1>(L, kst, rst); kd = kfrag<1, 1>(L, kst, rst); QKR(0, 0, true, ka, kb_); EXP4(p[0][2]); PIN(p[0][2]); SBAR();
  if (D.kr) glds16(D.k0, D.dk);
  ka = kfrag<0, 2>(L, kst, rst); kb_ = kfrag<1, 2>(L, kst, rst); QKR(0, 1, false, kc, kd); EXP4(p[0][3]); PIN(p[0][3]); SBAR();
  kc = kfrag<0, 3>(L, kst, rst); kd = kfrag<1, 3>(L, kst, rst); QKR(0, 2, false, ka, kb_); EXP4(p[1][2]); PIN(p[1][2]); SBAR();
  if (D.kr) glds16(D.k1, D.dk + 8192);
  ka = kfrag<0, 4>(L, kst, rst); kb_ = kfrag<1, 4>(L, kst, rst); QKR(0, 3, false, kc, kd); EXP4(p[1][3]); PIN(p[1][3]); SBAR();
  kc = kfrag<0, 5>(L, kst, rst); kd = kfrag<1, 5>(L, kst, rst); QKR(0, 4, false, ka, kb_);
  { float s = (p[0][0][0] + p[0][0][1]) + (p[0][0][2] + p[0][0][3]); s += (p[0][1][0] + p[0][1][1]) + (p[0][1][2] + p[0][1][3]); s += (p[0][2][0] + p[0][2][1]) + (p[0][2][2] + p[0][2][3]); s += (p[0][3][0] + p[0][3][1]) + (p[0][3][2] + p[0][3][3]);
    l[0] = l[0] * alp[0] + s; PIN(l[0]); } SBAR();
  if (D.kr) glds16(D.r, D.dr);
  ka = kfrag<2, 0>(L, kst, rst); kb_ = kfrag<3, 0>(L, kst, rst); QKR(0, 5, false, kc, kd);
  { float s = (p[1][0][0] + p[1][0][1]) + (p[1][0][2] + p[1][0][3]); s += (p[1][1][0] + p[1][1][1]) + (p[1][1][2] + p[1][1][3]); s += (p[1][2][0] + p[1][2][1]) + (p[1][2][2] + p[1][2][3]); s += (p[1][3][0] + p[1][3][1]) + (p[1][3][2] + p[1][3][3]);
    l[1] = l[1] * alp[1] + s; PIN(l[1]); } SBAR();
  kc = kfrag<2, 1>(L, kst, rst); kd = kfrag<3, 1>(L, kst, rst); QKR(2, 0, true, ka, kb_); P00 = packp(p[0][0], p[0][1]); PIN(P00); SBAR();
  glds16(D.v0, D.dv);
  ka = kfrag<2, 2>(L, kst, rst); kb_ = kfrag<3, 2>(L, kst, rst); QKR(2, 1, false, kc, kd); P01 = packp(p[0][2], p[0][3]); PIN(P01); SBAR();
  kc = kfrag<2, 3>(L, kst, rst); kd = kfrag<3, 3>(L, kst, rst); QKR(2, 2, false, ka, kb_); P10 = packp(p[1][0], p[1][1]); PIN(P10); SBAR();
  glds16(D.v1, D.dv + 8192);
  ka = kfrag<2, 4>(L, kst, rst); kb_ = kfrag<3, 4>(L, kst, rst); QKR(2, 3, false, kc, kd); P11 = packp(p[1][2], p[1][3]); PIN(P11); SBAR();
  kc = kfrag<2, 5>(L, kst, rst); kd = kfrag<3, 5>(L, kst, rst); QKR(2, 4, false, ka, kb_); SBAR();
  ka = vfrag<0, 0>(L, vst); kb_ = vfrag<1, 0>(L, vst); QKR(2, 5, false, kc, kd); SBAR();
#define PVR(DB, VX, VY, PA, PB) do { o[0][DB] = MF16(VX, PA, o[0][DB]); o[1][DB] = MF16(VX, PB, o[1][DB]); o[0][DB + 1] = MF16(VY, PA, o[0][DB + 1]); o[1][DB + 1] = MF16(VY, PB, o[1][DB + 1]); } while (0)
  float pm0, pm1;
  kc = vfrag<2, 0>(L, vst); kd = vfrag<3, 0>(L, vst); PVR(0, ka, kb_, P00, P10); pm0 = rowmax<0>(c); PIN(pm0); SBAR();
  ka = vfrag<4, 0>(L, vst); kb_ = vfrag<5, 0>(L, vst); PVR(2, kc, kd, P00, P10); pm1 = rowmax<1>(c); PIN(pm1); SBAR();
  kc = vfrag<6, 0>(L, vst); kd = vfrag<7, 0>(L, vst); PVR(4, ka, kb_, P00, P10); decide(pm0, pm1, c, mh, negm, alc); SBAR();
  ka = vfrag<0, 1>(L, vst); kb_ = vfrag<1, 1>(L, vst); PVR(6, kc, kd, P00, P10); EXP4(c[0][0]); PIN(c[0][0]); SBAR();
  kc = vfrag<2, 1>(L, vst); kd = vfrag<3, 1>(L, vst); PVR(0, ka, kb_, P01, P11); EXP4(c[0][1]); PIN(c[0][1]); SBAR();
  ka = vfrag<4, 1>(L, vst); kb_ = vfrag<5, 1>(L, vst); PVR(2, kc, kd, P01, P11); EXP4(c[1][0]); PIN(c[1][0]); SBAR();
  kc = vfrag<6, 1>(L, vst); kd = vfrag<7, 1>(L, vst); PVR(4, ka, kb_, P01, P11); EXP4(c[1][1]); PIN(c[1][1]); SBAR();
  PVR(6, kc, kd, P01, P11); SBAR();
#undef QKR
#undef PVR
}

__device__ __forceinline__ void attn_unit(const bf16* __restrict__ Qb, const bf16* __restrict__ Kh, const bf16* __restrict__ VTh, const bf16* __restrict__ Rh,
                                          bf16* __restrict__ Ob, float* __restrict__ st, int seq, int k0g, char* lds, int wid) {
  int lane_l = (int)__builtin_amdgcn_mbcnt_hi(~0u, __builtin_amdgcn_mbcnt_lo(~0u, 0u)); asm volatile("" : "+v"(lane_l));
  const int lane = lane_l, l15 = lane & 15, kq = lane >> 4;
  bf16x8 qn[2][6]; Lane L;
  L.qrl = (const LAS char*)(lds + OFF_QR + wid * 4096 + lane * 16);
  { const bf16* Qw = Qb + (long)(wid * 32 + l15) * LDQ + kq * 8;
#pragma unroll
    for (int qb = 0; qb < 2; ++qb) {
#pragma unroll
      for (int s = 0; s < 6; ++s) qn[qb][s] = *(const GAS bf16x8*)(Qw + (long)qb * 16 * LDQ + s * 32); } }
  L.Kl = (const LAS char*)(lds + OFF_K) + l15 * 256; L.Rl = (const LAS char*)(lds + OFF_R) + l15 * 128; L.Vl = (const LAS char*)(lds + OFF_V) + l15 * 128;
  L.ky = (kq ^ l15) << 4; L.rz = (kq ^ ((l15 >> 1) & 7)) << 4; L.vz = 0;
  unsigned kof0, kof1, rof, vof0, vof1;
  { const int q0 = wid, q1 = wid + 8;
    { const int row = 4 * q0 + (lane >> 4), ch = (lane & 15) ^ (row & 15); kof0 = (unsigned)(row * LDK + ch * 8) * 2u; }
    { const int row = 4 * q1 + (lane >> 4), ch = (lane & 15) ^ (row & 15); kof1 = (unsigned)(row * LDK + ch * 8) * 2u; }
    { const int row = 8 * q0 + (lane >> 3), ch = (lane & 7) ^ ((row >> 1) & 7); rof = (unsigned)(row * LDR + ch * 8) * 2u; }
    { const int row = 8 * q0 + (lane >> 3), ch = (lane & 7) ^ ((row >> 1) & 7); vof0 = (unsigned)(row * LDVT + ch * 8) * 2u; }
    { const int row = 8 * q1 + (lane >> 3), ch = (lane & 7) ^ ((row >> 1) & 7); vof1 = (unsigned)(row * LDVT + ch * 8) * 2u; } }
  const unsigned lds0 = (unsigned)(uintptr_t)lds;
  const unsigned dK = (unsigned)__builtin_amdgcn_readfirstlane(lds0 + OFF_K + wid * 1024), dR = (unsigned)__builtin_amdgcn_readfirstlane(lds0 + OFF_R + wid * 1024), dV = (unsigned)__builtin_amdgcn_readfirstlane(lds0 + OFF_V + wid * 1024);
  const char* VTk = (const char*)VTh + (size_t)k0g * 2;
#define DMA_KR(t, s) do { const char* kb_ = (const char*)Kh + (size_t)(t) * (KVBLK * LDK * 2); const char* rb_ = (const char*)Rh + (size_t)(t) * (KVBLK * LDR * 2); \
    glds16(kb_ + kof0, dK + (s) * SHM_K); glds16(kb_ + kof1, dK + (s) * SHM_K + 8192); glds16(rb_ + rof, dR + (s) * SHM_R); } while (0)
#define DMA_V(t, s) do { const char* vb_ = VTk + (size_t)(t) * (KVBLK * 2); glds16(vb_ + vof0, dV + (s) * SHM_V); glds16(vb_ + vof1, dV + (s) * SHM_V + 8192); } while (0)
#define WAIT_BAR() asm volatile("s_waitcnt vmcnt(0) lgkmcnt(0)\n\ts_barrier" ::: "memory")
#define RESC(a) do { if (__any(((a)[0] < 1.f) || ((a)[1] < 1.f))) { _Pragma("unroll") for (int d_ = 0; d_ < 8; ++d_) { o[0][d_] *= (a)[0]; o[1][d_] *= (a)[1]; } } } while (0)
  f32x4v o[2][8], sA[2][4], sB[2][4], negm[2]; float mh[2], l[2] = {0.f, 0.f}, alA[2], alB[2];
#pragma unroll
  for (int d = 0; d < 8; ++d) { o[0][d] = (f32x4v){0.f, 0.f, 0.f, 0.f}; o[1][d] = (f32x4v){0.f, 0.f, 0.f, 0.f}; }
  const int NT = seq / KVBLK;
  DMA_KR(0, 0); DMA_V(0, 0); WAIT_BAR();
  DMA_KR(1, 1);
  qk_block_plain<0>(sA, qn, L, 0, 0); qk_block_plain<1>(sA, qn, L, 0, 0); qk_block_plain<2>(sA, qn, L, 0, 0); qk_block_plain<3>(sA, qn, L, 0, 0);
  { mh[0] = xmax32(xmax16(rowmax<0>(sA))); mh[1] = xmax32(xmax16(rowmax<1>(sA))); alA[0] = 1.f; alA[1] = 1.f;
    negm[0] = (f32x4v){-mh[0], -mh[0], -mh[0], -mh[0]}; negm[1] = (f32x4v){-mh[1], -mh[1], -mh[1], -mh[1]};
#pragma unroll
    for (int kb = 0; kb < 4; ++kb) { sA[0][kb] = sA[0][kb] - mh[0]; sA[1][kb] = sA[1][kb] - mh[1]; }
#pragma unroll
    for (int kb = 0; kb < 2; ++kb)
#pragma unroll
      for (int e = 0; e < 4; ++e) { sA[0][kb][e] = __builtin_amdgcn_exp2f(sA[0][kb][e]); sA[1][kb][e] = __builtin_amdgcn_exp2f(sA[1][kb][e]); } }
  WAIT_BAR();
#pragma unroll 1
  for (int j = 1; j + 1 < NT; j += 2) {
    { const char* kb_ = (const char*)Kh + (size_t)(j + 1) * (KVBLK * LDK * 2); const char* rb_ = (const char*)Rh + (size_t)(j + 1) * (KVBLK * LDR * 2); const char* vb_ = VTk + (size_t)j * (KVBLK * 2);
      const Dma D{kb_ + kof0, kb_ + kof1, rb_ + rof, vb_ + vof0, vb_ + vof1, dK, dR, dV + SHM_V, true};
      attn_step(sB, sA, o, qn, L, SHM_K, SHM_R, 0, alA, l, mh, negm, alB, D); }
    RESC(alB); WAIT_BAR();
    { const char* kb_ = (const char*)Kh + (size_t)(j + 2) * (KVBLK * LDK * 2); const char* rb_ = (const char*)Rh + (size_t)(j + 2) * (KVBLK * LDR * 2); const char* vb_ = VTk + (size_t)(j + 1) * (KVBLK * 2);
      const Dma D{kb_ + kof0, kb_ + kof1, rb_ + rof, vb_ + vof0, vb_ + vof1, dK + SHM_K, dR + SHM_R, dV, (j + 2 < NT)};
      attn_step(sA, sB, o, qn, L, 0, 0, SHM_V, alB, l, mh, negm, alA, D); }
    RESC(alA); WAIT_BAR();
  }
  { const char* vb_ = VTk + (size_t)(NT - 1) * (KVBLK * 2);
    const Dma D{vb_, vb_, vb_, vb_ + vof0, vb_ + vof1, dK, dR, dV + SHM_V, false};
    attn_step(sB, sA, o, qn, L, SHM_K, SHM_R, 0, alA, l, mh, negm, alB, D); }
  RESC(alB); WAIT_BAR();
  {
#pragma unroll
    for (int kb = 2; kb < 4; ++kb)
#pragma unroll
      for (int e = 0; e < 4; ++e) { sB[0][kb][e] = __builtin_amdgcn_exp2f(sB[0][kb][e]); sB[1][kb][e] = __builtin_amdgcn_exp2f(sB[1][kb][e]); }
    float s0 = 0.f, s1 = 0.f;
#pragma unroll
    for (int kb = 0; kb < 4; ++kb) { s0 += (sB[0][kb][0] + sB[0][kb][1]) + (sB[0][kb][2] + sB[0][kb][3]); s1 += (sB[1][kb][0] + sB[1][kb][1]) + (sB[1][kb][2] + sB[1][kb][3]); }
    l[0] = l[0] * alB[0] + s0; l[1] = l[1] * alB[1] + s1;
    const bf16x8 P00 = packp(sB[0][0], sB[0][1]), P01 = packp(sB[0][2], sB[0][3]), P10 = packp(sB[1][0], sB[1][1]), P11 = packp(sB[1][2], sB[1][3]);
#define PVD(DB) do { bf16x8 v0 = vfrag<DB, 0>(L, SHM_V), v1 = vfrag<DB, 1>(L, SHM_V); o[0][DB] = MF16(v0, P00, o[0][DB]); o[1][DB] = MF16(v0, P10, o[1][DB]); o[0][DB] = MF16(v1, P01, o[0][DB]); o[1][DB] = MF16(v1, P11, o[1][DB]); } while (0)
    PVD(0); PVD(1); PVD(2); PVD(3); PVD(4); PVD(5); PVD(6); PVD(7);
#undef PVD
  }
  int lane_e = (int)__builtin_amdgcn_mbcnt_hi(~0u, __builtin_amdgcn_mbcnt_lo(~0u, 0u)); asm volatile("" : "+v"(lane_e)); const int l15e = lane_e & 15, kqe = lane_e >> 4;
  GAS bf16* Ow = (GAS bf16*)Ob + (long)(wid * 32 + l15e) * LDO + 4 * kqe; GAS float* stw = (GAS float*)st + (long)(wid * 32 + l15e) * 16;
  asm volatile("" : "+v"(Ow), "+v"(stw));
#pragma unroll
  for (int qb = 0; qb < 2; ++qb) { const float lt = xsum32(xsum16(l[qb])); const float rl = __builtin_amdgcn_rcpf(lt); float ss = 0.f;
#pragma unroll
    for (int db = 0; db < 8; ++db) { const f32x4v v = o[qb][db] * rl; u32x2v w; w.x = cvtpk(v[0], v[1]); w.y = cvtpk(v[2], v[3]);
      const float a0 = bflo(w.x), a1 = bfhi(w.x), a2 = bflo(w.y), a3 = bfhi(w.y); ss += (a0 * a0 + a1 * a1) + (a2 * a2 + a3 * a3);
      *(GAS u32x2v*)(Ow + (long)(qb * 16) * LDO + db * 16) = w; }
    ss = xsum32(xsum16(ss)); if (kqe == 0) stw[(long)(qb * 16) * 16] = ss; }
  asm volatile("s_waitcnt lgkmcnt(0)\n\ts_barrier" ::: "memory");
#undef DMA_KR
#undef DMA_V
#undef WAIT_BAR
#undef RESC
}
#undef SBAR
#undef PIN
#undef MF16
#undef EXP4
}

constexpr size_t MiB = 1u << 20;
constexpr size_t WS_CTL = 0, CTL_ZERO_BYTES = 1 * MiB;
constexpr size_t WS_RSTDX = 1 * MiB, WS_RSTDQ = WS_RSTDX + 98304, WS_RSTDKV = WS_RSTDQ + 98304, WS_R2 = WS_RSTDKV + 98304, WS_RATIO = WS_R2 + 98304, WS_RSTDX1 = WS_RATIO + 98304;
constexpr size_t WS_STA = 2 * MiB;
constexpr size_t WS_STB = 8 * MiB;
constexpr size_t WS_STQ = 10 * MiB;
constexpr size_t WS_STKV = 12 * MiB;
constexpr size_t WS_ROPE = 13 * MiB;
constexpr size_t WS_WIN = 16 * MiB;
constexpr size_t WS_WGLU = 46 * MiB;
constexpr size_t WS_WQ = 54 * MiB;
constexpr size_t WS_WKV = 60 * MiB;
constexpr size_t WS_WOUT = 64 * MiB;
constexpr size_t WS_WUG = 96 * MiB;
constexpr size_t WS_WDN = 268 * MiB;
constexpr size_t WS_W1T = 354 * MiB;
constexpr size_t WS_W2T = 370 * MiB;
constexpr size_t WS_A = 402 * MiB;
constexpr size_t WS_B = 594 * MiB;
constexpr size_t WS_QLAT = 786 * MiB, WS_KVLAT = 828 * MiB, WS_KROPE = 852 * MiB;
constexpr size_t WS_GACT = 856 * MiB;
constexpr size_t WS_HUP = 952 * MiB, WS_HGATE = 964 * MiB, WS_END = 970 * MiB;
static_assert(WS_HUP + (size_t)128 * 4 * DFF * 2 <= WS_HGATE && WS_HGATE + (size_t)128 * 2 * DFF * 2 <= WS_END, "halo");
constexpr size_t OUT_X = 0, OUT_KV = 192 * MiB;
constexpr int CW_BAR = 4096;

constexpr int NWAVES = 8;
constexpr int RING_BYTES = 131072, LDSCTL_OFF = 143360, MISC_OFF = LDSCTL_OFF + 320, LDS_BYTES = 147456;

typedef GAS unsigned gu32;
#define RLX_AGENT __ATOMIC_RELAXED, __HIP_MEMORY_SCOPE_AGENT
#define LDS_WAIT() asm volatile("s_waitcnt lgkmcnt(0)" ::: "memory")

#define XB_TMO      128
#define XB_XCNT(j)  (256  + 64 * (j))
#define XB_XSUB(j)  (1280 + 64 * (j))
#define XB_XGEN(j)  (2304 + 64 * (j))
#define XB_TOP      3328
#define XB_TOPGEN   3392
#define XCD_BAR_WORDS 3456
#define XB_SPIN_CAP (1u << 18)
__device__ __forceinline__ unsigned xb_ld(unsigned* p)              { return __hip_atomic_load(p, __ATOMIC_RELAXED, __HIP_MEMORY_SCOPE_AGENT); }
__device__ __forceinline__ unsigned xb_add(unsigned* p, unsigned v) { return __hip_atomic_fetch_add(p, v, __ATOMIC_RELAXED, __HIP_MEMORY_SCOPE_AGENT); }
__device__ __forceinline__ unsigned xb_xcc_id() { return (unsigned)__builtin_amdgcn_s_getreg((3 << 11) | 20) & 0xFu; }
#define XB_SPIN(cond, bar) do { unsigned _sp = 0; while (cond) { __builtin_amdgcn_s_sleep(1); \
    if ((++_sp & 255u) == 0u) { if (xb_ld(&(bar)[XB_TMO])) break; if (_sp > XB_SPIN_CAP) { atomicAdd(&(bar)[XB_TMO], 1u); break; } } } } while (0)
struct XcdBarrier { unsigned* bar; unsigned x; volatile LAS unsigned* st; };
__device__ __forceinline__ XcdBarrier xcd_barrier_post(unsigned* bar, volatile LAS unsigned* st) {
    XcdBarrier b; b.bar = bar; b.x = xb_xcc_id(); b.st = st;
    if (threadIdx.x == 0) (void)xb_add(&bar[XB_XCNT(b.x)], 1u);
    return b;
}
__device__ __forceinline__ void xcd_barrier_complete(unsigned* bar, unsigned x, unsigned& nloc, unsigned& nx) {
    const unsigned G = gridDim.x * gridDim.y * gridDim.z;
    unsigned sum, cnt, mine, sp = 0u;
    for (;;) {
        sum = 0u; cnt = 0u; mine = 0u;
#pragma unroll
        for (unsigned j = 0; j < 16; ++j) { const unsigned c = xb_ld(&bar[XB_XCNT(j)]); sum += c; cnt += (c > 0u) ? 1u : 0u; mine = (j == x) ? c : mine; }
        if (sum == G) break;
        __builtin_amdgcn_s_sleep(1);
        if ((++sp & 255u) == 0u) { if (xb_ld(&bar[XB_TMO])) break; if (sp > XB_SPIN_CAP) { atomicAdd(&bar[XB_TMO], 1u); break; } }
    }
    nloc = mine > 0u ? mine : 1u; nx = cnt > 0u ? cnt : 1u;
}
__device__ __forceinline__ void xcd_barrier(const XcdBarrier& b) {
    asm volatile("s_waitcnt vmcnt(0)" ::: "memory");
    __syncthreads();
    if (threadIdx.x == 0) {
        unsigned* bar = b.bar;
        __builtin_amdgcn_s_waitcnt(0);
        unsigned nloc = b.st[0], nx = b.st[1];
        if (nloc == 0u) { xcd_barrier_complete(bar, b.x, nloc, nx); b.st[0] = nloc; b.st[1] = nx; }
        const unsigned old = xb_add(&bar[XB_XSUB(b.x)], 1u);
        const unsigned gen = old / nloc;
        if (old + 1u == (gen + 1u) * nloc) {
            __builtin_amdgcn_fence(__ATOMIC_RELEASE, "agent");
            asm volatile("s_waitcnt vmcnt(0)" ::: "memory");
            const unsigned og = xb_add(&bar[XB_TOP], 1u);
            const unsigned tg = og / nx;
            if (og + 1u == (tg + 1u) * nx) xb_add(&bar[XB_TOPGEN], 1u);
            else XB_SPIN(xb_ld(&bar[XB_TOPGEN]) == tg, bar);
            __builtin_amdgcn_fence(__ATOMIC_ACQUIRE, "agent");
            xb_add(&bar[XB_XGEN(b.x)], 1u);
            asm volatile("s_waitcnt vmcnt(0)" ::: "memory");
        } else {
            XB_SPIN(xb_ld(&bar[XB_XGEN(b.x)]) == gen, bar);
            __builtin_amdgcn_fence(__ATOMIC_ACQUIRE, "agent");
            asm volatile("s_waitcnt vmcnt(0)" ::: "memory");
        }
    }
    __syncthreads();
}

__device__ __forceinline__ float wave_sum(float v) {
#pragma unroll
    for (int o = 1; o < 64; o <<= 1) v += __shfl_xor(v, o);
    return v;
}
template <class RowMap>
__device__ __forceinline__ void transpose_item(const float* W, int K, int N, bf16* WT, const float* g1, const float* g2, int ksplit, RowMap rm, LAS float* scr, int item, int lane) {
    const int nblk = N / 64; int kb, nb;
    if ((nblk & 3) == 0) { const int w = item & 7, rest = item >> 3, q = nblk >> 2; nb = (rest % q) * 4 + (w & 3); kb = (rest / q) * 2 + (w >> 2); }
    else { kb = item / nblk; nb = item % nblk; }
    const int k0 = 64 * kb, n0 = 64 * nb;
    f32x2 wv[32];
    const GAS f32x2* wp = (const GAS f32x2*)((const GAS float*)W + (size_t)(k0 + (lane >> 5)) * N + n0) + (lane & 31);
#pragma unroll
    for (int i = 0; i < 32; ++i) wv[i] = *(const GAS f32x2*)((const GAS float*)wp + (size_t)(2 * i) * N);
    float gn[32];
#pragma unroll
    for (int i = 0; i < 32; ++i) { const int k = k0 + 2 * i + (lane >> 5); gn[i] = g1 ? (k < ksplit ? g1[k] : g2[k - ksplit]) : 1.0f; }
    const int c = lane & 7;
#pragma unroll
    for (int sub = 0; sub < 2; ++sub) {
#pragma unroll
        for (int i = 0; i < 32; ++i) { const int kk = 2 * i + (lane >> 5); scr[kk * 33 + (lane & 31)] = (sub ? wv[i].y : wv[i].x) * gn[i]; }
        LDS_WAIT(); asm volatile("" ::: "memory");
#pragma unroll
        for (int j = 0; j < 4; ++j) { const int nl = (lane >> 3) + 8 * j; const LAS float* s = scr + (8 * c) * 33 + nl;
            v4u o; o.x = pg8::cvt_pk_bf16(s[0 * 33], s[1 * 33]); o.y = pg8::cvt_pk_bf16(s[2 * 33], s[3 * 33]); o.z = pg8::cvt_pk_bf16(s[4 * 33], s[5 * 33]); o.w = pg8::cvt_pk_bf16(s[6 * 33], s[7 * 33]);
            *(GAS v4u*)(WT + (size_t)rm(n0 + 2 * nl + sub) * K + k0 + 8 * c) = o; }
        LDS_WAIT(); asm volatile("" ::: "memory");
    }
}
__device__ __forceinline__ void tr_coords(int N, int item, int& k0, int& n0) { const int nblk = N / 64; int kb, nb;
    if ((nblk & 3) == 0) { const int w = item & 7, rest = item >> 3, q = nblk >> 2; nb = (rest % q) * 4 + (w & 3); kb = (rest / q) * 2 + (w >> 2); } else { kb = item / nblk; nb = item % nblk; }
    k0 = 64 * kb; n0 = 64 * nb; }
__device__ __forceinline__ void tr_load(const float* W, int N, const float* g1, const float* g2, int ksplit, int item, int lane, f32x4 (&wv)[16], f32x4 (&gq)[4]) {
    int k0, n0; tr_coords(N, item, k0, n0);
    const int kb = k0 + 16 * (lane >> 4);
    const GAS float* wp = (const GAS float*)W + (size_t)kb * N + n0 + 4 * (lane & 15);
#pragma unroll
    for (int i = 0; i < 16; ++i) wv[i] = *(const GAS f32x4*)(wp + (size_t)i * N);
    if (g1) { const GAS float* gp = (const GAS float*)(kb < ksplit ? g1 + kb : g2 + (kb - ksplit));
#pragma unroll
        for (int j = 0; j < 4; ++j) gq[j] = *(const GAS f32x4*)(gp + 4 * j); }
    else {
#pragma unroll
        for (int j = 0; j < 4; ++j) gq[j] = (f32x4){1.f, 1.f, 1.f, 1.f}; }
}
constexpr int TRS = 66;
template <class RowMap>
__device__ __forceinline__ void tr_emit(int K, int N, bf16* WT, RowMap rm, LAS float* scr, int item, int lane, const f32x4 (&wv)[16], const f32x4 (&gq)[4]) {
    int k0, n0; tr_coords(N, item, k0, n0);
    LAS float* wr_ = scr + (16 * (lane >> 4)) * TRS + 4 * (lane & 15);
#pragma unroll
    for (int i = 0; i < 16; ++i) { const float gg = gq[i >> 2][i & 3]; const f32x4 v = wv[i] * gg;
        *(LAS f32x2*)(wr_ + i * TRS) = (f32x2){v[0], v[1]}; *(LAS f32x2*)(wr_ + i * TRS + 2) = (f32x2){v[2], v[3]}; }
    LDS_WAIT(); asm volatile("" ::: "memory");
    const int c = lane & 7;
#pragma unroll
    for (int j = 0; j < 8; ++j) { const int nl = (lane >> 3) + 8 * j; const LAS float* s = scr + (8 * c) * TRS + nl;
        v4u o; o.x = pg8::cvt_pk_bf16(s[0 * TRS], s[1 * TRS]); o.y = pg8::cvt_pk_bf16(s[2 * TRS], s[3 * TRS]); o.z = pg8::cvt_pk_bf16(s[4 * TRS], s[5 * TRS]); o.w = pg8::cvt_pk_bf16(s[6 * TRS], s[7 * TRS]);
        *(GAS v4u*)(WT + (size_t)rm(n0 + nl) * K + k0 + 8 * c) = o; }
    LDS_WAIT(); asm volatile("" ::: "memory");
}
template <class RowMap>
__device__ __forceinline__ void transpose_range(const float* W, int K, int N, bf16* WT, const float* g1, const float* g2, int ksplit, RowMap rm, LAS float* scr, int first, int last, int stride, int lane) {
    if (first >= last) return;
    f32x4 wa[16], wb[16], ga[4], gb[4];
    int it = first; tr_load(W, N, g1, g2, ksplit, it, lane, wa, ga);
#pragma unroll 1
    for (;;) {
        const int n1 = it + stride; const bool h1 = n1 < last;
        if (h1) tr_load(W, N, g1, g2, ksplit, n1, lane, wb, gb);
        tr_emit(K, N, WT, rm, scr, it, lane, wa, ga);
        if (!h1) break;
        const int n2 = n1 + stride; const bool h2 = n2 < last;
        if (h2) tr_load(W, N, g1, g2, ksplit, n2, lane, wa, ga);
        tr_emit(K, N, WT, rm, scr, n1, lane, wb, gb);
        if (!h2) break;
        it = n2;
    }
}
struct RmId  { __device__ __forceinline__ int operator()(int n) const { return n; } };
struct RmWin { __device__ __forceinline__ int operator()(int n) const { if (n < 2944) return n; if (n < 3456) return n + 128; const int i = n - 3456; return 3584 + (i < 32 ? 2 * i : 2 * (i - 32) + 1); } };
struct RmQ   { __device__ __forceinline__ int operator()(int n) const { const int r = n % 192, hb = n - r; if (r < 128) return n; const int i = r - 128; return hb + 128 + (i < 32 ? 2 * i : 2 * (i - 32) + 1); } };
struct RmKV  { __device__ __forceinline__ int operator()(int n) const { const int h = n >> 8, c = n & 255; return c < 128 ? h * 128 + c : 2048 + h * 128 + (c - 128); } };
struct RmUp  { __device__ __forceinline__ int operator()(int n) const { return (n >> 7) * 256 + (n & 127); } };
struct RmGate{ __device__ __forceinline__ int operator()(int n) const { return (n >> 7) * 256 + 128 + (n & 127); } };

__device__ __forceinline__ void sincos_d(double a, double& s, double& c) {
    const double kd = __builtin_rint(a * 0.63661977236758134308); const long k = (long)kd;
    double r = __builtin_fma(-kd, 1.57079632679489655800e+00, a); r = __builtin_fma(-kd, 6.12323399573676603587e-17, r);
    const double r2 = r * r;
    double sp = 1.0 / 6227020800.0; sp = sp * r2 - 1.0 / 39916800.0; sp = sp * r2 + 1.0 / 362880.0; sp = sp * r2 - 1.0 / 5040.0; sp = sp * r2 + 1.0 / 120.0; sp = sp * r2 - 1.0 / 6.0; sp = sp * r2 * r + r;
    double cp = 1.0 / 479001600.0; cp = cp * r2 - 1.0 / 3628800.0; cp = cp * r2 + 1.0 / 40320.0; cp = cp * r2 - 1.0 / 720.0; cp = cp * r2 + 1.0 / 24.0; cp = cp * r2 - 0.5; cp = cp * r2 + 1.0;
    const int q = (int)(k & 3);
    s = (q == 0) ? sp : (q == 1) ? cp : (q == 2) ? -sp : -cp;
    c = (q == 0) ? cp : (q == 1) ? -sp : (q == 2) ? -cp : sp;
}

__device__ __forceinline__ void ssm_weights_group(int g, const float* a_re, const float* a_im, const float* b_re, const float* b_im, const float* c_re, const float* c_im,
                                                  const float* log_dt, const float* dskip, bf16* W1t, bf16* W2t, LAS float* L, int tid) {
    LAS float* PW = L;
    LAS float* BB = PW + 2 * 17 * 64 * 2;
    LAS float* CC = BB + 2 * 64 * 16 * 2;
    LAS float* KT = CC + 2 * 16 * 64 * 2;
    for (int i = tid; i < 2 * 17 * 64; i += 512) { const int d = i / (17 * 64), e = (i / 64) % 17, p = i & 63;
        const double dt = exp((double)log_dt[d * 128 + g]); const double are = a_re[(d * 128 + g) * 64 + p], aim = a_im[(d * 128 + g) * 64 + p];
        const double mag = exp((double)e * dt * are); double s, c; sincos_d((double)e * dt * aim, s, c);
        PW[i * 2] = (float)(mag * c); PW[i * 2 + 1] = (float)(mag * s); }
    for (int i = tid; i < 2 * 64 * 16; i += 512) { const int d = i / 1024, p = (i >> 4) & 63, h = i & 15;
        const double dt = exp((double)log_dt[d * 128 + g]); const double are = a_re[(d * 128 + g) * 64 + p], aim = a_im[(d * 128 + g) * 64 + p];
        const double x = dt * are, y = dt * aim; double sy, cy, sh, ch; sincos_d(y, sy, cy); sincos_d(0.5 * y, sh, ch);
        const double em1 = expm1(x); const double re1 = em1 * cy - 2.0 * sh * sh, im1 = (em1 + 1.0) * sy;
        const double den = are * are + aim * aim; const double qre = (re1 * are + im1 * aim) / den, qim = (im1 * are - re1 * aim) / den;
        const size_t bi = ((size_t)((d * 128 + g) * 64 + p)) * 16 + h; const double br = b_re[bi], bim = b_im[bi];
        BB[i * 2] = (float)(qre * br - qim * bim); BB[i * 2 + 1] = (float)(qre * bim + qim * br); }
    for (int i = tid; i < 2 * 16 * 64; i += 512) { const int d = i / 1024, h = (i >> 6) & 15, p = i & 63; const size_t ci = ((size_t)((d * 128 + g) * 16 + h)) * 64 + p;
        CC[i * 2] = c_re[ci]; CC[i * 2 + 1] = c_im[ci]; }
    __syncthreads();
    { const int d = tid >> 8, e = (tid >> 4) & 15, h = tid & 15; float acc[16];
#pragma unroll
        for (int q = 0; q < 16; ++q) acc[q] = 0.f;
        for (int p = 0; p < 64; ++p) { const float cr = CC[((d * 16 + h) * 64 + p) * 2], ci = CC[((d * 16 + h) * 64 + p) * 2 + 1];
            const float pr = PW[((d * 17 + e) * 64 + p) * 2], pi = PW[((d * 17 + e) * 64 + p) * 2 + 1];
            const float tr = cr * pr - ci * pi, ti = cr * pi + ci * pr; const LAS f32x4* bp = (const LAS f32x4*)(BB + ((d * 64 + p) * 16) * 2);
#pragma unroll
            for (int q = 0; q < 8; ++q) { const f32x4 b = bp[q]; acc[2 * q] += tr * b[0] - ti * b[1]; acc[2 * q + 1] += tr * b[2] - ti * b[3]; } }
#pragma unroll
        for (int q = 0; q < 16; ++q) KT[((d * 16 + e) * 16 + h) * 16 + q] = acc[q]; }
    __syncthreads();
    for (int i = tid; i < 256 * 32; i += 512) { const int n = i >> 5, k0 = (i & 31) * 8; const int d = n >> 7, im = (n >> 6) & 1, p = n & 63; const int s = k0 >> 4, h0 = k0 & 15, e = d ? s : 15 - s;
        const float pr = PW[((d * 17 + e) * 64 + p) * 2], pi = PW[((d * 17 + e) * 64 + p) * 2 + 1]; float v[8];
#pragma unroll
        for (int j = 0; j < 8; ++j) { const float br = BB[((d * 64 + p) * 16 + h0 + j) * 2], bi = BB[((d * 64 + p) * 16 + h0 + j) * 2 + 1]; v[j] = im ? (pr * bi + pi * br) : (pr * br - pi * bi); }
        v4u o; o.x = pk2(v[0], v[1]); o.y = pk2(v[2], v[3]); o.z = pk2(v[4], v[5]); o.w = pk2(v[6], v[7]);
        *(GAS v4u*)(W1t + ((size_t)(g * 256 + n)) * 256 + k0) = o; }
    for (int i = tid; i < 256 * 64; i += 512) { const int n = i >> 6, k0 = (i & 63) * 8; const int j = n >> 4, h = n & 15; float v[8];
        if (k0 < 256) { const int d = k0 >> 7, im = (k0 >> 6) & 1, p0 = k0 & 63, e = d ? 16 - j : j + 1;
#pragma unroll
            for (int q = 0; q < 8; ++q) { const int p = p0 + q; const float cr = CC[((d * 16 + h) * 64 + p) * 2], ci = CC[((d * 16 + h) * 64 + p) * 2 + 1];
                const float pr = PW[((d * 17 + e) * 64 + p) * 2], pi = PW[((d * 17 + e) * 64 + p) * 2 + 1]; v[q] = im ? -(cr * pi + ci * pr) : (cr * pr - ci * pi); }
        } else { const int s = (k0 - 256) >> 4, h0 = (k0 - 256) & 15;
#pragma unroll
            for (int q = 0; q < 8; ++q) { const int hh = h0 + q; float val = 0.f;
                if (s <= j) val += KT[((0 * 16 + (j - s)) * 16 + h) * 16 + hh];
                if (s >= j) val += KT[((1 * 16 + (s - j)) * 16 + h) * 16 + hh];
                if (s == j && h == hh) val += dskip[g * 16 + h];
                v[q] = val; } }
        v4u o; o.x = pk2(v[0], v[1]); o.y = pk2(v[2], v[3]); o.z = pk2(v[4], v[5]); o.w = pk2(v[6], v[7]);
        *(GAS v4u*)(W2t + ((size_t)(g * 256 + n)) * 512 + k0) = o; }
    __syncthreads();
}
#ifndef PROBE_ATTN
#define PROBE_ATTN 1
#endif
#ifndef PROBE_P0
#define PROBE_P0 1
#endif
#ifndef PROBE_P1
#define PROBE_P1 1
#endif
#ifndef PROBE_P7
#define PROBE_P7 1
#endif
#ifndef PROBE_FA
#define PROBE_FA 1
#endif

struct Args { const float* in[27]; float* out; unsigned char* ws; int ph_lo, ph_hi; };

__global__ void __launch_bounds__(NWAVES * 64, 2) enc_fwd(Args args) {
    extern __shared__ __attribute__((aligned(16))) unsigned char lds[];
    LAS unsigned char* ldsb = (LAS unsigned char*)lds;
    volatile LAS unsigned* MISC = (volatile LAS unsigned*)(ldsb + MISC_OFF);
    const int wave0 = __builtin_amdgcn_readfirstlane(threadIdx.x >> 6);
    const int G = gridDim.x, bx = blockIdx.x; const int vcu = (G % 8 == 0) ? (bx % 8) * (G / 8) + bx / 8 : bx;
    const int NGW = G * NWAVES, NGT = G * NWAVES * 64;
    gu32* ctl = (gu32*)(args.ws + WS_CTL);
#define PHB unsigned char* wsl = args.ws; unsigned char* outl = (unsigned char*)args.out; asm volatile("" : "+s"(wsl), "+s"(outl)); \
    int tid = wave0 * 64 + (int)__builtin_amdgcn_mbcnt_hi(~0u, __builtin_amdgcn_mbcnt_lo(~0u, 0u)); asm volatile("" : "+v"(tid)); const int lane = tid & 63, wave = wave0; \
    const int gw = vcu * NWAVES + wave, gt = vcu * (NWAVES * 64) + tid; (void)lane; (void)gw; (void)gt; (void)wsl; (void)outl
#define x_p (args.in[0])
#define x_s (args.in[1])
#define rstd_x ((float*)(wsl + WS_RSTDX))
#define rstd_q ((float*)(wsl + WS_RSTDQ))
#define rstd_kv ((float*)(wsl + WS_RSTDKV))
#define r2v ((float*)(wsl + WS_R2))
#define ratio ((float*)(wsl + WS_RATIO))
#define rstd_x1 ((float*)(wsl + WS_RSTDX1))
#define stA ((float*)(wsl + WS_STA))
#define stB ((float*)(wsl + WS_STB))
#define stQ ((float*)(wsl + WS_STQ))
#define stKV ((float*)(wsl + WS_STKV))
#define ropetab ((float*)(wsl + WS_ROPE))
#define Wi ((bf16*)(wsl + WS_WIN))
#define Wglu ((bf16*)(wsl + WS_WGLU))
#define Wq ((bf16*)(wsl + WS_WQ))
#define Wkv ((bf16*)(wsl + WS_WKV))
#define Wout ((bf16*)(wsl + WS_WOUT))
#define Wug ((bf16*)(wsl + WS_WUG))
#define Wdn ((bf16*)(wsl + WS_WDN))
#define W1t ((bf16*)(wsl + WS_W1T))
#define W2t ((bf16*)(wsl + WS_W2T))
#define bufA ((bf16*)(wsl + WS_A))
#define bufB ((bf16*)(wsl + WS_B))
#define qlat ((bf16*)(wsl + WS_QLAT))
#define kvlat ((bf16*)(wsl + WS_KVLAT))
#define krope ((bf16*)(wsl + WS_KROPE))
#define gact ((bf16*)(wsl + WS_GACT))
#define hup ((bf16*)(wsl + WS_HUP))
#define hgate ((bf16*)(wsl + WS_HGATE))
#define X ((bf16*)(outl + OUT_X))
#define mrg ((bf16*)(outl + OUT_X))
#define kvb ((bf16*)(outl + OUT_KV))
#define vtb ((bf16*)(outl + OUT_KV) + (size_t)T * 2048)
#define xoutf ((float*)outl)
    for (int u = threadIdx.x; u < (LDS_BYTES - LDSCTL_OFF) / 4; u += NWAVES * 64) ((LAS unsigned*)(ldsb + LDSCTL_OFF))[u] = 0u;
    __syncthreads();
    XcdBarrier bar = xcd_barrier_post((unsigned*)(ctl + CW_BAR), MISC + 8);
    const int lo = args.ph_lo, hi = args.ph_hi;
#ifndef PHMASK
#define PHMASK 0xfffffffu
#endif
#define IN(k) (((PHMASK >> ((k) < 9 ? (k) : ((k) >= 18 ? 12 : 9 + ((k) - 9) % 3))) & 1u) && lo <= (k) && (k) < hi)
#define SEAM(k) do { if (IN(k) && IN((k) + 1)) xcd_barrier(bar); } while (0)

#pragma unroll 1
    for (int rep = 0; rep < PROBE_P0; ++rep)
    if (IN(0)) {
        PHB;
        if (rep) __syncthreads();
        if (vcu < 128) ssm_weights_group(vcu, args.in[4], args.in[5], args.in[6], args.in[7], args.in[8], args.in[9], args.in[10], args.in[11], W1t, W2t, (LAS float*)ldsb, tid);
        LAS float* scr = (LAS float*)(ldsb + wave * (64 * TRS * 4));
        constexpr int I_IN = 64 * 55, I_GLU = 32 * 32, I_Q = 14 * 48, I_KV = 8 * 64, I_OUT = 64 * 64, I_UP = 64 * 172, I_DN = 172 * 64;
#define TR_M(off, W_, K_, N_, WT_, G1, G2, KS, RM, CNT) transpose_range(W_, K_, N_, WT_, G1, G2, KS, RM, scr, ((gw - (off)) % NGW + NGW) % NGW, CNT, NGW, lane)
        TR_M(0, args.in[2], 4096, 3520, Wi, args.in[3], args.in[3], 4096, RmWin(), I_IN);
        TR_M(I_IN, args.in[12], 2048, 2048, Wglu, nullptr, nullptr, 0, RmId(), I_GLU);
        TR_M(I_IN + I_GLU, args.in[14], 896, 3072, Wq, args.in[13], args.in[13], 896, RmQ(), I_Q);
        TR_M(I_IN + I_GLU + I_Q, args.in[16], 512, 4096, Wkv, args.in[15], args.in[15], 512, RmKV(), I_KV);
        TR_M(I_IN + I_GLU + I_Q + I_KV, args.in[19], 4096, 4096, Wout, args.in[17], args.in[18], 2048, RmId(), I_OUT);
        TR_M(I_IN + I_GLU + I_Q + I_KV + I_OUT, args.in[21], 4096, 11008, Wug, args.in[20], args.in[20], 4096, RmUp(), I_UP);
        TR_M(I_IN + I_GLU + I_Q + I_KV + I_OUT + I_UP, args.in[22], 4096, 11008, Wug, args.in[20], args.in[20], 4096, RmGate(), I_UP);
        TR_M(I_IN + I_GLU + I_Q + I_KV + I_OUT + 2 * I_UP, args.in[25], 11008, 4096, Wdn, nullptr, nullptr, 0, RmId(), I_DN);
#undef TR_M
        for (int i = gt; i < 320 * 512; i += NGT) { const int rr = i >> 9, c8 = (i & 511) * 8; const int row = rr < 128 ? 2944 + rr : 3648 + (rr - 128);
            *(GAS v4u*)(Wi + (size_t)row * 4096 + c8) = (v4u){0u, 0u, 0u, 0u}; }
        for (int m = gw; m < T; m += 2 * NGW) {
            const int m1 = m + NGW; const bool h1 = m1 < T;
            const float* xr0 = m < 16384 ? x_p + (size_t)m * DM : x_s + (size_t)(m - 16384) * DM; const float* xr1 = !h1 ? xr0 : (m1 < 16384 ? x_p + (size_t)m1 * DM : x_s + (size_t)(m1 - 16384) * DM);
            f32x4 v[16], w[16]; float s = 0.f, s1 = 0.f;
#pragma unroll
            for (int j = 0; j < 16; ++j) v[j] = *((const GAS f32x4*)xr0 + lane + 64 * j);
#pragma unroll
            for (int j = 0; j < 16; ++j) w[j] = *((const GAS f32x4*)xr1 + lane + 64 * j);
#pragma unroll
            for (int j = 0; j < 16; ++j) s += (v[j].x * v[j].x + v[j].y * v[j].y) + (v[j].z * v[j].z + v[j].w * v[j].w);
            s = wave_sum(s); if (lane == 0) rstd_x[m] = 1.0f / sqrtf(s * (1.0f / DM) + EPS);
            { GAS v2u* o8 = (GAS v2u*)(bufA + (size_t)m * DM) + lane;
#pragma unroll
              for (int j = 0; j < 16; ++j) o8[64 * j] = (v2u){pg8::cvt_pk_bf16(v[j].x, v[j].y), pg8::cvt_pk_bf16(v[j].z, v[j].w)}; }
            if (h1) {
#pragma unroll
                for (int j = 0; j < 16; ++j) s1 += (w[j].x * w[j].x + w[j].y * w[j].y) + (w[j].z * w[j].z + w[j].w * w[j].w);
                s1 = wave_sum(s1); if (lane == 0) rstd_x[m1] = 1.0f / sqrtf(s1 * (1.0f / DM) + EPS);
                GAS v2u* o8 = (GAS v2u*)(bufA + (size_t)m1 * DM) + lane;
#pragma unroll
                for (int j = 0; j < 16; ++j) o8[64 * j] = (v2u){pg8::cvt_pk_bf16(w[j].x, w[j].y), pg8::cvt_pk_bf16(w[j].z, w[j].w)}; } }
        for (int i = gt; i < 8192 * 32; i += NGT) { const int pos = i >> 5, k = i & 31; const double inv = exp(-(double)k * (9.210340371976184 / 32.0));
            double s, c; sincos_d((double)pos * inv, s, c); *(GAS f32x2*)(ropetab + (size_t)i * 2) = (f32x2){(float)c, (float)s}; }
    }
    SEAM(0);

#pragma unroll 1
    for (int rep = 0; rep < PROBE_P1; ++rep)
    if (IN(1)) {
        PHB;
        pg8::Gemm g{bufA, Wi, DM, DM, DM}; pg8::StaticOrder S; S.init(T, 3840, G, bx);
        pg8::EpiWin E{rstd_x, X, qlat, kvlat, krope, stQ, stKV, ropetab};
        pg8::gemm_phase(ldsb, g, S, E, tid);
    }
    SEAM(1);

    if (IN(2)) {
        PHB;
        pg8::Gemm g{X + 256, W1t, 512, 256, 256}; pg8::GroupOrder S{768, 6, G, vcu};
        pg8::EpiSsm1 E{X};
        pg8::gemm_phase(ldsb, g, S, E, tid);
        for (int r = gt; r < T; r += NGT) { float s = 0.f;
#pragma unroll
            for (int j = 0; j < 4; ++j) { const f32x4 v = *(const GAS f32x4*)(stQ + (size_t)r * 16 + 4 * j); s += (v.x + v.y) + (v.z + v.w); }
            rstd_q[r] = 1.0f / sqrtf(s * (1.0f / QLAT) + EPS); float s2 = 0.f;
#pragma unroll
            for (int j = 0; j < 2; ++j) { const f32x4 v = *(const GAS f32x4*)(stKV + (size_t)r * 8 + 4 * j); s2 += (v.x + v.y) + (v.z + v.w); }
            rstd_kv[r] = 1.0f / sqrtf(s2 * (1.0f / KVLAT) + EPS); }
    }
    SEAM(2);

    if (IN(3)) {
        PHB;
        const bool scan_cu = (G == 256) ? ((vcu & 1) == 0) : true;
        if (G == 256 ? scan_cu : (wave < 4)) { const int task = (G == 256) ? (vcu >> 1) * 8 + wave : vcu * 4 + wave;
            if (task < 1024) { const int seq = task >> 8, g = (task >> 1) & 127, dir = task & 1, p = lane;
                const int c0 = seq < 2 ? seq * 512 : 1024 + (seq - 2) * 256, nc = seq < 2 ? 512 : 256;
                const double dt = exp((double)args.in[10][dir * 128 + g]); const double are = args.in[4][(dir * 128 + g) * 64 + p], aim = args.in[5][(dir * 128 + g) * 64 + p];
                const double mag = exp(16.0 * dt * are); double sn, cs; sincos_d(16.0 * dt * aim, sn, cs);
                const float ar = (float)(mag * cs), ai = (float)(mag * sn);
                GAS bf16* Xg = (GAS bf16*)X + (size_t)g * NCHUNK * 512 + dir * 128 + p;
                float zr = 0.f, zi = 0.f;
                for (int cb = 0; cb < nc; cb += 16) {
                    unsigned short sre[16], sim[16];
#pragma unroll
                    for (int i = 0; i < 16; ++i) { const int c = dir ? (c0 + nc - 1 - (cb + i)) : (c0 + cb + i); sre[i] = Xg[(size_t)c * 512]; sim[i] = Xg[(size_t)c * 512 + 64]; }
#pragma unroll
                    for (int i = 0; i < 16; ++i) { const int c = dir ? (c0 + nc - 1 - (cb + i)) : (c0 + cb + i);
                        Xg[(size_t)c * 512] = (bf16)f2bf(zr); Xg[(size_t)c * 512 + 64] = (bf16)f2bf(zi);
                        const float sr = bf2f(sre[i]), si = bf2f(sim[i]); const float nr = ar * zr - ai * zi + sr, ni = ar * zi + ai * zr + si; zr = nr; zi = ni; }
                }
            }
        }
        __syncthreads();
        if (G == 256) { pg8::Gemm g{qlat, Wq, QLAT, QLAT, QLAT}; pg8::RangeOrder S{scan_cu ? (vcu >> 1) * 3 : 384 + (vcu >> 1) * 6, scan_cu ? 3 : 6, 12}; pg8::EpiQ E{rstd_q, bufB, ropetab}; pg8::gemm_phase(ldsb, g, S, E, tid); }
        else { pg8::Gemm g{qlat, Wq, QLAT, QLAT, QLAT}; pg8::StaticOrder S; S.init(T, QW, G, bx); pg8::EpiQ E{rstd_q, bufB, ropetab}; pg8::gemm_phase(ldsb, g, S, E, tid); }
        { pg8::Gemm g{kvlat, Wkv, KVLAT, KVLAT, KVLAT}; pg8::StaticOrder S; S.init(T, 2048, G, bx); pg8::EpiKV E{rstd_kv, kvb}; pg8::gemm_phase(ldsb, g, S, E, tid); }
        { pg8::Gemm g{Wkv + (size_t)2048 * KVLAT, kvlat, KVLAT, KVLAT, KVLAT}; pg8::StaticOrder S; S.init(2048, T, G, bx); pg8::EpiVT E{rstd_kv, vtb}; pg8::gemm_phase(ldsb, g, S, E, tid); }
    }
    SEAM(3);

    if (IN(4)) {
        PHB;
        pg8::Gemm g{X, W2t, 512, 512, 512}; pg8::GroupOrder S{768, 6, G, vcu};
        pg8::EpiSsm2 E{gact};
        pg8::gemm_phase(ldsb, g, S, E, tid);
    }
    SEAM(4);

    if (IN(5)) {
        PHB;
#ifndef NO_GLU
        { pg8::Gemm g{gact, Wglu, MIXW, MIXW, MIXW}; pg8::StaticOrder S; S.init(T, MIXW, G, bx); pg8::EpiGlu E{gact, mrg, stA}; pg8::gemm_phase(ldsb, g, S, E, tid); }
#endif
#ifndef NO_ATTN
        const int xcd = vcu >> 5, cc = vcu & 31; const int nun = (G == 256) ? 6 : (1536 - bx + G - 1) / G;
#pragma unroll 1
        for (int i = 0; i < nun; ++i) {
            int bh, qb, seq, rowbase;
            if (G == 256) { if (i < 4) { bh = xcd * 4 + i; qb = cc; seq = 8192; } else { bh = xcd * 4 + 2 * (i - 4) + (cc >> 4); qb = cc & 15; seq = 4096; } }
            else { const int uidx = bx + i * G; if (uidx < 1024) { bh = uidx >> 5; qb = uidx & 31; seq = 8192; } else { const int v = uidx - 1024; bh = v >> 4; qb = v & 15; seq = 4096; } }
            const int b = bh >> 4, h = bh & 15; rowbase = (seq == 8192) ? b * 8192 : 16384 + b * 4096;
            __syncthreads();
            attn::attn_unit(bufB + (size_t)(rowbase + qb * 256) * QW + h * 192, kvb + (size_t)rowbase * 2048 + h * 128, vtb + (size_t)(h * 128) * T,
                            krope + (size_t)rowbase * 64, mrg + (size_t)(rowbase + qb * 256) * DM + 2048 + h * 128, stB + (size_t)(rowbase + qb * 256) * 16 + h, seq, rowbase, (char*)lds, wave0);
        }
#endif
    }
    SEAM(5);

    if (IN(6)) {
        PHB;
        for (int r = gt; r < T; r += NGT) { float s = 0.f;
#pragma unroll
            for (int j = 0; j < 8; ++j) { const f32x4 v = *(const GAS f32x4*)(stA + (size_t)r * 32 + 4 * j); s += (v.x + v.y) + (v.z + v.w); }
            const float r1 = 1.0f / sqrtf(s * (1.0f / MIXW) + EPS); float s2 = 0.f;
#pragma unroll
            for (int j = 0; j < 4; ++j) { const f32x4 v = *(const GAS f32x4*)(stB + (size_t)r * 16 + 4 * j); s2 += (v.x + v.y) + (v.z + v.w); }
            const float r2 = 1.0f / sqrtf(s2 * (1.0f / MIXW) + EPS); r2v[r] = r2; ratio[r] = r1 / r2; }
    }
    SEAM(6);

#pragma unroll 1
    for (int rep = 0; rep < PROBE_P7; ++rep)
    if (IN(7)) {
        PHB;
        pg8::Gemm g{mrg, Wout, DM, DM, DM}; pg8::StaticOrder S; S.init(T, DM, G, bx);
        pg8::EpiWout E{bufA, r2v, ratio, bufA, stA};
        pg8::gemm_phase(ldsb, g, S, E, tid);
    }
    SEAM(7);

    if (IN(8)) {
        PHB;
        for (int r = gt; r < T; r += NGT) { float s = 0.f;
#pragma unroll
            for (int j = 0; j < 16; ++j) { const f32x4 v = *(const GAS f32x4*)(stA + (size_t)r * 64 + 4 * j); s += (v.x + v.y) + (v.z + v.w); }
            rstd_x1[r] = 1.0f / sqrtf(s * (1.0f / DM) + EPS); }
    }
    SEAM(8);

#ifdef PROBE_DOWN
    if (IN(9)) { PHB;
#pragma unroll 1
        for (int ch = 0; ch < 3; ++ch) { pg8::Gemm g{bufB, Wdn, DFF, DFF, DFF}; pg8::StaticOrder S; S.init(8192, DM, G, bx); pg8::EpiNull E0; pg8::gemm_phase(ldsb, g, S, E0, tid); }
    }
#endif
#ifdef PROBE_KLOOP
    if (IN(9)) {
        PHB;
#pragma unroll 1
        for (int ch = 0; ch < 3; ++ch) { pg8::Gemm g{bufA + (size_t)(ch * 8192) * DM, Wug, DM, DM, DM}; pg8::StaticOrder S; S.init(8192, 2 * DFF, G, bx); pg8::EpiNull E0; pg8::gemm_phase(ldsb, g, S, E0, tid); }
    }
#endif
#pragma unroll 1
    for (int ch2 = 0; ch2 < 3 * PROBE_FA; ++ch2) {
        const int ch = ch2 / PROBE_FA; const bool lastrep = (ch2 % PROBE_FA) == PROBE_FA - 1;
        const int rb = ch * 8192;
        if (IN(9 + 3 * ch)) {
        PHB;
            pg8::Gemm g{bufA + (size_t)rb * DM, Wug, DM, DM, DM}; pg8::StaticOrder S; S.init(8192, 2 * DFF, G, bx);
            pg8::EpiFfnA E{rstd_x1, rb, bufB, hup, hgate, args.in[23], args.in[24]};
            pg8::gemm_phase(ldsb, g, S, E, tid);
        }
        SEAM(9 + 3 * ch);
        if (lastrep && IN(10 + 3 * ch)) {
        PHB;
            const float* cw = args.in[23]; const float* cb = args.in[24];
            for (int i = gt; i < 128 * 2 * (DFF / 8); i += NGT) { const int f0 = (i % (DFF / 8)) * 8, sw = i / (DFF / 8), strip = sw >> 1, which = sw & 1;
                const int lrow = strip * 64 + (which ? 63 : 0), grow = rb + lrow, pos = pos_of(grow), len = len_of(grow);
                v4u up0, up1, up2;
                if (which == 0) { up1 = *(const GAS v4u*)(hup + ((size_t)strip * 4 + 0) * DFF + f0); up2 = *(const GAS v4u*)(hup + ((size_t)strip * 4 + 1) * DFF + f0);
                    up0 = (pos == 0) ? (v4u){0u, 0u, 0u, 0u} : *(const GAS v4u*)(hup + ((size_t)(strip - 1) * 4 + 3) * DFF + f0); }
                else { up0 = *(const GAS v4u*)(hup + ((size_t)strip * 4 + 2) * DFF + f0); up1 = *(const GAS v4u*)(hup + ((size_t)strip * 4 + 3) * DFF + f0);
                    up2 = (pos == len - 1) ? (v4u){0u, 0u, 0u, 0u} : *(const GAS v4u*)(hup + ((size_t)(strip + 1) * 4 + 0) * DFF + f0); }
                const v4u gt4 = *(const GAS v4u*)(hgate + ((size_t)strip * 2 + which) * DFF + f0);
                unsigned ow[4];
#pragma unroll
                for (int k = 0; k < 4; ++k) { const int f = f0 + 2 * k;
                    const float a0 = bflo(up0[k]), a1 = bflo(up1[k]), a2 = bflo(up2[k]), b0 = bfhi(up0[k]), b1 = bfhi(up1[k]), b2 = bfhi(up2[k]);
                    const float c0 = cw[f] * a0 + cw[DFF + f] * a1 + cw[2 * DFF + f] * a2 + cb[f], c1 = cw[f + 1] * b0 + cw[DFF + f + 1] * b1 + cw[2 * DFF + f + 1] * b2 + cb[f + 1];
                    ow[k] = pk2(c0 * sigmoidf_fast(c0) * bflo(gt4[k]), c1 * sigmoidf_fast(c1) * bfhi(gt4[k])); }
                *(GAS v4u*)(bufB + (size_t)lrow * DFF + f0) = (v4u){ow[0], ow[1], ow[2], ow[3]}; }
        }
        if (lastrep) SEAM(10 + 3 * ch);
        if (lastrep && IN(11 + 3 * ch)) {
        PHB;
            pg8::Gemm g{bufB, Wdn, DFF, DFF, DFF}; pg8::StaticOrder S; S.init(8192, DM, G, bx);
            pg8::EpiDown E{bufA, rb, stA};
            pg8::gemm_phase(ldsb, g, S, E, tid);
        }
        if (lastrep) SEAM(11 + 3 * ch);
    }

    if (IN(18)) {
        PHB;
        const GAS f32x4* gr = (const GAS f32x4*)args.in[26] + 2 * lane; f32x4 gv[16];
#pragma unroll
        for (int j = 0; j < 8; ++j) { gv[2 * j] = gr[128 * j]; gv[2 * j + 1] = gr[128 * j + 1]; }
        for (int m = gw; m < T; m += 2 * NGW) { const int m1 = m + NGW; const bool h1 = m1 < T; const int mb = h1 ? m1 : m;
            const GAS v4u* xr0 = (const GAS v4u*)(bufA + (size_t)m * DM) + lane; const GAS v4u* xr1 = (const GAS v4u*)(bufA + (size_t)mb * DM) + lane;
            v4u w0[8], w1[8];
#pragma unroll
            for (int j = 0; j < 8; ++j) w0[j] = xr0[64 * j];
#pragma unroll
            for (int j = 0; j < 8; ++j) w1[j] = xr1[64 * j];
            const float s0 = wave_sum(stA[(size_t)m * 64 + lane]), s1 = wave_sum(stA[(size_t)mb * 64 + lane]);
            const float rs0 = 1.0f / sqrtf(s0 * (1.0f / DM) + EPS), rs1 = 1.0f / sqrtf(s1 * (1.0f / DM) + EPS);
            { GAS f32x4* orow = (GAS f32x4*)(xoutf + (size_t)m * DM) + 2 * lane;
#pragma unroll
              for (int j = 0; j < 8; ++j) { const v4u w = w0[j]; const f32x4 g0 = gv[2 * j], g1 = gv[2 * j + 1];
                orow[128 * j] = (f32x4){bflo(w.x) * rs0 * g0[0], bfhi(w.x) * rs0 * g0[1], bflo(w.y) * rs0 * g0[2], bfhi(w.y) * rs0 * g0[3]};
                orow[128 * j + 1] = (f32x4){bflo(w.z) * rs0 * g1[0], bfhi(w.z) * rs0 * g1[1], bflo(w.w) * rs0 * g1[2], bfhi(w.w) * rs0 * g1[3]}; } }
            if (h1) { GAS f32x4* orow = (GAS f32x4*)(xoutf + (size_t)m1 * DM) + 2 * lane;
#pragma unroll
              for (int j = 0; j < 8; ++j) { const v4u w = w1[j]; const f32x4 g0 = gv[2 * j], g1 = gv[2 * j + 1];
                orow[128 * j] = (f32x4){bflo(w.x) * rs1 * g0[0], bfhi(w.x) * rs1 * g0[1], bflo(w.y) * rs1 * g0[2], bfhi(w.y) * rs1 * g0[3]};
                orow[128 * j + 1] = (f32x4){bflo(w.z) * rs1 * g1[0], bfhi(w.z) * rs1 * g1[1], bflo(w.w) * rs1 * g1[2], bfhi(w.w) * rs1 * g1[3]}; } }
        }
    }
#undef IN
#undef SEAM
}

constexpr int N_PHASES = 19;
extern "C" void kernel_launch(void* const* d_in, const int* in_sizes, int n_in, void* d_out, int out_size, void* d_ws, size_t ws_size, hipStream_t stream) {
    static int grid = 0;
    if (grid == 0) {
        if (n_in != 27 || out_size != T * DM || ws_size < WS_END) { fprintf(stderr, "kernel_launch: unexpected shapes (n_in %d out %d ws %zu)\n", n_in, out_size, ws_size); grid = -1; return; }
        int dev = 0, cus = 0, per_cu = 0;
        if (hipGetDevice(&dev) != hipSuccess || hipDeviceGetAttribute(&cus, hipDeviceAttributeMultiprocessorCount, dev) != hipSuccess) { grid = -1; return; }
        if (hipFuncSetAttribute((const void*)enc_fwd, hipFuncAttributeMaxDynamicSharedMemorySize, LDS_BYTES) != hipSuccess) { fprintf(stderr, "kernel_launch: hipFuncSetAttribute failed\n"); grid = -1; return; }
        if (hipOccupancyMaxActiveBlocksPerMultiprocessor(&per_cu, (const void*)enc_fwd, NWAVES * 64, LDS_BYTES) != hipSuccess || per_cu < 1) { fprintf(stderr, "kernel_launch: occupancy query says %d\n", per_cu); }
        (void)hipGetLastError();
        grid = cus;
    }
    if (grid < 0) return;
    if (hipMemsetAsync((char*)d_ws + WS_CTL, 0, CTL_ZERO_BYTES, stream) != hipSuccess) return;
    Args a{};
    for (int i = 0; i < 27; ++i) a.in[i] = (const float*)d_in[i];
    a.out = (float*)d_out; a.ws = (unsigned char*)d_ws;
#ifndef MK_N_LAUNCHES
#define MK_N_LAUNCHES 1
#endif
    if (MK_N_LAUNCHES == 1) { a.ph_lo = 0; a.ph_hi = N_PHASES; hipLaunchKernelGGL(enc_fwd, dim3(grid), dim3(NWAVES * 64), LDS_BYTES, stream, a); }
    else { for (int p = 0; p < N_PHASES; ++p) { a.ph_lo = p; a.ph_hi = p + 1; hipLaunchKernelGGL(enc_fwd, dim3(grid), dim3(NWAVES * 64), LDS_BYTES, stream, a); } }
    const hipError_t le = hipPeekAtLastError();
    if (le != hipSuccess) fprintf(stderr, "kernel_launch: launch failed: %s\n", hipGetErrorName(le));
}
```
